# Optimizing an MI355X kernel written in HIP

```python
import jax, jax.numpy as jnp
from jax import lax
import numpy as np

D_MODEL = 2048
BATCH = 2
SEQ = 4096
DEPTH = 1

GRID_W = 64
PLE_DIM = 256
D_ATTN = 1024
N_HEADS = 8
N_KV_HEADS = 2
HEAD_DIM = D_ATTN // N_HEADS
ROPE_THETA = 10000.0
Q_BLOCK = 128
D_SSM = 1024
SSM_GROUP = 16
N_SSM_GROUPS = D_SSM // SSM_GROUP
SSM_STATE = 64
DT_MIN = 0.001
DT_MAX = 0.1
D_MIX = D_ATTN + D_SSM
D_KV = N_KV_HEADS * HEAD_DIM
IN_SPLITS = (D_ATTN, D_KV, D_KV, D_ATTN, D_SSM, D_SSM)
D_IN = sum(IN_SPLITS)
EPS = 1e-6

kernel_name = "hybrid_gqa_axialrope_bis5_block"


def rms_norm(x, g):
    xf = x.astype(jnp.float32)
    y = xf * lax.rsqrt(jnp.mean(xf * xf, axis=-1, keepdims=True) + EPS)
    return (y * g.astype(jnp.float32)).astype(x.dtype)


def _rotate(x, ang):
    x1, x2 = jnp.split(x, 2, axis=-1)
    c = jnp.cos(ang)[None, :, None, :]
    s = jnp.sin(ang)[None, :, None, :]
    return jnp.concatenate([x1 * c - x2 * s, x2 * c + x1 * s], axis=-1)


def axial_rope(x, ang_row, ang_col):
    xf = x.astype(jnp.float32)
    half = x.shape[-1] // 2
    out = jnp.concatenate([_rotate(xf[..., :half], ang_row),
                           _rotate(xf[..., half:], ang_col)], axis=-1)
    return out.astype(x.dtype)


def grid_angles(L):
    rows_n = L // GRID_W
    rows = jnp.repeat(jnp.arange(rows_n), GRID_W).astype(jnp.float32)
    cols = jnp.tile(jnp.arange(GRID_W), rows_n).astype(jnp.float32)
    n_freq = HEAD_DIM // 4
    inv_freq = ROPE_THETA ** (-jnp.arange(n_freq, dtype=jnp.float32) / n_freq)
    return rows[:, None] * inv_freq[None, :], cols[:, None] * inv_freq[None, :]


def block_attention(q, k, v):
    bsz, L, H, Dh = q.shape
    kv = k.shape[2]
    rep = H // kv
    nb = L // Q_BLOCK
    scale = Dh ** -0.5
    qb = q.reshape(bsz, nb, Q_BLOCK, kv, rep, Dh).transpose(1, 0, 2, 3, 4, 5)

    def one_block(qblk):
        s = jnp.einsum('bqkrd,bskd->bkrqs', qblk, k).astype(jnp.float32) * scale
        pr = jax.nn.softmax(s, axis=-1).astype(v.dtype)
        return jnp.einsum('bkrqs,bskd->bqkrd', pr, v)

    o = lax.map(one_block, qb)
    return o.transpose(1, 0, 2, 3, 4, 5).reshape(bsz, L, H * Dh)


def _lin_combine(e1, e2):
    a1, b1 = e1
    a2, b2 = e2
    return a1 * a2, a2 * b1 + b2


def s5_bidirectional(u, a_re, a_im, log_dt, b_re, b_im, c_re, c_im, d):
    bsz, L, _ = u.shape
    ug = u.astype(jnp.float32).reshape(bsz, L, N_SSM_GROUPS, SSM_GROUP)
    uc = ug.astype(jnp.complex64)
    y = d.astype(jnp.float32).reshape(N_SSM_GROUPS, SSM_GROUP) * ug
    for direction in range(2):
        lam = lax.complex(jnp.minimum(a_re[direction].astype(jnp.float32), -1e-4),
                          a_im[direction].astype(jnp.float32))
        dt = jnp.exp(log_dt[direction].astype(jnp.float32))[:, None]
        lam_bar = jnp.exp(lam * dt)
        bmat = lax.complex(b_re[direction].astype(jnp.float32),
                           b_im[direction].astype(jnp.float32))
        b_bar = ((lam_bar - 1.0) / lam)[..., None] * bmat
        bu = jnp.einsum('blgh,gph->blgp', uc, b_bar)
        a = jnp.broadcast_to(lam_bar, bu.shape)
        _, xs = lax.associative_scan(_lin_combine, (a, bu), axis=1,
                                     reverse=(direction == 1))
        cmat = lax.complex(c_re[direction].astype(jnp.float32),
                           c_im[direction].astype(jnp.float32))
        y = y + jnp.real(jnp.einsum('blgp,ghp->blgh', xs, cmat))
    return y.reshape(bsz, L, D_SSM)


def setup_inputs(seed: int = 0) -> dict:
    key = jax.random.key(seed)
    ks = jax.random.split(key, 24)
    f32 = jnp.float32
    G, P, H = N_SSM_GROUPS, SSM_STATE, SSM_GROUP
    nrm = lambda k, shape, s: jax.random.normal(k, shape, f32) * s
    x = jax.random.normal(ks[0], (BATCH, SEQ, D_MODEL), f32)
    p = jax.random.normal(ks[1], (DEPTH, BATCH, SEQ, PLE_DIM), f32)
    norm_mix = 1.0 + nrm(ks[2], (DEPTH, D_MODEL), 0.02)
    w_in = nrm(ks[3], (DEPTH, D_MODEL, D_IN), D_MODEL ** -0.5)
    q_norm = 1.0 + nrm(ks[4], (DEPTH, HEAD_DIM), 0.02)
    k_norm = 1.0 + nrm(ks[5], (DEPTH, HEAD_DIM), 0.02)
    ssm_a_re = -0.5 + nrm(ks[6], (DEPTH, 2, G, P), 0.01)
    ssm_a_im = (np.pi * jnp.arange(P, dtype=f32))[None, None, None, :] + nrm(ks[7], (DEPTH, 2, G, P), 0.01)
    ssm_log_dt = jax.random.uniform(ks[8], (DEPTH, 2, G), f32,
                                    minval=float(np.log(DT_MIN)), maxval=float(np.log(DT_MAX)))
    ssm_b_re = nrm(ks[9], (DEPTH, 2, G, P, H), (0.5 / H) ** 0.5)
    ssm_b_im = nrm(ks[10], (DEPTH, 2, G, P, H), (0.5 / H) ** 0.5)
    ssm_c_re = nrm(ks[11], (DEPTH, 2, G, H, P), (0.5 / P) ** 0.5)
    ssm_c_im = nrm(ks[12], (DEPTH, 2, G, H, P), (0.5 / P) ** 0.5)
    ssm_d = nrm(ks[13], (DEPTH, D_SSM), 1.0)
    w_glu = nrm(ks[14], (DEPTH, D_SSM, 2 * D_SSM), D_SSM ** -0.5)
    b_glu = nrm(ks[15], (DEPTH, 2 * D_SSM), 0.01)
    w_out = nrm(ks[16], (DEPTH, D_MIX, D_MODEL), D_MIX ** -0.5)
    norm_ple = 1.0 + nrm(ks[17], (DEPTH, D_MODEL), 0.02)
    w_ple_gate = nrm(ks[18], (DEPTH, D_MODEL, D_MODEL), D_MODEL ** -0.5)
    w_ple_proj = nrm(ks[19], (DEPTH, PLE_DIM, D_MODEL), PLE_DIM ** -0.5)
    norm_final = 1.0 + nrm(ks[20], (D_MODEL,), 0.02)
    return {"x": x, "p": p, "norm_mix": norm_mix, "w_in": w_in,
            "q_norm": q_norm, "k_norm": k_norm,
            "ssm_a_re": ssm_a_re, "ssm_a_im": ssm_a_im, "ssm_log_dt": ssm_log_dt,
            "ssm_b_re": ssm_b_re, "ssm_b_im": ssm_b_im,
            "ssm_c_re": ssm_c_re, "ssm_c_im": ssm_c_im, "ssm_d": ssm_d,
            "w_glu": w_glu, "b_glu": b_glu, "w_out": w_out,
            "norm_ple": norm_ple, "w_ple_gate": w_ple_gate, "w_ple_proj": w_ple_proj,
            "norm_final": norm_final}


def reference(x, p, norm_mix, w_in, q_norm, k_norm, ssm_a_re, ssm_a_im, ssm_log_dt,
              ssm_b_re, ssm_b_im, ssm_c_re, ssm_c_im, ssm_d, w_glu, b_glu, w_out,
              norm_ple, w_ple_gate, w_ple_proj, norm_final):
    bsz, L, _ = x.shape
    ang_row, ang_col = grid_angles(L)
    split_idx = list(np.cumsum(IN_SPLITS)[:-1])
    h = x
    for i in range(DEPTH):
        hn = rms_norm(h, norm_mix[i])
        z = hn @ w_in[i]
        q, k, v, gate_a, u, gate_s = jnp.split(z, split_idx, axis=-1)

        q = q.reshape(bsz, L, N_HEADS, HEAD_DIM)
        k = k.reshape(bsz, L, N_KV_HEADS, HEAD_DIM)
        v = v.reshape(bsz, L, N_KV_HEADS, HEAD_DIM)
        q = axial_rope(rms_norm(q, q_norm[i]), ang_row, ang_col)
        k = axial_rope(rms_norm(k, k_norm[i]), ang_row, ang_col)
        y_attn = block_attention(q, k, v) * jax.nn.silu(gate_a)

        y_ssm = s5_bidirectional(u, ssm_a_re[i], ssm_a_im[i], ssm_log_dt[i],
                                 ssm_b_re[i], ssm_b_im[i], ssm_c_re[i], ssm_c_im[i],
                                 ssm_d[i])
        y_ssm = jax.nn.gelu(y_ssm).astype(x.dtype)
        glu = y_ssm @ w_glu[i] + b_glu[i]
        y_ssm = glu[..., :D_SSM] * jax.nn.sigmoid(glu[..., D_SSM:])
        y_ssm = y_ssm * jax.nn.silu(gate_s)

        h = h + jnp.concatenate([y_attn, y_ssm], axis=-1) @ w_out[i]

        gate = jax.nn.sigmoid(rms_norm(h, norm_ple[i]) @ w_ple_gate[i])
        h = h + gate * (p[i] @ w_ple_proj[i])
    return rms_norm(h, norm_final)
```

```cpp
#include <hip/hip_runtime.h>
#include <hip/hip_cooperative_groups.h>
#include <cstdio>
#include <cstdint>
namespace cg = cooperative_groups;

#define LAS __attribute__((address_space(3)))
typedef unsigned short bf16_t;
typedef short bf16x8 __attribute__((ext_vector_type(8)));
typedef short s16x4 __attribute__((ext_vector_type(4)));
typedef float f32x4 __attribute__((ext_vector_type(4)));
typedef float f32x16 __attribute__((ext_vector_type(16)));
typedef unsigned u32x4 __attribute__((ext_vector_type(4)));
typedef unsigned u32x2 __attribute__((ext_vector_type(2)));

constexpr int T = 8192, SEQ = 4096, DM = 2048, DIN = 4608, DATT = 1024, DKV = 256, DSSM = 1024, PLE = 256;
constexpr int NG = 64, NCH = T / 16;
constexpr float EPS = 1e-6f;
#ifndef PH_MASK
#define PH_MASK 0xff
#endif

constexpr size_t MiB = 1u << 20;
constexpr size_t WS_W1T = 1 * MiB, WS_WGLUT = 19 * MiB, WS_WOT = 23 * MiB, WS_WGT = 31 * MiB, WS_WPT = 39 * MiB;
constexpr size_t WS_ROPE = 40 * MiB, WS_RINV = 40 * MiB + 65536, WS_LB16 = 40 * MiB + 131072, WS_SSQ1 = 41 * MiB, WS_SSQ2 = 42 * MiB;
constexpr size_t WS_PB = 43 * MiB, WS_WIN = 47 * MiB, WS_WBIG = 55 * MiB;
constexpr size_t WS_XB = 71 * MiB;
constexpr size_t WS_Q = 103 * MiB, WS_K = 119 * MiB, WS_V = 123 * MiB, WS_GA = 127 * MiB, WS_GS = 143 * MiB;
constexpr size_t WS_UCAT = 159 * MiB;
constexpr size_t WS_YMIX = 191 * MiB, WS_YS = 223 * MiB, WS_END = 239 * MiB;

constexpr int RING_BYTES = 131072, XCH_OFF = RING_BYTES, R2_OFF = RING_BYTES + 4096, LDS_BYTES = 147456;

struct Args {
    const float *x, *p, *norm_mix, *w_in, *q_norm, *k_norm, *a_re, *a_im, *log_dt, *b_re, *b_im, *c_re, *c_im, *ssm_d, *w_glu, *b_glu, *w_out, *norm_ple, *w_ple_gate, *w_ple_proj, *norm_final;
    float* out; unsigned char* ws;
};

__device__ __forceinline__ unsigned f2bf(float f) { unsigned u = __builtin_bit_cast(unsigned, f); return (u + 0x7fffu + ((u >> 16) & 1u)) >> 16; }
__device__ __forceinline__ unsigned pk2(float lo, float hi) { return f2bf(lo) | (f2bf(hi) << 16); }
__device__ __forceinline__ float bf2f(unsigned short b) { return __builtin_bit_cast(float, (unsigned)b << 16); }
__device__ __forceinline__ float bflo(unsigned w) { return __builtin_bit_cast(float, w << 16); }
__device__ __forceinline__ float bfhi(unsigned w) { return __builtin_bit_cast(float, w & 0xffff0000u); }
__device__ __forceinline__ unsigned cvt_pk_bf16(float lo, float hi) { unsigned r; asm volatile("v_cvt_pk_bf16_f32 %0, %1, %2" : "=v"(r) : "v"(lo), "v"(hi)); return r; }
__device__ __forceinline__ float sigmoidf_(float v) { return 1.f / (1.f + __expf(-v)); }
__device__ __forceinline__ float siluf_(float v) { return v / (1.f + __expf(-v)); }
__device__ __forceinline__ float gelu_tanh(float v) { const float t = 1.5957691216057308f * (v + 0.044715f * v * v * v); return v / (1.f + __expf(-t)); }
__device__ __forceinline__ float wave_sum(float v) {
#pragma unroll
    for (int o = 1; o < 64; o <<= 1) v += __shfl_xor(v, o);
    return v;
}
#define LDS_WAIT() asm volatile("s_waitcnt lgkmcnt(0)" ::: "memory")
__device__ __forceinline__ int lane_id_opaque() { int l = __builtin_amdgcn_mbcnt_hi(~0u, __builtin_amdgcn_mbcnt_lo(~0u, 0u)); asm volatile("" : "+v"(l)); return l; }

namespace pg8 {
constexpr int BM = 256, BK = 64, HALF = 128, HTB = HALF * BK * 2, NXCD = 8, WGM = 8;
__host__ __device__ __forceinline__ int lds_byte(int r, int c) { const int st = (r >> 4) * 2 + (c >> 5), rr = r & 15, cc = c & 31, ob = rr * 64 + cc * 2; return st * 1024 + (ob ^ (((ob >> 9) & 1) << 5)); }
__host__ __device__ __forceinline__ void stage_rc(int b, int& R, int& C) { const int st = b / 1024, sb = b % 1024, swz = sb ^ (((sb >> 9) & 1) << 5); R = (st >> 1) * 16 + swz / 64; C = (st & 1) * 32 + (swz % 64) / 2; }
__host__ __device__ __forceinline__ int perm32(int rho) { const int n = rho >> 4, i = rho & 15; return 8 * (i >> 2) + 4 * n + (i & 3); }

struct Unit { int pm, pn, z; };
struct Gemm { const bf16_t* A; const bf16_t* Bt; int K, lda, ldb; size_t zA, zB; };

struct StaticOrder {
    int nM, nN, nwg, G, c;
    __device__ void init(int M, int N, int G_, int c_) { nM = M / BM; nN = N / BM; nwg = nM * nN; G = G_; c = c_; }
    __device__ bool next(int i, Unit& u) const {
        const long L = (long)i * G + c; if (L >= nwg) return false;
        int wgid = (int)L; { const int q = nwg / NXCD, r = nwg % NXCD, xcd = wgid % NXCD, off = wgid / NXCD; wgid = (xcd < r ? xcd * (q + 1) : r * (q + 1) + (xcd - r) * q) + off; }
        const int nig = WGM * nN, gid = wgid / nig, fm = gid * WGM, gsz = (nM - fm) < WGM ? (nM - fm) : WGM;
        u.pm = fm + ((wgid % nig) % gsz); u.pn = (wgid % nig) / gsz; u.z = 0; return true;
    }
};
struct BatchOrder {
    int n, G, c;
    __device__ bool next(int i, Unit& u) const { const int L = i * G + c; if (L >= n) return false; u.z = L >> 1; u.pm = L & 1; u.pn = 0; return true; }
};

template <class Epi, class Sched, bool ALIGN_EPI>
__device__ __forceinline__ void gemm_phase(LAS unsigned char* lds, const Gemm g, const Sched& S, const Epi& E, const int wid) {
    const int lane = lane_id_opaque(), tid = wid * 64 + lane, wr = wid >> 2, wc = wid & 3, fr = lane & 15, fq = lane >> 4;
    const int K = g.K, nt = K / BK;
    unsigned voffA[2], voffB[2];
#pragma unroll
    for (int i = 0; i < 2; ++i) { int R, C; stage_rc(tid * 16 + i * 8192, R, C); const int Rb = (R & ~31) + perm32(R & 31);
        voffA[i] = (unsigned)(R * g.lda + C) * 2u; voffB[i] = (unsigned)(Rb * g.ldb + C) * 2u; }
    const size_t kstep = (size_t)(BK * 2);
    const size_t hstepA = (size_t)HALF * g.lda * 2, hstepB = (size_t)HALF * g.ldb * 2;
    const size_t tstepA = 2 * hstepA, tstepB = 2 * hstepB;
    const unsigned ldsw = (unsigned)wid * 1024u;
    const int aoff = lds_byte(wr * 64 + fr, fq * 8), boff = lds_byte(wc * 32 + fr, fq * 8);
#define PG8_SA(b, h) (((b) * 2 + (h)) * HTB)
#define PG8_SB(b, h) ((4 + (b) * 2 + (h)) * HTB)
#define PG8_STAGE(bufoff, gbase, voff) do { _Pragma("unroll") for (int _i = 0; _i < 2; ++_i) \
        __builtin_amdgcn_global_load_lds((const unsigned*)((const char*)(gbase) + (voff)[_i]), (LAS unsigned*)(lds + (bufoff) + ldsw + _i * 8192), 16, 0, 0); } while (0)
#define PG8_LDA(dst, b, h) do { _Pragma("unroll") for (int m = 0; m < 4; ++m) _Pragma("unroll") for (int k = 0; k < 2; ++k) dst[m][k] = *(const LAS bf16x8*)(lds + PG8_SA(b, h) + aoff + m * 2048 + k * 1024); } while (0)
#define PG8_LDB(dst, b, h) do { _Pragma("unroll") for (int n = 0; n < 2; ++n) _Pragma("unroll") for (int k = 0; k < 2; ++k) dst[n][k] = *(const LAS bf16x8*)(lds + PG8_SB(b, h) + boff + n * 2048 + k * 1024); } while (0)
#define PG8_MMA(ai, bj, At, Bt) do { __builtin_amdgcn_s_setprio(1); _Pragma("unroll") for (int m = 0; m < 4; ++m) _Pragma("unroll") for (int n = 0; n < 2; ++n) _Pragma("unroll") for (int k = 0; k < 2; ++k) \
        acc[ai][bj][m][n] = __builtin_amdgcn_mfma_f32_16x16x32_bf16(Bt[n][k], At[m][k], acc[ai][bj][m][n], 0, 0, 0); __builtin_amdgcn_s_setprio(0); } while (0)
#define PG8_WAIT_V(n) asm volatile("s_waitcnt vmcnt(" #n ")" ::: "memory")
#define PG8_WAIT_L(n) asm volatile("s_waitcnt lgkmcnt(" #n ")" ::: "memory")
#define PG8_BAR __builtin_amdgcn_s_barrier()
#define PG8_SCHED __builtin_amdgcn_sched_barrier(0)
    Unit cur, nxt; int ui = 0;
    if (!S.next(0, cur)) return;
    f32x4 acc[2][2][4][2];
#pragma unroll
    for (int a = 0; a < 2; ++a)
#pragma unroll
        for (int b = 0; b < 2; ++b)
#pragma unroll
            for (int m = 0; m < 4; ++m)
#pragma unroll
                for (int n = 0; n < 2; ++n) acc[a][b][m][n] = (f32x4){0.f, 0.f, 0.f, 0.f};
    bf16x8 At[4][2], B0[2][2], B1[2][2];
    const char* cA = (const char*)g.A + (size_t)cur.z * g.zA + (size_t)cur.pm * tstepA; const char* cB = (const char*)g.Bt + (size_t)cur.z * g.zB + (size_t)cur.pn * tstepB;
    PG8_STAGE(PG8_SB(0, 0), cB, voffB); PG8_STAGE(PG8_SB(0, 1), cB + hstepB, voffB); PG8_STAGE(PG8_SA(0, 0), cA, voffA); PG8_STAGE(PG8_SA(0, 1), cA + hstepA, voffA);
    if (wr == 1) PG8_BAR;
    PG8_WAIT_V(2); PG8_BAR;
    PG8_STAGE(PG8_SB(1, 0), cB + kstep, voffB); PG8_STAGE(PG8_SA(1, 0), cA + kstep, voffA); PG8_STAGE(PG8_SB(1, 1), cB + hstepB + kstep, voffB);
    PG8_WAIT_V(6); PG8_BAR;
    for (;;) {
        const bool has_next = S.next(ui + 1, nxt);
        const char* nA = has_next ? (const char*)g.A + (size_t)nxt.z * g.zA + (size_t)nxt.pm * tstepA : cA;
        const char* nB = has_next ? (const char*)g.Bt + (size_t)nxt.z * g.zB + (size_t)nxt.pn * tstepB : cB;
        for (int t = 0; t < nt; t += 2) {
            const bool last = (t == nt - 2);
            const char* a1 = cA + (size_t)(t + 1) * kstep;
            const char* a2 = last ? nA : cA + (size_t)(t + 2) * kstep; const char* b2 = last ? nB : cB + (size_t)(t + 2) * kstep;
            const char* a3 = a2 + kstep; const char* b3 = b2 + kstep;
            PG8_LDB(B0, 0, 0); PG8_LDB(B1, 0, 1); PG8_SCHED; PG8_LDA(At, 0, 0); PG8_STAGE(PG8_SA(1, 1), a1 + hstepA, voffA);
            PG8_WAIT_V(8); PG8_WAIT_L(0); PG8_BAR; PG8_MMA(0, 0, At, B0); PG8_MMA(0, 1, At, B1); PG8_BAR; PG8_SCHED;
            PG8_LDA(At, 0, 1); PG8_STAGE(PG8_SB(0, 0), b2, voffB); PG8_STAGE(PG8_SB(0, 1), b2 + hstepB, voffB); PG8_STAGE(PG8_SA(0, 0), a2, voffA);
            PG8_WAIT_V(8); PG8_WAIT_L(0); PG8_BAR; PG8_MMA(1, 0, At, B0); PG8_MMA(1, 1, At, B1); PG8_BAR; PG8_SCHED;
            PG8_LDB(B0, 1, 0); PG8_LDB(B1, 1, 1); PG8_SCHED; PG8_LDA(At, 1, 0); PG8_STAGE(PG8_SA(0, 1), a2 + hstepA, voffA);
            PG8_WAIT_V(8); PG8_WAIT_L(0); PG8_BAR; PG8_MMA(0, 0, At, B0); PG8_MMA(0, 1, At, B1); PG8_BAR; PG8_SCHED;
            PG8_LDA(At, 1, 1); PG8_STAGE(PG8_SB(1, 0), b3, voffB); PG8_STAGE(PG8_SB(1, 1), b3 + hstepB, voffB); PG8_STAGE(PG8_SA(1, 0), a3, voffA);
            PG8_WAIT_V(8); PG8_WAIT_L(0); PG8_BAR; PG8_MMA(1, 0, At, B0); PG8_MMA(1, 1, At, B1); PG8_BAR; PG8_SCHED;
        }
        if constexpr (ALIGN_EPI) { if (wr == 0) PG8_BAR; }
        E(acc, cur, wr, wc, fr, fq);
        if (!has_next) break;
#pragma unroll
        for (int a = 0; a < 2; ++a)
#pragma unroll
            for (int b = 0; b < 2; ++b)
#pragma unroll
                for (int m = 0; m < 4; ++m)
#pragma unroll
                    for (int n = 0; n < 2; ++n) acc[a][b][m][n] = (f32x4){0.f, 0.f, 0.f, 0.f};
        cur = nxt; cA = nA; cB = nB; ++ui;
        if constexpr (ALIGN_EPI) { if (wr == 1) PG8_BAR; }
    }
    PG8_WAIT_V(0);
    if constexpr (!ALIGN_EPI) { if (wr == 0) PG8_BAR; }
    PG8_BAR;
#undef PG8_SA
#undef PG8_SB
#undef PG8_STAGE
#undef PG8_LDA
#undef PG8_LDB
#undef PG8_MMA
#undef PG8_WAIT_V
#undef PG8_WAIT_L
#undef PG8_BAR
#undef PG8_SCHED
}

#define EPI_FOR_ROWS _Pragma("unroll") for (int ai = 0; ai < 2; ++ai) _Pragma("unroll") for (int m = 0; m < 4; ++m)
#define EPI_ROWDEF const int rit = ai * HALF + wr * 64 + m * 16 + fr; const int row = u.pm * BM + rit; (void)rit; (void)row;

struct Epi1 {
    const float* rinv; const float* qnw; const float* knw; const float2* rope;
    bf16_t *Q, *Kb, *Vb, *GA, *GS, *UCAT; LAS float* xch;
    __device__ __forceinline__ void operator()(const f32x4 (&acc)[2][2][4][2], const Unit& u, int wr, int wc, int, int) const {
        const int l_ = lane_id_opaque(), fr = l_ & 15, fq = l_ >> 4;
        const int pn = u.pn;
        if (pn <= 4) {
            float ss[2][4];
            EPI_FOR_ROWS { EPI_ROWDEF const float r = rinv[row]; float s = 0.f;
#pragma unroll
                for (int bj = 0; bj < 2; ++bj)
#pragma unroll
                    for (int n = 0; n < 2; ++n) { const f32x4 v = acc[ai][bj][m][n] * r; s += (v[0] * v[0] + v[1] * v[1]) + (v[2] * v[2] + v[3] * v[3]); }
                s += __shfl_xor(s, 16); s += __shfl_xor(s, 32); ss[ai][m] = s;
                if (fq == 0) xch[wc * 256 + rit] = s; }
            LDS_WAIT(); __builtin_amdgcn_s_barrier(); asm volatile("" ::: "memory");
            const int half = wc & 1, hd = wc >> 1;
            const float* nw = (pn < 4 ? qnw : knw) + 64 * half + 8 * fq;
            float w1[8], w2[8];
#pragma unroll
            for (int i = 0; i < 8; ++i) { w1[i] = nw[i]; w2[i] = nw[32 + i]; }
            EPI_FOR_ROWS { EPI_ROWDEF const float tot = ss[ai][m] + xch[(wc ^ 1) * 256 + rit];
                const float sc = rinv[row] * rsqrtf(tot * (1.f / 128.f) + EPS);
                const int t = row & (SEQ - 1); const int pos = half ? (t & 63) : (t >> 6);
                const float2* rp = rope + pos * 32 + 8 * fq;
                float o1[8], o2[8];
#pragma unroll
                for (int n = 0; n < 2; ++n)
#pragma unroll
                    for (int e = 0; e < 4; ++e) { const int i = 4 * n + e; const float2 cs = rp[i];
                        const float x1 = acc[ai][0][m][n][e] * sc * w1[i], x2 = acc[ai][1][m][n][e] * sc * w2[i];
                        o1[i] = x1 * cs.x - x2 * cs.y; o2[i] = x2 * cs.x + x1 * cs.y; }
                bf16_t* dst = (pn < 4) ? Q + (size_t)row * DATT + (2 * pn + hd) * 128 + 64 * half + 8 * fq : Kb + (size_t)row * DKV + hd * 128 + 64 * half + 8 * fq;
                u32x4 a; a.x = pk2(o1[0], o1[1]); a.y = pk2(o1[2], o1[3]); a.z = pk2(o1[4], o1[5]); a.w = pk2(o1[6], o1[7]);
                u32x4 b; b.x = pk2(o2[0], o2[1]); b.y = pk2(o2[2], o2[3]); b.z = pk2(o2[4], o2[5]); b.w = pk2(o2[6], o2[7]);
                *(u32x4*)dst = a; *(u32x4*)(dst + 32) = b; }
        } else {
            const int lg0 = 4 * (wc >> 1) + 2 * (wc & 1);
            EPI_FOR_ROWS { EPI_ROWDEF const float r = rinv[row];
#pragma unroll
                for (int bj = 0; bj < 2; ++bj) { const int L = 256 * pn + 32 * (lg0 + bj) + 8 * fq;
                    f32x4 v0 = acc[ai][bj][m][0] * r, v1 = acc[ai][bj][m][1] * r; bf16_t* dst;
                    if (pn == 5) dst = Vb + (size_t)row * DKV + (L - 1280);
                    else if (pn < 10) dst = GA + (size_t)row * DATT + (L - 1536);
                    else if (pn < 14) { const int Lu = L - 2560; dst = UCAT + ((size_t)(Lu >> 4) * NCH + (row >> 4)) * 512 + (row & 15) * 16 + (Lu & 15); }
                    else dst = GS + (size_t)row * DSSM + (L - 3584);
                    if ((pn >= 6 && pn < 10) || pn >= 14) {
#pragma unroll
                        for (int e = 0; e < 4; ++e) { v0[e] = siluf_(v0[e]); v1[e] = siluf_(v1[e]); } }
                    u32x4 w; w.x = pk2(v0[0], v0[1]); w.y = pk2(v0[2], v0[3]); w.z = pk2(v1[0], v1[1]); w.w = pk2(v1[2], v1[3]);
                    *(u32x4*)dst = w; } }
        }
    }
};
struct EpiS1 {
    float* S;
    __device__ __forceinline__ void operator()(const f32x4 (&acc)[2][2][4][2], const Unit& u, int wr, int wc, int, int) const {
        const int l_ = lane_id_opaque(), fr = l_ & 15, fq = l_ >> 4;
        EPI_FOR_ROWS { EPI_ROWDEF float* rp = S + ((size_t)u.z * NCH + row) * 256 + wc * 32 + 8 * fq;
#pragma unroll
            for (int bj = 0; bj < 2; ++bj) { *(f32x4*)(rp + bj * HALF) = acc[ai][bj][m][0]; *(f32x4*)(rp + bj * HALF + 4) = acc[ai][bj][m][1]; } }
    }
};
struct EpiS2 {
    bf16_t* YS;
    __device__ __forceinline__ void operator()(const f32x4 (&acc)[2][2][4][2], const Unit& u, int wr, int wc, int, int) const {
        const int l_ = lane_id_opaque(), fr = l_ & 15, fq = l_ >> 4;
        EPI_FOR_ROWS { EPI_ROWDEF
#pragma unroll
            for (int bj = 0; bj < 2; ++bj) { const int c = bj * HALF + wc * 32 + 8 * fq; const int j = c >> 4, h0 = c & 15;
                const f32x4 v0 = acc[ai][bj][m][0], v1 = acc[ai][bj][m][1];
                u32x4 w; w.x = pk2(gelu_tanh(v0[0]), gelu_tanh(v0[1])); w.y = pk2(gelu_tanh(v0[2]), gelu_tanh(v0[3])); w.z = pk2(gelu_tanh(v1[0]), gelu_tanh(v1[1])); w.w = pk2(gelu_tanh(v1[2]), gelu_tanh(v1[3]));
                *(u32x4*)(YS + ((size_t)row * 16 + j) * DSSM + u.z * 16 + h0) = w; } }
    }
};
struct EpiGlu {
    const float* bglu; const bf16_t* GS; bf16_t* YMIX;
    __device__ __forceinline__ void operator()(const f32x4 (&acc)[2][2][4][2], const Unit& u, int wr, int wc, int, int) const {
        const int l_ = lane_id_opaque(), fr = l_ & 15, fq = l_ >> 4;
        const int a0 = 128 * u.pn + 32 * wc + 8 * fq;
        float bv[8], bg[8];
#pragma unroll
        for (int i = 0; i < 8; ++i) { bv[i] = bglu[a0 + i]; bg[i] = bglu[1024 + a0 + i]; }
        EPI_FOR_ROWS { EPI_ROWDEF const u32x4 gs = *(const u32x4*)(GS + (size_t)row * DSSM + a0);
            float o[8];
#pragma unroll
            for (int n = 0; n < 2; ++n)
#pragma unroll
                for (int e = 0; e < 4; ++e) { const int i = 4 * n + e; o[i] = (acc[ai][0][m][n][e] + bv[i]) * sigmoidf_(acc[ai][1][m][n][e] + bg[i]); }
            o[0] *= bflo(gs.x); o[1] *= bfhi(gs.x); o[2] *= bflo(gs.y); o[3] *= bfhi(gs.y); o[4] *= bflo(gs.z); o[5] *= bfhi(gs.z); o[6] *= bflo(gs.w); o[7] *= bfhi(gs.w);
            u32x4 w; w.x = pk2(o[0], o[1]); w.y = pk2(o[2], o[3]); w.z = pk2(o[4], o[5]); w.w = pk2(o[6], o[7]);
            *(u32x4*)(YMIX + (size_t)row * DM + 1024 + a0) = w; }
    }
};
struct EpiBf {
    bf16_t* O; int ldc;
    __device__ __forceinline__ void operator()(const f32x4 (&acc)[2][2][4][2], const Unit& u, int wr, int wc, int, int) const {
        const int l_ = lane_id_opaque(), fr = l_ & 15, fq = l_ >> 4;
        EPI_FOR_ROWS { EPI_ROWDEF
#pragma unroll
            for (int bj = 0; bj < 2; ++bj) { const f32x4 v0 = acc[ai][bj][m][0], v1 = acc[ai][bj][m][1];
                u32x4 w; w.x = pk2(v0[0], v0[1]); w.y = pk2(v0[2], v0[3]); w.z = pk2(v1[0], v1[1]); w.w = pk2(v1[2], v1[3]);
                *(u32x4*)(O + (size_t)row * ldc + u.pn * BM + bj * HALF + wc * 32 + 8 * fq) = w; } }
    }
};
struct EpiOut {
    const float* x; float* H; bf16_t* HB; float* ssq;
    __device__ __forceinline__ void operator()(const f32x4 (&acc)[2][2][4][2], const Unit& u, int wr, int wc, int, int) const {
        const int l_ = lane_id_opaque(), fr = l_ & 15, fq = l_ >> 4;
        EPI_FOR_ROWS { EPI_ROWDEF float s = 0.f;
#pragma unroll
            for (int bj = 0; bj < 2; ++bj) { const size_t off = (size_t)row * DM + u.pn * BM + bj * HALF + wc * 32 + 8 * fq;
                const f32x4 v0 = acc[ai][bj][m][0] + *(const f32x4*)(x + off), v1 = acc[ai][bj][m][1] + *(const f32x4*)(x + off + 4);
                *(f32x4*)(H + off) = v0; *(f32x4*)(H + off + 4) = v1;
                s += (v0[0] * v0[0] + v0[1] * v0[1]) + (v0[2] * v0[2] + v0[3] * v0[3]) + (v1[0] * v1[0] + v1[1] * v1[1]) + (v1[2] * v1[2] + v1[3] * v1[3]);
                u32x4 w; w.x = pk2(v0[0], v0[1]); w.y = pk2(v0[2], v0[3]); w.z = pk2(v1[0], v1[1]); w.w = pk2(v1[2], v1[3]);
                *(u32x4*)(HB + off) = w; }
            s += __shfl_xor(s, 16); s += __shfl_xor(s, 32);
            if (fq == 0) ssq[(size_t)row * 32 + u.pn * 4 + wc] = s; }
    }
};
struct EpiGate {
    float* H; const bf16_t* PP; float* ssq; const LAS float* r2;
    __device__ __forceinline__ void operator()(const f32x4 (&acc)[2][2][4][2], const Unit& u, int wr, int wc, int, int) const {
        const int l_ = lane_id_opaque(), fr = l_ & 15, fq = l_ >> 4;
        EPI_FOR_ROWS { EPI_ROWDEF float s = 0.f; const float r = r2[rit];
#pragma unroll
            for (int bj = 0; bj < 2; ++bj) { const size_t off = (size_t)row * DM + u.pn * BM + bj * HALF + wc * 32 + 8 * fq;
                const u32x4 pp = *(const u32x4*)(PP + off);
                f32x4 h0 = *(const f32x4*)(H + off), h1 = *(const f32x4*)(H + off + 4);
                const f32x4 a0 = acc[ai][bj][m][0] * r, a1 = acc[ai][bj][m][1] * r;
                h0[0] += sigmoidf_(a0[0]) * bflo(pp.x); h0[1] += sigmoidf_(a0[1]) * bfhi(pp.x); h0[2] += sigmoidf_(a0[2]) * bflo(pp.y); h0[3] += sigmoidf_(a0[3]) * bfhi(pp.y);
                h1[0] += sigmoidf_(a1[0]) * bflo(pp.z); h1[1] += sigmoidf_(a1[1]) * bfhi(pp.z); h1[2] += sigmoidf_(a1[2]) * bflo(pp.w); h1[3] += sigmoidf_(a1[3]) * bfhi(pp.w);
                *(f32x4*)(H + off) = h0; *(f32x4*)(H + off + 4) = h1;
                s += (h0[0] * h0[0] + h0[1] * h0[1]) + (h0[2] * h0[2] + h0[3] * h0[3]) + (h1[0] * h1[0] + h1[1] * h1[1]) + (h1[2] * h1[2] + h1[3] * h1[3]); }
            s += __shfl_xor(s, 16); s += __shfl_xor(s, 32);
            if (fq == 0) ssq[(size_t)row * 32 + u.pn * 4 + wc] = s; }
    }
};
}

namespace att {
constexpr int D = 128, NW = 8, QBLK = 32, KVBLK = 64;
constexpr float SCALE = 0.088388347648318440f;
constexpr float THR = 8.f;
constexpr int LDQ = DATT, LDK = DKV;
constexpr size_t SHM_V = KVBLK * D * 2, SHM_K = KVBLK * D * 2, SHM_ATTN = 2 * SHM_V + 2 * SHM_K + NW * 64 * 4;
#define KSWZ(row, colB) ((row) * 256 + ((colB) ^ (((row) & 7) << 4)))
#define SBAR() __builtin_amdgcn_sched_barrier(0)
__device__ __forceinline__ int crow(int r, int hi) { return (r & 3) + 8 * (r >> 2) + 4 * hi; }
__device__ __forceinline__ void partialSM(f32x16& p0, f32x16& p1, float& m_reg, float& mn, float& alpha) {
  constexpr float C = SCALE * 1.4426950408889634f;
  float pmax = p0[0]; for (int r = 1; r < 16; ++r) pmax = fmaxf(pmax, p0[r]); for (int r = 0; r < 16; ++r) pmax = fmaxf(pmax, p1[r]);
  { auto rr = __builtin_amdgcn_permlane32_swap(__float_as_uint(pmax), __float_as_uint(pmax), false, false);
    pmax = fmaxf(__uint_as_float(rr[0]), __uint_as_float(rr[1])); }
  if (__builtin_expect(__all(pmax - m_reg <= THR / SCALE), 1)) { mn = m_reg; alpha = 1.f; }
  else { mn = fmaxf(m_reg, pmax); alpha = __builtin_amdgcn_exp2f((m_reg - mn) * C); m_reg = mn; }
  float mnC = -mn * C;
  for (int r = 0; r < 16; ++r) p0[r] = fmaf(p0[r], C, mnC); for (int r = 0; r < 16; ++r) p1[r] = fmaf(p1[r], C, mnC);
  for (int r = 0; r < 16; ++r) p0[r] = __builtin_amdgcn_exp2f(p0[r]);
}
__device__ __forceinline__ void finishSM(f32x16& p0, f32x16& p1, float alpha, float& l_reg, bf16x8& pa0, bf16x8& pa1, bf16x8& pa2, bf16x8& pa3) {
  for (int r = 0; r < 16; ++r) p1[r] = __builtin_amdgcn_exp2f(p1[r]);
  float ps = 0; for (int r = 0; r < 16; ++r) ps += p0[r]; for (int r = 0; r < 16; ++r) ps += p1[r];
  { auto rr = __builtin_amdgcn_permlane32_swap(__float_as_uint(ps), __float_as_uint(ps), false, false);
    ps = __uint_as_float(rr[0]) + __uint_as_float(rr[1]); }
  l_reg = l_reg * alpha + ps;
#define PK4(P, BASE, OUT) do { unsigned a0 = cvt_pk_bf16(P[BASE + 0], P[BASE + 1]), a1 = cvt_pk_bf16(P[BASE + 2], P[BASE + 3]);   \
    unsigned b0 = cvt_pk_bf16(P[BASE + 4], P[BASE + 5]), b1 = cvt_pk_bf16(P[BASE + 6], P[BASE + 7]);                              \
    auto r0 = __builtin_amdgcn_permlane32_swap(a0, b0, false, false); auto r1 = __builtin_amdgcn_permlane32_swap(a1, b1, false, false); \
    u32x4 w = {r0[0], r1[0], r0[1], r1[1]}; OUT = *reinterpret_cast<bf16x8*>(&w); } while (0)
  PK4(p0, 0, pa0); PK4(p0, 8, pa1); PK4(p1, 0, pa2); PK4(p1, 8, pa3);
#undef PK4
}
__device__ __forceinline__ void qkt(f32x16& p0, f32x16& p1, const bf16_t* Ks, const bf16x8* qr, int r32, int hi) {
  p0 = f32x16{}; p1 = f32x16{};
  for (int d0 = 0; d0 < 8; ++d0) { int cb = (d0 * 16 + hi * 8) * 2;
    bf16x8 b0 = *reinterpret_cast<const bf16x8*>((const char*)Ks + KSWZ(r32, cb));
    bf16x8 b1 = *reinterpret_cast<const bf16x8*>((const char*)Ks + KSWZ(32 + r32, cb));
    p0 = __builtin_amdgcn_mfma_f32_32x32x16_bf16(b0, qr[d0], p0, 0, 0, 0);
    p1 = __builtin_amdgcn_mfma_f32_32x32x16_bf16(b1, qr[d0], p1, 0, 0, 0); }
}
__device__ __forceinline__ int v_st(int k, int c) { const int kk = (k & ~0xC) | ((k & 4) << 1) | ((k & 8) >> 1); return ((kk >> 3) * 4 + (c >> 5)) * 512 + ((kk & 7) * 32 + (c & 31)) * 2; }
__device__ __forceinline__ int v_rd_base(int lane) { return ((lane & 3) << 3) | (((lane >> 2) & 3) << 6) | (((lane >> 4) & 1) << 5) | (((lane >> 5) & 1) << 8); }
constexpr int v_rd_off(int d0, int ks, int half) { return d0 * 512 + ks * 4096 + half * 2048; }
template <int OFF> __device__ __forceinline__ s16x4 tr_read(int vb) {
  s16x4 r; asm volatile("ds_read_b64_tr_b16 %0, %1 offset:%2" : "=&v"(r) : "v"(vb), "i"(OFF) : "memory"); return r;
}
template <int D0> __device__ __forceinline__ void pv_one(f32x16& od, int vb, bf16x8 pa0, bf16x8 pa1, bf16x8 pa2, bf16x8 pa3) {
  const s16x4 l0 = tr_read<v_rd_off(D0, 0, 0)>(vb), h0 = tr_read<v_rd_off(D0, 0, 1)>(vb), l1 = tr_read<v_rd_off(D0, 1, 0)>(vb), h1 = tr_read<v_rd_off(D0, 1, 1)>(vb);
  const s16x4 l2 = tr_read<v_rd_off(D0, 2, 0)>(vb), h2 = tr_read<v_rd_off(D0, 2, 1)>(vb), l3 = tr_read<v_rd_off(D0, 3, 0)>(vb), h3 = tr_read<v_rd_off(D0, 3, 1)>(vb);
  asm volatile("s_waitcnt lgkmcnt(0)" ::: "memory"); SBAR();
#define PK(L, H) (bf16x8){L[0], L[1], L[2], L[3], H[0], H[1], H[2], H[3]}
  od = __builtin_amdgcn_mfma_f32_32x32x16_bf16(pa0, PK(l0, h0), od, 0, 0, 0);
  od = __builtin_amdgcn_mfma_f32_32x32x16_bf16(pa1, PK(l1, h1), od, 0, 0, 0);
  od = __builtin_amdgcn_mfma_f32_32x32x16_bf16(pa2, PK(l2, h2), od, 0, 0, 0);
  od = __builtin_amdgcn_mfma_f32_32x32x16_bf16(pa3, PK(l3, h3), od, 0, 0, 0);
#undef PK
}
__device__ __forceinline__ void pv_d0(f32x16* o, int vb, bf16x8 pa0, bf16x8 pa1, bf16x8 pa2, bf16x8 pa3) {
  pv_one<0>(o[0], vb, pa0, pa1, pa2, pa3); pv_one<1>(o[1], vb, pa0, pa1, pa2, pa3); pv_one<2>(o[2], vb, pa0, pa1, pa2, pa3); pv_one<3>(o[3], vb, pa0, pa1, pa2, pa3);
}
__device__ __forceinline__ void attn_dense_body(const bf16_t* __restrict__ Qb, const bf16_t* __restrict__ Kh, const bf16_t* __restrict__ Vh,
                                                const bf16_t* __restrict__ Gb, bf16_t* __restrict__ Yb, int seq, char* lds, const int wid) {
  const int lane = lane_id_opaque(), tid = wid * 64 + lane, r32 = lane & 31, hi = lane >> 5;
  bf16_t* V_lds = (bf16_t*)lds; bf16_t* K_lds = (bf16_t*)(lds + 2 * SHM_V);
  float* ws = (float*)(lds + 2 * SHM_V + 2 * SHM_K) + wid * 64; float* li_l = ws; float* al_l = ws + 32;
  float m_reg = -1e30f, l_reg = 0; f32x16 o[4] = {}; bf16x8 qr[8];
  const bf16_t* Qw = Qb + (long)(wid * QBLK + r32) * LDQ + hi * 8;
#pragma unroll
  for (int d0 = 0; d0 < 8; ++d0) qr[d0] = *reinterpret_cast<const bf16x8*>(Qw + d0 * 16);
  const int sr = tid >> 4, sc = (tid & 15) * 8, vst0 = v_st(sr, sc), vst1 = v_st(32 + sr, sc);
  const int vb0 = (int)(uintptr_t)V_lds + v_rd_base(lane);
  struct { bf16x8 vs0, vs1, ks0, ks1; } sr_[2];
#define SLOAD(i, k0) do { sr_[i].vs0 = *reinterpret_cast<const bf16x8*>(&Vh[(long)((k0) + sr) * LDK + sc]); sr_[i].vs1 = *reinterpret_cast<const bf16x8*>(&Vh[(long)((k0) + 32 + sr) * LDK + sc]); \
    sr_[i].ks0 = *reinterpret_cast<const bf16x8*>(&Kh[(long)((k0) + sr) * LDK + sc]); sr_[i].ks1 = *reinterpret_cast<const bf16x8*>(&Kh[(long)((k0) + 32 + sr) * LDK + sc]); } while (0)
#define SWRITE(b, i) do { *(bf16x8*)((char*)V_lds + (b) * SHM_V + vst0) = sr_[i].vs0;          \
    *(bf16x8*)((char*)V_lds + (b) * SHM_V + vst1) = sr_[i].vs1; int kc = sc * 2;               \
    *(bf16x8*)((char*)K_lds + (b) * SHM_K + KSWZ(sr, kc)) = sr_[i].ks0;                       \
    *(bf16x8*)((char*)K_lds + (b) * SHM_K + KSWZ(32 + sr, kc)) = sr_[i].ks1; } while (0)
#define SWAIT() asm volatile("s_waitcnt vmcnt(4)" ::: "memory")
#define RESC(a) do { if (__any((a) < 1.f)) { if (hi == 0) al_l[r32] = (a); asm volatile("s_waitcnt lgkmcnt(0)" ::: "memory"); \
    for (int d = 0; d < 4; ++d) for (int r = 0; r < 16; ++r) o[d][r] *= al_l[crow(r, hi)]; } } while (0)
  f32x16 pA0, pA1, pB0, pB1; float mnA, mnB, alA, alB; bf16x8 pa0, pa1, pa2, pa3; const int NT = seq / KVBLK;
  constexpr int SE = 0, SO = 1;
  SLOAD(SE, 0); asm volatile("s_waitcnt vmcnt(0)" ::: "memory"); SWRITE(0, SE); __syncthreads();
  qkt(pA0, pA1, K_lds, qr, r32, hi); partialSM(pA0, pA1, m_reg, mnA, alA);
  SLOAD(SO, KVBLK); if (2 < NT) SLOAD(SE, 2 * KVBLK);
  SWAIT(); SWRITE(1, SO); __syncthreads();
  for (int j = 1; j + 1 < NT; j += 2) {
    SBAR(); qkt(pB0, pB1, (bf16_t*)((char*)K_lds + SHM_K), qr, r32, hi);
    finishSM(pA0, pA1, alA, l_reg, pa0, pa1, pa2, pa3); SBAR();
    SLOAD(SO, (j + 2) * KVBLK); SBAR();
    pv_d0(o, vb0, pa0, pa1, pa2, pa3); partialSM(pB0, pB1, m_reg, mnB, alB);
    __syncthreads(); SWAIT(); SWRITE(0, SE);
    RESC(alB); __syncthreads();
    SBAR(); qkt(pA0, pA1, K_lds, qr, r32, hi);
    finishSM(pB0, pB1, alB, l_reg, pa0, pa1, pa2, pa3); SBAR();
    if (j + 3 < NT) SLOAD(SE, (j + 3) * KVBLK); SBAR();
    pv_d0(o, vb0 + (int)SHM_V, pa0, pa1, pa2, pa3); partialSM(pA0, pA1, m_reg, mnA, alA);
    __syncthreads(); SWAIT(); SWRITE(1, SO);
    RESC(alA); __syncthreads();
  }
  SBAR(); qkt(pB0, pB1, (bf16_t*)((char*)K_lds + SHM_K), qr, r32, hi);
  finishSM(pA0, pA1, alA, l_reg, pa0, pa1, pa2, pa3); SBAR();
  pv_d0(o, vb0, pa0, pa1, pa2, pa3); partialSM(pB0, pB1, m_reg, mnB, alB);
  __syncthreads(); RESC(alB);
  finishSM(pB0, pB1, alB, l_reg, pa0, pa1, pa2, pa3); SBAR();
  pv_d0(o, vb0 + (int)SHM_V, pa0, pa1, pa2, pa3);
  if (hi == 0) li_l[r32] = l_reg; asm volatile("s_waitcnt lgkmcnt(0)" ::: "memory");
  float rli[16];
#pragma unroll
  for (int r = 0; r < 16; ++r) rli[r] = __builtin_amdgcn_rcpf(li_l[crow(r, hi)]);
  bf16_t* Yw = Yb + (long)(wid * QBLK) * DM; const bf16_t* Gw = Gb + (long)(wid * QBLK) * DATT;
  __syncthreads();
  bf16_t* stg = (bf16_t*)(lds + wid * 8192);
#pragma unroll
  for (int r = 0; r < 16; ++r) { const int orow = crow(r, hi);
#pragma unroll
    for (int d0 = 0; d0 < 4; ++d0) stg[orow * 128 + d0 * 32 + r32] = (bf16_t)f2bf(o[d0][r] * rli[r]); }
  asm volatile("s_waitcnt lgkmcnt(0)" ::: "memory");
  const int l2 = lane_id_opaque();
#pragma unroll
  for (int i = 0; i < 8; ++i) { const int q = l2 + 64 * i, row = q >> 4, c8 = (q & 15) * 8;
    const u32x4 v = *(const u32x4*)(stg + row * 128 + c8); const u32x4 gg = *(const u32x4*)(Gw + (unsigned)(row * DATT + c8));
    u32x4 w; w.x = pk2(bflo(v.x) * bflo(gg.x), bfhi(v.x) * bfhi(gg.x)); w.y = pk2(bflo(v.y) * bflo(gg.y), bfhi(v.y) * bfhi(gg.y));
    w.z = pk2(bflo(v.z) * bflo(gg.z), bfhi(v.z) * bfhi(gg.z)); w.w = pk2(bflo(v.w) * bflo(gg.w), bfhi(v.w) * bfhi(gg.w));
    *(u32x4*)(Yw + (unsigned)(row * DM + c8)) = w; }
  __syncthreads();
#undef SLOAD
#undef SWRITE
#undef SWAIT
#undef RESC
}
#undef SBAR
}

__device__ __forceinline__ void p0_transpose_item(const float* W, int K, int N, bf16_t* WT, int wt_row0, const float* kscale, LAS float* scr, int k0, int n0, int lane) {
#pragma unroll 8
    for (int i = 0; i < 32; ++i) { const int kk = 2 * i + (lane >> 5); float v = W[(size_t)(k0 + kk) * N + n0 + (lane & 31)]; if (kscale) v *= kscale[k0 + kk]; scr[kk * 33 + (lane & 31)] = v; }
    LDS_WAIT(); asm volatile("" ::: "memory");
    const int c = lane & 7;
#pragma unroll
    for (int j = 0; j < 4; ++j) { const int n = (lane >> 3) + 8 * j; const LAS float* s = scr + (8 * c) * 33 + n;
        u32x4 o; o.x = pk2(s[0 * 33], s[1 * 33]); o.y = pk2(s[2 * 33], s[3 * 33]); o.z = pk2(s[4 * 33], s[5 * 33]); o.w = pk2(s[6 * 33], s[7 * 33]);
        *(u32x4*)(WT + (size_t)(wt_row0 + n) * K + k0 + 8 * c) = o; }
    LDS_WAIT(); asm volatile("" ::: "memory");
}

__device__ __forceinline__ void ssm_tables(const Args& a, int g, LAS unsigned char* lds, int tid) {
    LAS float* LD = (LAS float*)lds;
    LAS float* LBs = LD + 256;
    LAS float* BB = LBs + 256;
    LAS float* KT = BB + 4096;
    float* lb16 = (float*)(a.ws + WS_LB16);
    bf16_t* WIN = (bf16_t*)(a.ws + WS_WIN) + (size_t)g * 256 * 256;
    bf16_t* WBIG = (bf16_t*)(a.ws + WS_WBIG) + (size_t)g * 256 * 512;
    if (tid < 128) {
        const int d = tid >> 6, p = tid & 63; const int idx = (d * NG + g) * 64 + p;
        const float lr = fminf(a.a_re[idx], -1e-4f), li = a.a_im[idx];
        const float dt = expf(a.log_dt[d * NG + g]);
        const float er = expf(lr * dt); float sn, cs; sincosf(li * dt, &sn, &cs);
        const float br = er * cs, bi = er * sn;
        LD[tid * 2] = lr * dt; LD[tid * 2 + 1] = li * dt; LBs[tid * 2] = br; LBs[tid * 2 + 1] = bi;
        const float nr = br - 1.f, ni = bi, den = lr * lr + li * li;
        KT[tid * 2] = (nr * lr + ni * li) / den; KT[tid * 2 + 1] = (ni * lr - nr * li) / den;
        const float e16 = expf(16.f * lr * dt); float s16, c16; sincosf(16.f * li * dt, &s16, &c16);
        lb16[(g * 128 + tid) * 2] = e16 * c16; lb16[(g * 128 + tid) * 2 + 1] = e16 * s16;
    }
    __syncthreads();
    for (int e = tid; e < 2048; e += 512) {
        const int dp = e >> 4, h = e & 15, d = dp >> 6, p = dp & 63;
        const size_t bi_ = ((size_t)(d * NG + g) * 64 + p) * 16 + h;
        const float xr = a.b_re[bi_], xi = a.b_im[bi_], cr = KT[dp * 2], ci = KT[dp * 2 + 1];
        BB[e * 2] = cr * xr - ci * xi; BB[e * 2 + 1] = cr * xi + ci * xr;
    }
    __syncthreads();
    {
        const int d = tid >> 8, hp = (tid >> 4) & 15, h = tid & 15; float acc[16];
#pragma unroll
        for (int t = 0; t < 16; ++t) acc[t] = 0.f;
        const float* cre = a.c_re + ((size_t)(d * NG + g) * 16 + hp) * 64; const float* cim = a.c_im + ((size_t)(d * NG + g) * 16 + hp) * 64;
        for (int p = 0; p < 64; ++p) {
            const float c_r = cre[p], c_i = cim[p], b_r = BB[((d * 64 + p) * 16 + h) * 2], b_i = BB[((d * 64 + p) * 16 + h) * 2 + 1];
            float wr = c_r * b_r - c_i * b_i, wi = c_r * b_i + c_i * b_r; const float l_r = LBs[(d * 64 + p) * 2], l_i = LBs[(d * 64 + p) * 2 + 1];
#pragma unroll
            for (int t = 0; t < 16; ++t) { acc[t] += wr; const float nr = wr * l_r - wi * l_i; wi = wr * l_i + wi * l_r; wr = nr; }
        }
#pragma unroll
        for (int t = 0; t < 16; ++t) KT[((d * 16 + t) * 16 + hp) * 16 + h] = acc[t];
    }
    __syncthreads();
    for (int q = tid; q < 8192; q += 512) {
        const int n = q >> 5, kc = q & 31, s = kc >> 1, h0 = (kc & 1) * 8, j = n >> 4, hp = n & 15;
        float v[8];
#pragma unroll
        for (int e = 0; e < 8; ++e) { const int h = h0 + e;
            if (s < j) v[e] = KT[((0 * 16 + (j - s)) * 16 + hp) * 16 + h];
            else if (s > j) v[e] = KT[((1 * 16 + (s - j)) * 16 + hp) * 16 + h];
            else v[e] = KT[((0 * 16 + 0) * 16 + hp) * 16 + h] + KT[((1 * 16 + 0) * 16 + hp) * 16 + h] + (h == hp ? a.ssm_d[g * 16 + h] : 0.f); }
        u32x4 w; w.x = pk2(v[0], v[1]); w.y = pk2(v[2], v[3]); w.z = pk2(v[4], v[5]); w.w = pk2(v[6], v[7]);
        *(u32x4*)(WBIG + (size_t)n * 512 + s * 16 + h0) = w;
    }
    for (int q = tid; q < 2048; q += 512) {
        const int p = q & 63, js = (q >> 6) & 15, d = q >> 10; const float ldr = LD[(d * 64 + p) * 2], ldi = LD[(d * 64 + p) * 2 + 1];
        {   const float pw = (float)(d == 0 ? js + 1 : 16 - js); const float er = expf(pw * ldr); float sn, cs; sincosf(pw * ldi, &sn, &cs); const float pr = er * cs, pi = er * sn;
            for (int hp = 0; hp < 16; ++hp) { const size_t ci_ = ((size_t)(d * NG + g) * 16 + hp) * 64 + p; const float c_r = a.c_re[ci_], c_i = a.c_im[ci_];
                bf16_t* dst = WBIG + (size_t)(js * 16 + hp) * 512 + 256 + d * 128 + p;
                dst[0] = (bf16_t)f2bf(c_r * pr - c_i * pi); dst[64] = (bf16_t)f2bf(-(c_r * pi + c_i * pr)); } }
        {   const float pw = (float)(d == 0 ? 15 - js : js); const float er = expf(pw * ldr); float sn, cs; sincosf(pw * ldi, &sn, &cs); const float pr = er * cs, pi = er * sn;
            float zr[16], zi[16];
#pragma unroll
            for (int h = 0; h < 16; ++h) { const float b_r = BB[((d * 64 + p) * 16 + h) * 2], b_i = BB[((d * 64 + p) * 16 + h) * 2 + 1]; zr[h] = pr * b_r - pi * b_i; zi[h] = pr * b_i + pi * b_r; }
            bf16_t* d0 = WIN + (size_t)(d * 128 + p) * 256 + js * 16; bf16_t* d1 = d0 + (size_t)64 * 256;
            u32x4 w; w.x = pk2(zr[0], zr[1]); w.y = pk2(zr[2], zr[3]); w.z = pk2(zr[4], zr[5]); w.w = pk2(zr[6], zr[7]); *(u32x4*)d0 = w;
            w.x = pk2(zr[8], zr[9]); w.y = pk2(zr[10], zr[11]); w.z = pk2(zr[12], zr[13]); w.w = pk2(zr[14], zr[15]); *(u32x4*)(d0 + 8) = w;
            w.x = pk2(zi[0], zi[1]); w.y = pk2(zi[2], zi[3]); w.z = pk2(zi[4], zi[5]); w.w = pk2(zi[6], zi[7]); *(u32x4*)d1 = w;
            w.x = pk2(zi[8], zi[9]); w.y = pk2(zi[10], zi[11]); w.z = pk2(zi[12], zi[13]); w.w = pk2(zi[14], zi[15]); *(u32x4*)(d1 + 8) = w; }
    }
    __syncthreads();
}

__global__ void __launch_bounds__(512, 2) fwd_kernel(Args a) {
    extern __shared__ __attribute__((aligned(16))) unsigned char lds_raw[];
    LAS unsigned char* lds = (LAS unsigned char*)lds_raw;
    cg::grid_group grid = cg::this_grid();
    const int wave = __builtin_amdgcn_readfirstlane(threadIdx.x >> 6);
#define LANE_IDS const int lane = lane_id_opaque(), tid = wave * 64 + lane; (void)tid;
    const int G = gridDim.x, bid = blockIdx.x;
    unsigned char* ws = a.ws;
    bf16_t* W1T = (bf16_t*)(ws + WS_W1T); bf16_t* WGLUT = (bf16_t*)(ws + WS_WGLUT); bf16_t* WOT = (bf16_t*)(ws + WS_WOT); bf16_t* WGT = (bf16_t*)(ws + WS_WGT); bf16_t* WPT = (bf16_t*)(ws + WS_WPT);
    float2* ROPE = (float2*)(ws + WS_ROPE); float* RINV = (float*)(ws + WS_RINV); float* LB16 = (float*)(ws + WS_LB16); float* SSQ1 = (float*)(ws + WS_SSQ1); float* SSQ2 = (float*)(ws + WS_SSQ2);
    bf16_t* PB = (bf16_t*)(ws + WS_PB); bf16_t* WIN = (bf16_t*)(ws + WS_WIN); bf16_t* WBIG = (bf16_t*)(ws + WS_WBIG);
    bf16_t* XB = (bf16_t*)(ws + WS_XB); float* SS = (float*)(ws + WS_XB); bf16_t* HB = (bf16_t*)(ws + WS_XB);
    bf16_t* Q = (bf16_t*)(ws + WS_Q); bf16_t* KB = (bf16_t*)(ws + WS_K); bf16_t* VB = (bf16_t*)(ws + WS_V); bf16_t* GA = (bf16_t*)(ws + WS_GA); bf16_t* GS = (bf16_t*)(ws + WS_GS);
    bf16_t* UCAT = (bf16_t*)(ws + WS_UCAT); bf16_t* PPB = (bf16_t*)(ws + WS_UCAT); bf16_t* YMIX = (bf16_t*)(ws + WS_YMIX); bf16_t* YS = (bf16_t*)(ws + WS_YS);

    if constexpr ((PH_MASK >> 0) & 1) { LANE_IDS
        if (bid < NG) ssm_tables(a, bid, lds, tid);
        const int gw = bid * 8 + wave, NGW = G * 8;
        LAS float* scr = (LAS float*)(lds + wave * 16384);
        constexpr int I1 = 32 * 144, I2 = 16 * 64, I3 = 32 * 64, I4 = 32 * 64, I5 = 4 * 64;
        for (int it = gw; it < I1 + I2 + I3 + I4 + I5; it += NGW) {
            int r = it;
            if (r < I1) { const int kb = r / 144, lgg = r % 144, pn = lgg >> 3, lg = lgg & 7, wtg = pn * 8 + 4 * (lg & 1) + 2 * (lg >> 2) + ((lg >> 1) & 1);
                p0_transpose_item(a.w_in, DM, DIN, W1T, wtg * 32, a.norm_mix, scr, kb * 64, lgg * 32, lane); continue; } r -= I1;
            if (r < I2) { const int kb = r / 64, lgg = r % 64, l2 = lgg & 31, wtg = (l2 >> 2) * 8 + 4 * (lgg >> 5) + (l2 & 3);
                p0_transpose_item(a.w_glu, DSSM, 2 * DSSM, WGLUT, wtg * 32, nullptr, scr, kb * 64, lgg * 32, lane); continue; } r -= I2;
            if (r < I3) { const int kb = r / 64, lgg = r % 64; p0_transpose_item(a.w_out, DM, DM, WOT, lgg * 32, nullptr, scr, kb * 64, lgg * 32, lane); continue; } r -= I3;
            if (r < I4) { const int kb = r / 64, lgg = r % 64; p0_transpose_item(a.w_ple_gate, DM, DM, WGT, lgg * 32, a.norm_ple, scr, kb * 64, lgg * 32, lane); continue; } r -= I4;
            { const int kb = r / 64, lgg = r % 64; p0_transpose_item(a.w_ple_proj, PLE, DM, WPT, lgg * 32, nullptr, scr, kb * 64, lgg * 32, lane); }
        }
        for (int m = gw; m < T; m += NGW) {
            const f32x4* xr = (const f32x4*)(a.x + (size_t)m * DM) + lane; f32x4 v[8]; float s = 0.f;
#pragma unroll
            for (int j = 0; j < 8; ++j) { v[j] = xr[64 * j]; s += (v[j][0] * v[j][0] + v[j][1] * v[j][1]) + (v[j][2] * v[j][2] + v[j][3] * v[j][3]); }
            s = wave_sum(s);
            if (lane == 0) RINV[m] = rsqrtf(s * (1.f / DM) + EPS);
            u32x2* o = (u32x2*)(XB + (size_t)m * DM) + lane;
#pragma unroll
            for (int j = 0; j < 8; ++j) { u32x2 w; w.x = pk2(v[j][0], v[j][1]); w.y = pk2(v[j][2], v[j][3]); o[64 * j] = w; }
        }
        for (int i = bid * 512 + tid; i < T * PLE / 4; i += G * 512) { const f32x4 v = ((const f32x4*)a.p)[i]; u32x2 w; w.x = pk2(v[0], v[1]); w.y = pk2(v[2], v[3]); ((u32x2*)PB)[i] = w; }
        for (int i = bid * 512 + tid; i < 2048; i += G * 512) { const int pos = i >> 5, f = i & 31; const float inv = powf(10000.f, -(float)f / 32.f); float sn, cs; sincosf((float)pos * inv, &sn, &cs); ROPE[i] = make_float2(cs, sn); }
    }
    grid.sync();

    if constexpr ((PH_MASK >> 1) & 1) {
        pg8::Gemm g{XB, W1T, DM, DM, DM, 0, 0}; pg8::StaticOrder S; S.init(T, DIN, G, bid);
        pg8::Epi1 E{RINV, a.q_norm, a.k_norm, ROPE, Q, KB, VB, GA, GS, UCAT, (LAS float*)(lds + XCH_OFF)};
        pg8::gemm_phase<pg8::Epi1, pg8::StaticOrder, true>(lds, g, S, E, wave);
    }
    grid.sync();

    if constexpr ((PH_MASK >> 2) & 1) {
#ifndef NO_S1
        { pg8::Gemm g{UCAT, WIN, 256, 512, 256, (size_t)NCH * 512 * 2, (size_t)256 * 256 * 2}; pg8::BatchOrder S{2 * NG, G, bid};
        pg8::EpiS1 E{SS};
        pg8::gemm_phase<pg8::EpiS1, pg8::BatchOrder, false>(lds, g, S, E, wave); }
        __syncthreads();
#endif
        for (int un = bid; un < 256; un += G) {
            const int x = un & 7, jj = un >> 3, b = x >> 2, kvh = (x >> 1) & 1, idx = (x & 1) * 32 + jj, h = kvh * 4 + (idx >> 4), qb = idx & 15;
            const size_t tok0 = (size_t)b * SEQ + qb * 256;
            att::attn_dense_body(Q + tok0 * DATT + h * 128, KB + (size_t)b * SEQ * DKV + kvh * 128, VB + (size_t)b * SEQ * DKV + kvh * 128,
                                 GA + tok0 * DATT + h * 128, YMIX + tok0 * DM + h * 128, SEQ, (char*)lds_raw, wave);
        }
    }
    grid.sync();

    if constexpr ((PH_MASK >> 3) & 1) { LANE_IDS
        for (int un = bid; un < 2 * NG; un += G) {
            const int g_ = un >> 1, b = un & 1;
            if (tid < 128) {
                const int d = tid >> 6, p = tid & 63; const float lr = LB16[(g_ * 128 + tid) * 2], li = LB16[(g_ * 128 + tid) * 2 + 1];
                float xr = 0.f, xi = 0.f;
                for (int cb = 0; cb < 256; cb += 32) {
                    float sr[32], si[32];
#pragma unroll
                    for (int k = 0; k < 32; ++k) { const int c = d ? 255 - (cb + k) : cb + k; const size_t row = (size_t)g_ * NCH + b * 256 + c;
                        sr[k] = SS[row * 256 + d * 128 + p]; si[k] = SS[row * 256 + d * 128 + 64 + p]; }
#pragma unroll
                    for (int k = 0; k < 32; ++k) { const int c = d ? 255 - (cb + k) : cb + k; const size_t row = (size_t)g_ * NCH + b * 256 + c;
                        bf16_t* ux = UCAT + row * 512 + 256 + d * 128 + p; ux[0] = (bf16_t)f2bf(xr); ux[64] = (bf16_t)f2bf(xi);
                        const float nr = lr * xr - li * xi + sr[k]; xi = lr * xi + li * xr + si[k]; xr = nr; }
                }
            }
        }
        __threadfence(); __syncthreads();
        pg8::Gemm g{UCAT, WBIG, 512, 512, 512, (size_t)NCH * 512 * 2, (size_t)256 * 512 * 2}; pg8::BatchOrder S{2 * NG, G, bid};
        pg8::EpiS2 E{YS};
        pg8::gemm_phase<pg8::EpiS2, pg8::BatchOrder, false>(lds, g, S, E, wave);
    }
    grid.sync();

    if constexpr ((PH_MASK >> 4) & 1) {
        { pg8::Gemm g{YS, WGLUT, DSSM, DSSM, DSSM, 0, 0}; pg8::StaticOrder S; S.init(T, 2 * DSSM, G, bid);
          pg8::EpiGlu E{a.b_glu, GS, YMIX}; pg8::gemm_phase<pg8::EpiGlu, pg8::StaticOrder, false>(lds, g, S, E, wave); }
        __syncthreads();
        { pg8::Gemm g{PB, WPT, PLE, PLE, PLE, 0, 0}; pg8::StaticOrder S; S.init(T, DM, G, bid);
          pg8::EpiBf E{PPB, DM}; pg8::gemm_phase<pg8::EpiBf, pg8::StaticOrder, false>(lds, g, S, E, wave); }
    }
    grid.sync();

    if constexpr ((PH_MASK >> 5) & 1) {
        pg8::Gemm g{YMIX, WOT, DM, DM, DM, 0, 0}; pg8::StaticOrder S; S.init(T, DM, G, bid);
        pg8::EpiOut E{a.x, a.out, HB, SSQ1}; pg8::gemm_phase<pg8::EpiOut, pg8::StaticOrder, false>(lds, g, S, E, wave);
    }
    grid.sync();

    if constexpr ((PH_MASK >> 6) & 1) { LANE_IDS
        pg8::StaticOrder S; S.init(T, DM, G, bid); pg8::Unit u0;
        LAS float* r2 = (LAS float*)(lds + R2_OFF);
        if (S.next(0, u0) && tid < 256) { const float* sp = SSQ1 + (size_t)(u0.pm * 256 + tid) * 32; float s = 0.f;
#pragma unroll
            for (int i = 0; i < 8; ++i) { const f32x4 v = ((const f32x4*)sp)[i]; s += (v[0] + v[1]) + (v[2] + v[3]); }
            r2[tid] = rsqrtf(s * (1.f / DM) + EPS); }
        __syncthreads();
        pg8::Gemm g{HB, WGT, DM, DM, DM, 0, 0};
        pg8::EpiGate E{a.out, PPB, SSQ2, r2}; pg8::gemm_phase<pg8::EpiGate, pg8::StaticOrder, false>(lds, g, S, E, wave);
    }
    grid.sync();

    if constexpr ((PH_MASK >> 7) & 1) { LANE_IDS
        const int gw = bid * 8 + wave, NGW = G * 8;
        for (int m = gw; m < T; m += NGW) {
            float s = (lane < 32) ? SSQ2[(size_t)m * 32 + lane] : 0.f; s = wave_sum(s);
            const float r = rsqrtf(s * (1.f / DM) + EPS);
            f32x4* o = (f32x4*)(a.out + (size_t)m * DM) + lane; const f32x4* nf = (const f32x4*)a.norm_final + lane;
#pragma unroll
            for (int j = 0; j < 8; ++j) { o[64 * j] = o[64 * j] * r * nf[64 * j]; }
        }
    }
}

extern "C" void kernel_launch(void* const* d_in, const int* in_sizes, int n_in, void* d_out, int out_size, void* d_ws, size_t ws_size, hipStream_t stream) {
    static int grid = 0;
    if (grid == 0) {
        if (n_in != 21 || in_sizes[0] != T * DM || out_size != T * DM || ws_size < WS_END) { fprintf(stderr, "kernel_launch: unexpected shapes (n_in %d, in0 %d, out %d, ws %zu)\n", n_in, n_in > 0 ? in_sizes[0] : -1, out_size, ws_size); grid = -1; return; }
        int dev = 0, cus = 0, per_cu = 0;
        hipGetDevice(&dev); hipDeviceGetAttribute(&cus, hipDeviceAttributeMultiprocessorCount, dev);
        if (hipFuncSetAttribute((const void*)fwd_kernel, hipFuncAttributeMaxDynamicSharedMemorySize, LDS_BYTES) != hipSuccess) { fprintf(stderr, "kernel_launch: hipFuncSetAttribute failed\n"); grid = -1; return; }
        hipOccupancyMaxActiveBlocksPerMultiprocessor(&per_cu, (const void*)fwd_kernel, 512, LDS_BYTES);
        (void)hipGetLastError();
        if (per_cu < 1) fprintf(stderr, "kernel_launch: occupancy query reports %d blocks per CU\n", per_cu);
        grid = cus > 256 ? 256 : cus;
    }
    if (grid < 0) return;
    Args a{};
    const float** f = (const float**)&a;
    for (int i = 0; i < 21; ++i) f[i] = (const float*)d_in[i];
    a.out = (float*)d_out; a.ws = (unsigned char*)d_ws;
    void* args[] = {&a};
    hipError_t e = hipLaunchCooperativeKernel((const void*)fwd_kernel, dim3(grid), dim3(512), args, LDS_BYTES, stream);
    if (e != hipSuccess) fprintf(stderr, "kernel_launch: cooperative launch failed: %s (grid %d)\n", hipGetErrorString(e), grid);
}
```

```cpp
#include <hip/hip_runtime.h>
#include <hip/hip_cooperative_groups.h>
#include <cstdio>
#include <cstdint>
namespace cg = cooperative_groups;

#define LAS __attribute__((address_space(3)))
typedef unsigned short bf16_t;
typedef short bf16x8 __attribute__((ext_vector_type(8)));
typedef short s16x4 __attribute__((ext_vector_type(4)));
typedef float f32x4 __attribute__((ext_vector_type(4)));
typedef float f32x16 __attribute__((ext_vector_type(16)));
typedef unsigned u32x4 __attribute__((ext_vector_type(4)));
typedef unsigned u32x2 __attribute__((ext_vector_type(2)));

constexpr int T = 8192, SEQ = 4096, DM = 2048, DIN = 4608, DATT = 1024, DKV = 256, DSSM = 1024, PLE = 256;
constexpr int NG = 64, NCH = T / 16;
constexpr float EPS = 1e-6f;
#ifndef PH_MASK
#define PH_MASK 0xff
#endif
#ifndef REP_MASK
#define REP_MASK 0
#endif

constexpr size_t MiB = 1u << 20;
constexpr size_t WS_W1T = 1 * MiB, WS_WGLUT = 19 * MiB, WS_WOT = 23 * MiB, WS_WGT = 31 * MiB, WS_WPT = 39 * MiB;
constexpr size_t WS_ROPE = 40 * MiB, WS_RINV = 40 * MiB + 65536, WS_LB16 = 40 * MiB + 131072, WS_SSQ1 = 41 * MiB, WS_SSQ2 = 42 * MiB;
constexpr size_t WS_PB = 43 * MiB, WS_WIN = 47 * MiB, WS_WBIG = 55 * MiB;
constexpr size_t WS_XB = 71 * MiB;
constexpr size_t WS_Q = 103 * MiB, WS_K = 119 * MiB, WS_V = 123 * MiB, WS_GA = 127 * MiB, WS_GS = 143 * MiB;
constexpr size_t WS_UCAT = 159 * MiB;
constexpr size_t WS_YMIX = 191 * MiB, WS_YS = 223 * MiB, WS_END = 239 * MiB;

constexpr int RING_BYTES = 131072, XCH_OFF = RING_BYTES, R2_OFF = RING_BYTES + 4096, LDS_BYTES = 147456;

struct Args {
    const float *x, *p, *norm_mix, *w_in, *q_norm, *k_norm, *a_re, *a_im, *log_dt, *b_re, *b_im, *c_re, *c_im, *ssm_d, *w_glu, *b_glu, *w_out, *norm_ple, *w_ple_gate, *w_ple_proj, *norm_final;
    float* out; unsigned char* ws;
};

__device__ __forceinline__ unsigned f2bf(float f) { unsigned u = __builtin_bit_cast(unsigned, f); return (u + 0x7fffu + ((u >> 16) & 1u)) >> 16; }
__device__ __forceinline__ unsigned pk2(float lo, float hi) { return f2bf(lo) | (f2bf(hi) << 16); }
__device__ __forceinline__ float bf2f(unsigned short b) { return __builtin_bit_cast(float, (unsigned)b << 16); }
__device__ __forceinline__ float bflo(unsigned w) { return __builtin_bit_cast(float, w << 16); }
__device__ __forceinline__ float bfhi(unsigned w) { return __builtin_bit_cast(float, w & 0xffff0000u); }
__device__ __forceinline__ unsigned cvt_pk_bf16(float lo, float hi) { unsigned r; asm volatile("v_cvt_pk_bf16_f32 %0, %1, %2" : "=v"(r) : "v"(lo), "v"(hi)); return r; }
__device__ __forceinline__ float sigmoidf_(float v) { return 1.f / (1.f + __expf(-v)); }
__device__ __forceinline__ float siluf_(float v) { return v / (1.f + __expf(-v)); }
__device__ __forceinline__ float gelu_tanh(float v) { const float t = 1.5957691216057308f * (v + 0.044715f * v * v * v); return v / (1.f + __expf(-t)); }
template <int K> __device__ __forceinline__ float swz_xor(float v) { return __int_as_float(__builtin_amdgcn_ds_swizzle(__float_as_int(v), (K << 10) | 0x1f)); }
__device__ __forceinline__ float sum_xor32(float v) { auto rr = __builtin_amdgcn_permlane32_swap(__float_as_uint(v), __float_as_uint(v), false, false); return __uint_as_float(rr[0]) + __uint_as_float(rr[1]); }
__device__ __forceinline__ float wave_sum(float v) { v += swz_xor<1>(v); v += swz_xor<2>(v); v += swz_xor<4>(v); v += swz_xor<8>(v); v += swz_xor<16>(v); return sum_xor32(v); }
#define LDS_WAIT() asm volatile("s_waitcnt lgkmcnt(0)" ::: "memory")
__device__ __forceinline__ int lane_id_opaque() { int l = __builtin_amdgcn_mbcnt_hi(~0u, __builtin_amdgcn_mbcnt_lo(~0u, 0u)); asm volatile("" : "+v"(l)); return l; }

namespace pg8 {
constexpr int BM = 256, BK = 64, HALF = 128, HTB = HALF * BK * 2, NXCD = 8, WGM = 8;
__host__ __device__ __forceinline__ int lds_byte(int r, int c) { const int st = (r >> 4) * 2 + (c >> 5), rr = r & 15, cc = c & 31, ob = rr * 64 + cc * 2; return st * 1024 + (ob ^ (((ob >> 9) & 1) << 5)); }
__host__ __device__ __forceinline__ void stage_rc(int b, int& R, int& C) { const int st = b / 1024, sb = b % 1024, swz = sb ^ (((sb >> 9) & 1) << 5); R = (st >> 1) * 16 + swz / 64; C = (st & 1) * 32 + (swz % 64) / 2; }
__host__ __device__ __forceinline__ int perm32(int rho) { const int n = rho >> 4, i = rho & 15; return 8 * (i >> 2) + 4 * n + (i & 3); }

struct Unit { int pm, pn, z; };
struct Gemm { const bf16_t* A; const bf16_t* Bt; int K, lda, ldb; size_t zA, zB; };

struct StaticOrder {
    int nM, nN, nwg, G, c;
    __device__ void init(int M, int N, int G_, int c_) { nM = M / BM; nN = N / BM; nwg = nM * nN; G = G_; c = c_; }
    __device__ bool next(int i, Unit& u) const {
        const long L = (long)i * G + c; if (L >= nwg) return false;
        int wgid = (int)L; { const int q = nwg / NXCD, r = nwg % NXCD, xcd = wgid % NXCD, off = wgid / NXCD; wgid = (xcd < r ? xcd * (q + 1) : r * (q + 1) + (xcd - r) * q) + off; }
        const int nig = WGM * nN, gid = wgid / nig, fm = gid * WGM, gsz = (nM - fm) < WGM ? (nM - fm) : WGM;
        u.pm = fm + ((wgid % nig) % gsz); u.pn = (wgid % nig) / gsz; u.z = 0; return true;
    }
};
struct BatchOrder {
    int n, G, c;
    __device__ bool next(int i, Unit& u) const { const int L = i * G + c; if (L >= n) return false; u.z = L >> 1; u.pm = L & 1; u.pn = 0; return true; }
};

struct ListOrder {
    int L0, n, stride;
    __device__ bool next(int i, Unit& u) const { const int L = L0 + i * stride; if (L < 0 || L >= n) return false; u.pm = L >> 2; u.pn = L & 3; u.z = 0; return true; }
};
template <class Epi, class Sched, bool ALIGN_EPI>
__device__ __forceinline__ void gemm_phase(LAS unsigned char* lds, const Gemm g, const Sched& S, const Epi& E, const int wid) {
    const int lane = lane_id_opaque(), tid = wid * 64 + lane, wr = wid >> 2, wc = wid & 3, fr = lane & 15, fq = lane >> 4;
    const int K = g.K, nt = K / BK;
    unsigned voffA[2], voffB[2];
#pragma unroll
    for (int i = 0; i < 2; ++i) { int R, C; stage_rc(tid * 16 + i * 8192, R, C); const int Rb = (R & ~31) + perm32(R & 31);
        voffA[i] = (unsigned)(R * g.lda + C) * 2u; voffB[i] = (unsigned)(Rb * g.ldb + C) * 2u; }
    const size_t kstep = (size_t)(BK * 2);
    const size_t hstepA = (size_t)HALF * g.lda * 2, hstepB = (size_t)HALF * g.ldb * 2;
    const size_t tstepA = 2 * hstepA, tstepB = 2 * hstepB;
    const unsigned ldsw = (unsigned)wid * 1024u;
    const int aoff = lds_byte(wr * 64 + fr, fq * 8), boff = lds_byte(wc * 32 + fr, fq * 8);
#define PG8_SA(b, h) (((b) * 2 + (h)) * HTB)
#define PG8_SB(b, h) ((4 + (b) * 2 + (h)) * HTB)
#define PG8_STAGE(bufoff, gbase, voff) do { _Pragma("unroll") for (int _i = 0; _i < 2; ++_i) \
        __builtin_amdgcn_global_load_lds((const unsigned*)((const char*)(gbase) + (voff)[_i]), (LAS unsigned*)(lds + (bufoff) + ldsw + _i * 8192), 16, 0, 0); } while (0)
#define PG8_LDA(dst, b, h) do { _Pragma("unroll") for (int m = 0; m < 4; ++m) _Pragma("unroll") for (int k = 0; k < 2; ++k) dst[m][k] = *(const LAS bf16x8*)(lds + PG8_SA(b, h) + aoff + m * 2048 + k * 1024); } while (0)
#define PG8_LDB(dst, b, h) do { _Pragma("unroll") for (int n = 0; n < 2; ++n) _Pragma("unroll") for (int k = 0; k < 2; ++k) dst[n][k] = *(const LAS bf16x8*)(lds + PG8_SB(b, h) + boff + n * 2048 + k * 1024); } while (0)
#define PG8_MMA(ai, bj, At, Bt) do { __builtin_amdgcn_s_setprio(1); _Pragma("unroll") for (int m = 0; m < 4; ++m) _Pragma("unroll") for (int n = 0; n < 2; ++n) _Pragma("unroll") for (int k = 0; k < 2; ++k) \
        acc[ai][bj][m][n] = __builtin_amdgcn_mfma_f32_16x16x32_bf16(Bt[n][k], At[m][k], acc[ai][bj][m][n], 0, 0, 0); __builtin_amdgcn_s_setprio(0); } while (0)
#define PG8_WAIT_V(n) asm volatile("s_waitcnt vmcnt(" #n ")" ::: "memory")
#define PG8_WAIT_L(n) asm volatile("s_waitcnt lgkmcnt(" #n ")" ::: "memory")
#define PG8_BAR __builtin_amdgcn_s_barrier()
#define PG8_SCHED __builtin_amdgcn_sched_barrier(0)
    Unit cur, nxt; int ui = 0;
    if (!S.next(0, cur)) return;
    f32x4 acc[2][2][4][2];
#pragma unroll
    for (int a = 0; a < 2; ++a)
#pragma unroll
        for (int b = 0; b < 2; ++b)
#pragma unroll
            for (int m = 0; m < 4; ++m)
#pragma unroll
                for (int n = 0; n < 2; ++n) acc[a][b][m][n] = (f32x4){0.f, 0.f, 0.f, 0.f};
    bf16x8 At[4][2], B0[2][2], B1[2][2];
    const char* cA = (const char*)g.A + (size_t)cur.z * g.zA + (size_t)cur.pm * tstepA; const char* cB = (const char*)g.Bt + (size_t)cur.z * g.zB + (size_t)cur.pn * tstepB;
    PG8_STAGE(PG8_SB(0, 0), cB, voffB); PG8_STAGE(PG8_SB(0, 1), cB + hstepB, voffB); PG8_STAGE(PG8_SA(0, 0), cA, voffA); PG8_STAGE(PG8_SA(0, 1), cA + hstepA, voffA);
    if (wr == 1) PG8_BAR;
    PG8_WAIT_V(2); PG8_BAR;
    PG8_STAGE(PG8_SB(1, 0), cB + kstep, voffB); PG8_STAGE(PG8_SA(1, 0), cA + kstep, voffA); PG8_STAGE(PG8_SB(1, 1), cB + hstepB + kstep, voffB);
    PG8_WAIT_V(6); PG8_BAR;
    for (;;) {
        const bool has_next = S.next(ui + 1, nxt);
        const char* nA = has_next ? (const char*)g.A + (size_t)nxt.z * g.zA + (size_t)nxt.pm * tstepA : cA;
        const char* nB = has_next ? (const char*)g.Bt + (size_t)nxt.z * g.zB + (size_t)nxt.pn * tstepB : cB;
        for (int t = 0; t < nt; t += 2) {
            const bool last = (t == nt - 2);
            const char* a1 = cA + (size_t)(t + 1) * kstep;
            const char* a2 = last ? nA : cA + (size_t)(t + 2) * kstep; const char* b2 = last ? nB : cB + (size_t)(t + 2) * kstep;
            const char* a3 = a2 + kstep; const char* b3 = b2 + kstep;
            PG8_LDB(B0, 0, 0); PG8_LDB(B1, 0, 1); PG8_SCHED; PG8_LDA(At, 0, 0); PG8_STAGE(PG8_SA(1, 1), a1 + hstepA, voffA);
            PG8_WAIT_V(8); PG8_WAIT_L(0); PG8_BAR; PG8_MMA(0, 0, At, B0); PG8_MMA(0, 1, At, B1); PG8_BAR; PG8_SCHED;
            PG8_LDA(At, 0, 1); PG8_STAGE(PG8_SB(0, 0), b2, voffB); PG8_STAGE(PG8_SB(0, 1), b2 + hstepB, voffB); PG8_STAGE(PG8_SA(0, 0), a2, voffA);
            PG8_WAIT_V(8); PG8_WAIT_L(0); PG8_BAR; PG8_MMA(1, 0, At, B0); PG8_MMA(1, 1, At, B1); PG8_BAR; PG8_SCHED;
            PG8_LDB(B0, 1, 0); PG8_LDB(B1, 1, 1); PG8_SCHED; PG8_LDA(At, 1, 0); PG8_STAGE(PG8_SA(0, 1), a2 + hstepA, voffA);
            PG8_WAIT_V(8); PG8_WAIT_L(0); PG8_BAR; PG8_MMA(0, 0, At, B0); PG8_MMA(0, 1, At, B1); PG8_BAR; PG8_SCHED;
            PG8_LDA(At, 1, 1); PG8_STAGE(PG8_SB(1, 0), b3, voffB); PG8_STAGE(PG8_SB(1, 1), b3 + hstepB, voffB); PG8_STAGE(PG8_SA(1, 0), a3, voffA);
            PG8_WAIT_V(8); PG8_WAIT_L(0); PG8_BAR; PG8_MMA(1, 0, At, B0); PG8_MMA(1, 1, At, B1); PG8_BAR; PG8_SCHED;
        }
        if constexpr (ALIGN_EPI) { if (wr == 0) PG8_BAR; }
        if constexpr (!Epi::AFTER_DRAIN) E(acc, cur, wr, wc, fr, fq);
        if (!has_next) break;
#pragma unroll
        for (int a = 0; a < 2; ++a)
#pragma unroll
            for (int b = 0; b < 2; ++b)
#pragma unroll
                for (int m = 0; m < 4; ++m)
#pragma unroll
                    for (int n = 0; n < 2; ++n) acc[a][b][m][n] = (f32x4){0.f, 0.f, 0.f, 0.f};
        cur = nxt; cA = nA; cB = nB; ++ui;
        if constexpr (ALIGN_EPI) { if (wr == 1) PG8_BAR; }
    }
    PG8_WAIT_V(0);
    if constexpr (!ALIGN_EPI) { if (wr == 0) PG8_BAR; }
    PG8_BAR;
    if constexpr (Epi::AFTER_DRAIN) E.fused(acc, cur, wr, wc, lds, wid);
#undef PG8_SA
#undef PG8_SB
#undef PG8_STAGE
#undef PG8_LDA
#undef PG8_LDB
#undef PG8_MMA
#undef PG8_WAIT_V
#undef PG8_WAIT_L
#undef PG8_BAR
#undef PG8_SCHED
}

#define EPI_FOR_ROWS _Pragma("unroll") for (int ai = 0; ai < 2; ++ai) _Pragma("unroll") for (int m = 0; m < 4; ++m)
#define EPI_ROWDEF const int rit = ai * HALF + wr * 64 + m * 16 + fr; const int row = u.pm * BM + rit; (void)rit; (void)row;

struct Epi1 {
    static constexpr bool AFTER_DRAIN = false;
    const float* rinv; const float* qnw; const float* knw; const float2* rope;
    bf16_t *Q, *Kb, *Vb, *GA, *GS, *UCAT; LAS float* xch; int pn0;
    __device__ __forceinline__ void operator()(const f32x4 (&acc)[2][2][4][2], const Unit& u, int wr, int wc, int, int) const {
        const int l_ = lane_id_opaque(), fr = l_ & 15, fq = l_ >> 4;
        const int pn = u.pn + pn0;
        if (pn <= 4) {
            float ss[2][4];
            EPI_FOR_ROWS { EPI_ROWDEF const float r = rinv[row]; float s = 0.f;
#pragma unroll
                for (int bj = 0; bj < 2; ++bj)
#pragma unroll
                    for (int n = 0; n < 2; ++n) { const f32x4 v = acc[ai][bj][m][n] * r; s += (v[0] * v[0] + v[1] * v[1]) + (v[2] * v[2] + v[3] * v[3]); }
                s += swz_xor<16>(s); s = sum_xor32(s); ss[ai][m] = s;
                if (fq == 0) xch[wc * 256 + rit] = s; }
            LDS_WAIT(); __builtin_amdgcn_s_barrier(); asm volatile("" ::: "memory");
            const int half = wc & 1, hd = wc >> 1;
            const float* nw = (pn < 4 ? qnw : knw) + 64 * half + 8 * fq;
            float w1[8], w2[8];
#pragma unroll
            for (int i = 0; i < 8; ++i) { w1[i] = nw[i]; w2[i] = nw[32 + i]; }
            EPI_FOR_ROWS { EPI_ROWDEF const float tot = ss[ai][m] + xch[(wc ^ 1) * 256 + rit];
                const float sc = rinv[row] * rsqrtf(tot * (1.f / 128.f) + EPS);
                const int t = row & (SEQ - 1); const int pos = half ? (t & 63) : (t >> 6);
                const float2* rp = rope + pos * 32 + 8 * fq;
                float o1[8], o2[8];
#pragma unroll
                for (int n = 0; n < 2; ++n)
#pragma unroll
                    for (int e = 0; e < 4; ++e) { const int i = 4 * n + e; const float2 cs = rp[i];
                        const float x1 = acc[ai][0][m][n][e] * sc * w1[i], x2 = acc[ai][1][m][n][e] * sc * w2[i];
                        o1[i] = x1 * cs.x - x2 * cs.y; o2[i] = x2 * cs.x + x1 * cs.y; }
                bf16_t* dst = (pn < 4) ? Q + (size_t)row * DATT + (2 * pn + hd) * 128 + 64 * half + 8 * fq : Kb + (size_t)row * DKV + hd * 128 + 64 * half + 8 * fq;
                u32x4 a; a.x = pk2(o1[0], o1[1]); a.y = pk2(o1[2], o1[3]); a.z = pk2(o1[4], o1[5]); a.w = pk2(o1[6], o1[7]);
                u32x4 b; b.x = pk2(o2[0], o2[1]); b.y = pk2(o2[2], o2[3]); b.z = pk2(o2[4], o2[5]); b.w = pk2(o2[6], o2[7]);
                *(u32x4*)dst = a; *(u32x4*)(dst + 32) = b; }
        } else {
            const int lg0 = 4 * (wc >> 1) + 2 * (wc & 1);
            EPI_FOR_ROWS { EPI_ROWDEF const float r = rinv[row];
#pragma unroll
                for (int bj = 0; bj < 2; ++bj) { const int L = 256 * pn + 32 * (lg0 + bj) + 8 * fq;
                    f32x4 v0 = acc[ai][bj][m][0] * r, v1 = acc[ai][bj][m][1] * r; bf16_t* dst;
                    if (pn == 5) dst = Vb + (size_t)row * DKV + (L - 1280);
                    else if (pn < 10) dst = GA + (size_t)row * DATT + (L - 1536);
                    else if (pn < 14) { const int Lu = L - 2560; dst = UCAT + ((size_t)(Lu >> 4) * NCH + (row >> 4)) * 512 + (row & 15) * 16 + (Lu & 15); }
                    else dst = GS + (size_t)row * DSSM + (L - 3584);
                    if ((pn >= 6 && pn < 10) || pn >= 14) {
#pragma unroll
                        for (int e = 0; e < 4; ++e) { v0[e] = siluf_(v0[e]); v1[e] = siluf_(v1[e]); } }
                    u32x4 w; w.x = pk2(v0[0], v0[1]); w.y = pk2(v0[2], v0[3]); w.z = pk2(v1[0], v1[1]); w.w = pk2(v1[2], v1[3]);
                    *(u32x4*)dst = w; } }
        }
    }
};
struct EpiS1 {
    static constexpr bool AFTER_DRAIN = true;
    const float* lb16; bf16_t* UCAT;
    __device__ __forceinline__ void operator()(const f32x4 (&)[2][2][4][2], const Unit&, int, int, int, int) const {}
    __device__ __forceinline__ void fused(const f32x4 (&acc)[2][2][4][2], const Unit& u, int wr, int wc, LAS unsigned char* lds, int wid) const {
        const int l_ = lane_id_opaque(), fr = l_ & 15, fq = l_ >> 4;
        LAS float* Tl = (LAS float*)lds;
#pragma unroll
        for (int d = 0; d < 2; ++d) {
            EPI_FOR_ROWS { const int rit = ai * HALF + wr * 64 + m * 16 + fr; LAS float* rp = Tl + rit * 128 + wc * 32 + 8 * fq;
                *(LAS f32x4*)rp = acc[ai][d][m][0]; *(LAS f32x4*)(rp + 4) = acc[ai][d][m][1]; }
            LDS_WAIT(); __builtin_amdgcn_s_barrier(); asm volatile("" ::: "memory");
            if (wid == 0) {
                const int p = l_; const float lr = lb16[((u.z * 2 + d) * 64 + p) * 2], li = lb16[((u.z * 2 + d) * 64 + p) * 2 + 1];
                float xr = 0.f, xi = 0.f;
#pragma unroll 8
                for (int cc = 0; cc < 256; ++cc) { const int c = d ? 255 - cc : cc;
                    const float sr = Tl[c * 128 + p], si = Tl[c * 128 + 64 + p];
                    Tl[c * 128 + p] = __uint_as_float(pk2(xr, xi));
                    const float nr = lr * xr - li * xi + sr; xi = lr * xi + li * xr + si; xr = nr; }
            }
            LDS_WAIT(); __builtin_amdgcn_s_barrier(); asm volatile("" ::: "memory");
            {   bf16_t* ub = UCAT + ((size_t)u.z * NCH + u.pm * 256) * 512 + 256 + d * 128;
#pragma unroll
                for (int i = 0; i < 8; ++i) { const int q = wid * 64 + l_ + 512 * i, r = q >> 4, c8 = (q & 15) * 8;
                    *(u32x4*)(ub + (size_t)r * 512 + c8) = *(const LAS u32x4*)((LAS bf16_t*)(Tl + r * 128) + c8); } }
            LDS_WAIT(); __builtin_amdgcn_s_barrier(); asm volatile("" ::: "memory");
        }
    }
};
struct EpiS2 {
    static constexpr bool AFTER_DRAIN = false;
    bf16_t* YS;
    __device__ __forceinline__ void operator()(const f32x4 (&acc)[2][2][4][2], const Unit& u, int wr, int wc, int, int) const {
        const int l_ = lane_id_opaque(), fr = l_ & 15, fq = l_ >> 4;
        EPI_FOR_ROWS { EPI_ROWDEF
#pragma unroll
            for (int bj = 0; bj < 2; ++bj) { const int c = bj * HALF + wc * 32 + 8 * fq; const int j = c >> 4, h0 = c & 15;
                const f32x4 v0 = acc[ai][bj][m][0], v1 = acc[ai][bj][m][1];
                u32x4 w; w.x = pk2(gelu_tanh(v0[0]), gelu_tanh(v0[1])); w.y = pk2(gelu_tanh(v0[2]), gelu_tanh(v0[3])); w.z = pk2(gelu_tanh(v1[0]), gelu_tanh(v1[1])); w.w = pk2(gelu_tanh(v1[2]), gelu_tanh(v1[3]));
                *(u32x4*)(YS + ((size_t)row * 16 + j) * DSSM + u.z * 16 + h0) = w; } }
    }
};
struct EpiGlu {
    static constexpr bool AFTER_DRAIN = false;
    const float* bglu; const bf16_t* GS; bf16_t* YMIX;
    __device__ __forceinline__ void operator()(const f32x4 (&acc)[2][2][4][2], const Unit& u, int wr, int wc, int, int) const {
        const int l_ = lane_id_opaque(), fr = l_ & 15, fq = l_ >> 4;
        const int a0 = 128 * u.pn + 32 * wc + 8 * fq;
        float bv[8], bg[8];
#pragma unroll
        for (int i = 0; i < 8; ++i) { bv[i] = bglu[a0 + i]; bg[i] = bglu[1024 + a0 + i]; }
        EPI_FOR_ROWS { EPI_ROWDEF const u32x4 gs = *(const u32x4*)(GS + (size_t)row * DSSM + a0);
            float o[8];
#pragma unroll
            for (int n = 0; n < 2; ++n)
#pragma unroll
                for (int e = 0; e < 4; ++e) { const int i = 4 * n + e; o[i] = (acc[ai][0][m][n][e] + bv[i]) * sigmoidf_(acc[ai][1][m][n][e] + bg[i]); }
            o[0] *= bflo(gs.x); o[1] *= bfhi(gs.x); o[2] *= bflo(gs.y); o[3] *= bfhi(gs.y); o[4] *= bflo(gs.z); o[5] *= bfhi(gs.z); o[6] *= bflo(gs.w); o[7] *= bfhi(gs.w);
            u32x4 w; w.x = pk2(o[0], o[1]); w.y = pk2(o[2], o[3]); w.z = pk2(o[4], o[5]); w.w = pk2(o[6], o[7]);
            *(u32x4*)(YMIX + (size_t)row * DM + 1024 + a0) = w; }
    }
};
struct EpiBf {
    static constexpr bool AFTER_DRAIN = false;
    bf16_t* O; int ldc;
    __device__ __forceinline__ void operator()(const f32x4 (&acc)[2][2][4][2], const Unit& u, int wr, int wc, int, int) const {
        const int l_ = lane_id_opaque(), fr = l_ & 15, fq = l_ >> 4;
        EPI_FOR_ROWS { EPI_ROWDEF
#pragma unroll
            for (int bj = 0; bj < 2; ++bj) { const f32x4 v0 = acc[ai][bj][m][0], v1 = acc[ai][bj][m][1];
                u32x4 w; w.x = pk2(v0[0], v0[1]); w.y = pk2(v0[2], v0[3]); w.z = pk2(v1[0], v1[1]); w.w = pk2(v1[2], v1[3]);
                *(u32x4*)(O + (size_t)row * ldc + u.pn * BM + bj * HALF + wc * 32 + 8 * fq) = w; } }
    }
};
struct EpiOut {
    static constexpr bool AFTER_DRAIN = false;
    const float* x; float* H; bf16_t* HB; float* ssq;
    __device__ __forceinline__ void operator()(const f32x4 (&acc)[2][2][4][2], const Unit& u, int wr, int wc, int, int) const {
        const int l_ = lane_id_opaque(), fr = l_ & 15, fq = l_ >> 4;
        EPI_FOR_ROWS { EPI_ROWDEF float s = 0.f;
#pragma unroll
            for (int bj = 0; bj < 2; ++bj) { const size_t off = (size_t)row * DM + u.pn * BM + bj * HALF + wc * 32 + 8 * fq;
                const f32x4 v0 = acc[ai][bj][m][0] + *(const f32x4*)(x + off), v1 = acc[ai][bj][m][1] + *(const f32x4*)(x + off + 4);
                *(f32x4*)(H + off) = v0; *(f32x4*)(H + off + 4) = v1;
                s += (v0[0] * v0[0] + v0[1] * v0[1]) + (v0[2] * v0[2] + v0[3] * v0[3]) + (v1[0] * v1[0] + v1[1] * v1[1]) + (v1[2] * v1[2] + v1[3] * v1[3]);
                u32x4 w; w.x = pk2(v0[0], v0[1]); w.y = pk2(v0[2], v0[3]); w.z = pk2(v1[0], v1[1]); w.w = pk2(v1[2], v1[3]);
                *(u32x4*)(HB + off) = w; }
            s += swz_xor<16>(s); s = sum_xor32(s);
            if (fq == 0) ssq[(size_t)row * 32 + u.pn * 4 + wc] = s; }
    }
};
struct EpiGate {
    static constexpr bool AFTER_DRAIN = true;
    float* H; const bf16_t* PP; float* ssq; unsigned* cnt; const float* nf; const LAS float* r2;
    __device__ __forceinline__ void operator()(const f32x4 (&)[2][2][4][2], const Unit&, int, int, int, int) const {}
    __device__ __forceinline__ void fused(f32x4 (&acc)[2][2][4][2], const Unit& u, int wr, int wc, LAS unsigned char* lds, int wid) const {
        const int l_ = lane_id_opaque(), fr = l_ & 15, fq = l_ >> 4, tid = wid * 64 + l_;
        LAS float* P = (LAS float*)lds; LAS float* Rn = P + 1024;
        EPI_FOR_ROWS { EPI_ROWDEF float s = 0.f; const float r = r2[rit];
#pragma unroll
            for (int bj = 0; bj < 2; ++bj) { const size_t off = (size_t)row * DM + u.pn * BM + bj * HALF + wc * 32 + 8 * fq;
                const u32x4 pp = *(const u32x4*)(PP + off);
                f32x4 h0 = *(const f32x4*)(H + off), h1 = *(const f32x4*)(H + off + 4);
                const f32x4 a0 = acc[ai][bj][m][0] * r, a1 = acc[ai][bj][m][1] * r;
                h0[0] += sigmoidf_(a0[0]) * bflo(pp.x); h0[1] += sigmoidf_(a0[1]) * bfhi(pp.x); h0[2] += sigmoidf_(a0[2]) * bflo(pp.y); h0[3] += sigmoidf_(a0[3]) * bfhi(pp.y);
                h1[0] += sigmoidf_(a1[0]) * bflo(pp.z); h1[1] += sigmoidf_(a1[1]) * bfhi(pp.z); h1[2] += sigmoidf_(a1[2]) * bflo(pp.w); h1[3] += sigmoidf_(a1[3]) * bfhi(pp.w);
                acc[ai][bj][m][0] = h0; acc[ai][bj][m][1] = h1;
                s += (h0[0] * h0[0] + h0[1] * h0[1]) + (h0[2] * h0[2] + h0[3] * h0[3]) + (h1[0] * h1[0] + h1[1] * h1[1]) + (h1[2] * h1[2] + h1[3] * h1[3]); }
            s += swz_xor<16>(s); s = sum_xor32(s);
            if (fq == 0) P[rit * 4 + wc] = s; }
        LDS_WAIT(); __builtin_amdgcn_s_barrier(); asm volatile("" ::: "memory");
        if (tid < 256) { const float t = (P[tid * 4] + P[tid * 4 + 1]) + (P[tid * 4 + 2] + P[tid * 4 + 3]);
            __hip_atomic_store(ssq + (size_t)(u.pm * 256 + tid) * 8 + u.pn, t, __ATOMIC_RELAXED, __HIP_MEMORY_SCOPE_AGENT); }
        asm volatile("s_waitcnt vmcnt(0)" ::: "memory");
        if (wid < 4 && l_ == 0) __hip_atomic_fetch_add(cnt + 64 * u.pm, 1u, __ATOMIC_RELAXED, __HIP_MEMORY_SCOPE_AGENT);
        if (wid == 0) {
            unsigned sp = 0;
            while ((unsigned)__builtin_amdgcn_readfirstlane(__hip_atomic_load(cnt + 64 * u.pm, __ATOMIC_RELAXED, __HIP_MEMORY_SCOPE_AGENT)) < 32u) { __builtin_amdgcn_s_sleep(2); if (++sp > (1u << 22)) break; }
            __builtin_amdgcn_fence(__ATOMIC_ACQUIRE, "agent");
        }
        asm volatile("s_waitcnt vmcnt(0) lgkmcnt(0)" ::: "memory"); __builtin_amdgcn_s_barrier(); asm volatile("" ::: "memory");
        if (tid < 256) { const float* sp = ssq + (size_t)(u.pm * 256 + tid) * 8; float t = 0.f;
#pragma unroll
            for (int i = 0; i < 8; ++i) t += __hip_atomic_load(sp + i, __ATOMIC_RELAXED, __HIP_MEMORY_SCOPE_AGENT);
            Rn[tid] = rsqrtf(t * (1.f / DM) + EPS); }
        LDS_WAIT(); __builtin_amdgcn_s_barrier(); asm volatile("" ::: "memory");
        EPI_FOR_ROWS { EPI_ROWDEF const float rn = Rn[rit];
#pragma unroll
            for (int bj = 0; bj < 2; ++bj) { const int col = u.pn * BM + bj * HALF + wc * 32 + 8 * fq; const size_t off = (size_t)row * DM + col;
                *(f32x4*)(H + off) = acc[ai][bj][m][0] * rn * *(const f32x4*)(nf + col); *(f32x4*)(H + off + 4) = acc[ai][bj][m][1] * rn * *(const f32x4*)(nf + col + 4); } }
    }
};
}

namespace att {
constexpr int D = 128, NW = 8, QBLK = 32, KVBLK = 64;
constexpr float SCALE = 0.088388347648318440f;
constexpr float THR = 8.f;
constexpr int LDQ = DATT, LDK = DKV;
constexpr size_t SHM_V = KVBLK * D * 2, SHM_K = KVBLK * D * 2, SHM_ATTN = 2 * SHM_V + 2 * SHM_K + NW * 64 * 4;
#define KSWZ(row, colB) ((row) * 256 + ((colB) ^ (((row) & 7) << 4)))
#define SBAR() __builtin_amdgcn_sched_barrier(0)
__device__ __forceinline__ int crow(int r, int hi) { return (r & 3) + 8 * (r >> 2) + 4 * hi; }
__device__ __forceinline__ void partialSM(f32x16& p0, f32x16& p1, float& m_reg, float& mn, float& alpha) {
  constexpr float C = SCALE * 1.4426950408889634f;
  float pmax = p0[0]; for (int r = 1; r < 16; ++r) pmax = fmaxf(pmax, p0[r]); for (int r = 0; r < 16; ++r) pmax = fmaxf(pmax, p1[r]);
  { auto rr = __builtin_amdgcn_permlane32_swap(__float_as_uint(pmax), __float_as_uint(pmax), false, false);
    pmax = fmaxf(__uint_as_float(rr[0]), __uint_as_float(rr[1])); }
  if (__builtin_expect(__all(pmax - m_reg <= THR / SCALE), 1)) { mn = m_reg; alpha = 1.f; }
  else { mn = fmaxf(m_reg, pmax); alpha = __builtin_amdgcn_exp2f((m_reg - mn) * C); m_reg = mn; }
  float mnC = -mn * C;
  for (int r = 0; r < 16; ++r) p0[r] = fmaf(p0[r], C, mnC); for (int r = 0; r < 16; ++r) p1[r] = fmaf(p1[r], C, mnC);
  for (int r = 0; r < 16; ++r) p0[r] = __builtin_amdgcn_exp2f(p0[r]);
}
__device__ __forceinline__ void finishSM(f32x16& p0, f32x16& p1, float alpha, float& l_reg, bf16x8& pa0, bf16x8& pa1, bf16x8& pa2, bf16x8& pa3) {
  for (int r = 0; r < 16; ++r) p1[r] = __builtin_amdgcn_exp2f(p1[r]);
  float ps = 0; for (int r = 0; r < 16; ++r) ps += p0[r]; for (int r = 0; r < 16; ++r) ps += p1[r];
  { auto rr = __builtin_amdgcn_permlane32_swap(__float_as_uint(ps), __float_as_uint(ps), false, false);
    ps = __uint_as_float(rr[0]) + __uint_as_float(rr[1]); }
  l_reg = l_reg * alpha + ps;
#define PK4(P, BASE, OUT) do { unsigned a0 = cvt_pk_bf16(P[BASE + 0], P[BASE + 1]), a1 = cvt_pk_bf16(P[BASE + 2], P[BASE + 3]);   \
    unsigned b0 = cvt_pk_bf16(P[BASE + 4], P[BASE + 5]), b1 = cvt_pk_bf16(P[BASE + 6], P[BASE + 7]);                              \
    auto r0 = __builtin_amdgcn_permlane32_swap(a0, b0, false, false); auto r1 = __builtin_amdgcn_permlane32_swap(a1, b1, false, false); \
    u32x4 w = {r0[0], r1[0], r0[1], r1[1]}; OUT = *reinterpret_cast<bf16x8*>(&w); } while (0)
  PK4(p0, 0, pa0); PK4(p0, 8, pa1); PK4(p1, 0, pa2); PK4(p1, 8, pa3);
#undef PK4
}
__device__ __forceinline__ void qkt(f32x16& p0, f32x16& p1, const bf16_t* Ks, const bf16x8* qr, int r32, int hi) {
  p0 = f32x16{}; p1 = f32x16{};
  for (int d0 = 0; d0 < 8; ++d0) { int cb = (d0 * 16 + hi * 8) * 2;
    bf16x8 b0 = *reinterpret_cast<const bf16x8*>((const char*)Ks + KSWZ(r32, cb));
    bf16x8 b1 = *reinterpret_cast<const bf16x8*>((const char*)Ks + KSWZ(32 + r32, cb));
    p0 = __builtin_amdgcn_mfma_f32_32x32x16_bf16(b0, qr[d0], p0, 0, 0, 0);
    p1 = __builtin_amdgcn_mfma_f32_32x32x16_bf16(b1, qr[d0], p1, 0, 0, 0); }
}
__device__ __forceinline__ int v_st(int k, int c) { const int kk = (k & ~0xC) | ((k & 4) << 1) | ((k & 8) >> 1); return ((kk >> 3) * 4 + (c >> 5)) * 512 + ((kk & 7) * 32 + (c & 31)) * 2; }
__device__ __forceinline__ int v_rd_base(int lane) { return ((lane & 3) << 3) | (((lane >> 2) & 3) << 6) | (((lane >> 4) & 1) << 5) | (((lane >> 5) & 1) << 8); }
constexpr int v_rd_off(int d0, int ks, int half) { return d0 * 512 + ks * 4096 + half * 2048; }
template <int OFF> __device__ __forceinline__ s16x4 tr_read(int vb) {
  s16x4 r; asm volatile("ds_read_b64_tr_b16 %0, %1 offset:%2" : "=&v"(r) : "v"(vb), "i"(OFF) : "memory"); return r;
}
template <int D0> __device__ __forceinline__ void pv_one(f32x16& od, int vb, bf16x8 pa0, bf16x8 pa1, bf16x8 pa2, bf16x8 pa3) {
  const s16x4 l0 = tr_read<v_rd_off(D0, 0, 0)>(vb), h0 = tr_read<v_rd_off(D0, 0, 1)>(vb), l1 = tr_read<v_rd_off(D0, 1, 0)>(vb), h1 = tr_read<v_rd_off(D0, 1, 1)>(vb);
  const s16x4 l2 = tr_read<v_rd_off(D0, 2, 0)>(vb), h2 = tr_read<v_rd_off(D0, 2, 1)>(vb), l3 = tr_read<v_rd_off(D0, 3, 0)>(vb), h3 = tr_read<v_rd_off(D0, 3, 1)>(vb);
  asm volatile("s_waitcnt lgkmcnt(0)" ::: "memory"); SBAR();
#define PK(L, H) (bf16x8){L[0], L[1], L[2], L[3], H[0], H[1], H[2], H[3]}
  od = __builtin_amdgcn_mfma_f32_32x32x16_bf16(pa0, PK(l0, h0), od, 0, 0, 0);
  od = __builtin_amdgcn_mfma_f32_32x32x16_bf16(pa1, PK(l1, h1), od, 0, 0, 0);
  od = __builtin_amdgcn_mfma_f32_32x32x16_bf16(pa2, PK(l2, h2), od, 0, 0, 0);
  od = __builtin_amdgcn_mfma_f32_32x32x16_bf16(pa3, PK(l3, h3), od, 0, 0, 0);
#undef PK
}
__device__ __forceinline__ void pv_d0(f32x16* o, int vb, bf16x8 pa0, bf16x8 pa1, bf16x8 pa2, bf16x8 pa3) {
  pv_one<0>(o[0], vb, pa0, pa1, pa2, pa3); pv_one<1>(o[1], vb, pa0, pa1, pa2, pa3); pv_one<2>(o[2], vb, pa0, pa1, pa2, pa3); pv_one<3>(o[3], vb, pa0, pa1, pa2, pa3);
}
__device__ __forceinline__ void attn_dense_body(const bf16_t* __restrict__ Qb, const bf16_t* __restrict__ Kh, const bf16_t* __restrict__ Vh,
                                                const bf16_t* __restrict__ Gb, bf16_t* __restrict__ Yb, int seq, char* lds, const int wid) {
  const int lane = lane_id_opaque(), tid = wid * 64 + lane, r32 = lane & 31, hi = lane >> 5;
  bf16_t* V_lds = (bf16_t*)lds; bf16_t* K_lds = (bf16_t*)(lds + 2 * SHM_V);
  float* ws = (float*)(lds + 2 * SHM_V + 2 * SHM_K) + wid * 64; float* li_l = ws; float* al_l = ws + 32;
  float m_reg = -1e30f, l_reg = 0; f32x16 o[4] = {}; bf16x8 qr[8];
  const bf16_t* Qw = Qb + (long)(wid * QBLK + r32) * LDQ + hi * 8;
#pragma unroll
  for (int d0 = 0; d0 < 8; ++d0) qr[d0] = *reinterpret_cast<const bf16x8*>(Qw + d0 * 16);
  const int sr = tid >> 4, sc = (tid & 15) * 8, vst0 = v_st(sr, sc), vst1 = v_st(32 + sr, sc);
  const int vb0 = (int)(uintptr_t)V_lds + v_rd_base(lane);
  struct { bf16x8 vs0, vs1, ks0, ks1; } sr_[2];
#define SLOAD(i, k0) do { sr_[i].vs0 = *reinterpret_cast<const bf16x8*>(&Vh[(long)((k0) + sr) * LDK + sc]); sr_[i].vs1 = *reinterpret_cast<const bf16x8*>(&Vh[(long)((k0) + 32 + sr) * LDK + sc]); \
    sr_[i].ks0 = *reinterpret_cast<const bf16x8*>(&Kh[(long)((k0) + sr) * LDK + sc]); sr_[i].ks1 = *reinterpret_cast<const bf16x8*>(&Kh[(long)((k0) + 32 + sr) * LDK + sc]); } while (0)
#define SWRITE(b, i) do { *(bf16x8*)((char*)V_lds + (b) * SHM_V + vst0) = sr_[i].vs0;          \
    *(bf16x8*)((char*)V_lds + (b) * SHM_V + vst1) = sr_[i].vs1; int kc = sc * 2;               \
    *(bf16x8*)((char*)K_lds + (b) * SHM_K + KSWZ(sr, kc)) = sr_[i].ks0;                       \
    *(bf16x8*)((char*)K_lds + (b) * SHM_K + KSWZ(32 + sr, kc)) = sr_[i].ks1; } while (0)
#define SWAIT() asm volatile("s_waitcnt vmcnt(4)" ::: "memory")
#define RESC(a) do { if (__any((a) < 1.f)) { if (hi == 0) al_l[r32] = (a); asm volatile("s_waitcnt lgkmcnt(0)" ::: "memory"); \
    for (int d = 0; d < 4; ++d) for (int r = 0; r < 16; ++r) o[d][r] *= al_l[crow(r, hi)]; } } while (0)
  f32x16 pA0, pA1, pB0, pB1; float mnA, mnB, alA, alB; bf16x8 pa0, pa1, pa2, pa3; const int NT = seq / KVBLK;
  constexpr int SE = 0, SO = 1;
  SLOAD(SE, 0); asm volatile("s_waitcnt vmcnt(0)" ::: "memory"); SWRITE(0, SE); __syncthreads();
  qkt(pA0, pA1, K_lds, qr, r32, hi); partialSM(pA0, pA1, m_reg, mnA, alA);
  SLOAD(SO, KVBLK); if (2 < NT) SLOAD(SE, 2 * KVBLK);
  SWAIT(); SWRITE(1, SO); __syncthreads();
  for (int j = 1; j + 1 < NT; j += 2) {
    SBAR(); qkt(pB0, pB1, (bf16_t*)((char*)K_lds + SHM_K), qr, r32, hi);
    finishSM(pA0, pA1, alA, l_reg, pa0, pa1, pa2, pa3); SBAR();
    SLOAD(SO, (j + 2) * KVBLK); SBAR();
    pv_d0(o, vb0, pa0, pa1, pa2, pa3); partialSM(pB0, pB1, m_reg, mnB, alB);
    __syncthreads(); SWAIT(); SWRITE(0, SE);
    RESC(alB); __syncthreads();
    SBAR(); qkt(pA0, pA1, K_lds, qr, r32, hi);
    finishSM(pB0, pB1, alB, l_reg, pa0, pa1, pa2, pa3); SBAR();
    if (j + 3 < NT) SLOAD(SE, (j + 3) * KVBLK); SBAR();
    pv_d0(o, vb0 + (int)SHM_V, pa0, pa1, pa2, pa3); partialSM(pA0, pA1, m_reg, mnA, alA);
    __syncthreads(); SWAIT(); SWRITE(1, SO);
    RESC(alA); __syncthreads();
  }
  SBAR(); qkt(pB0, pB1, (bf16_t*)((char*)K_lds + SHM_K), qr, r32, hi);
  finishSM(pA0, pA1, alA, l_reg, pa0, pa1, pa2, pa3); SBAR();
  pv_d0(o, vb0, pa0, pa1, pa2, pa3); partialSM(pB0, pB1, m_reg, mnB, alB);
  __syncthreads(); RESC(alB);
  finishSM(pB0, pB1, alB, l_reg, pa0, pa1, pa2, pa3); SBAR();
  pv_d0(o, vb0 + (int)SHM_V, pa0, pa1, pa2, pa3);
  if (hi == 0) li_l[r32] = l_reg; asm volatile("s_waitcnt lgkmcnt(0)" ::: "memory");
  float rli[16];
#pragma unroll
  for (int r = 0; r < 16; ++r) rli[r] = __builtin_amdgcn_rcpf(li_l[crow(r, hi)]);
  bf16_t* Yw = Yb + (long)(wid * QBLK) * DM; const bf16_t* Gw = Gb + (long)(wid * QBLK) * DATT;
  __syncthreads();
  bf16_t* stg = (bf16_t*)(lds + wid * 8192);
#pragma unroll
  for (int r = 0; r < 16; ++r) { const int orow = crow(r, hi);
#pragma unroll
    for (int d0 = 0; d0 < 4; ++d0) stg[orow * 128 + d0 * 32 + r32] = (bf16_t)f2bf(o[d0][r] * rli[r]); }
  asm volatile("s_waitcnt lgkmcnt(0)" ::: "memory");
  const int l2 = lane_id_opaque();
#pragma unroll
  for (int i = 0; i < 8; ++i) { const int q = l2 + 64 * i, row = q >> 4, c8 = (q & 15) * 8;
    const u32x4 v = *(const u32x4*)(stg + row * 128 + c8); const u32x4 gg = *(const u32x4*)(Gw + (unsigned)(row * DATT + c8));
    u32x4 w; w.x = pk2(bflo(v.x) * bflo(gg.x), bfhi(v.x) * bfhi(gg.x)); w.y = pk2(bflo(v.y) * bflo(gg.y), bfhi(v.y) * bfhi(gg.y));
    w.z = pk2(bflo(v.z) * bflo(gg.z), bfhi(v.z) * bfhi(gg.z)); w.w = pk2(bflo(v.w) * bflo(gg.w), bfhi(v.w) * bfhi(gg.w));
    *(u32x4*)(Yw + (unsigned)(row * DM + c8)) = w; }
  __syncthreads();
#undef SLOAD
#undef SWRITE
#undef SWAIT
#undef RESC
}
#undef SBAR
}

__device__ __forceinline__ void p0_transpose_item(const float* W, int K, int N, bf16_t* WT, int wt_row0, const float* kscale, LAS float* scr, int k0, int n0, int lane) {
#pragma unroll
    for (int i = 0; i < 32; ++i) { const int kk = 2 * i + (lane >> 5); float v = W[(size_t)(k0 + kk) * N + n0 + (lane & 31)]; if (kscale) v *= kscale[k0 + kk]; scr[kk * 33 + (lane & 31)] = v; }
    LDS_WAIT(); asm volatile("" ::: "memory");
    const int c = lane & 7;
#pragma unroll
    for (int j = 0; j < 4; ++j) { const int n = (lane >> 3) + 8 * j; const LAS float* s = scr + (8 * c) * 33 + n;
        u32x4 o; o.x = pk2(s[0 * 33], s[1 * 33]); o.y = pk2(s[2 * 33], s[3 * 33]); o.z = pk2(s[4 * 33], s[5 * 33]); o.w = pk2(s[6 * 33], s[7 * 33]);
        *(u32x4*)(WT + (size_t)(wt_row0 + n) * K + k0 + 8 * c) = o; }
    LDS_WAIT(); asm volatile("" ::: "memory");
}

__device__ __forceinline__ void ssm_tables(const Args& a, int g, LAS unsigned char* lds, int tid) {
    LAS float* LD = (LAS float*)lds;
    LAS float* LBs = LD + 256;
    LAS float* BB = LBs + 256;
    LAS float* KT = BB + 4096;
    LAS float* CC = KT + 8192;
    float* lb16 = (float*)(a.ws + WS_LB16);
    bf16_t* WIN = (bf16_t*)(a.ws + WS_WIN) + (size_t)g * 256 * 256;
    bf16_t* WBIG = (bf16_t*)(a.ws + WS_WBIG) + (size_t)g * 256 * 512;
    for (int e = tid; e < 2048; e += 512) { const int d = e >> 10, r = e & 1023; const size_t ci_ = (size_t)(d * NG + g) * 1024 + r; CC[e * 2] = a.c_re[ci_]; CC[e * 2 + 1] = a.c_im[ci_]; }
    if (tid < 128) {
        const int d = tid >> 6, p = tid & 63; const int idx = (d * NG + g) * 64 + p;
        const float lr = fminf(a.a_re[idx], -1e-4f), li = a.a_im[idx];
        const float dt = expf(a.log_dt[d * NG + g]);
        const float er = expf(lr * dt); float sn, cs; sincosf(li * dt, &sn, &cs);
        const float br = er * cs, bi = er * sn;
        LD[tid * 2] = lr * dt; LD[tid * 2 + 1] = li * dt; LBs[tid * 2] = br; LBs[tid * 2 + 1] = bi;
        const float nr = br - 1.f, ni = bi, den = lr * lr + li * li;
        KT[tid * 2] = (nr * lr + ni * li) / den; KT[tid * 2 + 1] = (ni * lr - nr * li) / den;
        const float e16 = expf(16.f * lr * dt); float s16, c16; sincosf(16.f * li * dt, &s16, &c16);
        lb16[(g * 128 + tid) * 2] = e16 * c16; lb16[(g * 128 + tid) * 2 + 1] = e16 * s16;
    }
    __syncthreads();
    for (int e = tid; e < 2048; e += 512) {
        const int dp = e >> 4, h = e & 15, d = dp >> 6, p = dp & 63;
        const size_t bi_ = ((size_t)(d * NG + g) * 64 + p) * 16 + h;
        const float xr = a.b_re[bi_], xi = a.b_im[bi_], cr = KT[dp * 2], ci = KT[dp * 2 + 1];
        BB[e * 2] = cr * xr - ci * xi; BB[e * 2 + 1] = cr * xi + ci * xr;
    }
    __syncthreads();
    {
        const int d = tid >> 8, hp = (tid >> 4) & 15, h = tid & 15; float acc[16];
#pragma unroll
        for (int t = 0; t < 16; ++t) acc[t] = 0.f;
        const LAS float* cc = CC + ((d * 16 + hp) * 64) * 2;
        for (int p = 0; p < 64; ++p) {
            const float c_r = cc[p * 2], c_i = cc[p * 2 + 1], b_r = BB[((d * 64 + p) * 16 + h) * 2], b_i = BB[((d * 64 + p) * 16 + h) * 2 + 1];
            float wr = c_r * b_r - c_i * b_i, wi = c_r * b_i + c_i * b_r; const float l_r = LBs[(d * 64 + p) * 2], l_i = LBs[(d * 64 + p) * 2 + 1];
#pragma unroll
            for (int t = 0; t < 16; ++t) { acc[t] += wr; const float nr = wr * l_r - wi * l_i; wi = wr * l_i + wi * l_r; wr = nr; }
        }
#pragma unroll
        for (int t = 0; t < 16; ++t) KT[((d * 16 + t) * 16 + hp) * 16 + h] = acc[t];
    }
    __syncthreads();
    for (int q = tid; q < 8192; q += 512) {
        const int n = q >> 5, kc = q & 31, s = kc >> 1, h0 = (kc & 1) * 8, j = n >> 4, hp = n & 15;
        float v[8];
#pragma unroll
        for (int e = 0; e < 8; ++e) { const int h = h0 + e;
            if (s < j) v[e] = KT[((0 * 16 + (j - s)) * 16 + hp) * 16 + h];
            else if (s > j) v[e] = KT[((1 * 16 + (s - j)) * 16 + hp) * 16 + h];
            else v[e] = KT[((0 * 16 + 0) * 16 + hp) * 16 + h] + KT[((1 * 16 + 0) * 16 + hp) * 16 + h] + (h == hp ? a.ssm_d[g * 16 + h] : 0.f); }
        u32x4 w; w.x = pk2(v[0], v[1]); w.y = pk2(v[2], v[3]); w.z = pk2(v[4], v[5]); w.w = pk2(v[6], v[7]);
        *(u32x4*)(WBIG + (size_t)n * 512 + s * 16 + h0) = w;
    }
    for (int q = tid; q < 2048; q += 512) {
        const int p = q & 63, js = (q >> 6) & 15, d = q >> 10; const float ldr = LD[(d * 64 + p) * 2], ldi = LD[(d * 64 + p) * 2 + 1];
        {   const float pw = (float)(d == 0 ? js + 1 : 16 - js); const float er = expf(pw * ldr); float sn, cs; sincosf(pw * ldi, &sn, &cs); const float pr = er * cs, pi = er * sn;
#pragma unroll
            for (int hp = 0; hp < 16; ++hp) { const float c_r = CC[((d * 16 + hp) * 64 + p) * 2], c_i = CC[((d * 16 + hp) * 64 + p) * 2 + 1];
                *(unsigned*)(WBIG + (size_t)(js * 16 + hp) * 512 + 256 + d * 128 + 2 * p) = pk2(c_r * pr - c_i * pi, -(c_r * pi + c_i * pr)); } }
        {   const float pw = (float)(d == 0 ? 15 - js : js); const float er = expf(pw * ldr); float sn, cs; sincosf(pw * ldi, &sn, &cs); const float pr = er * cs, pi = er * sn;
            float zr[16], zi[16];
#pragma unroll
            for (int h = 0; h < 16; ++h) { const float b_r = BB[((d * 64 + p) * 16 + h) * 2], b_i = BB[((d * 64 + p) * 16 + h) * 2 + 1]; zr[h] = pr * b_r - pi * b_i; zi[h] = pr * b_i + pi * b_r; }
            bf16_t* d0 = WIN + (size_t)(d * 128 + p) * 256 + js * 16; bf16_t* d1 = d0 + (size_t)64 * 256;
            u32x4 w; w.x = pk2(zr[0], zr[1]); w.y = pk2(zr[2], zr[3]); w.z = pk2(zr[4], zr[5]); w.w = pk2(zr[6], zr[7]); *(u32x4*)d0 = w;
            w.x = pk2(zr[8], zr[9]); w.y = pk2(zr[10], zr[11]); w.z = pk2(zr[12], zr[13]); w.w = pk2(zr[14], zr[15]); *(u32x4*)(d0 + 8) = w;
            w.x = pk2(zi[0], zi[1]); w.y = pk2(zi[2], zi[3]); w.z = pk2(zi[4], zi[5]); w.w = pk2(zi[6], zi[7]); *(u32x4*)d1 = w;
            w.x = pk2(zi[8], zi[9]); w.y = pk2(zi[10], zi[11]); w.z = pk2(zi[12], zi[13]); w.w = pk2(zi[14], zi[15]); *(u32x4*)(d1 + 8) = w; }
    }
    __syncthreads();
}

__global__ void __launch_bounds__(512, 2) fwd_kernel(Args a) {
    extern __shared__ __attribute__((aligned(16))) unsigned char lds_raw[];
    LAS unsigned char* lds = (LAS unsigned char*)lds_raw;
    cg::grid_group grid = cg::this_grid();
    const int wave = __builtin_amdgcn_readfirstlane(threadIdx.x >> 6);
#define LANE_IDS const int lane = lane_id_opaque(), tid = wave * 64 + lane; (void)tid;
    const int G = gridDim.x, bid = blockIdx.x;
    unsigned char* ws = a.ws;
    bf16_t* W1T = (bf16_t*)(ws + WS_W1T); bf16_t* WGLUT = (bf16_t*)(ws + WS_WGLUT); bf16_t* WOT = (bf16_t*)(ws + WS_WOT); bf16_t* WGT = (bf16_t*)(ws + WS_WGT); bf16_t* WPT = (bf16_t*)(ws + WS_WPT);
    float2* ROPE = (float2*)(ws + WS_ROPE); float* RINV = (float*)(ws + WS_RINV); float* LB16 = (float*)(ws + WS_LB16); float* SSQ1 = (float*)(ws + WS_SSQ1); float* SSQ2 = (float*)(ws + WS_SSQ2);
    bf16_t* PB = (bf16_t*)(ws + WS_PB); bf16_t* WIN = (bf16_t*)(ws + WS_WIN); bf16_t* WBIG = (bf16_t*)(ws + WS_WBIG);
    bf16_t* XB = (bf16_t*)(ws + WS_XB); bf16_t* HB = (bf16_t*)(ws + WS_XB);
    bf16_t* Q = (bf16_t*)(ws + WS_Q); bf16_t* KB = (bf16_t*)(ws + WS_K); bf16_t* VB = (bf16_t*)(ws + WS_V); bf16_t* GA = (bf16_t*)(ws + WS_GA); bf16_t* GS = (bf16_t*)(ws + WS_GS);
    bf16_t* UCAT = (bf16_t*)(ws + WS_UCAT); bf16_t* PPB = (bf16_t*)(ws + WS_UCAT); bf16_t* YMIX = (bf16_t*)(ws + WS_YMIX); bf16_t* YS = (bf16_t*)(ws + WS_YS);

#pragma unroll
    for (int rep_ = 0; rep_ < 1 + ((REP_MASK >> 0) & 1); ++rep_) { LANE_IDS
        if (bid == 0 && tid < 32) ((unsigned*)ws)[64 * tid] = 0u;
        const int gw = bid * 8 + wave, NGW = G * 8;
        LAS float* scr = (LAS float*)(lds + wave * 16384);
        constexpr int I1 = 32 * 144, I2 = 16 * 64, I3 = 32 * 64, I4 = 32 * 64, I5 = 4 * 64;
        for (int it = gw; it < I1 + I2 + I3 + I4 + I5; it += NGW) {
            int r = it;
            if (r < I1) { const int kb = r / 144, lgg = r % 144, pn = lgg >> 3, lg = lgg & 7, wtg = pn * 8 + 4 * (lg & 1) + 2 * (lg >> 2) + ((lg >> 1) & 1);
                p0_transpose_item(a.w_in, DM, DIN, W1T, wtg * 32, a.norm_mix, scr, kb * 64, lgg * 32, lane); continue; } r -= I1;
            if (r < I2) { const int kb = r / 64, lgg = r % 64, l2 = lgg & 31, wtg = (l2 >> 2) * 8 + 4 * (lgg >> 5) + (l2 & 3);
                p0_transpose_item(a.w_glu, DSSM, 2 * DSSM, WGLUT, wtg * 32, nullptr, scr, kb * 64, lgg * 32, lane); continue; } r -= I2;
            if (r < I3) { const int kb = r / 64, lgg = r % 64; p0_transpose_item(a.w_out, DM, DM, WOT, lgg * 32, nullptr, scr, kb * 64, lgg * 32, lane); continue; } r -= I3;
            if (r < I4) { const int kb = r / 64, lgg = r % 64; p0_transpose_item(a.w_ple_gate, DM, DM, WGT, lgg * 32, a.norm_ple, scr, kb * 64, lgg * 32, lane); continue; } r -= I4;
            { const int kb = r / 64, lgg = r % 64; p0_transpose_item(a.w_ple_proj, PLE, DM, WPT, lgg * 32, nullptr, scr, kb * 64, lgg * 32, lane); }
        }
        for (int m = gw; m < T; m += NGW) {
            const f32x4* xr = (const f32x4*)(a.x + (size_t)m * DM) + lane; f32x4 v[8]; float s = 0.f;
#pragma unroll
            for (int j = 0; j < 8; ++j) { v[j] = xr[64 * j]; s += (v[j][0] * v[j][0] + v[j][1] * v[j][1]) + (v[j][2] * v[j][2] + v[j][3] * v[j][3]); }
            s = wave_sum(s);
            if (lane == 0) RINV[m] = rsqrtf(s * (1.f / DM) + EPS);
            u32x2* o = (u32x2*)(XB + (size_t)m * DM) + lane;
#pragma unroll
            for (int j = 0; j < 8; ++j) { u32x2 w; w.x = pk2(v[j][0], v[j][1]); w.y = pk2(v[j][2], v[j][3]); o[64 * j] = w; }
        }
        for (int i = bid * 512 + tid; i < T * PLE / 4; i += G * 512) { const f32x4 v = ((const f32x4*)a.p)[i]; u32x2 w; w.x = pk2(v[0], v[1]); w.y = pk2(v[2], v[3]); ((u32x2*)PB)[i] = w; }
        for (int i = bid * 512 + tid; i < 2048; i += G * 512) { const int pos = i >> 5, f = i & 31; const float inv = powf(10000.f, -(float)f / 32.f); float sn, cs; sincosf((float)pos * inv, &sn, &cs); ROPE[i] = make_float2(cs, sn); }
    grid.sync(); }


#pragma unroll
    for (int rep_ = 0; rep_ < 1 + ((REP_MASK >> 1) & 1); ++rep_) { LANE_IDS
        { pg8::Gemm g{XB, W1T, DM, DM, DM, 0, 0}; pg8::StaticOrder S; S.init(T, 14 * 256, G, bid);
          pg8::Epi1 E{RINV, a.q_norm, a.k_norm, ROPE, Q, KB, VB, GA, GS, UCAT, (LAS float*)(lds + XCH_OFF), 0};
          pg8::gemm_phase<pg8::Epi1, pg8::StaticOrder, true>(lds, g, S, E, wave); }
        __syncthreads();
        for (int gi = bid - (G - NG); gi >= 0 && gi < NG; gi += NG) ssm_tables(a, gi, lds, tid);
    grid.sync(); }

#pragma unroll
    for (int rep_ = 0; rep_ < 1 + ((REP_MASK >> 2) & 1); ++rep_) {
#pragma unroll
        for (int rq_ = 0; rq_ < 1 + ((REP_MASK >> 6) & 1); ++rq_) {
        if (bid < 2 * NG) {
            pg8::BatchOrder S{2 * NG, G, bid};
            { pg8::Gemm g{UCAT, WIN, 256, 512, 256, (size_t)NCH * 512 * 2, (size_t)256 * 256 * 2};
              pg8::EpiS1 E{LB16, UCAT}; pg8::gemm_phase<pg8::EpiS1, pg8::BatchOrder, false>(lds, g, S, E, wave); }
            __threadfence(); __syncthreads();
            { pg8::Gemm g{UCAT, WBIG, 512, 512, 512, (size_t)NCH * 512 * 2, (size_t)256 * 512 * 2};
              pg8::EpiS2 E{YS}; pg8::gemm_phase<pg8::EpiS2, pg8::BatchOrder, false>(lds, g, S, E, wave); }
        } else {
            pg8::Gemm g{XB, W1T + (size_t)14 * 256 * DM, DM, DM, DM, 0, 0}; pg8::ListOrder S{bid - 2 * NG, 128, G};
            pg8::Epi1 E{RINV, a.q_norm, a.k_norm, ROPE, Q, KB, VB, GA, GS, UCAT, (LAS float*)(lds + XCH_OFF), 14};
            pg8::gemm_phase<pg8::Epi1, pg8::ListOrder, true>(lds, g, S, E, wave);
        }
        __syncthreads(); }
#pragma unroll
        for (int rq_ = 0; rq_ < 1 + ((REP_MASK >> 7) & 1); ++rq_)
        for (int un = bid; un < 256; un += G) {
            const int x = un & 7, jj = un >> 3, b = x >> 2, kvh = (x >> 1) & 1, idx = (x & 1) * 32 + jj, h = kvh * 4 + (idx >> 4), qb = idx & 15;
            const size_t tok0 = (size_t)b * SEQ + qb * 256;
            att::attn_dense_body(Q + tok0 * DATT + h * 128, KB + (size_t)b * SEQ * DKV + kvh * 128, VB + (size_t)b * SEQ * DKV + kvh * 128,
                                 GA + tok0 * DATT + h * 128, YMIX + tok0 * DM + h * 128, SEQ, (char*)lds_raw, wave);
        }
    grid.sync(); }

#pragma unroll
    for (int rep_ = 0; rep_ < 1 + ((REP_MASK >> 3) & 1); ++rep_) {
        { pg8::Gemm g{YS, WGLUT, DSSM, DSSM, DSSM, 0, 0}; pg8::StaticOrder S; S.init(T, 2 * DSSM, G, bid);
          pg8::EpiGlu E{a.b_glu, GS, YMIX}; pg8::gemm_phase<pg8::EpiGlu, pg8::StaticOrder, false>(lds, g, S, E, wave); }
        __syncthreads();
        { pg8::Gemm g{PB, WPT, PLE, PLE, PLE, 0, 0}; pg8::StaticOrder S; S.init(T, DM, G, bid);
          pg8::EpiBf E{PPB, DM}; pg8::gemm_phase<pg8::EpiBf, pg8::StaticOrder, false>(lds, g, S, E, wave); }
    grid.sync(); }


#pragma unroll
    for (int rep_ = 0; rep_ < 1 + ((REP_MASK >> 4) & 1); ++rep_) {
        pg8::Gemm g{YMIX, WOT, DM, DM, DM, 0, 0}; pg8::StaticOrder S; S.init(T, DM, G, bid);
        pg8::EpiOut E{a.x, a.out, HB, SSQ1}; pg8::gemm_phase<pg8::EpiOut, pg8::StaticOrder, false>(lds, g, S, E, wave);
    grid.sync(); }


    { LANE_IDS
        pg8::StaticOrder S; S.init(T, DM, G, bid); pg8::Unit u0;
        LAS float* r2 = (LAS float*)(lds + R2_OFF);
        if (S.next(0, u0) && tid < 256) { const float* sp = SSQ1 + (size_t)(u0.pm * 256 + tid) * 32; float s = 0.f;
#pragma unroll
            for (int i = 0; i < 8; ++i) { const f32x4 v = ((const f32x4*)sp)[i]; s += (v[0] + v[1]) + (v[2] + v[3]); }
            r2[tid] = rsqrtf(s * (1.f / DM) + EPS); }
        __syncthreads();
        pg8::Gemm g{HB, WGT, DM, DM, DM, 0, 0};
        pg8::EpiGate E{a.out, PPB, SSQ2, (unsigned*)ws, a.norm_final, r2}; pg8::gemm_phase<pg8::EpiGate, pg8::StaticOrder, false>(lds, g, S, E, wave);
    }
}

extern "C" void kernel_launch(void* const* d_in, const int* in_sizes, int n_in, void* d_out, int out_size, void* d_ws, size_t ws_size, hipStream_t stream) {
    static int grid = 0;
    if (grid == 0) {
        if (n_in != 21 || in_sizes[0] != T * DM || out_size != T * DM || ws_size < WS_END) { fprintf(stderr, "kernel_launch: unexpected shapes (n_in %d, in0 %d, out %d, ws %zu)\n", n_in, n_in > 0 ? in_sizes[0] : -1, out_size, ws_size); grid = -1; return; }
        int dev = 0, cus = 0, per_cu = 0;
        hipGetDevice(&dev); hipDeviceGetAttribute(&cus, hipDeviceAttributeMultiprocessorCount, dev);
        if (hipFuncSetAttribute((const void*)fwd_kernel, hipFuncAttributeMaxDynamicSharedMemorySize, LDS_BYTES) != hipSuccess) { fprintf(stderr, "kernel_launch: hipFuncSetAttribute failed\n"); grid = -1; return; }
        hipOccupancyMaxActiveBlocksPerMultiprocessor(&per_cu, (const void*)fwd_kernel, 512, LDS_BYTES);
        (void)hipGetLastError();
        if (per_cu < 1) fprintf(stderr, "kernel_launch: occupancy query reports %d blocks per CU\n", per_cu);
        grid = cus > 256 ? 256 : cus;
    }
    if (grid < 0) return;
    Args a{};
    const float** f = (const float**)&a;
    for (int i = 0; i < 21; ++i) f[i] = (const float*)d_in[i];
    a.out = (float*)d_out; a.ws = (unsigned char*)d_ws;
    void* args[] = {&a};
    hipError_t e = hipLaunchCooperativeKernel((const void*)fwd_kernel, dim3(grid), dim3(512), args, LDS_BYTES, stream);
    if (e != hipSuccess) fprintf(stderr, "kernel_launch: cooperative launch failed: %s (grid %d)\n", hipGetErrorString(e), grid);
}
```

```cpp
#include <hip/hip_runtime.h>
#include <hip/hip_cooperative_groups.h>
#include <cstdio>
#include <cstdint>
namespace cg = cooperative_groups;

#define LAS __attribute__((address_space(3)))
typedef unsigned short bf16_t;
typedef short bf16x8 __attribute__((ext_vector_type(8)));
typedef short s16x4 __attribute__((ext_vector_type(4)));
typedef float f32x4 __attribute__((ext_vector_type(4)));
typedef float f32x16 __attribute__((ext_vector_type(16)));
typedef unsigned u32x4 __attribute__((ext_vector_type(4)));
typedef unsigned u32x2 __attribute__((ext_vector_type(2)));

constexpr int T = 8192, SEQ = 4096, DM = 2048, DIN = 4608, DATT = 1024, DKV = 256, DSSM = 1024, PLE = 256;
constexpr int NG = 64, NCH = T / 16;
constexpr float EPS = 1e-6f;
#ifndef PH_MASK
#define PH_MASK 0xff
#endif
#ifndef REP_MASK
#define REP_MASK 0
#endif

constexpr size_t MiB = 1u << 20;
constexpr size_t WS_W1T = 1 * MiB, WS_WGLUT = 19 * MiB, WS_WOT = 23 * MiB, WS_WGT = 31 * MiB, WS_WPT = 39 * MiB;
constexpr size_t WS_ROPE = 40 * MiB, WS_RINV = 40 * MiB + 65536, WS_LB16 = 40 * MiB + 131072, WS_SSQ1 = 41 * MiB, WS_SSQ2 = 42 * MiB;
constexpr size_t WS_PB = 43 * MiB, WS_WIN = 47 * MiB, WS_WBIG = 55 * MiB;
constexpr size_t WS_XB = 71 * MiB;
constexpr size_t WS_Q = 103 * MiB, WS_K = 119 * MiB, WS_V = 123 * MiB, WS_GA = 127 * MiB, WS_GS = 143 * MiB;
constexpr size_t WS_UCAT = 159 * MiB;
constexpr size_t WS_YMIX = 191 * MiB, WS_YS = 223 * MiB, WS_END = 239 * MiB;

constexpr int RING_BYTES = 131072, XCH_OFF = RING_BYTES, R2_OFF = RING_BYTES + 4096, XBST_OFF = RING_BYTES + 8192, LDS_BYTES = 147456;
constexpr size_t WS_BAR = 65536, WS_CTL_BYTES = 131072;

struct Args {
    const float *x, *p, *norm_mix, *w_in, *q_norm, *k_norm, *a_re, *a_im, *log_dt, *b_re, *b_im, *c_re, *c_im, *ssm_d, *w_glu, *b_glu, *w_out, *norm_ple, *w_ple_gate, *w_ple_proj, *norm_final;
    float* out; unsigned char* ws;
};

__device__ __forceinline__ unsigned f2bf(float f) { unsigned u = __builtin_bit_cast(unsigned, f); return (u + 0x7fffu + ((u >> 16) & 1u)) >> 16; }
__device__ __forceinline__ unsigned pk2(float lo, float hi) { return f2bf(lo) | (f2bf(hi) << 16); }
__device__ __forceinline__ float bf2f(unsigned short b) { return __builtin_bit_cast(float, (unsigned)b << 16); }
__device__ __forceinline__ float bflo(unsigned w) { return __builtin_bit_cast(float, w << 16); }
__device__ __forceinline__ float bfhi(unsigned w) { return __builtin_bit_cast(float, w & 0xffff0000u); }
__device__ __forceinline__ unsigned cvt_pk_bf16(float lo, float hi) { unsigned r; asm volatile("v_cvt_pk_bf16_f32 %0, %1, %2" : "=v"(r) : "v"(lo), "v"(hi)); return r; }
__device__ __forceinline__ float sigmoidf_(float v) { return 1.f / (1.f + __expf(-v)); }
__device__ __forceinline__ float siluf_(float v) { return v / (1.f + __expf(-v)); }
__device__ __forceinline__ float gelu_tanh(float v) { const float t = 1.5957691216057308f * (v + 0.044715f * v * v * v); return v / (1.f + __expf(-t)); }
template <int K> __device__ __forceinline__ float swz_xor(float v) { return __int_as_float(__builtin_amdgcn_ds_swizzle(__float_as_int(v), (K << 10) | 0x1f)); }
__device__ __forceinline__ float sum_xor32(float v) { auto rr = __builtin_amdgcn_permlane32_swap(__float_as_uint(v), __float_as_uint(v), false, false); return __uint_as_float(rr[0]) + __uint_as_float(rr[1]); }
__device__ __forceinline__ float wave_sum(float v) { v += swz_xor<1>(v); v += swz_xor<2>(v); v += swz_xor<4>(v); v += swz_xor<8>(v); v += swz_xor<16>(v); return sum_xor32(v); }
#define LDS_WAIT() asm volatile("s_waitcnt lgkmcnt(0)" ::: "memory")
__device__ __forceinline__ int lane_id_opaque() { int l = __builtin_amdgcn_mbcnt_hi(~0u, __builtin_amdgcn_mbcnt_lo(~0u, 0u)); asm volatile("" : "+v"(l)); return l; }

namespace pg8 {
constexpr int BM = 256, BK = 64, HALF = 128, HTB = HALF * BK * 2, NXCD = 8, WGM = 8;
__host__ __device__ __forceinline__ int lds_byte(int r, int c) { const int st = (r >> 4) * 2 + (c >> 5), rr = r & 15, cc = c & 31, ob = rr * 64 + cc * 2; return st * 1024 + (ob ^ (((ob >> 9) & 1) << 5)); }
__host__ __device__ __forceinline__ void stage_rc(int b, int& R, int& C) { const int st = b / 1024, sb = b % 1024, swz = sb ^ (((sb >> 9) & 1) << 5); R = (st >> 1) * 16 + swz / 64; C = (st & 1) * 32 + (swz % 64) / 2; }
__host__ __device__ __forceinline__ int perm32(int rho) { const int n = rho >> 4, i = rho & 15; return 8 * (i >> 2) + 4 * n + (i & 3); }

struct Unit { int pm, pn, z; };
struct Gemm { const bf16_t* A; const bf16_t* Bt; int K, lda, ldb; size_t zA, zB; };

struct StaticOrder {
    int nM, nN, nwg, G, c;
    __device__ void init(int M, int N, int G_, int c_) { nM = M / BM; nN = N / BM; nwg = nM * nN; G = G_; c = c_; }
    __device__ bool next(int i, Unit& u) const {
        const long L = (long)i * G + c; if (L >= nwg) return false;
        int wgid = (int)L; { const int q = nwg / NXCD, r = nwg % NXCD, xcd = wgid % NXCD, off = wgid / NXCD; wgid = (xcd < r ? xcd * (q + 1) : r * (q + 1) + (xcd - r) * q) + off; }
        const int nig = WGM * nN, gid = wgid / nig, fm = gid * WGM, gsz = (nM - fm) < WGM ? (nM - fm) : WGM;
        u.pm = fm + ((wgid % nig) % gsz); u.pn = (wgid % nig) / gsz; u.z = 0; return true;
    }
};
struct BatchOrder {
    int n, G, c;
    __device__ bool next(int i, Unit& u) const { const int L = i * G + c; if (L >= n) return false; u.z = L >> 1; u.pm = L & 1; u.pn = 0; return true; }
};

struct ListOrder {
    int L0, n, stride;
    __device__ bool next(int i, Unit& u) const { const int L = L0 + i * stride; if (L < 0 || L >= n) return false; u.pm = L >> 2; u.pn = L & 3; u.z = 0; return true; }
};
template <class Epi, class Sched, bool ALIGN_EPI>
__device__ __forceinline__ void gemm_phase(LAS unsigned char* lds, const Gemm g, const Sched& S, const Epi& E, const int wid) {
    const int lane = lane_id_opaque(), tid = wid * 64 + lane, wr = wid >> 2, wc = wid & 3, fr = lane & 15, fq = lane >> 4;
    const int K = g.K, nt = K / BK;
    unsigned voffA[2], voffB[2];
#pragma unroll
    for (int i = 0; i < 2; ++i) { int R, C; stage_rc(tid * 16 + i * 8192, R, C); const int Rb = (R & ~31) + perm32(R & 31);
        voffA[i] = (unsigned)(R * g.lda + C) * 2u; voffB[i] = (unsigned)(Rb * g.ldb + C) * 2u; }
    const size_t kstep = (size_t)(BK * 2);
    const size_t hstepA = (size_t)HALF * g.lda * 2, hstepB = (size_t)HALF * g.ldb * 2;
    const size_t tstepA = 2 * hstepA, tstepB = 2 * hstepB;
    const unsigned ldsw = (unsigned)wid * 1024u;
    const int aoff = lds_byte(wr * 64 + fr, fq * 8), boff = lds_byte(wc * 32 + fr, fq * 8);
#define PG8_SA(b, h) (((b) * 2 + (h)) * HTB)
#define PG8_SB(b, h) ((4 + (b) * 2 + (h)) * HTB)
#define PG8_STAGE(bufoff, gbase, voff) do { _Pragma("unroll") for (int _i = 0; _i < 2; ++_i) \
        __builtin_amdgcn_global_load_lds((const unsigned*)((const char*)(gbase) + (voff)[_i]), (LAS unsigned*)(lds + (bufoff) + ldsw + _i * 8192), 16, 0, 0); } while (0)
#define PG8_LDA(dst, b, h) do { _Pragma("unroll") for (int m = 0; m < 4; ++m) _Pragma("unroll") for (int k = 0; k < 2; ++k) dst[m][k] = *(const LAS bf16x8*)(lds + PG8_SA(b, h) + aoff + m * 2048 + k * 1024); } while (0)
#define PG8_LDB(dst, b, h) do { _Pragma("unroll") for (int n = 0; n < 2; ++n) _Pragma("unroll") for (int k = 0; k < 2; ++k) dst[n][k] = *(const LAS bf16x8*)(lds + PG8_SB(b, h) + boff + n * 2048 + k * 1024); } while (0)
#define PG8_MMA(ai, bj, At, Bt) do { __builtin_amdgcn_s_setprio(1); _Pragma("unroll") for (int m = 0; m < 4; ++m) _Pragma("unroll") for (int n = 0; n < 2; ++n) _Pragma("unroll") for (int k = 0; k < 2; ++k) \
        acc[ai][bj][m][n] = __builtin_amdgcn_mfma_f32_16x16x32_bf16(Bt[n][k], At[m][k], acc[ai][bj][m][n], 0, 0, 0); __builtin_amdgcn_s_setprio(0); } while (0)
#define PG8_WAIT_V(n) asm volatile("s_waitcnt vmcnt(" #n ")" ::: "memory")
#define PG8_WAIT_L(n) asm volatile("s_waitcnt lgkmcnt(" #n ")" ::: "memory")
#define PG8_BAR __builtin_amdgcn_s_barrier()
#define PG8_SCHED __builtin_amdgcn_sched_barrier(0)
    Unit cur, nxt; int ui = 0;
    if (!S.next(0, cur)) return;
    f32x4 acc[2][2][4][2];
#pragma unroll
    for (int a = 0; a < 2; ++a)
#pragma unroll
        for (int b = 0; b < 2; ++b)
#pragma unroll
            for (int m = 0; m < 4; ++m)
#pragma unroll
                for (int n = 0; n < 2; ++n) acc[a][b][m][n] = (f32x4){0.f, 0.f, 0.f, 0.f};
    bf16x8 At[4][2], B0[2][2], B1[2][2];
    const char* cA = (const char*)g.A + (size_t)cur.z * g.zA + (size_t)cur.pm * tstepA; const char* cB = (const char*)g.Bt + (size_t)cur.z * g.zB + (size_t)cur.pn * tstepB;
    PG8_STAGE(PG8_SB(0, 0), cB, voffB); PG8_STAGE(PG8_SB(0, 1), cB + hstepB, voffB); PG8_STAGE(PG8_SA(0, 0), cA, voffA); PG8_STAGE(PG8_SA(0, 1), cA + hstepA, voffA);
    if (wr == 1) PG8_BAR;
    PG8_WAIT_V(2); PG8_BAR;
    PG8_STAGE(PG8_SB(1, 0), cB + kstep, voffB); PG8_STAGE(PG8_SA(1, 0), cA + kstep, voffA); PG8_STAGE(PG8_SB(1, 1), cB + hstepB + kstep, voffB);
    PG8_WAIT_V(6); PG8_BAR;
    for (;;) {
        const bool has_next = S.next(ui + 1, nxt);
        const char* nA = has_next ? (const char*)g.A + (size_t)nxt.z * g.zA + (size_t)nxt.pm * tstepA : cA;
        const char* nB = has_next ? (const char*)g.Bt + (size_t)nxt.z * g.zB + (size_t)nxt.pn * tstepB : cB;
        for (int t = 0; t < nt; t += 2) {
            const bool last = (t == nt - 2);
            const char* a1 = cA + (size_t)(t + 1) * kstep;
            const char* a2 = last ? nA : cA + (size_t)(t + 2) * kstep; const char* b2 = last ? nB : cB + (size_t)(t + 2) * kstep;
            const char* a3 = a2 + kstep; const char* b3 = b2 + kstep;
            PG8_LDB(B0, 0, 0); PG8_LDB(B1, 0, 1); PG8_SCHED; PG8_LDA(At, 0, 0); PG8_STAGE(PG8_SA(1, 1), a1 + hstepA, voffA);
            PG8_WAIT_V(8); PG8_WAIT_L(0); PG8_BAR; PG8_MMA(0, 0, At, B0); PG8_MMA(0, 1, At, B1); PG8_BAR; PG8_SCHED;
            PG8_LDA(At, 0, 1); PG8_STAGE(PG8_SB(0, 0), b2, voffB); PG8_STAGE(PG8_SB(0, 1), b2 + hstepB, voffB); PG8_STAGE(PG8_SA(0, 0), a2, voffA);
            PG8_WAIT_V(8); PG8_WAIT_L(0); PG8_BAR; PG8_MMA(1, 0, At, B0); PG8_MMA(1, 1, At, B1); PG8_BAR; PG8_SCHED;
            PG8_LDB(B0, 1, 0); PG8_LDB(B1, 1, 1); PG8_SCHED; PG8_LDA(At, 1, 0); PG8_STAGE(PG8_SA(0, 1), a2 + hstepA, voffA);
            PG8_WAIT_V(8); PG8_WAIT_L(0); PG8_BAR; PG8_MMA(0, 0, At, B0); PG8_MMA(0, 1, At, B1); PG8_BAR; PG8_SCHED;
            PG8_LDA(At, 1, 1); PG8_STAGE(PG8_SB(1, 0), b3, voffB); PG8_STAGE(PG8_SB(1, 1), b3 + hstepB, voffB); PG8_STAGE(PG8_SA(1, 0), a3, voffA);
            PG8_WAIT_V(8); PG8_WAIT_L(0); PG8_BAR; PG8_MMA(1, 0, At, B0); PG8_MMA(1, 1, At, B1); PG8_BAR; PG8_SCHED;
        }
        if constexpr (ALIGN_EPI) { if (wr == 0) PG8_BAR; }
        if constexpr (!Epi::AFTER_DRAIN) E(acc, cur, wr, wc, fr, fq);
        if (!has_next) break;
#pragma unroll
        for (int a = 0; a < 2; ++a)
#pragma unroll
            for (int b = 0; b < 2; ++b)
#pragma unroll
                for (int m = 0; m < 4; ++m)
#pragma unroll
                    for (int n = 0; n < 2; ++n) acc[a][b][m][n] = (f32x4){0.f, 0.f, 0.f, 0.f};
        cur = nxt; cA = nA; cB = nB; ++ui;
        if constexpr (ALIGN_EPI) { if (wr == 1) PG8_BAR; }
    }
    PG8_WAIT_V(0);
    if constexpr (!ALIGN_EPI) { if (wr == 0) PG8_BAR; }
    PG8_BAR;
    if constexpr (Epi::AFTER_DRAIN) E.fused(acc, cur, wr, wc, lds, wid);
#undef PG8_SA
#undef PG8_SB
#undef PG8_STAGE
#undef PG8_LDA
#undef PG8_LDB
#undef PG8_MMA
#undef PG8_WAIT_V
#undef PG8_WAIT_L
#undef PG8_BAR
#undef PG8_SCHED
}

#define EPI_FOR_ROWS _Pragma("unroll") for (int ai = 0; ai < 2; ++ai) _Pragma("unroll") for (int m = 0; m < 4; ++m)
#define EPI_ROWDEF const int rit = ai * HALF + wr * 64 + m * 16 + fr; const int row = u.pm * BM + rit; (void)rit; (void)row;

struct Epi1 {
    static constexpr bool AFTER_DRAIN = false;
    const float* rinv; const float* qnw; const float* knw; const float2* rope;
    bf16_t *Q, *Kb, *Vb, *GA, *GS, *UCAT; LAS float* xch; int pn0;
    __device__ __forceinline__ void operator()(const f32x4 (&acc)[2][2][4][2], const Unit& u, int wr, int wc, int, int) const {
        const int l_ = lane_id_opaque(), fr = l_ & 15, fq = l_ >> 4;
        const int pn = u.pn + pn0;
        if (pn <= 4) {
            float ss[2][4];
            EPI_FOR_ROWS { EPI_ROWDEF const float r = rinv[row]; float s = 0.f;
#pragma unroll
                for (int bj = 0; bj < 2; ++bj)
#pragma unroll
                    for (int n = 0; n < 2; ++n) { const f32x4 v = acc[ai][bj][m][n] * r; s += (v[0] * v[0] + v[1] * v[1]) + (v[2] * v[2] + v[3] * v[3]); }
                s += swz_xor<16>(s); s = sum_xor32(s); ss[ai][m] = s;
                if (fq == 0) xch[wc * 256 + rit] = s; }
            LDS_WAIT(); __builtin_amdgcn_s_barrier(); asm volatile("" ::: "memory");
            const int half = wc & 1, hd = wc >> 1;
            const float* nw = (pn < 4 ? qnw : knw) + 64 * half + 8 * fq;
            float w1[8], w2[8];
#pragma unroll
            for (int i = 0; i < 8; ++i) { w1[i] = nw[i]; w2[i] = nw[32 + i]; }
            EPI_FOR_ROWS { EPI_ROWDEF const float tot = ss[ai][m] + xch[(wc ^ 1) * 256 + rit];
                const float sc = rinv[row] * rsqrtf(tot * (1.f / 128.f) + EPS);
                const int t = row & (SEQ - 1); const int pos = half ? (t & 63) : (t >> 6);
                const float2* rp = rope + pos * 32 + 8 * fq;
                float o1[8], o2[8];
#pragma unroll
                for (int n = 0; n < 2; ++n)
#pragma unroll
                    for (int e = 0; e < 4; ++e) { const int i = 4 * n + e; const float2 cs = rp[i];
                        const float x1 = acc[ai][0][m][n][e] * sc * w1[i], x2 = acc[ai][1][m][n][e] * sc * w2[i];
                        o1[i] = x1 * cs.x - x2 * cs.y; o2[i] = x2 * cs.x + x1 * cs.y; }
                bf16_t* dst = (pn < 4) ? Q + (size_t)row * DATT + (2 * pn + hd) * 128 + 64 * half + 8 * fq : Kb + (size_t)row * DKV + hd * 128 + 64 * half + 8 * fq;
                u32x4 a; a.x = pk2(o1[0], o1[1]); a.y = pk2(o1[2], o1[3]); a.z = pk2(o1[4], o1[5]); a.w = pk2(o1[6], o1[7]);
                u32x4 b; b.x = pk2(o2[0], o2[1]); b.y = pk2(o2[2], o2[3]); b.z = pk2(o2[4], o2[5]); b.w = pk2(o2[6], o2[7]);
                *(u32x4*)dst = a; *(u32x4*)(dst + 32) = b; }
        } else {
            const int lg0 = 4 * (wc >> 1) + 2 * (wc & 1);
            EPI_FOR_ROWS { EPI_ROWDEF const float r = rinv[row];
#pragma unroll
                for (int bj = 0; bj < 2; ++bj) { const int L = 256 * pn + 32 * (lg0 + bj) + 8 * fq;
                    f32x4 v0 = acc[ai][bj][m][0] * r, v1 = acc[ai][bj][m][1] * r; bf16_t* dst;
                    if (pn == 5) dst = Vb + (size_t)row * DKV + (L - 1280);
                    else if (pn < 10) dst = GA + (size_t)row * DATT + (L - 1536);
                    else if (pn < 14) { const int Lu = L - 2560; dst = UCAT + ((size_t)(Lu >> 4) * NCH + (row >> 4)) * 512 + (row & 15) * 16 + (Lu & 15); }
                    else dst = GS + (size_t)row * DSSM + (L - 3584);
                    if ((pn >= 6 && pn < 10) || pn >= 14) {
#pragma unroll
                        for (int e = 0; e < 4; ++e) { v0[e] = siluf_(v0[e]); v1[e] = siluf_(v1[e]); } }
                    u32x4 w; w.x = pk2(v0[0], v0[1]); w.y = pk2(v0[2], v0[3]); w.z = pk2(v1[0], v1[1]); w.w = pk2(v1[2], v1[3]);
                    *(u32x4*)dst = w; } }
        }
    }
};
struct EpiS1 {
    static constexpr bool AFTER_DRAIN = true;
    const float* lb16; bf16_t* UCAT;
    __device__ __forceinline__ void operator()(const f32x4 (&)[2][2][4][2], const Unit&, int, int, int, int) const {}
    __device__ __forceinline__ void fused(const f32x4 (&acc)[2][2][4][2], const Unit& u, int wr, int wc, LAS unsigned char* lds, int wid) const {
        const int l_ = lane_id_opaque(), fr = l_ & 15, fq = l_ >> 4;
        LAS float* Tl = (LAS float*)lds;
#pragma unroll
        for (int d = 0; d < 2; ++d) {
            EPI_FOR_ROWS { const int rit = ai * HALF + wr * 64 + m * 16 + fr; LAS float* rp = Tl + rit * 128 + wc * 32 + 8 * fq;
                *(LAS f32x4*)rp = acc[ai][d][m][0]; *(LAS f32x4*)(rp + 4) = acc[ai][d][m][1]; }
            LDS_WAIT(); __builtin_amdgcn_s_barrier(); asm volatile("" ::: "memory");
            if (wid == 0) {
                const int p = l_; const float lr = lb16[((u.z * 2 + d) * 64 + p) * 2], li = lb16[((u.z * 2 + d) * 64 + p) * 2 + 1];
                float xr = 0.f, xi = 0.f;
#pragma unroll 8
                for (int cc = 0; cc < 256; ++cc) { const int c = d ? 255 - cc : cc;
                    const float sr = Tl[c * 128 + p], si = Tl[c * 128 + 64 + p];
                    Tl[c * 128 + p] = __uint_as_float(pk2(xr, xi));
                    const float nr = lr * xr - li * xi + sr; xi = lr * xi + li * xr + si; xr = nr; }
            }
            LDS_WAIT(); __builtin_amdgcn_s_barrier(); asm volatile("" ::: "memory");
            {   bf16_t* ub = UCAT + ((size_t)u.z * NCH + u.pm * 256) * 512 + 256 + d * 128;
#pragma unroll
                for (int i = 0; i < 8; ++i) { const int q = wid * 64 + l_ + 512 * i, r = q >> 4, c8 = (q & 15) * 8;
                    *(u32x4*)(ub + (size_t)r * 512 + c8) = *(const LAS u32x4*)((LAS bf16_t*)(Tl + r * 128) + c8); } }
            LDS_WAIT(); __builtin_amdgcn_s_barrier(); asm volatile("" ::: "memory");
        }
    }
};
struct EpiS2 {
    static constexpr bool AFTER_DRAIN = false;
    bf16_t* YS;
    __device__ __forceinline__ void operator()(const f32x4 (&acc)[2][2][4][2], const Unit& u, int wr, int wc, int, int) const {
        const int l_ = lane_id_opaque(), fr = l_ & 15, fq = l_ >> 4;
        EPI_FOR_ROWS { EPI_ROWDEF
#pragma unroll
            for (int bj = 0; bj < 2; ++bj) { const int c = bj * HALF + wc * 32 + 8 * fq; const int j = c >> 4, h0 = c & 15;
                const f32x4 v0 = acc[ai][bj][m][0], v1 = acc[ai][bj][m][1];
                u32x4 w; w.x = pk2(gelu_tanh(v0[0]), gelu_tanh(v0[1])); w.y = pk2(gelu_tanh(v0[2]), gelu_tanh(v0[3])); w.z = pk2(gelu_tanh(v1[0]), gelu_tanh(v1[1])); w.w = pk2(gelu_tanh(v1[2]), gelu_tanh(v1[3]));
                *(u32x4*)(YS + ((size_t)row * 16 + j) * DSSM + u.z * 16 + h0) = w; } }
    }
};
struct EpiGlu {
    static constexpr bool AFTER_DRAIN = false;
    const float* bglu; const bf16_t* GS; bf16_t* YMIX;
    __device__ __forceinline__ void operator()(const f32x4 (&acc)[2][2][4][2], const Unit& u, int wr, int wc, int, int) const {
        const int l_ = lane_id_opaque(), fr = l_ & 15, fq = l_ >> 4;
        const int a0 = 128 * u.pn + 32 * wc + 8 * fq;
        float bv[8], bg[8];
#pragma unroll
        for (int i = 0; i < 8; ++i) { bv[i] = bglu[a0 + i]; bg[i] = bglu[1024 + a0 + i]; }
        EPI_FOR_ROWS { EPI_ROWDEF const u32x4 gs = *(const u32x4*)(GS + (size_t)row * DSSM + a0);
            float o[8];
#pragma unroll
            for (int n = 0; n < 2; ++n)
#pragma unroll
                for (int e = 0; e < 4; ++e) { const int i = 4 * n + e; o[i] = (acc[ai][0][m][n][e] + bv[i]) * sigmoidf_(acc[ai][1][m][n][e] + bg[i]); }
            o[0] *= bflo(gs.x); o[1] *= bfhi(gs.x); o[2] *= bflo(gs.y); o[3] *= bfhi(gs.y); o[4] *= bflo(gs.z); o[5] *= bfhi(gs.z); o[6] *= bflo(gs.w); o[7] *= bfhi(gs.w);
            u32x4 w; w.x = pk2(o[0], o[1]); w.y = pk2(o[2], o[3]); w.z = pk2(o[4], o[5]); w.w = pk2(o[6], o[7]);
            *(u32x4*)(YMIX + (size_t)row * DM + 1024 + a0) = w; }
    }
};
struct EpiBf {
    static constexpr bool AFTER_DRAIN = false;
    bf16_t* O; int ldc;
    __device__ __forceinline__ void operator()(const f32x4 (&acc)[2][2][4][2], const Unit& u, int wr, int wc, int, int) const {
        const int l_ = lane_id_opaque(), fr = l_ & 15, fq = l_ >> 4;
        EPI_FOR_ROWS { EPI_ROWDEF
#pragma unroll
            for (int bj = 0; bj < 2; ++bj) { const f32x4 v0 = acc[ai][bj][m][0], v1 = acc[ai][bj][m][1];
                u32x4 w; w.x = pk2(v0[0], v0[1]); w.y = pk2(v0[2], v0[3]); w.z = pk2(v1[0], v1[1]); w.w = pk2(v1[2], v1[3]);
                *(u32x4*)(O + (size_t)row * ldc + u.pn * BM + bj * HALF + wc * 32 + 8 * fq) = w; } }
    }
};
struct EpiOut {
    static constexpr bool AFTER_DRAIN = false;
    const float* x; float* H; bf16_t* HB; float* ssq;
    __device__ __forceinline__ void operator()(const f32x4 (&acc)[2][2][4][2], const Unit& u, int wr, int wc, int, int) const {
        const int l_ = lane_id_opaque(), fr = l_ & 15, fq = l_ >> 4;
        EPI_FOR_ROWS { EPI_ROWDEF float s = 0.f;
#pragma unroll
            for (int bj = 0; bj < 2; ++bj) { const size_t off = (size_t)row * DM + u.pn * BM + bj * HALF + wc * 32 + 8 * fq;
                const f32x4 v0 = acc[ai][bj][m][0] + *(const f32x4*)(x + off), v1 = acc[ai][bj][m][1] + *(const f32x4*)(x + off + 4);
                *(f32x4*)(H + off) = v0; *(f32x4*)(H + off + 4) = v1;
                s += (v0[0] * v0[0] + v0[1] * v0[1]) + (v0[2] * v0[2] + v0[3] * v0[3]) + (v1[0] * v1[0] + v1[1] * v1[1]) + (v1[2] * v1[2] + v1[3] * v1[3]);
                u32x4 w; w.x = pk2(v0[0], v0[1]); w.y = pk2(v0[2], v0[3]); w.z = pk2(v1[0], v1[1]); w.w = pk2(v1[2], v1[3]);
                *(u32x4*)(HB + off) = w; }
            s += swz_xor<16>(s); s = sum_xor32(s);
            if (fq == 0) ssq[(size_t)row * 32 + u.pn * 4 + wc] = s; }
    }
};
struct EpiGate {
    static constexpr bool AFTER_DRAIN = true;
    float* H; const bf16_t* PP; float* ssq; unsigned* cnt; const float* nf; const LAS float* r2;
    __device__ __forceinline__ void operator()(const f32x4 (&)[2][2][4][2], const Unit&, int, int, int, int) const {}
    __device__ __forceinline__ void fused(f32x4 (&acc)[2][2][4][2], const Unit& u, int wr, int wc, LAS unsigned char* lds, int wid) const {
        const int l_ = lane_id_opaque(), fr = l_ & 15, fq = l_ >> 4, tid = wid * 64 + l_;
        LAS float* P = (LAS float*)lds; LAS float* Rn = P + 1024;
        EPI_FOR_ROWS { EPI_ROWDEF float s = 0.f; const float r = r2[rit];
#pragma unroll
            for (int bj = 0; bj < 2; ++bj) { const size_t off = (size_t)row * DM + u.pn * BM + bj * HALF + wc * 32 + 8 * fq;
                const u32x4 pp = *(const u32x4*)(PP + off);
                f32x4 h0 = *(const f32x4*)(H + off), h1 = *(const f32x4*)(H + off + 4);
                const f32x4 a0 = acc[ai][bj][m][0] * r, a1 = acc[ai][bj][m][1] * r;
                h0[0] += sigmoidf_(a0[0]) * bflo(pp.x); h0[1] += sigmoidf_(a0[1]) * bfhi(pp.x); h0[2] += sigmoidf_(a0[2]) * bflo(pp.y); h0[3] += sigmoidf_(a0[3]) * bfhi(pp.y);
                h1[0] += sigmoidf_(a1[0]) * bflo(pp.z); h1[1] += sigmoidf_(a1[1]) * bfhi(pp.z); h1[2] += sigmoidf_(a1[2]) * bflo(pp.w); h1[3] += sigmoidf_(a1[3]) * bfhi(pp.w);
                acc[ai][bj][m][0] = h0; acc[ai][bj][m][1] = h1;
                s += (h0[0] * h0[0] + h0[1] * h0[1]) + (h0[2] * h0[2] + h0[3] * h0[3]) + (h1[0] * h1[0] + h1[1] * h1[1]) + (h1[2] * h1[2] + h1[3] * h1[3]); }
            s += swz_xor<16>(s); s = sum_xor32(s);
            if (fq == 0) P[rit * 4 + wc] = s; }
        LDS_WAIT(); __builtin_amdgcn_s_barrier(); asm volatile("" ::: "memory");
        if (tid < 256) { const float t = (P[tid * 4] + P[tid * 4 + 1]) + (P[tid * 4 + 2] + P[tid * 4 + 3]);
            __hip_atomic_store(ssq + (size_t)(u.pm * 256 + tid) * 8 + u.pn, t, __ATOMIC_RELAXED, __HIP_MEMORY_SCOPE_AGENT); }
        asm volatile("s_waitcnt vmcnt(0)" ::: "memory");
        if (wid < 4 && l_ == 0) __hip_atomic_fetch_add(cnt + 64 * u.pm, 1u, __ATOMIC_RELAXED, __HIP_MEMORY_SCOPE_AGENT);
        if (wid == 0) {
            unsigned sp = 0;
            while ((unsigned)__builtin_amdgcn_readfirstlane(__hip_atomic_load(cnt + 64 * u.pm, __ATOMIC_RELAXED, __HIP_MEMORY_SCOPE_AGENT)) < 32u) { __builtin_amdgcn_s_sleep(2); if (++sp > (1u << 22)) break; }
            __builtin_amdgcn_fence(__ATOMIC_ACQUIRE, "agent");
        }
        asm volatile("s_waitcnt vmcnt(0) lgkmcnt(0)" ::: "memory"); __builtin_amdgcn_s_barrier(); asm volatile("" ::: "memory");
        if (tid < 256) { const float* sp = ssq + (size_t)(u.pm * 256 + tid) * 8; float t = 0.f;
#pragma unroll
            for (int i = 0; i < 8; ++i) t += __hip_atomic_load(sp + i, __ATOMIC_RELAXED, __HIP_MEMORY_SCOPE_AGENT);
            Rn[tid] = rsqrtf(t * (1.f / DM) + EPS); }
        LDS_WAIT(); __builtin_amdgcn_s_barrier(); asm volatile("" ::: "memory");
        EPI_FOR_ROWS { EPI_ROWDEF const float rn = Rn[rit];
#pragma unroll
            for (int bj = 0; bj < 2; ++bj) { const int col = u.pn * BM + bj * HALF + wc * 32 + 8 * fq; const size_t off = (size_t)row * DM + col;
                *(f32x4*)(H + off) = acc[ai][bj][m][0] * rn * *(const f32x4*)(nf + col); *(f32x4*)(H + off + 4) = acc[ai][bj][m][1] * rn * *(const f32x4*)(nf + col + 4); } }
    }
};
}

namespace att {
constexpr int D = 128, NW = 8, QBLK = 32, KVBLK = 64;
constexpr float SCALE = 0.088388347648318440f;
constexpr float THR = 8.f;
constexpr int LDQ = DATT, LDK = DKV;
constexpr size_t SHM_V = KVBLK * D * 2, SHM_K = KVBLK * D * 2, SHM_ATTN = 2 * SHM_V + 2 * SHM_K + NW * 64 * 4;
#define KSWZ(row, colB) ((row) * 256 + ((colB) ^ (((row) & 7) << 4)))
#define SBAR() __builtin_amdgcn_sched_barrier(0)
__device__ __forceinline__ int crow(int r, int hi) { return (r & 3) + 8 * (r >> 2) + 4 * hi; }
__device__ __forceinline__ void partialSM(f32x16& p0, f32x16& p1, float& m_reg, float& mn, float& alpha) {
  constexpr float C = SCALE * 1.4426950408889634f;
  float pmax = p0[0]; for (int r = 1; r < 16; ++r) pmax = fmaxf(pmax, p0[r]); for (int r = 0; r < 16; ++r) pmax = fmaxf(pmax, p1[r]);
  { auto rr = __builtin_amdgcn_permlane32_swap(__float_as_uint(pmax), __float_as_uint(pmax), false, false);
    pmax = fmaxf(__uint_as_float(rr[0]), __uint_as_float(rr[1])); }
  if (__builtin_expect(__all(pmax - m_reg <= THR / SCALE), 1)) { mn = m_reg; alpha = 1.f; }
  else { mn = fmaxf(m_reg, pmax); alpha = __builtin_amdgcn_exp2f((m_reg - mn) * C); m_reg = mn; }
  float mnC = -mn * C;
  for (int r = 0; r < 16; ++r) p0[r] = fmaf(p0[r], C, mnC); for (int r = 0; r < 16; ++r) p1[r] = fmaf(p1[r], C, mnC);
  for (int r = 0; r < 16; ++r) p0[r] = __builtin_amdgcn_exp2f(p0[r]);
}
__device__ __forceinline__ void finishSM(f32x16& p0, f32x16& p1, float alpha, float& l_reg, bf16x8& pa0, bf16x8& pa1, bf16x8& pa2, bf16x8& pa3) {
  for (int r = 0; r < 16; ++r) p1[r] = __builtin_amdgcn_exp2f(p1[r]);
  float ps = 0; for (int r = 0; r < 16; ++r) ps += p0[r]; for (int r = 0; r < 16; ++r) ps += p1[r];
  { auto rr = __builtin_amdgcn_permlane32_swap(__float_as_uint(ps), __float_as_uint(ps), false, false);
    ps = __uint_as_float(rr[0]) + __uint_as_float(rr[1]); }
  l_reg = l_reg * alpha + ps;
#define PK4(P, BASE, OUT) do { unsigned a0 = cvt_pk_bf16(P[BASE + 0], P[BASE + 1]), a1 = cvt_pk_bf16(P[BASE + 2], P[BASE + 3]);   \
    unsigned b0 = cvt_pk_bf16(P[BASE + 4], P[BASE + 5]), b1 = cvt_pk_bf16(P[BASE + 6], P[BASE + 7]);                              \
    auto r0 = __builtin_amdgcn_permlane32_swap(a0, b0, false, false); auto r1 = __builtin_amdgcn_permlane32_swap(a1, b1, false, false); \
    u32x4 w = {r0[0], r1[0], r0[1], r1[1]}; OUT = *reinterpret_cast<bf16x8*>(&w); } while (0)
  PK4(p0, 0, pa0); PK4(p0, 8, pa1); PK4(p1, 0, pa2); PK4(p1, 8, pa3);
#undef PK4
}
__device__ __forceinline__ void qkt(f32x16& p0, f32x16& p1, const bf16_t* Ks, const bf16x8* qr, int r32, int hi) {
  p0 = f32x16{}; p1 = f32x16{};
  for (int d0 = 0; d0 < 8; ++d0) { int cb = (d0 * 16 + hi * 8) * 2;
    bf16x8 b0 = *reinterpret_cast<const bf16x8*>((const char*)Ks + KSWZ(r32, cb));
    bf16x8 b1 = *reinterpret_cast<const bf16x8*>((const char*)Ks + KSWZ(32 + r32, cb));
    p0 = __builtin_amdgcn_mfma_f32_32x32x16_bf16(b0, qr[d0], p0, 0, 0, 0);
    p1 = __builtin_amdgcn_mfma_f32_32x32x16_bf16(b1, qr[d0], p1, 0, 0, 0); }
}
__device__ __forceinline__ int v_st(int k, int c) { const int kk = (k & ~0xC) | ((k & 4) << 1) | ((k & 8) >> 1); return ((kk >> 3) * 4 + (c >> 5)) * 512 + ((kk & 7) * 32 + (c & 31)) * 2; }
__device__ __forceinline__ int v_rd_base(int lane) { return ((lane & 3) << 3) | (((lane >> 2) & 3) << 6) | (((lane >> 4) & 1) << 5) | (((lane >> 5) & 1) << 8); }
constexpr int v_rd_off(int d0, int ks, int half) { return d0 * 512 + ks * 4096 + half * 2048; }
template <int OFF> __device__ __forceinline__ s16x4 tr_read(int vb) {
  s16x4 r; asm volatile("ds_read_b64_tr_b16 %0, %1 offset:%2" : "=&v"(r) : "v"(vb), "i"(OFF) : "memory"); return r;
}
template <int D0> __device__ __forceinline__ void pv_one(f32x16& od, int vb, bf16x8 pa0, bf16x8 pa1, bf16x8 pa2, bf16x8 pa3) {
  const s16x4 l0 = tr_read<v_rd_off(D0, 0, 0)>(vb), h0 = tr_read<v_rd_off(D0, 0, 1)>(vb), l1 = tr_read<v_rd_off(D0, 1, 0)>(vb), h1 = tr_read<v_rd_off(D0, 1, 1)>(vb);
  const s16x4 l2 = tr_read<v_rd_off(D0, 2, 0)>(vb), h2 = tr_read<v_rd_off(D0, 2, 1)>(vb), l3 = tr_read<v_rd_off(D0, 3, 0)>(vb), h3 = tr_read<v_rd_off(D0, 3, 1)>(vb);
  asm volatile("s_waitcnt lgkmcnt(0)" ::: "memory"); SBAR();
#define PK(L, H) (bf16x8){L[0], L[1], L[2], L[3], H[0], H[1], H[2], H[3]}
  od = __builtin_amdgcn_mfma_f32_32x32x16_bf16(pa0, PK(l0, h0), od, 0, 0, 0);
  od = __builtin_amdgcn_mfma_f32_32x32x16_bf16(pa1, PK(l1, h1), od, 0, 0, 0);
  od = __builtin_amdgcn_mfma_f32_32x32x16_bf16(pa2, PK(l2, h2), od, 0, 0, 0);
  od = __builtin_amdgcn_mfma_f32_32x32x16_bf16(pa3, PK(l3, h3), od, 0, 0, 0);
#undef PK
}
__device__ __forceinline__ void pv_d0(f32x16* o, int vb, bf16x8 pa0, bf16x8 pa1, bf16x8 pa2, bf16x8 pa3) {
  pv_one<0>(o[0], vb, pa0, pa1, pa2, pa3); pv_one<1>(o[1], vb, pa0, pa1, pa2, pa3); pv_one<2>(o[2], vb, pa0, pa1, pa2, pa3); pv_one<3>(o[3], vb, pa0, pa1, pa2, pa3);
}
__device__ __forceinline__ void attn_dense_body(const bf16_t* __restrict__ Qb, const bf16_t* __restrict__ Kh, const bf16_t* __restrict__ Vh,
                                                const bf16_t* __restrict__ Gb, bf16_t* __restrict__ Yb, int seq, char* lds, const int wid) {
  const int lane = lane_id_opaque(), tid = wid * 64 + lane, r32 = lane & 31, hi = lane >> 5;
  bf16_t* V_lds = (bf16_t*)lds; bf16_t* K_lds = (bf16_t*)(lds + 2 * SHM_V);
  float* ws = (float*)(lds + 2 * SHM_V + 2 * SHM_K) + wid * 64; float* li_l = ws; float* al_l = ws + 32;
  float m_reg = -1e30f, l_reg = 0; f32x16 o[4] = {}; bf16x8 qr[8];
  const bf16_t* Qw = Qb + (long)(wid * QBLK + r32) * LDQ + hi * 8;
#pragma unroll
  for (int d0 = 0; d0 < 8; ++d0) qr[d0] = *reinterpret_cast<const bf16x8*>(Qw + d0 * 16);
  const int sr = tid >> 4, sc = (tid & 15) * 8, vst0 = v_st(sr, sc), vst1 = v_st(32 + sr, sc);
  const int vb0 = (int)(uintptr_t)V_lds + v_rd_base(lane);
  struct { bf16x8 vs0, vs1, ks0, ks1; } sr_[2];
#define SLOAD(i, k0) do { sr_[i].vs0 = *reinterpret_cast<const bf16x8*>(&Vh[(long)((k0) + sr) * LDK + sc]); sr_[i].vs1 = *reinterpret_cast<const bf16x8*>(&Vh[(long)((k0) + 32 + sr) * LDK + sc]); \
    sr_[i].ks0 = *reinterpret_cast<const bf16x8*>(&Kh[(long)((k0) + sr) * LDK + sc]); sr_[i].ks1 = *reinterpret_cast<const bf16x8*>(&Kh[(long)((k0) + 32 + sr) * LDK + sc]); } while (0)
#define SWRITE(b, i) do { *(bf16x8*)((char*)V_lds + (b) * SHM_V + vst0) = sr_[i].vs0;          \
    *(bf16x8*)((char*)V_lds + (b) * SHM_V + vst1) = sr_[i].vs1; int kc = sc * 2;               \
    *(bf16x8*)((char*)K_lds + (b) * SHM_K + KSWZ(sr, kc)) = sr_[i].ks0;                       \
    *(bf16x8*)((char*)K_lds + (b) * SHM_K + KSWZ(32 + sr, kc)) = sr_[i].ks1; } while (0)
#define SWAIT() asm volatile("s_waitcnt vmcnt(4)" ::: "memory")
#define RESC(a) do { if (__any((a) < 1.f)) { if (hi == 0) al_l[r32] = (a); asm volatile("s_waitcnt lgkmcnt(0)" ::: "memory"); \
    for (int d = 0; d < 4; ++d) for (int r = 0; r < 16; ++r) o[d][r] *= al_l[crow(r, hi)]; } } while (0)
  f32x16 pA0, pA1, pB0, pB1; float mnA, mnB, alA, alB; bf16x8 pa0, pa1, pa2, pa3; const int NT = seq / KVBLK;
  constexpr int SE = 0, SO = 1;
  SLOAD(SE, 0); asm volatile("s_waitcnt vmcnt(0)" ::: "memory"); SWRITE(0, SE); __syncthreads();
  qkt(pA0, pA1, K_lds, qr, r32, hi); partialSM(pA0, pA1, m_reg, mnA, alA);
  SLOAD(SO, KVBLK); if (2 < NT) SLOAD(SE, 2 * KVBLK);
  SWAIT(); SWRITE(1, SO); __syncthreads();
  for (int j = 1; j + 1 < NT; j += 2) {
    SBAR(); qkt(pB0, pB1, (bf16_t*)((char*)K_lds + SHM_K), qr, r32, hi);
    finishSM(pA0, pA1, alA, l_reg, pa0, pa1, pa2, pa3); SBAR();
    SLOAD(SO, (j + 2) * KVBLK); SBAR();
    pv_d0(o, vb0, pa0, pa1, pa2, pa3); partialSM(pB0, pB1, m_reg, mnB, alB);
    __syncthreads(); SWAIT(); SWRITE(0, SE);
    RESC(alB); __syncthreads();
    SBAR(); qkt(pA0, pA1, K_lds, qr, r32, hi);
    finishSM(pB0, pB1, alB, l_reg, pa0, pa1, pa2, pa3); SBAR();
    if (j + 3 < NT) SLOAD(SE, (j + 3) * KVBLK); SBAR();
    pv_d0(o, vb0 + (int)SHM_V, pa0, pa1, pa2, pa3); partialSM(pA0, pA1, m_reg, mnA, alA);
    __syncthreads(); SWAIT(); SWRITE(1, SO);
    RESC(alA); __syncthreads();
  }
  SBAR(); qkt(pB0, pB1, (bf16_t*)((char*)K_lds + SHM_K), qr, r32, hi);
  finishSM(pA0, pA1, alA, l_reg, pa0, pa1, pa2, pa3); SBAR();
  pv_d0(o, vb0, pa0, pa1, pa2, pa3); partialSM(pB0, pB1, m_reg, mnB, alB);
  __syncthreads(); RESC(alB);
  finishSM(pB0, pB1, alB, l_reg, pa0, pa1, pa2, pa3); SBAR();
  pv_d0(o, vb0 + (int)SHM_V, pa0, pa1, pa2, pa3);
  if (hi == 0) li_l[r32] = l_reg; asm volatile("s_waitcnt lgkmcnt(0)" ::: "memory");
  float rli[16];
#pragma unroll
  for (int r = 0; r < 16; ++r) rli[r] = __builtin_amdgcn_rcpf(li_l[crow(r, hi)]);
  bf16_t* Yw = Yb + (long)(wid * QBLK) * DM; const bf16_t* Gw = Gb + (long)(wid * QBLK) * DATT;
  __syncthreads();
  bf16_t* stg = (bf16_t*)(lds + wid * 8192);
#pragma unroll
  for (int r = 0; r < 16; ++r) { const int orow = crow(r, hi);
#pragma unroll
    for (int d0 = 0; d0 < 4; ++d0) stg[orow * 128 + d0 * 32 + r32] = (bf16_t)f2bf(o[d0][r] * rli[r]); }
  asm volatile("s_waitcnt lgkmcnt(0)" ::: "memory");
  const int l2 = lane_id_opaque();
#pragma unroll
  for (int i = 0; i < 8; ++i) { const int q = l2 + 64 * i, row = q >> 4, c8 = (q & 15) * 8;
    const u32x4 v = *(const u32x4*)(stg + row * 128 + c8); const u32x4 gg = *(const u32x4*)(Gw + (unsigned)(row * DATT + c8));
    u32x4 w; w.x = pk2(bflo(v.x) * bflo(gg.x), bfhi(v.x) * bfhi(gg.x)); w.y = pk2(bflo(v.y) * bflo(gg.y), bfhi(v.y) * bfhi(gg.y));
    w.z = pk2(bflo(v.z) * bflo(gg.z), bfhi(v.z) * bfhi(gg.z)); w.w = pk2(bflo(v.w) * bflo(gg.w), bfhi(v.w) * bfhi(gg.w));
    *(u32x4*)(Yw + (unsigned)(row * DM + c8)) = w; }
  __syncthreads();
#undef SLOAD
#undef SWRITE
#undef SWAIT
#undef RESC
}
#undef SBAR
}

__device__ __forceinline__ void p0_transpose_item(const float* W, int K, int N, bf16_t* WT, int wt_row0, const float* kscale, LAS float* scr, int k0, int n0, int lane) {
#pragma unroll
    for (int i = 0; i < 32; ++i) { const int kk = 2 * i + (lane >> 5); float v = W[(size_t)(k0 + kk) * N + n0 + (lane & 31)]; if (kscale) v *= kscale[k0 + kk]; scr[kk * 33 + (lane & 31)] = v; }
    LDS_WAIT(); asm volatile("" ::: "memory");
    const int c = lane & 7;
#pragma unroll
    for (int j = 0; j < 4; ++j) { const int n = (lane >> 3) + 8 * j; const LAS float* s = scr + (8 * c) * 33 + n;
        u32x4 o; o.x = pk2(s[0 * 33], s[1 * 33]); o.y = pk2(s[2 * 33], s[3 * 33]); o.z = pk2(s[4 * 33], s[5 * 33]); o.w = pk2(s[6 * 33], s[7 * 33]);
        *(u32x4*)(WT + (size_t)(wt_row0 + n) * K + k0 + 8 * c) = o; }
    LDS_WAIT(); asm volatile("" ::: "memory");
}

__device__ __forceinline__ void ssm_tables(const Args& a, int g, LAS unsigned char* lds, int tid) {
    LAS float* LD = (LAS float*)lds;
    LAS float* LBs = LD + 256;
    LAS float* BB = LBs + 256;
    LAS float* KT = BB + 4096;
    LAS float* CC = KT + 8192;
    float* lb16 = (float*)(a.ws + WS_LB16);
    bf16_t* WIN = (bf16_t*)(a.ws + WS_WIN) + (size_t)g * 256 * 256;
    bf16_t* WBIG = (bf16_t*)(a.ws + WS_WBIG) + (size_t)g * 256 * 512;
    for (int e = tid; e < 2048; e += 512) { const int d = e >> 10, r = e & 1023; const size_t ci_ = (size_t)(d * NG + g) * 1024 + r; CC[e * 2] = a.c_re[ci_]; CC[e * 2 + 1] = a.c_im[ci_]; }
    if (tid < 128) {
        const int d = tid >> 6, p = tid & 63; const int idx = (d * NG + g) * 64 + p;
        const float lr = fminf(a.a_re[idx], -1e-4f), li = a.a_im[idx];
        const float dt = expf(a.log_dt[d * NG + g]);
        const float er = expf(lr * dt); float sn, cs; sincosf(li * dt, &sn, &cs);
        const float br = er * cs, bi = er * sn;
        LD[tid * 2] = lr * dt; LD[tid * 2 + 1] = li * dt; LBs[tid * 2] = br; LBs[tid * 2 + 1] = bi;
        const float nr = br - 1.f, ni = bi, den = lr * lr + li * li;
        KT[tid * 2] = (nr * lr + ni * li) / den; KT[tid * 2 + 1] = (ni * lr - nr * li) / den;
        const float e16 = expf(16.f * lr * dt); float s16, c16; sincosf(16.f * li * dt, &s16, &c16);
        lb16[(g * 128 + tid) * 2] = e16 * c16; lb16[(g * 128 + tid) * 2 + 1] = e16 * s16;
    }
    __syncthreads();
    for (int e = tid; e < 2048; e += 512) {
        const int dp = e >> 4, h = e & 15, d = dp >> 6, p = dp & 63;
        const size_t bi_ = ((size_t)(d * NG + g) * 64 + p) * 16 + h;
        const float xr = a.b_re[bi_], xi = a.b_im[bi_], cr = KT[dp * 2], ci = KT[dp * 2 + 1];
        BB[e * 2] = cr * xr - ci * xi; BB[e * 2 + 1] = cr * xi + ci * xr;
    }
    __syncthreads();
    {
        const int d = tid >> 8, hp = (tid >> 4) & 15, h = tid & 15; float acc[16];
#pragma unroll
        for (int t = 0; t < 16; ++t) acc[t] = 0.f;
        const LAS float* cc = CC + ((d * 16 + hp) * 64) * 2;
        for (int p = 0; p < 64; ++p) {
            const float c_r = cc[p * 2], c_i = cc[p * 2 + 1], b_r = BB[((d * 64 + p) * 16 + h) * 2], b_i = BB[((d * 64 + p) * 16 + h) * 2 + 1];
            float wr = c_r * b_r - c_i * b_i, wi = c_r * b_i + c_i * b_r; const float l_r = LBs[(d * 64 + p) * 2], l_i = LBs[(d * 64 + p) * 2 + 1];
#pragma unroll
            for (int t = 0; t < 16; ++t) { acc[t] += wr; const float nr = wr * l_r - wi * l_i; wi = wr * l_i + wi * l_r; wr = nr; }
        }
#pragma unroll
        for (int t = 0; t < 16; ++t) KT[((d * 16 + t) * 16 + hp) * 16 + h] = acc[t];
    }
    __syncthreads();
    for (int q = tid; q < 8192; q += 512) {
        const int n = q >> 5, kc = q & 31, s = kc >> 1, h0 = (kc & 1) * 8, j = n >> 4, hp = n & 15;
        float v[8];
#pragma unroll
        for (int e = 0; e < 8; ++e) { const int h = h0 + e;
            if (s < j) v[e] = KT[((0 * 16 + (j - s)) * 16 + hp) * 16 + h];
            else if (s > j) v[e] = KT[((1 * 16 + (s - j)) * 16 + hp) * 16 + h];
            else v[e] = KT[((0 * 16 + 0) * 16 + hp) * 16 + h] + KT[((1 * 16 + 0) * 16 + hp) * 16 + h] + (h == hp ? a.ssm_d[g * 16 + h] : 0.f); }
        u32x4 w; w.x = pk2(v[0], v[1]); w.y = pk2(v[2], v[3]); w.z = pk2(v[4], v[5]); w.w = pk2(v[6], v[7]);
        *(u32x4*)(WBIG + (size_t)n * 512 + s * 16 + h0) = w;
    }
    for (int q = tid; q < 2048; q += 512) {
        const int p = q & 63, js = (q >> 6) & 15, d = q >> 10; const float ldr = LD[(d * 64 + p) * 2], ldi = LD[(d * 64 + p) * 2 + 1];
        {   const float pw = (float)(d == 0 ? js + 1 : 16 - js); const float er = expf(pw * ldr); float sn, cs; sincosf(pw * ldi, &sn, &cs); const float pr = er * cs, pi = er * sn;
#pragma unroll
            for (int hp = 0; hp < 16; ++hp) { const float c_r = CC[((d * 16 + hp) * 64 + p) * 2], c_i = CC[((d * 16 + hp) * 64 + p) * 2 + 1];
                *(unsigned*)(WBIG + (size_t)(js * 16 + hp) * 512 + 256 + d * 128 + 2 * p) = pk2(c_r * pr - c_i * pi, -(c_r * pi + c_i * pr)); } }
        {   const float pw = (float)(d == 0 ? 15 - js : js); const float er = expf(pw * ldr); float sn, cs; sincosf(pw * ldi, &sn, &cs); const float pr = er * cs, pi = er * sn;
            float zr[16], zi[16];
#pragma unroll
            for (int h = 0; h < 16; ++h) { const float b_r = BB[((d * 64 + p) * 16 + h) * 2], b_i = BB[((d * 64 + p) * 16 + h) * 2 + 1]; zr[h] = pr * b_r - pi * b_i; zi[h] = pr * b_i + pi * b_r; }
            bf16_t* d0 = WIN + (size_t)(d * 128 + p) * 256 + js * 16; bf16_t* d1 = d0 + (size_t)64 * 256;
            u32x4 w; w.x = pk2(zr[0], zr[1]); w.y = pk2(zr[2], zr[3]); w.z = pk2(zr[4], zr[5]); w.w = pk2(zr[6], zr[7]); *(u32x4*)d0 = w;
            w.x = pk2(zr[8], zr[9]); w.y = pk2(zr[10], zr[11]); w.z = pk2(zr[12], zr[13]); w.w = pk2(zr[14], zr[15]); *(u32x4*)(d0 + 8) = w;
            w.x = pk2(zi[0], zi[1]); w.y = pk2(zi[2], zi[3]); w.z = pk2(zi[4], zi[5]); w.w = pk2(zi[6], zi[7]); *(u32x4*)d1 = w;
            w.x = pk2(zi[8], zi[9]); w.y = pk2(zi[10], zi[11]); w.z = pk2(zi[12], zi[13]); w.w = pk2(zi[14], zi[15]); *(u32x4*)(d1 + 8) = w; }
    }
    __syncthreads();
}

#define XB_TMO      128
#define XB_XCNT(j)  (256  + 64 * (j))
#define XB_XSUB(j)  (1280 + 64 * (j))
#define XB_XGEN(j)  (2304 + 64 * (j))
#define XB_TOP      3328
#define XB_TOPGEN   3392
#define XCD_BAR_WORDS 3456
#define XB_SPIN_CAP (1u << 18)
__device__ __forceinline__ unsigned xb_ld(unsigned* p)              { return __hip_atomic_load(p, __ATOMIC_RELAXED, __HIP_MEMORY_SCOPE_AGENT); }
__device__ __forceinline__ unsigned xb_add(unsigned* p, unsigned v) { return __hip_atomic_fetch_add(p, v, __ATOMIC_RELAXED, __HIP_MEMORY_SCOPE_AGENT); }
__device__ __forceinline__ unsigned xb_xcc_id() { return (unsigned)__builtin_amdgcn_s_getreg((3 << 11) | 20) & 0xFu; }
#define XB_SPIN(cond, bar) do { unsigned _sp = 0; while (cond) { __builtin_amdgcn_s_sleep(1); \
    if ((++_sp & 255u) == 0u) { if (xb_ld(&(bar)[XB_TMO])) break; if (_sp > XB_SPIN_CAP) { atomicAdd(&(bar)[XB_TMO], 1u); break; } } } } while (0)
struct XcdBarrier { unsigned* bar; unsigned x; volatile LAS unsigned* st; };
__device__ __forceinline__ XcdBarrier xcd_barrier_post(unsigned* bar, volatile LAS unsigned* st, bool leader) {
    XcdBarrier b; b.bar = bar; b.x = xb_xcc_id(); b.st = st;
    if (leader) (void)xb_add(&bar[XB_XCNT(b.x)], 1u);
    return b;
}
__device__ __forceinline__ void xcd_barrier_complete(unsigned* bar, unsigned x, unsigned& nloc, unsigned& nx) {
    const unsigned G = gridDim.x * gridDim.y * gridDim.z;
    unsigned sum, cnt, mine, sp = 0u;
    for (;;) {
        sum = 0u; cnt = 0u; mine = 0u;
#pragma unroll
        for (unsigned j = 0; j < 16; ++j) { const unsigned c = xb_ld(&bar[XB_XCNT(j)]); sum += c; cnt += (c > 0u) ? 1u : 0u; mine = (j == x) ? c : mine; }
        if (sum == G) break;
        __builtin_amdgcn_s_sleep(1);
        if ((++sp & 255u) == 0u) { if (xb_ld(&bar[XB_TMO])) break; if (sp > XB_SPIN_CAP) { atomicAdd(&bar[XB_TMO], 1u); break; } }
    }
    nloc = mine > 0u ? mine : 1u; nx = cnt > 0u ? cnt : 1u;
}
__device__ __forceinline__ void xcd_barrier(const XcdBarrier& b, bool leader) {
    asm volatile("s_waitcnt vmcnt(0)" ::: "memory");
    __syncthreads();
    if (leader) {
        unsigned* bar = b.bar;
        __builtin_amdgcn_s_waitcnt(0);
        unsigned nloc = b.st[0], nx = b.st[1];
        if (nloc == 0u) { xcd_barrier_complete(bar, b.x, nloc, nx); b.st[0] = nloc; b.st[1] = nx; }
        const unsigned old = xb_add(&bar[XB_XSUB(b.x)], 1u);
        const unsigned gen = old / nloc;
        if (old + 1u == (gen + 1u) * nloc) {
            __builtin_amdgcn_fence(__ATOMIC_RELEASE, "agent");
            asm volatile("s_waitcnt vmcnt(0)" ::: "memory");
            const unsigned og = xb_add(&bar[XB_TOP], 1u);
            const unsigned tg = og / nx;
            if (og + 1u == (tg + 1u) * nx) xb_add(&bar[XB_TOPGEN], 1u);
            else XB_SPIN(xb_ld(&bar[XB_TOPGEN]) == tg, bar);
            __builtin_amdgcn_fence(__ATOMIC_ACQUIRE, "agent");
            xb_add(&bar[XB_XGEN(b.x)], 1u);
            asm volatile("s_waitcnt vmcnt(0)" ::: "memory");
        } else {
            XB_SPIN(xb_ld(&bar[XB_XGEN(b.x)]) == gen, bar);
            __builtin_amdgcn_fence(__ATOMIC_ACQUIRE, "agent");
            asm volatile("s_waitcnt vmcnt(0)" ::: "memory");
        }
    }
    __syncthreads();
}

__global__ void __launch_bounds__(512, 2) fwd_kernel(Args a) {
    extern __shared__ __attribute__((aligned(16))) unsigned char lds_raw[];
    LAS unsigned char* lds = (LAS unsigned char*)lds_raw;
    cg::grid_group grid = cg::this_grid();
    const int wave = __builtin_amdgcn_readfirstlane(threadIdx.x >> 6);
    const bool leader = (wave == 0) && (lane_id_opaque() == 0);
    volatile LAS unsigned* xst = (volatile LAS unsigned*)(lds + XBST_OFF);
    if (leader) { xst[0] = 0u; xst[1] = 0u; }
    __syncthreads();
    if (a.ws == nullptr) grid.sync();
    const XcdBarrier xbar = xcd_barrier_post((unsigned*)(a.ws + WS_BAR), xst, leader);
#define GRID_SYNC() xcd_barrier(xbar, (wave == 0) && (lane_id_opaque() == 0))
#define LANE_IDS const int lane = lane_id_opaque(), tid = wave * 64 + lane; (void)tid;
    const int G = gridDim.x, bid = blockIdx.x;
    unsigned char* ws = a.ws;
    bf16_t* W1T = (bf16_t*)(ws + WS_W1T); bf16_t* WGLUT = (bf16_t*)(ws + WS_WGLUT); bf16_t* WOT = (bf16_t*)(ws + WS_WOT); bf16_t* WGT = (bf16_t*)(ws + WS_WGT); bf16_t* WPT = (bf16_t*)(ws + WS_WPT);
    float2* ROPE = (float2*)(ws + WS_ROPE); float* RINV = (float*)(ws + WS_RINV); float* LB16 = (float*)(ws + WS_LB16); float* SSQ1 = (float*)(ws + WS_SSQ1); float* SSQ2 = (float*)(ws + WS_SSQ2);
    bf16_t* PB = (bf16_t*)(ws + WS_PB); bf16_t* WIN = (bf16_t*)(ws + WS_WIN); bf16_t* WBIG = (bf16_t*)(ws + WS_WBIG);
    bf16_t* XB = (bf16_t*)(ws + WS_XB); bf16_t* HB = (bf16_t*)(ws + WS_XB);
    bf16_t* Q = (bf16_t*)(ws + WS_Q); bf16_t* KB = (bf16_t*)(ws + WS_K); bf16_t* VB = (bf16_t*)(ws + WS_V); bf16_t* GA = (bf16_t*)(ws + WS_GA); bf16_t* GS = (bf16_t*)(ws + WS_GS);
    bf16_t* UCAT = (bf16_t*)(ws + WS_UCAT); bf16_t* PPB = (bf16_t*)(ws + WS_UCAT); bf16_t* YMIX = (bf16_t*)(ws + WS_YMIX); bf16_t* YS = (bf16_t*)(ws + WS_YS);

#pragma unroll
    for (int rep_ = 0; rep_ < 1 + ((REP_MASK >> 0) & 1); ++rep_) { LANE_IDS
        const int gw = bid * 8 + wave, NGW = G * 8;
        LAS float* scr = (LAS float*)(lds + wave * 16384);
        constexpr int I1 = 32 * 144, I2 = 16 * 64, I3 = 32 * 64, I4 = 32 * 64, I5 = 4 * 64;
#pragma unroll
        for (int rq_ = 0; rq_ < 1 + ((REP_MASK >> 8) & 1); ++rq_)
        for (int it = gw; it < I1 + I2 + I3 + I4 + I5; it += NGW) {
            int r = it;
            if (r < I1) { const int kb = r / 144, lgg = r % 144, pn = lgg >> 3, lg = lgg & 7, wtg = pn * 8 + 4 * (lg & 1) + 2 * (lg >> 2) + ((lg >> 1) & 1);
                p0_transpose_item(a.w_in, DM, DIN, W1T, wtg * 32, a.norm_mix, scr, kb * 64, lgg * 32, lane); continue; } r -= I1;
            if (r < I2) { const int kb = r / 64, lgg = r % 64, l2 = lgg & 31, wtg = (l2 >> 2) * 8 + 4 * (lgg >> 5) + (l2 & 3);
                p0_transpose_item(a.w_glu, DSSM, 2 * DSSM, WGLUT, wtg * 32, nullptr, scr, kb * 64, lgg * 32, lane); continue; } r -= I2;
            if (r < I3) { const int kb = r / 64, lgg = r % 64; p0_transpose_item(a.w_out, DM, DM, WOT, lgg * 32, nullptr, scr, kb * 64, lgg * 32, lane); continue; } r -= I3;
            if (r < I4) { const int kb = r / 64, lgg = r % 64; p0_transpose_item(a.w_ple_gate, DM, DM, WGT, lgg * 32, a.norm_ple, scr, kb * 64, lgg * 32, lane); continue; } r -= I4;
            { const int kb = r / 64, lgg = r % 64; p0_transpose_item(a.w_ple_proj, PLE, DM, WPT, lgg * 32, nullptr, scr, kb * 64, lgg * 32, lane); }
        }
#pragma unroll
        for (int rq_ = 0; rq_ < 1 + ((REP_MASK >> 9) & 1); ++rq_)
        for (int m = gw; m < T; m += NGW) {
            const f32x4* xr = (const f32x4*)(a.x + (size_t)m * DM) + lane; f32x4 v[8]; float s = 0.f;
#pragma unroll
            for (int j = 0; j < 8; ++j) { v[j] = xr[64 * j]; s += (v[j][0] * v[j][0] + v[j][1] * v[j][1]) + (v[j][2] * v[j][2] + v[j][3] * v[j][3]); }
            s = wave_sum(s);
            if (lane == 0) RINV[m] = rsqrtf(s * (1.f / DM) + EPS);
            u32x2* o = (u32x2*)(XB + (size_t)m * DM) + lane;
#pragma unroll
            for (int j = 0; j < 8; ++j) { u32x2 w; w.x = pk2(v[j][0], v[j][1]); w.y = pk2(v[j][2], v[j][3]); o[64 * j] = w; }
        }
        for (int i = bid * 512 + tid; i < T * PLE / 4; i += G * 512) { const f32x4 v = ((const f32x4*)a.p)[i]; u32x2 w; w.x = pk2(v[0], v[1]); w.y = pk2(v[2], v[3]); ((u32x2*)PB)[i] = w; }
        for (int i = bid * 512 + tid; i < 2048; i += G * 512) { const int pos = i >> 5, f = i & 31; const float inv = powf(10000.f, -(float)f / 32.f); float sn, cs; sincosf((float)pos * inv, &sn, &cs); ROPE[i] = make_float2(cs, sn); }
    GRID_SYNC(); }


    if constexpr ((REP_MASK >> 10) & 1) { GRID_SYNC(); GRID_SYNC(); GRID_SYNC(); GRID_SYNC(); }
#pragma unroll
    for (int rep_ = 0; rep_ < 1 + ((REP_MASK >> 1) & 1); ++rep_) { LANE_IDS
        { pg8::Gemm g{XB, W1T, DM, DM, DM, 0, 0}; pg8::StaticOrder S; S.init(T, 14 * 256, G, bid);
          pg8::Epi1 E{RINV, a.q_norm, a.k_norm, ROPE, Q, KB, VB, GA, GS, UCAT, (LAS float*)(lds + XCH_OFF), 0};
          pg8::gemm_phase<pg8::Epi1, pg8::StaticOrder, true>(lds, g, S, E, wave); }
        __syncthreads();
        for (int gi = bid - (G - NG); gi >= 0 && gi < NG; gi += NG) ssm_tables(a, gi, lds, tid);
    GRID_SYNC(); }

#pragma unroll
    for (int rep_ = 0; rep_ < 1 + ((REP_MASK >> 2) & 1); ++rep_) {
#pragma unroll
        for (int rq_ = 0; rq_ < 1 + ((REP_MASK >> 6) & 1); ++rq_) {
        if (bid < 2 * NG) {
            pg8::BatchOrder S{2 * NG, G, bid};
            { pg8::Gemm g{UCAT, WIN, 256, 512, 256, (size_t)NCH * 512 * 2, (size_t)256 * 256 * 2};
              pg8::EpiS1 E{LB16, UCAT}; pg8::gemm_phase<pg8::EpiS1, pg8::BatchOrder, false>(lds, g, S, E, wave); }
            __threadfence(); __syncthreads();
            { pg8::Gemm g{UCAT, WBIG, 512, 512, 512, (size_t)NCH * 512 * 2, (size_t)256 * 512 * 2};
              pg8::EpiS2 E{YS}; pg8::gemm_phase<pg8::EpiS2, pg8::BatchOrder, false>(lds, g, S, E, wave); }
        } else {
            pg8::Gemm g{XB, W1T + (size_t)14 * 256 * DM, DM, DM, DM, 0, 0}; pg8::ListOrder S{bid - 2 * NG, 128, G};
            pg8::Epi1 E{RINV, a.q_norm, a.k_norm, ROPE, Q, KB, VB, GA, GS, UCAT, (LAS float*)(lds + XCH_OFF), 14};
            pg8::gemm_phase<pg8::Epi1, pg8::ListOrder, true>(lds, g, S, E, wave);
        }
        __syncthreads(); }
#pragma unroll
        for (int rq_ = 0; rq_ < 1 + ((REP_MASK >> 7) & 1); ++rq_)
        for (int un = bid; un < 256; un += G) {
            const int x = un & 7, jj = un >> 3, b = x >> 2, kvh = (x >> 1) & 1, idx = (x & 1) * 32 + jj, h = kvh * 4 + (idx >> 4), qb = idx & 15;
            const size_t tok0 = (size_t)b * SEQ + qb * 256;
            att::attn_dense_body(Q + tok0 * DATT + h * 128, KB + (size_t)b * SEQ * DKV + kvh * 128, VB + (size_t)b * SEQ * DKV + kvh * 128,
                                 GA + tok0 * DATT + h * 128, YMIX + tok0 * DM + h * 128, SEQ, (char*)lds_raw, wave);
        }
    GRID_SYNC(); }

#pragma unroll
    for (int rep_ = 0; rep_ < 1 + ((REP_MASK >> 3) & 1); ++rep_) {
        { pg8::Gemm g{YS, WGLUT, DSSM, DSSM, DSSM, 0, 0}; pg8::StaticOrder S; S.init(T, 2 * DSSM, G, bid);
          pg8::EpiGlu E{a.b_glu, GS, YMIX}; pg8::gemm_phase<pg8::EpiGlu, pg8::StaticOrder, false>(lds, g, S, E, wave); }
        __syncthreads();
        { pg8::Gemm g{PB, WPT, PLE, PLE, PLE, 0, 0}; pg8::StaticOrder S; S.init(T, DM, G, bid);
          pg8::EpiBf E{PPB, DM}; pg8::gemm_phase<pg8::EpiBf, pg8::StaticOrder, false>(lds, g, S, E, wave); }
    GRID_SYNC(); }


#pragma unroll
    for (int rep_ = 0; rep_ < 1 + ((REP_MASK >> 4) & 1); ++rep_) {
        pg8::Gemm g{YMIX, WOT, DM, DM, DM, 0, 0}; pg8::StaticOrder S; S.init(T, DM, G, bid);
        pg8::EpiOut E{a.x, a.out, HB, SSQ1}; pg8::gemm_phase<pg8::EpiOut, pg8::StaticOrder, false>(lds, g, S, E, wave);
    GRID_SYNC(); }


    { LANE_IDS
        pg8::StaticOrder S; S.init(T, DM, G, bid); pg8::Unit u0;
        LAS float* r2 = (LAS float*)(lds + R2_OFF);
        if (S.next(0, u0) && tid < 256) { const float* sp = SSQ1 + (size_t)(u0.pm * 256 + tid) * 32; float s = 0.f;
#pragma unroll
            for (int i = 0; i < 8; ++i) { const f32x4 v = ((const f32x4*)sp)[i]; s += (v[0] + v[1]) + (v[2] + v[3]); }
            r2[tid] = rsqrtf(s * (1.f / DM) + EPS); }
        __syncthreads();
        pg8::Gemm g{HB, WGT, DM, DM, DM, 0, 0};
        pg8::EpiGate E{a.out, PPB, SSQ2, (unsigned*)ws, a.norm_final, r2}; pg8::gemm_phase<pg8::EpiGate, pg8::StaticOrder, false>(lds, g, S, E, wave);
    }
}

extern "C" void kernel_launch(void* const* d_in, const int* in_sizes, int n_in, void* d_out, int out_size, void* d_ws, size_t ws_size, hipStream_t stream) {
    static int grid = 0;
    if (grid == 0) {
        if (n_in != 21 || in_sizes[0] != T * DM || out_size != T * DM || ws_size < WS_END) { fprintf(stderr, "kernel_launch: unexpected shapes (n_in %d, in0 %d, out %d, ws %zu)\n", n_in, n_in > 0 ? in_sizes[0] : -1, out_size, ws_size); grid = -1; return; }
        int dev = 0, cus = 0, per_cu = 0;
        hipGetDevice(&dev); hipDeviceGetAttribute(&cus, hipDeviceAttributeMultiprocessorCount, dev);
        if (hipFuncSetAttribute((const void*)fwd_kernel, hipFuncAttributeMaxDynamicSharedMemorySize, LDS_BYTES) != hipSuccess) { fprintf(stderr, "kernel_launch: hipFuncSetAttribute failed\n"); grid = -1; return; }
        hipOccupancyMaxActiveBlocksPerMultiprocessor(&per_cu, (const void*)fwd_kernel, 512, LDS_BYTES);
        (void)hipGetLastError();
        if (per_cu < 1) fprintf(stderr, "kernel_launch: occupancy query reports %d blocks per CU\n", per_cu);
        grid = cus > 256 ? 256 : cus;
    }
    if (grid < 0) return;
    Args a{};
    const float** f = (const float**)&a;
    for (int i = 0; i < 21; ++i) f[i] = (const float*)d_in[i];
    a.out = (float*)d_out; a.ws = (unsigned char*)d_ws;
    if (hipMemsetAsync(d_ws, 0, WS_CTL_BYTES, stream) != hipSuccess) { fprintf(stderr, "kernel_launch: hipMemsetAsync failed\n"); return; }
    void* args[] = {&a};
    hipError_t e = hipLaunchCooperativeKernel((const void*)fwd_kernel, dim3(grid), dim3(512), args, LDS_BYTES, stream);
    if (e != hipSuccess) fprintf(stderr, "kernel_launch: cooperative launch failed: %s (grid %d)\n", hipGetErrorString(e), grid);
}
```

```cpp
#include <hip/hip_runtime.h>
#include <hip/hip_cooperative_groups.h>
#include <cstdio>
#include <cstdint>
namespace cg = cooperative_groups;

#define LAS __attribute__((address_space(3)))
typedef unsigned short bf16_t;
typedef short bf16x8 __attribute__((ext_vector_type(8)));
typedef short s16x4 __attribute__((ext_vector_type(4)));
typedef float f32x4 __attribute__((ext_vector_type(4)));
typedef float f32x16 __attribute__((ext_vector_type(16)));
typedef unsigned u32x4 __attribute__((ext_vector_type(4)));
typedef unsigned u32x2 __attribute__((ext_vector_type(2)));

constexpr int T = 8192, SEQ = 4096, DM = 2048, DIN = 4608, DATT = 1024, DKV = 256, DSSM = 1024, PLE = 256;
constexpr int NG = 64, NCH = T / 16;
constexpr float EPS = 1e-6f;
#ifndef PH_MASK
#define PH_MASK 0xff
#endif
#ifndef REP_MASK
#define REP_MASK 0
#endif

constexpr size_t MiB = 1u << 20;
constexpr size_t WS_W1T = 1 * MiB, WS_WGLUT = 19 * MiB, WS_WOT = 23 * MiB, WS_WGT = 31 * MiB, WS_WPT = 39 * MiB;
constexpr size_t WS_ROPE = 40 * MiB, WS_RINV = 40 * MiB + 65536, WS_LB16 = 40 * MiB + 131072, WS_SSQ1 = 41 * MiB, WS_SSQ2 = 42 * MiB;
constexpr size_t WS_PB = 43 * MiB, WS_WIN = 47 * MiB, WS_WBIG = 55 * MiB;
constexpr size_t WS_XB = 71 * MiB;
constexpr size_t WS_Q = 103 * MiB, WS_K = 119 * MiB, WS_V = 123 * MiB, WS_GA = 127 * MiB, WS_GS = 143 * MiB;
constexpr size_t WS_UCAT = 159 * MiB;
constexpr size_t WS_YMIX = 191 * MiB, WS_YS = 223 * MiB, WS_END = 239 * MiB;

constexpr int RING_BYTES = 131072, XCH_OFF = RING_BYTES, R2_OFF = RING_BYTES + 4096, XBST_OFF = RING_BYTES + 8192, LDS_BYTES = 147456;
constexpr size_t WS_BAR = 65536, WS_CTL_BYTES = 131072;

struct Args {
    const float *x, *p, *norm_mix, *w_in, *q_norm, *k_norm, *a_re, *a_im, *log_dt, *b_re, *b_im, *c_re, *c_im, *ssm_d, *w_glu, *b_glu, *w_out, *norm_ple, *w_ple_gate, *w_ple_proj, *norm_final;
    float* out; unsigned char* ws;
};

__device__ __forceinline__ unsigned f2bf(float f) { unsigned u = __builtin_bit_cast(unsigned, f); return (u + 0x7fffu + ((u >> 16) & 1u)) >> 16; }
__device__ __forceinline__ unsigned pk2(float lo, float hi) { return f2bf(lo) | (f2bf(hi) << 16); }
__device__ __forceinline__ float bf2f(unsigned short b) { return __builtin_bit_cast(float, (unsigned)b << 16); }
__device__ __forceinline__ float bflo(unsigned w) { return __builtin_bit_cast(float, w << 16); }
__device__ __forceinline__ float bfhi(unsigned w) { return __builtin_bit_cast(float, w & 0xffff0000u); }
__device__ __forceinline__ unsigned cvt_pk_bf16(float lo, float hi) { unsigned r; asm volatile("v_cvt_pk_bf16_f32 %0, %1, %2" : "=v"(r) : "v"(lo), "v"(hi)); return r; }
__device__ __forceinline__ float sigmoidf_(float v) { return 1.f / (1.f + __expf(-v)); }
__device__ __forceinline__ float siluf_(float v) { return v / (1.f + __expf(-v)); }
__device__ __forceinline__ float gelu_tanh(float v) { const float t = 1.5957691216057308f * (v + 0.044715f * v * v * v); return v / (1.f + __expf(-t)); }
template <int K> __device__ __forceinline__ float swz_xor(float v) { return __int_as_float(__builtin_amdgcn_ds_swizzle(__float_as_int(v), (K << 10) | 0x1f)); }
__device__ __forceinline__ float sum_xor32(float v) { auto rr = __builtin_amdgcn_permlane32_swap(__float_as_uint(v), __float_as_uint(v), false, false); return __uint_as_float(rr[0]) + __uint_as_float(rr[1]); }
__device__ __forceinline__ float wave_sum(float v) { v += swz_xor<1>(v); v += swz_xor<2>(v); v += swz_xor<4>(v); v += swz_xor<8>(v); v += swz_xor<16>(v); return sum_xor32(v); }
#define LDS_WAIT() asm volatile("s_waitcnt lgkmcnt(0)" ::: "memory")
__device__ __forceinline__ int lane_id_opaque() { int l = __builtin_amdgcn_mbcnt_hi(~0u, __builtin_amdgcn_mbcnt_lo(~0u, 0u)); asm volatile("" : "+v"(l)); return l; }

namespace pg8 {
constexpr int BM = 256, BK = 64, HALF = 128, HTB = HALF * BK * 2, NXCD = 8, WGM = 8;
__host__ __device__ __forceinline__ int lds_byte(int r, int c) { const int st = (r >> 4) * 2 + (c >> 5), rr = r & 15, cc = c & 31, ob = rr * 64 + cc * 2; return st * 1024 + (ob ^ (((ob >> 9) & 1) << 5)); }
__host__ __device__ __forceinline__ void stage_rc(int b, int& R, int& C) { const int st = b / 1024, sb = b % 1024, swz = sb ^ (((sb >> 9) & 1) << 5); R = (st >> 1) * 16 + swz / 64; C = (st & 1) * 32 + (swz % 64) / 2; }
__host__ __device__ __forceinline__ int perm32(int rho) { const int n = rho >> 4, i = rho & 15; return 8 * (i >> 2) + 4 * n + (i & 3); }

struct Unit { int pm, pn, z; };
struct Gemm { const bf16_t* A; const bf16_t* Bt; int K, lda, ldb; size_t zA, zB; };

struct StaticOrder {
    int nM, nN, nwg, G, c;
    __device__ void init(int M, int N, int G_, int c_) { nM = M / BM; nN = N / BM; nwg = nM * nN; G = G_; c = c_; }
    __device__ bool next(int i, Unit& u) const {
        const long L = (long)i * G + c; if (L >= nwg) return false;
        int wgid = (int)L; { const int q = nwg / NXCD, r = nwg % NXCD, xcd = wgid % NXCD, off = wgid / NXCD; wgid = (xcd < r ? xcd * (q + 1) : r * (q + 1) + (xcd - r) * q) + off; }
        const int nig = WGM * nN, gid = wgid / nig, fm = gid * WGM, gsz = (nM - fm) < WGM ? (nM - fm) : WGM;
        u.pm = fm + ((wgid % nig) % gsz); u.pn = (wgid % nig) / gsz; u.z = 0; return true;
    }
};
struct BatchOrder {
    int n, G, c;
    __device__ bool next(int i, Unit& u) const { const int L = i * G + c; if (L >= n) return false; u.z = L >> 1; u.pm = L & 1; u.pn = 0; return true; }
};

struct ListOrder {
    int L0, n, stride;
    __device__ bool next(int i, Unit& u) const { const int L = L0 + i * stride; if (L < 0 || L >= n) return false; u.pm = L >> 2; u.pn = L & 3; u.z = 0; return true; }
};
template <class Epi, class Sched, bool ALIGN_EPI>
__device__ __forceinline__ void gemm_phase(LAS unsigned char* lds, const Gemm g, const Sched& S, const Epi& E, const int wid) {
    const int lane = lane_id_opaque(), tid = wid * 64 + lane, wr = wid >> 2, wc = wid & 3, fr = lane & 15, fq = lane >> 4;
    const int K = g.K, nt = K / BK;
    unsigned voffA[2], voffB[2];
#pragma unroll
    for (int i = 0; i < 2; ++i) { int R, C; stage_rc(tid * 16 + i * 8192, R, C); const int Rb = (R & ~31) + perm32(R & 31);
        voffA[i] = (unsigned)(R * g.lda + C) * 2u; voffB[i] = (unsigned)(Rb * g.ldb + C) * 2u; }
    const size_t kstep = (size_t)(BK * 2);
    const size_t hstepA = (size_t)HALF * g.lda * 2, hstepB = (size_t)HALF * g.ldb * 2;
    const size_t tstepA = 2 * hstepA, tstepB = 2 * hstepB;
    const unsigned ldsw = (unsigned)wid * 1024u;
    const int aoff = lds_byte(wr * 64 + fr, fq * 8), boff = lds_byte(wc * 32 + fr, fq * 8);
#define PG8_SA(b, h) (((b) * 2 + (h)) * HTB)
#define PG8_SB(b, h) ((4 + (b) * 2 + (h)) * HTB)
#define PG8_STAGE(bufoff, gbase, voff) do { _Pragma("unroll") for (int _i = 0; _i < 2; ++_i) \
        __builtin_amdgcn_global_load_lds((const unsigned*)((const char*)(gbase) + (voff)[_i]), (LAS unsigned*)(lds + (bufoff) + ldsw + _i * 8192), 16, 0, 0); } while (0)
#define PG8_LDA(dst, b, h) do { _Pragma("unroll") for (int m = 0; m < 4; ++m) _Pragma("unroll") for (int k = 0; k < 2; ++k) dst[m][k] = *(const LAS bf16x8*)(lds + PG8_SA(b, h) + aoff + m * 2048 + k * 1024); } while (0)
#define PG8_LDB(dst, b, h) do { _Pragma("unroll") for (int n = 0; n < 2; ++n) _Pragma("unroll") for (int k = 0; k < 2; ++k) dst[n][k] = *(const LAS bf16x8*)(lds + PG8_SB(b, h) + boff + n * 2048 + k * 1024); } while (0)
#define PG8_MMA(ai, bj, At, Bt) do { __builtin_amdgcn_s_setprio(1); _Pragma("unroll") for (int m = 0; m < 4; ++m) _Pragma("unroll") for (int n = 0; n < 2; ++n) _Pragma("unroll") for (int k = 0; k < 2; ++k) \
        acc[ai][bj][m][n] = __builtin_amdgcn_mfma_f32_16x16x32_bf16(Bt[n][k], At[m][k], acc[ai][bj][m][n], 0, 0, 0); __builtin_amdgcn_s_setprio(0); } while (0)
#define PG8_WAIT_V(n) asm volatile("s_waitcnt vmcnt(" #n ")" ::: "memory")
#define PG8_WAIT_L(n) asm volatile("s_waitcnt lgkmcnt(" #n ")" ::: "memory")
#define PG8_BAR __builtin_amdgcn_s_barrier()
#define PG8_SCHED __builtin_amdgcn_sched_barrier(0)
    Unit cur, nxt; int ui = 0;
    if (!S.next(0, cur)) return;
    f32x4 acc[2][2][4][2];
#pragma unroll
    for (int a = 0; a < 2; ++a)
#pragma unroll
        for (int b = 0; b < 2; ++b)
#pragma unroll
            for (int m = 0; m < 4; ++m)
#pragma unroll
                for (int n = 0; n < 2; ++n) acc[a][b][m][n] = (f32x4){0.f, 0.f, 0.f, 0.f};
    bf16x8 At[4][2], B0[2][2], B1[2][2];
    const char* cA = (const char*)g.A + (size_t)cur.z * g.zA + (size_t)cur.pm * tstepA; const char* cB = (const char*)g.Bt + (size_t)cur.z * g.zB + (size_t)cur.pn * tstepB;
    PG8_STAGE(PG8_SB(0, 0), cB, voffB); PG8_STAGE(PG8_SB(0, 1), cB + hstepB, voffB); PG8_STAGE(PG8_SA(0, 0), cA, voffA); PG8_STAGE(PG8_SA(0, 1), cA + hstepA, voffA);
    if (wr == 1) PG8_BAR;
    PG8_WAIT_V(2); PG8_BAR;
    PG8_STAGE(PG8_SB(1, 0), cB + kstep, voffB); PG8_STAGE(PG8_SA(1, 0), cA + kstep, voffA); PG8_STAGE(PG8_SB(1, 1), cB + hstepB + kstep, voffB);
    PG8_WAIT_V(6); PG8_BAR;
    for (;;) {
        const bool has_next = S.next(ui + 1, nxt);
        const char* nA = has_next ? (const char*)g.A + (size_t)nxt.z * g.zA + (size_t)nxt.pm * tstepA : cA;
        const char* nB = has_next ? (const char*)g.Bt + (size_t)nxt.z * g.zB + (size_t)nxt.pn * tstepB : cB;
        for (int t = 0; t < nt; t += 2) {
            const bool last = (t == nt - 2);
            const char* a1 = cA + (size_t)(t + 1) * kstep;
            const char* a2 = last ? nA : cA + (size_t)(t + 2) * kstep; const char* b2 = last ? nB : cB + (size_t)(t + 2) * kstep;
            const char* a3 = a2 + kstep; const char* b3 = b2 + kstep;
            PG8_LDB(B0, 0, 0); PG8_LDB(B1, 0, 1); PG8_SCHED; PG8_LDA(At, 0, 0); PG8_STAGE(PG8_SA(1, 1), a1 + hstepA, voffA);
            PG8_WAIT_V(8); PG8_WAIT_L(0); PG8_BAR; PG8_MMA(0, 0, At, B0); PG8_MMA(0, 1, At, B1); PG8_BAR; PG8_SCHED;
            PG8_LDA(At, 0, 1); PG8_STAGE(PG8_SB(0, 0), b2, voffB); PG8_STAGE(PG8_SB(0, 1), b2 + hstepB, voffB); PG8_STAGE(PG8_SA(0, 0), a2, voffA);
            PG8_WAIT_V(8); PG8_WAIT_L(0); PG8_BAR; PG8_MMA(1, 0, At, B0); PG8_MMA(1, 1, At, B1); PG8_BAR; PG8_SCHED;
            PG8_LDB(B0, 1, 0); PG8_LDB(B1, 1, 1); PG8_SCHED; PG8_LDA(At, 1, 0); PG8_STAGE(PG8_SA(0, 1), a2 + hstepA, voffA);
            PG8_WAIT_V(8); PG8_WAIT_L(0); PG8_BAR; PG8_MMA(0, 0, At, B0); PG8_MMA(0, 1, At, B1); PG8_BAR; PG8_SCHED;
            PG8_LDA(At, 1, 1); PG8_STAGE(PG8_SB(1, 0), b3, voffB); PG8_STAGE(PG8_SB(1, 1), b3 + hstepB, voffB); PG8_STAGE(PG8_SA(1, 0), a3, voffA);
            PG8_WAIT_V(8); PG8_WAIT_L(0); PG8_BAR; PG8_MMA(1, 0, At, B0); PG8_MMA(1, 1, At, B1); PG8_BAR; PG8_SCHED;
        }
        if constexpr (ALIGN_EPI) { if (wr == 0) PG8_BAR; }
        if constexpr (!Epi::AFTER_DRAIN) E(acc, cur, wr, wc, fr, fq);
        if (!has_next) break;
#pragma unroll
        for (int a = 0; a < 2; ++a)
#pragma unroll
            for (int b = 0; b < 2; ++b)
#pragma unroll
                for (int m = 0; m < 4; ++m)
#pragma unroll
                    for (int n = 0; n < 2; ++n) acc[a][b][m][n] = (f32x4){0.f, 0.f, 0.f, 0.f};
        cur = nxt; cA = nA; cB = nB; ++ui;
        if constexpr (ALIGN_EPI) { if (wr == 1) PG8_BAR; }
    }
    PG8_WAIT_V(0);
    if constexpr (!ALIGN_EPI) { if (wr == 0) PG8_BAR; }
    PG8_BAR;
    if constexpr (Epi::AFTER_DRAIN) E.fused(acc, cur, wr, wc, lds, wid);
#undef PG8_SA
#undef PG8_SB
#undef PG8_STAGE
#undef PG8_LDA
#undef PG8_LDB
#undef PG8_MMA
#undef PG8_WAIT_V
#undef PG8_WAIT_L
#undef PG8_BAR
#undef PG8_SCHED
}

#define EPI_FOR_ROWS _Pragma("unroll") for (int ai = 0; ai < 2; ++ai) _Pragma("unroll") for (int m = 0; m < 4; ++m)
#define EPI_ROWDEF const int rit = ai * HALF + wr * 64 + m * 16 + fr; const int row = u.pm * BM + rit; (void)rit; (void)row;

struct Epi1 {
    static constexpr bool AFTER_DRAIN = false;
    const float* rinv; const float* qnw; const float* knw; const float2* rope;
    bf16_t *Q, *Kb, *Vb, *GA, *GS, *UCAT; LAS float* xch; int pn0;
    __device__ __forceinline__ void operator()(const f32x4 (&acc)[2][2][4][2], const Unit& u, int wr, int wc, int, int) const {
        const int l_ = lane_id_opaque(), fr = l_ & 15, fq = l_ >> 4;
        const int pn = u.pn + pn0;
        if (pn <= 4) {
            float ss[2][4];
            EPI_FOR_ROWS { EPI_ROWDEF const float r = rinv[row]; float s = 0.f;
#pragma unroll
                for (int bj = 0; bj < 2; ++bj)
#pragma unroll
                    for (int n = 0; n < 2; ++n) { const f32x4 v = acc[ai][bj][m][n] * r; s += (v[0] * v[0] + v[1] * v[1]) + (v[2] * v[2] + v[3] * v[3]); }
                s += swz_xor<16>(s); s = sum_xor32(s); ss[ai][m] = s;
                if (fq == 0) xch[wc * 256 + rit] = s; }
            LDS_WAIT(); __builtin_amdgcn_s_barrier(); asm volatile("" ::: "memory");
            const int half = wc & 1, hd = wc >> 1;
            const float* nw = (pn < 4 ? qnw : knw) + 64 * half + 8 * fq;
            float w1[8], w2[8];
#pragma unroll
            for (int i = 0; i < 8; ++i) { w1[i] = nw[i]; w2[i] = nw[32 + i]; }
            EPI_FOR_ROWS { EPI_ROWDEF const float tot = ss[ai][m] + xch[(wc ^ 1) * 256 + rit];
                const float sc = rinv[row] * rsqrtf(tot * (1.f / 128.f) + EPS);
                const int t = row & (SEQ - 1); const int pos = half ? (t & 63) : (t >> 6);
                const float2* rp = rope + pos * 32 + 8 * fq;
                float o1[8], o2[8];
#pragma unroll
                for (int n = 0; n < 2; ++n)
#pragma unroll
                    for (int e = 0; e < 4; ++e) { const int i = 4 * n + e; const float2 cs = rp[i];
                        const float x1 = acc[ai][0][m][n][e] * sc * w1[i], x2 = acc[ai][1][m][n][e] * sc * w2[i];
                        o1[i] = x1 * cs.x - x2 * cs.y; o2[i] = x2 * cs.x + x1 * cs.y; }
                bf16_t* dst = (pn < 4) ? Q + (size_t)row * DATT + (2 * pn + hd) * 128 + 64 * half + 8 * fq : Kb + (size_t)row * DKV + hd * 128 + 64 * half + 8 * fq;
                u32x4 a; a.x = pk2(o1[0], o1[1]); a.y = pk2(o1[2], o1[3]); a.z = pk2(o1[4], o1[5]); a.w = pk2(o1[6], o1[7]);
                u32x4 b; b.x = pk2(o2[0], o2[1]); b.y = pk2(o2[2], o2[3]); b.z = pk2(o2[4], o2[5]); b.w = pk2(o2[6], o2[7]);
                *(u32x4*)dst = a; *(u32x4*)(dst + 32) = b; }
        } else {
            const int lg0 = 4 * (wc >> 1) + 2 * (wc & 1);
            EPI_FOR_ROWS { EPI_ROWDEF const float r = rinv[row];
#pragma unroll
                for (int bj = 0; bj < 2; ++bj) { const int L = 256 * pn + 32 * (lg0 + bj) + 8 * fq;
                    f32x4 v0 = acc[ai][bj][m][0] * r, v1 = acc[ai][bj][m][1] * r; bf16_t* dst;
                    if (pn == 5) dst = Vb + (size_t)row * DKV + (L - 1280);
                    else if (pn < 10) dst = GA + (size_t)row * DATT + (L - 1536);
                    else if (pn < 14) { const int Lu = L - 2560; dst = UCAT + ((size_t)(Lu >> 4) * NCH + (row >> 4)) * 512 + (row & 15) * 16 + (Lu & 15); }
                    else dst = GS + (size_t)row * DSSM + (L - 3584);
                    if ((pn >= 6 && pn < 10) || pn >= 14) {
#pragma unroll
                        for (int e = 0; e < 4; ++e) { v0[e] = siluf_(v0[e]); v1[e] = siluf_(v1[e]); } }
                    u32x4 w; w.x = pk2(v0[0], v0[1]); w.y = pk2(v0[2], v0[3]); w.z = pk2(v1[0], v1[1]); w.w = pk2(v1[2], v1[3]);
                    *(u32x4*)dst = w; } }
        }
    }
};
struct EpiS1 {
    static constexpr bool AFTER_DRAIN = true;
    const float* lb16; bf16_t* UCAT;
    __device__ __forceinline__ void operator()(const f32x4 (&)[2][2][4][2], const Unit&, int, int, int, int) const {}
    __device__ __forceinline__ void fused(const f32x4 (&acc)[2][2][4][2], const Unit& u, int wr, int wc, LAS unsigned char* lds, int wid) const {
        const int l_ = lane_id_opaque(), fr = l_ & 15, fq = l_ >> 4;
        LAS float* Tl = (LAS float*)lds;
#pragma unroll
        for (int d = 0; d < 2; ++d) {
            EPI_FOR_ROWS { const int rit = ai * HALF + wr * 64 + m * 16 + fr; LAS float* rp = Tl + rit * 128 + wc * 32 + 8 * fq;
                *(LAS f32x4*)rp = acc[ai][d][m][0]; *(LAS f32x4*)(rp + 4) = acc[ai][d][m][1]; }
            LDS_WAIT(); __builtin_amdgcn_s_barrier(); asm volatile("" ::: "memory");
            {
                const int p = l_; const float lr = lb16[((u.z * 2 + d) * 64 + p) * 2], li = lb16[((u.z * 2 + d) * 64 + p) * 2 + 1];
                LAS float* SEG = (LAS float*)(lds + XCH_OFF);
                float xr = 0.f, xi = 0.f;
#pragma unroll 8
                for (int i = 0; i < 32; ++i) { const int cc = wid * 32 + i, c = d ? 255 - cc : cc;
                    const float sr = Tl[c * 128 + p], si = Tl[c * 128 + 64 + p];
                    Tl[c * 128 + p] = xr; Tl[c * 128 + 64 + p] = xi;
                    const float nr = lr * xr - li * xi + sr; xi = lr * xi + li * xr + si; xr = nr; }
                SEG[(wid * 64 + p) * 2] = xr; SEG[(wid * 64 + p) * 2 + 1] = xi;
                LDS_WAIT(); __builtin_amdgcn_s_barrier(); asm volatile("" ::: "memory");
                float l32r = lr, l32i = li;
#pragma unroll
                for (int q = 0; q < 5; ++q) { const float t = l32r * l32r - l32i * l32i; l32i = 2.f * l32r * l32i; l32r = t; }
                float er = 0.f, ei = 0.f;
                for (int j = 0; j < wid; ++j) { const float tr = SEG[(j * 64 + p) * 2], ti = SEG[(j * 64 + p) * 2 + 1];
                    const float nr = l32r * er - l32i * ei + tr; ei = l32r * ei + l32i * er + ti; er = nr; }
#pragma unroll 8
                for (int i = 0; i < 32; ++i) { const int cc = wid * 32 + i, c = d ? 255 - cc : cc;
                    const float tr = Tl[c * 128 + p] + er, ti = Tl[c * 128 + 64 + p] + ei;
                    Tl[c * 128 + p] = __uint_as_float(pk2(tr, ti));
                    const float nr = lr * er - li * ei; ei = lr * ei + li * er; er = nr; }
            }
            LDS_WAIT(); __builtin_amdgcn_s_barrier(); asm volatile("" ::: "memory");
            {   bf16_t* ub = UCAT + ((size_t)u.z * NCH + u.pm * 256) * 512 + 256 + d * 128;
#pragma unroll
                for (int i = 0; i < 8; ++i) { const int q = wid * 64 + l_ + 512 * i, r = q >> 4, c8 = (q & 15) * 8;
                    *(u32x4*)(ub + (size_t)r * 512 + c8) = *(const LAS u32x4*)((LAS bf16_t*)(Tl + r * 128) + c8); } }
            LDS_WAIT(); __builtin_amdgcn_s_barrier(); asm volatile("" ::: "memory");
        }
    }
};
struct EpiS2 {
    static constexpr bool AFTER_DRAIN = false;
    bf16_t* YS;
    __device__ __forceinline__ void operator()(const f32x4 (&acc)[2][2][4][2], const Unit& u, int wr, int wc, int, int) const {
        const int l_ = lane_id_opaque(), fr = l_ & 15, fq = l_ >> 4;
        EPI_FOR_ROWS { EPI_ROWDEF
#pragma unroll
            for (int bj = 0; bj < 2; ++bj) { const int c = bj * HALF + wc * 32 + 8 * fq; const int j = c >> 4, h0 = c & 15;
                const f32x4 v0 = acc[ai][bj][m][0], v1 = acc[ai][bj][m][1];
                u32x4 w; w.x = pk2(gelu_tanh(v0[0]), gelu_tanh(v0[1])); w.y = pk2(gelu_tanh(v0[2]), gelu_tanh(v0[3])); w.z = pk2(gelu_tanh(v1[0]), gelu_tanh(v1[1])); w.w = pk2(gelu_tanh(v1[2]), gelu_tanh(v1[3]));
                *(u32x4*)(YS + ((size_t)row * 16 + j) * DSSM + u.z * 16 + h0) = w; } }
    }
};
struct EpiGlu {
    static constexpr bool AFTER_DRAIN = false;
    const float* bglu; const bf16_t* GS; bf16_t* YMIX;
    __device__ __forceinline__ void operator()(const f32x4 (&acc)[2][2][4][2], const Unit& u, int wr, int wc, int, int) const {
        const int l_ = lane_id_opaque(), fr = l_ & 15, fq = l_ >> 4;
        const int a0 = 128 * u.pn + 32 * wc + 8 * fq;
        float bv[8], bg[8];
#pragma unroll
        for (int i = 0; i < 8; ++i) { bv[i] = bglu[a0 + i]; bg[i] = bglu[1024 + a0 + i]; }
        EPI_FOR_ROWS { EPI_ROWDEF const u32x4 gs = *(const u32x4*)(GS + (size_t)row * DSSM + a0);
            float o[8];
#pragma unroll
            for (int n = 0; n < 2; ++n)
#pragma unroll
                for (int e = 0; e < 4; ++e) { const int i = 4 * n + e; o[i] = (acc[ai][0][m][n][e] + bv[i]) * sigmoidf_(acc[ai][1][m][n][e] + bg[i]); }
            o[0] *= bflo(gs.x); o[1] *= bfhi(gs.x); o[2] *= bflo(gs.y); o[3] *= bfhi(gs.y); o[4] *= bflo(gs.z); o[5] *= bfhi(gs.z); o[6] *= bflo(gs.w); o[7] *= bfhi(gs.w);
            u32x4 w; w.x = pk2(o[0], o[1]); w.y = pk2(o[2], o[3]); w.z = pk2(o[4], o[5]); w.w = pk2(o[6], o[7]);
            *(u32x4*)(YMIX + (size_t)row * DM + 1024 + a0) = w; }
    }
};
struct EpiBf {
    static constexpr bool AFTER_DRAIN = false;
    bf16_t* O; int ldc;
    __device__ __forceinline__ void operator()(const f32x4 (&acc)[2][2][4][2], const Unit& u, int wr, int wc, int, int) const {
        const int l_ = lane_id_opaque(), fr = l_ & 15, fq = l_ >> 4;
        EPI_FOR_ROWS { EPI_ROWDEF
#pragma unroll
            for (int bj = 0; bj < 2; ++bj) { const f32x4 v0 = acc[ai][bj][m][0], v1 = acc[ai][bj][m][1];
                u32x4 w; w.x = pk2(v0[0], v0[1]); w.y = pk2(v0[2], v0[3]); w.z = pk2(v1[0], v1[1]); w.w = pk2(v1[2], v1[3]);
                *(u32x4*)(O + (size_t)row * ldc + u.pn * BM + bj * HALF + wc * 32 + 8 * fq) = w; } }
    }
};
struct EpiOut {
    static constexpr bool AFTER_DRAIN = false;
    const float* x; float* H; bf16_t* HB; float* ssq;
    __device__ __forceinline__ void operator()(const f32x4 (&acc)[2][2][4][2], const Unit& u, int wr, int wc, int, int) const {
        const int l_ = lane_id_opaque(), fr = l_ & 15, fq = l_ >> 4;
        EPI_FOR_ROWS { EPI_ROWDEF float s = 0.f;
#pragma unroll
            for (int bj = 0; bj < 2; ++bj) { const size_t off = (size_t)row * DM + u.pn * BM + bj * HALF + wc * 32 + 8 * fq;
                const f32x4 v0 = acc[ai][bj][m][0] + *(const f32x4*)(x + off), v1 = acc[ai][bj][m][1] + *(const f32x4*)(x + off + 4);
                *(f32x4*)(H + off) = v0; *(f32x4*)(H + off + 4) = v1;
                s += (v0[0] * v0[0] + v0[1] * v0[1]) + (v0[2] * v0[2] + v0[3] * v0[3]) + (v1[0] * v1[0] + v1[1] * v1[1]) + (v1[2] * v1[2] + v1[3] * v1[3]);
                u32x4 w; w.x = pk2(v0[0], v0[1]); w.y = pk2(v0[2], v0[3]); w.z = pk2(v1[0], v1[1]); w.w = pk2(v1[2], v1[3]);
                *(u32x4*)(HB + off) = w; }
            s += swz_xor<16>(s); s = sum_xor32(s);
            if (fq == 0) ssq[(size_t)row * 32 + u.pn * 4 + wc] = s; }
    }
};
struct EpiGate {
    static constexpr bool AFTER_DRAIN = true;
    float* H; const bf16_t* PP; float* ssq; unsigned* cnt; const float* nf; const LAS float* r2;
    __device__ __forceinline__ void operator()(const f32x4 (&)[2][2][4][2], const Unit&, int, int, int, int) const {}
    __device__ __forceinline__ void fused(f32x4 (&acc)[2][2][4][2], const Unit& u, int wr, int wc, LAS unsigned char* lds, int wid) const {
        const int l_ = lane_id_opaque(), fr = l_ & 15, fq = l_ >> 4, tid = wid * 64 + l_;
        LAS float* P = (LAS float*)lds; LAS float* Rn = P + 1024;
        EPI_FOR_ROWS { EPI_ROWDEF float s = 0.f; const float r = r2[rit];
#pragma unroll
            for (int bj = 0; bj < 2; ++bj) { const size_t off = (size_t)row * DM + u.pn * BM + bj * HALF + wc * 32 + 8 * fq;
                const u32x4 pp = *(const u32x4*)(PP + off);
                f32x4 h0 = *(const f32x4*)(H + off), h1 = *(const f32x4*)(H + off + 4);
                const f32x4 a0 = acc[ai][bj][m][0] * r, a1 = acc[ai][bj][m][1] * r;
                h0[0] += sigmoidf_(a0[0]) * bflo(pp.x); h0[1] += sigmoidf_(a0[1]) * bfhi(pp.x); h0[2] += sigmoidf_(a0[2]) * bflo(pp.y); h0[3] += sigmoidf_(a0[3]) * bfhi(pp.y);
                h1[0] += sigmoidf_(a1[0]) * bflo(pp.z); h1[1] += sigmoidf_(a1[1]) * bfhi(pp.z); h1[2] += sigmoidf_(a1[2]) * bflo(pp.w); h1[3] += sigmoidf_(a1[3]) * bfhi(pp.w);
                acc[ai][bj][m][0] = h0; acc[ai][bj][m][1] = h1;
                s += (h0[0] * h0[0] + h0[1] * h0[1]) + (h0[2] * h0[2] + h0[3] * h0[3]) + (h1[0] * h1[0] + h1[1] * h1[1]) + (h1[2] * h1[2] + h1[3] * h1[3]); }
            s += swz_xor<16>(s); s = sum_xor32(s);
            if (fq == 0) P[rit * 4 + wc] = s; }
        LDS_WAIT(); __builtin_amdgcn_s_barrier(); asm volatile("" ::: "memory");
        if (tid < 256) { const float t = (P[tid * 4] + P[tid * 4 + 1]) + (P[tid * 4 + 2] + P[tid * 4 + 3]);
            __hip_atomic_store(ssq + (size_t)(u.pm * 256 + tid) * 8 + u.pn, t, __ATOMIC_RELAXED, __HIP_MEMORY_SCOPE_AGENT); }
        asm volatile("s_waitcnt vmcnt(0)" ::: "memory");
        if (wid < 4 && l_ == 0) __hip_atomic_fetch_add(cnt + 64 * u.pm, 1u, __ATOMIC_RELAXED, __HIP_MEMORY_SCOPE_AGENT);
        if (wid == 0) {
            unsigned sp = 0;
            while ((unsigned)__builtin_amdgcn_readfirstlane(__hip_atomic_load(cnt + 64 * u.pm, __ATOMIC_RELAXED, __HIP_MEMORY_SCOPE_AGENT)) < 32u) { __builtin_amdgcn_s_sleep(2); if (++sp > (1u << 22)) break; }
            __builtin_amdgcn_fence(__ATOMIC_ACQUIRE, "agent");
        }
        asm volatile("s_waitcnt vmcnt(0) lgkmcnt(0)" ::: "memory"); __builtin_amdgcn_s_barrier(); asm volatile("" ::: "memory");
        if (tid < 256) { const float* sp = ssq + (size_t)(u.pm * 256 + tid) * 8; float t = 0.f;
#pragma unroll
            for (int i = 0; i < 8; ++i) t += __hip_atomic_load(sp + i, __ATOMIC_RELAXED, __HIP_MEMORY_SCOPE_AGENT);
            Rn[tid] = rsqrtf(t * (1.f / DM) + EPS); }
        LDS_WAIT(); __builtin_amdgcn_s_barrier(); asm volatile("" ::: "memory");
        EPI_FOR_ROWS { EPI_ROWDEF const float rn = Rn[rit];
#pragma unroll
            for (int bj = 0; bj < 2; ++bj) { const int col = u.pn * BM + bj * HALF + wc * 32 + 8 * fq; const size_t off = (size_t)row * DM + col;
                *(f32x4*)(H + off) = acc[ai][bj][m][0] * rn * *(const f32x4*)(nf + col); *(f32x4*)(H + off + 4) = acc[ai][bj][m][1] * rn * *(const f32x4*)(nf + col + 4); } }
    }
};
}

namespace att {
constexpr int D = 128, NW = 8, QBLK = 32, KVBLK = 64;
constexpr float SCALE = 0.088388347648318440f;
constexpr float THR = 8.f;
constexpr int LDQ = DATT, LDK = DKV;
constexpr size_t SHM_V = KVBLK * D * 2, SHM_K = KVBLK * D * 2, SHM_ATTN = 2 * SHM_V + 2 * SHM_K + NW * 64 * 4;
#define KSWZ(row, colB) ((row) * 256 + ((colB) ^ (((row) & 7) << 4)))
#define SBAR() __builtin_amdgcn_sched_barrier(0)
__device__ __forceinline__ int crow(int r, int hi) { return (r & 3) + 8 * (r >> 2) + 4 * hi; }
__device__ __forceinline__ void partialSM(f32x16& p0, f32x16& p1, float& m_reg, float& mn, float& alpha) {
  constexpr float C = SCALE * 1.4426950408889634f;
  float pmax = p0[0]; for (int r = 1; r < 16; ++r) pmax = fmaxf(pmax, p0[r]); for (int r = 0; r < 16; ++r) pmax = fmaxf(pmax, p1[r]);
  { auto rr = __builtin_amdgcn_permlane32_swap(__float_as_uint(pmax), __float_as_uint(pmax), false, false);
    pmax = fmaxf(__uint_as_float(rr[0]), __uint_as_float(rr[1])); }
  if (__builtin_expect(__all(pmax - m_reg <= THR / SCALE), 1)) { mn = m_reg; alpha = 1.f; }
  else { mn = fmaxf(m_reg, pmax); alpha = __builtin_amdgcn_exp2f((m_reg - mn) * C); m_reg = mn; }
  float mnC = -mn * C;
  for (int r = 0; r < 16; ++r) p0[r] = fmaf(p0[r], C, mnC); for (int r = 0; r < 16; ++r) p1[r] = fmaf(p1[r], C, mnC);
  for (int r = 0; r < 16; ++r) p0[r] = __builtin_amdgcn_exp2f(p0[r]);
}
__device__ __forceinline__ void finishSM(f32x16& p0, f32x16& p1, float alpha, float& l_reg, bf16x8& pa0, bf16x8& pa1, bf16x8& pa2, bf16x8& pa3) {
  for (int r = 0; r < 16; ++r) p1[r] = __builtin_amdgcn_exp2f(p1[r]);
  float ps = 0; for (int r = 0; r < 16; ++r) ps += p0[r]; for (int r = 0; r < 16; ++r) ps += p1[r];
  { auto rr = __builtin_amdgcn_permlane32_swap(__float_as_uint(ps), __float_as_uint(ps), false, false);
    ps = __uint_as_float(rr[0]) + __uint_as_float(rr[1]); }
  l_reg = l_reg * alpha + ps;
#define PK4(P, BASE, OUT) do { unsigned a0 = cvt_pk_bf16(P[BASE + 0], P[BASE + 1]), a1 = cvt_pk_bf16(P[BASE + 2], P[BASE + 3]);   \
    unsigned b0 = cvt_pk_bf16(P[BASE + 4], P[BASE + 5]), b1 = cvt_pk_bf16(P[BASE + 6], P[BASE + 7]);                              \
    auto r0 = __builtin_amdgcn_permlane32_swap(a0, b0, false, false); auto r1 = __builtin_amdgcn_permlane32_swap(a1, b1, false, false); \
    u32x4 w = {r0[0], r1[0], r0[1], r1[1]}; OUT = *reinterpret_cast<bf16x8*>(&w); } while (0)
  PK4(p0, 0, pa0); PK4(p0, 8, pa1); PK4(p1, 0, pa2); PK4(p1, 8, pa3);
#undef PK4
}
__device__ __forceinline__ void qkt(f32x16& p0, f32x16& p1, const bf16_t* Ks, const bf16x8* qr, int r32, int hi) {
  p0 = f32x16{}; p1 = f32x16{};
  for (int d0 = 0; d0 < 8; ++d0) { int cb = (d0 * 16 + hi * 8) * 2;
    bf16x8 b0 = *reinterpret_cast<const bf16x8*>((const char*)Ks + KSWZ(r32, cb));
    bf16x8 b1 = *reinterpret_cast<const bf16x8*>((const char*)Ks + KSWZ(32 + r32, cb));
    p0 = __builtin_amdgcn_mfma_f32_32x32x16_bf16(b0, qr[d0], p0, 0, 0, 0);
    p1 = __builtin_amdgcn_mfma_f32_32x32x16_bf16(b1, qr[d0], p1, 0, 0, 0); }
}
__device__ __forceinline__ int v_st(int k, int c) { const int kk = (k & ~0xC) | ((k & 4) << 1) | ((k & 8) >> 1); return ((kk >> 3) * 4 + (c >> 5)) * 512 + ((kk & 7) * 32 + (c & 31)) * 2; }
__device__ __forceinline__ int v_rd_base(int lane) { return ((lane & 3) << 3) | (((lane >> 2) & 3) << 6) | (((lane >> 4) & 1) << 5) | (((lane >> 5) & 1) << 8); }
constexpr int v_rd_off(int d0, int ks, int half) { return d0 * 512 + ks * 4096 + half * 2048; }
template <int OFF> __device__ __forceinline__ s16x4 tr_read(int vb) {
  s16x4 r; asm volatile("ds_read_b64_tr_b16 %0, %1 offset:%2" : "=&v"(r) : "v"(vb), "i"(OFF) : "memory"); return r;
}
template <int D0> __device__ __forceinline__ void pv_one(f32x16& od, int vb, bf16x8 pa0, bf16x8 pa1, bf16x8 pa2, bf16x8 pa3) {
  const s16x4 l0 = tr_read<v_rd_off(D0, 0, 0)>(vb), h0 = tr_read<v_rd_off(D0, 0, 1)>(vb), l1 = tr_read<v_rd_off(D0, 1, 0)>(vb), h1 = tr_read<v_rd_off(D0, 1, 1)>(vb);
  const s16x4 l2 = tr_read<v_rd_off(D0, 2, 0)>(vb), h2 = tr_read<v_rd_off(D0, 2, 1)>(vb), l3 = tr_read<v_rd_off(D0, 3, 0)>(vb), h3 = tr_read<v_rd_off(D0, 3, 1)>(vb);
  asm volatile("s_waitcnt lgkmcnt(0)" ::: "memory"); SBAR();
#define PK(L, H) (bf16x8){L[0], L[1], L[2], L[3], H[0], H[1], H[2], H[3]}
  od = __builtin_amdgcn_mfma_f32_32x32x16_bf16(pa0, PK(l0, h0), od, 0, 0, 0);
  od = __builtin_amdgcn_mfma_f32_32x32x16_bf16(pa1, PK(l1, h1), od, 0, 0, 0);
  od = __builtin_amdgcn_mfma_f32_32x32x16_bf16(pa2, PK(l2, h2), od, 0, 0, 0);
  od = __builtin_amdgcn_mfma_f32_32x32x16_bf16(pa3, PK(l3, h3), od, 0, 0, 0);
#undef PK
}
__device__ __forceinline__ void pv_d0(f32x16* o, int vb, bf16x8 pa0, bf16x8 pa1, bf16x8 pa2, bf16x8 pa3) {
  pv_one<0>(o[0], vb, pa0, pa1, pa2, pa3); pv_one<1>(o[1], vb, pa0, pa1, pa2, pa3); pv_one<2>(o[2], vb, pa0, pa1, pa2, pa3); pv_one<3>(o[3], vb, pa0, pa1, pa2, pa3);
}
__device__ __forceinline__ void attn_dense_body(const bf16_t* __restrict__ Qb, const bf16_t* __restrict__ Kh, const bf16_t* __restrict__ Vh,
                                                const bf16_t* __restrict__ Gb, bf16_t* __restrict__ Yb, int seq, char* lds, const int wid) {
  const int lane = lane_id_opaque(), tid = wid * 64 + lane, r32 = lane & 31, hi = lane >> 5;
  bf16_t* V_lds = (bf16_t*)lds; bf16_t* K_lds = (bf16_t*)(lds + 2 * SHM_V);
  float* ws = (float*)(lds + 2 * SHM_V + 2 * SHM_K) + wid * 64; float* li_l = ws; float* al_l = ws + 32;
  float m_reg = -1e30f, l_reg = 0; f32x16 o[4] = {}; bf16x8 qr[8];
  const bf16_t* Qw = Qb + (long)(wid * QBLK + r32) * LDQ + hi * 8;
#pragma unroll
  for (int d0 = 0; d0 < 8; ++d0) qr[d0] = *reinterpret_cast<const bf16x8*>(Qw + d0 * 16);
  const int sr = tid >> 4, sc = (tid & 15) * 8, vst0 = v_st(sr, sc), vst1 = v_st(32 + sr, sc);
  const int vb0 = (int)(uintptr_t)V_lds + v_rd_base(lane);
  struct { bf16x8 vs0, vs1, ks0, ks1; } sr_[2];
#define SLOAD(i, k0) do { sr_[i].vs0 = *reinterpret_cast<const bf16x8*>(&Vh[(long)((k0) + sr) * LDK + sc]); sr_[i].vs1 = *reinterpret_cast<const bf16x8*>(&Vh[(long)((k0) + 32 + sr) * LDK + sc]); \
    sr_[i].ks0 = *reinterpret_cast<const bf16x8*>(&Kh[(long)((k0) + sr) * LDK + sc]); sr_[i].ks1 = *reinterpret_cast<const bf16x8*>(&Kh[(long)((k0) + 32 + sr) * LDK + sc]); } while (0)
#define SWRITE(b, i) do { *(bf16x8*)((char*)V_lds + (b) * SHM_V + vst0) = sr_[i].vs0;          \
    *(bf16x8*)((char*)V_lds + (b) * SHM_V + vst1) = sr_[i].vs1; int kc = sc * 2;               \
    *(bf16x8*)((char*)K_lds + (b) * SHM_K + KSWZ(sr, kc)) = sr_[i].ks0;                       \
    *(bf16x8*)((char*)K_lds + (b) * SHM_K + KSWZ(32 + sr, kc)) = sr_[i].ks1; } while (0)
#define SWAIT() asm volatile("s_waitcnt vmcnt(4)" ::: "memory")
#define RESC(a) do { if (__any((a) < 1.f)) { if (hi == 0) al_l[r32] = (a); asm volatile("s_waitcnt lgkmcnt(0)" ::: "memory"); \
    for (int d = 0; d < 4; ++d) for (int r = 0; r < 16; ++r) o[d][r] *= al_l[crow(r, hi)]; } } while (0)
  f32x16 pA0, pA1, pB0, pB1; float mnA, mnB, alA, alB; bf16x8 pa0, pa1, pa2, pa3; const int NT = seq / KVBLK;
  constexpr int SE = 0, SO = 1;
  SLOAD(SE, 0); asm volatile("s_waitcnt vmcnt(0)" ::: "memory"); SWRITE(0, SE); __syncthreads();
  qkt(pA0, pA1, K_lds, qr, r32, hi); partialSM(pA0, pA1, m_reg, mnA, alA);
  SLOAD(SO, KVBLK); if (2 < NT) SLOAD(SE, 2 * KVBLK);
  SWAIT(); SWRITE(1, SO); __syncthreads();
  for (int j = 1; j + 1 < NT; j += 2) {
    SBAR(); qkt(pB0, pB1, (bf16_t*)((char*)K_lds + SHM_K), qr, r32, hi);
    finishSM(pA0, pA1, alA, l_reg, pa0, pa1, pa2, pa3); SBAR();
    SLOAD(SO, (j + 2) * KVBLK); SBAR();
    pv_d0(o, vb0, pa0, pa1, pa2, pa3); partialSM(pB0, pB1, m_reg, mnB, alB);
    __syncthreads(); SWAIT(); SWRITE(0, SE);
    RESC(alB); __syncthreads();
    SBAR(); qkt(pA0, pA1, K_lds, qr, r32, hi);
    finishSM(pB0, pB1, alB, l_reg, pa0, pa1, pa2, pa3); SBAR();
    if (j + 3 < NT) SLOAD(SE, (j + 3) * KVBLK); SBAR();
    pv_d0(o, vb0 + (int)SHM_V, pa0, pa1, pa2, pa3); partialSM(pA0, pA1, m_reg, mnA, alA);
    __syncthreads(); SWAIT(); SWRITE(1, SO);
    RESC(alA); __syncthreads();
  }
  SBAR(); qkt(pB0, pB1, (bf16_t*)((char*)K_lds + SHM_K), qr, r32, hi);
  finishSM(pA0, pA1, alA, l_reg, pa0, pa1, pa2, pa3); SBAR();
  pv_d0(o, vb0, pa0, pa1, pa2, pa3); partialSM(pB0, pB1, m_reg, mnB, alB);
  __syncthreads(); RESC(alB);
  finishSM(pB0, pB1, alB, l_reg, pa0, pa1, pa2, pa3); SBAR();
  pv_d0(o, vb0 + (int)SHM_V, pa0, pa1, pa2, pa3);
  if (hi == 0) li_l[r32] = l_reg; asm volatile("s_waitcnt lgkmcnt(0)" ::: "memory");
  float rli[16];
#pragma unroll
  for (int r = 0; r < 16; ++r) rli[r] = __builtin_amdgcn_rcpf(li_l[crow(r, hi)]);
  bf16_t* Yw = Yb + (long)(wid * QBLK) * DM; const bf16_t* Gw = Gb + (long)(wid * QBLK) * DATT;
  __syncthreads();
  bf16_t* stg = (bf16_t*)(lds + wid * 8192);
#pragma unroll
  for (int r = 0; r < 16; ++r) { const int orow = crow(r, hi);
#pragma unroll
    for (int d0 = 0; d0 < 4; ++d0) stg[orow * 128 + d0 * 32 + r32] = (bf16_t)f2bf(o[d0][r] * rli[r]); }
  asm volatile("s_waitcnt lgkmcnt(0)" ::: "memory");
  const int l2 = lane_id_opaque();
#pragma unroll
  for (int i = 0; i < 8; ++i) { const int q = l2 + 64 * i, row = q >> 4, c8 = (q & 15) * 8;
    const u32x4 v = *(const u32x4*)(stg + row * 128 + c8); const u32x4 gg = *(const u32x4*)(Gw + (unsigned)(row * DATT + c8));
    u32x4 w; w.x = pk2(bflo(v.x) * bflo(gg.x), bfhi(v.x) * bfhi(gg.x)); w.y = pk2(bflo(v.y) * bflo(gg.y), bfhi(v.y) * bfhi(gg.y));
    w.z = pk2(bflo(v.z) * bflo(gg.z), bfhi(v.z) * bfhi(gg.z)); w.w = pk2(bflo(v.w) * bflo(gg.w), bfhi(v.w) * bfhi(gg.w));
    *(u32x4*)(Yw + (unsigned)(row * DM + c8)) = w; }
  __syncthreads();
#undef SLOAD
#undef SWRITE
#undef SWAIT
#undef RESC
}
#undef SBAR
}

__device__ __forceinline__ void p0_transpose_item(const float* W, int K, int N, bf16_t* WT, int wt_row0, const float* kscale, LAS float* scr, int k0, int n0, int lane) {
#pragma unroll
    for (int i = 0; i < 32; ++i) { const int kk = 2 * i + (lane >> 5); float v = W[(size_t)(k0 + kk) * N + n0 + (lane & 31)]; if (kscale) v *= kscale[k0 + kk]; scr[kk * 33 + (lane & 31)] = v; }
    LDS_WAIT(); asm volatile("" ::: "memory");
    const int c = lane & 7;
#pragma unroll
    for (int j = 0; j < 4; ++j) { const int n = (lane >> 3) + 8 * j; const LAS float* s = scr + (8 * c) * 33 + n;
        u32x4 o; o.x = pk2(s[0 * 33], s[1 * 33]); o.y = pk2(s[2 * 33], s[3 * 33]); o.z = pk2(s[4 * 33], s[5 * 33]); o.w = pk2(s[6 * 33], s[7 * 33]);
        *(u32x4*)(WT + (size_t)(wt_row0 + n) * K + k0 + 8 * c) = o; }
    LDS_WAIT(); asm volatile("" ::: "memory");
}

struct TrItem { const float* W; bf16_t* WT; const float* kscale; int K, N, wt_row0, k0, n0; };
__device__ __forceinline__ void p0_tr_load(const TrItem& d, float (&v)[32], int lane) {
#pragma unroll
    for (int i = 0; i < 32; ++i) { const int kk = 2 * i + (lane >> 5); v[i] = d.W[(size_t)(d.k0 + kk) * d.N + d.n0 + (lane & 31)]; }
    if (d.kscale) {
#pragma unroll
        for (int i = 0; i < 32; ++i) { const int kk = 2 * i + (lane >> 5); v[i] *= d.kscale[d.k0 + kk]; } }
}
__device__ __forceinline__ void p0_tr_store(const TrItem& d, const float (&v)[32], LAS float* scr, int lane) {
#pragma unroll
    for (int i = 0; i < 32; ++i) { const int kk = 2 * i + (lane >> 5); scr[kk * 33 + (lane & 31)] = v[i]; }
    LDS_WAIT(); asm volatile("" ::: "memory");
    const int c = lane & 7;
#pragma unroll
    for (int j = 0; j < 4; ++j) { const int n = (lane >> 3) + 8 * j; const LAS float* s = scr + (8 * c) * 33 + n;
        u32x4 o; o.x = pk2(s[0 * 33], s[1 * 33]); o.y = pk2(s[2 * 33], s[3 * 33]); o.z = pk2(s[4 * 33], s[5 * 33]); o.w = pk2(s[6 * 33], s[7 * 33]);
        *(u32x4*)(d.WT + (size_t)(d.wt_row0 + n) * d.K + d.k0 + 8 * c) = o; }
    LDS_WAIT(); asm volatile("" ::: "memory");
}
__device__ __forceinline__ void ssm_tables(const Args& a, int g, LAS unsigned char* lds, int tid) {
    LAS float* LD = (LAS float*)lds;
    LAS float* LBs = LD + 256;
    LAS float* BB = LBs + 256;
    LAS float* KT = BB + 4096;
    LAS float* CC = KT + 8192;
    float* lb16 = (float*)(a.ws + WS_LB16);
    bf16_t* WIN = (bf16_t*)(a.ws + WS_WIN) + (size_t)g * 256 * 256;
    bf16_t* WBIG = (bf16_t*)(a.ws + WS_WBIG) + (size_t)g * 256 * 512;
    for (int e = tid; e < 2048; e += 512) { const int d = e >> 10, r = e & 1023; const size_t ci_ = (size_t)(d * NG + g) * 1024 + r; CC[e * 2] = a.c_re[ci_]; CC[e * 2 + 1] = a.c_im[ci_]; }
    if (tid < 128) {
        const int d = tid >> 6, p = tid & 63; const int idx = (d * NG + g) * 64 + p;
        const float lr = fminf(a.a_re[idx], -1e-4f), li = a.a_im[idx];
        const float dt = expf(a.log_dt[d * NG + g]);
        const float er = expf(lr * dt); float sn, cs; sincosf(li * dt, &sn, &cs);
        const float br = er * cs, bi = er * sn;
        LD[tid * 2] = lr * dt; LD[tid * 2 + 1] = li * dt; LBs[tid * 2] = br; LBs[tid * 2 + 1] = bi;
        const float nr = br - 1.f, ni = bi, den = lr * lr + li * li;
        KT[tid * 2] = (nr * lr + ni * li) / den; KT[tid * 2 + 1] = (ni * lr - nr * li) / den;
        const float e16 = expf(16.f * lr * dt); float s16, c16; sincosf(16.f * li * dt, &s16, &c16);
        lb16[(g * 128 + tid) * 2] = e16 * c16; lb16[(g * 128 + tid) * 2 + 1] = e16 * s16;
    }
    __syncthreads();
    for (int e = tid; e < 2048; e += 512) {
        const int dp = e >> 4, h = e & 15, d = dp >> 6, p = dp & 63;
        const size_t bi_ = ((size_t)(d * NG + g) * 64 + p) * 16 + h;
        const float xr = a.b_re[bi_], xi = a.b_im[bi_], cr = KT[dp * 2], ci = KT[dp * 2 + 1];
        BB[e * 2] = cr * xr - ci * xi; BB[e * 2 + 1] = cr * xi + ci * xr;
    }
    __syncthreads();
    {
        const int d = tid >> 8, hp = (tid >> 4) & 15, h = tid & 15; float acc[16];
#pragma unroll
        for (int t = 0; t < 16; ++t) acc[t] = 0.f;
        const LAS float* cc = CC + ((d * 16 + hp) * 64) * 2;
        for (int p = 0; p < 64; ++p) {
            const float c_r = cc[p * 2], c_i = cc[p * 2 + 1], b_r = BB[((d * 64 + p) * 16 + h) * 2], b_i = BB[((d * 64 + p) * 16 + h) * 2 + 1];
            float wr = c_r * b_r - c_i * b_i, wi = c_r * b_i + c_i * b_r; const float l_r = LBs[(d * 64 + p) * 2], l_i = LBs[(d * 64 + p) * 2 + 1];
#pragma unroll
            for (int t = 0; t < 16; ++t) { acc[t] += wr; const float nr = wr * l_r - wi * l_i; wi = wr * l_i + wi * l_r; wr = nr; }
        }
#pragma unroll
        for (int t = 0; t < 16; ++t) KT[((d * 16 + t) * 16 + hp) * 16 + h] = acc[t];
    }
    __syncthreads();
    for (int q = tid; q < 8192; q += 512) {
        const int n = q >> 5, kc = q & 31, s = kc >> 1, h0 = (kc & 1) * 8, j = n >> 4, hp = n & 15;
        float v[8];
#pragma unroll
        for (int e = 0; e < 8; ++e) { const int h = h0 + e;
            if (s < j) v[e] = KT[((0 * 16 + (j - s)) * 16 + hp) * 16 + h];
            else if (s > j) v[e] = KT[((1 * 16 + (s - j)) * 16 + hp) * 16 + h];
            else v[e] = KT[((0 * 16 + 0) * 16 + hp) * 16 + h] + KT[((1 * 16 + 0) * 16 + hp) * 16 + h] + (h == hp ? a.ssm_d[g * 16 + h] : 0.f); }
        u32x4 w; w.x = pk2(v[0], v[1]); w.y = pk2(v[2], v[3]); w.z = pk2(v[4], v[5]); w.w = pk2(v[6], v[7]);
        *(u32x4*)(WBIG + (size_t)n * 512 + s * 16 + h0) = w;
    }
    for (int q = tid; q < 2048; q += 512) {
        const int p = q & 63, js = (q >> 6) & 15, d = q >> 10; const float ldr = LD[(d * 64 + p) * 2], ldi = LD[(d * 64 + p) * 2 + 1];
        {   const float pw = (float)(d == 0 ? js + 1 : 16 - js); const float er = expf(pw * ldr); float sn, cs; sincosf(pw * ldi, &sn, &cs); const float pr = er * cs, pi = er * sn;
#pragma unroll
            for (int hp = 0; hp < 16; ++hp) { const float c_r = CC[((d * 16 + hp) * 64 + p) * 2], c_i = CC[((d * 16 + hp) * 64 + p) * 2 + 1];
                *(unsigned*)(WBIG + (size_t)(js * 16 + hp) * 512 + 256 + d * 128 + 2 * p) = pk2(c_r * pr - c_i * pi, -(c_r * pi + c_i * pr)); } }
        {   const float pw = (float)(d == 0 ? 15 - js : js); const float er = expf(pw * ldr); float sn, cs; sincosf(pw * ldi, &sn, &cs); const float pr = er * cs, pi = er * sn;
            float zr[16], zi[16];
#pragma unroll
            for (int h = 0; h < 16; ++h) { const float b_r = BB[((d * 64 + p) * 16 + h) * 2], b_i = BB[((d * 64 + p) * 16 + h) * 2 + 1]; zr[h] = pr * b_r - pi * b_i; zi[h] = pr * b_i + pi * b_r; }
            bf16_t* d0 = WIN + (size_t)(d * 128 + p) * 256 + js * 16; bf16_t* d1 = d0 + (size_t)64 * 256;
            u32x4 w; w.x = pk2(zr[0], zr[1]); w.y = pk2(zr[2], zr[3]); w.z = pk2(zr[4], zr[5]); w.w = pk2(zr[6], zr[7]); *(u32x4*)d0 = w;
            w.x = pk2(zr[8], zr[9]); w.y = pk2(zr[10], zr[11]); w.z = pk2(zr[12], zr[13]); w.w = pk2(zr[14], zr[15]); *(u32x4*)(d0 + 8) = w;
            w.x = pk2(zi[0], zi[1]); w.y = pk2(zi[2], zi[3]); w.z = pk2(zi[4], zi[5]); w.w = pk2(zi[6], zi[7]); *(u32x4*)d1 = w;
            w.x = pk2(zi[8], zi[9]); w.y = pk2(zi[10], zi[11]); w.z = pk2(zi[12], zi[13]); w.w = pk2(zi[14], zi[15]); *(u32x4*)(d1 + 8) = w; }
    }
    __syncthreads();
}

#define XB_TMO      128
#define XB_XCNT(j)  (256  + 64 * (j))
#define XB_XSUB(j)  (1280 + 64 * (j))
#define XB_XGEN(j)  (2304 + 64 * (j))
#define XB_TOP      3328
#define XB_TOPGEN   3392
#define XCD_BAR_WORDS 3456
#define XB_SPIN_CAP (1u << 18)
__device__ __forceinline__ unsigned xb_ld(unsigned* p)              { return __hip_atomic_load(p, __ATOMIC_RELAXED, __HIP_MEMORY_SCOPE_AGENT); }
__device__ __forceinline__ unsigned xb_add(unsigned* p, unsigned v) { return __hip_atomic_fetch_add(p, v, __ATOMIC_RELAXED, __HIP_MEMORY_SCOPE_AGENT); }
__device__ __forceinline__ unsigned xb_xcc_id() { return (unsigned)__builtin_amdgcn_s_getreg((3 << 11) | 20) & 0xFu; }
#define XB_SPIN(cond, bar) do { unsigned _sp = 0; while (cond) { __builtin_amdgcn_s_sleep(1); \
    if ((++_sp & 255u) == 0u) { if (xb_ld(&(bar)[XB_TMO])) break; if (_sp > XB_SPIN_CAP) { atomicAdd(&(bar)[XB_TMO], 1u); break; } } } } while (0)
struct XcdBarrier { unsigned* bar; unsigned x; volatile LAS unsigned* st; };
__device__ __forceinline__ XcdBarrier xcd_barrier_post(unsigned* bar, volatile LAS unsigned* st, bool leader) {
    XcdBarrier b; b.bar = bar; b.x = xb_xcc_id(); b.st = st;
    if (leader) (void)xb_add(&bar[XB_XCNT(b.x)], 1u);
    return b;
}
__device__ __forceinline__ void xcd_barrier_complete(unsigned* bar, unsigned x, unsigned& nloc, unsigned& nx) {
    const unsigned G = gridDim.x * gridDim.y * gridDim.z;
    unsigned sum, cnt, mine, sp = 0u;
    for (;;) {
        sum = 0u; cnt = 0u; mine = 0u;
#pragma unroll
        for (unsigned j = 0; j < 16; ++j) { const unsigned c = xb_ld(&bar[XB_XCNT(j)]); sum += c; cnt += (c > 0u) ? 1u : 0u; mine = (j == x) ? c : mine; }
        if (sum == G) break;
        __builtin_amdgcn_s_sleep(1);
        if ((++sp & 255u) == 0u) { if (xb_ld(&bar[XB_TMO])) break; if (sp > XB_SPIN_CAP) { atomicAdd(&bar[XB_TMO], 1u); break; } }
    }
    nloc = mine > 0u ? mine : 1u; nx = cnt > 0u ? cnt : 1u;
}
__device__ __forceinline__ void xcd_barrier(const XcdBarrier& b, bool leader) {
    asm volatile("s_waitcnt vmcnt(0)" ::: "memory");
    __syncthreads();
    if (leader) {
        unsigned* bar = b.bar;
        __builtin_amdgcn_s_waitcnt(0);
        unsigned nloc = b.st[0], nx = b.st[1];
        if (nloc == 0u) { xcd_barrier_complete(bar, b.x, nloc, nx); b.st[0] = nloc; b.st[1] = nx; }
        const unsigned old = xb_add(&bar[XB_XSUB(b.x)], 1u);
        const unsigned gen = old / nloc;
        if (old + 1u == (gen + 1u) * nloc) {
            __builtin_amdgcn_fence(__ATOMIC_RELEASE, "agent");
            asm volatile("s_waitcnt vmcnt(0)" ::: "memory");
            const unsigned og = xb_add(&bar[XB_TOP], 1u);
            const unsigned tg = og / nx;
            if (og + 1u == (tg + 1u) * nx) xb_add(&bar[XB_TOPGEN], 1u);
            else XB_SPIN(xb_ld(&bar[XB_TOPGEN]) == tg, bar);
            __builtin_amdgcn_fence(__ATOMIC_ACQUIRE, "agent");
            xb_add(&bar[XB_XGEN(b.x)], 1u);
            asm volatile("s_waitcnt vmcnt(0)" ::: "memory");
        } else {
            XB_SPIN(xb_ld(&bar[XB_XGEN(b.x)]) == gen, bar);
            __builtin_amdgcn_fence(__ATOMIC_ACQUIRE, "agent");
            asm volatile("s_waitcnt vmcnt(0)" ::: "memory");
        }
    }
    __syncthreads();
}

__global__ void __launch_bounds__(512, 2) fwd_kernel(Args a) {
    extern __shared__ __attribute__((aligned(16))) unsigned char lds_raw[];
    LAS unsigned char* lds = (LAS unsigned char*)lds_raw;
    cg::grid_group grid = cg::this_grid();
    const int wave = __builtin_amdgcn_readfirstlane(threadIdx.x >> 6);
    const bool leader = (wave == 0) && (lane_id_opaque() == 0);
    volatile LAS unsigned* xst = (volatile LAS unsigned*)(lds + XBST_OFF);
    if (leader) { xst[0] = 0u; xst[1] = 0u; }
    __syncthreads();
    if (a.ws == nullptr) grid.sync();
    const XcdBarrier xbar = xcd_barrier_post((unsigned*)(a.ws + WS_BAR), xst, leader);
#define GRID_SYNC() xcd_barrier(xbar, (wave == 0) && (lane_id_opaque() == 0))
#define LANE_IDS const int lane = lane_id_opaque(), tid = wave * 64 + lane; (void)tid;
    const int G = gridDim.x, bid = blockIdx.x;
    unsigned char* ws = a.ws;
    bf16_t* W1T = (bf16_t*)(ws + WS_W1T); bf16_t* WGLUT = (bf16_t*)(ws + WS_WGLUT); bf16_t* WOT = (bf16_t*)(ws + WS_WOT); bf16_t* WGT = (bf16_t*)(ws + WS_WGT); bf16_t* WPT = (bf16_t*)(ws + WS_WPT);
    float2* ROPE = (float2*)(ws + WS_ROPE); float* RINV = (float*)(ws + WS_RINV); float* LB16 = (float*)(ws + WS_LB16); float* SSQ1 = (float*)(ws + WS_SSQ1); float* SSQ2 = (float*)(ws + WS_SSQ2);
    bf16_t* PB = (bf16_t*)(ws + WS_PB); bf16_t* WIN = (bf16_t*)(ws + WS_WIN); bf16_t* WBIG = (bf16_t*)(ws + WS_WBIG);
    bf16_t* XB = (bf16_t*)(ws + WS_XB); bf16_t* HB = (bf16_t*)(ws + WS_XB);
    bf16_t* Q = (bf16_t*)(ws + WS_Q); bf16_t* KB = (bf16_t*)(ws + WS_K); bf16_t* VB = (bf16_t*)(ws + WS_V); bf16_t* GA = (bf16_t*)(ws + WS_GA); bf16_t* GS = (bf16_t*)(ws + WS_GS);
    bf16_t* UCAT = (bf16_t*)(ws + WS_UCAT); bf16_t* PPB = (bf16_t*)(ws + WS_UCAT); bf16_t* YMIX = (bf16_t*)(ws + WS_YMIX); bf16_t* YS = (bf16_t*)(ws + WS_YS);

#pragma unroll
    for (int rep_ = 0; rep_ < 1 + ((REP_MASK >> 0) & 1); ++rep_) { LANE_IDS
        const int gw = bid * 8 + wave, NGW = G * 8;
        LAS float* scr = (LAS float*)(lds + wave * 16384);
        constexpr int I1 = 32 * 144, I2 = 16 * 64, I3 = 32 * 64, I4 = 32 * 64, I5 = 4 * 64, NIT = I1 + I2 + I3 + I4 + I5;
        auto item_desc = [&](int r) -> TrItem {
            if (r < I1) { const int kb = r / 144, lgg = r % 144, pn = lgg >> 3, lg = lgg & 7, wtg = pn * 8 + 4 * (lg & 1) + 2 * (lg >> 2) + ((lg >> 1) & 1);
                return TrItem{a.w_in, W1T, a.norm_mix, DM, DIN, wtg * 32, kb * 64, lgg * 32}; } r -= I1;
            if (r < I2) { const int kb = r / 64, lgg = r % 64, l2 = lgg & 31, wtg = (l2 >> 2) * 8 + 4 * (lgg >> 5) + (l2 & 3);
                return TrItem{a.w_glu, WGLUT, nullptr, DSSM, 2 * DSSM, wtg * 32, kb * 64, lgg * 32}; } r -= I2;
            if (r < I3) { const int kb = r / 64, lgg = r % 64; return TrItem{a.w_out, WOT, nullptr, DM, DM, lgg * 32, kb * 64, lgg * 32}; } r -= I3;
            if (r < I4) { const int kb = r / 64, lgg = r % 64; return TrItem{a.w_ple_gate, WGT, a.norm_ple, DM, DM, lgg * 32, kb * 64, lgg * 32}; } r -= I4;
            const int kb = r / 64, lgg = r % 64; return TrItem{a.w_ple_proj, WPT, nullptr, PLE, DM, lgg * 32, kb * 64, lgg * 32};
        };
#pragma unroll
        for (int rq_ = 0; rq_ < 1 + ((REP_MASK >> 8) & 1); ++rq_)
        for (int it = gw; it < NIT; it += 2 * NGW) {
            const bool two = it + NGW < NIT;
            const TrItem dA = item_desc(it), dB = item_desc(two ? it + NGW : it);
            float vA[32], vB[32];
            p0_tr_load(dA, vA, lane); if (two) p0_tr_load(dB, vB, lane);
            p0_tr_store(dA, vA, scr, lane); if (two) p0_tr_store(dB, vB, scr, lane);
        }
#pragma unroll
        for (int rq_ = 0; rq_ < 1 + ((REP_MASK >> 9) & 1); ++rq_)
        for (int m = gw; m < T; m += 2 * NGW) {
            const int m2 = m + NGW; const bool two = m2 < T;
            const f32x4* xr = (const f32x4*)(a.x + (size_t)m * DM) + lane; const f32x4* xr2 = (const f32x4*)(a.x + (size_t)(two ? m2 : m) * DM) + lane;
            f32x4 v[8], w2[8]; float s = 0.f, s2 = 0.f;
#pragma unroll
            for (int j = 0; j < 8; ++j) v[j] = xr[64 * j];
#pragma unroll
            for (int j = 0; j < 8; ++j) w2[j] = xr2[64 * j];
#pragma unroll
            for (int j = 0; j < 8; ++j) { s += (v[j][0] * v[j][0] + v[j][1] * v[j][1]) + (v[j][2] * v[j][2] + v[j][3] * v[j][3]); s2 += (w2[j][0] * w2[j][0] + w2[j][1] * w2[j][1]) + (w2[j][2] * w2[j][2] + w2[j][3] * w2[j][3]); }
            s = wave_sum(s); s2 = wave_sum(s2);
            if (lane == 0) { RINV[m] = rsqrtf(s * (1.f / DM) + EPS); if (two) RINV[m2] = rsqrtf(s2 * (1.f / DM) + EPS); }
            u32x2* o = (u32x2*)(XB + (size_t)m * DM) + lane; u32x2* o2 = (u32x2*)(XB + (size_t)m2 * DM) + lane;
#pragma unroll
            for (int j = 0; j < 8; ++j) { u32x2 w; w.x = pk2(v[j][0], v[j][1]); w.y = pk2(v[j][2], v[j][3]); o[64 * j] = w; }
            if (two) {
#pragma unroll
                for (int j = 0; j < 8; ++j) { u32x2 w; w.x = pk2(w2[j][0], w2[j][1]); w.y = pk2(w2[j][2], w2[j][3]); o2[64 * j] = w; } }
        }
        for (int i = bid * 512 + tid; i < T * PLE / 4; i += G * 512) { const f32x4 v = ((const f32x4*)a.p)[i]; u32x2 w; w.x = pk2(v[0], v[1]); w.y = pk2(v[2], v[3]); ((u32x2*)PB)[i] = w; }
        for (int i = bid * 512 + tid; i < 2048; i += G * 512) { const int pos = i >> 5, f = i & 31; const float inv = powf(10000.f, -(float)f / 32.f); float sn, cs; sincosf((float)pos * inv, &sn, &cs); ROPE[i] = make_float2(cs, sn); }
    GRID_SYNC(); }


    if constexpr ((REP_MASK >> 10) & 1) { GRID_SYNC(); GRID_SYNC(); GRID_SYNC(); GRID_SYNC(); }
#pragma unroll
    for (int rep_ = 0; rep_ < 1 + ((REP_MASK >> 1) & 1); ++rep_) { LANE_IDS
        { pg8::Gemm g{XB, W1T, DM, DM, DM, 0, 0}; pg8::StaticOrder S; S.init(T, 14 * 256, G, bid);
          pg8::Epi1 E{RINV, a.q_norm, a.k_norm, ROPE, Q, KB, VB, GA, GS, UCAT, (LAS float*)(lds + XCH_OFF), 0};
          pg8::gemm_phase<pg8::Epi1, pg8::StaticOrder, true>(lds, g, S, E, wave); }
        __syncthreads();
        for (int gi = bid - (G - NG); gi >= 0 && gi < NG; gi += NG) ssm_tables(a, gi, lds, tid);
    GRID_SYNC(); }

#pragma unroll
    for (int rep_ = 0; rep_ < 1 + ((REP_MASK >> 2) & 1); ++rep_) {
#pragma unroll
        for (int rq_ = 0; rq_ < 2; ++rq_) {
        if (bid < 2 * NG) { if (rq_ == 1 && !((REP_MASK >> 6) & 1)) break;
            pg8::BatchOrder S{2 * NG, G, bid};
            { pg8::Gemm g{UCAT, WIN, 256, 512, 256, (size_t)NCH * 512 * 2, (size_t)256 * 256 * 2};
              pg8::EpiS1 E{LB16, UCAT}; pg8::gemm_phase<pg8::EpiS1, pg8::BatchOrder, false>(lds, g, S, E, wave); }
            asm volatile("s_waitcnt vmcnt(0)\n\tbuffer_inv sc1\n\ts_waitcnt vmcnt(0)" ::: "memory"); __syncthreads();
            { pg8::Gemm g{UCAT, WBIG, 512, 512, 512, (size_t)NCH * 512 * 2, (size_t)256 * 512 * 2};
              pg8::EpiS2 E{YS}; pg8::gemm_phase<pg8::EpiS2, pg8::BatchOrder, false>(lds, g, S, E, wave); }
        } else { if (rq_ == 1 && !((REP_MASK >> 11) & 1)) break;
            pg8::Gemm g{XB, W1T + (size_t)14 * 256 * DM, DM, DM, DM, 0, 0}; pg8::ListOrder S{bid - 2 * NG, 128, G};
            pg8::Epi1 E{RINV, a.q_norm, a.k_norm, ROPE, Q, KB, VB, GA, GS, UCAT, (LAS float*)(lds + XCH_OFF), 14};
            pg8::gemm_phase<pg8::Epi1, pg8::ListOrder, true>(lds, g, S, E, wave);
        }
        __syncthreads(); }
#pragma unroll
        for (int rq_ = 0; rq_ < 1 + ((REP_MASK >> 7) & 1); ++rq_)
        for (int un = bid; un < 256; un += G) {
            const int x = un & 7, jj = un >> 3, b = x >> 2, kvh = (x >> 1) & 1, idx = (x & 1) * 32 + jj, h = kvh * 4 + (idx >> 4), qb = idx & 15;
            const size_t tok0 = (size_t)b * SEQ + qb * 256;
            att::attn_dense_body(Q + tok0 * DATT + h * 128, KB + (size_t)b * SEQ * DKV + kvh * 128, VB + (size_t)b * SEQ * DKV + kvh * 128,
                                 GA + tok0 * DATT + h * 128, YMIX + tok0 * DM + h * 128, SEQ, (char*)lds_raw, wave);
        }
    GRID_SYNC(); }

#pragma unroll
    for (int rep_ = 0; rep_ < 1 + ((REP_MASK >> 3) & 1); ++rep_) {
        { pg8::Gemm g{YS, WGLUT, DSSM, DSSM, DSSM, 0, 0}; pg8::StaticOrder S; S.init(T, 2 * DSSM, G, bid);
          pg8::EpiGlu E{a.b_glu, GS, YMIX}; pg8::gemm_phase<pg8::EpiGlu, pg8::StaticOrder, false>(lds, g, S, E, wave); }
        __syncthreads();
        { pg8::Gemm g{PB, WPT, PLE, PLE, PLE, 0, 0}; pg8::StaticOrder S; S.init(T, DM, G, bid);
          pg8::EpiBf E{PPB, DM}; pg8::gemm_phase<pg8::EpiBf, pg8::StaticOrder, false>(lds, g, S, E, wave); }
    GRID_SYNC(); }


#pragma unroll
    for (int rep_ = 0; rep_ < 1 + ((REP_MASK >> 4) & 1); ++rep_) {
        pg8::Gemm g{YMIX, WOT, DM, DM, DM, 0, 0}; pg8::StaticOrder S; S.init(T, DM, G, bid);
        pg8::EpiOut E{a.x, a.out, HB, SSQ1}; pg8::gemm_phase<pg8::EpiOut, pg8::StaticOrder, false>(lds, g, S, E, wave);
    GRID_SYNC(); }


    { LANE_IDS
        pg8::StaticOrder S; S.init(T, DM, G, bid); pg8::Unit u0;
        LAS float* r2 = (LAS float*)(lds + R2_OFF);
        if (S.next(0, u0) && tid < 256) { const float* sp = SSQ1 + (size_t)(u0.pm * 256 + tid) * 32; float s = 0.f;
#pragma unroll
            for (int i = 0; i < 8; ++i) { const f32x4 v = ((const f32x4*)sp)[i]; s += (v[0] + v[1]) + (v[2] + v[3]); }
            r2[tid] = rsqrtf(s * (1.f / DM) + EPS); }
        __syncthreads();
        pg8::Gemm g{HB, WGT, DM, DM, DM, 0, 0};
        pg8::EpiGate E{a.out, PPB, SSQ2, (unsigned*)ws, a.norm_final, r2}; pg8::gemm_phase<pg8::EpiGate, pg8::StaticOrder, false>(lds, g, S, E, wave);
    }
}

extern "C" void kernel_launch(void* const* d_in, const int* in_sizes, int n_in, void* d_out, int out_size, void* d_ws, size_t ws_size, hipStream_t stream) {
    static int grid = 0;
    if (grid == 0) {
        if (n_in != 21 || in_sizes[0] != T * DM || out_size != T * DM || ws_size < WS_END) { fprintf(stderr, "kernel_launch: unexpected shapes (n_in %d, in0 %d, out %d, ws %zu)\n", n_in, n_in > 0 ? in_sizes[0] : -1, out_size, ws_size); grid = -1; return; }
        int dev = 0, cus = 0, per_cu = 0;
        hipGetDevice(&dev); hipDeviceGetAttribute(&cus, hipDeviceAttributeMultiprocessorCount, dev);
        if (hipFuncSetAttribute((const void*)fwd_kernel, hipFuncAttributeMaxDynamicSharedMemorySize, LDS_BYTES) != hipSuccess) { fprintf(stderr, "kernel_launch: hipFuncSetAttribute failed\n"); grid = -1; return; }
        hipOccupancyMaxActiveBlocksPerMultiprocessor(&per_cu, (const void*)fwd_kernel, 512, LDS_BYTES);
        (void)hipGetLastError();
        if (per_cu < 1) fprintf(stderr, "kernel_launch: occupancy query reports %d blocks per CU\n", per_cu);
        grid = cus > 256 ? 256 : cus;
    }
    if (grid < 0) return;
    Args a{};
    const float** f = (const float**)&a;
    for (int i = 0; i < 21; ++i) f[i] = (const float*)d_in[i];
    a.out = (float*)d_out; a.ws = (unsigned char*)d_ws;
    if (hipMemsetAsync(d_ws, 0, WS_CTL_BYTES, stream) != hipSuccess) { fprintf(stderr, "kernel_launch: hipMemsetAsync failed\n"); return; }
    void* args[] = {&a};
    hipError_t e = hipLaunchCooperativeKernel((const void*)fwd_kernel, dim3(grid), dim3(512), args, LDS_BYTES, stream);
    if (e != hipSuccess) fprintf(stderr, "kernel_launch: cooperative launch failed: %s (grid %d)\n", hipGetErrorString(e), grid);
}
```

```cpp
#include <hip/hip_runtime.h>
#include <hip/hip_cooperative_groups.h>
#include <cstdio>
#include <cstdint>
namespace cg = cooperative_groups;

#define LAS __attribute__((address_space(3)))
typedef unsigned short bf16_t;
typedef short bf16x8 __attribute__((ext_vector_type(8)));
typedef short s16x4 __attribute__((ext_vector_type(4)));
typedef float f32x4 __attribute__((ext_vector_type(4)));
typedef float f32x16 __attribute__((ext_vector_type(16)));
typedef unsigned u32x4 __attribute__((ext_vector_type(4)));
typedef unsigned u32x2 __attribute__((ext_vector_type(2)));

constexpr int T = 8192, SEQ = 4096, DM = 2048, DIN = 4608, DATT = 1024, DKV = 256, DSSM = 1024, PLE = 256;
constexpr int NG = 64, NCH = T / 16;
constexpr float EPS = 1e-6f;
#ifndef PH_MASK
#define PH_MASK 0xff
#endif
#ifndef REP_MASK
#define REP_MASK 0
#endif

constexpr size_t MiB = 1u << 20;
constexpr size_t WS_W1T = 1 * MiB, WS_WGLUT = 19 * MiB, WS_WOT = 23 * MiB, WS_WGT = 31 * MiB, WS_WPT = 39 * MiB;
constexpr size_t WS_ROPE = 40 * MiB, WS_RINV = 40 * MiB + 65536, WS_LB16 = 40 * MiB + 131072, WS_SSQ1 = 41 * MiB, WS_SSQ2 = 42 * MiB;
constexpr size_t WS_PB = 43 * MiB, WS_WIN = 47 * MiB, WS_WBIG = 55 * MiB;
constexpr size_t WS_XB = 71 * MiB;
constexpr size_t WS_Q = 103 * MiB, WS_K = 119 * MiB, WS_V = 123 * MiB, WS_GA = 127 * MiB, WS_GS = 143 * MiB;
constexpr size_t WS_UCAT = 159 * MiB;
constexpr size_t WS_YMIX = 191 * MiB, WS_YS = 223 * MiB, WS_END = 239 * MiB;

constexpr int RING_BYTES = 131072, XCH_OFF = RING_BYTES, R2_OFF = RING_BYTES + 4096, XBST_OFF = RING_BYTES + 8192, LDS_BYTES = 147456;
constexpr size_t WS_BAR = 65536, WS_CTL_BYTES = 131072;

struct Args {
    const float *x, *p, *norm_mix, *w_in, *q_norm, *k_norm, *a_re, *a_im, *log_dt, *b_re, *b_im, *c_re, *c_im, *ssm_d, *w_glu, *b_glu, *w_out, *norm_ple, *w_ple_gate, *w_ple_proj, *norm_final;
    float* out; unsigned char* ws;
};

__device__ __forceinline__ unsigned f2bf(float f) { unsigned u = __builtin_bit_cast(unsigned, f); return (u + 0x7fffu + ((u >> 16) & 1u)) >> 16; }
__device__ __forceinline__ unsigned pk2(float lo, float hi) { return f2bf(lo) | (f2bf(hi) << 16); }
__device__ __forceinline__ float bf2f(unsigned short b) { return __builtin_bit_cast(float, (unsigned)b << 16); }
__device__ __forceinline__ float bflo(unsigned w) { return __builtin_bit_cast(float, w << 16); }
__device__ __forceinline__ float bfhi(unsigned w) { return __builtin_bit_cast(float, w & 0xffff0000u); }
__device__ __forceinline__ unsigned cvt_pk_bf16(float lo, float hi) { unsigned r; asm volatile("v_cvt_pk_bf16_f32 %0, %1, %2" : "=v"(r) : "v"(lo), "v"(hi)); return r; }
__device__ __forceinline__ float sigmoidf_(float v) { return 1.f / (1.f + __expf(-v)); }
__device__ __forceinline__ float siluf_(float v) { return v / (1.f + __expf(-v)); }
__device__ __forceinline__ float gelu_tanh(float v) { const float t = 1.5957691216057308f * (v + 0.044715f * v * v * v); return v / (1.f + __expf(-t)); }
template <int K> __device__ __forceinline__ float swz_xor(float v) { return __int_as_float(__builtin_amdgcn_ds_swizzle(__float_as_int(v), (K << 10) | 0x1f)); }
__device__ __forceinline__ float sum_xor32(float v) { auto rr = __builtin_amdgcn_permlane32_swap(__float_as_uint(v), __float_as_uint(v), false, false); return __uint_as_float(rr[0]) + __uint_as_float(rr[1]); }
__device__ __forceinline__ float wave_sum(float v) { v += swz_xor<1>(v); v += swz_xor<2>(v); v += swz_xor<4>(v); v += swz_xor<8>(v); v += swz_xor<16>(v); return sum_xor32(v); }
#define LDS_WAIT() asm volatile("s_waitcnt lgkmcnt(0)" ::: "memory")
__device__ __forceinline__ int lane_id_opaque() { int l = __builtin_amdgcn_mbcnt_hi(~0u, __builtin_amdgcn_mbcnt_lo(~0u, 0u)); asm volatile("" : "+v"(l)); return l; }

namespace pg8 {
constexpr int BM = 256, BK = 64, HALF = 128, HTB = HALF * BK * 2, NXCD = 8, WGM = 8;
__host__ __device__ __forceinline__ int lds_byte(int r, int c) { const int st = (r >> 4) * 2 + (c >> 5), rr = r & 15, cc = c & 31, ob = rr * 64 + cc * 2; return st * 1024 + (ob ^ (((ob >> 9) & 1) << 5)); }
__host__ __device__ __forceinline__ void stage_rc(int b, int& R, int& C) { const int st = b / 1024, sb = b % 1024, swz = sb ^ (((sb >> 9) & 1) << 5); R = (st >> 1) * 16 + swz / 64; C = (st & 1) * 32 + (swz % 64) / 2; }
__host__ __device__ __forceinline__ int perm32(int rho) { const int n = rho >> 4, i = rho & 15; return 8 * (i >> 2) + 4 * n + (i & 3); }

struct Unit { int pm, pn, z; };
struct Gemm { const bf16_t* A; const bf16_t* Bt; int K, lda, ldb; size_t zA, zB; };

struct StaticOrder {
    int nM, nN, nwg, G, c;
    __device__ void init(int M, int N, int G_, int c_) { nM = M / BM; nN = N / BM; nwg = nM * nN; G = G_; c = c_; }
    __device__ bool next(int i, Unit& u) const {
        const long L = (long)i * G + c; if (L >= nwg) return false;
        int wgid = (int)L; { const int q = nwg / NXCD, r = nwg % NXCD, xcd = wgid % NXCD, off = wgid / NXCD; wgid = (xcd < r ? xcd * (q + 1) : r * (q + 1) + (xcd - r) * q) + off; }
        const int nig = WGM * nN, gid = wgid / nig, fm = gid * WGM, gsz = (nM - fm) < WGM ? (nM - fm) : WGM;
        u.pm = fm + ((wgid % nig) % gsz); u.pn = (wgid % nig) / gsz; u.z = 0; return true;
    }
};
struct BatchOrder {
    int n, G, c;
    __device__ bool next(int i, Unit& u) const { const int L = i * G + c; if (L >= n) return false; u.z = L >> 1; u.pm = L & 1; u.pn = 0; return true; }
};

struct ListOrder {
    int L0, n, stride;
    __device__ bool next(int i, Unit& u) const { const int L = L0 + i * stride; if (L < 0 || L >= n) return false; u.pm = L >> 2; u.pn = L & 3; u.z = 0; return true; }
};
template <class Epi, class Sched, bool ALIGN_EPI>
__device__ __forceinline__ void gemm_phase(LAS unsigned char* lds, const Gemm g, const Sched& S, const Epi& E, const int wid) {
    const int lane = lane_id_opaque(), tid = wid * 64 + lane, wr = wid >> 2, wc = wid & 3, fr = lane & 15, fq = lane >> 4;
    const int K = g.K, nt = K / BK;
    unsigned voffA[2], voffB[2];
#pragma unroll
    for (int i = 0; i < 2; ++i) { int R, C; stage_rc(tid * 16 + i * 8192, R, C); const int Rb = (R & ~31) + perm32(R & 31);
        voffA[i] = (unsigned)(R * g.lda + C) * 2u; voffB[i] = (unsigned)(Rb * g.ldb + C) * 2u; }
    const size_t kstep = (size_t)(BK * 2);
    const size_t hstepA = (size_t)HALF * g.lda * 2, hstepB = (size_t)HALF * g.ldb * 2;
    const size_t tstepA = 2 * hstepA, tstepB = 2 * hstepB;
    const unsigned ldsw = (unsigned)wid * 1024u;
    const int aoff = lds_byte(wr * 64 + fr, fq * 8), boff = lds_byte(wc * 32 + fr, fq * 8);
#define PG8_SA(b, h) (((b) * 2 + (h)) * HTB)
#define PG8_SB(b, h) ((4 + (b) * 2 + (h)) * HTB)
#define PG8_STAGE(bufoff, gbase, voff) do { _Pragma("unroll") for (int _i = 0; _i < 2; ++_i) \
        __builtin_amdgcn_global_load_lds((const unsigned*)((const char*)(gbase) + (voff)[_i]), (LAS unsigned*)(lds + (bufoff) + ldsw + _i * 8192), 16, 0, 0); } while (0)
#define PG8_LDA(dst, b, h) do { _Pragma("unroll") for (int m = 0; m < 4; ++m) _Pragma("unroll") for (int k = 0; k < 2; ++k) dst[m][k] = *(const LAS bf16x8*)(lds + PG8_SA(b, h) + aoff + m * 2048 + k * 1024); } while (0)
#define PG8_LDB(dst, b, h) do { _Pragma("unroll") for (int n = 0; n < 2; ++n) _Pragma("unroll") for (int k = 0; k < 2; ++k) dst[n][k] = *(const LAS bf16x8*)(lds + PG8_SB(b, h) + boff + n * 2048 + k * 1024); } while (0)
#define PG8_MMA(ai, bj, At, Bt) do { __builtin_amdgcn_s_setprio(1); _Pragma("unroll") for (int m = 0; m < 4; ++m) _Pragma("unroll") for (int n = 0; n < 2; ++n) _Pragma("unroll") for (int k = 0; k < 2; ++k) \
        acc[ai][bj][m][n] = __builtin_amdgcn_mfma_f32_16x16x32_bf16(Bt[n][k], At[m][k], acc[ai][bj][m][n], 0, 0, 0); __builtin_amdgcn_s_setprio(0); } while (0)
#define PG8_WAIT_V(n) asm volatile("s_waitcnt vmcnt(" #n ")" ::: "memory")
#define PG8_WAIT_L(n) asm volatile("s_waitcnt lgkmcnt(" #n ")" ::: "memory")
#define PG8_BAR __builtin_amdgcn_s_barrier()
#define PG8_SCHED __builtin_amdgcn_sched_barrier(0)
    Unit cur, nxt; int ui = 0;
    if (!S.next(0, cur)) return;
    f32x4 acc[2][2][4][2];
#pragma unroll
    for (int a = 0; a < 2; ++a)
#pragma unroll
        for (int b = 0; b < 2; ++b)
#pragma unroll
            for (int m = 0; m < 4; ++m)
#pragma unroll
                for (int n = 0; n < 2; ++n) acc[a][b][m][n] = (f32x4){0.f, 0.f, 0.f, 0.f};
    bf16x8 At[4][2], B0[2][2], B1[2][2];
    const char* cA = (const char*)g.A + (size_t)cur.z * g.zA + (size_t)cur.pm * tstepA; const char* cB = (const char*)g.Bt + (size_t)cur.z * g.zB + (size_t)cur.pn * tstepB;
    PG8_STAGE(PG8_SB(0, 0), cB, voffB); PG8_STAGE(PG8_SB(0, 1), cB + hstepB, voffB); PG8_STAGE(PG8_SA(0, 0), cA, voffA); PG8_STAGE(PG8_SA(0, 1), cA + hstepA, voffA);
    if (wr == 1) PG8_BAR;
    PG8_WAIT_V(2); PG8_BAR;
    PG8_STAGE(PG8_SB(1, 0), cB + kstep, voffB); PG8_STAGE(PG8_SA(1, 0), cA + kstep, voffA); PG8_STAGE(PG8_SB(1, 1), cB + hstepB + kstep, voffB);
    PG8_WAIT_V(6); PG8_BAR;
    for (;;) {
        const bool has_next = S.next(ui + 1, nxt);
        const char* nA = has_next ? (const char*)g.A + (size_t)nxt.z * g.zA + (size_t)nxt.pm * tstepA : cA;
        const char* nB = has_next ? (const char*)g.Bt + (size_t)nxt.z * g.zB + (size_t)nxt.pn * tstepB : cB;
        for (int t = 0; t < nt; t += 2) {
            const bool last = (t == nt - 2);
            const char* a1 = cA + (size_t)(t + 1) * kstep;
            const char* a2 = last ? nA : cA + (size_t)(t + 2) * kstep; const char* b2 = last ? nB : cB + (size_t)(t + 2) * kstep;
            const char* a3 = a2 + kstep; const char* b3 = b2 + kstep;
            PG8_LDB(B0, 0, 0); PG8_LDB(B1, 0, 1); PG8_SCHED; PG8_LDA(At, 0, 0); PG8_STAGE(PG8_SA(1, 1), a1 + hstepA, voffA);
            PG8_WAIT_V(8); PG8_WAIT_L(0); PG8_BAR; PG8_MMA(0, 0, At, B0); PG8_MMA(0, 1, At, B1); PG8_BAR; PG8_SCHED;
            PG8_LDA(At, 0, 1); PG8_STAGE(PG8_SB(0, 0), b2, voffB); PG8_STAGE(PG8_SB(0, 1), b2 + hstepB, voffB); PG8_STAGE(PG8_SA(0, 0), a2, voffA);
            PG8_WAIT_V(8); PG8_WAIT_L(0); PG8_BAR; PG8_MMA(1, 0, At, B0); PG8_MMA(1, 1, At, B1); PG8_BAR; PG8_SCHED;
            PG8_LDB(B0, 1, 0); PG8_LDB(B1, 1, 1); PG8_SCHED; PG8_LDA(At, 1, 0); PG8_STAGE(PG8_SA(0, 1), a2 + hstepA, voffA);
            PG8_WAIT_V(8); PG8_WAIT_L(0); PG8_BAR; PG8_MMA(0, 0, At, B0); PG8_MMA(0, 1, At, B1); PG8_BAR; PG8_SCHED;
            PG8_LDA(At, 1, 1); PG8_STAGE(PG8_SB(1, 0), b3, voffB); PG8_STAGE(PG8_SB(1, 1), b3 + hstepB, voffB); PG8_STAGE(PG8_SA(1, 0), a3, voffA);
            PG8_WAIT_V(8); PG8_WAIT_L(0); PG8_BAR; PG8_MMA(1, 0, At, B0); PG8_MMA(1, 1, At, B1); PG8_BAR; PG8_SCHED;
        }
        if constexpr (ALIGN_EPI) { if (wr == 0) PG8_BAR; }
        if constexpr (!Epi::AFTER_DRAIN) E(acc, cur, wr, wc, fr, fq);
        if (!has_next) break;
#pragma unroll
        for (int a = 0; a < 2; ++a)
#pragma unroll
            for (int b = 0; b < 2; ++b)
#pragma unroll
                for (int m = 0; m < 4; ++m)
#pragma unroll
                    for (int n = 0; n < 2; ++n) acc[a][b][m][n] = (f32x4){0.f, 0.f, 0.f, 0.f};
        cur = nxt; cA = nA; cB = nB; ++ui;
        if constexpr (ALIGN_EPI) { if (wr == 1) PG8_BAR; }
    }
    PG8_WAIT_V(0);
    if constexpr (!ALIGN_EPI) { if (wr == 0) PG8_BAR; }
    PG8_BAR;
    if constexpr (Epi::AFTER_DRAIN) E.fused(acc, cur, wr, wc, lds, wid);
#undef PG8_SA
#undef PG8_SB
#undef PG8_STAGE
#undef PG8_LDA
#undef PG8_LDB
#undef PG8_MMA
#undef PG8_WAIT_V
#undef PG8_WAIT_L
#undef PG8_BAR
#undef PG8_SCHED
}

#define EPI_FOR_ROWS _Pragma("unroll") for (int ai = 0; ai < 2; ++ai) _Pragma("unroll") for (int m = 0; m < 4; ++m)
#define EPI_ROWDEF const int rit = ai * HALF + wr * 64 + m * 16 + fr; const int row = u.pm * BM + rit; (void)rit; (void)row;

struct Epi1 {
    static constexpr bool AFTER_DRAIN = false;
    const float* rinv; const float* qnw; const float* knw; const float2* rope;
    bf16_t *Q, *Kb, *Vb, *GA, *GS, *UCAT; LAS float* xch; int pn0;
    __device__ __forceinline__ void operator()(const f32x4 (&acc)[2][2][4][2], const Unit& u, int wr, int wc, int, int) const {
        const int l_ = lane_id_opaque(), fr = l_ & 15, fq = l_ >> 4;
        const int pn = u.pn + pn0;
        if (pn <= 4) {
            float ss[2][4];
            EPI_FOR_ROWS { EPI_ROWDEF const float r = rinv[row]; float s = 0.f;
#pragma unroll
                for (int bj = 0; bj < 2; ++bj)
#pragma unroll
                    for (int n = 0; n < 2; ++n) { const f32x4 v = acc[ai][bj][m][n] * r; s += (v[0] * v[0] + v[1] * v[1]) + (v[2] * v[2] + v[3] * v[3]); }
                s += swz_xor<16>(s); s = sum_xor32(s); ss[ai][m] = s;
                if (fq == 0) xch[wc * 256 + rit] = s; }
            LDS_WAIT(); __builtin_amdgcn_s_barrier(); asm volatile("" ::: "memory");
            const int half = wc & 1, hd = wc >> 1;
            const float* nw = (pn < 4 ? qnw : knw) + 64 * half + 8 * fq;
            float w1[8], w2[8];
#pragma unroll
            for (int i = 0; i < 8; ++i) { w1[i] = nw[i]; w2[i] = nw[32 + i]; }
            EPI_FOR_ROWS { EPI_ROWDEF const float tot = ss[ai][m] + xch[(wc ^ 1) * 256 + rit];
                const float sc = rinv[row] * rsqrtf(tot * (1.f / 128.f) + EPS);
                const int t = row & (SEQ - 1); const int pos = half ? (t & 63) : (t >> 6);
                const float2* rp = rope + pos * 32 + 8 * fq;
                float o1[8], o2[8];
#pragma unroll
                for (int n = 0; n < 2; ++n)
#pragma unroll
                    for (int e = 0; e < 4; ++e) { const int i = 4 * n + e; const float2 cs = rp[i];
                        const float x1 = acc[ai][0][m][n][e] * sc * w1[i], x2 = acc[ai][1][m][n][e] * sc * w2[i];
                        o1[i] = x1 * cs.x - x2 * cs.y; o2[i] = x2 * cs.x + x1 * cs.y; }
                bf16_t* dst = (pn < 4) ? Q + (size_t)row * DATT + (2 * pn + hd) * 128 + 64 * half + 8 * fq : Kb + (size_t)row * DKV + hd * 128 + 64 * half + 8 * fq;
                u32x4 a; a.x = pk2(o1[0], o1[1]); a.y = pk2(o1[2], o1[3]); a.z = pk2(o1[4], o1[5]); a.w = pk2(o1[6], o1[7]);
                u32x4 b; b.x = pk2(o2[0], o2[1]); b.y = pk2(o2[2], o2[3]); b.z = pk2(o2[4], o2[5]); b.w = pk2(o2[6], o2[7]);
                *(u32x4*)dst = a; *(u32x4*)(dst + 32) = b; }
        } else {
            const int lg0 = 4 * (wc >> 1) + 2 * (wc & 1);
            EPI_FOR_ROWS { EPI_ROWDEF const float r = rinv[row];
#pragma unroll
                for (int bj = 0; bj < 2; ++bj) { const int L = 256 * pn + 32 * (lg0 + bj) + 8 * fq;
                    f32x4 v0 = acc[ai][bj][m][0] * r, v1 = acc[ai][bj][m][1] * r; bf16_t* dst;
                    if (pn == 5) dst = Vb + (size_t)row * DKV + (L - 1280);
                    else if (pn < 10) dst = GA + (size_t)row * DATT + (L - 1536);
                    else if (pn < 14) { const int Lu = L - 2560; dst = UCAT + ((size_t)(Lu >> 4) * NCH + (row >> 4)) * 512 + (row & 15) * 16 + (Lu & 15); }
                    else dst = GS + (size_t)row * DSSM + (L - 3584);
                    if ((pn >= 6 && pn < 10) || pn >= 14) {
#pragma unroll
                        for (int e = 0; e < 4; ++e) { v0[e] = siluf_(v0[e]); v1[e] = siluf_(v1[e]); } }
                    u32x4 w; w.x = pk2(v0[0], v0[1]); w.y = pk2(v0[2], v0[3]); w.z = pk2(v1[0], v1[1]); w.w = pk2(v1[2], v1[3]);
                    *(u32x4*)dst = w; } }
        }
    }
};
struct EpiS1 {
    static constexpr bool AFTER_DRAIN = true;
    const float* lb16; bf16_t* UCAT;
    __device__ __forceinline__ void operator()(const f32x4 (&)[2][2][4][2], const Unit&, int, int, int, int) const {}
    __device__ __forceinline__ void fused(const f32x4 (&acc)[2][2][4][2], const Unit& u, int wr, int wc, LAS unsigned char* lds, int wid) const {
        const int l_ = lane_id_opaque(), fr = l_ & 15, fq = l_ >> 4;
        LAS float* Tl = (LAS float*)lds;
#pragma unroll
        for (int d = 0; d < 2; ++d) {
            EPI_FOR_ROWS { const int rit = ai * HALF + wr * 64 + m * 16 + fr; LAS float* rp = Tl + rit * 128 + wc * 32 + 8 * fq;
                *(LAS f32x4*)rp = acc[ai][d][m][0]; *(LAS f32x4*)(rp + 4) = acc[ai][d][m][1]; }
            LDS_WAIT(); __builtin_amdgcn_s_barrier(); asm volatile("" ::: "memory");
            {
                const int p = l_; const float lr = lb16[((u.z * 2 + d) * 64 + p) * 2], li = lb16[((u.z * 2 + d) * 64 + p) * 2 + 1];
                LAS float* SEG = (LAS float*)(lds + XCH_OFF);
                float xr = 0.f, xi = 0.f;
#pragma unroll 8
                for (int i = 0; i < 32; ++i) { const int cc = wid * 32 + i, c = d ? 255 - cc : cc;
                    const float sr = Tl[c * 128 + p], si = Tl[c * 128 + 64 + p];
                    Tl[c * 128 + p] = xr; Tl[c * 128 + 64 + p] = xi;
                    const float nr = lr * xr - li * xi + sr; xi = lr * xi + li * xr + si; xr = nr; }
                SEG[(wid * 64 + p) * 2] = xr; SEG[(wid * 64 + p) * 2 + 1] = xi;
                LDS_WAIT(); __builtin_amdgcn_s_barrier(); asm volatile("" ::: "memory");
                float l32r = lr, l32i = li;
#pragma unroll
                for (int q = 0; q < 5; ++q) { const float t = l32r * l32r - l32i * l32i; l32i = 2.f * l32r * l32i; l32r = t; }
                float er = 0.f, ei = 0.f;
                for (int j = 0; j < wid; ++j) { const float tr = SEG[(j * 64 + p) * 2], ti = SEG[(j * 64 + p) * 2 + 1];
                    const float nr = l32r * er - l32i * ei + tr; ei = l32r * ei + l32i * er + ti; er = nr; }
#pragma unroll 8
                for (int i = 0; i < 32; ++i) { const int cc = wid * 32 + i, c = d ? 255 - cc : cc;
                    const float tr = Tl[c * 128 + p] + er, ti = Tl[c * 128 + 64 + p] + ei;
                    Tl[c * 128 + p] = __uint_as_float(pk2(tr, ti));
                    const float nr = lr * er - li * ei; ei = lr * ei + li * er; er = nr; }
            }
            LDS_WAIT(); __builtin_amdgcn_s_barrier(); asm volatile("" ::: "memory");
            {   bf16_t* ub = UCAT + ((size_t)u.z * NCH + u.pm * 256) * 512 + 256 + d * 128;
#pragma unroll
                for (int i = 0; i < 8; ++i) { const int q = wid * 64 + l_ + 512 * i, r = q >> 4, c8 = (q & 15) * 8;
                    *(u32x4*)(ub + (size_t)r * 512 + c8) = *(const LAS u32x4*)((LAS bf16_t*)(Tl + r * 128) + c8); } }
            LDS_WAIT(); __builtin_amdgcn_s_barrier(); asm volatile("" ::: "memory");
        }
    }
};
struct EpiS2 {
    static constexpr bool AFTER_DRAIN = false;
    bf16_t* YS;
    __device__ __forceinline__ void operator()(const f32x4 (&acc)[2][2][4][2], const Unit& u, int wr, int wc, int, int) const {
        const int l_ = lane_id_opaque(), fr = l_ & 15, fq = l_ >> 4;
        EPI_FOR_ROWS { EPI_ROWDEF
#pragma unroll
            for (int bj = 0; bj < 2; ++bj) { const int c = bj * HALF + wc * 32 + 8 * fq; const int j = c >> 4, h0 = c & 15;
                const f32x4 v0 = acc[ai][bj][m][0], v1 = acc[ai][bj][m][1];
                u32x4 w; w.x = pk2(gelu_tanh(v0[0]), gelu_tanh(v0[1])); w.y = pk2(gelu_tanh(v0[2]), gelu_tanh(v0[3])); w.z = pk2(gelu_tanh(v1[0]), gelu_tanh(v1[1])); w.w = pk2(gelu_tanh(v1[2]), gelu_tanh(v1[3]));
                *(u32x4*)(YS + ((size_t)row * 16 + j) * DSSM + u.z * 16 + h0) = w; } }
    }
};
struct EpiGlu {
    static constexpr bool AFTER_DRAIN = false;
    const float* bglu; const bf16_t* GS; bf16_t* YMIX;
    __device__ __forceinline__ void operator()(const f32x4 (&acc)[2][2][4][2], const Unit& u, int wr, int wc, int, int) const {
        const int l_ = lane_id_opaque(), fr = l_ & 15, fq = l_ >> 4;
        const int a0 = 128 * u.pn + 32 * wc + 8 * fq;
        float bv[8], bg[8];
#pragma unroll
        for (int i = 0; i < 8; ++i) { bv[i] = bglu[a0 + i]; bg[i] = bglu[1024 + a0 + i]; }
        u32x4 gsv[2][4];
        EPI_FOR_ROWS { EPI_ROWDEF gsv[ai][m] = *(const u32x4*)(GS + (size_t)row * DSSM + a0); }
        EPI_FOR_ROWS { EPI_ROWDEF const u32x4 gs = gsv[ai][m];
            float o[8];
#pragma unroll
            for (int n = 0; n < 2; ++n)
#pragma unroll
                for (int e = 0; e < 4; ++e) { const int i = 4 * n + e; o[i] = (acc[ai][0][m][n][e] + bv[i]) * sigmoidf_(acc[ai][1][m][n][e] + bg[i]); }
            o[0] *= bflo(gs.x); o[1] *= bfhi(gs.x); o[2] *= bflo(gs.y); o[3] *= bfhi(gs.y); o[4] *= bflo(gs.z); o[5] *= bfhi(gs.z); o[6] *= bflo(gs.w); o[7] *= bfhi(gs.w);
            u32x4 w; w.x = pk2(o[0], o[1]); w.y = pk2(o[2], o[3]); w.z = pk2(o[4], o[5]); w.w = pk2(o[6], o[7]);
            *(u32x4*)(YMIX + (size_t)row * DM + 1024 + a0) = w; }
    }
};
struct EpiBf {
    static constexpr bool AFTER_DRAIN = false;
    bf16_t* O; int ldc;
    __device__ __forceinline__ void operator()(const f32x4 (&acc)[2][2][4][2], const Unit& u, int wr, int wc, int, int) const {
        const int l_ = lane_id_opaque(), fr = l_ & 15, fq = l_ >> 4;
        EPI_FOR_ROWS { EPI_ROWDEF
#pragma unroll
            for (int bj = 0; bj < 2; ++bj) { const f32x4 v0 = acc[ai][bj][m][0], v1 = acc[ai][bj][m][1];
                u32x4 w; w.x = pk2(v0[0], v0[1]); w.y = pk2(v0[2], v0[3]); w.z = pk2(v1[0], v1[1]); w.w = pk2(v1[2], v1[3]);
                *(u32x4*)(O + (size_t)row * ldc + u.pn * BM + bj * HALF + wc * 32 + 8 * fq) = w; } }
    }
};
struct EpiOut {
    static constexpr bool AFTER_DRAIN = false;
    const float* x; float* H; bf16_t* HB; float* ssq;
    __device__ __forceinline__ void operator()(const f32x4 (&acc)[2][2][4][2], const Unit& u, int wr, int wc, int, int) const {
        const int l_ = lane_id_opaque(), fr = l_ & 15, fq = l_ >> 4;
#pragma unroll
        for (int ai = 0; ai < 2; ++ai) {
            f32x4 xv[4][2][2];
#pragma unroll
            for (int m = 0; m < 4; ++m) { EPI_ROWDEF
#pragma unroll
                for (int bj = 0; bj < 2; ++bj) { const size_t off = (size_t)row * DM + u.pn * BM + bj * HALF + wc * 32 + 8 * fq; xv[m][bj][0] = *(const f32x4*)(x + off); xv[m][bj][1] = *(const f32x4*)(x + off + 4); } }
#pragma unroll
            for (int m = 0; m < 4; ++m) { EPI_ROWDEF float s = 0.f;
#pragma unroll
                for (int bj = 0; bj < 2; ++bj) { const size_t off = (size_t)row * DM + u.pn * BM + bj * HALF + wc * 32 + 8 * fq;
                    const f32x4 v0 = acc[ai][bj][m][0] + xv[m][bj][0], v1 = acc[ai][bj][m][1] + xv[m][bj][1];
                    *(f32x4*)(H + off) = v0; *(f32x4*)(H + off + 4) = v1;
                    s += (v0[0] * v0[0] + v0[1] * v0[1]) + (v0[2] * v0[2] + v0[3] * v0[3]) + (v1[0] * v1[0] + v1[1] * v1[1]) + (v1[2] * v1[2] + v1[3] * v1[3]);
                    u32x4 w; w.x = pk2(v0[0], v0[1]); w.y = pk2(v0[2], v0[3]); w.z = pk2(v1[0], v1[1]); w.w = pk2(v1[2], v1[3]);
                    *(u32x4*)(HB + off) = w; }
                s += swz_xor<16>(s); s = sum_xor32(s);
                if (fq == 0) ssq[(size_t)row * 32 + u.pn * 4 + wc] = s; }
        }
    }
};
struct EpiGate {
    static constexpr bool AFTER_DRAIN = true;
    float* H; const bf16_t* PP; float* ssq; unsigned* cnt; const float* nf; const LAS float* r2;
    __device__ __forceinline__ void operator()(const f32x4 (&)[2][2][4][2], const Unit&, int, int, int, int) const {}
    __device__ __forceinline__ void fused(f32x4 (&acc)[2][2][4][2], const Unit& u, int wr, int wc, LAS unsigned char* lds, int wid) const {
        const int l_ = lane_id_opaque(), fr = l_ & 15, fq = l_ >> 4, tid = wid * 64 + l_;
        LAS float* P = (LAS float*)lds; LAS float* Rn = P + 1024;
        EPI_FOR_ROWS { EPI_ROWDEF float s = 0.f; const float r = r2[rit];
#pragma unroll
            for (int bj = 0; bj < 2; ++bj) { const size_t off = (size_t)row * DM + u.pn * BM + bj * HALF + wc * 32 + 8 * fq;
                const u32x4 pp = *(const u32x4*)(PP + off);
                f32x4 h0 = *(const f32x4*)(H + off), h1 = *(const f32x4*)(H + off + 4);
                const f32x4 a0 = acc[ai][bj][m][0] * r, a1 = acc[ai][bj][m][1] * r;
                h0[0] += sigmoidf_(a0[0]) * bflo(pp.x); h0[1] += sigmoidf_(a0[1]) * bfhi(pp.x); h0[2] += sigmoidf_(a0[2]) * bflo(pp.y); h0[3] += sigmoidf_(a0[3]) * bfhi(pp.y);
                h1[0] += sigmoidf_(a1[0]) * bflo(pp.z); h1[1] += sigmoidf_(a1[1]) * bfhi(pp.z); h1[2] += sigmoidf_(a1[2]) * bflo(pp.w); h1[3] += sigmoidf_(a1[3]) * bfhi(pp.w);
                acc[ai][bj][m][0] = h0; acc[ai][bj][m][1] = h1;
                s += (h0[0] * h0[0] + h0[1] * h0[1]) + (h0[2] * h0[2] + h0[3] * h0[3]) + (h1[0] * h1[0] + h1[1] * h1[1]) + (h1[2] * h1[2] + h1[3] * h1[3]); }
            s += swz_xor<16>(s); s = sum_xor32(s);
            if (fq == 0) P[rit * 4 + wc] = s; }
        LDS_WAIT(); __builtin_amdgcn_s_barrier(); asm volatile("" ::: "memory");
        if (tid < 256) { const float t = (P[tid * 4] + P[tid * 4 + 1]) + (P[tid * 4 + 2] + P[tid * 4 + 3]);
            __hip_atomic_store(ssq + (size_t)(u.pm * 256 + tid) * 8 + u.pn, t, __ATOMIC_RELAXED, __HIP_MEMORY_SCOPE_AGENT); }
        asm volatile("s_waitcnt vmcnt(0)" ::: "memory");
        if (wid < 4 && l_ == 0) __hip_atomic_fetch_add(cnt + 64 * u.pm, 1u, __ATOMIC_RELAXED, __HIP_MEMORY_SCOPE_AGENT);
        if (wid == 0) {
            unsigned sp = 0;
            while ((unsigned)__builtin_amdgcn_readfirstlane(__hip_atomic_load(cnt + 64 * u.pm, __ATOMIC_RELAXED, __HIP_MEMORY_SCOPE_AGENT)) < 32u) { __builtin_amdgcn_s_sleep(2); if (++sp > (1u << 22)) break; }
            __builtin_amdgcn_fence(__ATOMIC_ACQUIRE, "agent");
        }
        asm volatile("s_waitcnt vmcnt(0) lgkmcnt(0)" ::: "memory"); __builtin_amdgcn_s_barrier(); asm volatile("" ::: "memory");
        if (tid < 256) { const float* sp = ssq + (size_t)(u.pm * 256 + tid) * 8; float t = 0.f;
#pragma unroll
            for (int i = 0; i < 8; ++i) t += __hip_atomic_load(sp + i, __ATOMIC_RELAXED, __HIP_MEMORY_SCOPE_AGENT);
            Rn[tid] = rsqrtf(t * (1.f / DM) + EPS); }
        LDS_WAIT(); __builtin_amdgcn_s_barrier(); asm volatile("" ::: "memory");
        EPI_FOR_ROWS { EPI_ROWDEF const float rn = Rn[rit];
#pragma unroll
            for (int bj = 0; bj < 2; ++bj) { const int col = u.pn * BM + bj * HALF + wc * 32 + 8 * fq; const size_t off = (size_t)row * DM + col;
                *(f32x4*)(H + off) = acc[ai][bj][m][0] * rn * *(const f32x4*)(nf + col); *(f32x4*)(H + off + 4) = acc[ai][bj][m][1] * rn * *(const f32x4*)(nf + col + 4); } }
    }
};
}

namespace att {
constexpr int D = 128, NW = 8, QBLK = 32, KVBLK = 64;
constexpr float SCALE = 0.088388347648318440f;
constexpr float THR = 8.f;
constexpr int LDQ = DATT, LDK = DKV;
constexpr size_t SHM_V = KVBLK * D * 2, SHM_K = KVBLK * D * 2, SHM_ATTN = 2 * SHM_V + 2 * SHM_K + NW * 64 * 4;
#define KSWZ(row, colB) ((row) * 256 + ((colB) ^ (((row) & 7) << 4)))
#define SBAR() __builtin_amdgcn_sched_barrier(0)
__device__ __forceinline__ int crow(int r, int hi) { return (r & 3) + 8 * (r >> 2) + 4 * hi; }
__device__ __forceinline__ void partialSM(f32x16& p0, f32x16& p1, float& m_reg, float& mn, float& alpha) {
  constexpr float C = SCALE * 1.4426950408889634f;
  float pmax = p0[0]; for (int r = 1; r < 16; ++r) pmax = fmaxf(pmax, p0[r]); for (int r = 0; r < 16; ++r) pmax = fmaxf(pmax, p1[r]);
  { auto rr = __builtin_amdgcn_permlane32_swap(__float_as_uint(pmax), __float_as_uint(pmax), false, false);
    pmax = fmaxf(__uint_as_float(rr[0]), __uint_as_float(rr[1])); }
  if (__builtin_expect(__all(pmax - m_reg <= THR / SCALE), 1)) { mn = m_reg; alpha = 1.f; }
  else { mn = fmaxf(m_reg, pmax); alpha = __builtin_amdgcn_exp2f((m_reg - mn) * C); m_reg = mn; }
  float mnC = -mn * C;
  for (int r = 0; r < 16; ++r) p0[r] = fmaf(p0[r], C, mnC); for (int r = 0; r < 16; ++r) p1[r] = fmaf(p1[r], C, mnC);
  for (int r = 0; r < 16; ++r) p0[r] = __builtin_amdgcn_exp2f(p0[r]);
}
__device__ __forceinline__ void finishSM(f32x16& p0, f32x16& p1, float alpha, float& l_reg, bf16x8& pa0, bf16x8& pa1, bf16x8& pa2, bf16x8& pa3) {
  for (int r = 0; r < 16; ++r) p1[r] = __builtin_amdgcn_exp2f(p1[r]);
  float ps = 0; for (int r = 0; r < 16; ++r) ps += p0[r]; for (int r = 0; r < 16; ++r) ps += p1[r];
  { auto rr = __builtin_amdgcn_permlane32_swap(__float_as_uint(ps), __float_as_uint(ps), false, false);
    ps = __uint_as_float(rr[0]) + __uint_as_float(rr[1]); }
  l_reg = l_reg * alpha + ps;
#define PK4(P, BASE, OUT) do { unsigned a0 = cvt_pk_bf16(P[BASE + 0], P[BASE + 1]), a1 = cvt_pk_bf16(P[BASE + 2], P[BASE + 3]);   \
    unsigned b0 = cvt_pk_bf16(P[BASE + 4], P[BASE + 5]), b1 = cvt_pk_bf16(P[BASE + 6], P[BASE + 7]);                              \
    auto r0 = __builtin_amdgcn_permlane32_swap(a0, b0, false, false); auto r1 = __builtin_amdgcn_permlane32_swap(a1, b1, false, false); \
    u32x4 w = {r0[0], r1[0], r0[1], r1[1]}; OUT = *reinterpret_cast<bf16x8*>(&w); } while (0)
  PK4(p0, 0, pa0); PK4(p0, 8, pa1); PK4(p1, 0, pa2); PK4(p1, 8, pa3);
#undef PK4
}
__device__ __forceinline__ void qkt(f32x16& p0, f32x16& p1, const bf16_t* Ks, const bf16x8* qr, int r32, int hi) {
  p0 = f32x16{}; p1 = f32x16{};
  for (int d0 = 0; d0 < 8; ++d0) { int cb = (d0 * 16 + hi * 8) * 2;
    bf16x8 b0 = *reinterpret_cast<const bf16x8*>((const char*)Ks + KSWZ(r32, cb));
    bf16x8 b1 = *reinterpret_cast<const bf16x8*>((const char*)Ks + KSWZ(32 + r32, cb));
    p0 = __builtin_amdgcn_mfma_f32_32x32x16_bf16(b0, qr[d0], p0, 0, 0, 0);
    p1 = __builtin_amdgcn_mfma_f32_32x32x16_bf16(b1, qr[d0], p1, 0, 0, 0); }
}
__device__ __forceinline__ int v_st(int k, int c) { const int kk = (k & ~0xC) | ((k & 4) << 1) | ((k & 8) >> 1); return ((kk >> 3) * 4 + (c >> 5)) * 512 + ((kk & 7) * 32 + (c & 31)) * 2; }
__device__ __forceinline__ int v_rd_base(int lane) { return ((lane & 3) << 3) | (((lane >> 2) & 3) << 6) | (((lane >> 4) & 1) << 5) | (((lane >> 5) & 1) << 8); }
constexpr int v_rd_off(int d0, int ks, int half) { return d0 * 512 + ks * 4096 + half * 2048; }
template <int OFF> __device__ __forceinline__ s16x4 tr_read(int vb) {
  s16x4 r; asm volatile("ds_read_b64_tr_b16 %0, %1 offset:%2" : "=&v"(r) : "v"(vb), "i"(OFF) : "memory"); return r;
}
template <int D0> __device__ __forceinline__ void pv_one(f32x16& od, int vb, bf16x8 pa0, bf16x8 pa1, bf16x8 pa2, bf16x8 pa3) {
  const s16x4 l0 = tr_read<v_rd_off(D0, 0, 0)>(vb), h0 = tr_read<v_rd_off(D0, 0, 1)>(vb), l1 = tr_read<v_rd_off(D0, 1, 0)>(vb), h1 = tr_read<v_rd_off(D0, 1, 1)>(vb);
  const s16x4 l2 = tr_read<v_rd_off(D0, 2, 0)>(vb), h2 = tr_read<v_rd_off(D0, 2, 1)>(vb), l3 = tr_read<v_rd_off(D0, 3, 0)>(vb), h3 = tr_read<v_rd_off(D0, 3, 1)>(vb);
  asm volatile("s_waitcnt lgkmcnt(0)" ::: "memory"); SBAR();
#define PK(L, H) (bf16x8){L[0], L[1], L[2], L[3], H[0], H[1], H[2], H[3]}
  od = __builtin_amdgcn_mfma_f32_32x32x16_bf16(pa0, PK(l0, h0), od, 0, 0, 0);
  od = __builtin_amdgcn_mfma_f32_32x32x16_bf16(pa1, PK(l1, h1), od, 0, 0, 0);
  od = __builtin_amdgcn_mfma_f32_32x32x16_bf16(pa2, PK(l2, h2), od, 0, 0, 0);
  od = __builtin_amdgcn_mfma_f32_32x32x16_bf16(pa3, PK(l3, h3), od, 0, 0, 0);
#undef PK
}
__device__ __forceinline__ void pv_d0(f32x16* o, int vb, bf16x8 pa0, bf16x8 pa1, bf16x8 pa2, bf16x8 pa3) {
  pv_one<0>(o[0], vb, pa0, pa1, pa2, pa3); pv_one<1>(o[1], vb, pa0, pa1, pa2, pa3); pv_one<2>(o[2], vb, pa0, pa1, pa2, pa3); pv_one<3>(o[3], vb, pa0, pa1, pa2, pa3);
}
__device__ __forceinline__ void attn_dense_body(const bf16_t* __restrict__ Qb, const bf16_t* __restrict__ Kh, const bf16_t* __restrict__ Vh,
                                                const bf16_t* __restrict__ Gb, bf16_t* __restrict__ Yb, int seq, char* lds, const int wid) {
  const int lane = lane_id_opaque(), tid = wid * 64 + lane, r32 = lane & 31, hi = lane >> 5;
  bf16_t* V_lds = (bf16_t*)lds; bf16_t* K_lds = (bf16_t*)(lds + 2 * SHM_V);
  float* ws = (float*)(lds + 2 * SHM_V + 2 * SHM_K) + wid * 64; float* li_l = ws; float* al_l = ws + 32;
  float m_reg = -1e30f, l_reg = 0; f32x16 o[4] = {}; bf16x8 qr[8];
  const bf16_t* Qw = Qb + (long)(wid * QBLK + r32) * LDQ + hi * 8;
#pragma unroll
  for (int d0 = 0; d0 < 8; ++d0) qr[d0] = *reinterpret_cast<const bf16x8*>(Qw + d0 * 16);
  const int sr = tid >> 4, sc = (tid & 15) * 8, vst0 = v_st(sr, sc), vst1 = v_st(32 + sr, sc);
  const int vb0 = (int)(uintptr_t)V_lds + v_rd_base(lane);
  struct { bf16x8 vs0, vs1, ks0, ks1; } sr_[2];
#define SLOAD(i, k0) do { sr_[i].vs0 = *reinterpret_cast<const bf16x8*>(&Vh[(long)((k0) + sr) * LDK + sc]); sr_[i].vs1 = *reinterpret_cast<const bf16x8*>(&Vh[(long)((k0) + 32 + sr) * LDK + sc]); \
    sr_[i].ks0 = *reinterpret_cast<const bf16x8*>(&Kh[(long)((k0) + sr) * LDK + sc]); sr_[i].ks1 = *reinterpret_cast<const bf16x8*>(&Kh[(long)((k0) + 32 + sr) * LDK + sc]); } while (0)
#define SWRITE(b, i) do { *(bf16x8*)((char*)V_lds + (b) * SHM_V + vst0) = sr_[i].vs0;          \
    *(bf16x8*)((char*)V_lds + (b) * SHM_V + vst1) = sr_[i].vs1; int kc = sc * 2;               \
    *(bf16x8*)((char*)K_lds + (b) * SHM_K + KSWZ(sr, kc)) = sr_[i].ks0;                       \
    *(bf16x8*)((char*)K_lds + (b) * SHM_K + KSWZ(32 + sr, kc)) = sr_[i].ks1; } while (0)
#define SWAIT() asm volatile("s_waitcnt vmcnt(4)" ::: "memory")
#define RESC(a) do { if (__any((a) < 1.f)) { if (hi == 0) al_l[r32] = (a); asm volatile("s_waitcnt lgkmcnt(0)" ::: "memory"); \
    for (int d = 0; d < 4; ++d) for (int r = 0; r < 16; ++r) o[d][r] *= al_l[crow(r, hi)]; } } while (0)
  f32x16 pA0, pA1, pB0, pB1; float mnA, mnB, alA, alB; bf16x8 pa0, pa1, pa2, pa3; const int NT = seq / KVBLK;
  constexpr int SE = 0, SO = 1;
  SLOAD(SE, 0); asm volatile("s_waitcnt vmcnt(0)" ::: "memory"); SWRITE(0, SE); __syncthreads();
  qkt(pA0, pA1, K_lds, qr, r32, hi); partialSM(pA0, pA1, m_reg, mnA, alA);
  SLOAD(SO, KVBLK); if (2 < NT) SLOAD(SE, 2 * KVBLK);
  SWAIT(); SWRITE(1, SO); __syncthreads();
  for (int j = 1; j + 1 < NT; j += 2) {
    SBAR(); qkt(pB0, pB1, (bf16_t*)((char*)K_lds + SHM_K), qr, r32, hi);
    finishSM(pA0, pA1, alA, l_reg, pa0, pa1, pa2, pa3); SBAR();
    SLOAD(SO, (j + 2) * KVBLK); SBAR();
    pv_d0(o, vb0, pa0, pa1, pa2, pa3); partialSM(pB0, pB1, m_reg, mnB, alB);
    __syncthreads(); SWAIT(); SWRITE(0, SE);
    RESC(alB); __syncthreads();
    SBAR(); qkt(pA0, pA1, K_lds, qr, r32, hi);
    finishSM(pB0, pB1, alB, l_reg, pa0, pa1, pa2, pa3); SBAR();
    if (j + 3 < NT) SLOAD(SE, (j + 3) * KVBLK); SBAR();
    pv_d0(o, vb0 + (int)SHM_V, pa0, pa1, pa2, pa3); partialSM(pA0, pA1, m_reg, mnA, alA);
    __syncthreads(); SWAIT(); SWRITE(1, SO);
    RESC(alA); __syncthreads();
  }
  SBAR(); qkt(pB0, pB1, (bf16_t*)((char*)K_lds + SHM_K), qr, r32, hi);
  finishSM(pA0, pA1, alA, l_reg, pa0, pa1, pa2, pa3); SBAR();
  pv_d0(o, vb0, pa0, pa1, pa2, pa3); partialSM(pB0, pB1, m_reg, mnB, alB);
  __syncthreads(); RESC(alB);
  finishSM(pB0, pB1, alB, l_reg, pa0, pa1, pa2, pa3); SBAR();
  pv_d0(o, vb0 + (int)SHM_V, pa0, pa1, pa2, pa3);
  if (hi == 0) li_l[r32] = l_reg; asm volatile("s_waitcnt lgkmcnt(0)" ::: "memory");
  float rli[16];
#pragma unroll
  for (int r = 0; r < 16; ++r) rli[r] = __builtin_amdgcn_rcpf(li_l[crow(r, hi)]);
  bf16_t* Yw = Yb + (long)(wid * QBLK) * DM; const bf16_t* Gw = Gb + (long)(wid * QBLK) * DATT;
  __syncthreads();
  bf16_t* stg = (bf16_t*)(lds + wid * 8192);
#pragma unroll
  for (int r = 0; r < 16; ++r) { const int orow = crow(r, hi);
#pragma unroll
    for (int d0 = 0; d0 < 4; ++d0) stg[orow * 128 + d0 * 32 + r32] = (bf16_t)f2bf(o[d0][r] * rli[r]); }
  asm volatile("s_waitcnt lgkmcnt(0)" ::: "memory");
  const int l2 = lane_id_opaque();
#pragma unroll
  for (int i = 0; i < 8; ++i) { const int q = l2 + 64 * i, row = q >> 4, c8 = (q & 15) * 8;
    const u32x4 v = *(const u32x4*)(stg + row * 128 + c8); const u32x4 gg = *(const u32x4*)(Gw + (unsigned)(row * DATT + c8));
    u32x4 w; w.x = pk2(bflo(v.x) * bflo(gg.x), bfhi(v.x) * bfhi(gg.x)); w.y = pk2(bflo(v.y) * bflo(gg.y), bfhi(v.y) * bfhi(gg.y));
    w.z = pk2(bflo(v.z) * bflo(gg.z), bfhi(v.z) * bfhi(gg.z)); w.w = pk2(bflo(v.w) * bflo(gg.w), bfhi(v.w) * bfhi(gg.w));
    *(u32x4*)(Yw + (unsigned)(row * DM + c8)) = w; }
  __syncthreads();
#undef SLOAD
#undef SWRITE
#undef SWAIT
#undef RESC
}
#undef SBAR
}

__device__ __forceinline__ void p0_transpose_item(const float* W, int K, int N, bf16_t* WT, int wt_row0, const float* kscale, LAS float* scr, int k0, int n0, int lane) {
#pragma unroll
    for (int i = 0; i < 32; ++i) { const int kk = 2 * i + (lane >> 5); float v = W[(size_t)(k0 + kk) * N + n0 + (lane & 31)]; if (kscale) v *= kscale[k0 + kk]; scr[kk * 33 + (lane & 31)] = v; }
    LDS_WAIT(); asm volatile("" ::: "memory");
    const int c = lane & 7;
#pragma unroll
    for (int j = 0; j < 4; ++j) { const int n = (lane >> 3) + 8 * j; const LAS float* s = scr + (8 * c) * 33 + n;
        u32x4 o; o.x = pk2(s[0 * 33], s[1 * 33]); o.y = pk2(s[2 * 33], s[3 * 33]); o.z = pk2(s[4 * 33], s[5 * 33]); o.w = pk2(s[6 * 33], s[7 * 33]);
        *(u32x4*)(WT + (size_t)(wt_row0 + n) * K + k0 + 8 * c) = o; }
    LDS_WAIT(); asm volatile("" ::: "memory");
}

struct TrItem { const float* W; bf16_t* WT; const float* kscale; int K, N, wt_row0, k0, n0; };
__device__ __forceinline__ void p0_tr_load(const TrItem& d, float (&v)[32], int lane) {
#pragma unroll
    for (int i = 0; i < 32; ++i) { const int kk = 2 * i + (lane >> 5); v[i] = d.W[(size_t)(d.k0 + kk) * d.N + d.n0 + (lane & 31)]; }
    if (d.kscale) {
#pragma unroll
        for (int i = 0; i < 32; ++i) { const int kk = 2 * i + (lane >> 5); v[i] *= d.kscale[d.k0 + kk]; } }
}
__device__ __forceinline__ void p0_tr_store(const TrItem& d, const float (&v)[32], LAS float* scr, int lane) {
#pragma unroll
    for (int i = 0; i < 32; ++i) { const int kk = 2 * i + (lane >> 5); scr[kk * 33 + (lane & 31)] = v[i]; }
    LDS_WAIT(); asm volatile("" ::: "memory");
    const int c = lane & 7;
#pragma unroll
    for (int j = 0; j < 4; ++j) { const int n = (lane >> 3) + 8 * j; const LAS float* s = scr + (8 * c) * 33 + n;
        u32x4 o; o.x = pk2(s[0 * 33], s[1 * 33]); o.y = pk2(s[2 * 33], s[3 * 33]); o.z = pk2(s[4 * 33], s[5 * 33]); o.w = pk2(s[6 * 33], s[7 * 33]);
        *(u32x4*)(d.WT + (size_t)(d.wt_row0 + n) * d.K + d.k0 + 8 * c) = o; }
    LDS_WAIT(); asm volatile("" ::: "memory");
}
__device__ __forceinline__ void ssm_tables(const Args& a, int g, LAS unsigned char* lds, int tid) {
    LAS float* LD = (LAS float*)lds;
    LAS float* LBs = LD + 256;
    LAS float* BB = LBs + 256;
    LAS float* KT = BB + 4096;
    LAS float* CC = KT + 8192;
    float* lb16 = (float*)(a.ws + WS_LB16);
    bf16_t* WIN = (bf16_t*)(a.ws + WS_WIN) + (size_t)g * 256 * 256;
    bf16_t* WBIG = (bf16_t*)(a.ws + WS_WBIG) + (size_t)g * 256 * 512;
    for (int e = tid; e < 2048; e += 512) { const int d = e >> 10, r = e & 1023; const size_t ci_ = (size_t)(d * NG + g) * 1024 + r; CC[e * 2] = a.c_re[ci_]; CC[e * 2 + 1] = a.c_im[ci_]; }
    if (tid < 128) {
        const int d = tid >> 6, p = tid & 63; const int idx = (d * NG + g) * 64 + p;
        const float lr = fminf(a.a_re[idx], -1e-4f), li = a.a_im[idx];
        const float dt = expf(a.log_dt[d * NG + g]);
        const float er = expf(lr * dt); float sn, cs; sincosf(li * dt, &sn, &cs);
        const float br = er * cs, bi = er * sn;
        LD[tid * 2] = lr * dt; LD[tid * 2 + 1] = li * dt; LBs[tid * 2] = br; LBs[tid * 2 + 1] = bi;
        const float nr = br - 1.f, ni = bi, den = lr * lr + li * li;
        KT[tid * 2] = (nr * lr + ni * li) / den; KT[tid * 2 + 1] = (ni * lr - nr * li) / den;
        const float e16 = expf(16.f * lr * dt); float s16, c16; sincosf(16.f * li * dt, &s16, &c16);
        lb16[(g * 128 + tid) * 2] = e16 * c16; lb16[(g * 128 + tid) * 2 + 1] = e16 * s16;
    }
    __syncthreads();
    for (int e = tid; e < 2048; e += 512) {
        const int dp = e >> 4, h = e & 15, d = dp >> 6, p = dp & 63;
        const size_t bi_ = ((size_t)(d * NG + g) * 64 + p) * 16 + h;
        const float xr = a.b_re[bi_], xi = a.b_im[bi_], cr = KT[dp * 2], ci = KT[dp * 2 + 1];
        BB[e * 2] = cr * xr - ci * xi; BB[e * 2 + 1] = cr * xi + ci * xr;
    }
    __syncthreads();
    {
        const int d = tid >> 8, hp = (tid >> 4) & 15, h = tid & 15; float acc[16];
#pragma unroll
        for (int t = 0; t < 16; ++t) acc[t] = 0.f;
        const LAS float* cc = CC + ((d * 16 + hp) * 64) * 2;
        for (int p = 0; p < 64; ++p) {
            const float c_r = cc[p * 2], c_i = cc[p * 2 + 1], b_r = BB[((d * 64 + p) * 16 + h) * 2], b_i = BB[((d * 64 + p) * 16 + h) * 2 + 1];
            float wr = c_r * b_r - c_i * b_i, wi = c_r * b_i + c_i * b_r; const float l_r = LBs[(d * 64 + p) * 2], l_i = LBs[(d * 64 + p) * 2 + 1];
#pragma unroll
            for (int t = 0; t < 16; ++t) { acc[t] += wr; const float nr = wr * l_r - wi * l_i; wi = wr * l_i + wi * l_r; wr = nr; }
        }
#pragma unroll
        for (int t = 0; t < 16; ++t) KT[((d * 16 + t) * 16 + hp) * 16 + h] = acc[t];
    }
    __syncthreads();
    for (int q = tid; q < 8192; q += 512) {
        const int n = q >> 5, kc = q & 31, s = kc >> 1, h0 = (kc & 1) * 8, j = n >> 4, hp = n & 15;
        float v[8];
#pragma unroll
        for (int e = 0; e < 8; ++e) { const int h = h0 + e;
            if (s < j) v[e] = KT[((0 * 16 + (j - s)) * 16 + hp) * 16 + h];
            else if (s > j) v[e] = KT[((1 * 16 + (s - j)) * 16 + hp) * 16 + h];
            else v[e] = KT[((0 * 16 + 0) * 16 + hp) * 16 + h] + KT[((1 * 16 + 0) * 16 + hp) * 16 + h] + (h == hp ? a.ssm_d[g * 16 + h] : 0.f); }
        u32x4 w; w.x = pk2(v[0], v[1]); w.y = pk2(v[2], v[3]); w.z = pk2(v[4], v[5]); w.w = pk2(v[6], v[7]);
        *(u32x4*)(WBIG + (size_t)n * 512 + s * 16 + h0) = w;
    }
    for (int q = tid; q < 2048; q += 512) {
        const int p = q & 63, js = (q >> 6) & 15, d = q >> 10; const float ldr = LD[(d * 64 + p) * 2], ldi = LD[(d * 64 + p) * 2 + 1];
        {   const float pw = (float)(d == 0 ? js + 1 : 16 - js); const float er = expf(pw * ldr); float sn, cs; sincosf(pw * ldi, &sn, &cs); const float pr = er * cs, pi = er * sn;
#pragma unroll
            for (int hp = 0; hp < 16; ++hp) { const float c_r = CC[((d * 16 + hp) * 64 + p) * 2], c_i = CC[((d * 16 + hp) * 64 + p) * 2 + 1];
                *(unsigned*)(WBIG + (size_t)(js * 16 + hp) * 512 + 256 + d * 128 + 2 * p) = pk2(c_r * pr - c_i * pi, -(c_r * pi + c_i * pr)); } }
        {   const float pw = (float)(d == 0 ? 15 - js : js); const float er = expf(pw * ldr); float sn, cs; sincosf(pw * ldi, &sn, &cs); const float pr = er * cs, pi = er * sn;
            float zr[16], zi[16];
#pragma unroll
            for (int h = 0; h < 16; ++h) { const float b_r = BB[((d * 64 + p) * 16 + h) * 2], b_i = BB[((d * 64 + p) * 16 + h) * 2 + 1]; zr[h] = pr * b_r - pi * b_i; zi[h] = pr * b_i + pi * b_r; }
            bf16_t* d0 = WIN + (size_t)(d * 128 + p) * 256 + js * 16; bf16_t* d1 = d0 + (size_t)64 * 256;
            u32x4 w; w.x = pk2(zr[0], zr[1]); w.y = pk2(zr[2], zr[3]); w.z = pk2(zr[4], zr[5]); w.w = pk2(zr[6], zr[7]); *(u32x4*)d0 = w;
            w.x = pk2(zr[8], zr[9]); w.y = pk2(zr[10], zr[11]); w.z = pk2(zr[12], zr[13]); w.w = pk2(zr[14], zr[15]); *(u32x4*)(d0 + 8) = w;
            w.x = pk2(zi[0], zi[1]); w.y = pk2(zi[2], zi[3]); w.z = pk2(zi[4], zi[5]); w.w = pk2(zi[6], zi[7]); *(u32x4*)d1 = w;
            w.x = pk2(zi[8], zi[9]); w.y = pk2(zi[10], zi[11]); w.z = pk2(zi[12], zi[13]); w.w = pk2(zi[14], zi[15]); *(u32x4*)(d1 + 8) = w; }
    }
    __syncthreads();
}

#define XB_TMO      128
#define XB_XCNT(j)  (256  + 64 * (j))
#define XB_XSUB(j)  (1280 + 64 * (j))
#define XB_XGEN(j)  (2304 + 64 * (j))
#define XB_TOP      3328
#define XB_TOPGEN   3392
#define XCD_BAR_WORDS 3456
#define XB_SPIN_CAP (1u << 18)
__device__ __forceinline__ unsigned xb_ld(unsigned* p)              { return __hip_atomic_load(p, __ATOMIC_RELAXED, __HIP_MEMORY_SCOPE_AGENT); }
__device__ __forceinline__ unsigned xb_add(unsigned* p, unsigned v) { return __hip_atomic_fetch_add(p, v, __ATOMIC_RELAXED, __HIP_MEMORY_SCOPE_AGENT); }
__device__ __forceinline__ unsigned xb_xcc_id() { return (unsigned)__builtin_amdgcn_s_getreg((3 << 11) | 20) & 0xFu; }
#define XB_SPIN(cond, bar) do { unsigned _sp = 0; while (cond) { __builtin_amdgcn_s_sleep(1); \
    if ((++_sp & 255u) == 0u) { if (xb_ld(&(bar)[XB_TMO])) break; if (_sp > XB_SPIN_CAP) { atomicAdd(&(bar)[XB_TMO], 1u); break; } } } } while (0)
struct XcdBarrier { unsigned* bar; unsigned x; volatile LAS unsigned* st; };
__device__ __forceinline__ XcdBarrier xcd_barrier_post(unsigned* bar, volatile LAS unsigned* st, bool leader) {
    XcdBarrier b; b.bar = bar; b.x = xb_xcc_id(); b.st = st;
    if (leader) (void)xb_add(&bar[XB_XCNT(b.x)], 1u);
    return b;
}
__device__ __forceinline__ void xcd_barrier_complete(unsigned* bar, unsigned x, unsigned& nloc, unsigned& nx) {
    const unsigned G = gridDim.x * gridDim.y * gridDim.z;
    unsigned sum, cnt, mine, sp = 0u;
    for (;;) {
        sum = 0u; cnt = 0u; mine = 0u;
#pragma unroll
        for (unsigned j = 0; j < 16; ++j) { const unsigned c = xb_ld(&bar[XB_XCNT(j)]); sum += c; cnt += (c > 0u) ? 1u : 0u; mine = (j == x) ? c : mine; }
        if (sum == G) break;
        __builtin_amdgcn_s_sleep(1);
        if ((++sp & 255u) == 0u) { if (xb_ld(&bar[XB_TMO])) break; if (sp > XB_SPIN_CAP) { atomicAdd(&bar[XB_TMO], 1u); break; } }
    }
    nloc = mine > 0u ? mine : 1u; nx = cnt > 0u ? cnt : 1u;
}
__device__ __forceinline__ void xcd_barrier(const XcdBarrier& b, bool leader) {
    asm volatile("s_waitcnt vmcnt(0)" ::: "memory");
    __syncthreads();
    if (leader) {
        unsigned* bar = b.bar;
        __builtin_amdgcn_s_waitcnt(0);
        unsigned nloc = b.st[0], nx = b.st[1];
        if (nloc == 0u) { xcd_barrier_complete(bar, b.x, nloc, nx); b.st[0] = nloc; b.st[1] = nx; }
        const unsigned old = xb_add(&bar[XB_XSUB(b.x)], 1u);
        const unsigned gen = old / nloc;
        if (old + 1u == (gen + 1u) * nloc) {
            __builtin_amdgcn_fence(__ATOMIC_RELEASE, "agent");
            asm volatile("s_waitcnt vmcnt(0)" ::: "memory");
            const unsigned og = xb_add(&bar[XB_TOP], 1u);
            const unsigned tg = og / nx;
            if (og + 1u == (tg + 1u) * nx) xb_add(&bar[XB_TOPGEN], 1u);
            else XB_SPIN(xb_ld(&bar[XB_TOPGEN]) == tg, bar);
            __builtin_amdgcn_fence(__ATOMIC_ACQUIRE, "agent");
            xb_add(&bar[XB_XGEN(b.x)], 1u);
            asm volatile("s_waitcnt vmcnt(0)" ::: "memory");
        } else {
            XB_SPIN(xb_ld(&bar[XB_XGEN(b.x)]) == gen, bar);
            __builtin_amdgcn_fence(__ATOMIC_ACQUIRE, "agent");
            asm volatile("s_waitcnt vmcnt(0)" ::: "memory");
        }
    }
    __syncthreads();
}

__global__ void __launch_bounds__(512, 2) fwd_kernel(Args a) {
    extern __shared__ __attribute__((aligned(16))) unsigned char lds_raw[];
    LAS unsigned char* lds = (LAS unsigned char*)lds_raw;
    cg::grid_group grid = cg::this_grid();
    const int wave = __builtin_amdgcn_readfirstlane(threadIdx.x >> 6);
    const bool leader = (wave == 0) && (lane_id_opaque() == 0);
    volatile LAS unsigned* xst = (volatile LAS unsigned*)(lds + XBST_OFF);
    if (leader) { xst[0] = 0u; xst[1] = 0u; }
    __syncthreads();
    if (a.ws == nullptr) grid.sync();
    const XcdBarrier xbar = xcd_barrier_post((unsigned*)(a.ws + WS_BAR), xst, leader);
#define GRID_SYNC() xcd_barrier(xbar, (wave == 0) && (lane_id_opaque() == 0))
#define LANE_IDS const int lane = lane_id_opaque(), tid = wave * 64 + lane; (void)tid;
    const int G = gridDim.x, bid = blockIdx.x;
    unsigned char* ws = a.ws;
    bf16_t* W1T = (bf16_t*)(ws + WS_W1T); bf16_t* WGLUT = (bf16_t*)(ws + WS_WGLUT); bf16_t* WOT = (bf16_t*)(ws + WS_WOT); bf16_t* WGT = (bf16_t*)(ws + WS_WGT); bf16_t* WPT = (bf16_t*)(ws + WS_WPT);
    float2* ROPE = (float2*)(ws + WS_ROPE); float* RINV = (float*)(ws + WS_RINV); float* LB16 = (float*)(ws + WS_LB16); float* SSQ1 = (float*)(ws + WS_SSQ1); float* SSQ2 = (float*)(ws + WS_SSQ2);
    bf16_t* PB = (bf16_t*)(ws + WS_PB); bf16_t* WIN = (bf16_t*)(ws + WS_WIN); bf16_t* WBIG = (bf16_t*)(ws + WS_WBIG);
    bf16_t* XB = (bf16_t*)(ws + WS_XB); bf16_t* HB = (bf16_t*)(ws + WS_XB);
    bf16_t* Q = (bf16_t*)(ws + WS_Q); bf16_t* KB = (bf16_t*)(ws + WS_K); bf16_t* VB = (bf16_t*)(ws + WS_V); bf16_t* GA = (bf16_t*)(ws + WS_GA); bf16_t* GS = (bf16_t*)(ws + WS_GS);
    bf16_t* UCAT = (bf16_t*)(ws + WS_UCAT); bf16_t* PPB = (bf16_t*)(ws + WS_UCAT); bf16_t* YMIX = (bf16_t*)(ws + WS_YMIX); bf16_t* YS = (bf16_t*)(ws + WS_YS);

#pragma unroll
    for (int rep_ = 0; rep_ < 1 + ((REP_MASK >> 0) & 1); ++rep_) { LANE_IDS
        const int gw = bid * 8 + wave, NGW = G * 8;
        LAS float* scr = (LAS float*)(lds + wave * 16384);
        constexpr int I1 = 32 * 144, I2 = 16 * 64, I3 = 32 * 64, I4 = 32 * 64, I5 = 4 * 64, NIT = I1 + I2 + I3 + I4 + I5;
        auto item_desc = [&](int r) -> TrItem {
            if (r < I1) { const int kb = r / 144, lgg = r % 144, pn = lgg >> 3, lg = lgg & 7, wtg = pn * 8 + 4 * (lg & 1) + 2 * (lg >> 2) + ((lg >> 1) & 1);
                return TrItem{a.w_in, W1T, a.norm_mix, DM, DIN, wtg * 32, kb * 64, lgg * 32}; } r -= I1;
            if (r < I2) { const int kb = r / 64, lgg = r % 64, l2 = lgg & 31, wtg = (l2 >> 2) * 8 + 4 * (lgg >> 5) + (l2 & 3);
                return TrItem{a.w_glu, WGLUT, nullptr, DSSM, 2 * DSSM, wtg * 32, kb * 64, lgg * 32}; } r -= I2;
            if (r < I3) { const int kb = r / 64, lgg = r % 64; return TrItem{a.w_out, WOT, nullptr, DM, DM, lgg * 32, kb * 64, lgg * 32}; } r -= I3;
            if (r < I4) { const int kb = r / 64, lgg = r % 64; return TrItem{a.w_ple_gate, WGT, a.norm_ple, DM, DM, lgg * 32, kb * 64, lgg * 32}; } r -= I4;
            const int kb = r / 64, lgg = r % 64; return TrItem{a.w_ple_proj, WPT, nullptr, PLE, DM, lgg * 32, kb * 64, lgg * 32};
        };
#pragma unroll
        for (int rq_ = 0; rq_ < 1 + ((REP_MASK >> 8) & 1); ++rq_)
        for (int it = gw; it < NIT; it += 2 * NGW) {
            const bool two = it + NGW < NIT;
            const TrItem dA = item_desc(it), dB = item_desc(two ? it + NGW : it);
            float vA[32], vB[32];
            p0_tr_load(dA, vA, lane); if (two) p0_tr_load(dB, vB, lane);
            p0_tr_store(dA, vA, scr, lane); if (two) p0_tr_store(dB, vB, scr, lane);
        }
#pragma unroll
        for (int rq_ = 0; rq_ < 1 + ((REP_MASK >> 9) & 1); ++rq_)
        for (int m = gw; m < T; m += 2 * NGW) {
            const int m2 = m + NGW; const bool two = m2 < T;
            const f32x4* xr = (const f32x4*)(a.x + (size_t)m * DM) + lane; const f32x4* xr2 = (const f32x4*)(a.x + (size_t)(two ? m2 : m) * DM) + lane;
            f32x4 v[8], w2[8]; float s = 0.f, s2 = 0.f;
#pragma unroll
            for (int j = 0; j < 8; ++j) v[j] = xr[64 * j];
#pragma unroll
            for (int j = 0; j < 8; ++j) w2[j] = xr2[64 * j];
#pragma unroll
            for (int j = 0; j < 8; ++j) { s += (v[j][0] * v[j][0] + v[j][1] * v[j][1]) + (v[j][2] * v[j][2] + v[j][3] * v[j][3]); s2 += (w2[j][0] * w2[j][0] + w2[j][1] * w2[j][1]) + (w2[j][2] * w2[j][2] + w2[j][3] * w2[j][3]); }
            s = wave_sum(s); s2 = wave_sum(s2);
            if (lane == 0) { RINV[m] = rsqrtf(s * (1.f / DM) + EPS); if (two) RINV[m2] = rsqrtf(s2 * (1.f / DM) + EPS); }
            u32x2* o = (u32x2*)(XB + (size_t)m * DM) + lane; u32x2* o2 = (u32x2*)(XB + (size_t)m2 * DM) + lane;
#pragma unroll
            for (int j = 0; j < 8; ++j) { u32x2 w; w.x = pk2(v[j][0], v[j][1]); w.y = pk2(v[j][2], v[j][3]); o[64 * j] = w; }
            if (two) {
#pragma unroll
                for (int j = 0; j < 8; ++j) { u32x2 w; w.x = pk2(w2[j][0], w2[j][1]); w.y = pk2(w2[j][2], w2[j][3]); o2[64 * j] = w; } }
        }
        for (int i = bid * 512 + tid; i < T * PLE / 4; i += G * 512) { const f32x4 v = ((const f32x4*)a.p)[i]; u32x2 w; w.x = pk2(v[0], v[1]); w.y = pk2(v[2], v[3]); ((u32x2*)PB)[i] = w; }
        for (int i = bid * 512 + tid; i < 2048; i += G * 512) { const int pos = i >> 5, f = i & 31; const float inv = powf(10000.f, -(float)f / 32.f); float sn, cs; sincosf((float)pos * inv, &sn, &cs); ROPE[i] = make_float2(cs, sn); }
    GRID_SYNC(); }


    if constexpr ((REP_MASK >> 10) & 1) { GRID_SYNC(); GRID_SYNC(); GRID_SYNC(); GRID_SYNC(); }
#pragma unroll
    for (int rep_ = 0; rep_ < 1 + ((REP_MASK >> 1) & 1); ++rep_) { LANE_IDS
        { pg8::Gemm g{XB, W1T, DM, DM, DM, 0, 0}; pg8::StaticOrder S; S.init(T, 14 * 256, G, bid);
          pg8::Epi1 E{RINV, a.q_norm, a.k_norm, ROPE, Q, KB, VB, GA, GS, UCAT, (LAS float*)(lds + XCH_OFF), 0};
          pg8::gemm_phase<pg8::Epi1, pg8::StaticOrder, true>(lds, g, S, E, wave); }
        __syncthreads();
        for (int gi = bid - (G - NG); gi >= 0 && gi < NG; gi += NG) ssm_tables(a, gi, lds, tid);
    GRID_SYNC(); }

#pragma unroll
    for (int rep_ = 0; rep_ < 1 + ((REP_MASK >> 2) & 1); ++rep_) {
#pragma unroll
        for (int rq_ = 0; rq_ < 2; ++rq_) {
        if (bid < 2 * NG) { if (rq_ == 1 && !((REP_MASK >> 6) & 1)) break;
            pg8::BatchOrder S{2 * NG, G, bid};
            { pg8::Gemm g{UCAT, WIN, 256, 512, 256, (size_t)NCH * 512 * 2, (size_t)256 * 256 * 2};
              pg8::EpiS1 E{LB16, UCAT}; pg8::gemm_phase<pg8::EpiS1, pg8::BatchOrder, false>(lds, g, S, E, wave); }
            asm volatile("s_waitcnt vmcnt(0)\n\tbuffer_inv sc1\n\ts_waitcnt vmcnt(0)" ::: "memory"); __syncthreads();
            { pg8::Gemm g{UCAT, WBIG, 512, 512, 512, (size_t)NCH * 512 * 2, (size_t)256 * 512 * 2};
              pg8::EpiS2 E{YS}; pg8::gemm_phase<pg8::EpiS2, pg8::BatchOrder, false>(lds, g, S, E, wave); }
        } else { if (rq_ == 1 && !((REP_MASK >> 11) & 1)) break;
            pg8::Gemm g{XB, W1T + (size_t)14 * 256 * DM, DM, DM, DM, 0, 0}; pg8::ListOrder S{bid - 2 * NG, 128, G};
            pg8::Epi1 E{RINV, a.q_norm, a.k_norm, ROPE, Q, KB, VB, GA, GS, UCAT, (LAS float*)(lds + XCH_OFF), 14};
            pg8::gemm_phase<pg8::Epi1, pg8::ListOrder, true>(lds, g, S, E, wave);
        }
        __syncthreads(); }
#pragma unroll
        for (int rq_ = 0; rq_ < 1 + ((REP_MASK >> 7) & 1); ++rq_)
        for (int un = bid; un < 256; un += G) {
            const int x = un & 7, jj = un >> 3, b = x >> 2, kvh = (x >> 1) & 1, idx = (x & 1) * 32 + jj, h = kvh * 4 + (idx >> 4), qb = idx & 15;
            const size_t tok0 = (size_t)b * SEQ + qb * 256;
            att::attn_dense_body(Q + tok0 * DATT + h * 128, KB + (size_t)b * SEQ * DKV + kvh * 128, VB + (size_t)b * SEQ * DKV + kvh * 128,
                                 GA + tok0 * DATT + h * 128, YMIX + tok0 * DM + h * 128, SEQ, (char*)lds_raw, wave);
        }
    GRID_SYNC(); }

#pragma unroll
    for (int rep_ = 0; rep_ < 1 + ((REP_MASK >> 3) & 1); ++rep_) {
        { pg8::Gemm g{YS, WGLUT, DSSM, DSSM, DSSM, 0, 0}; pg8::StaticOrder S; S.init(T, 2 * DSSM, G, bid);
          pg8::EpiGlu E{a.b_glu, GS, YMIX}; pg8::gemm_phase<pg8::EpiGlu, pg8::StaticOrder, false>(lds, g, S, E, wave); }
        __syncthreads();
        { pg8::Gemm g{PB, WPT, PLE, PLE, PLE, 0, 0}; pg8::StaticOrder S; S.init(T, DM, G, bid);
          pg8::EpiBf E{PPB, DM}; pg8::gemm_phase<pg8::EpiBf, pg8::StaticOrder, false>(lds, g, S, E, wave); }
    GRID_SYNC(); }


#pragma unroll
    for (int rep_ = 0; rep_ < 1 + ((REP_MASK >> 4) & 1); ++rep_) {
        pg8::Gemm g{YMIX, WOT, DM, DM, DM, 0, 0}; pg8::StaticOrder S; S.init(T, DM, G, bid);
        pg8::EpiOut E{a.x, a.out, HB, SSQ1}; pg8::gemm_phase<pg8::EpiOut, pg8::StaticOrder, false>(lds, g, S, E, wave);
    GRID_SYNC(); }


    { LANE_IDS
        pg8::StaticOrder S; S.init(T, DM, G, bid); pg8::Unit u0;
        LAS float* r2 = (LAS float*)(lds + R2_OFF);
        if (S.next(0, u0) && tid < 256) { const float* sp = SSQ1 + (size_t)(u0.pm * 256 + tid) * 32; float s = 0.f;
#pragma unroll
            for (int i = 0; i < 8; ++i) { const f32x4 v = ((const f32x4*)sp)[i]; s += (v[0] + v[1]) + (v[2] + v[3]); }
            r2[tid] = rsqrtf(s * (1.f / DM) + EPS); }
        __syncthreads();
        pg8::Gemm g{HB, WGT, DM, DM, DM, 0, 0};
        pg8::EpiGate E{a.out, PPB, SSQ2, (unsigned*)ws, a.norm_final, r2}; pg8::gemm_phase<pg8::EpiGate, pg8::StaticOrder, false>(lds, g, S, E, wave);
    }
}

extern "C" void kernel_launch(void* const* d_in, const int* in_sizes, int n_in, void* d_out, int out_size, void* d_ws, size_t ws_size, hipStream_t stream) {
    static int grid = 0;
    if (grid == 0) {
        if (n_in != 21 || in_sizes[0] != T * DM || out_size != T * DM || ws_size < WS_END) { fprintf(stderr, "kernel_launch: unexpected shapes (n_in %d, in0 %d, out %d, ws %zu)\n", n_in, n_in > 0 ? in_sizes[0] : -1, out_size, ws_size); grid = -1; return; }
        int dev = 0, cus = 0, per_cu = 0;
        hipGetDevice(&dev); hipDeviceGetAttribute(&cus, hipDeviceAttributeMultiprocessorCount, dev);
        if (hipFuncSetAttribute((const void*)fwd_kernel, hipFuncAttributeMaxDynamicSharedMemorySize, LDS_BYTES) != hipSuccess) { fprintf(stderr, "kernel_launch: hipFuncSetAttribute failed\n"); grid = -1; return; }
        hipOccupancyMaxActiveBlocksPerMultiprocessor(&per_cu, (const void*)fwd_kernel, 512, LDS_BYTES);
        (void)hipGetLastError();
        if (per_cu < 1) fprintf(stderr, "kernel_launch: occupancy query reports %d blocks per CU\n", per_cu);
        grid = cus > 256 ? 256 : cus;
    }
    if (grid < 0) return;
    Args a{};
    const float** f = (const float**)&a;
    for (int i = 0; i < 21; ++i) f[i] = (const float*)d_in[i];
    a.out = (float*)d_out; a.ws = (unsigned char*)d_ws;
    if (hipMemsetAsync(d_ws, 0, WS_CTL_BYTES, stream) != hipSuccess) { fprintf(stderr, "kernel_launch: hipMemsetAsync failed\n"); return; }
    void* args[] = {&a};
    hipError_t e = hipLaunchCooperativeKernel((const void*)fwd_kernel, dim3(grid), dim3(512), args, LDS_BYTES, stream);
    if (e != hipSuccess) fprintf(stderr, "kernel_launch: cooperative launch failed: %s (grid %d)\n", hipGetErrorString(e), grid);
}
```

```cpp
#include <hip/hip_runtime.h>
#include <hip/hip_cooperative_groups.h>
#include <cstdio>
#include <cstdint>
namespace cg = cooperative_groups;

#define LAS __attribute__((address_space(3)))
typedef unsigned short bf16_t;
typedef short bf16x8 __attribute__((ext_vector_type(8)));
typedef short s16x4 __attribute__((ext_vector_type(4)));
typedef float f32x4 __attribute__((ext_vector_type(4)));
typedef float f32x16 __attribute__((ext_vector_type(16)));
typedef unsigned u32x4 __attribute__((ext_vector_type(4)));
typedef unsigned u32x2 __attribute__((ext_vector_type(2)));

constexpr int T = 8192, SEQ = 4096, DM = 2048, DIN = 4608, DATT = 1024, DKV = 256, DSSM = 1024, PLE = 256;
constexpr int NG = 64, NCH = T / 16;
constexpr float EPS = 1e-6f;
#ifndef PH_MASK
#define PH_MASK 0xff
#endif
#ifndef REP_MASK
#define REP_MASK 0
#endif

constexpr size_t MiB = 1u << 20;
constexpr size_t WS_W1T = 1 * MiB, WS_WGLUT = 19 * MiB, WS_WOT = 23 * MiB, WS_WGT = 31 * MiB, WS_WPT = 39 * MiB;
constexpr size_t WS_ROPE = 40 * MiB, WS_RINV = 40 * MiB + 65536, WS_LB16 = 40 * MiB + 131072, WS_SSQ1 = 41 * MiB, WS_SSQ2 = 42 * MiB;
constexpr size_t WS_PB = 43 * MiB, WS_WIN = 47 * MiB, WS_WBIG = 55 * MiB;
constexpr size_t WS_XB = 71 * MiB;
constexpr size_t WS_Q = 103 * MiB, WS_K = 119 * MiB, WS_V = 123 * MiB, WS_GA = 127 * MiB, WS_GS = 143 * MiB;
constexpr size_t WS_UCAT = 159 * MiB;
constexpr size_t WS_YMIX = 191 * MiB, WS_YS = 223 * MiB, WS_END = 239 * MiB;

constexpr int RING_BYTES = 131072, XCH_OFF = RING_BYTES, R2_OFF = RING_BYTES + 4096, XBST_OFF = RING_BYTES + 8192, LDS_BYTES = 147456;
constexpr size_t WS_BAR = 65536, WS_CTL_BYTES = 131072;

struct Args {
    const float *x, *p, *norm_mix, *w_in, *q_norm, *k_norm, *a_re, *a_im, *log_dt, *b_re, *b_im, *c_re, *c_im, *ssm_d, *w_glu, *b_glu, *w_out, *norm_ple, *w_ple_gate, *w_ple_proj, *norm_final;
    float* out; unsigned char* ws;
};

__device__ __forceinline__ unsigned f2bf(float f) { unsigned u = __builtin_bit_cast(unsigned, f); return (u + 0x7fffu + ((u >> 16) & 1u)) >> 16; }
__device__ __forceinline__ unsigned pk2(float lo, float hi) { return f2bf(lo) | (f2bf(hi) << 16); }
__device__ __forceinline__ float bf2f(unsigned short b) { return __builtin_bit_cast(float, (unsigned)b << 16); }
__device__ __forceinline__ float bflo(unsigned w) { return __builtin_bit_cast(float, w << 16); }
__device__ __forceinline__ float bfhi(unsigned w) { return __builtin_bit_cast(float, w & 0xffff0000u); }
__device__ __forceinline__ unsigned cvt_pk_bf16(float lo, float hi) { unsigned r; asm volatile("v_cvt_pk_bf16_f32 %0, %1, %2" : "=v"(r) : "v"(lo), "v"(hi)); return r; }
__device__ __forceinline__ float sigmoidf_(float v) { return 1.f / (1.f + __expf(-v)); }
__device__ __forceinline__ float siluf_(float v) { return v / (1.f + __expf(-v)); }
__device__ __forceinline__ float gelu_tanh(float v) { const float t = 1.5957691216057308f * (v + 0.044715f * v * v * v); return v / (1.f + __expf(-t)); }
template <int K> __device__ __forceinline__ float swz_xor(float v) { return __int_as_float(__builtin_amdgcn_ds_swizzle(__float_as_int(v), (K << 10) | 0x1f)); }
__device__ __forceinline__ float sum_xor32(float v) { auto rr = __builtin_amdgcn_permlane32_swap(__float_as_uint(v), __float_as_uint(v), false, false); return __uint_as_float(rr[0]) + __uint_as_float(rr[1]); }
__device__ __forceinline__ float wave_sum(float v) { v += swz_xor<1>(v); v += swz_xor<2>(v); v += swz_xor<4>(v); v += swz_xor<8>(v); v += swz_xor<16>(v); return sum_xor32(v); }
#define LDS_WAIT() asm volatile("s_waitcnt lgkmcnt(0)" ::: "memory")
__device__ __forceinline__ int lane_id_opaque() { int l = __builtin_amdgcn_mbcnt_hi(~0u, __builtin_amdgcn_mbcnt_lo(~0u, 0u)); asm volatile("" : "+v"(l)); return l; }

namespace pg8 {
constexpr int BM = 256, BK = 64, HALF = 128, HTB = HALF * BK * 2, NXCD = 8, WGM = 8;
__host__ __device__ __forceinline__ int lds_byte(int r, int c) { const int st = (r >> 4) * 2 + (c >> 5), rr = r & 15, cc = c & 31, ob = rr * 64 + cc * 2; return st * 1024 + (ob ^ (((ob >> 9) & 1) << 5)); }
__host__ __device__ __forceinline__ void stage_rc(int b, int& R, int& C) { const int st = b / 1024, sb = b % 1024, swz = sb ^ (((sb >> 9) & 1) << 5); R = (st >> 1) * 16 + swz / 64; C = (st & 1) * 32 + (swz % 64) / 2; }
__host__ __device__ __forceinline__ int perm32(int rho) { const int n = rho >> 4, i = rho & 15; return 8 * (i >> 2) + 4 * n + (i & 3); }

struct Unit { int pm, pn, z; };
struct Gemm { const bf16_t* A; const bf16_t* Bt; int K, lda, ldb; size_t zA, zB; };

struct StaticOrder {
    int nM, nN, nwg, G, c;
    __device__ void init(int M, int N, int G_, int c_) { nM = M / BM; nN = N / BM; nwg = nM * nN; G = G_; c = c_; }
    __device__ bool next(int i, Unit& u) const {
        const long L = (long)i * G + c; if (L >= nwg) return false;
        int wgid = (int)L; { const int q = nwg / NXCD, r = nwg % NXCD, xcd = wgid % NXCD, off = wgid / NXCD; wgid = (xcd < r ? xcd * (q + 1) : r * (q + 1) + (xcd - r) * q) + off; }
        const int nig = WGM * nN, gid = wgid / nig, fm = gid * WGM, gsz = (nM - fm) < WGM ? (nM - fm) : WGM;
        u.pm = fm + ((wgid % nig) % gsz); u.pn = (wgid % nig) / gsz; u.z = 0; return true;
    }
};
struct BatchOrder {
    int n, G, c;
    __device__ bool next(int i, Unit& u) const { const int L = i * G + c; if (L >= n) return false; u.z = L >> 1; u.pm = L & 1; u.pn = 0; return true; }
};

struct ListOrder {
    int L0, n, stride;
    __device__ bool next(int i, Unit& u) const { const int L = L0 + i * stride; if (L < 0 || L >= n) return false; u.pm = L >> 2; u.pn = L & 3; u.z = 0; return true; }
};
template <class Epi, class Sched, bool ALIGN_EPI>
__device__ __forceinline__ void gemm_phase(LAS unsigned char* lds, const Gemm g, const Sched& S, const Epi& E, const int wid) {
    const int lane = lane_id_opaque(), tid = wid * 64 + lane, wr = wid >> 2, wc = wid & 3, fr = lane & 15, fq = lane >> 4;
    const int K = g.K, nt = K / BK;
    unsigned voffA[2], voffB[2];
#pragma unroll
    for (int i = 0; i < 2; ++i) { int R, C; stage_rc(tid * 16 + i * 8192, R, C); const int Rb = (R & ~31) + perm32(R & 31);
        voffA[i] = (unsigned)(R * g.lda + C) * 2u; voffB[i] = (unsigned)(Rb * g.ldb + C) * 2u; }
    const size_t kstep = (size_t)(BK * 2);
    const size_t hstepA = (size_t)HALF * g.lda * 2, hstepB = (size_t)HALF * g.ldb * 2;
    const size_t tstepA = 2 * hstepA, tstepB = 2 * hstepB;
    const unsigned ldsw = (unsigned)wid * 1024u;
    const int aoff = lds_byte(wr * 64 + fr, fq * 8), boff = lds_byte(wc * 32 + fr, fq * 8);
#define PG8_SA(b, h) (((b) * 2 + (h)) * HTB)
#define PG8_SB(b, h) ((4 + (b) * 2 + (h)) * HTB)
#define PG8_STAGE(bufoff, gbase, voff) do { _Pragma("unroll") for (int _i = 0; _i < 2; ++_i) \
        __builtin_amdgcn_global_load_lds((const unsigned*)((const char*)(gbase) + (voff)[_i]), (LAS unsigned*)(lds + (bufoff) + ldsw + _i * 8192), 16, 0, 0); } while (0)
#define PG8_LDA(dst, b, h) do { _Pragma("unroll") for (int m = 0; m < 4; ++m) _Pragma("unroll") for (int k = 0; k < 2; ++k) dst[m][k] = *(const LAS bf16x8*)(lds + PG8_SA(b, h) + aoff + m * 2048 + k * 1024); } while (0)
#define PG8_LDB(dst, b, h) do { _Pragma("unroll") for (int n = 0; n < 2; ++n) _Pragma("unroll") for (int k = 0; k < 2; ++k) dst[n][k] = *(const LAS bf16x8*)(lds + PG8_SB(b, h) + boff + n * 2048 + k * 1024); } while (0)
#define PG8_MMA(ai, bj, At, Bt) do { __builtin_amdgcn_s_setprio(1); _Pragma("unroll") for (int m = 0; m < 4; ++m) _Pragma("unroll") for (int n = 0; n < 2; ++n) _Pragma("unroll") for (int k = 0; k < 2; ++k) \
        acc[ai][bj][m][n] = __builtin_amdgcn_mfma_f32_16x16x32_bf16(Bt[n][k], At[m][k], acc[ai][bj][m][n], 0, 0, 0); __builtin_amdgcn_s_setprio(0); } while (0)
#define PG8_WAIT_V(n) asm volatile("s_waitcnt vmcnt(" #n ")" ::: "memory")
#define PG8_WAIT_L(n) asm volatile("s_waitcnt lgkmcnt(" #n ")" ::: "memory")
#define PG8_BAR __builtin_amdgcn_s_barrier()
#define PG8_SCHED __builtin_amdgcn_sched_barrier(0)
    Unit cur, nxt; int ui = 0;
    if (!S.next(0, cur)) return;
    f32x4 acc[2][2][4][2];
#pragma unroll
    for (int a = 0; a < 2; ++a)
#pragma unroll
        for (int b = 0; b < 2; ++b)
#pragma unroll
            for (int m = 0; m < 4; ++m)
#pragma unroll
                for (int n = 0; n < 2; ++n) acc[a][b][m][n] = (f32x4){0.f, 0.f, 0.f, 0.f};
    bf16x8 At[4][2], B0[2][2], B1[2][2];
    const char* cA = (const char*)g.A + (size_t)cur.z * g.zA + (size_t)cur.pm * tstepA; const char* cB = (const char*)g.Bt + (size_t)cur.z * g.zB + (size_t)cur.pn * tstepB;
    PG8_STAGE(PG8_SB(0, 0), cB, voffB); PG8_STAGE(PG8_SB(0, 1), cB + hstepB, voffB); PG8_STAGE(PG8_SA(0, 0), cA, voffA); PG8_STAGE(PG8_SA(0, 1), cA + hstepA, voffA);
    if (wr == 1) PG8_BAR;
    PG8_WAIT_V(2); PG8_BAR;
    PG8_STAGE(PG8_SB(1, 0), cB + kstep, voffB); PG8_STAGE(PG8_SA(1, 0), cA + kstep, voffA); PG8_STAGE(PG8_SB(1, 1), cB + hstepB + kstep, voffB);
    PG8_WAIT_V(6); PG8_BAR;
    for (;;) {
        const bool has_next = S.next(ui + 1, nxt);
        const char* nA = has_next ? (const char*)g.A + (size_t)nxt.z * g.zA + (size_t)nxt.pm * tstepA : cA;
        const char* nB = has_next ? (const char*)g.Bt + (size_t)nxt.z * g.zB + (size_t)nxt.pn * tstepB : cB;
        for (int t = 0; t < nt; t += 2) {
            const bool last = (t == nt - 2);
            const char* a1 = cA + (size_t)(t + 1) * kstep;
            const char* a2 = last ? nA : cA + (size_t)(t + 2) * kstep; const char* b2 = last ? nB : cB + (size_t)(t + 2) * kstep;
            const char* a3 = a2 + kstep; const char* b3 = b2 + kstep;
            PG8_LDB(B0, 0, 0); PG8_LDB(B1, 0, 1); PG8_SCHED; PG8_LDA(At, 0, 0); PG8_STAGE(PG8_SA(1, 1), a1 + hstepA, voffA);
            PG8_WAIT_V(8); PG8_WAIT_L(0); PG8_BAR; PG8_MMA(0, 0, At, B0); PG8_MMA(0, 1, At, B1); PG8_BAR; PG8_SCHED;
            PG8_LDA(At, 0, 1); PG8_STAGE(PG8_SB(0, 0), b2, voffB); PG8_STAGE(PG8_SB(0, 1), b2 + hstepB, voffB); PG8_STAGE(PG8_SA(0, 0), a2, voffA);
            PG8_WAIT_V(8); PG8_WAIT_L(0); PG8_BAR; PG8_MMA(1, 0, At, B0); PG8_MMA(1, 1, At, B1); PG8_BAR; PG8_SCHED;
            PG8_LDB(B0, 1, 0); PG8_LDB(B1, 1, 1); PG8_SCHED; PG8_LDA(At, 1, 0); PG8_STAGE(PG8_SA(0, 1), a2 + hstepA, voffA);
            PG8_WAIT_V(8); PG8_WAIT_L(0); PG8_BAR; PG8_MMA(0, 0, At, B0); PG8_MMA(0, 1, At, B1); PG8_BAR; PG8_SCHED;
            PG8_LDA(At, 1, 1); PG8_STAGE(PG8_SB(1, 0), b3, voffB); PG8_STAGE(PG8_SB(1, 1), b3 + hstepB, voffB); PG8_STAGE(PG8_SA(1, 0), a3, voffA);
            PG8_WAIT_V(8); PG8_WAIT_L(0); PG8_BAR; PG8_MMA(1, 0, At, B0); PG8_MMA(1, 1, At, B1); PG8_BAR; PG8_SCHED;
        }
        if constexpr (ALIGN_EPI) { if (wr == 0) PG8_BAR; }
        if constexpr (!Epi::AFTER_DRAIN) E(acc, cur, wr, wc, fr, fq);
        if (!has_next) break;
#pragma unroll
        for (int a = 0; a < 2; ++a)
#pragma unroll
            for (int b = 0; b < 2; ++b)
#pragma unroll
                for (int m = 0; m < 4; ++m)
#pragma unroll
                    for (int n = 0; n < 2; ++n) acc[a][b][m][n] = (f32x4){0.f, 0.f, 0.f, 0.f};
        cur = nxt; cA = nA; cB = nB; ++ui;
        if constexpr (ALIGN_EPI) { if (wr == 1) PG8_BAR; }
    }
    PG8_WAIT_V(0);
    if constexpr (!ALIGN_EPI) { if (wr == 0) PG8_BAR; }
    PG8_BAR;
    if constexpr (Epi::AFTER_DRAIN) E.fused(acc, cur, wr, wc, lds, wid);
#undef PG8_SA
#undef PG8_SB
#undef PG8_STAGE
#undef PG8_LDA
#undef PG8_LDB
#undef PG8_MMA
#undef PG8_WAIT_V
#undef PG8_WAIT_L
#undef PG8_BAR
#undef PG8_SCHED
}

#define EPI_FOR_ROWS _Pragma("unroll") for (int ai = 0; ai < 2; ++ai) _Pragma("unroll") for (int m = 0; m < 4; ++m)
#define EPI_ROWDEF const int rit = ai * HALF + wr * 64 + m * 16 + fr; const int row = u.pm * BM + rit; (void)rit; (void)row;

struct Epi1 {
    static constexpr bool AFTER_DRAIN = false;
    const float* rinv; const float* qnw; const float* knw; const float2* rope;
    bf16_t *Q, *Kb, *Vb, *GA, *GS, *UCAT; LAS float* xch; int pn0;
    __device__ __forceinline__ void operator()(const f32x4 (&acc)[2][2][4][2], const Unit& u, int wr, int wc, int, int) const {
        const int l_ = lane_id_opaque(), fr = l_ & 15, fq = l_ >> 4;
        const int pn = u.pn + pn0;
        if (pn <= 4) {
            float ss[2][4];
            EPI_FOR_ROWS { EPI_ROWDEF const float r = rinv[row]; float s = 0.f;
#pragma unroll
                for (int bj = 0; bj < 2; ++bj)
#pragma unroll
                    for (int n = 0; n < 2; ++n) { const f32x4 v = acc[ai][bj][m][n] * r; s += (v[0] * v[0] + v[1] * v[1]) + (v[2] * v[2] + v[3] * v[3]); }
                s += swz_xor<16>(s); s = sum_xor32(s); ss[ai][m] = s;
                if (fq == 0) xch[wc * 256 + rit] = s; }
            LDS_WAIT(); __builtin_amdgcn_s_barrier(); asm volatile("" ::: "memory");
            const int half = wc & 1, hd = wc >> 1;
            const float* nw = (pn < 4 ? qnw : knw) + 64 * half + 8 * fq;
            float w1[8], w2[8];
#pragma unroll
            for (int i = 0; i < 8; ++i) { w1[i] = nw[i]; w2[i] = nw[32 + i]; }
            EPI_FOR_ROWS { EPI_ROWDEF const float tot = ss[ai][m] + xch[(wc ^ 1) * 256 + rit];
                const float sc = rinv[row] * rsqrtf(tot * (1.f / 128.f) + EPS);
                const int t = row & (SEQ - 1); const int pos = half ? (t & 63) : (t >> 6);
                const float2* rp = rope + pos * 32 + 8 * fq;
                float o1[8], o2[8];
#pragma unroll
                for (int n = 0; n < 2; ++n)
#pragma unroll
                    for (int e = 0; e < 4; ++e) { const int i = 4 * n + e; const float2 cs = rp[i];
                        const float x1 = acc[ai][0][m][n][e] * sc * w1[i], x2 = acc[ai][1][m][n][e] * sc * w2[i];
                        o1[i] = x1 * cs.x - x2 * cs.y; o2[i] = x2 * cs.x + x1 * cs.y; }
                bf16_t* dst = (pn < 4) ? Q + (size_t)row * DATT + (2 * pn + hd) * 128 + 64 * half + 8 * fq : Kb + (size_t)row * DKV + hd * 128 + 64 * half + 8 * fq;
                u32x4 a; a.x = pk2(o1[0], o1[1]); a.y = pk2(o1[2], o1[3]); a.z = pk2(o1[4], o1[5]); a.w = pk2(o1[6], o1[7]);
                u32x4 b; b.x = pk2(o2[0], o2[1]); b.y = pk2(o2[2], o2[3]); b.z = pk2(o2[4], o2[5]); b.w = pk2(o2[6], o2[7]);
                *(u32x4*)dst = a; *(u32x4*)(dst + 32) = b; }
        } else {
            const int lg0 = 4 * (wc >> 1) + 2 * (wc & 1);
            EPI_FOR_ROWS { EPI_ROWDEF const float r = rinv[row];
#pragma unroll
                for (int bj = 0; bj < 2; ++bj) { const int L = 256 * pn + 32 * (lg0 + bj) + 8 * fq;
                    f32x4 v0 = acc[ai][bj][m][0] * r, v1 = acc[ai][bj][m][1] * r; bf16_t* dst;
                    if (pn == 5) dst = Vb + (size_t)row * DKV + (L - 1280);
                    else if (pn < 10) dst = GA + (size_t)row * DATT + (L - 1536);
                    else if (pn < 14) { const int Lu = L - 2560; dst = UCAT + ((size_t)(Lu >> 4) * NCH + (row >> 4)) * 512 + (row & 15) * 16 + (Lu & 15); }
                    else dst = GS + (size_t)row * DSSM + (L - 3584);
                    if ((pn >= 6 && pn < 10) || pn >= 14) {
#pragma unroll
                        for (int e = 0; e < 4; ++e) { v0[e] = siluf_(v0[e]); v1[e] = siluf_(v1[e]); } }
                    u32x4 w; w.x = pk2(v0[0], v0[1]); w.y = pk2(v0[2], v0[3]); w.z = pk2(v1[0], v1[1]); w.w = pk2(v1[2], v1[3]);
                    *(u32x4*)dst = w; } }
        }
    }
};
struct EpiS1 {
    static constexpr bool AFTER_DRAIN = true;
    const float* lb16; bf16_t* UCAT;
    __device__ __forceinline__ void operator()(const f32x4 (&)[2][2][4][2], const Unit&, int, int, int, int) const {}
    __device__ __forceinline__ void fused(const f32x4 (&acc)[2][2][4][2], const Unit& u, int wr, int wc, LAS unsigned char* lds, int wid) const {
        const int l_ = lane_id_opaque(), fr = l_ & 15, fq = l_ >> 4;
        LAS float* Tl = (LAS float*)lds;
#pragma unroll
        for (int d = 0; d < 2; ++d) {
            EPI_FOR_ROWS { const int rit = ai * HALF + wr * 64 + m * 16 + fr; LAS float* rp = Tl + rit * 128 + wc * 32 + 8 * fq;
                *(LAS f32x4*)rp = acc[ai][d][m][0]; *(LAS f32x4*)(rp + 4) = acc[ai][d][m][1]; }
            LDS_WAIT(); __builtin_amdgcn_s_barrier(); asm volatile("" ::: "memory");
            {
                const int p = l_; const float lr = lb16[((u.z * 2 + d) * 64 + p) * 2], li = lb16[((u.z * 2 + d) * 64 + p) * 2 + 1];
                LAS float* SEG = (LAS float*)(lds + XCH_OFF);
                float xr = 0.f, xi = 0.f;
#pragma unroll 8
                for (int i = 0; i < 32; ++i) { const int cc = wid * 32 + i, c = d ? 255 - cc : cc;
                    const float sr = Tl[c * 128 + p], si = Tl[c * 128 + 64 + p];
                    Tl[c * 128 + p] = xr; Tl[c * 128 + 64 + p] = xi;
                    const float nr = lr * xr - li * xi + sr; xi = lr * xi + li * xr + si; xr = nr; }
                SEG[(wid * 64 + p) * 2] = xr; SEG[(wid * 64 + p) * 2 + 1] = xi;
                LDS_WAIT(); __builtin_amdgcn_s_barrier(); asm volatile("" ::: "memory");
                float l32r = lr, l32i = li;
#pragma unroll
                for (int q = 0; q < 5; ++q) { const float t = l32r * l32r - l32i * l32i; l32i = 2.f * l32r * l32i; l32r = t; }
                float er = 0.f, ei = 0.f;
                for (int j = 0; j < wid; ++j) { const float tr = SEG[(j * 64 + p) * 2], ti = SEG[(j * 64 + p) * 2 + 1];
                    const float nr = l32r * er - l32i * ei + tr; ei = l32r * ei + l32i * er + ti; er = nr; }
#pragma unroll 8
                for (int i = 0; i < 32; ++i) { const int cc = wid * 32 + i, c = d ? 255 - cc : cc;
                    const float tr = Tl[c * 128 + p] + er, ti = Tl[c * 128 + 64 + p] + ei;
                    Tl[c * 128 + p] = __uint_as_float(pk2(tr, ti));
                    const float nr = lr * er - li * ei; ei = lr * ei + li * er; er = nr; }
            }
            LDS_WAIT(); __builtin_amdgcn_s_barrier(); asm volatile("" ::: "memory");
            {   bf16_t* ub = UCAT + ((size_t)u.z * NCH + u.pm * 256) * 512 + 256 + d * 128;
#pragma unroll
                for (int i = 0; i < 8; ++i) { const int q = wid * 64 + l_ + 512 * i, r = q >> 4, c8 = (q & 15) * 8;
                    *(u32x4*)(ub + (size_t)r * 512 + c8) = *(const LAS u32x4*)((LAS bf16_t*)(Tl + r * 128) + c8); } }
            LDS_WAIT(); __builtin_amdgcn_s_barrier(); asm volatile("" ::: "memory");
        }
    }
};
struct EpiS2 {
    static constexpr bool AFTER_DRAIN = false;
    bf16_t* YS;
    __device__ __forceinline__ void operator()(const f32x4 (&acc)[2][2][4][2], const Unit& u, int wr, int wc, int, int) const {
        const int l_ = lane_id_opaque(), fr = l_ & 15, fq = l_ >> 4;
        EPI_FOR_ROWS { EPI_ROWDEF
#pragma unroll
            for (int bj = 0; bj < 2; ++bj) { const int c = bj * HALF + wc * 32 + 8 * fq; const int j = c >> 4, h0 = c & 15;
                const f32x4 v0 = acc[ai][bj][m][0], v1 = acc[ai][bj][m][1];
                u32x4 w; w.x = pk2(gelu_tanh(v0[0]), gelu_tanh(v0[1])); w.y = pk2(gelu_tanh(v0[2]), gelu_tanh(v0[3])); w.z = pk2(gelu_tanh(v1[0]), gelu_tanh(v1[1])); w.w = pk2(gelu_tanh(v1[2]), gelu_tanh(v1[3]));
                *(u32x4*)(YS + ((size_t)row * 16 + j) * DSSM + u.z * 16 + h0) = w; } }
    }
};
struct EpiGlu {
    static constexpr bool AFTER_DRAIN = false;
    const float* bglu; const bf16_t* GS; bf16_t* YMIX;
    __device__ __forceinline__ void operator()(const f32x4 (&acc)[2][2][4][2], const Unit& u, int wr, int wc, int, int) const {
        const int l_ = lane_id_opaque(), fr = l_ & 15, fq = l_ >> 4;
        const int a0 = 128 * u.pn + 32 * wc + 8 * fq;
        float bv[8], bg[8];
#pragma unroll
        for (int i = 0; i < 8; ++i) { bv[i] = bglu[a0 + i]; bg[i] = bglu[1024 + a0 + i]; }
        u32x4 gsv[2][4];
        EPI_FOR_ROWS { EPI_ROWDEF gsv[ai][m] = *(const u32x4*)(GS + (size_t)row * DSSM + a0); }
        EPI_FOR_ROWS { EPI_ROWDEF const u32x4 gs = gsv[ai][m];
            float o[8];
#pragma unroll
            for (int n = 0; n < 2; ++n)
#pragma unroll
                for (int e = 0; e < 4; ++e) { const int i = 4 * n + e; o[i] = (acc[ai][0][m][n][e] + bv[i]) * sigmoidf_(acc[ai][1][m][n][e] + bg[i]); }
            o[0] *= bflo(gs.x); o[1] *= bfhi(gs.x); o[2] *= bflo(gs.y); o[3] *= bfhi(gs.y); o[4] *= bflo(gs.z); o[5] *= bfhi(gs.z); o[6] *= bflo(gs.w); o[7] *= bfhi(gs.w);
            u32x4 w; w.x = pk2(o[0], o[1]); w.y = pk2(o[2], o[3]); w.z = pk2(o[4], o[5]); w.w = pk2(o[6], o[7]);
            *(u32x4*)(YMIX + (size_t)row * DM + 1024 + a0) = w; }
    }
};
struct EpiBf {
    static constexpr bool AFTER_DRAIN = false;
    bf16_t* O; int ldc;
    __device__ __forceinline__ void operator()(const f32x4 (&acc)[2][2][4][2], const Unit& u, int wr, int wc, int, int) const {
        const int l_ = lane_id_opaque(), fr = l_ & 15, fq = l_ >> 4;
        EPI_FOR_ROWS { EPI_ROWDEF
#pragma unroll
            for (int bj = 0; bj < 2; ++bj) { const f32x4 v0 = acc[ai][bj][m][0], v1 = acc[ai][bj][m][1];
                u32x4 w; w.x = pk2(v0[0], v0[1]); w.y = pk2(v0[2], v0[3]); w.z = pk2(v1[0], v1[1]); w.w = pk2(v1[2], v1[3]);
                *(u32x4*)(O + (size_t)row * ldc + u.pn * BM + bj * HALF + wc * 32 + 8 * fq) = w; } }
    }
};
struct EpiOut {
    static constexpr bool AFTER_DRAIN = false;
    const float* x; float* H; bf16_t* HB; float* ssq;
    __device__ __forceinline__ void operator()(const f32x4 (&acc)[2][2][4][2], const Unit& u, int wr, int wc, int, int) const {
        const int l_ = lane_id_opaque(), fr = l_ & 15, fq = l_ >> 4;
#pragma unroll
        for (int ai = 0; ai < 2; ++ai) {
            f32x4 xv[4][2][2];
#pragma unroll
            for (int m = 0; m < 4; ++m) { EPI_ROWDEF
#pragma unroll
                for (int bj = 0; bj < 2; ++bj) { const size_t off = (size_t)row * DM + u.pn * BM + bj * HALF + wc * 32 + 8 * fq; xv[m][bj][0] = *(const f32x4*)(x + off); xv[m][bj][1] = *(const f32x4*)(x + off + 4); } }
#pragma unroll
            for (int m = 0; m < 4; ++m) { EPI_ROWDEF float s = 0.f;
#pragma unroll
                for (int bj = 0; bj < 2; ++bj) { const size_t off = (size_t)row * DM + u.pn * BM + bj * HALF + wc * 32 + 8 * fq;
                    const f32x4 v0 = acc[ai][bj][m][0] + xv[m][bj][0], v1 = acc[ai][bj][m][1] + xv[m][bj][1];
                    s += (v0[0] * v0[0] + v0[1] * v0[1]) + (v0[2] * v0[2] + v0[3] * v0[3]) + (v1[0] * v1[0] + v1[1] * v1[1]) + (v1[2] * v1[2] + v1[3] * v1[3]);
                    u32x4 w; w.x = pk2(v0[0], v0[1]); w.y = pk2(v0[2], v0[3]); w.z = pk2(v1[0], v1[1]); w.w = pk2(v1[2], v1[3]);
                    *(u32x4*)(HB + off) = w; }
                s += swz_xor<16>(s); s = sum_xor32(s);
                if (fq == 0) ssq[(size_t)row * 32 + u.pn * 4 + wc] = s; }
        }
    }
};
struct EpiGate {
    static constexpr bool AFTER_DRAIN = true;
    float* H; const bf16_t* PP; float* ssq; unsigned* cnt; const float* nf; const LAS float* r2; const bf16_t* HBr;
    __device__ __forceinline__ void operator()(const f32x4 (&)[2][2][4][2], const Unit&, int, int, int, int) const {}
    __device__ __forceinline__ void fused(f32x4 (&acc)[2][2][4][2], const Unit& u, int wr, int wc, LAS unsigned char* lds, int wid) const {
        const int l_ = lane_id_opaque(), fr = l_ & 15, fq = l_ >> 4, tid = wid * 64 + l_;
        LAS float* P = (LAS float*)lds; LAS float* Rn = P + 1024;
        EPI_FOR_ROWS { EPI_ROWDEF float s = 0.f; const float r = r2[rit];
#pragma unroll
            for (int bj = 0; bj < 2; ++bj) { const size_t off = (size_t)row * DM + u.pn * BM + bj * HALF + wc * 32 + 8 * fq;
                const u32x4 pp = *(const u32x4*)(PP + off);
                const u32x4 hb = *(const u32x4*)(HBr + off);
                f32x4 h0 = {bflo(hb.x), bfhi(hb.x), bflo(hb.y), bfhi(hb.y)}, h1 = {bflo(hb.z), bfhi(hb.z), bflo(hb.w), bfhi(hb.w)};
                const f32x4 a0 = acc[ai][bj][m][0] * r, a1 = acc[ai][bj][m][1] * r;
                h0[0] += sigmoidf_(a0[0]) * bflo(pp.x); h0[1] += sigmoidf_(a0[1]) * bfhi(pp.x); h0[2] += sigmoidf_(a0[2]) * bflo(pp.y); h0[3] += sigmoidf_(a0[3]) * bfhi(pp.y);
                h1[0] += sigmoidf_(a1[0]) * bflo(pp.z); h1[1] += sigmoidf_(a1[1]) * bfhi(pp.z); h1[2] += sigmoidf_(a1[2]) * bflo(pp.w); h1[3] += sigmoidf_(a1[3]) * bfhi(pp.w);
                acc[ai][bj][m][0] = h0; acc[ai][bj][m][1] = h1;
                s += (h0[0] * h0[0] + h0[1] * h0[1]) + (h0[2] * h0[2] + h0[3] * h0[3]) + (h1[0] * h1[0] + h1[1] * h1[1]) + (h1[2] * h1[2] + h1[3] * h1[3]); }
            s += swz_xor<16>(s); s = sum_xor32(s);
            if (fq == 0) P[rit * 4 + wc] = s; }
        LDS_WAIT(); __builtin_amdgcn_s_barrier(); asm volatile("" ::: "memory");
        if (tid < 256) { const float t = (P[tid * 4] + P[tid * 4 + 1]) + (P[tid * 4 + 2] + P[tid * 4 + 3]);
            __hip_atomic_store(ssq + (size_t)(u.pm * 256 + tid) * 8 + u.pn, t, __ATOMIC_RELAXED, __HIP_MEMORY_SCOPE_AGENT); }
        asm volatile("s_waitcnt vmcnt(0)" ::: "memory");
        if (wid < 4 && l_ == 0) __hip_atomic_fetch_add(cnt + 64 * u.pm, 1u, __ATOMIC_RELAXED, __HIP_MEMORY_SCOPE_AGENT);
        if (wid == 0) {
            unsigned sp = 0;
            while ((unsigned)__builtin_amdgcn_readfirstlane(__hip_atomic_load(cnt + 64 * u.pm, __ATOMIC_RELAXED, __HIP_MEMORY_SCOPE_AGENT)) < 32u) { __builtin_amdgcn_s_sleep(2); if (++sp > (1u << 22)) break; }
            __builtin_amdgcn_fence(__ATOMIC_ACQUIRE, "agent");
        }
        asm volatile("s_waitcnt vmcnt(0) lgkmcnt(0)" ::: "memory"); __builtin_amdgcn_s_barrier(); asm volatile("" ::: "memory");
        if (tid < 256) { const float* sp = ssq + (size_t)(u.pm * 256 + tid) * 8; float t = 0.f;
#pragma unroll
            for (int i = 0; i < 8; ++i) t += __hip_atomic_load(sp + i, __ATOMIC_RELAXED, __HIP_MEMORY_SCOPE_AGENT);
            Rn[tid] = rsqrtf(t * (1.f / DM) + EPS); }
        LDS_WAIT(); __builtin_amdgcn_s_barrier(); asm volatile("" ::: "memory");
        EPI_FOR_ROWS { EPI_ROWDEF const float rn = Rn[rit];
#pragma unroll
            for (int bj = 0; bj < 2; ++bj) { const int col = u.pn * BM + bj * HALF + wc * 32 + 8 * fq; const size_t off = (size_t)row * DM + col;
                *(f32x4*)(H + off) = acc[ai][bj][m][0] * rn * *(const f32x4*)(nf + col); *(f32x4*)(H + off + 4) = acc[ai][bj][m][1] * rn * *(const f32x4*)(nf + col + 4); } }
    }
};
}

namespace att {
constexpr int D = 128, NW = 8, QBLK = 32, KVBLK = 64;
constexpr float SCALE = 0.088388347648318440f;
constexpr float THR = 8.f;
constexpr int LDQ = DATT, LDK = DKV;
constexpr size_t SHM_V = KVBLK * D * 2, SHM_K = KVBLK * D * 2, SHM_ATTN = 2 * SHM_V + 2 * SHM_K + NW * 64 * 4;
#define KSWZ(row, colB) ((row) * 256 + ((colB) ^ (((row) & 7) << 4)))
#define SBAR() __builtin_amdgcn_sched_barrier(0)
__device__ __forceinline__ int crow(int r, int hi) { return (r & 3) + 8 * (r >> 2) + 4 * hi; }
__device__ __forceinline__ void partialSM(f32x16& p0, f32x16& p1, float& m_reg, float& mn, float& alpha) {
  constexpr float C = SCALE * 1.4426950408889634f;
  float pmax = p0[0]; for (int r = 1; r < 16; ++r) pmax = fmaxf(pmax, p0[r]); for (int r = 0; r < 16; ++r) pmax = fmaxf(pmax, p1[r]);
  { auto rr = __builtin_amdgcn_permlane32_swap(__float_as_uint(pmax), __float_as_uint(pmax), false, false);
    pmax = fmaxf(__uint_as_float(rr[0]), __uint_as_float(rr[1])); }
  if (__builtin_expect(__all(pmax - m_reg <= THR / SCALE), 1)) { mn = m_reg; alpha = 1.f; }
  else { mn = fmaxf(m_reg, pmax); alpha = __builtin_amdgcn_exp2f((m_reg - mn) * C); m_reg = mn; }
  float mnC = -mn * C;
  for (int r = 0; r < 16; ++r) p0[r] = fmaf(p0[r], C, mnC); for (int r = 0; r < 16; ++r) p1[r] = fmaf(p1[r], C, mnC);
  for (int r = 0; r < 16; ++r) p0[r] = __builtin_amdgcn_exp2f(p0[r]);
}
__device__ __forceinline__ void finishSM(f32x16& p0, f32x16& p1, float alpha, float& l_reg, bf16x8& pa0, bf16x8& pa1, bf16x8& pa2, bf16x8& pa3) {
  for (int r = 0; r < 16; ++r) p1[r] = __builtin_amdgcn_exp2f(p1[r]);
  float ps = 0; for (int r = 0; r < 16; ++r) ps += p0[r]; for (int r = 0; r < 16; ++r) ps += p1[r];
  { auto rr = __builtin_amdgcn_permlane32_swap(__float_as_uint(ps), __float_as_uint(ps), false, false);
    ps = __uint_as_float(rr[0]) + __uint_as_float(rr[1]); }
  l_reg = l_reg * alpha + ps;
#define PK4(P, BASE, OUT) do { unsigned a0 = cvt_pk_bf16(P[BASE + 0], P[BASE + 1]), a1 = cvt_pk_bf16(P[BASE + 2], P[BASE + 3]);   \
    unsigned b0 = cvt_pk_bf16(P[BASE + 4], P[BASE + 5]), b1 = cvt_pk_bf16(P[BASE + 6], P[BASE + 7]);                              \
    auto r0 = __builtin_amdgcn_permlane32_swap(a0, b0, false, false); auto r1 = __builtin_amdgcn_permlane32_swap(a1, b1, false, false); \
    u32x4 w = {r0[0], r1[0], r0[1], r1[1]}; OUT = *reinterpret_cast<bf16x8*>(&w); } while (0)
  PK4(p0, 0, pa0); PK4(p0, 8, pa1); PK4(p1, 0, pa2); PK4(p1, 8, pa3);
#undef PK4
}
__device__ __forceinline__ void qkt(f32x16& p0, f32x16& p1, const bf16_t* Ks, const bf16x8* qr, int r32, int hi) {
  p0 = f32x16{}; p1 = f32x16{};
  for (int d0 = 0; d0 < 8; ++d0) { int cb = (d0 * 16 + hi * 8) * 2;
    bf16x8 b0 = *reinterpret_cast<const bf16x8*>((const char*)Ks + KSWZ(r32, cb));
    bf16x8 b1 = *reinterpret_cast<const bf16x8*>((const char*)Ks + KSWZ(32 + r32, cb));
    p0 = __builtin_amdgcn_mfma_f32_32x32x16_bf16(b0, qr[d0], p0, 0, 0, 0);
    p1 = __builtin_amdgcn_mfma_f32_32x32x16_bf16(b1, qr[d0], p1, 0, 0, 0); }
}
__device__ __forceinline__ int v_st(int k, int c) { const int kk = (k & ~0xC) | ((k & 4) << 1) | ((k & 8) >> 1); return ((kk >> 3) * 4 + (c >> 5)) * 512 + ((kk & 7) * 32 + (c & 31)) * 2; }
__device__ __forceinline__ int v_rd_base(int lane) { return ((lane & 3) << 3) | (((lane >> 2) & 3) << 6) | (((lane >> 4) & 1) << 5) | (((lane >> 5) & 1) << 8); }
constexpr int v_rd_off(int d0, int ks, int half) { return d0 * 512 + ks * 4096 + half * 2048; }
template <int OFF> __device__ __forceinline__ s16x4 tr_read(int vb) {
  s16x4 r; asm volatile("ds_read_b64_tr_b16 %0, %1 offset:%2" : "=&v"(r) : "v"(vb), "i"(OFF) : "memory"); return r;
}
template <int D0> __device__ __forceinline__ void pv_one(f32x16& od, int vb, bf16x8 pa0, bf16x8 pa1, bf16x8 pa2, bf16x8 pa3) {
  const s16x4 l0 = tr_read<v_rd_off(D0, 0, 0)>(vb), h0 = tr_read<v_rd_off(D0, 0, 1)>(vb), l1 = tr_read<v_rd_off(D0, 1, 0)>(vb), h1 = tr_read<v_rd_off(D0, 1, 1)>(vb);
  const s16x4 l2 = tr_read<v_rd_off(D0, 2, 0)>(vb), h2 = tr_read<v_rd_off(D0, 2, 1)>(vb), l3 = tr_read<v_rd_off(D0, 3, 0)>(vb), h3 = tr_read<v_rd_off(D0, 3, 1)>(vb);
  asm volatile("s_waitcnt lgkmcnt(0)" ::: "memory"); SBAR();
#define PK(L, H) (bf16x8){L[0], L[1], L[2], L[3], H[0], H[1], H[2], H[3]}
  od = __builtin_amdgcn_mfma_f32_32x32x16_bf16(pa0, PK(l0, h0), od, 0, 0, 0);
  od = __builtin_amdgcn_mfma_f32_32x32x16_bf16(pa1, PK(l1, h1), od, 0, 0, 0);
  od = __builtin_amdgcn_mfma_f32_32x32x16_bf16(pa2, PK(l2, h2), od, 0, 0, 0);
  od = __builtin_amdgcn_mfma_f32_32x32x16_bf16(pa3, PK(l3, h3), od, 0, 0, 0);
#undef PK
}
__device__ __forceinline__ void pv_d0(f32x16* o, int vb, bf16x8 pa0, bf16x8 pa1, bf16x8 pa2, bf16x8 pa3) {
  pv_one<0>(o[0], vb, pa0, pa1, pa2, pa3); pv_one<1>(o[1], vb, pa0, pa1, pa2, pa3); pv_one<2>(o[2], vb, pa0, pa1, pa2, pa3); pv_one<3>(o[3], vb, pa0, pa1, pa2, pa3);
}
__device__ __forceinline__ void attn_dense_body(const bf16_t* __restrict__ Qb, const bf16_t* __restrict__ Kh, const bf16_t* __restrict__ Vh,
                                                const bf16_t* __restrict__ Gb, bf16_t* __restrict__ Yb, int seq, char* lds, const int wid) {
  const int lane = lane_id_opaque(), tid = wid * 64 + lane, r32 = lane & 31, hi = lane >> 5;
  bf16_t* V_lds = (bf16_t*)lds; bf16_t* K_lds = (bf16_t*)(lds + 2 * SHM_V);
  float* ws = (float*)(lds + 2 * SHM_V + 2 * SHM_K) + wid * 64; float* li_l = ws; float* al_l = ws + 32;
  float m_reg = -1e30f, l_reg = 0; f32x16 o[4] = {}; bf16x8 qr[8];
  const bf16_t* Qw = Qb + (long)(wid * QBLK + r32) * LDQ + hi * 8;
#pragma unroll
  for (int d0 = 0; d0 < 8; ++d0) qr[d0] = *reinterpret_cast<const bf16x8*>(Qw + d0 * 16);
  const int sr = tid >> 4, sc = (tid & 15) * 8, vst0 = v_st(sr, sc), vst1 = v_st(32 + sr, sc);
  const int vb0 = (int)(uintptr_t)V_lds + v_rd_base(lane);
  struct { bf16x8 vs0, vs1, ks0, ks1; } sr_[2];
#define SLOAD(i, k0) do { sr_[i].vs0 = *reinterpret_cast<const bf16x8*>(&Vh[(long)((k0) + sr) * LDK + sc]); sr_[i].vs1 = *reinterpret_cast<const bf16x8*>(&Vh[(long)((k0) + 32 + sr) * LDK + sc]); \
    sr_[i].ks0 = *reinterpret_cast<const bf16x8*>(&Kh[(long)((k0) + sr) * LDK + sc]); sr_[i].ks1 = *reinterpret_cast<const bf16x8*>(&Kh[(long)((k0) + 32 + sr) * LDK + sc]); } while (0)
#define SWRITE(b, i) do { *(bf16x8*)((char*)V_lds + (b) * SHM_V + vst0) = sr_[i].vs0;          \
    *(bf16x8*)((char*)V_lds + (b) * SHM_V + vst1) = sr_[i].vs1; int kc = sc * 2;               \
    *(bf16x8*)((char*)K_lds + (b) * SHM_K + KSWZ(sr, kc)) = sr_[i].ks0;                       \
    *(bf16x8*)((char*)K_lds + (b) * SHM_K + KSWZ(32 + sr, kc)) = sr_[i].ks1; } while (0)
#define SWAIT() asm volatile("s_waitcnt vmcnt(4)" ::: "memory")
#define RESC(a) do { if (__any((a) < 1.f)) { if (hi == 0) al_l[r32] = (a); asm volatile("s_waitcnt lgkmcnt(0)" ::: "memory"); \
    for (int d = 0; d < 4; ++d) for (int r = 0; r < 16; ++r) o[d][r] *= al_l[crow(r, hi)]; } } while (0)
  f32x16 pA0, pA1, pB0, pB1; float mnA, mnB, alA, alB; bf16x8 pa0, pa1, pa2, pa3; const int NT = seq / KVBLK;
  constexpr int SE = 0, SO = 1;
  SLOAD(SE, 0); asm volatile("s_waitcnt vmcnt(0)" ::: "memory"); SWRITE(0, SE); __syncthreads();
  qkt(pA0, pA1, K_lds, qr, r32, hi); partialSM(pA0, pA1, m_reg, mnA, alA);
  SLOAD(SO, KVBLK); if (2 < NT) SLOAD(SE, 2 * KVBLK);
  SWAIT(); SWRITE(1, SO); __syncthreads();
  for (int j = 1; j + 1 < NT; j += 2) {
    SBAR(); qkt(pB0, pB1, (bf16_t*)((char*)K_lds + SHM_K), qr, r32, hi);
    finishSM(pA0, pA1, alA, l_reg, pa0, pa1, pa2, pa3); SBAR();
    SLOAD(SO, (j + 2) * KVBLK); SBAR();
    pv_d0(o, vb0, pa0, pa1, pa2, pa3); partialSM(pB0, pB1, m_reg, mnB, alB);
    __syncthreads(); SWAIT(); SWRITE(0, SE);
    RESC(alB); __syncthreads();
    SBAR(); qkt(pA0, pA1, K_lds, qr, r32, hi);
    finishSM(pB0, pB1, alB, l_reg, pa0, pa1, pa2, pa3); SBAR();
    if (j + 3 < NT) SLOAD(SE, (j + 3) * KVBLK); SBAR();
    pv_d0(o, vb0 + (int)SHM_V, pa0, pa1, pa2, pa3); partialSM(pA0, pA1, m_reg, mnA, alA);
    __syncthreads(); SWAIT(); SWRITE(1, SO);
    RESC(alA); __syncthreads();
  }
  SBAR(); qkt(pB0, pB1, (bf16_t*)((char*)K_lds + SHM_K), qr, r32, hi);
  finishSM(pA0, pA1, alA, l_reg, pa0, pa1, pa2, pa3); SBAR();
  pv_d0(o, vb0, pa0, pa1, pa2, pa3); partialSM(pB0, pB1, m_reg, mnB, alB);
  __syncthreads(); RESC(alB);
  finishSM(pB0, pB1, alB, l_reg, pa0, pa1, pa2, pa3); SBAR();
  pv_d0(o, vb0 + (int)SHM_V, pa0, pa1, pa2, pa3);
  if (hi == 0) li_l[r32] = l_reg; asm volatile("s_waitcnt lgkmcnt(0)" ::: "memory");
  float rli[16];
#pragma unroll
  for (int r = 0; r < 16; ++r) rli[r] = __builtin_amdgcn_rcpf(li_l[crow(r, hi)]);
  bf16_t* Yw = Yb + (long)(wid * QBLK) * DM; const bf16_t* Gw = Gb + (long)(wid * QBLK) * DATT;
  __syncthreads();
  bf16_t* stg = (bf16_t*)(lds + wid * 8192);
#pragma unroll
  for (int r = 0; r < 16; ++r) { const int orow = crow(r, hi);
#pragma unroll
    for (int d0 = 0; d0 < 4; ++d0) stg[orow * 128 + d0 * 32 + r32] = (bf16_t)f2bf(o[d0][r] * rli[r]); }
  asm volatile("s_waitcnt lgkmcnt(0)" ::: "memory");
  const int l2 = lane_id_opaque();
#pragma unroll
  for (int i = 0; i < 8; ++i) { const int q = l2 + 64 * i, row = q >> 4, c8 = (q & 15) * 8;
    const u32x4 v = *(const u32x4*)(stg + row * 128 + c8); const u32x4 gg = *(const u32x4*)(Gw + (unsigned)(row * DATT + c8));
    u32x4 w; w.x = pk2(bflo(v.x) * bflo(gg.x), bfhi(v.x) * bfhi(gg.x)); w.y = pk2(bflo(v.y) * bflo(gg.y), bfhi(v.y) * bfhi(gg.y));
    w.z = pk2(bflo(v.z) * bflo(gg.z), bfhi(v.z) * bfhi(gg.z)); w.w = pk2(bflo(v.w) * bflo(gg.w), bfhi(v.w) * bfhi(gg.w));
    *(u32x4*)(Yw + (unsigned)(row * DM + c8)) = w; }
  __syncthreads();
#undef SLOAD
#undef SWRITE
#undef SWAIT
#undef RESC
}
#undef SBAR
}

__device__ __forceinline__ void p0_transpose_item(const float* W, int K, int N, bf16_t* WT, int wt_row0, const float* kscale, LAS float* scr, int k0, int n0, int lane) {
#pragma unroll
    for (int i = 0; i < 32; ++i) { const int kk = 2 * i + (lane >> 5); float v = W[(size_t)(k0 + kk) * N + n0 + (lane & 31)]; if (kscale) v *= kscale[k0 + kk]; scr[kk * 33 + (lane & 31)] = v; }
    LDS_WAIT(); asm volatile("" ::: "memory");
    const int c = lane & 7;
#pragma unroll
    for (int j = 0; j < 4; ++j) { const int n = (lane >> 3) + 8 * j; const LAS float* s = scr + (8 * c) * 33 + n;
        u32x4 o; o.x = pk2(s[0 * 33], s[1 * 33]); o.y = pk2(s[2 * 33], s[3 * 33]); o.z = pk2(s[4 * 33], s[5 * 33]); o.w = pk2(s[6 * 33], s[7 * 33]);
        *(u32x4*)(WT + (size_t)(wt_row0 + n) * K + k0 + 8 * c) = o; }
    LDS_WAIT(); asm volatile("" ::: "memory");
}

struct TrItem { const float* W; bf16_t* WT; const float* kscale; int K, N, wt_row0, k0, n0; };
__device__ __forceinline__ void p0_tr_load(const TrItem& d, float (&v)[32], int lane) {
#pragma unroll
    for (int i = 0; i < 32; ++i) { const int kk = 2 * i + (lane >> 5); v[i] = d.W[(size_t)(d.k0 + kk) * d.N + d.n0 + (lane & 31)]; }
    if (d.kscale) {
#pragma unroll
        for (int i = 0; i < 32; ++i) { const int kk = 2 * i + (lane >> 5); v[i] *= d.kscale[d.k0 + kk]; } }
}
__device__ __forceinline__ void p0_tr_store(const TrItem& d, const float (&v)[32], LAS float* scr, int lane) {
#pragma unroll
    for (int i = 0; i < 32; ++i) { const int kk = 2 * i + (lane >> 5); scr[kk * 33 + (lane & 31)] = v[i]; }
    LDS_WAIT(); asm volatile("" ::: "memory");
    const int c = lane & 7;
#pragma unroll
    for (int j = 0; j < 4; ++j) { const int n = (lane >> 3) + 8 * j; const LAS float* s = scr + (8 * c) * 33 + n;
        u32x4 o; o.x = pk2(s[0 * 33], s[1 * 33]); o.y = pk2(s[2 * 33], s[3 * 33]); o.z = pk2(s[4 * 33], s[5 * 33]); o.w = pk2(s[6 * 33], s[7 * 33]);
        *(u32x4*)(d.WT + (size_t)(d.wt_row0 + n) * d.K + d.k0 + 8 * c) = o; }
    LDS_WAIT(); asm volatile("" ::: "memory");
}
__device__ __forceinline__ void ssm_tables(const Args& a, int g, LAS unsigned char* lds, int tid) {
    LAS float* LD = (LAS float*)lds;
    LAS float* LBs = LD + 256;
    LAS float* BB = LBs + 256;
    LAS float* KT = BB + 4096;
    LAS float* CC = KT + 8192;
    float* lb16 = (float*)(a.ws + WS_LB16);
    bf16_t* WIN = (bf16_t*)(a.ws + WS_WIN) + (size_t)g * 256 * 256;
    bf16_t* WBIG = (bf16_t*)(a.ws + WS_WBIG) + (size_t)g * 256 * 512;
    for (int e = tid; e < 2048; e += 512) { const int d = e >> 10, r = e & 1023; const size_t ci_ = (size_t)(d * NG + g) * 1024 + r; CC[e * 2] = a.c_re[ci_]; CC[e * 2 + 1] = a.c_im[ci_]; }
    if (tid < 128) {
        const int d = tid >> 6, p = tid & 63; const int idx = (d * NG + g) * 64 + p;
        const float lr = fminf(a.a_re[idx], -1e-4f), li = a.a_im[idx];
        const float dt = expf(a.log_dt[d * NG + g]);
        const float er = expf(lr * dt); float sn, cs; sincosf(li * dt, &sn, &cs);
        const float br = er * cs, bi = er * sn;
        LD[tid * 2] = lr * dt; LD[tid * 2 + 1] = li * dt; LBs[tid * 2] = br; LBs[tid * 2 + 1] = bi;
        const float nr = br - 1.f, ni = bi, den = lr * lr + li * li;
        KT[tid * 2] = (nr * lr + ni * li) / den; KT[tid * 2 + 1] = (ni * lr - nr * li) / den;
        const float e16 = expf(16.f * lr * dt); float s16, c16; sincosf(16.f * li * dt, &s16, &c16);
        lb16[(g * 128 + tid) * 2] = e16 * c16; lb16[(g * 128 + tid) * 2 + 1] = e16 * s16;
    }
    __syncthreads();
    for (int e = tid; e < 2048; e += 512) {
        const int dp = e >> 4, h = e & 15, d = dp >> 6, p = dp & 63;
        const size_t bi_ = ((size_t)(d * NG + g) * 64 + p) * 16 + h;
        const float xr = a.b_re[bi_], xi = a.b_im[bi_], cr = KT[dp * 2], ci = KT[dp * 2 + 1];
        BB[e * 2] = cr * xr - ci * xi; BB[e * 2 + 1] = cr * xi + ci * xr;
    }
    __syncthreads();
    {
        const int d = tid >> 8, hp = (tid >> 4) & 15, h = tid & 15; float acc[16];
#pragma unroll
        for (int t = 0; t < 16; ++t) acc[t] = 0.f;
        const LAS float* cc = CC + ((d * 16 + hp) * 64) * 2;
        for (int p = 0; p < 64; ++p) {
            const float c_r = cc[p * 2], c_i = cc[p * 2 + 1], b_r = BB[((d * 64 + p) * 16 + h) * 2], b_i = BB[((d * 64 + p) * 16 + h) * 2 + 1];
            float wr = c_r * b_r - c_i * b_i, wi = c_r * b_i + c_i * b_r; const float l_r = LBs[(d * 64 + p) * 2], l_i = LBs[(d * 64 + p) * 2 + 1];
#pragma unroll
            for (int t = 0; t < 16; ++t) { acc[t] += wr; const float nr = wr * l_r - wi * l_i; wi = wr * l_i + wi * l_r; wr = nr; }
        }
#pragma unroll
        for (int t = 0; t < 16; ++t) KT[((d * 16 + t) * 16 + hp) * 16 + h] = acc[t];
    }
    __syncthreads();
    for (int q = tid; q < 8192; q += 512) {
        const int n = q >> 5, kc = q & 31, s = kc >> 1, h0 = (kc & 1) * 8, j = n >> 4, hp = n & 15;
        float v[8];
#pragma unroll
        for (int e = 0; e < 8; ++e) { const int h = h0 + e;
            if (s < j) v[e] = KT[((0 * 16 + (j - s)) * 16 + hp) * 16 + h];
            else if (s > j) v[e] = KT[((1 * 16 + (s - j)) * 16 + hp) * 16 + h];
            else v[e] = KT[((0 * 16 + 0) * 16 + hp) * 16 + h] + KT[((1 * 16 + 0) * 16 + hp) * 16 + h] + (h == hp ? a.ssm_d[g * 16 + h] : 0.f); }
        u32x4 w; w.x = pk2(v[0], v[1]); w.y = pk2(v[2], v[3]); w.z = pk2(v[4], v[5]); w.w = pk2(v[6], v[7]);
        *(u32x4*)(WBIG + (size_t)n * 512 + s * 16 + h0) = w;
    }
    for (int q = tid; q < 2048; q += 512) {
        const int p = q & 63, js = (q >> 6) & 15, d = q >> 10; const float ldr = LD[(d * 64 + p) * 2], ldi = LD[(d * 64 + p) * 2 + 1];
        {   const float pw = (float)(d == 0 ? js + 1 : 16 - js); const float er = expf(pw * ldr); float sn, cs; sincosf(pw * ldi, &sn, &cs); const float pr = er * cs, pi = er * sn;
#pragma unroll
            for (int hp = 0; hp < 16; ++hp) { const float c_r = CC[((d * 16 + hp) * 64 + p) * 2], c_i = CC[((d * 16 + hp) * 64 + p) * 2 + 1];
                *(unsigned*)(WBIG + (size_t)(js * 16 + hp) * 512 + 256 + d * 128 + 2 * p) = pk2(c_r * pr - c_i * pi, -(c_r * pi + c_i * pr)); } }
        {   const float pw = (float)(d == 0 ? 15 - js : js); const float er = expf(pw * ldr); float sn, cs; sincosf(pw * ldi, &sn, &cs); const float pr = er * cs, pi = er * sn;
            float zr[16], zi[16];
#pragma unroll
            for (int h = 0; h < 16; ++h) { const float b_r = BB[((d * 64 + p) * 16 + h) * 2], b_i = BB[((d * 64 + p) * 16 + h) * 2 + 1]; zr[h] = pr * b_r - pi * b_i; zi[h] = pr * b_i + pi * b_r; }
            bf16_t* d0 = WIN + (size_t)(d * 128 + p) * 256 + js * 16; bf16_t* d1 = d0 + (size_t)64 * 256;
            u32x4 w; w.x = pk2(zr[0], zr[1]); w.y = pk2(zr[2], zr[3]); w.z = pk2(zr[4], zr[5]); w.w = pk2(zr[6], zr[7]); *(u32x4*)d0 = w;
            w.x = pk2(zr[8], zr[9]); w.y = pk2(zr[10], zr[11]); w.z = pk2(zr[12], zr[13]); w.w = pk2(zr[14], zr[15]); *(u32x4*)(d0 + 8) = w;
            w.x = pk2(zi[0], zi[1]); w.y = pk2(zi[2], zi[3]); w.z = pk2(zi[4], zi[5]); w.w = pk2(zi[6], zi[7]); *(u32x4*)d1 = w;
            w.x = pk2(zi[8], zi[9]); w.y = pk2(zi[10], zi[11]); w.z = pk2(zi[12], zi[13]); w.w = pk2(zi[14], zi[15]); *(u32x4*)(d1 + 8) = w; }
    }
    __syncthreads();
}

#define XB_TMO      128
#define XB_XCNT(j)  (256  + 64 * (j))
#define XB_XSUB(j)  (1280 + 64 * (j))
#define XB_XGEN(j)  (2304 + 64 * (j))
#define XB_TOP      3328
#define XB_TOPGEN   3392
#define XCD_BAR_WORDS 3456
#define XB_SPIN_CAP (1u << 18)
__device__ __forceinline__ unsigned xb_ld(unsigned* p)              { return __hip_atomic_load(p, __ATOMIC_RELAXED, __HIP_MEMORY_SCOPE_AGENT); }
__device__ __forceinline__ unsigned xb_add(unsigned* p, unsigned v) { return __hip_atomic_fetch_add(p, v, __ATOMIC_RELAXED, __HIP_MEMORY_SCOPE_AGENT); }
__device__ __forceinline__ unsigned xb_xcc_id() { return (unsigned)__builtin_amdgcn_s_getreg((3 << 11) | 20) & 0xFu; }
#define XB_SPIN(cond, bar) do { unsigned _sp = 0; while (cond) { __builtin_amdgcn_s_sleep(1); \
    if ((++_sp & 255u) == 0u) { if (xb_ld(&(bar)[XB_TMO])) break; if (_sp > XB_SPIN_CAP) { atomicAdd(&(bar)[XB_TMO], 1u); break; } } } } while (0)
struct XcdBarrier { unsigned* bar; unsigned x; volatile LAS unsigned* st; };
__device__ __forceinline__ XcdBarrier xcd_barrier_post(unsigned* bar, volatile LAS unsigned* st, bool leader) {
    XcdBarrier b; b.bar = bar; b.x = xb_xcc_id(); b.st = st;
    if (leader) (void)xb_add(&bar[XB_XCNT(b.x)], 1u);
    return b;
}
__device__ __forceinline__ void xcd_barrier_complete(unsigned* bar, unsigned x, unsigned& nloc, unsigned& nx) {
    const unsigned G = gridDim.x * gridDim.y * gridDim.z;
    unsigned sum, cnt, mine, sp = 0u;
    for (;;) {
        sum = 0u; cnt = 0u; mine = 0u;
#pragma unroll
        for (unsigned j = 0; j < 16; ++j) { const unsigned c = xb_ld(&bar[XB_XCNT(j)]); sum += c; cnt += (c > 0u) ? 1u : 0u; mine = (j == x) ? c : mine; }
        if (sum == G) break;
        __builtin_amdgcn_s_sleep(1);
        if ((++sp & 255u) == 0u) { if (xb_ld(&bar[XB_TMO])) break; if (sp > XB_SPIN_CAP) { atomicAdd(&bar[XB_TMO], 1u); break; } }
    }
    nloc = mine > 0u ? mine : 1u; nx = cnt > 0u ? cnt : 1u;
}
__device__ __forceinline__ void xcd_barrier(const XcdBarrier& b, bool leader) {
    asm volatile("s_waitcnt vmcnt(0)" ::: "memory");
    __syncthreads();
    if (leader) {
        unsigned* bar = b.bar;
        __builtin_amdgcn_s_waitcnt(0);
        unsigned nloc = b.st[0], nx = b.st[1];
        if (nloc == 0u) { xcd_barrier_complete(bar, b.x, nloc, nx); b.st[0] = nloc; b.st[1] = nx; }
        const unsigned old = xb_add(&bar[XB_XSUB(b.x)], 1u);
        const unsigned gen = old / nloc;
        if (old + 1u == (gen + 1u) * nloc) {
            __builtin_amdgcn_fence(__ATOMIC_RELEASE, "agent");
            asm volatile("s_waitcnt vmcnt(0)" ::: "memory");
            const unsigned og = xb_add(&bar[XB_TOP], 1u);
            const unsigned tg = og / nx;
            if (og + 1u == (tg + 1u) * nx) xb_add(&bar[XB_TOPGEN], 1u);
            else XB_SPIN(xb_ld(&bar[XB_TOPGEN]) == tg, bar);
            __builtin_amdgcn_fence(__ATOMIC_ACQUIRE, "agent");
            xb_add(&bar[XB_XGEN(b.x)], 1u);
            asm volatile("s_waitcnt vmcnt(0)" ::: "memory");
        } else {
            XB_SPIN(xb_ld(&bar[XB_XGEN(b.x)]) == gen, bar);
            __builtin_amdgcn_fence(__ATOMIC_ACQUIRE, "agent");
            asm volatile("s_waitcnt vmcnt(0)" ::: "memory");
        }
    }
    __syncthreads();
}

__global__ void __launch_bounds__(512, 2) fwd_kernel(Args a) {
    extern __shared__ __attribute__((aligned(16))) unsigned char lds_raw[];
    LAS unsigned char* lds = (LAS unsigned char*)lds_raw;
    cg::grid_group grid = cg::this_grid();
    const int wave = __builtin_amdgcn_readfirstlane(threadIdx.x >> 6);
    const bool leader = (wave == 0) && (lane_id_opaque() == 0);
    volatile LAS unsigned* xst = (volatile LAS unsigned*)(lds + XBST_OFF);
    if (leader) { xst[0] = 0u; xst[1] = 0u; }
    __syncthreads();
    if (a.ws == nullptr) grid.sync();
    const XcdBarrier xbar = xcd_barrier_post((unsigned*)(a.ws + WS_BAR), xst, leader);
#define GRID_SYNC() xcd_barrier(xbar, (wave == 0) && (lane_id_opaque() == 0))
#define LANE_IDS const int lane = lane_id_opaque(), tid = wave * 64 + lane; (void)tid;
    const int G = gridDim.x, bid = blockIdx.x;
    unsigned char* ws = a.ws;
    bf16_t* W1T = (bf16_t*)(ws + WS_W1T); bf16_t* WGLUT = (bf16_t*)(ws + WS_WGLUT); bf16_t* WOT = (bf16_t*)(ws + WS_WOT); bf16_t* WGT = (bf16_t*)(ws + WS_WGT); bf16_t* WPT = (bf16_t*)(ws + WS_WPT);
    float2* ROPE = (float2*)(ws + WS_ROPE); float* RINV = (float*)(ws + WS_RINV); float* LB16 = (float*)(ws + WS_LB16); float* SSQ1 = (float*)(ws + WS_SSQ1); float* SSQ2 = (float*)(ws + WS_SSQ2);
    bf16_t* PB = (bf16_t*)(ws + WS_PB); bf16_t* WIN = (bf16_t*)(ws + WS_WIN); bf16_t* WBIG = (bf16_t*)(ws + WS_WBIG);
    bf16_t* XB = (bf16_t*)(ws + WS_XB); bf16_t* HB = (bf16_t*)(ws + WS_XB);
    bf16_t* Q = (bf16_t*)(ws + WS_Q); bf16_t* KB = (bf16_t*)(ws + WS_K); bf16_t* VB = (bf16_t*)(ws + WS_V); bf16_t* GA = (bf16_t*)(ws + WS_GA); bf16_t* GS = (bf16_t*)(ws + WS_GS);
    bf16_t* UCAT = (bf16_t*)(ws + WS_UCAT); bf16_t* PPB = (bf16_t*)(ws + WS_UCAT); bf16_t* YMIX = (bf16_t*)(ws + WS_YMIX); bf16_t* YS = (bf16_t*)(ws + WS_YS);

#pragma unroll
    for (int rep_ = 0; rep_ < 1 + ((REP_MASK >> 0) & 1); ++rep_) { LANE_IDS
        const int gw = bid * 8 + wave, NGW = G * 8;
        LAS float* scr = (LAS float*)(lds + wave * 16384);
        constexpr int I1 = 32 * 144, I2 = 16 * 64, I3 = 32 * 64, I4 = 32 * 64, I5 = 4 * 64, NIT = I1 + I2 + I3 + I4 + I5;
        auto item_desc = [&](int r) -> TrItem {
            if (r < I1) { const int kb = r / 144, lgg = r % 144, pn = lgg >> 3, lg = lgg & 7, wtg = pn * 8 + 4 * (lg & 1) + 2 * (lg >> 2) + ((lg >> 1) & 1);
                return TrItem{a.w_in, W1T, a.norm_mix, DM, DIN, wtg * 32, kb * 64, lgg * 32}; } r -= I1;
            if (r < I2) { const int kb = r / 64, lgg = r % 64, l2 = lgg & 31, wtg = (l2 >> 2) * 8 + 4 * (lgg >> 5) + (l2 & 3);
                return TrItem{a.w_glu, WGLUT, nullptr, DSSM, 2 * DSSM, wtg * 32, kb * 64, lgg * 32}; } r -= I2;
            if (r < I3) { const int kb = r / 64, lgg = r % 64; return TrItem{a.w_out, WOT, nullptr, DM, DM, lgg * 32, kb * 64, lgg * 32}; } r -= I3;
            if (r < I4) { const int kb = r / 64, lgg = r % 64; return TrItem{a.w_ple_gate, WGT, a.norm_ple, DM, DM, lgg * 32, kb * 64, lgg * 32}; } r -= I4;
            const int kb = r / 64, lgg = r % 64; return TrItem{a.w_ple_proj, WPT, nullptr, PLE, DM, lgg * 32, kb * 64, lgg * 32};
        };
#pragma unroll
        for (int rq_ = 0; rq_ < 1 + ((REP_MASK >> 8) & 1); ++rq_)
        for (int it = gw; it < NIT; it += 2 * NGW) {
            const bool two = it + NGW < NIT;
            const TrItem dA = item_desc(it), dB = item_desc(two ? it + NGW : it);
            float vA[32], vB[32];
            p0_tr_load(dA, vA, lane); if (two) p0_tr_load(dB, vB, lane);
            p0_tr_store(dA, vA, scr, lane); if (two) p0_tr_store(dB, vB, scr, lane);
        }
#pragma unroll
        for (int rq_ = 0; rq_ < 1 + ((REP_MASK >> 9) & 1); ++rq_)
        for (int m = gw; m < T; m += 2 * NGW) {
            const int m2 = m + NGW; const bool two = m2 < T;
            const f32x4* xr = (const f32x4*)(a.x + (size_t)m * DM) + lane; const f32x4* xr2 = (const f32x4*)(a.x + (size_t)(two ? m2 : m) * DM) + lane;
            f32x4 v[8], w2[8]; float s = 0.f, s2 = 0.f;
#pragma unroll
            for (int j = 0; j < 8; ++j) v[j] = xr[64 * j];
#pragma unroll
            for (int j = 0; j < 8; ++j) w2[j] = xr2[64 * j];
#pragma unroll
            for (int j = 0; j < 8; ++j) { s += (v[j][0] * v[j][0] + v[j][1] * v[j][1]) + (v[j][2] * v[j][2] + v[j][3] * v[j][3]); s2 += (w2[j][0] * w2[j][0] + w2[j][1] * w2[j][1]) + (w2[j][2] * w2[j][2] + w2[j][3] * w2[j][3]); }
            s = wave_sum(s); s2 = wave_sum(s2);
            if (lane == 0) { RINV[m] = rsqrtf(s * (1.f / DM) + EPS); if (two) RINV[m2] = rsqrtf(s2 * (1.f / DM) + EPS); }
            u32x2* o = (u32x2*)(XB + (size_t)m * DM) + lane; u32x2* o2 = (u32x2*)(XB + (size_t)m2 * DM) + lane;
#pragma unroll
            for (int j = 0; j < 8; ++j) { u32x2 w; w.x = pk2(v[j][0], v[j][1]); w.y = pk2(v[j][2], v[j][3]); o[64 * j] = w; }
            if (two) {
#pragma unroll
                for (int j = 0; j < 8; ++j) { u32x2 w; w.x = pk2(w2[j][0], w2[j][1]); w.y = pk2(w2[j][2], w2[j][3]); o2[64 * j] = w; } }
        }
        for (int i = bid * 512 + tid; i < T * PLE / 4; i += G * 512) { const f32x4 v = ((const f32x4*)a.p)[i]; u32x2 w; w.x = pk2(v[0], v[1]); w.y = pk2(v[2], v[3]); ((u32x2*)PB)[i] = w; }
        for (int i = bid * 512 + tid; i < 2048; i += G * 512) { const int pos = i >> 5, f = i & 31; const float inv = powf(10000.f, -(float)f / 32.f); float sn, cs; sincosf((float)pos * inv, &sn, &cs); ROPE[i] = make_float2(cs, sn); }
    GRID_SYNC(); }


    if constexpr ((REP_MASK >> 10) & 1) { GRID_SYNC(); GRID_SYNC(); GRID_SYNC(); GRID_SYNC(); }
#pragma unroll
    for (int rep_ = 0; rep_ < 1 + ((REP_MASK >> 1) & 1); ++rep_) { LANE_IDS
        { pg8::Gemm g{XB, W1T, DM, DM, DM, 0, 0}; pg8::StaticOrder S; S.init(T, 14 * 256, G, bid);
          pg8::Epi1 E{RINV, a.q_norm, a.k_norm, ROPE, Q, KB, VB, GA, GS, UCAT, (LAS float*)(lds + XCH_OFF), 0};
          pg8::gemm_phase<pg8::Epi1, pg8::StaticOrder, true>(lds, g, S, E, wave); }
        __syncthreads();
        for (int gi = bid - (G - NG); gi >= 0 && gi < NG; gi += NG) ssm_tables(a, gi, lds, tid);
    GRID_SYNC(); }

#pragma unroll
    for (int rep_ = 0; rep_ < 1 + ((REP_MASK >> 2) & 1); ++rep_) {
#pragma unroll
        for (int rq_ = 0; rq_ < 2; ++rq_) {
        if (bid < 2 * NG) { if (rq_ == 1 && !((REP_MASK >> 6) & 1)) break;
            pg8::BatchOrder S{2 * NG, G, bid};
            { pg8::Gemm g{UCAT, WIN, 256, 512, 256, (size_t)NCH * 512 * 2, (size_t)256 * 256 * 2};
              pg8::EpiS1 E{LB16, UCAT}; pg8::gemm_phase<pg8::EpiS1, pg8::BatchOrder, false>(lds, g, S, E, wave); }
            asm volatile("s_waitcnt vmcnt(0)\n\tbuffer_inv sc1\n\ts_waitcnt vmcnt(0)" ::: "memory"); __syncthreads();
            { pg8::Gemm g{UCAT, WBIG, 512, 512, 512, (size_t)NCH * 512 * 2, (size_t)256 * 512 * 2};
              pg8::EpiS2 E{YS}; pg8::gemm_phase<pg8::EpiS2, pg8::BatchOrder, false>(lds, g, S, E, wave); }
        } else { if (rq_ == 1 && !((REP_MASK >> 11) & 1)) break;
            pg8::Gemm g{XB, W1T + (size_t)14 * 256 * DM, DM, DM, DM, 0, 0}; pg8::ListOrder S{bid - 2 * NG, 128, G};
            pg8::Epi1 E{RINV, a.q_norm, a.k_norm, ROPE, Q, KB, VB, GA, GS, UCAT, (LAS float*)(lds + XCH_OFF), 14};
            pg8::gemm_phase<pg8::Epi1, pg8::ListOrder, true>(lds, g, S, E, wave);
        }
        __syncthreads(); }
#pragma unroll
        for (int rq_ = 0; rq_ < 1 + ((REP_MASK >> 7) & 1); ++rq_)
        for (int un = bid; un < 256; un += G) {
            const int x = un & 7, jj = un >> 3, b = x >> 2, kvh = (x >> 1) & 1, idx = (x & 1) * 32 + jj, h = kvh * 4 + (idx >> 4), qb = idx & 15;
            const size_t tok0 = (size_t)b * SEQ + qb * 256;
            att::attn_dense_body(Q + tok0 * DATT + h * 128, KB + (size_t)b * SEQ * DKV + kvh * 128, VB + (size_t)b * SEQ * DKV + kvh * 128,
                                 GA + tok0 * DATT + h * 128, YMIX + tok0 * DM + h * 128, SEQ, (char*)lds_raw, wave);
        }
    GRID_SYNC(); }

#pragma unroll
    for (int rep_ = 0; rep_ < 1 + ((REP_MASK >> 3) & 1); ++rep_) {
        { pg8::Gemm g{YS, WGLUT, DSSM, DSSM, DSSM, 0, 0}; pg8::StaticOrder S; S.init(T, 2 * DSSM, G, bid);
          pg8::EpiGlu E{a.b_glu, GS, YMIX}; pg8::gemm_phase<pg8::EpiGlu, pg8::StaticOrder, false>(lds, g, S, E, wave); }
        __syncthreads();
        { pg8::Gemm g{PB, WPT, PLE, PLE, PLE, 0, 0}; pg8::StaticOrder S; S.init(T, DM, G, bid);
          pg8::EpiBf E{PPB, DM}; pg8::gemm_phase<pg8::EpiBf, pg8::StaticOrder, false>(lds, g, S, E, wave); }
    GRID_SYNC(); }


#pragma unroll
    for (int rep_ = 0; rep_ < 1 + ((REP_MASK >> 4) & 1); ++rep_) {
        pg8::Gemm g{YMIX, WOT, DM, DM, DM, 0, 0}; pg8::StaticOrder S; S.init(T, DM, G, bid);
        pg8::EpiOut E{a.x, a.out, HB, SSQ1}; pg8::gemm_phase<pg8::EpiOut, pg8::StaticOrder, false>(lds, g, S, E, wave);
    GRID_SYNC(); }


    { LANE_IDS
        pg8::StaticOrder S; S.init(T, DM, G, bid); pg8::Unit u0;
        LAS float* r2 = (LAS float*)(lds + R2_OFF);
        if (S.next(0, u0) && tid < 256) { const float* sp = SSQ1 + (size_t)(u0.pm * 256 + tid) * 32; float s = 0.f;
#pragma unroll
            for (int i = 0; i < 8; ++i) { const f32x4 v = ((const f32x4*)sp)[i]; s += (v[0] + v[1]) + (v[2] + v[3]); }
            r2[tid] = rsqrtf(s * (1.f / DM) + EPS); }
        __syncthreads();
        pg8::Gemm g{HB, WGT, DM, DM, DM, 0, 0};
        pg8::EpiGate E{a.out, PPB, SSQ2, (unsigned*)ws, a.norm_final, r2, HB}; pg8::gemm_phase<pg8::EpiGate, pg8::StaticOrder, false>(lds, g, S, E, wave);
    }
}

extern "C" void kernel_launch(void* const* d_in, const int* in_sizes, int n_in, void* d_out, int out_size, void* d_ws, size_t ws_size, hipStream_t stream) {
    static int grid = 0;
    if (grid == 0) {
        if (n_in != 21 || in_sizes[0] != T * DM || out_size != T * DM || ws_size < WS_END) { fprintf(stderr, "kernel_launch: unexpected shapes (n_in %d, in0 %d, out %d, ws %zu)\n", n_in, n_in > 0 ? in_sizes[0] : -1, out_size, ws_size); grid = -1; return; }
        int dev = 0, cus = 0, per_cu = 0;
        hipGetDevice(&dev); hipDeviceGetAttribute(&cus, hipDeviceAttributeMultiprocessorCount, dev);
        if (hipFuncSetAttribute((const void*)fwd_kernel, hipFuncAttributeMaxDynamicSharedMemorySize, LDS_BYTES) != hipSuccess) { fprintf(stderr, "kernel_launch: hipFuncSetAttribute failed\n"); grid = -1; return; }
        hipOccupancyMaxActiveBlocksPerMultiprocessor(&per_cu, (const void*)fwd_kernel, 512, LDS_BYTES);
        (void)hipGetLastError();
        if (per_cu < 1) fprintf(stderr, "kernel_launch: occupancy query reports %d blocks per CU\n", per_cu);
        grid = cus > 256 ? 256 : cus;
    }
    if (grid < 0) return;
    Args a{};
    const float** f = (const float**)&a;
    for (int i = 0; i < 21; ++i) f[i] = (const float*)d_in[i];
    a.out = (float*)d_out; a.ws = (unsigned char*)d_ws;
    if (hipMemsetAsync(d_ws, 0, WS_CTL_BYTES, stream) != hipSuccess) { fprintf(stderr, "kernel_launch: hipMemsetAsync failed\n"); return; }
    void* args[] = {&a};
    hipError_t e = hipLaunchCooperativeKernel((const void*)fwd_kernel, dim3(grid), dim3(512), args, LDS_BYTES, stream);
    if (e != hipSuccess) fprintf(stderr, "kernel_launch: cooperative launch failed: %s (grid %d)\n", hipGetErrorString(e), grid);
}
```

```cpp
#include <hip/hip_runtime.h>
#include <hip/hip_cooperative_groups.h>
#include <cstdio>
#include <cstdint>
namespace cg = cooperative_groups;

#define LAS __attribute__((address_space(3)))
typedef unsigned short bf16_t;
typedef short bf16x8 __attribute__((ext_vector_type(8)));
typedef short s16x4 __attribute__((ext_vector_type(4)));
typedef float f32x4 __attribute__((ext_vector_type(4)));
typedef float f32x16 __attribute__((ext_vector_type(16)));
typedef unsigned u32x4 __attribute__((ext_vector_type(4)));
typedef unsigned u32x2 __attribute__((ext_vector_type(2)));

constexpr int T = 8192, SEQ = 4096, DM = 2048, DIN = 4608, DATT = 1024, DKV = 256, DSSM = 1024, PLE = 256;
constexpr int NG = 64, NCH = T / 16;
constexpr float EPS = 1e-6f;
#ifndef PH_MASK
#define PH_MASK 0xff
#endif
#ifndef REP_MASK
#define REP_MASK 0
#endif

constexpr size_t MiB = 1u << 20;
constexpr size_t WS_W1T = 1 * MiB, WS_WGLUT = 19 * MiB, WS_WOT = 23 * MiB, WS_WGT = 31 * MiB, WS_WPT = 39 * MiB;
constexpr size_t WS_ROPE = 40 * MiB, WS_RINV = 40 * MiB + 65536, WS_LB16 = 40 * MiB + 131072, WS_SSQ1 = 41 * MiB, WS_SSQ2 = 42 * MiB;
constexpr size_t WS_PB = 43 * MiB, WS_WIN = 47 * MiB, WS_WBIG = 55 * MiB;
constexpr size_t WS_XB = 71 * MiB;
constexpr size_t WS_Q = 103 * MiB, WS_K = 119 * MiB, WS_V = 123 * MiB, WS_GA = 127 * MiB, WS_GS = 143 * MiB;
constexpr size_t WS_UCAT = 159 * MiB;
constexpr size_t WS_YMIX = 191 * MiB, WS_YS = 223 * MiB, WS_END = 239 * MiB;

constexpr int RING_BYTES = 131072, XCH_OFF = RING_BYTES, R2_OFF = RING_BYTES + 4096, XBST_OFF = RING_BYTES + 8192, LDS_BYTES = 147456;
constexpr size_t WS_BAR = 65536, WS_CTL_BYTES = 131072;

struct Args {
    const float *x, *p, *norm_mix, *w_in, *q_norm, *k_norm, *a_re, *a_im, *log_dt, *b_re, *b_im, *c_re, *c_im, *ssm_d, *w_glu, *b_glu, *w_out, *norm_ple, *w_ple_gate, *w_ple_proj, *norm_final;
    float* out; unsigned char* ws;
};

__device__ __forceinline__ unsigned f2bf(float f) { unsigned u = __builtin_bit_cast(unsigned, f); return (u + 0x7fffu + ((u >> 16) & 1u)) >> 16; }
__device__ __forceinline__ unsigned pk2(float lo, float hi) { return f2bf(lo) | (f2bf(hi) << 16); }
__device__ __forceinline__ float bf2f(unsigned short b) { return __builtin_bit_cast(float, (unsigned)b << 16); }
__device__ __forceinline__ float bflo(unsigned w) { return __builtin_bit_cast(float, w << 16); }
__device__ __forceinline__ float bfhi(unsigned w) { return __builtin_bit_cast(float, w & 0xffff0000u); }
__device__ __forceinline__ unsigned cvt_pk_bf16(float lo, float hi) { unsigned r; asm volatile("v_cvt_pk_bf16_f32 %0, %1, %2" : "=v"(r) : "v"(lo), "v"(hi)); return r; }
__device__ __forceinline__ float sigmoidf_(float v) { return 1.f / (1.f + __expf(-v)); }
__device__ __forceinline__ float siluf_(float v) { return v / (1.f + __expf(-v)); }
__device__ __forceinline__ float gelu_tanh(float v) { const float t = 1.5957691216057308f * (v + 0.044715f * v * v * v); return v / (1.f + __expf(-t)); }
template <int K> __device__ __forceinline__ float swz_xor(float v) { return __int_as_float(__builtin_amdgcn_ds_swizzle(__float_as_int(v), (K << 10) | 0x1f)); }
__device__ __forceinline__ float sum_xor32(float v) { auto rr = __builtin_amdgcn_permlane32_swap(__float_as_uint(v), __float_as_uint(v), false, false); return __uint_as_float(rr[0]) + __uint_as_float(rr[1]); }
__device__ __forceinline__ float wave_sum(float v) { v += swz_xor<1>(v); v += swz_xor<2>(v); v += swz_xor<4>(v); v += swz_xor<8>(v); v += swz_xor<16>(v); return sum_xor32(v); }
#define LDS_WAIT() asm volatile("s_waitcnt lgkmcnt(0)" ::: "memory")
__device__ __forceinline__ int lane_id_opaque() { int l = __builtin_amdgcn_mbcnt_hi(~0u, __builtin_amdgcn_mbcnt_lo(~0u, 0u)); asm volatile("" : "+v"(l)); return l; }

namespace pg8 {
constexpr int BM = 256, BK = 64, HALF = 128, HTB = HALF * BK * 2, NXCD = 8, WGM = 8;
__host__ __device__ __forceinline__ int lds_byte(int r, int c) { const int st = (r >> 4) * 2 + (c >> 5), rr = r & 15, cc = c & 31, ob = rr * 64 + cc * 2; return st * 1024 + (ob ^ (((ob >> 9) & 1) << 5)); }
__host__ __device__ __forceinline__ void stage_rc(int b, int& R, int& C) { const int st = b / 1024, sb = b % 1024, swz = sb ^ (((sb >> 9) & 1) << 5); R = (st >> 1) * 16 + swz / 64; C = (st & 1) * 32 + (swz % 64) / 2; }
__host__ __device__ __forceinline__ int perm32(int rho) { const int n = rho >> 4, i = rho & 15; return 8 * (i >> 2) + 4 * n + (i & 3); }

struct Unit { int pm, pn, z; };
struct Gemm { const bf16_t* A; const bf16_t* Bt; int K, lda, ldb; size_t zA, zB; };

struct StaticOrder {
    int nM, nN, nwg, G, c;
    __device__ void init(int M, int N, int G_, int c_) { nM = M / BM; nN = N / BM; nwg = nM * nN; G = G_; c = c_; }
    __device__ bool next(int i, Unit& u) const {
        const long L = (long)i * G + c; if (L >= nwg) return false;
        int wgid = (int)L; { const int q = nwg / NXCD, r = nwg % NXCD, xcd = wgid % NXCD, off = wgid / NXCD; wgid = (xcd < r ? xcd * (q + 1) : r * (q + 1) + (xcd - r) * q) + off; }
        const int nig = WGM * nN, gid = wgid / nig, fm = gid * WGM, gsz = (nM - fm) < WGM ? (nM - fm) : WGM;
        u.pm = fm + ((wgid % nig) % gsz); u.pn = (wgid % nig) / gsz; u.z = 0; return true;
    }
};
struct BatchOrder {
    int n, G, c;
    __device__ bool next(int i, Unit& u) const { const int L = i * G + c; if (L >= n) return false; u.z = L >> 1; u.pm = L & 1; u.pn = 0; return true; }
};

struct ListOrder {
    int L0, n, stride;
    __device__ bool next(int i, Unit& u) const { const int L = L0 + i * stride; if (L < 0 || L >= n) return false; u.pm = L >> 2; u.pn = L & 3; u.z = 0; return true; }
};
template <class Epi, class Sched, bool ALIGN_EPI>
__device__ __forceinline__ void gemm_phase(LAS unsigned char* lds, const Gemm g, const Sched& S, const Epi& E, const int wid) {
    const int lane = lane_id_opaque(), tid = wid * 64 + lane, wr = wid >> 2, wc = wid & 3, fr = lane & 15, fq = lane >> 4;
    const int K = g.K, nt = K / BK;
    unsigned voffA[2], voffB[2];
#pragma unroll
    for (int i = 0; i < 2; ++i) { int R, C; stage_rc(tid * 16 + i * 8192, R, C); const int Rb = (R & ~31) + perm32(R & 31);
        voffA[i] = (unsigned)(R * g.lda + C) * 2u; voffB[i] = (unsigned)(Rb * g.ldb + C) * 2u; }
    const size_t kstep = (size_t)(BK * 2);
    const size_t hstepA = (size_t)HALF * g.lda * 2, hstepB = (size_t)HALF * g.ldb * 2;
    const size_t tstepA = 2 * hstepA, tstepB = 2 * hstepB;
    const unsigned ldsw = (unsigned)wid * 1024u;
    const int aoff = lds_byte(wr * 64 + fr, fq * 8), boff = lds_byte(wc * 32 + fr, fq * 8);
#define PG8_SA(b, h) (((b) * 2 + (h)) * HTB)
#define PG8_SB(b, h) ((4 + (b) * 2 + (h)) * HTB)
#define PG8_STAGE(bufoff, gbase, voff) do { _Pragma("unroll") for (int _i = 0; _i < 2; ++_i) \
        __builtin_amdgcn_global_load_lds((const unsigned*)((const char*)(gbase) + (voff)[_i]), (LAS unsigned*)(lds + (bufoff) + ldsw + _i * 8192), 16, 0, 0); } while (0)
#define PG8_LDA(dst, b, h) do { _Pragma("unroll") for (int m = 0; m < 4; ++m) _Pragma("unroll") for (int k = 0; k < 2; ++k) dst[m][k] = *(const LAS bf16x8*)(lds + PG8_SA(b, h) + aoff + m * 2048 + k * 1024); } while (0)
#define PG8_LDB(dst, b, h) do { _Pragma("unroll") for (int n = 0; n < 2; ++n) _Pragma("unroll") for (int k = 0; k < 2; ++k) dst[n][k] = *(const LAS bf16x8*)(lds + PG8_SB(b, h) + boff + n * 2048 + k * 1024); } while (0)
#define PG8_MMA(ai, bj, At, Bt) do { __builtin_amdgcn_s_setprio(1); _Pragma("unroll") for (int m = 0; m < 4; ++m) _Pragma("unroll") for (int n = 0; n < 2; ++n) _Pragma("unroll") for (int k = 0; k < 2; ++k) \
        acc[ai][bj][m][n] = __builtin_amdgcn_mfma_f32_16x16x32_bf16(Bt[n][k], At[m][k], acc[ai][bj][m][n], 0, 0, 0); __builtin_amdgcn_s_setprio(0); } while (0)
#define PG8_WAIT_V(n) asm volatile("s_waitcnt vmcnt(" #n ")" ::: "memory")
#define PG8_WAIT_L(n) asm volatile("s_waitcnt lgkmcnt(" #n ")" ::: "memory")
#define PG8_BAR __builtin_amdgcn_s_barrier()
#define PG8_SCHED __builtin_amdgcn_sched_barrier(0)
    Unit cur, nxt; int ui = 0;
    if (!S.next(0, cur)) return;
    f32x4 acc[2][2][4][2];
#pragma unroll
    for (int a = 0; a < 2; ++a)
#pragma unroll
        for (int b = 0; b < 2; ++b)
#pragma unroll
            for (int m = 0; m < 4; ++m)
#pragma unroll
                for (int n = 0; n < 2; ++n) acc[a][b][m][n] = (f32x4){0.f, 0.f, 0.f, 0.f};
    bf16x8 At[4][2], B0[2][2], B1[2][2];
    const char* cA = (const char*)g.A + (size_t)cur.z * g.zA + (size_t)cur.pm * tstepA; const char* cB = (const char*)g.Bt + (size_t)cur.z * g.zB + (size_t)cur.pn * tstepB;
    PG8_STAGE(PG8_SB(0, 0), cB, voffB); PG8_STAGE(PG8_SB(0, 1), cB + hstepB, voffB); PG8_STAGE(PG8_SA(0, 0), cA, voffA); PG8_STAGE(PG8_SA(0, 1), cA + hstepA, voffA);
    if (wr == 1) PG8_BAR;
    PG8_WAIT_V(2); PG8_BAR;
    PG8_STAGE(PG8_SB(1, 0), cB + kstep, voffB); PG8_STAGE(PG8_SA(1, 0), cA + kstep, voffA); PG8_STAGE(PG8_SB(1, 1), cB + hstepB + kstep, voffB);
    PG8_WAIT_V(6); PG8_BAR;
    for (;;) {
        const bool has_next = S.next(ui + 1, nxt);
        const char* nA = has_next ? (const char*)g.A + (size_t)nxt.z * g.zA + (size_t)nxt.pm * tstepA : cA;
        const char* nB = has_next ? (const char*)g.Bt + (size_t)nxt.z * g.zB + (size_t)nxt.pn * tstepB : cB;
        for (int t = 0; t < nt; t += 2) {
            const bool last = (t == nt - 2);
            const char* a1 = cA + (size_t)(t + 1) * kstep;
            const char* a2 = last ? nA : cA + (size_t)(t + 2) * kstep; const char* b2 = last ? nB : cB + (size_t)(t + 2) * kstep;
            const char* a3 = a2 + kstep; const char* b3 = b2 + kstep;
            PG8_LDB(B0, 0, 0); PG8_LDB(B1, 0, 1); PG8_SCHED; PG8_LDA(At, 0, 0); PG8_STAGE(PG8_SA(1, 1), a1 + hstepA, voffA);
            PG8_WAIT_V(8); PG8_WAIT_L(0); PG8_BAR; PG8_MMA(0, 0, At, B0); PG8_MMA(0, 1, At, B1); PG8_BAR; PG8_SCHED;
            PG8_LDA(At, 0, 1); PG8_STAGE(PG8_SB(0, 0), b2, voffB); PG8_STAGE(PG8_SB(0, 1), b2 + hstepB, voffB); PG8_STAGE(PG8_SA(0, 0), a2, voffA);
            PG8_WAIT_V(8); PG8_WAIT_L(0); PG8_BAR; PG8_MMA(1, 0, At, B0); PG8_MMA(1, 1, At, B1); PG8_BAR; PG8_SCHED;
            PG8_LDB(B0, 1, 0); PG8_LDB(B1, 1, 1); PG8_SCHED; PG8_LDA(At, 1, 0); PG8_STAGE(PG8_SA(0, 1), a2 + hstepA, voffA);
            PG8_WAIT_V(8); PG8_WAIT_L(0); PG8_BAR; PG8_MMA(0, 0, At, B0); PG8_MMA(0, 1, At, B1); PG8_BAR; PG8_SCHED;
            PG8_LDA(At, 1, 1); PG8_STAGE(PG8_SB(1, 0), b3, voffB); PG8_STAGE(PG8_SB(1, 1), b3 + hstepB, voffB); PG8_STAGE(PG8_SA(1, 0), a3, voffA);
            PG8_WAIT_V(8); PG8_WAIT_L(0); PG8_BAR; PG8_MMA(1, 0, At, B0); PG8_MMA(1, 1, At, B1); PG8_BAR; PG8_SCHED;
        }
        if constexpr (ALIGN_EPI) { if (wr == 0) PG8_BAR; }
        if constexpr (!Epi::AFTER_DRAIN) E(acc, cur, wr, wc, fr, fq);
        if (!has_next) break;
#pragma unroll
        for (int a = 0; a < 2; ++a)
#pragma unroll
            for (int b = 0; b < 2; ++b)
#pragma unroll
                for (int m = 0; m < 4; ++m)
#pragma unroll
                    for (int n = 0; n < 2; ++n) acc[a][b][m][n] = (f32x4){0.f, 0.f, 0.f, 0.f};
        cur = nxt; cA = nA; cB = nB; ++ui;
        if constexpr (ALIGN_EPI) { if (wr == 1) PG8_BAR; }
    }
    PG8_WAIT_V(0);
    if constexpr (!ALIGN_EPI) { if (wr == 0) PG8_BAR; }
    PG8_BAR;
    if constexpr (Epi::AFTER_DRAIN) E.fused(acc, cur, wr, wc, lds, wid);
#undef PG8_SA
#undef PG8_SB
#undef PG8_STAGE
#undef PG8_LDA
#undef PG8_LDB
#undef PG8_MMA
#undef PG8_WAIT_V
#undef PG8_WAIT_L
#undef PG8_BAR
#undef PG8_SCHED
}

#define EPI_FOR_ROWS _Pragma("unroll") for (int ai = 0; ai < 2; ++ai) _Pragma("unroll") for (int m = 0; m < 4; ++m)
#define EPI_ROWDEF const int rit = ai * HALF + wr * 64 + m * 16 + fr; const int row = u.pm * BM + rit; (void)rit; (void)row;

struct Epi1 {
    static constexpr bool AFTER_DRAIN = false;
    const float* rinv; const float* qnw; const float* knw; const float2* rope;
    bf16_t *Q, *Kb, *Vb, *GA, *GS, *UCAT; LAS float* xch; int pn0;
    __device__ __forceinline__ void operator()(const f32x4 (&acc)[2][2][4][2], const Unit& u, int wr, int wc, int, int) const {
        const int l_ = lane_id_opaque(), fr = l_ & 15, fq = l_ >> 4;
        const int pn = u.pn + pn0;
        if (pn <= 4) {
            float ss[2][4];
            EPI_FOR_ROWS { EPI_ROWDEF const float r = rinv[row]; float s = 0.f;
#pragma unroll
                for (int bj = 0; bj < 2; ++bj)
#pragma unroll
                    for (int n = 0; n < 2; ++n) { const f32x4 v = acc[ai][bj][m][n] * r; s += (v[0] * v[0] + v[1] * v[1]) + (v[2] * v[2] + v[3] * v[3]); }
                s += swz_xor<16>(s); s = sum_xor32(s); ss[ai][m] = s;
                if (fq == 0) xch[wc * 256 + rit] = s; }
            LDS_WAIT(); __builtin_amdgcn_s_barrier(); asm volatile("" ::: "memory");
            const int half = wc & 1, hd = wc >> 1;
            const float* nw = (pn < 4 ? qnw : knw) + 64 * half + 8 * fq;
            float w1[8], w2[8];
#pragma unroll
            for (int i = 0; i < 8; ++i) { w1[i] = nw[i]; w2[i] = nw[32 + i]; }
            EPI_FOR_ROWS { EPI_ROWDEF const float tot = ss[ai][m] + xch[(wc ^ 1) * 256 + rit];
                const float sc = rinv[row] * rsqrtf(tot * (1.f / 128.f) + EPS);
                const int t = row & (SEQ - 1); const int pos = half ? (t & 63) : (t >> 6);
                const float2* rp = rope + pos * 32 + 8 * fq;
                float o1[8], o2[8];
#pragma unroll
                for (int n = 0; n < 2; ++n)
#pragma unroll
                    for (int e = 0; e < 4; ++e) { const int i = 4 * n + e; const float2 cs = rp[i];
                        const float x1 = acc[ai][0][m][n][e] * sc * w1[i], x2 = acc[ai][1][m][n][e] * sc * w2[i];
                        o1[i] = x1 * cs.x - x2 * cs.y; o2[i] = x2 * cs.x + x1 * cs.y; }
                bf16_t* dst = (pn < 4) ? Q + (size_t)row * DATT + (2 * pn + hd) * 128 + 64 * half + 8 * fq : Kb + (size_t)row * DKV + hd * 128 + 64 * half + 8 * fq;
                u32x4 a; a.x = pk2(o1[0], o1[1]); a.y = pk2(o1[2], o1[3]); a.z = pk2(o1[4], o1[5]); a.w = pk2(o1[6], o1[7]);
                u32x4 b; b.x = pk2(o2[0], o2[1]); b.y = pk2(o2[2], o2[3]); b.z = pk2(o2[4], o2[5]); b.w = pk2(o2[6], o2[7]);
                *(u32x4*)dst = a; *(u32x4*)(dst + 32) = b; }
        } else {
            const int lg0 = 4 * (wc >> 1) + 2 * (wc & 1);
            EPI_FOR_ROWS { EPI_ROWDEF const float r = rinv[row];
#pragma unroll
                for (int bj = 0; bj < 2; ++bj) { const int L = 256 * pn + 32 * (lg0 + bj) + 8 * fq;
                    f32x4 v0 = acc[ai][bj][m][0] * r, v1 = acc[ai][bj][m][1] * r; bf16_t* dst;
                    if (pn == 5) dst = Vb + (size_t)row * DKV + (L - 1280);
                    else if (pn < 10) dst = GA + (size_t)row * DATT + (L - 1536);
                    else if (pn < 14) { const int Lu = L - 2560; dst = UCAT + ((size_t)(Lu >> 4) * NCH + (row >> 4)) * 512 + (row & 15) * 16 + (Lu & 15); }
                    else dst = GS + (size_t)row * DSSM + (L - 3584);
                    if ((pn >= 6 && pn < 10) || pn >= 14) {
#pragma unroll
                        for (int e = 0; e < 4; ++e) { v0[e] = siluf_(v0[e]); v1[e] = siluf_(v1[e]); } }
                    u32x4 w; w.x = pk2(v0[0], v0[1]); w.y = pk2(v0[2], v0[3]); w.z = pk2(v1[0], v1[1]); w.w = pk2(v1[2], v1[3]);
                    *(u32x4*)dst = w; } }
        }
    }
};
struct EpiS1 {
    static constexpr bool AFTER_DRAIN = true;
    const float* lb16; bf16_t* UCAT;
    __device__ __forceinline__ void operator()(const f32x4 (&)[2][2][4][2], const Unit&, int, int, int, int) const {}
    __device__ __forceinline__ void fused(const f32x4 (&acc)[2][2][4][2], const Unit& u, int wr, int wc, LAS unsigned char* lds, int wid) const {
        const int l_ = lane_id_opaque(), fr = l_ & 15, fq = l_ >> 4;
        LAS float* Tl = (LAS float*)lds;
#pragma unroll
        for (int d = 0; d < 2; ++d) {
            EPI_FOR_ROWS { const int rit = ai * HALF + wr * 64 + m * 16 + fr; LAS float* rp = Tl + rit * 128 + wc * 32 + 8 * fq;
                *(LAS f32x4*)rp = acc[ai][d][m][0]; *(LAS f32x4*)(rp + 4) = acc[ai][d][m][1]; }
            LDS_WAIT(); __builtin_amdgcn_s_barrier(); asm volatile("" ::: "memory");
            {
                const int p = l_; const float lr = lb16[((u.z * 2 + d) * 64 + p) * 2], li = lb16[((u.z * 2 + d) * 64 + p) * 2 + 1];
                LAS float* SEG = (LAS float*)(lds + XCH_OFF);
                float xr = 0.f, xi = 0.f;
#pragma unroll 8
                for (int i = 0; i < 32; ++i) { const int cc = wid * 32 + i, c = d ? 255 - cc : cc;
                    const float sr = Tl[c * 128 + p], si = Tl[c * 128 + 64 + p];
                    Tl[c * 128 + p] = xr; Tl[c * 128 + 64 + p] = xi;
                    const float nr = lr * xr - li * xi + sr; xi = lr * xi + li * xr + si; xr = nr; }
                SEG[(wid * 64 + p) * 2] = xr; SEG[(wid * 64 + p) * 2 + 1] = xi;
                LDS_WAIT(); __builtin_amdgcn_s_barrier(); asm volatile("" ::: "memory");
                float l32r = lr, l32i = li;
#pragma unroll
                for (int q = 0; q < 5; ++q) { const float t = l32r * l32r - l32i * l32i; l32i = 2.f * l32r * l32i; l32r = t; }
                float er = 0.f, ei = 0.f;
                for (int j = 0; j < wid; ++j) { const float tr = SEG[(j * 64 + p) * 2], ti = SEG[(j * 64 + p) * 2 + 1];
                    const float nr = l32r * er - l32i * ei + tr; ei = l32r * ei + l32i * er + ti; er = nr; }
#pragma unroll 8
                for (int i = 0; i < 32; ++i) { const int cc = wid * 32 + i, c = d ? 255 - cc : cc;
                    const float tr = Tl[c * 128 + p] + er, ti = Tl[c * 128 + 64 + p] + ei;
                    Tl[c * 128 + p] = __uint_as_float(pk2(tr, ti));
                    const float nr = lr * er - li * ei; ei = lr * ei + li * er; er = nr; }
            }
            LDS_WAIT(); __builtin_amdgcn_s_barrier(); asm volatile("" ::: "memory");
            {   bf16_t* ub = UCAT + ((size_t)u.z * NCH + u.pm * 256) * 512 + 256 + d * 128;
#pragma unroll
                for (int i = 0; i < 8; ++i) { const int q = wid * 64 + l_ + 512 * i, r = q >> 4, c8 = (q & 15) * 8;
                    *(u32x4*)(ub + (size_t)r * 512 + c8) = *(const LAS u32x4*)((LAS bf16_t*)(Tl + r * 128) + c8); } }
            LDS_WAIT(); __builtin_amdgcn_s_barrier(); asm volatile("" ::: "memory");
        }
    }
};
struct EpiS2 {
    static constexpr bool AFTER_DRAIN = false;
    bf16_t* YS;
    __device__ __forceinline__ void operator()(const f32x4 (&acc)[2][2][4][2], const Unit& u, int wr, int wc, int, int) const {
        const int l_ = lane_id_opaque(), fr = l_ & 15, fq = l_ >> 4;
        EPI_FOR_ROWS { EPI_ROWDEF
#pragma unroll
            for (int bj = 0; bj < 2; ++bj) { const int c = bj * HALF + wc * 32 + 8 * fq; const int j = c >> 4, h0 = c & 15;
                const f32x4 v0 = acc[ai][bj][m][0], v1 = acc[ai][bj][m][1];
                u32x4 w; w.x = pk2(gelu_tanh(v0[0]), gelu_tanh(v0[1])); w.y = pk2(gelu_tanh(v0[2]), gelu_tanh(v0[3])); w.z = pk2(gelu_tanh(v1[0]), gelu_tanh(v1[1])); w.w = pk2(gelu_tanh(v1[2]), gelu_tanh(v1[3]));
                *(u32x4*)(YS + ((size_t)row * 16 + j) * DSSM + u.z * 16 + h0) = w; } }
    }
};
struct EpiGlu {
    static constexpr bool AFTER_DRAIN = false;
    const float* bglu; const bf16_t* GS; bf16_t* YMIX;
    __device__ __forceinline__ void operator()(const f32x4 (&acc)[2][2][4][2], const Unit& u, int wr, int wc, int, int) const {
        const int l_ = lane_id_opaque(), fr = l_ & 15, fq = l_ >> 4;
        const int a0 = 128 * u.pn + 32 * wc + 8 * fq;
        float bv[8], bg[8];
#pragma unroll
        for (int i = 0; i < 8; ++i) { bv[i] = bglu[a0 + i]; bg[i] = bglu[1024 + a0 + i]; }
        u32x4 gsv[2][4];
        EPI_FOR_ROWS { EPI_ROWDEF gsv[ai][m] = *(const u32x4*)(GS + (size_t)row * DSSM + a0); }
        EPI_FOR_ROWS { EPI_ROWDEF const u32x4 gs = gsv[ai][m];
            float o[8];
#pragma unroll
            for (int n = 0; n < 2; ++n)
#pragma unroll
                for (int e = 0; e < 4; ++e) { const int i = 4 * n + e; o[i] = (acc[ai][0][m][n][e] + bv[i]) * sigmoidf_(acc[ai][1][m][n][e] + bg[i]); }
            o[0] *= bflo(gs.x); o[1] *= bfhi(gs.x); o[2] *= bflo(gs.y); o[3] *= bfhi(gs.y); o[4] *= bflo(gs.z); o[5] *= bfhi(gs.z); o[6] *= bflo(gs.w); o[7] *= bfhi(gs.w);
            u32x4 w; w.x = pk2(o[0], o[1]); w.y = pk2(o[2], o[3]); w.z = pk2(o[4], o[5]); w.w = pk2(o[6], o[7]);
            *(u32x4*)(YMIX + (size_t)row * DM + 1024 + a0) = w; }
    }
};
struct EpiBf {
    static constexpr bool AFTER_DRAIN = false;
    bf16_t* O; int ldc;
    __device__ __forceinline__ void operator()(const f32x4 (&acc)[2][2][4][2], const Unit& u, int wr, int wc, int, int) const {
        const int l_ = lane_id_opaque(), fr = l_ & 15, fq = l_ >> 4;
        EPI_FOR_ROWS { EPI_ROWDEF
#pragma unroll
            for (int bj = 0; bj < 2; ++bj) { const f32x4 v0 = acc[ai][bj][m][0], v1 = acc[ai][bj][m][1];
                u32x4 w; w.x = pk2(v0[0], v0[1]); w.y = pk2(v0[2], v0[3]); w.z = pk2(v1[0], v1[1]); w.w = pk2(v1[2], v1[3]);
                *(u32x4*)(O + (size_t)row * ldc + u.pn * BM + bj * HALF + wc * 32 + 8 * fq) = w; } }
    }
};
struct EpiOut {
    static constexpr bool AFTER_DRAIN = false;
    const float* x; float* H; bf16_t* HB; float* ssq;
    __device__ __forceinline__ void operator()(const f32x4 (&acc)[2][2][4][2], const Unit& u, int wr, int wc, int, int) const {
        const int l_ = lane_id_opaque(), fr = l_ & 15, fq = l_ >> 4;
#pragma unroll
        for (int ai = 0; ai < 2; ++ai) {
            f32x4 xv[4][2][2];
#pragma unroll
            for (int m = 0; m < 4; ++m) { EPI_ROWDEF
#pragma unroll
                for (int bj = 0; bj < 2; ++bj) { const size_t off = (size_t)row * DM + u.pn * BM + bj * HALF + wc * 32 + 8 * fq; xv[m][bj][0] = *(const f32x4*)(x + off); xv[m][bj][1] = *(const f32x4*)(x + off + 4); } }
#pragma unroll
            for (int m = 0; m < 4; ++m) { EPI_ROWDEF float s = 0.f;
#pragma unroll
                for (int bj = 0; bj < 2; ++bj) { const size_t off = (size_t)row * DM + u.pn * BM + bj * HALF + wc * 32 + 8 * fq;
                    const f32x4 v0 = acc[ai][bj][m][0] + xv[m][bj][0], v1 = acc[ai][bj][m][1] + xv[m][bj][1];
                    s += (v0[0] * v0[0] + v0[1] * v0[1]) + (v0[2] * v0[2] + v0[3] * v0[3]) + (v1[0] * v1[0] + v1[1] * v1[1]) + (v1[2] * v1[2] + v1[3] * v1[3]);
                    u32x4 w; w.x = pk2(v0[0], v0[1]); w.y = pk2(v0[2], v0[3]); w.z = pk2(v1[0], v1[1]); w.w = pk2(v1[2], v1[3]);
                    *(u32x4*)(HB + off) = w; }
                s += swz_xor<16>(s); s = sum_xor32(s);
                if (fq == 0) ssq[(size_t)row * 32 + u.pn * 4 + wc] = s; }
        }
    }
};
struct EpiGate {
    static constexpr bool AFTER_DRAIN = true;
    float* H; const bf16_t* PP; float* ssq; unsigned* cnt; const float* nf; const LAS float* r2; const bf16_t* HBr;
    __device__ __forceinline__ void operator()(const f32x4 (&)[2][2][4][2], const Unit&, int, int, int, int) const {}
    __device__ __forceinline__ void fused(f32x4 (&acc)[2][2][4][2], const Unit& u, int wr, int wc, LAS unsigned char* lds, int wid) const {
        const int l_ = lane_id_opaque(), fr = l_ & 15, fq = l_ >> 4, tid = wid * 64 + l_;
        LAS float* P = (LAS float*)lds; LAS float* Rn = P + 1024;
        EPI_FOR_ROWS { EPI_ROWDEF float s = 0.f; const float r = r2[rit];
#pragma unroll
            for (int bj = 0; bj < 2; ++bj) { const size_t off = (size_t)row * DM + u.pn * BM + bj * HALF + wc * 32 + 8 * fq;
                const u32x4 pp = *(const u32x4*)(PP + off);
                const u32x4 hb = *(const u32x4*)(HBr + off);
                f32x4 h0 = {bflo(hb.x), bfhi(hb.x), bflo(hb.y), bfhi(hb.y)}, h1 = {bflo(hb.z), bfhi(hb.z), bflo(hb.w), bfhi(hb.w)};
                const f32x4 a0 = acc[ai][bj][m][0] * r, a1 = acc[ai][bj][m][1] * r;
                h0[0] += sigmoidf_(a0[0]) * bflo(pp.x); h0[1] += sigmoidf_(a0[1]) * bfhi(pp.x); h0[2] += sigmoidf_(a0[2]) * bflo(pp.y); h0[3] += sigmoidf_(a0[3]) * bfhi(pp.y);
                h1[0] += sigmoidf_(a1[0]) * bflo(pp.z); h1[1] += sigmoidf_(a1[1]) * bfhi(pp.z); h1[2] += sigmoidf_(a1[2]) * bflo(pp.w); h1[3] += sigmoidf_(a1[3]) * bfhi(pp.w);
                acc[ai][bj][m][0] = h0; acc[ai][bj][m][1] = h1;
                s += (h0[0] * h0[0] + h0[1] * h0[1]) + (h0[2] * h0[2] + h0[3] * h0[3]) + (h1[0] * h1[0] + h1[1] * h1[1]) + (h1[2] * h1[2] + h1[3] * h1[3]); }
            s += swz_xor<16>(s); s = sum_xor32(s);
            if (fq == 0) P[rit * 4 + wc] = s; }
        LDS_WAIT(); __builtin_amdgcn_s_barrier(); asm volatile("" ::: "memory");
        if (tid < 256) { const float t = (P[tid * 4] + P[tid * 4 + 1]) + (P[tid * 4 + 2] + P[tid * 4 + 3]);
            __hip_atomic_store(ssq + (size_t)(u.pm * 256 + tid) * 8 + u.pn, t, __ATOMIC_RELAXED, __HIP_MEMORY_SCOPE_AGENT); }
        asm volatile("s_waitcnt vmcnt(0)" ::: "memory");
        if (wid < 4 && l_ == 0) __hip_atomic_fetch_add(cnt + 64 * u.pm, 1u, __ATOMIC_RELAXED, __HIP_MEMORY_SCOPE_AGENT);
        if (wid == 0) {
            unsigned sp = 0;
            while ((unsigned)__builtin_amdgcn_readfirstlane(__hip_atomic_load(cnt + 64 * u.pm, __ATOMIC_RELAXED, __HIP_MEMORY_SCOPE_AGENT)) < 32u) { __builtin_amdgcn_s_sleep(2); if (++sp > (1u << 22)) break; }
            __builtin_amdgcn_fence(__ATOMIC_ACQUIRE, "agent");
        }
        asm volatile("s_waitcnt vmcnt(0) lgkmcnt(0)" ::: "memory"); __builtin_amdgcn_s_barrier(); asm volatile("" ::: "memory");
        if (tid < 256) { const float* sp = ssq + (size_t)(u.pm * 256 + tid) * 8; float t = 0.f;
#pragma unroll
            for (int i = 0; i < 8; ++i) t += __hip_atomic_load(sp + i, __ATOMIC_RELAXED, __HIP_MEMORY_SCOPE_AGENT);
            Rn[tid] = rsqrtf(t * (1.f / DM) + EPS); }
        LDS_WAIT(); __builtin_amdgcn_s_barrier(); asm volatile("" ::: "memory");
        EPI_FOR_ROWS { EPI_ROWDEF const float rn = Rn[rit];
#pragma unroll
            for (int bj = 0; bj < 2; ++bj) { const int col = u.pn * BM + bj * HALF + wc * 32 + 8 * fq; const size_t off = (size_t)row * DM + col;
                *(f32x4*)(H + off) = acc[ai][bj][m][0] * rn * *(const f32x4*)(nf + col); *(f32x4*)(H + off + 4) = acc[ai][bj][m][1] * rn * *(const f32x4*)(nf + col + 4); } }
    }
};
}

namespace att {
constexpr int D = 128, NW = 8, QBLK = 32, KVBLK = 64;
constexpr float SCALE = 0.088388347648318440f;
constexpr float THR = 8.f;
constexpr int LDQ = DATT, LDK = DKV;
constexpr size_t SHM_V = KVBLK * D * 2, SHM_K = KVBLK * D * 2, SHM_ATTN = 2 * SHM_V + 2 * SHM_K + NW * 64 * 4;
#define KSWZ(row, colB) ((row) * 256 + ((colB) ^ (((row) & 7) << 4)))
#define SBAR() __builtin_amdgcn_sched_barrier(0)
__device__ __forceinline__ int crow(int r, int hi) { return (r & 3) + 8 * (r >> 2) + 4 * hi; }
__device__ __forceinline__ void partialSM(f32x16& p0, f32x16& p1, float& m_reg, float& mn, float& alpha) {
  constexpr float C = SCALE * 1.4426950408889634f;
  float pmax = p0[0]; for (int r = 1; r < 16; ++r) pmax = fmaxf(pmax, p0[r]); for (int r = 0; r < 16; ++r) pmax = fmaxf(pmax, p1[r]);
  { auto rr = __builtin_amdgcn_permlane32_swap(__float_as_uint(pmax), __float_as_uint(pmax), false, false);
    pmax = fmaxf(__uint_as_float(rr[0]), __uint_as_float(rr[1])); }
  if (__builtin_expect(__all(pmax - m_reg <= THR / SCALE), 1)) { mn = m_reg; alpha = 1.f; }
  else { mn = fmaxf(m_reg, pmax); alpha = __builtin_amdgcn_exp2f((m_reg - mn) * C); m_reg = mn; }
  float mnC = -mn * C;
  for (int r = 0; r < 16; ++r) p0[r] = fmaf(p0[r], C, mnC); for (int r = 0; r < 16; ++r) p1[r] = fmaf(p1[r], C, mnC);
  for (int r = 0; r < 16; ++r) p0[r] = __builtin_amdgcn_exp2f(p0[r]);
}
__device__ __forceinline__ void finishSM(f32x16& p0, f32x16& p1, float alpha, float& l_reg, bf16x8& pa0, bf16x8& pa1, bf16x8& pa2, bf16x8& pa3) {
  for (int r = 0; r < 16; ++r) p1[r] = __builtin_amdgcn_exp2f(p1[r]);
  float ps = 0; for (int r = 0; r < 16; ++r) ps += p0[r]; for (int r = 0; r < 16; ++r) ps += p1[r];
  { auto rr = __builtin_amdgcn_permlane32_swap(__float_as_uint(ps), __float_as_uint(ps), false, false);
    ps = __uint_as_float(rr[0]) + __uint_as_float(rr[1]); }
  l_reg = l_reg * alpha + ps;
#define PK4(P, BASE, OUT) do { unsigned a0 = cvt_pk_bf16(P[BASE + 0], P[BASE + 1]), a1 = cvt_pk_bf16(P[BASE + 2], P[BASE + 3]);   \
    unsigned b0 = cvt_pk_bf16(P[BASE + 4], P[BASE + 5]), b1 = cvt_pk_bf16(P[BASE + 6], P[BASE + 7]);                              \
    auto r0 = __builtin_amdgcn_permlane32_swap(a0, b0, false, false); auto r1 = __builtin_amdgcn_permlane32_swap(a1, b1, false, false); \
    u32x4 w = {r0[0], r1[0], r0[1], r1[1]}; OUT = *reinterpret_cast<bf16x8*>(&w); } while (0)
  PK4(p0, 0, pa0); PK4(p0, 8, pa1); PK4(p1, 0, pa2); PK4(p1, 8, pa3);
#undef PK4
}
__device__ __forceinline__ void qkt(f32x16& p0, f32x16& p1, const bf16_t* Ks, const bf16x8* qr, int r32, int hi) {
  p0 = f32x16{}; p1 = f32x16{};
  for (int d0 = 0; d0 < 8; ++d0) { int cb = (d0 * 16 + hi * 8) * 2;
    bf16x8 b0 = *reinterpret_cast<const bf16x8*>((const char*)Ks + KSWZ(r32, cb));
    bf16x8 b1 = *reinterpret_cast<const bf16x8*>((const char*)Ks + KSWZ(32 + r32, cb));
    p0 = __builtin_amdgcn_mfma_f32_32x32x16_bf16(b0, qr[d0], p0, 0, 0, 0);
    p1 = __builtin_amdgcn_mfma_f32_32x32x16_bf16(b1, qr[d0], p1, 0, 0, 0); }
}
__device__ __forceinline__ int v_st(int k, int c) { const int kk = (k & ~0xC) | ((k & 4) << 1) | ((k & 8) >> 1); return ((kk >> 3) * 4 + (c >> 5)) * 512 + ((kk & 7) * 32 + (c & 31)) * 2; }
__device__ __forceinline__ int v_rd_base(int lane) { return ((lane & 3) << 3) | (((lane >> 2) & 3) << 6) | (((lane >> 4) & 1) << 5) | (((lane >> 5) & 1) << 8); }
constexpr int v_rd_off(int d0, int ks, int half) { return d0 * 512 + ks * 4096 + half * 2048; }
template <int OFF> __device__ __forceinline__ s16x4 tr_read(int vb) {
  s16x4 r; asm volatile("ds_read_b64_tr_b16 %0, %1 offset:%2" : "=&v"(r) : "v"(vb), "i"(OFF) : "memory"); return r;
}
template <int D0> __device__ __forceinline__ void pv_one(f32x16& od, int vb, bf16x8 pa0, bf16x8 pa1, bf16x8 pa2, bf16x8 pa3) {
  const s16x4 l0 = tr_read<v_rd_off(D0, 0, 0)>(vb), h0 = tr_read<v_rd_off(D0, 0, 1)>(vb), l1 = tr_read<v_rd_off(D0, 1, 0)>(vb), h1 = tr_read<v_rd_off(D0, 1, 1)>(vb);
  const s16x4 l2 = tr_read<v_rd_off(D0, 2, 0)>(vb), h2 = tr_read<v_rd_off(D0, 2, 1)>(vb), l3 = tr_read<v_rd_off(D0, 3, 0)>(vb), h3 = tr_read<v_rd_off(D0, 3, 1)>(vb);
  asm volatile("s_waitcnt lgkmcnt(0)" ::: "memory"); SBAR();
#define PK(L, H) (bf16x8){L[0], L[1], L[2], L[3], H[0], H[1], H[2], H[3]}
  od = __builtin_amdgcn_mfma_f32_32x32x16_bf16(pa0, PK(l0, h0), od, 0, 0, 0);
  od = __builtin_amdgcn_mfma_f32_32x32x16_bf16(pa1, PK(l1, h1), od, 0, 0, 0);
  od = __builtin_amdgcn_mfma_f32_32x32x16_bf16(pa2, PK(l2, h2), od, 0, 0, 0);
  od = __builtin_amdgcn_mfma_f32_32x32x16_bf16(pa3, PK(l3, h3), od, 0, 0, 0);
#undef PK
}
__device__ __forceinline__ void pv_d0(f32x16* o, int vb, bf16x8 pa0, bf16x8 pa1, bf16x8 pa2, bf16x8 pa3) {
  pv_one<0>(o[0], vb, pa0, pa1, pa2, pa3); pv_one<1>(o[1], vb, pa0, pa1, pa2, pa3); pv_one<2>(o[2], vb, pa0, pa1, pa2, pa3); pv_one<3>(o[3], vb, pa0, pa1, pa2, pa3);
}
__device__ __forceinline__ void attn_dense_body(const bf16_t* __restrict__ Qb, const bf16_t* __restrict__ Kh, const bf16_t* __restrict__ Vh,
                                                const bf16_t* __restrict__ Gb, bf16_t* __restrict__ Yb, int seq, char* lds, const int wid) {
  const int lane = lane_id_opaque(), tid = wid * 64 + lane, r32 = lane & 31, hi = lane >> 5;
  bf16_t* V_lds = (bf16_t*)lds; bf16_t* K_lds = (bf16_t*)(lds + 2 * SHM_V);
  float* ws = (float*)(lds + 2 * SHM_V + 2 * SHM_K) + wid * 64; float* li_l = ws; float* al_l = ws + 32;
  float m_reg = -1e30f, l_reg = 0; f32x16 o[4] = {}; bf16x8 qr[8];
  const bf16_t* Qw = Qb + (long)(wid * QBLK + r32) * LDQ + hi * 8;
#pragma unroll
  for (int d0 = 0; d0 < 8; ++d0) qr[d0] = *reinterpret_cast<const bf16x8*>(Qw + d0 * 16);
  const int sr = tid >> 4, sc = (tid & 15) * 8, vst0 = v_st(sr, sc), vst1 = v_st(32 + sr, sc);
  const int vb0 = (int)(uintptr_t)V_lds + v_rd_base(lane);
  struct { bf16x8 vs0, vs1, ks0, ks1; } sr_[2];
#define SLOAD(i, k0) do { sr_[i].vs0 = *reinterpret_cast<const bf16x8*>(&Vh[(long)((k0) + sr) * LDK + sc]); sr_[i].vs1 = *reinterpret_cast<const bf16x8*>(&Vh[(long)((k0) + 32 + sr) * LDK + sc]); \
    sr_[i].ks0 = *reinterpret_cast<const bf16x8*>(&Kh[(long)((k0) + sr) * LDK + sc]); sr_[i].ks1 = *reinterpret_cast<const bf16x8*>(&Kh[(long)((k0) + 32 + sr) * LDK + sc]); } while (0)
#define SWRITE(b, i) do { *(bf16x8*)((char*)V_lds + (b) * SHM_V + vst0) = sr_[i].vs0;          \
    *(bf16x8*)((char*)V_lds + (b) * SHM_V + vst1) = sr_[i].vs1; int kc = sc * 2;               \
    *(bf16x8*)((char*)K_lds + (b) * SHM_K + KSWZ(sr, kc)) = sr_[i].ks0;                       \
    *(bf16x8*)((char*)K_lds + (b) * SHM_K + KSWZ(32 + sr, kc)) = sr_[i].ks1; } while (0)
#define SWAIT() asm volatile("s_waitcnt vmcnt(4)" ::: "memory")
#define RESC(a) do { if (__any((a) < 1.f)) { if (hi == 0) al_l[r32] = (a); asm volatile("s_waitcnt lgkmcnt(0)" ::: "memory"); \
    for (int d = 0; d < 4; ++d) for (int r = 0; r < 16; ++r) o[d][r] *= al_l[crow(r, hi)]; } } while (0)
  f32x16 pA0, pA1, pB0, pB1; float mnA, mnB, alA, alB; bf16x8 pa0, pa1, pa2, pa3; const int NT = seq / KVBLK;
  constexpr int SE = 0, SO = 1;
  SLOAD(SE, 0); asm volatile("s_waitcnt vmcnt(0)" ::: "memory"); SWRITE(0, SE); __syncthreads();
  qkt(pA0, pA1, K_lds, qr, r32, hi); partialSM(pA0, pA1, m_reg, mnA, alA);
  SLOAD(SO, KVBLK); if (2 < NT) SLOAD(SE, 2 * KVBLK);
  SWAIT(); SWRITE(1, SO); __syncthreads();
  for (int j = 1; j + 1 < NT; j += 2) {
    SBAR(); qkt(pB0, pB1, (bf16_t*)((char*)K_lds + SHM_K), qr, r32, hi);
    finishSM(pA0, pA1, alA, l_reg, pa0, pa1, pa2, pa3); SBAR();
    SLOAD(SO, (j + 2) * KVBLK); SBAR();
    pv_d0(o, vb0, pa0, pa1, pa2, pa3); partialSM(pB0, pB1, m_reg, mnB, alB);
    __syncthreads(); SWAIT(); SWRITE(0, SE);
    RESC(alB); __syncthreads();
    SBAR(); qkt(pA0, pA1, K_lds, qr, r32, hi);
    finishSM(pB0, pB1, alB, l_reg, pa0, pa1, pa2, pa3); SBAR();
    if (j + 3 < NT) SLOAD(SE, (j + 3) * KVBLK); SBAR();
    pv_d0(o, vb0 + (int)SHM_V, pa0, pa1, pa2, pa3); partialSM(pA0, pA1, m_reg, mnA, alA);
    __syncthreads(); SWAIT(); SWRITE(1, SO);
    RESC(alA); __syncthreads();
  }
  SBAR(); qkt(pB0, pB1, (bf16_t*)((char*)K_lds + SHM_K), qr, r32, hi);
  finishSM(pA0, pA1, alA, l_reg, pa0, pa1, pa2, pa3); SBAR();
  pv_d0(o, vb0, pa0, pa1, pa2, pa3); partialSM(pB0, pB1, m_reg, mnB, alB);
  __syncthreads(); RESC(alB);
  finishSM(pB0, pB1, alB, l_reg, pa0, pa1, pa2, pa3); SBAR();
  pv_d0(o, vb0 + (int)SHM_V, pa0, pa1, pa2, pa3);
  if (hi == 0) li_l[r32] = l_reg; asm volatile("s_waitcnt lgkmcnt(0)" ::: "memory");
  float rli[16];
#pragma unroll
  for (int r = 0; r < 16; ++r) rli[r] = __builtin_amdgcn_rcpf(li_l[crow(r, hi)]);
  bf16_t* Yw = Yb + (long)(wid * QBLK) * DM; const bf16_t* Gw = Gb + (long)(wid * QBLK) * DATT;
  __syncthreads();
  bf16_t* stg = (bf16_t*)(lds + wid * 8192);
#pragma unroll
  for (int r = 0; r < 16; ++r) { const int orow = crow(r, hi);
#pragma unroll
    for (int d0 = 0; d0 < 4; ++d0) stg[orow * 128 + d0 * 32 + r32] = (bf16_t)f2bf(o[d0][r] * rli[r]); }
  asm volatile("s_waitcnt lgkmcnt(0)" ::: "memory");
  const int l2 = lane_id_opaque();
#pragma unroll
  for (int i = 0; i < 8; ++i) { const int q = l2 + 64 * i, row = q >> 4, c8 = (q & 15) * 8;
    const u32x4 v = *(const u32x4*)(stg + row * 128 + c8); const u32x4 gg = *(const u32x4*)(Gw + (unsigned)(row * DATT + c8));
    u32x4 w; w.x = pk2(bflo(v.x) * bflo(gg.x), bfhi(v.x) * bfhi(gg.x)); w.y = pk2(bflo(v.y) * bflo(gg.y), bfhi(v.y) * bfhi(gg.y));
    w.z = pk2(bflo(v.z) * bflo(gg.z), bfhi(v.z) * bfhi(gg.z)); w.w = pk2(bflo(v.w) * bflo(gg.w), bfhi(v.w) * bfhi(gg.w));
    *(u32x4*)(Yw + (unsigned)(row * DM + c8)) = w; }
  __syncthreads();
#undef SLOAD
#undef SWRITE
#undef SWAIT
#undef RESC
}
#undef SBAR
}

__device__ __forceinline__ void p0_transpose_item(const float* W, int K, int N, bf16_t* WT, int wt_row0, const float* kscale, LAS float* scr, int k0, int n0, int lane) {
#pragma unroll
    for (int i = 0; i < 32; ++i) { const int kk = 2 * i + (lane >> 5); float v = W[(size_t)(k0 + kk) * N + n0 + (lane & 31)]; if (kscale) v *= kscale[k0 + kk]; scr[kk * 33 + (lane & 31)] = v; }
    LDS_WAIT(); asm volatile("" ::: "memory");
    const int c = lane & 7;
#pragma unroll
    for (int j = 0; j < 4; ++j) { const int n = (lane >> 3) + 8 * j; const LAS float* s = scr + (8 * c) * 33 + n;
        u32x4 o; o.x = pk2(s[0 * 33], s[1 * 33]); o.y = pk2(s[2 * 33], s[3 * 33]); o.z = pk2(s[4 * 33], s[5 * 33]); o.w = pk2(s[6 * 33], s[7 * 33]);
        *(u32x4*)(WT + (size_t)(wt_row0 + n) * K + k0 + 8 * c) = o; }
    LDS_WAIT(); asm volatile("" ::: "memory");
}

struct TrItem { const float* W; bf16_t* WT; const float* kscale; int K, N, wt_row0, k0, n0; };
__device__ __forceinline__ void p0_tr_load(const TrItem& d, float (&v)[32], int lane) {
#pragma unroll
    for (int i = 0; i < 32; ++i) { const int kk = 2 * i + (lane >> 5); v[i] = d.W[(size_t)(d.k0 + kk) * d.N + d.n0 + (lane & 31)]; }
    if (d.kscale) {
#pragma unroll
        for (int i = 0; i < 32; ++i) { const int kk = 2 * i + (lane >> 5); v[i] *= d.kscale[d.k0 + kk]; } }
}
__device__ __forceinline__ void p0_tr_store(const TrItem& d, const float (&v)[32], LAS float* scr, int lane) {
#pragma unroll
    for (int i = 0; i < 32; ++i) { const int kk = 2 * i + (lane >> 5); scr[kk * 33 + (lane & 31)] = v[i]; }
    LDS_WAIT(); asm volatile("" ::: "memory");
    const int c = lane & 7;
#pragma unroll
    for (int j = 0; j < 4; ++j) { const int n = (lane >> 3) + 8 * j; const LAS float* s = scr + (8 * c) * 33 + n;
        u32x4 o; o.x = pk2(s[0 * 33], s[1 * 33]); o.y = pk2(s[2 * 33], s[3 * 33]); o.z = pk2(s[4 * 33], s[5 * 33]); o.w = pk2(s[6 * 33], s[7 * 33]);
        *(u32x4*)(d.WT + (size_t)(d.wt_row0 + n) * d.K + d.k0 + 8 * c) = o; }
    LDS_WAIT(); asm volatile("" ::: "memory");
}
__device__ __forceinline__ void ssm_tables(const Args& a, int g, LAS unsigned char* lds, int tid) {
    LAS float* LD = (LAS float*)lds;
    LAS float* LBs = LD + 256;
    LAS float* BB = LBs + 256;
    LAS float* KT = BB + 4096;
    LAS float* CC = KT + 8192;
    float* lb16 = (float*)(a.ws + WS_LB16);
    bf16_t* WIN = (bf16_t*)(a.ws + WS_WIN) + (size_t)g * 256 * 256;
    bf16_t* WBIG = (bf16_t*)(a.ws + WS_WBIG) + (size_t)g * 256 * 512;
    for (int e = tid; e < 2048; e += 512) { const int d = e >> 10, r = e & 1023; const size_t ci_ = (size_t)(d * NG + g) * 1024 + r; CC[e * 2] = a.c_re[ci_]; CC[e * 2 + 1] = a.c_im[ci_]; }
    if (tid < 128) {
        const int d = tid >> 6, p = tid & 63; const int idx = (d * NG + g) * 64 + p;
        const float lr = fminf(a.a_re[idx], -1e-4f), li = a.a_im[idx];
        const float dt = expf(a.log_dt[d * NG + g]);
        const float er = expf(lr * dt); float sn, cs; sincosf(li * dt, &sn, &cs);
        const float br = er * cs, bi = er * sn;
        LD[tid * 2] = lr * dt; LD[tid * 2 + 1] = li * dt; LBs[tid * 2] = br; LBs[tid * 2 + 1] = bi;
        const float nr = br - 1.f, ni = bi, den = lr * lr + li * li;
        KT[tid * 2] = (nr * lr + ni * li) / den; KT[tid * 2 + 1] = (ni * lr - nr * li) / den;
        const float e16 = expf(16.f * lr * dt); float s16, c16; sincosf(16.f * li * dt, &s16, &c16);
        lb16[(g * 128 + tid) * 2] = e16 * c16; lb16[(g * 128 + tid) * 2 + 1] = e16 * s16;
    }
    __syncthreads();
    for (int e = tid; e < 2048; e += 512) {
        const int dp = e >> 4, h = e & 15, d = dp >> 6, p = dp & 63;
        const size_t bi_ = ((size_t)(d * NG + g) * 64 + p) * 16 + h;
        const float xr = a.b_re[bi_], xi = a.b_im[bi_], cr = KT[dp * 2], ci = KT[dp * 2 + 1];
        BB[e * 2] = cr * xr - ci * xi; BB[e * 2 + 1] = cr * xi + ci * xr;
    }
    __syncthreads();
    {
        const int d = tid >> 8, hp = (tid >> 4) & 15, h = tid & 15; float acc[16];
#pragma unroll
        for (int t = 0; t < 16; ++t) acc[t] = 0.f;
        const LAS float* cc = CC + ((d * 16 + hp) * 64) * 2;
        for (int p = 0; p < 64; ++p) {
            const float c_r = cc[p * 2], c_i = cc[p * 2 + 1], b_r = BB[((d * 64 + p) * 16 + h) * 2], b_i = BB[((d * 64 + p) * 16 + h) * 2 + 1];
            float wr = c_r * b_r - c_i * b_i, wi = c_r * b_i + c_i * b_r; const float l_r = LBs[(d * 64 + p) * 2], l_i = LBs[(d * 64 + p) * 2 + 1];
#pragma unroll
            for (int t = 0; t < 16; ++t) { acc[t] += wr; const float nr = wr * l_r - wi * l_i; wi = wr * l_i + wi * l_r; wr = nr; }
        }
#pragma unroll
        for (int t = 0; t < 16; ++t) KT[((d * 16 + t) * 16 + hp) * 16 + h] = acc[t];
    }
    __syncthreads();
    for (int q = tid; q < 8192; q += 512) {
        const int n = q >> 5, kc = q & 31, s = kc >> 1, h0 = (kc & 1) * 8, j = n >> 4, hp = n & 15;
        float v[8];
#pragma unroll
        for (int e = 0; e < 8; ++e) { const int h = h0 + e;
            if (s < j) v[e] = KT[((0 * 16 + (j - s)) * 16 + hp) * 16 + h];
            else if (s > j) v[e] = KT[((1 * 16 + (s - j)) * 16 + hp) * 16 + h];
            else v[e] = KT[((0 * 16 + 0) * 16 + hp) * 16 + h] + KT[((1 * 16 + 0) * 16 + hp) * 16 + h] + (h == hp ? a.ssm_d[g * 16 + h] : 0.f); }
        u32x4 w; w.x = pk2(v[0], v[1]); w.y = pk2(v[2], v[3]); w.z = pk2(v[4], v[5]); w.w = pk2(v[6], v[7]);
        *(u32x4*)(WBIG + (size_t)n * 512 + s * 16 + h0) = w;
    }
    for (int q = tid; q < 2048; q += 512) {
        const int p = q & 63, js = (q >> 6) & 15, d = q >> 10; const float ldr = LD[(d * 64 + p) * 2], ldi = LD[(d * 64 + p) * 2 + 1];
        {   const float pw = (float)(d == 0 ? js + 1 : 16 - js); const float er = expf(pw * ldr); float sn, cs; sincosf(pw * ldi, &sn, &cs); const float pr = er * cs, pi = er * sn;
#pragma unroll
            for (int hp = 0; hp < 16; ++hp) { const float c_r = CC[((d * 16 + hp) * 64 + p) * 2], c_i = CC[((d * 16 + hp) * 64 + p) * 2 + 1];
                *(unsigned*)(WBIG + (size_t)(js * 16 + hp) * 512 + 256 + d * 128 + 2 * p) = pk2(c_r * pr - c_i * pi, -(c_r * pi + c_i * pr)); } }
        {   const float pw = (float)(d == 0 ? 15 - js : js); const float er = expf(pw * ldr); float sn, cs; sincosf(pw * ldi, &sn, &cs); const float pr = er * cs, pi = er * sn;
            float zr[16], zi[16];
#pragma unroll
            for (int h = 0; h < 16; ++h) { const float b_r = BB[((d * 64 + p) * 16 + h) * 2], b_i = BB[((d * 64 + p) * 16 + h) * 2 + 1]; zr[h] = pr * b_r - pi * b_i; zi[h] = pr * b_i + pi * b_r; }
            bf16_t* d0 = WIN + (size_t)(d * 128 + p) * 256 + js * 16; bf16_t* d1 = d0 + (size_t)64 * 256;
            u32x4 w; w.x = pk2(zr[0], zr[1]); w.y = pk2(zr[2], zr[3]); w.z = pk2(zr[4], zr[5]); w.w = pk2(zr[6], zr[7]); *(u32x4*)d0 = w;
            w.x = pk2(zr[8], zr[9]); w.y = pk2(zr[10], zr[11]); w.z = pk2(zr[12], zr[13]); w.w = pk2(zr[14], zr[15]); *(u32x4*)(d0 + 8) = w;
            w.x = pk2(zi[0], zi[1]); w.y = pk2(zi[2], zi[3]); w.z = pk2(zi[4], zi[5]); w.w = pk2(zi[6], zi[7]); *(u32x4*)d1 = w;
            w.x = pk2(zi[8], zi[9]); w.y = pk2(zi[10], zi[11]); w.z = pk2(zi[12], zi[13]); w.w = pk2(zi[14], zi[15]); *(u32x4*)(d1 + 8) = w; }
    }
    __syncthreads();
}

#define XB_TMO      128
#define XB_XCNT(j)  (256  + 64 * (j))
#define XB_XSUB(j)  (1280 + 64 * (j))
#define XB_XGEN(j)  (2304 + 64 * (j))
#define XB_TOP      3328
#define XB_TOPGEN   3392
#define XCD_BAR_WORDS 3456
#define XB_SPIN_CAP (1u << 18)
__device__ __forceinline__ unsigned xb_ld(unsigned* p)              { return __hip_atomic_load(p, __ATOMIC_RELAXED, __HIP_MEMORY_SCOPE_AGENT); }
__device__ __forceinline__ unsigned xb_add(unsigned* p, unsigned v) { return __hip_atomic_fetch_add(p, v, __ATOMIC_RELAXED, __HIP_MEMORY_SCOPE_AGENT); }
__device__ __forceinline__ unsigned xb_xcc_id() { return (unsigned)__builtin_amdgcn_s_getreg((3 << 11) | 20) & 0xFu; }
#define XB_SPIN(cond, bar) do { unsigned _sp = 0; while (cond) { __builtin_amdgcn_s_sleep(1); \
    if ((++_sp & 255u) == 0u) { if (xb_ld(&(bar)[XB_TMO])) break; if (_sp > XB_SPIN_CAP) { atomicAdd(&(bar)[XB_TMO], 1u); break; } } } } while (0)
struct XcdBarrier { unsigned* bar; unsigned x; volatile LAS unsigned* st; };
__device__ __forceinline__ XcdBarrier xcd_barrier_post(unsigned* bar, volatile LAS unsigned* st, bool leader) {
    XcdBarrier b; b.bar = bar; b.x = xb_xcc_id(); b.st = st;
    if (leader) (void)xb_add(&bar[XB_XCNT(b.x)], 1u);
    return b;
}
__device__ __forceinline__ void xcd_barrier_complete(unsigned* bar, unsigned x, unsigned& nloc, unsigned& nx) {
    const unsigned G = gridDim.x * gridDim.y * gridDim.z;
    unsigned sum, cnt, mine, sp = 0u;
    for (;;) {
        sum = 0u; cnt = 0u; mine = 0u;
#pragma unroll
        for (unsigned j = 0; j < 16; ++j) { const unsigned c = xb_ld(&bar[XB_XCNT(j)]); sum += c; cnt += (c > 0u) ? 1u : 0u; mine = (j == x) ? c : mine; }
        if (sum == G) break;
        __builtin_amdgcn_s_sleep(1);
        if ((++sp & 255u) == 0u) { if (xb_ld(&bar[XB_TMO])) break; if (sp > XB_SPIN_CAP) { atomicAdd(&bar[XB_TMO], 1u); break; } }
    }
    nloc = mine > 0u ? mine : 1u; nx = cnt > 0u ? cnt : 1u;
}
__device__ __forceinline__ void xcd_barrier(const XcdBarrier& b, bool leader) {
    asm volatile("s_waitcnt vmcnt(0)" ::: "memory");
    __syncthreads();
    if (leader) {
        unsigned* bar = b.bar;
        __builtin_amdgcn_s_waitcnt(0);
        unsigned nloc = b.st[0], nx = b.st[1];
        if (nloc == 0u) { xcd_barrier_complete(bar, b.x, nloc, nx); b.st[0] = nloc; b.st[1] = nx; }
        const unsigned old = xb_add(&bar[XB_XSUB(b.x)], 1u);
        const unsigned gen = old / nloc;
        if (old + 1u == (gen + 1u) * nloc) {
            __builtin_amdgcn_fence(__ATOMIC_RELEASE, "agent");
            asm volatile("s_waitcnt vmcnt(0)" ::: "memory");
            const unsigned og = xb_add(&bar[XB_TOP], 1u);
            const unsigned tg = og / nx;
            if (og + 1u == (tg + 1u) * nx) xb_add(&bar[XB_TOPGEN], 1u);
            else XB_SPIN(xb_ld(&bar[XB_TOPGEN]) == tg, bar);
            __builtin_amdgcn_fence(__ATOMIC_ACQUIRE, "agent");
            xb_add(&bar[XB_XGEN(b.x)], 1u);
            asm volatile("s_waitcnt vmcnt(0)" ::: "memory");
        } else {
            XB_SPIN(xb_ld(&bar[XB_XGEN(b.x)]) == gen, bar);
            __builtin_amdgcn_fence(__ATOMIC_ACQUIRE, "agent");
            asm volatile("s_waitcnt vmcnt(0)" ::: "memory");
        }
    }
    __syncthreads();
}

__global__ void __launch_bounds__(512, 2) fwd_kernel(Args a) {
    extern __shared__ __attribute__((aligned(16))) unsigned char lds_raw[];
    LAS unsigned char* lds = (LAS unsigned char*)lds_raw;
    cg::grid_group grid = cg::this_grid();
    const int wave = __builtin_amdgcn_readfirstlane(threadIdx.x >> 6);
    const bool leader = (wave == 0) && (lane_id_opaque() == 0);
    volatile LAS unsigned* xst = (volatile LAS unsigned*)(lds + XBST_OFF);
    if (leader) { xst[0] = 0u; xst[1] = 0u; }
    __syncthreads();
    if (a.ws == nullptr) grid.sync();
    const XcdBarrier xbar = xcd_barrier_post((unsigned*)(a.ws + WS_BAR), xst, leader);
#define GRID_SYNC() xcd_barrier(xbar, (wave == 0) && (lane_id_opaque() == 0))
#define LANE_IDS const int lane = lane_id_opaque(), tid = wave * 64 + lane; (void)tid;
    const int G = gridDim.x, bid = blockIdx.x;
    unsigned char* ws = a.ws;
    bf16_t* W1T = (bf16_t*)(ws + WS_W1T); bf16_t* WGLUT = (bf16_t*)(ws + WS_WGLUT); bf16_t* WOT = (bf16_t*)(ws + WS_WOT); bf16_t* WGT = (bf16_t*)(ws + WS_WGT); bf16_t* WPT = (bf16_t*)(ws + WS_WPT);
    float2* ROPE = (float2*)(ws + WS_ROPE); float* RINV = (float*)(ws + WS_RINV); float* LB16 = (float*)(ws + WS_LB16); float* SSQ1 = (float*)(ws + WS_SSQ1); float* SSQ2 = (float*)(ws + WS_SSQ2);
    bf16_t* PB = (bf16_t*)(ws + WS_PB); bf16_t* WIN = (bf16_t*)(ws + WS_WIN); bf16_t* WBIG = (bf16_t*)(ws + WS_WBIG);
    bf16_t* XB = (bf16_t*)(ws + WS_XB); bf16_t* HB = (bf16_t*)(ws + WS_XB);
    bf16_t* Q = (bf16_t*)(ws + WS_Q); bf16_t* KB = (bf16_t*)(ws + WS_K); bf16_t* VB = (bf16_t*)(ws + WS_V); bf16_t* GA = (bf16_t*)(ws + WS_GA); bf16_t* GS = (bf16_t*)(ws + WS_GS);
    bf16_t* UCAT = (bf16_t*)(ws + WS_UCAT); bf16_t* PPB = (bf16_t*)(ws + WS_UCAT); bf16_t* YMIX = (bf16_t*)(ws + WS_YMIX); bf16_t* YS = (bf16_t*)(ws + WS_YS);

#pragma unroll
    for (int rep_ = 0; rep_ < 1 + ((REP_MASK >> 0) & 1); ++rep_) { LANE_IDS
        const int gw = bid * 8 + wave, NGW = G * 8;
        LAS float* scr = (LAS float*)(lds + wave * 16384);
        constexpr int I1 = 32 * 144, I2 = 16 * 64, I3 = 32 * 64, I4 = 32 * 64, I5 = 4 * 64, NIT = I1 + I2 + I3 + I4 + I5;
        auto item_desc = [&](int r) -> TrItem {
            if (r < I1) { const int kb = r / 144, lgg = r % 144, pn = lgg >> 3, lg = lgg & 7, wtg = pn * 8 + 4 * (lg & 1) + 2 * (lg >> 2) + ((lg >> 1) & 1);
                return TrItem{a.w_in, W1T, a.norm_mix, DM, DIN, wtg * 32, kb * 64, lgg * 32}; } r -= I1;
            if (r < I2) { const int kb = r / 64, lgg = r % 64, l2 = lgg & 31, wtg = (l2 >> 2) * 8 + 4 * (lgg >> 5) + (l2 & 3);
                return TrItem{a.w_glu, WGLUT, nullptr, DSSM, 2 * DSSM, wtg * 32, kb * 64, lgg * 32}; } r -= I2;
            if (r < I3) { const int kb = r / 64, lgg = r % 64; return TrItem{a.w_out, WOT, nullptr, DM, DM, lgg * 32, kb * 64, lgg * 32}; } r -= I3;
            if (r < I4) { const int kb = r / 64, lgg = r % 64; return TrItem{a.w_ple_gate, WGT, a.norm_ple, DM, DM, lgg * 32, kb * 64, lgg * 32}; } r -= I4;
            const int kb = r / 64, lgg = r % 64; return TrItem{a.w_ple_proj, WPT, nullptr, PLE, DM, lgg * 32, kb * 64, lgg * 32};
        };
#pragma unroll
        for (int rq_ = 0; rq_ < 1 + ((REP_MASK >> 8) & 1); ++rq_)
        for (int it = gw; it < NIT; it += 2 * NGW) {
            const bool two = it + NGW < NIT;
            const TrItem dA = item_desc(it), dB = item_desc(two ? it + NGW : it);
            float vA[32], vB[32];
            p0_tr_load(dA, vA, lane); if (two) p0_tr_load(dB, vB, lane);
            p0_tr_store(dA, vA, scr, lane); if (two) p0_tr_store(dB, vB, scr, lane);
        }
#pragma unroll
        for (int rq_ = 0; rq_ < 1 + ((REP_MASK >> 9) & 1); ++rq_)
        for (int m = gw; m < T; m += 2 * NGW) {
            const int m2 = m + NGW; const bool two = m2 < T;
            const f32x4* xr = (const f32x4*)(a.x + (size_t)m * DM) + lane; const f32x4* xr2 = (const f32x4*)(a.x + (size_t)(two ? m2 : m) * DM) + lane;
            f32x4 v[8], w2[8]; float s = 0.f, s2 = 0.f;
#pragma unroll
            for (int j = 0; j < 8; ++j) v[j] = xr[64 * j];
#pragma unroll
            for (int j = 0; j < 8; ++j) w2[j] = xr2[64 * j];
#pragma unroll
            for (int j = 0; j < 8; ++j) { s += (v[j][0] * v[j][0] + v[j][1] * v[j][1]) + (v[j][2] * v[j][2] + v[j][3] * v[j][3]); s2 += (w2[j][0] * w2[j][0] + w2[j][1] * w2[j][1]) + (w2[j][2] * w2[j][2] + w2[j][3] * w2[j][3]); }
            s = wave_sum(s); s2 = wave_sum(s2);
            if (lane == 0) { RINV[m] = rsqrtf(s * (1.f / DM) + EPS); if (two) RINV[m2] = rsqrtf(s2 * (1.f / DM) + EPS); }
            u32x2* o = (u32x2*)(XB + (size_t)m * DM) + lane; u32x2* o2 = (u32x2*)(XB + (size_t)m2 * DM) + lane;
#pragma unroll
            for (int j = 0; j < 8; ++j) { u32x2 w; w.x = pk2(v[j][0], v[j][1]); w.y = pk2(v[j][2], v[j][3]); o[64 * j] = w; }
            if (two) {
#pragma unroll
                for (int j = 0; j < 8; ++j) { u32x2 w; w.x = pk2(w2[j][0], w2[j][1]); w.y = pk2(w2[j][2], w2[j][3]); o2[64 * j] = w; } }
        }
        for (int i = bid * 512 + tid; i < T * PLE / 4; i += G * 512) { const f32x4 v = ((const f32x4*)a.p)[i]; u32x2 w; w.x = pk2(v[0], v[1]); w.y = pk2(v[2], v[3]); ((u32x2*)PB)[i] = w; }
        for (int i = bid * 512 + tid; i < 2048; i += G * 512) { const int pos = i >> 5, f = i & 31; const float inv = powf(10000.f, -(float)f / 32.f); float sn, cs; sincosf((float)pos * inv, &sn, &cs); ROPE[i] = make_float2(cs, sn); }
    GRID_SYNC(); }


    if constexpr ((REP_MASK >> 10) & 1) { GRID_SYNC(); GRID_SYNC(); GRID_SYNC(); GRID_SYNC(); }
#pragma unroll
    for (int rep_ = 0; rep_ < 1 + ((REP_MASK >> 1) & 1); ++rep_) { LANE_IDS
        { pg8::Gemm g{XB, W1T, DM, DM, DM, 0, 0}; pg8::StaticOrder S; S.init(T, 14 * 256, G, bid);
          pg8::Epi1 E{RINV, a.q_norm, a.k_norm, ROPE, Q, KB, VB, GA, GS, UCAT, (LAS float*)(lds + XCH_OFF), 0};
          pg8::gemm_phase<pg8::Epi1, pg8::StaticOrder, true>(lds, g, S, E, wave); }
        __syncthreads();
        for (int gi = bid - (G - NG); gi >= 0 && gi < NG; gi += NG) ssm_tables(a, gi, lds, tid);
    GRID_SYNC(); }

#pragma unroll
    for (int rep_ = 0; rep_ < 1 + ((REP_MASK >> 2) & 1); ++rep_) {
#pragma unroll
        for (int rq_ = 0; rq_ < 2; ++rq_) {
        if (bid < 2 * NG) { if (rq_ == 1 && !((REP_MASK >> 6) & 1)) break;
            pg8::BatchOrder S{2 * NG, G, bid};
            { pg8::Gemm g{UCAT, WIN, 256, 512, 256, (size_t)NCH * 512 * 2, (size_t)256 * 256 * 2};
              pg8::EpiS1 E{LB16, UCAT}; pg8::gemm_phase<pg8::EpiS1, pg8::BatchOrder, true>(lds, g, S, E, wave); }
            asm volatile("s_waitcnt vmcnt(0)\n\tbuffer_inv sc1\n\ts_waitcnt vmcnt(0)" ::: "memory"); __syncthreads();
            { pg8::Gemm g{UCAT, WBIG, 512, 512, 512, (size_t)NCH * 512 * 2, (size_t)256 * 512 * 2};
              pg8::EpiS2 E{YS}; pg8::gemm_phase<pg8::EpiS2, pg8::BatchOrder, true>(lds, g, S, E, wave); }
        } else { if (rq_ == 1 && !((REP_MASK >> 11) & 1)) break;
            pg8::Gemm g{XB, W1T + (size_t)14 * 256 * DM, DM, DM, DM, 0, 0}; pg8::ListOrder S{bid - 2 * NG, 128, G};
            pg8::Epi1 E{RINV, a.q_norm, a.k_norm, ROPE, Q, KB, VB, GA, GS, UCAT, (LAS float*)(lds + XCH_OFF), 14};
            pg8::gemm_phase<pg8::Epi1, pg8::ListOrder, true>(lds, g, S, E, wave);
        }
        __syncthreads(); }
#pragma unroll
        for (int rq_ = 0; rq_ < 1 + ((REP_MASK >> 7) & 1); ++rq_)
        for (int un = bid; un < 256; un += G) {
            const int x = un & 7, jj = un >> 3, b = x >> 2, kvh = (x >> 1) & 1, idx = (x & 1) * 32 + jj, h = kvh * 4 + (idx >> 4), qb = idx & 15;
            const size_t tok0 = (size_t)b * SEQ + qb * 256;
            att::attn_dense_body(Q + tok0 * DATT + h * 128, KB + (size_t)b * SEQ * DKV + kvh * 128, VB + (size_t)b * SEQ * DKV + kvh * 128,
                                 GA + tok0 * DATT + h * 128, YMIX + tok0 * DM + h * 128, SEQ, (char*)lds_raw, wave);
        }
    GRID_SYNC(); }

#pragma unroll
    for (int rep_ = 0; rep_ < 1 + ((REP_MASK >> 3) & 1); ++rep_) {
        { pg8::Gemm g{YS, WGLUT, DSSM, DSSM, DSSM, 0, 0}; pg8::StaticOrder S; S.init(T, 2 * DSSM, G, bid);
          pg8::EpiGlu E{a.b_glu, GS, YMIX}; pg8::gemm_phase<pg8::EpiGlu, pg8::StaticOrder, true>(lds, g, S, E, wave); }
        __syncthreads();
        { pg8::Gemm g{PB, WPT, PLE, PLE, PLE, 0, 0}; pg8::StaticOrder S; S.init(T, DM, G, bid);
          pg8::EpiBf E{PPB, DM}; pg8::gemm_phase<pg8::EpiBf, pg8::StaticOrder, true>(lds, g, S, E, wave); }
    GRID_SYNC(); }


#pragma unroll
    for (int rep_ = 0; rep_ < 1 + ((REP_MASK >> 4) & 1); ++rep_) {
        pg8::Gemm g{YMIX, WOT, DM, DM, DM, 0, 0}; pg8::StaticOrder S; S.init(T, DM, G, bid);
        pg8::EpiOut E{a.x, a.out, HB, SSQ1}; pg8::gemm_phase<pg8::EpiOut, pg8::StaticOrder, true>(lds, g, S, E, wave);
    GRID_SYNC(); }


    { LANE_IDS
        pg8::StaticOrder S; S.init(T, DM, G, bid); pg8::Unit u0;
        LAS float* r2 = (LAS float*)(lds + R2_OFF);
        if (S.next(0, u0) && tid < 256) { const float* sp = SSQ1 + (size_t)(u0.pm * 256 + tid) * 32; float s = 0.f;
#pragma unroll
            for (int i = 0; i < 8; ++i) { const f32x4 v = ((const f32x4*)sp)[i]; s += (v[0] + v[1]) + (v[2] + v[3]); }
            r2[tid] = rsqrtf(s * (1.f / DM) + EPS); }
        __syncthreads();
        pg8::Gemm g{HB, WGT, DM, DM, DM, 0, 0};
        pg8::EpiGate E{a.out, PPB, SSQ2, (unsigned*)ws, a.norm_final, r2, HB}; pg8::gemm_phase<pg8::EpiGate, pg8::StaticOrder, true>(lds, g, S, E, wave);
    }
}

extern "C" void kernel_launch(void* const* d_in, const int* in_sizes, int n_in, void* d_out, int out_size, void* d_ws, size_t ws_size, hipStream_t stream) {
    static int grid = 0;
    if (grid == 0) {
        if (n_in != 21 || in_sizes[0] != T * DM || out_size != T * DM || ws_size < WS_END) { fprintf(stderr, "kernel_launch: unexpected shapes (n_in %d, in0 %d, out %d, ws %zu)\n", n_in, n_in > 0 ? in_sizes[0] : -1, out_size, ws_size); grid = -1; return; }
        int dev = 0, cus = 0, per_cu = 0;
        hipGetDevice(&dev); hipDeviceGetAttribute(&cus, hipDeviceAttributeMultiprocessorCount, dev);
        if (hipFuncSetAttribute((const void*)fwd_kernel, hipFuncAttributeMaxDynamicSharedMemorySize, LDS_BYTES) != hipSuccess) { fprintf(stderr, "kernel_launch: hipFuncSetAttribute failed\n"); grid = -1; return; }
        hipOccupancyMaxActiveBlocksPerMultiprocessor(&per_cu, (const void*)fwd_kernel, 512, LDS_BYTES);
        (void)hipGetLastError();
        if (per_cu < 1) fprintf(stderr, "kernel_launch: occupancy query reports %d blocks per CU\n", per_cu);
        grid = cus > 256 ? 256 : cus;
    }
    if (grid < 0) return;
    Args a{};
    const float** f = (const float**)&a;
    for (int i = 0; i < 21; ++i) f[i] = (const float*)d_in[i];
    a.out = (float*)d_out; a.ws = (unsigned char*)d_ws;
    if (hipMemsetAsync(d_ws, 0, WS_CTL_BYTES, stream) != hipSuccess) { fprintf(stderr, "kernel_launch: hipMemsetAsync failed\n"); return; }
    void* args[] = {&a};
    hipError_t e = hipLaunchCooperativeKernel((const void*)fwd_kernel, dim3(grid), dim3(512), args, LDS_BYTES, stream);
    if (e != hipSuccess) fprintf(stderr, "kernel_launch: cooperative launch failed: %s (grid %d)\n", hipGetErrorString(e), grid);
}
```

```cpp
#include <hip/hip_runtime.h>
#include <hip/hip_cooperative_groups.h>
#include <cstdio>
#include <cstdint>
namespace cg = cooperative_groups;

#define LAS __attribute__((address_space(3)))
typedef unsigned short bf16_t;
typedef short bf16x8 __attribute__((ext_vector_type(8)));
typedef short s16x4 __attribute__((ext_vector_type(4)));
typedef float f32x4 __attribute__((ext_vector_type(4)));
typedef float f32x16 __attribute__((ext_vector_type(16)));
typedef unsigned u32x4 __attribute__((ext_vector_type(4)));
typedef unsigned u32x2 __attribute__((ext_vector_type(2)));

constexpr int T = 8192, SEQ = 4096, DM = 2048, DIN = 4608, DATT = 1024, DKV = 256, DSSM = 1024, PLE = 256;
constexpr int NG = 64, NCH = T / 16;
constexpr float EPS = 1e-6f;
#ifndef PH_MASK
#define PH_MASK 0xff
#endif
#ifndef REP_MASK
#define REP_MASK 0
#endif

constexpr size_t MiB = 1u << 20;
constexpr size_t WS_W1T = 1 * MiB, WS_WGLUT = 19 * MiB, WS_WOT = 23 * MiB, WS_WGT = 31 * MiB, WS_WPT = 39 * MiB;
constexpr size_t WS_ROPE = 40 * MiB, WS_RINV = 40 * MiB + 65536, WS_LB16 = 40 * MiB + 131072, WS_SSQ1 = 41 * MiB, WS_SSQ2 = 42 * MiB;
constexpr size_t WS_PB = 43 * MiB, WS_WIN = 47 * MiB, WS_WBIG = 55 * MiB;
constexpr size_t WS_XB = 71 * MiB;
constexpr size_t WS_Q = 103 * MiB, WS_K = 119 * MiB, WS_V = 123 * MiB, WS_GA = 127 * MiB, WS_GS = 143 * MiB;
constexpr size_t WS_UCAT = 159 * MiB;
constexpr size_t WS_YMIX = 191 * MiB, WS_YS = 223 * MiB, WS_END = 239 * MiB;

constexpr int RING_BYTES = 131072, XCH_OFF = RING_BYTES, R2_OFF = RING_BYTES + 4096, XBST_OFF = RING_BYTES + 8192, LDS_BYTES = 147456;
constexpr size_t WS_BAR = 65536, WS_CTL_BYTES = 131072;

struct Args {
    const float *x, *p, *norm_mix, *w_in, *q_norm, *k_norm, *a_re, *a_im, *log_dt, *b_re, *b_im, *c_re, *c_im, *ssm_d, *w_glu, *b_glu, *w_out, *norm_ple, *w_ple_gate, *w_ple_proj, *norm_final;
    float* out; unsigned char* ws;
};

typedef __bf16 bf16s_;
__device__ __forceinline__ unsigned f2bf(float f) { return (unsigned)__builtin_bit_cast(unsigned short, (bf16s_)f); }
typedef float f32x2_ __attribute__((ext_vector_type(2)));
typedef __bf16 bf16x2_ __attribute__((ext_vector_type(2)));
__device__ __forceinline__ unsigned pk2(float lo, float hi) { const f32x2_ v = {lo, hi}; return __builtin_bit_cast(unsigned, __builtin_convertvector(v, bf16x2_)); }
__device__ __forceinline__ float bf2f(unsigned short b) { return __builtin_bit_cast(float, (unsigned)b << 16); }
__device__ __forceinline__ float bflo(unsigned w) { return __builtin_bit_cast(float, w << 16); }
__device__ __forceinline__ float bfhi(unsigned w) { return __builtin_bit_cast(float, w & 0xffff0000u); }
__device__ __forceinline__ unsigned cvt_pk_bf16(float lo, float hi) { unsigned r; asm volatile("v_cvt_pk_bf16_f32 %0, %1, %2" : "=v"(r) : "v"(lo), "v"(hi)); return r; }
__device__ __forceinline__ float sigmoidf_(float v) { return __builtin_amdgcn_rcpf(1.f + __builtin_amdgcn_exp2f(-1.4426950408889634f * v)); }
__device__ __forceinline__ float siluf_(float v) { return v * __builtin_amdgcn_rcpf(1.f + __builtin_amdgcn_exp2f(-1.4426950408889634f * v)); }
__device__ __forceinline__ float gelu_tanh(float v) { const float t = (-1.5957691216057308f * 1.4426950408889634f) * (v + 0.044715f * v * v * v); return v * __builtin_amdgcn_rcpf(1.f + __builtin_amdgcn_exp2f(t)); }
template <int K> __device__ __forceinline__ float swz_xor(float v) { return __int_as_float(__builtin_amdgcn_ds_swizzle(__float_as_int(v), (K << 10) | 0x1f)); }
__device__ __forceinline__ float sum_xor32(float v) { auto rr = __builtin_amdgcn_permlane32_swap(__float_as_uint(v), __float_as_uint(v), false, false); return __uint_as_float(rr[0]) + __uint_as_float(rr[1]); }
__device__ __forceinline__ float wave_sum(float v) { v += swz_xor<1>(v); v += swz_xor<2>(v); v += swz_xor<4>(v); v += swz_xor<8>(v); v += swz_xor<16>(v); return sum_xor32(v); }
#define LDS_WAIT() asm volatile("s_waitcnt lgkmcnt(0)" ::: "memory")
__device__ __forceinline__ int lane_id_opaque() { int l = __builtin_amdgcn_mbcnt_hi(~0u, __builtin_amdgcn_mbcnt_lo(~0u, 0u)); asm volatile("" : "+v"(l)); return l; }

namespace pg8 {
constexpr int BM = 256, BK = 64, HALF = 128, HTB = HALF * BK * 2, NXCD = 8, WGM = 8;
__host__ __device__ __forceinline__ int lds_byte(int r, int c) { const int st = (r >> 4) * 2 + (c >> 5), rr = r & 15, cc = c & 31, ob = rr * 64 + cc * 2; return st * 1024 + (ob ^ (((ob >> 9) & 1) << 5)); }
__host__ __device__ __forceinline__ void stage_rc(int b, int& R, int& C) { const int st = b / 1024, sb = b % 1024, swz = sb ^ (((sb >> 9) & 1) << 5); R = (st >> 1) * 16 + swz / 64; C = (st & 1) * 32 + (swz % 64) / 2; }
__host__ __device__ __forceinline__ int perm32(int rho) { const int n = rho >> 4, i = rho & 15; return 8 * (i >> 2) + 4 * n + (i & 3); }

struct Unit { int pm, pn, z; };
struct Gemm { const bf16_t* A; const bf16_t* Bt; int K, lda, ldb; size_t zA, zB; };

struct StaticOrder {
    int nM, nN, nwg, G, c;
    __device__ void init(int M, int N, int G_, int c_) { nM = M / BM; nN = N / BM; nwg = nM * nN; G = G_; c = c_; }
    __device__ bool next(int i, Unit& u) const {
        const long L = (long)i * G + c; if (L >= nwg) return false;
        int wgid = (int)L; { const int q = nwg / NXCD, r = nwg % NXCD, xcd = wgid % NXCD, off = wgid / NXCD; wgid = (xcd < r ? xcd * (q + 1) : r * (q + 1) + (xcd - r) * q) + off; }
        const int nig = WGM * nN, gid = wgid / nig, fm = gid * WGM, gsz = (nM - fm) < WGM ? (nM - fm) : WGM;
        u.pm = fm + ((wgid % nig) % gsz); u.pn = (wgid % nig) / gsz; u.z = 0; return true;
    }
};
struct BatchOrder {
    int n, G, c;
    __device__ bool next(int i, Unit& u) const { const int L = i * G + c; if (L >= n) return false; u.z = L >> 1; u.pm = L & 1; u.pn = 0; return true; }
};

struct ListOrder {
    int L0, n, stride;
    __device__ bool next(int i, Unit& u) const { const int L = L0 + i * stride; if (L < 0 || L >= n) return false;
        const int x = L & 7, j = L >> 3; u.pm = 4 * x + (j >> 2); u.pn = j & 3; u.z = 0; return true; }
};
template <class Epi, class Sched, bool ALIGN_EPI>
__device__ __forceinline__ void gemm_phase(LAS unsigned char* lds, const Gemm g, const Sched& S, const Epi& E, const int wid) {
    const int lane = lane_id_opaque(), tid = wid * 64 + lane, wr = wid >> 2, wc = wid & 3, fr = lane & 15, fq = lane >> 4;
    const int K = g.K, nt = K / BK;
    unsigned voffA[2], voffB[2];
#pragma unroll
    for (int i = 0; i < 2; ++i) { int R, C; stage_rc(tid * 16 + i * 8192, R, C); const int Rb = (R & ~31) + perm32(R & 31);
        voffA[i] = (unsigned)(R * g.lda + C) * 2u; voffB[i] = (unsigned)(Rb * g.ldb + C) * 2u; }
    const size_t kstep = (size_t)(BK * 2);
    const size_t hstepA = (size_t)HALF * g.lda * 2, hstepB = (size_t)HALF * g.ldb * 2;
    const size_t tstepA = 2 * hstepA, tstepB = 2 * hstepB;
    const unsigned ldsw = (unsigned)wid * 1024u;
    const int aoff = lds_byte(wr * 64 + fr, fq * 8), boff = lds_byte(wc * 32 + fr, fq * 8);
#define PG8_SA(b, h) (((b) * 2 + (h)) * HTB)
#define PG8_SB(b, h) ((4 + (b) * 2 + (h)) * HTB)
#define PG8_STAGE(bufoff, gbase, voff) do { _Pragma("unroll") for (int _i = 0; _i < 2; ++_i) \
        __builtin_amdgcn_global_load_lds((const unsigned*)((const char*)(gbase) + (voff)[_i]), (LAS unsigned*)(lds + (bufoff) + ldsw + _i * 8192), 16, 0, 0); } while (0)
#define PG8_LDA(dst, b, h) do { _Pragma("unroll") for (int m = 0; m < 4; ++m) _Pragma("unroll") for (int k = 0; k < 2; ++k) dst[m][k] = *(const LAS bf16x8*)(lds + PG8_SA(b, h) + aoff + m * 2048 + k * 1024); } while (0)
#define PG8_LDB(dst, b, h) do { _Pragma("unroll") for (int n = 0; n < 2; ++n) _Pragma("unroll") for (int k = 0; k < 2; ++k) dst[n][k] = *(const LAS bf16x8*)(lds + PG8_SB(b, h) + boff + n * 2048 + k * 1024); } while (0)
#define PG8_MMA(ai, bj, At, Bt) do { __builtin_amdgcn_s_setprio(1); _Pragma("unroll") for (int m = 0; m < 4; ++m) _Pragma("unroll") for (int n = 0; n < 2; ++n) _Pragma("unroll") for (int k = 0; k < 2; ++k) \
        acc[ai][bj][m][n] = __builtin_amdgcn_mfma_f32_16x16x32_bf16(Bt[n][k], At[m][k], acc[ai][bj][m][n], 0, 0, 0); __builtin_amdgcn_s_setprio(0); } while (0)
#define PG8_WAIT_V(n) asm volatile("s_waitcnt vmcnt(" #n ")" ::: "memory")
#define PG8_WAIT_L(n) asm volatile("s_waitcnt lgkmcnt(" #n ")" ::: "memory")
#define PG8_BAR __builtin_amdgcn_s_barrier()
#define PG8_SCHED __builtin_amdgcn_sched_barrier(0)
    Unit cur, nxt; int ui = 0;
    if (!S.next(0, cur)) return;
    f32x4 acc[2][2][4][2];
#pragma unroll
    for (int a = 0; a < 2; ++a)
#pragma unroll
        for (int b = 0; b < 2; ++b)
#pragma unroll
            for (int m = 0; m < 4; ++m)
#pragma unroll
                for (int n = 0; n < 2; ++n) acc[a][b][m][n] = (f32x4){0.f, 0.f, 0.f, 0.f};
    bf16x8 At[4][2], B0[2][2], B1[2][2];
    const char* cA = (const char*)g.A + (size_t)cur.z * g.zA + (size_t)cur.pm * tstepA; const char* cB = (const char*)g.Bt + (size_t)cur.z * g.zB + (size_t)cur.pn * tstepB;
    PG8_STAGE(PG8_SB(0, 0), cB, voffB); PG8_STAGE(PG8_SB(0, 1), cB + hstepB, voffB); PG8_STAGE(PG8_SA(0, 0), cA, voffA); PG8_STAGE(PG8_SA(0, 1), cA + hstepA, voffA);
    if (wr == 1) PG8_BAR;
    PG8_WAIT_V(2); PG8_BAR;
    PG8_STAGE(PG8_SB(1, 0), cB + kstep, voffB); PG8_STAGE(PG8_SA(1, 0), cA + kstep, voffA); PG8_STAGE(PG8_SB(1, 1), cB + hstepB + kstep, voffB);
    PG8_WAIT_V(6); PG8_BAR;
    for (;;) {
        const bool has_next = S.next(ui + 1, nxt);
        const char* nA = has_next ? (const char*)g.A + (size_t)nxt.z * g.zA + (size_t)nxt.pm * tstepA : cA;
        const char* nB = has_next ? (const char*)g.Bt + (size_t)nxt.z * g.zB + (size_t)nxt.pn * tstepB : cB;
        for (int t = 0; t < nt; t += 2) {
            const bool last = (t == nt - 2);
            const char* a1 = cA + (size_t)(t + 1) * kstep;
            const char* a2 = last ? nA : cA + (size_t)(t + 2) * kstep; const char* b2 = last ? nB : cB + (size_t)(t + 2) * kstep;
            const char* a3 = a2 + kstep; const char* b3 = b2 + kstep;
            PG8_LDB(B0, 0, 0); PG8_LDB(B1, 0, 1); PG8_SCHED; PG8_LDA(At, 0, 0); PG8_STAGE(PG8_SA(1, 1), a1 + hstepA, voffA);
            PG8_WAIT_V(8); PG8_WAIT_L(0); PG8_BAR; PG8_MMA(0, 0, At, B0); PG8_MMA(0, 1, At, B1); PG8_BAR; PG8_SCHED;
            PG8_LDA(At, 0, 1); PG8_STAGE(PG8_SB(0, 0), b2, voffB); PG8_STAGE(PG8_SB(0, 1), b2 + hstepB, voffB); PG8_STAGE(PG8_SA(0, 0), a2, voffA);
            PG8_WAIT_V(8); PG8_WAIT_L(0); PG8_BAR; PG8_MMA(1, 0, At, B0); PG8_MMA(1, 1, At, B1); PG8_BAR; PG8_SCHED;
            PG8_LDB(B0, 1, 0); PG8_LDB(B1, 1, 1); PG8_SCHED; PG8_LDA(At, 1, 0); PG8_STAGE(PG8_SA(0, 1), a2 + hstepA, voffA);
            PG8_WAIT_V(8); PG8_WAIT_L(0); PG8_BAR; PG8_MMA(0, 0, At, B0); PG8_MMA(0, 1, At, B1); PG8_BAR; PG8_SCHED;
            PG8_LDA(At, 1, 1); PG8_STAGE(PG8_SB(1, 0), b3, voffB); PG8_STAGE(PG8_SB(1, 1), b3 + hstepB, voffB); PG8_STAGE(PG8_SA(1, 0), a3, voffA);
            PG8_WAIT_V(8); PG8_WAIT_L(0); PG8_BAR; PG8_MMA(1, 0, At, B0); PG8_MMA(1, 1, At, B1); PG8_BAR; PG8_SCHED;
        }
        if constexpr (ALIGN_EPI) { if (wr == 0) PG8_BAR; }
        if constexpr (!Epi::AFTER_DRAIN) E(acc, cur, wr, wc, fr, fq);
        if (!has_next) break;
#pragma unroll
        for (int a = 0; a < 2; ++a)
#pragma unroll
            for (int b = 0; b < 2; ++b)
#pragma unroll
                for (int m = 0; m < 4; ++m)
#pragma unroll
                    for (int n = 0; n < 2; ++n) acc[a][b][m][n] = (f32x4){0.f, 0.f, 0.f, 0.f};
        cur = nxt; cA = nA; cB = nB; ++ui;
        if constexpr (ALIGN_EPI) { if (wr == 1) PG8_BAR; }
    }
    PG8_WAIT_V(0);
    if constexpr (!ALIGN_EPI) { if (wr == 0) PG8_BAR; }
    PG8_BAR;
    if constexpr (Epi::AFTER_DRAIN) E.fused(acc, cur, wr, wc, lds, wid);
#undef PG8_SA
#undef PG8_SB
#undef PG8_STAGE
#undef PG8_LDA
#undef PG8_LDB
#undef PG8_MMA
#undef PG8_WAIT_V
#undef PG8_WAIT_L
#undef PG8_BAR
#undef PG8_SCHED
}

#define EPI_FOR_ROWS _Pragma("unroll") for (int ai = 0; ai < 2; ++ai) _Pragma("unroll") for (int m = 0; m < 4; ++m)
#define EPI_ROWDEF const int rit = ai * HALF + wr * 64 + m * 16 + fr; const int row = u.pm * BM + rit; (void)rit; (void)row;

struct Epi1 {
    static constexpr bool AFTER_DRAIN = false;
    const float* rinv; const float* qnw; const float* knw; const float2* rope;
    bf16_t *Q, *Kb, *Vb, *GA, *GS, *UCAT; LAS float* xch; int pn0;
    __device__ __forceinline__ void operator()(const f32x4 (&acc)[2][2][4][2], const Unit& u, int wr, int wc, int, int) const {
        const int l_ = lane_id_opaque(), fr = l_ & 15, fq = l_ >> 4;
        const int pn = u.pn + pn0;
        if (pn <= 4) {
            float ss[2][4], rv[2][4];
            EPI_FOR_ROWS { EPI_ROWDEF const float r = rinv[row]; rv[ai][m] = r; float s = 0.f;
#pragma unroll
                for (int bj = 0; bj < 2; ++bj)
#pragma unroll
                    for (int n = 0; n < 2; ++n) { const f32x4 v = acc[ai][bj][m][n] * r; s += (v[0] * v[0] + v[1] * v[1]) + (v[2] * v[2] + v[3] * v[3]); }
                s += swz_xor<16>(s); s = sum_xor32(s); ss[ai][m] = s;
                if (fq == 0) xch[wc * 256 + rit] = s; }
            LDS_WAIT(); __builtin_amdgcn_s_barrier(); asm volatile("" ::: "memory");
            const int half = wc & 1, hd = wc >> 1;
            const float* nw = (pn < 4 ? qnw : knw) + 64 * half + 8 * fq;
            float w1[8], w2[8];
#pragma unroll
            for (int i = 0; i < 8; ++i) { w1[i] = nw[i]; w2[i] = nw[32 + i]; }
            EPI_FOR_ROWS { EPI_ROWDEF const float tot = ss[ai][m] + xch[(wc ^ 1) * 256 + rit];
                const float sc = rv[ai][m] * rsqrtf(tot * (1.f / 128.f) + EPS);
                const int t = row & (SEQ - 1); const int pos = half ? (t & 63) : (t >> 6);
                const float2* rp = rope + pos * 32 + 8 * fq;
                float o1[8], o2[8];
#pragma unroll
                for (int n = 0; n < 2; ++n)
#pragma unroll
                    for (int e = 0; e < 4; ++e) { const int i = 4 * n + e; const float2 cs = rp[i];
                        const float x1 = acc[ai][0][m][n][e] * sc * w1[i], x2 = acc[ai][1][m][n][e] * sc * w2[i];
                        o1[i] = x1 * cs.x - x2 * cs.y; o2[i] = x2 * cs.x + x1 * cs.y; }
                bf16_t* dst = (pn < 4) ? Q + (size_t)row * DATT + (2 * pn + hd) * 128 + 64 * half + 8 * fq : Kb + (size_t)row * DKV + hd * 128 + 64 * half + 8 * fq;
                u32x4 a; a.x = pk2(o1[0], o1[1]); a.y = pk2(o1[2], o1[3]); a.z = pk2(o1[4], o1[5]); a.w = pk2(o1[6], o1[7]);
                u32x4 b; b.x = pk2(o2[0], o2[1]); b.y = pk2(o2[2], o2[3]); b.z = pk2(o2[4], o2[5]); b.w = pk2(o2[6], o2[7]);
                *(u32x4*)dst = a; *(u32x4*)(dst + 32) = b; }
        } else {
            const int lg0 = 4 * (wc >> 1) + 2 * (wc & 1);
            EPI_FOR_ROWS { EPI_ROWDEF const float r = rinv[row];
#pragma unroll
                for (int bj = 0; bj < 2; ++bj) { const int L = 256 * pn + 32 * (lg0 + bj) + 8 * fq;
                    f32x4 v0 = acc[ai][bj][m][0] * r, v1 = acc[ai][bj][m][1] * r; bf16_t* dst;
                    if (pn == 5) dst = Vb + (size_t)row * DKV + (L - 1280);
                    else if (pn < 10) dst = GA + (size_t)row * DATT + (L - 1536);
                    else if (pn < 14) { const int Lu = L - 2560; dst = UCAT + ((size_t)(Lu >> 4) * NCH + (row >> 4)) * 512 + (row & 15) * 16 + (Lu & 15); }
                    else dst = GS + (size_t)row * DSSM + (L - 3584);
                    if ((pn >= 6 && pn < 10) || pn >= 14) {
#pragma unroll
                        for (int e = 0; e < 4; ++e) { v0[e] = siluf_(v0[e]); v1[e] = siluf_(v1[e]); } }
                    u32x4 w; w.x = pk2(v0[0], v0[1]); w.y = pk2(v0[2], v0[3]); w.z = pk2(v1[0], v1[1]); w.w = pk2(v1[2], v1[3]);
                    *(u32x4*)dst = w; } }
        }
    }
};
struct EpiS1 {
    static constexpr bool AFTER_DRAIN = true;
    const float* lb16; bf16_t* UCAT;
    __device__ __forceinline__ void operator()(const f32x4 (&)[2][2][4][2], const Unit&, int, int, int, int) const {}
    __device__ __forceinline__ void fused(const f32x4 (&acc)[2][2][4][2], const Unit& u, int wr, int wc, LAS unsigned char* lds, int wid) const {
        const int l_ = lane_id_opaque(), fr = l_ & 15, fq = l_ >> 4;
        LAS float* Tl = (LAS float*)lds;
#pragma unroll
        for (int d = 0; d < 2; ++d) {
            EPI_FOR_ROWS { const int rit = ai * HALF + wr * 64 + m * 16 + fr; LAS float* rp = Tl + rit * 128 + wc * 32 + 8 * fq;
                *(LAS f32x4*)rp = acc[ai][d][m][0]; *(LAS f32x4*)(rp + 4) = acc[ai][d][m][1]; }
            LDS_WAIT(); __builtin_amdgcn_s_barrier(); asm volatile("" ::: "memory");
            {
                const int p = l_; const float lr = lb16[((u.z * 2 + d) * 64 + p) * 2], li = lb16[((u.z * 2 + d) * 64 + p) * 2 + 1];
                LAS float* SEG = (LAS float*)(lds + XCH_OFF);
                float xr = 0.f, xi = 0.f;
#pragma unroll 8
                for (int i = 0; i < 32; ++i) { const int cc = wid * 32 + i, c = d ? 255 - cc : cc;
                    const float sr = Tl[c * 128 + p], si = Tl[c * 128 + 64 + p];
                    Tl[c * 128 + p] = xr; Tl[c * 128 + 64 + p] = xi;
                    const float nr = lr * xr - li * xi + sr; xi = lr * xi + li * xr + si; xr = nr; }
                SEG[(wid * 64 + p) * 2] = xr; SEG[(wid * 64 + p) * 2 + 1] = xi;
                LDS_WAIT(); __builtin_amdgcn_s_barrier(); asm volatile("" ::: "memory");
                float l32r = lr, l32i = li;
#pragma unroll
                for (int q = 0; q < 5; ++q) { const float t = l32r * l32r - l32i * l32i; l32i = 2.f * l32r * l32i; l32r = t; }
                float er = 0.f, ei = 0.f;
                for (int j = 0; j < wid; ++j) { const float tr = SEG[(j * 64 + p) * 2], ti = SEG[(j * 64 + p) * 2 + 1];
                    const float nr = l32r * er - l32i * ei + tr; ei = l32r * ei + l32i * er + ti; er = nr; }
#pragma unroll 8
                for (int i = 0; i < 32; ++i) { const int cc = wid * 32 + i, c = d ? 255 - cc : cc;
                    const float tr = Tl[c * 128 + p] + er, ti = Tl[c * 128 + 64 + p] + ei;
                    Tl[c * 128 + p] = __uint_as_float(pk2(tr, ti));
                    const float nr = lr * er - li * ei; ei = lr * ei + li * er; er = nr; }
            }
            LDS_WAIT(); __builtin_amdgcn_s_barrier(); asm volatile("" ::: "memory");
            {   bf16_t* ub = UCAT + ((size_t)u.z * NCH + u.pm * 256) * 512 + 256 + d * 128;
#pragma unroll
                for (int i = 0; i < 8; ++i) { const int q = wid * 64 + l_ + 512 * i, r = q >> 4, c8 = (q & 15) * 8;
                    *(u32x4*)(ub + (size_t)r * 512 + c8) = *(const LAS u32x4*)((LAS bf16_t*)(Tl + r * 128) + c8); } }
            LDS_WAIT(); __builtin_amdgcn_s_barrier(); asm volatile("" ::: "memory");
        }
    }
};
struct EpiS2 {
    static constexpr bool AFTER_DRAIN = false;
    bf16_t* YS;
    __device__ __forceinline__ void operator()(const f32x4 (&acc)[2][2][4][2], const Unit& u, int wr, int wc, int, int) const {
        const int l_ = lane_id_opaque(), fr = l_ & 15, fq = l_ >> 4;
        EPI_FOR_ROWS { EPI_ROWDEF
#pragma unroll
            for (int bj = 0; bj < 2; ++bj) { const int c = bj * HALF + wc * 32 + 8 * fq; const int j = c >> 4, h0 = c & 15;
                const f32x4 v0 = acc[ai][bj][m][0], v1 = acc[ai][bj][m][1];
                u32x4 w; w.x = pk2(gelu_tanh(v0[0]), gelu_tanh(v0[1])); w.y = pk2(gelu_tanh(v0[2]), gelu_tanh(v0[3])); w.z = pk2(gelu_tanh(v1[0]), gelu_tanh(v1[1])); w.w = pk2(gelu_tanh(v1[2]), gelu_tanh(v1[3]));
                *(u32x4*)(YS + ((size_t)row * 16 + j) * DSSM + u.z * 16 + h0) = w; } }
    }
};
struct EpiGlu {
    static constexpr bool AFTER_DRAIN = false;
    const float* bglu; const bf16_t* GS; bf16_t* YMIX;
    __device__ __forceinline__ void operator()(const f32x4 (&acc)[2][2][4][2], const Unit& u, int wr, int wc, int, int) const {
        const int l_ = lane_id_opaque(), fr = l_ & 15, fq = l_ >> 4;
        const int a0 = 128 * u.pn + 32 * wc + 8 * fq;
        float bv[8], bg[8];
#pragma unroll
        for (int i = 0; i < 8; ++i) { bv[i] = bglu[a0 + i]; bg[i] = bglu[1024 + a0 + i]; }
        u32x4 gsv[2][4];
        EPI_FOR_ROWS { EPI_ROWDEF gsv[ai][m] = *(const u32x4*)(GS + (size_t)row * DSSM + a0); }
        EPI_FOR_ROWS { EPI_ROWDEF const u32x4 gs = gsv[ai][m];
            float o[8];
#pragma unroll
            for (int n = 0; n < 2; ++n)
#pragma unroll
                for (int e = 0; e < 4; ++e) { const int i = 4 * n + e; o[i] = (acc[ai][0][m][n][e] + bv[i]) * sigmoidf_(acc[ai][1][m][n][e] + bg[i]); }
            o[0] *= bflo(gs.x); o[1] *= bfhi(gs.x); o[2] *= bflo(gs.y); o[3] *= bfhi(gs.y); o[4] *= bflo(gs.z); o[5] *= bfhi(gs.z); o[6] *= bflo(gs.w); o[7] *= bfhi(gs.w);
            u32x4 w; w.x = pk2(o[0], o[1]); w.y = pk2(o[2], o[3]); w.z = pk2(o[4], o[5]); w.w = pk2(o[6], o[7]);
            *(u32x4*)(YMIX + (size_t)row * DM + 1024 + a0) = w; }
    }
};
struct EpiBf {
    static constexpr bool AFTER_DRAIN = false;
    bf16_t* O; int ldc;
    __device__ __forceinline__ void operator()(const f32x4 (&acc)[2][2][4][2], const Unit& u, int wr, int wc, int, int) const {
        const int l_ = lane_id_opaque(), fr = l_ & 15, fq = l_ >> 4;
        EPI_FOR_ROWS { EPI_ROWDEF
#pragma unroll
            for (int bj = 0; bj < 2; ++bj) { const f32x4 v0 = acc[ai][bj][m][0], v1 = acc[ai][bj][m][1];
                u32x4 w; w.x = pk2(v0[0], v0[1]); w.y = pk2(v0[2], v0[3]); w.z = pk2(v1[0], v1[1]); w.w = pk2(v1[2], v1[3]);
                *(u32x4*)(O + (size_t)row * ldc + u.pn * BM + bj * HALF + wc * 32 + 8 * fq) = w; } }
    }
};
struct EpiOut {
    static constexpr bool AFTER_DRAIN = false;
    const float* x; float* H; bf16_t* HB; float* ssq;
    __device__ __forceinline__ void operator()(const f32x4 (&acc)[2][2][4][2], const Unit& u, int wr, int wc, int, int) const {
        const int l_ = lane_id_opaque(), fr = l_ & 15, fq = l_ >> 4;
#pragma unroll
        for (int ai = 0; ai < 2; ++ai) {
            f32x4 xv[4][2][2];
#pragma unroll
            for (int m = 0; m < 4; ++m) { EPI_ROWDEF
#pragma unroll
                for (int bj = 0; bj < 2; ++bj) { const size_t off = (size_t)row * DM + u.pn * BM + bj * HALF + wc * 32 + 8 * fq; xv[m][bj][0] = *(const f32x4*)(x + off); xv[m][bj][1] = *(const f32x4*)(x + off + 4); } }
#pragma unroll
            for (int m = 0; m < 4; ++m) { EPI_ROWDEF float s = 0.f;
#pragma unroll
                for (int bj = 0; bj < 2; ++bj) { const size_t off = (size_t)row * DM + u.pn * BM + bj * HALF + wc * 32 + 8 * fq;
                    const f32x4 v0 = acc[ai][bj][m][0] + xv[m][bj][0], v1 = acc[ai][bj][m][1] + xv[m][bj][1];
                    s += (v0[0] * v0[0] + v0[1] * v0[1]) + (v0[2] * v0[2] + v0[3] * v0[3]) + (v1[0] * v1[0] + v1[1] * v1[1]) + (v1[2] * v1[2] + v1[3] * v1[3]);
                    u32x4 w; w.x = pk2(v0[0], v0[1]); w.y = pk2(v0[2], v0[3]); w.z = pk2(v1[0], v1[1]); w.w = pk2(v1[2], v1[3]);
                    *(u32x4*)(HB + off) = w; }
                s += swz_xor<16>(s); s = sum_xor32(s);
                if (fq == 0) ssq[(size_t)row * 32 + u.pn * 4 + wc] = s; }
        }
    }
};
struct EpiGate {
    static constexpr bool AFTER_DRAIN = true;
    float* H; const bf16_t* PP; float* ssq; unsigned* cnt; const float* nf; const LAS float* r2; const bf16_t* HBr;
    __device__ __forceinline__ void operator()(const f32x4 (&)[2][2][4][2], const Unit&, int, int, int, int) const {}
    __device__ __forceinline__ void fused(f32x4 (&acc)[2][2][4][2], const Unit& u, int wr, int wc, LAS unsigned char* lds, int wid) const {
        const int l_ = lane_id_opaque(), fr = l_ & 15, fq = l_ >> 4, tid = wid * 64 + l_;
        LAS float* P = (LAS float*)lds; LAS float* Rn = P + 1024;
        EPI_FOR_ROWS { EPI_ROWDEF float s = 0.f; const float r = r2[rit];
#pragma unroll
            for (int bj = 0; bj < 2; ++bj) { const size_t off = (size_t)row * DM + u.pn * BM + bj * HALF + wc * 32 + 8 * fq;
                const u32x4 pp = *(const u32x4*)(PP + off);
                const u32x4 hb = *(const u32x4*)(HBr + off);
                f32x4 h0 = {bflo(hb.x), bfhi(hb.x), bflo(hb.y), bfhi(hb.y)}, h1 = {bflo(hb.z), bfhi(hb.z), bflo(hb.w), bfhi(hb.w)};
                const f32x4 a0 = acc[ai][bj][m][0] * r, a1 = acc[ai][bj][m][1] * r;
                h0[0] += sigmoidf_(a0[0]) * bflo(pp.x); h0[1] += sigmoidf_(a0[1]) * bfhi(pp.x); h0[2] += sigmoidf_(a0[2]) * bflo(pp.y); h0[3] += sigmoidf_(a0[3]) * bfhi(pp.y);
                h1[0] += sigmoidf_(a1[0]) * bflo(pp.z); h1[1] += sigmoidf_(a1[1]) * bfhi(pp.z); h1[2] += sigmoidf_(a1[2]) * bflo(pp.w); h1[3] += sigmoidf_(a1[3]) * bfhi(pp.w);
                acc[ai][bj][m][0] = h0; acc[ai][bj][m][1] = h1;
                s += (h0[0] * h0[0] + h0[1] * h0[1]) + (h0[2] * h0[2] + h0[3] * h0[3]) + (h1[0] * h1[0] + h1[1] * h1[1]) + (h1[2] * h1[2] + h1[3] * h1[3]); }
            s += swz_xor<16>(s); s = sum_xor32(s);
            if (fq == 0) P[rit * 4 + wc] = s; }
        LDS_WAIT(); __builtin_amdgcn_s_barrier(); asm volatile("" ::: "memory");
        if (tid < 256) { const float t = (P[tid * 4] + P[tid * 4 + 1]) + (P[tid * 4 + 2] + P[tid * 4 + 3]);
            __hip_atomic_store(ssq + (size_t)(u.pm * 256 + tid) * 8 + u.pn, t, __ATOMIC_RELAXED, __HIP_MEMORY_SCOPE_AGENT); }
        asm volatile("s_waitcnt vmcnt(0)" ::: "memory");
        if (wid < 4 && l_ == 0) __hip_atomic_fetch_add(cnt + 64 * u.pm, 1u, __ATOMIC_RELAXED, __HIP_MEMORY_SCOPE_AGENT);
        if (wid == 0) {
            unsigned sp = 0;
            while ((unsigned)__builtin_amdgcn_readfirstlane(__hip_atomic_load(cnt + 64 * u.pm, __ATOMIC_RELAXED, __HIP_MEMORY_SCOPE_AGENT)) < 32u) { __builtin_amdgcn_s_sleep(2); if (++sp > (1u << 22)) break; }
            __builtin_amdgcn_fence(__ATOMIC_ACQUIRE, "agent");
        }
        asm volatile("s_waitcnt vmcnt(0) lgkmcnt(0)" ::: "memory"); __builtin_amdgcn_s_barrier(); asm volatile("" ::: "memory");
        if (tid < 256) { const float* sp = ssq + (size_t)(u.pm * 256 + tid) * 8; float t = 0.f;
#pragma unroll
            for (int i = 0; i < 8; ++i) t += __hip_atomic_load(sp + i, __ATOMIC_RELAXED, __HIP_MEMORY_SCOPE_AGENT);
            Rn[tid] = rsqrtf(t * (1.f / DM) + EPS); }
        LDS_WAIT(); __builtin_amdgcn_s_barrier(); asm volatile("" ::: "memory");
        EPI_FOR_ROWS { EPI_ROWDEF const float rn = Rn[rit];
#pragma unroll
            for (int bj = 0; bj < 2; ++bj) { const int col = u.pn * BM + bj * HALF + wc * 32 + 8 * fq; const size_t off = (size_t)row * DM + col;
                *(f32x4*)(H + off) = acc[ai][bj][m][0] * rn * *(const f32x4*)(nf + col); *(f32x4*)(H + off + 4) = acc[ai][bj][m][1] * rn * *(const f32x4*)(nf + col + 4); } }
    }
};
}

namespace att {
constexpr int D = 128, NW = 8, QBLK = 32, KVBLK = 64;
constexpr float SCALE = 0.088388347648318440f;
constexpr float THR = 8.f;
constexpr int LDQ = DATT, LDK = DKV;
constexpr size_t SHM_V = KVBLK * D * 2, SHM_K = KVBLK * D * 2, SHM_ATTN = 2 * SHM_V + 2 * SHM_K + NW * 64 * 4;
#define KSWZ(row, colB) ((row) * 256 + ((colB) ^ (((row) & 7) << 4)))
#define SBAR() __builtin_amdgcn_sched_barrier(0)
__device__ __forceinline__ int crow(int r, int hi) { return (r & 3) + 8 * (r >> 2) + 4 * hi; }
__device__ __forceinline__ void partialSM(f32x16& p0, f32x16& p1, float& m_reg, float& mn, float& alpha) {
  constexpr float C = SCALE * 1.4426950408889634f;
  float pmax = p0[0]; for (int r = 1; r < 16; ++r) pmax = fmaxf(pmax, p0[r]); for (int r = 0; r < 16; ++r) pmax = fmaxf(pmax, p1[r]);
  { auto rr = __builtin_amdgcn_permlane32_swap(__float_as_uint(pmax), __float_as_uint(pmax), false, false);
    pmax = fmaxf(__uint_as_float(rr[0]), __uint_as_float(rr[1])); }
  if (__builtin_expect(__all(pmax - m_reg <= THR / SCALE), 1)) { mn = m_reg; alpha = 1.f; }
  else { mn = fmaxf(m_reg, pmax); alpha = __builtin_amdgcn_exp2f((m_reg - mn) * C); m_reg = mn; }
  float mnC = -mn * C;
  for (int r = 0; r < 16; ++r) p0[r] = fmaf(p0[r], C, mnC); for (int r = 0; r < 16; ++r) p1[r] = fmaf(p1[r], C, mnC);
  for (int r = 0; r < 16; ++r) p0[r] = __builtin_amdgcn_exp2f(p0[r]);
}
__device__ __forceinline__ void finishSM(f32x16& p0, f32x16& p1, float alpha, float& l_reg, bf16x8& pa0, bf16x8& pa1, bf16x8& pa2, bf16x8& pa3) {
  for (int r = 0; r < 16; ++r) p1[r] = __builtin_amdgcn_exp2f(p1[r]);
  float ps = 0; for (int r = 0; r < 16; ++r) ps += p0[r]; for (int r = 0; r < 16; ++r) ps += p1[r];
  { auto rr = __builtin_amdgcn_permlane32_swap(__float_as_uint(ps), __float_as_uint(ps), false, false);
    ps = __uint_as_float(rr[0]) + __uint_as_float(rr[1]); }
  l_reg = l_reg * alpha + ps;
#define PK4(P, BASE, OUT) do { unsigned a0 = cvt_pk_bf16(P[BASE + 0], P[BASE + 1]), a1 = cvt_pk_bf16(P[BASE + 2], P[BASE + 3]);   \
    unsigned b0 = cvt_pk_bf16(P[BASE + 4], P[BASE + 5]), b1 = cvt_pk_bf16(P[BASE + 6], P[BASE + 7]);                              \
    auto r0 = __builtin_amdgcn_permlane32_swap(a0, b0, false, false); auto r1 = __builtin_amdgcn_permlane32_swap(a1, b1, false, false); \
    u32x4 w = {r0[0], r1[0], r0[1], r1[1]}; OUT = *reinterpret_cast<bf16x8*>(&w); } while (0)
  PK4(p0, 0, pa0); PK4(p0, 8, pa1); PK4(p1, 0, pa2); PK4(p1, 8, pa3);
#undef PK4
}
__device__ __forceinline__ void qkt(f32x16& p0, f32x16& p1, const bf16_t* Ks, const bf16x8* qr, int r32, int hi) {
  p0 = f32x16{}; p1 = f32x16{};
  for (int d0 = 0; d0 < 8; ++d0) { int cb = (d0 * 16 + hi * 8) * 2;
    bf16x8 b0 = *reinterpret_cast<const bf16x8*>((const char*)Ks + KSWZ(r32, cb));
    bf16x8 b1 = *reinterpret_cast<const bf16x8*>((const char*)Ks + KSWZ(32 + r32, cb));
    p0 = __builtin_amdgcn_mfma_f32_32x32x16_bf16(b0, qr[d0], p0, 0, 0, 0);
    p1 = __builtin_amdgcn_mfma_f32_32x32x16_bf16(b1, qr[d0], p1, 0, 0, 0); }
}
__device__ __forceinline__ int v_st(int k, int c) { const int kk = (k & ~0xC) | ((k & 4) << 1) | ((k & 8) >> 1); return ((kk >> 3) * 4 + (c >> 5)) * 512 + ((kk & 7) * 32 + (c & 31)) * 2; }
__device__ __forceinline__ int v_rd_base(int lane) { return ((lane & 3) << 3) | (((lane >> 2) & 3) << 6) | (((lane >> 4) & 1) << 5) | (((lane >> 5) & 1) << 8); }
constexpr int v_rd_off(int d0, int ks, int half) { return d0 * 512 + ks * 4096 + half * 2048; }
template <int OFF> __device__ __forceinline__ s16x4 tr_read(int vb) {
  s16x4 r; asm volatile("ds_read_b64_tr_b16 %0, %1 offset:%2" : "=&v"(r) : "v"(vb), "i"(OFF) : "memory"); return r;
}
template <int D0> __device__ __forceinline__ void pv_one(f32x16& od, int vb, bf16x8 pa0, bf16x8 pa1, bf16x8 pa2, bf16x8 pa3) {
  const s16x4 l0 = tr_read<v_rd_off(D0, 0, 0)>(vb), h0 = tr_read<v_rd_off(D0, 0, 1)>(vb), l1 = tr_read<v_rd_off(D0, 1, 0)>(vb), h1 = tr_read<v_rd_off(D0, 1, 1)>(vb);
  const s16x4 l2 = tr_read<v_rd_off(D0, 2, 0)>(vb), h2 = tr_read<v_rd_off(D0, 2, 1)>(vb), l3 = tr_read<v_rd_off(D0, 3, 0)>(vb), h3 = tr_read<v_rd_off(D0, 3, 1)>(vb);
  asm volatile("s_waitcnt lgkmcnt(0)" ::: "memory"); SBAR();
#define PK(L, H) (bf16x8){L[0], L[1], L[2], L[3], H[0], H[1], H[2], H[3]}
  od = __builtin_amdgcn_mfma_f32_32x32x16_bf16(pa0, PK(l0, h0), od, 0, 0, 0);
  od = __builtin_amdgcn_mfma_f32_32x32x16_bf16(pa1, PK(l1, h1), od, 0, 0, 0);
  od = __builtin_amdgcn_mfma_f32_32x32x16_bf16(pa2, PK(l2, h2), od, 0, 0, 0);
  od = __builtin_amdgcn_mfma_f32_32x32x16_bf16(pa3, PK(l3, h3), od, 0, 0, 0);
#undef PK
}
__device__ __forceinline__ void pv_d0(f32x16* o, int vb, bf16x8 pa0, bf16x8 pa1, bf16x8 pa2, bf16x8 pa3) {
  pv_one<0>(o[0], vb, pa0, pa1, pa2, pa3); pv_one<1>(o[1], vb, pa0, pa1, pa2, pa3); pv_one<2>(o[2], vb, pa0, pa1, pa2, pa3); pv_one<3>(o[3], vb, pa0, pa1, pa2, pa3);
}
__device__ __forceinline__ void attn_dense_body(const bf16_t* __restrict__ Qb, const bf16_t* __restrict__ Kh, const bf16_t* __restrict__ Vh,
                                                const bf16_t* __restrict__ Gb, bf16_t* __restrict__ Yb, int seq, char* lds, const int wid) {
  const int lane = lane_id_opaque(), tid = wid * 64 + lane, r32 = lane & 31, hi = lane >> 5;
  bf16_t* V_lds = (bf16_t*)lds; bf16_t* K_lds = (bf16_t*)(lds + 2 * SHM_V);
  float* ws = (float*)(lds + 2 * SHM_V + 2 * SHM_K) + wid * 64; float* li_l = ws; float* al_l = ws + 32;
  float m_reg = -1e30f, l_reg = 0; f32x16 o[4] = {}; bf16x8 qr[8];
  const bf16_t* Qw = Qb + (long)(wid * QBLK + r32) * LDQ + hi * 8;
#pragma unroll
  for (int d0 = 0; d0 < 8; ++d0) qr[d0] = *reinterpret_cast<const bf16x8*>(Qw + d0 * 16);
  const int sr = tid >> 4, sc = (tid & 15) * 8, vst0 = v_st(sr, sc), vst1 = v_st(32 + sr, sc);
  const int vb0 = (int)(uintptr_t)V_lds + v_rd_base(lane);
  struct { bf16x8 vs0, vs1, ks0, ks1; } sr_[2];
#define SLOAD(i, k0) do { sr_[i].vs0 = *reinterpret_cast<const bf16x8*>(&Vh[(long)((k0) + sr) * LDK + sc]); sr_[i].vs1 = *reinterpret_cast<const bf16x8*>(&Vh[(long)((k0) + 32 + sr) * LDK + sc]); \
    sr_[i].ks0 = *reinterpret_cast<const bf16x8*>(&Kh[(long)((k0) + sr) * LDK + sc]); sr_[i].ks1 = *reinterpret_cast<const bf16x8*>(&Kh[(long)((k0) + 32 + sr) * LDK + sc]); } while (0)
#define SWRITE(b, i) do { *(bf16x8*)((char*)V_lds + (b) * SHM_V + vst0) = sr_[i].vs0;          \
    *(bf16x8*)((char*)V_lds + (b) * SHM_V + vst1) = sr_[i].vs1; int kc = sc * 2;               \
    *(bf16x8*)((char*)K_lds + (b) * SHM_K + KSWZ(sr, kc)) = sr_[i].ks0;                       \
    *(bf16x8*)((char*)K_lds + (b) * SHM_K + KSWZ(32 + sr, kc)) = sr_[i].ks1; } while (0)
#define SWAIT() asm volatile("s_waitcnt vmcnt(4)" ::: "memory")
#define RESC(a) do { if (__any((a) < 1.f)) { if (hi == 0) al_l[r32] = (a); asm volatile("s_waitcnt lgkmcnt(0)" ::: "memory"); \
    for (int d = 0; d < 4; ++d) for (int r = 0; r < 16; ++r) o[d][r] *= al_l[crow(r, hi)]; } } while (0)
  f32x16 pA0, pA1, pB0, pB1; float mnA, mnB, alA, alB; bf16x8 pa0, pa1, pa2, pa3; const int NT = seq / KVBLK;
  constexpr int SE = 0, SO = 1;
  SLOAD(SE, 0); asm volatile("s_waitcnt vmcnt(0)" ::: "memory"); SWRITE(0, SE); __syncthreads();
  qkt(pA0, pA1, K_lds, qr, r32, hi); partialSM(pA0, pA1, m_reg, mnA, alA);
  SLOAD(SO, KVBLK); if (2 < NT) SLOAD(SE, 2 * KVBLK);
  SWAIT(); SWRITE(1, SO); __syncthreads();
  for (int j = 1; j + 1 < NT; j += 2) {
    SBAR(); qkt(pB0, pB1, (bf16_t*)((char*)K_lds + SHM_K), qr, r32, hi);
    finishSM(pA0, pA1, alA, l_reg, pa0, pa1, pa2, pa3); SBAR();
    SLOAD(SO, (j + 2) * KVBLK); SBAR();
    pv_d0(o, vb0, pa0, pa1, pa2, pa3); partialSM(pB0, pB1, m_reg, mnB, alB);
    __syncthreads(); SWAIT(); SWRITE(0, SE);
    RESC(alB); __syncthreads();
    SBAR(); qkt(pA0, pA1, K_lds, qr, r32, hi);
    finishSM(pB0, pB1, alB, l_reg, pa0, pa1, pa2, pa3); SBAR();
    if (j + 3 < NT) SLOAD(SE, (j + 3) * KVBLK); SBAR();
    pv_d0(o, vb0 + (int)SHM_V, pa0, pa1, pa2, pa3); partialSM(pA0, pA1, m_reg, mnA, alA);
    __syncthreads(); SWAIT(); SWRITE(1, SO);
    RESC(alA); __syncthreads();
  }
  SBAR(); qkt(pB0, pB1, (bf16_t*)((char*)K_lds + SHM_K), qr, r32, hi);
  finishSM(pA0, pA1, alA, l_reg, pa0, pa1, pa2, pa3); SBAR();
  pv_d0(o, vb0, pa0, pa1, pa2, pa3); partialSM(pB0, pB1, m_reg, mnB, alB);
  __syncthreads(); RESC(alB);
  finishSM(pB0, pB1, alB, l_reg, pa0, pa1, pa2, pa3); SBAR();
  pv_d0(o, vb0 + (int)SHM_V, pa0, pa1, pa2, pa3);
  if (hi == 0) li_l[r32] = l_reg; asm volatile("s_waitcnt lgkmcnt(0)" ::: "memory");
  float rli[16];
#pragma unroll
  for (int r = 0; r < 16; ++r) rli[r] = __builtin_amdgcn_rcpf(li_l[crow(r, hi)]);
  bf16_t* Yw = Yb + (long)(wid * QBLK) * DM; const bf16_t* Gw = Gb + (long)(wid * QBLK) * DATT;
  __syncthreads();
  bf16_t* stg = (bf16_t*)(lds + wid * 8192);
#pragma unroll
  for (int r = 0; r < 16; ++r) { const int orow = crow(r, hi);
#pragma unroll
    for (int d0 = 0; d0 < 4; ++d0) stg[orow * 128 + d0 * 32 + r32] = (bf16_t)f2bf(o[d0][r] * rli[r]); }
  asm volatile("s_waitcnt lgkmcnt(0)" ::: "memory");
  const int l2 = lane_id_opaque();
#pragma unroll
  for (int i = 0; i < 8; ++i) { const int q = l2 + 64 * i, row = q >> 4, c8 = (q & 15) * 8;
    const u32x4 v = *(const u32x4*)(stg + row * 128 + c8); const u32x4 gg = *(const u32x4*)(Gw + (unsigned)(row * DATT + c8));
    u32x4 w; w.x = pk2(bflo(v.x) * bflo(gg.x), bfhi(v.x) * bfhi(gg.x)); w.y = pk2(bflo(v.y) * bflo(gg.y), bfhi(v.y) * bfhi(gg.y));
    w.z = pk2(bflo(v.z) * bflo(gg.z), bfhi(v.z) * bfhi(gg.z)); w.w = pk2(bflo(v.w) * bflo(gg.w), bfhi(v.w) * bfhi(gg.w));
    *(u32x4*)(Yw + (unsigned)(row * DM + c8)) = w; }
  __syncthreads();
#undef SLOAD
#undef SWRITE
#undef SWAIT
#undef RESC
}
#undef SBAR
}

__device__ __forceinline__ void p0_transpose_item(const float* W, int K, int N, bf16_t* WT, int wt_row0, const float* kscale, LAS float* scr, int k0, int n0, int lane) {
#pragma unroll
    for (int i = 0; i < 32; ++i) { const int kk = 2 * i + (lane >> 5); float v = W[(size_t)(k0 + kk) * N + n0 + (lane & 31)]; if (kscale) v *= kscale[k0 + kk]; scr[kk * 33 + (lane & 31)] = v; }
    LDS_WAIT(); asm volatile("" ::: "memory");
    const int c = lane & 7;
#pragma unroll
    for (int j = 0; j < 4; ++j) { const int n = (lane >> 3) + 8 * j; const LAS float* s = scr + (8 * c) * 33 + n;
        u32x4 o; o.x = pk2(s[0 * 33], s[1 * 33]); o.y = pk2(s[2 * 33], s[3 * 33]); o.z = pk2(s[4 * 33], s[5 * 33]); o.w = pk2(s[6 * 33], s[7 * 33]);
        *(u32x4*)(WT + (size_t)(wt_row0 + n) * K + k0 + 8 * c) = o; }
    LDS_WAIT(); asm volatile("" ::: "memory");
}

struct TrItem { const float* W; bf16_t* WT; const float* kscale; int K, N, wt_row0, k0, n0; };
__device__ __forceinline__ void p0_tr_load(const TrItem& d, float (&v)[32], int lane) {
#pragma unroll
    for (int i = 0; i < 32; ++i) { const int kk = 2 * i + (lane >> 5); v[i] = d.W[(size_t)(d.k0 + kk) * d.N + d.n0 + (lane & 31)]; }
    if (d.kscale) {
#pragma unroll
        for (int i = 0; i < 32; ++i) { const int kk = 2 * i + (lane >> 5); v[i] *= d.kscale[d.k0 + kk]; } }
}
__device__ __forceinline__ void p0_tr_store(const TrItem& d, const float (&v)[32], LAS float* scr, int lane) {
#pragma unroll
    for (int i = 0; i < 32; ++i) { const int kk = 2 * i + (lane >> 5); scr[kk * 33 + (lane & 31)] = v[i]; }
    LDS_WAIT(); asm volatile("" ::: "memory");
    const int c = lane & 7;
#pragma unroll
    for (int j = 0; j < 4; ++j) { const int n = (lane >> 3) + 8 * j; const LAS float* s = scr + (8 * c) * 33 + n;
        u32x4 o; o.x = pk2(s[0 * 33], s[1 * 33]); o.y = pk2(s[2 * 33], s[3 * 33]); o.z = pk2(s[4 * 33], s[5 * 33]); o.w = pk2(s[6 * 33], s[7 * 33]);
        *(u32x4*)(d.WT + (size_t)(d.wt_row0 + n) * d.K + d.k0 + 8 * c) = o; }
    LDS_WAIT(); asm volatile("" ::: "memory");
}
__device__ __forceinline__ void ssm_tables(const Args& a, int g, LAS unsigned char* lds, int tid) {
    LAS float* LD = (LAS float*)lds;
    LAS float* LBs = LD + 256;
    LAS float* BB = LBs + 256;
    LAS float* KT = BB + 4096;
    LAS float* CC = KT + 8192;
    float* lb16 = (float*)(a.ws + WS_LB16);
    bf16_t* WIN = (bf16_t*)(a.ws + WS_WIN) + (size_t)g * 256 * 256;
    bf16_t* WBIG = (bf16_t*)(a.ws + WS_WBIG) + (size_t)g * 256 * 512;
    for (int e = tid; e < 2048; e += 512) { const int d = e >> 10, r = e & 1023; const size_t ci_ = (size_t)(d * NG + g) * 1024 + r; CC[e * 2] = a.c_re[ci_]; CC[e * 2 + 1] = a.c_im[ci_]; }
    if (tid < 128) {
        const int d = tid >> 6, p = tid & 63; const int idx = (d * NG + g) * 64 + p;
        const float lr = fminf(a.a_re[idx], -1e-4f), li = a.a_im[idx];
        const float dt = expf(a.log_dt[d * NG + g]);
        const float er = expf(lr * dt); float sn, cs; sincosf(li * dt, &sn, &cs);
        const float br = er * cs, bi = er * sn;
        LD[tid * 2] = lr * dt; LD[tid * 2 + 1] = li * dt; LBs[tid * 2] = br; LBs[tid * 2 + 1] = bi;
        const float nr = br - 1.f, ni = bi, den = lr * lr + li * li;
        KT[tid * 2] = (nr * lr + ni * li) / den; KT[tid * 2 + 1] = (ni * lr - nr * li) / den;
        const float e16 = expf(16.f * lr * dt); float s16, c16; sincosf(16.f * li * dt, &s16, &c16);
        lb16[(g * 128 + tid) * 2] = e16 * c16; lb16[(g * 128 + tid) * 2 + 1] = e16 * s16;
    }
    __syncthreads();
    for (int e = tid; e < 2048; e += 512) {
        const int dp = e >> 4, h = e & 15, d = dp >> 6, p = dp & 63;
        const size_t bi_ = ((size_t)(d * NG + g) * 64 + p) * 16 + h;
        const float xr = a.b_re[bi_], xi = a.b_im[bi_], cr = KT[dp * 2], ci = KT[dp * 2 + 1];
        BB[e * 2] = cr * xr - ci * xi; BB[e * 2 + 1] = cr * xi + ci * xr;
    }
    __syncthreads();
    {
        const int d = tid >> 8, hp = (tid >> 4) & 15, h = tid & 15; float acc[16];
#pragma unroll
        for (int t = 0; t < 16; ++t) acc[t] = 0.f;
        const LAS float* cc = CC + ((d * 16 + hp) * 64) * 2;
        for (int p = 0; p < 64; ++p) {
            const float c_r = cc[p * 2], c_i = cc[p * 2 + 1], b_r = BB[((d * 64 + p) * 16 + h) * 2], b_i = BB[((d * 64 + p) * 16 + h) * 2 + 1];
            float wr = c_r * b_r - c_i * b_i, wi = c_r * b_i + c_i * b_r; const float l_r = LBs[(d * 64 + p) * 2], l_i = LBs[(d * 64 + p) * 2 + 1];
#pragma unroll
            for (int t = 0; t < 16; ++t) { acc[t] += wr; const float nr = wr * l_r - wi * l_i; wi = wr * l_i + wi * l_r; wr = nr; }
        }
#pragma unroll
        for (int t = 0; t < 16; ++t) KT[((d * 16 + t) * 16 + hp) * 16 + h] = acc[t];
    }
    __syncthreads();
    for (int q = tid; q < 8192; q += 512) {
        const int n = q >> 5, kc = q & 31, s = kc >> 1, h0 = (kc & 1) * 8, j = n >> 4, hp = n & 15;
        float v[8];
#pragma unroll
        for (int e = 0; e < 8; ++e) { const int h = h0 + e;
            if (s < j) v[e] = KT[((0 * 16 + (j - s)) * 16 + hp) * 16 + h];
            else if (s > j) v[e] = KT[((1 * 16 + (s - j)) * 16 + hp) * 16 + h];
            else v[e] = KT[((0 * 16 + 0) * 16 + hp) * 16 + h] + KT[((1 * 16 + 0) * 16 + hp) * 16 + h] + (h == hp ? a.ssm_d[g * 16 + h] : 0.f); }
        u32x4 w; w.x = pk2(v[0], v[1]); w.y = pk2(v[2], v[3]); w.z = pk2(v[4], v[5]); w.w = pk2(v[6], v[7]);
        *(u32x4*)(WBIG + (size_t)n * 512 + s * 16 + h0) = w;
    }
    for (int q = tid; q < 2048; q += 512) {
        const int p = q & 63, js = (q >> 6) & 15, d = q >> 10; const float ldr = LD[(d * 64 + p) * 2], ldi = LD[(d * 64 + p) * 2 + 1];
        {   const float pw = (float)(d == 0 ? js + 1 : 16 - js); const float er = expf(pw * ldr); float sn, cs; sincosf(pw * ldi, &sn, &cs); const float pr = er * cs, pi = er * sn;
#pragma unroll
            for (int hp = 0; hp < 16; ++hp) { const float c_r = CC[((d * 16 + hp) * 64 + p) * 2], c_i = CC[((d * 16 + hp) * 64 + p) * 2 + 1];
                *(unsigned*)(WBIG + (size_t)(js * 16 + hp) * 512 + 256 + d * 128 + 2 * p) = pk2(c_r * pr - c_i * pi, -(c_r * pi + c_i * pr)); } }
        {   const float pw = (float)(d == 0 ? 15 - js : js); const float er = expf(pw * ldr); float sn, cs; sincosf(pw * ldi, &sn, &cs); const float pr = er * cs, pi = er * sn;
            float zr[16], zi[16];
#pragma unroll
            for (int h = 0; h < 16; ++h) { const float b_r = BB[((d * 64 + p) * 16 + h) * 2], b_i = BB[((d * 64 + p) * 16 + h) * 2 + 1]; zr[h] = pr * b_r - pi * b_i; zi[h] = pr * b_i + pi * b_r; }
            bf16_t* d0 = WIN + (size_t)(d * 128 + p) * 256 + js * 16; bf16_t* d1 = d0 + (size_t)64 * 256;
            u32x4 w; w.x = pk2(zr[0], zr[1]); w.y = pk2(zr[2], zr[3]); w.z = pk2(zr[4], zr[5]); w.w = pk2(zr[6], zr[7]); *(u32x4*)d0 = w;
            w.x = pk2(zr[8], zr[9]); w.y = pk2(zr[10], zr[11]); w.z = pk2(zr[12], zr[13]); w.w = pk2(zr[14], zr[15]); *(u32x4*)(d0 + 8) = w;
            w.x = pk2(zi[0], zi[1]); w.y = pk2(zi[2], zi[3]); w.z = pk2(zi[4], zi[5]); w.w = pk2(zi[6], zi[7]); *(u32x4*)d1 = w;
            w.x = pk2(zi[8], zi[9]); w.y = pk2(zi[10], zi[11]); w.z = pk2(zi[12], zi[13]); w.w = pk2(zi[14], zi[15]); *(u32x4*)(d1 + 8) = w; }
    }
    __syncthreads();
}

#define XB_TMO      128
#define XB_XCNT(j)  (256  + 64 * (j))
#define XB_XSUB(j)  (1280 + 64 * (j))
#define XB_XGEN(j)  (2304 + 64 * (j))
#define XB_TOP      3328
#define XB_TOPGEN   3392
#define XCD_BAR_WORDS 3456
#define XB_SPIN_CAP (1u << 18)
__device__ __forceinline__ unsigned xb_ld(unsigned* p)              { return __hip_atomic_load(p, __ATOMIC_RELAXED, __HIP_MEMORY_SCOPE_AGENT); }
__device__ __forceinline__ unsigned xb_add(unsigned* p, unsigned v) { return __hip_atomic_fetch_add(p, v, __ATOMIC_RELAXED, __HIP_MEMORY_SCOPE_AGENT); }
__device__ __forceinline__ unsigned xb_xcc_id() { return (unsigned)__builtin_amdgcn_s_getreg((3 << 11) | 20) & 0xFu; }
#define XB_SPIN(cond, bar) do { unsigned _sp = 0; while (cond) { __builtin_amdgcn_s_sleep(1); \
    if ((++_sp & 255u) == 0u) { if (xb_ld(&(bar)[XB_TMO])) break; if (_sp > XB_SPIN_CAP) { atomicAdd(&(bar)[XB_TMO], 1u); break; } } } } while (0)
struct XcdBarrier { unsigned* bar; unsigned x; volatile LAS unsigned* st; };
__device__ __forceinline__ XcdBarrier xcd_barrier_post(unsigned* bar, volatile LAS unsigned* st, bool leader) {
    XcdBarrier b; b.bar = bar; b.x = xb_xcc_id(); b.st = st;
    if (leader) (void)xb_add(&bar[XB_XCNT(b.x)], 1u);
    return b;
}
__device__ __forceinline__ void xcd_barrier_complete(unsigned* bar, unsigned x, unsigned& nloc, unsigned& nx) {
    const unsigned G = gridDim.x * gridDim.y * gridDim.z;
    unsigned sum, cnt, mine, sp = 0u;
    for (;;) {
        sum = 0u; cnt = 0u; mine = 0u;
#pragma unroll
        for (unsigned j = 0; j < 16; ++j) { const unsigned c = xb_ld(&bar[XB_XCNT(j)]); sum += c; cnt += (c > 0u) ? 1u : 0u; mine = (j == x) ? c : mine; }
        if (sum == G) break;
        __builtin_amdgcn_s_sleep(1);
        if ((++sp & 255u) == 0u) { if (xb_ld(&bar[XB_TMO])) break; if (sp > XB_SPIN_CAP) { atomicAdd(&bar[XB_TMO], 1u); break; } }
    }
    nloc = mine > 0u ? mine : 1u; nx = cnt > 0u ? cnt : 1u;
}
__device__ __forceinline__ void xcd_barrier(const XcdBarrier& b, bool leader) {
    asm volatile("s_waitcnt vmcnt(0)" ::: "memory");
    __syncthreads();
    if (leader) {
        unsigned* bar = b.bar;
        __builtin_amdgcn_s_waitcnt(0);
        unsigned nloc = b.st[0], nx = b.st[1];
        if (nloc == 0u) { xcd_barrier_complete(bar, b.x, nloc, nx); b.st[0] = nloc; b.st[1] = nx; }
        const unsigned old = xb_add(&bar[XB_XSUB(b.x)], 1u);
        const unsigned gen = old / nloc;
        if (old + 1u == (gen + 1u) * nloc) {
            __builtin_amdgcn_fence(__ATOMIC_RELEASE, "agent");
            asm volatile("s_waitcnt vmcnt(0)" ::: "memory");
            const unsigned og = xb_add(&bar[XB_TOP], 1u);
            const unsigned tg = og / nx;
            if (og + 1u == (tg + 1u) * nx) xb_add(&bar[XB_TOPGEN], 1u);
            else XB_SPIN(xb_ld(&bar[XB_TOPGEN]) == tg, bar);
            __builtin_amdgcn_fence(__ATOMIC_ACQUIRE, "agent");
            xb_add(&bar[XB_XGEN(b.x)], 1u);
            asm volatile("s_waitcnt vmcnt(0)" ::: "memory");
        } else {
            XB_SPIN(xb_ld(&bar[XB_XGEN(b.x)]) == gen, bar);
            __builtin_amdgcn_fence(__ATOMIC_ACQUIRE, "agent");
            asm volatile("s_waitcnt vmcnt(0)" ::: "memory");
        }
    }
    __syncthreads();
}

__global__ void __launch_bounds__(512, 2) fwd_kernel(Args a) {
    extern __shared__ __attribute__((aligned(16))) unsigned char lds_raw[];
    LAS unsigned char* lds = (LAS unsigned char*)lds_raw;
    cg::grid_group grid = cg::this_grid();
    const int wave = __builtin_amdgcn_readfirstlane(threadIdx.x >> 6);
    const bool leader = (wave == 0) && (lane_id_opaque() == 0);
    volatile LAS unsigned* xst = (volatile LAS unsigned*)(lds + XBST_OFF);
    if (leader) { xst[0] = 0u; xst[1] = 0u; }
    __syncthreads();
    if (a.ws == nullptr) grid.sync();
    const XcdBarrier xbar = xcd_barrier_post((unsigned*)(a.ws + WS_BAR), xst, leader);
#define GRID_SYNC() xcd_barrier(xbar, (wave == 0) && (lane_id_opaque() == 0))
#define LANE_IDS const int lane = lane_id_opaque(), tid = wave * 64 + lane; (void)tid;
    const int G = gridDim.x, bid = blockIdx.x;
    unsigned char* ws = a.ws;
    bf16_t* W1T = (bf16_t*)(ws + WS_W1T); bf16_t* WGLUT = (bf16_t*)(ws + WS_WGLUT); bf16_t* WOT = (bf16_t*)(ws + WS_WOT); bf16_t* WGT = (bf16_t*)(ws + WS_WGT); bf16_t* WPT = (bf16_t*)(ws + WS_WPT);
    float2* ROPE = (float2*)(ws + WS_ROPE); float* RINV = (float*)(ws + WS_RINV); float* LB16 = (float*)(ws + WS_LB16); float* SSQ1 = (float*)(ws + WS_SSQ1); float* SSQ2 = (float*)(ws + WS_SSQ2);
    bf16_t* PB = (bf16_t*)(ws + WS_PB); bf16_t* WIN = (bf16_t*)(ws + WS_WIN); bf16_t* WBIG = (bf16_t*)(ws + WS_WBIG);
    bf16_t* XB = (bf16_t*)(ws + WS_XB); bf16_t* HB = (bf16_t*)(ws + WS_XB);
    bf16_t* Q = (bf16_t*)(ws + WS_Q); bf16_t* KB = (bf16_t*)(ws + WS_K); bf16_t* VB = (bf16_t*)(ws + WS_V); bf16_t* GA = (bf16_t*)(ws + WS_GA); bf16_t* GS = (bf16_t*)(ws + WS_GS);
    bf16_t* UCAT = (bf16_t*)(ws + WS_UCAT); bf16_t* PPB = (bf16_t*)(ws + WS_UCAT); bf16_t* YMIX = (bf16_t*)(ws + WS_YMIX); bf16_t* YS = (bf16_t*)(ws + WS_YS);

#pragma unroll
    for (int rep_ = 0; rep_ < 1 + ((REP_MASK >> 0) & 1); ++rep_) { LANE_IDS
        const int gw = bid * 8 + wave, NGW = G * 8;
        LAS float* scr = (LAS float*)(lds + wave * 16384);
        constexpr int I1 = 32 * 144, I2 = 16 * 64, I3 = 32 * 64, I4 = 32 * 64, I5 = 4 * 64, NIT = I1 + I2 + I3 + I4 + I5;
        auto item_desc = [&](int r) -> TrItem {
            if (r < I1) { const int kb = r / 144, lgg = r % 144, pn = lgg >> 3, lg = lgg & 7, wtg = pn * 8 + 4 * (lg & 1) + 2 * (lg >> 2) + ((lg >> 1) & 1);
                return TrItem{a.w_in, W1T, a.norm_mix, DM, DIN, wtg * 32, kb * 64, lgg * 32}; } r -= I1;
            if (r < I2) { const int kb = r / 64, lgg = r % 64, l2 = lgg & 31, wtg = (l2 >> 2) * 8 + 4 * (lgg >> 5) + (l2 & 3);
                return TrItem{a.w_glu, WGLUT, nullptr, DSSM, 2 * DSSM, wtg * 32, kb * 64, lgg * 32}; } r -= I2;
            if (r < I3) { const int kb = r / 64, lgg = r % 64; return TrItem{a.w_out, WOT, nullptr, DM, DM, lgg * 32, kb * 64, lgg * 32}; } r -= I3;
            if (r < I4) { const int kb = r / 64, lgg = r % 64; return TrItem{a.w_ple_gate, WGT, a.norm_ple, DM, DM, lgg * 32, kb * 64, lgg * 32}; } r -= I4;
            const int kb = r / 64, lgg = r % 64; return TrItem{a.w_ple_proj, WPT, nullptr, PLE, DM, lgg * 32, kb * 64, lgg * 32};
        };
#pragma unroll
        for (int rq_ = 0; rq_ < 1 + ((REP_MASK >> 8) & 1); ++rq_)
        for (int it = gw; it < NIT; it += 2 * NGW) {
            const bool two = it + NGW < NIT;
            const TrItem dA = item_desc(it), dB = item_desc(two ? it + NGW : it);
            float vA[32], vB[32];
            p0_tr_load(dA, vA, lane); if (two) p0_tr_load(dB, vB, lane);
            p0_tr_store(dA, vA, scr, lane); if (two) p0_tr_store(dB, vB, scr, lane);
        }
#pragma unroll
        for (int rq_ = 0; rq_ < 1 + ((REP_MASK >> 9) & 1); ++rq_)
        for (int m = gw; m < T; m += 2 * NGW) {
            const int m2 = m + NGW; const bool two = m2 < T;
            const f32x4* xr = (const f32x4*)(a.x + (size_t)m * DM) + lane; const f32x4* xr2 = (const f32x4*)(a.x + (size_t)(two ? m2 : m) * DM) + lane;
            f32x4 v[8], w2[8]; float s = 0.f, s2 = 0.f;
#pragma unroll
            for (int j = 0; j < 8; ++j) v[j] = xr[64 * j];
#pragma unroll
            for (int j = 0; j < 8; ++j) w2[j] = xr2[64 * j];
#pragma unroll
            for (int j = 0; j < 8; ++j) { s += (v[j][0] * v[j][0] + v[j][1] * v[j][1]) + (v[j][2] * v[j][2] + v[j][3] * v[j][3]); s2 += (w2[j][0] * w2[j][0] + w2[j][1] * w2[j][1]) + (w2[j][2] * w2[j][2] + w2[j][3] * w2[j][3]); }
            s = wave_sum(s); s2 = wave_sum(s2);
            if (lane == 0) { RINV[m] = rsqrtf(s * (1.f / DM) + EPS); if (two) RINV[m2] = rsqrtf(s2 * (1.f / DM) + EPS); }
            u32x2* o = (u32x2*)(XB + (size_t)m * DM) + lane; u32x2* o2 = (u32x2*)(XB + (size_t)m2 * DM) + lane;
#pragma unroll
            for (int j = 0; j < 8; ++j) { u32x2 w; w.x = pk2(v[j][0], v[j][1]); w.y = pk2(v[j][2], v[j][3]); o[64 * j] = w; }
            if (two) {
#pragma unroll
                for (int j = 0; j < 8; ++j) { u32x2 w; w.x = pk2(w2[j][0], w2[j][1]); w.y = pk2(w2[j][2], w2[j][3]); o2[64 * j] = w; } }
        }
        for (int i = bid * 512 + tid; i < T * PLE / 4; i += G * 512) { const f32x4 v = ((const f32x4*)a.p)[i]; u32x2 w; w.x = pk2(v[0], v[1]); w.y = pk2(v[2], v[3]); ((u32x2*)PB)[i] = w; }
        for (int i = bid * 512 + tid; i < 2048; i += G * 512) { const int pos = i >> 5, f = i & 31; const float inv = powf(10000.f, -(float)f / 32.f); float sn, cs; sincosf((float)pos * inv, &sn, &cs); ROPE[i] = make_float2(cs, sn); }
    GRID_SYNC(); }


    if constexpr ((REP_MASK >> 10) & 1) { GRID_SYNC(); GRID_SYNC(); GRID_SYNC(); GRID_SYNC(); }
#pragma unroll
    for (int rep_ = 0; rep_ < 1 + ((REP_MASK >> 1) & 1); ++rep_) { LANE_IDS
        { pg8::Gemm g{XB, W1T, DM, DM, DM, 0, 0}; pg8::StaticOrder S; S.init(T, 14 * 256, G, bid);
          pg8::Epi1 E{RINV, a.q_norm, a.k_norm, ROPE, Q, KB, VB, GA, GS, UCAT, (LAS float*)(lds + XCH_OFF), 0};
          pg8::gemm_phase<pg8::Epi1, pg8::StaticOrder, true>(lds, g, S, E, wave); }
        __syncthreads();
        for (int gi = bid - (G - NG); gi >= 0 && gi < NG; gi += NG) ssm_tables(a, gi, lds, tid);
    GRID_SYNC(); }

#pragma unroll
    for (int rep_ = 0; rep_ < 1 + ((REP_MASK >> 2) & 1); ++rep_) {
#pragma unroll
        for (int rq_ = 0; rq_ < 2; ++rq_) {
        if (bid < 2 * NG) { if (rq_ == 1 && !((REP_MASK >> 6) & 1)) break;
            pg8::BatchOrder S{2 * NG, G, bid};
            { pg8::Gemm g{UCAT, WIN, 256, 512, 256, (size_t)NCH * 512 * 2, (size_t)256 * 256 * 2};
              pg8::EpiS1 E{LB16, UCAT}; pg8::gemm_phase<pg8::EpiS1, pg8::BatchOrder, true>(lds, g, S, E, wave); }
            asm volatile("s_waitcnt vmcnt(0)\n\tbuffer_inv sc1\n\ts_waitcnt vmcnt(0)" ::: "memory"); __syncthreads();
            { pg8::Gemm g{UCAT, WBIG, 512, 512, 512, (size_t)NCH * 512 * 2, (size_t)256 * 512 * 2};
              pg8::EpiS2 E{YS}; pg8::gemm_phase<pg8::EpiS2, pg8::BatchOrder, true>(lds, g, S, E, wave); }
        } else { if (rq_ == 1 && !((REP_MASK >> 11) & 1)) break;
            pg8::Gemm g{XB, W1T + (size_t)14 * 256 * DM, DM, DM, DM, 0, 0}; pg8::ListOrder S{bid - 2 * NG, 128, G};
            pg8::Epi1 E{RINV, a.q_norm, a.k_norm, ROPE, Q, KB, VB, GA, GS, UCAT, (LAS float*)(lds + XCH_OFF), 14};
            pg8::gemm_phase<pg8::Epi1, pg8::ListOrder, true>(lds, g, S, E, wave);
        }
        __syncthreads(); }
#pragma unroll
        for (int rq_ = 0; rq_ < 1 + ((REP_MASK >> 7) & 1); ++rq_)
        for (int un = bid; un < 256; un += G) {
            const int x = un & 7, jj = un >> 3, b = x >> 2, kvh = (x >> 1) & 1, idx = (x & 1) * 32 + jj, h = kvh * 4 + (idx >> 4), qb = idx & 15;
            const size_t tok0 = (size_t)b * SEQ + qb * 256;
            att::attn_dense_body(Q + tok0 * DATT + h * 128, KB + (size_t)b * SEQ * DKV + kvh * 128, VB + (size_t)b * SEQ * DKV + kvh * 128,
                                 GA + tok0 * DATT + h * 128, YMIX + tok0 * DM + h * 128, SEQ, (char*)lds_raw, wave);
        }
    GRID_SYNC(); }

#pragma unroll
    for (int rep_ = 0; rep_ < 1 + ((REP_MASK >> 3) & 1); ++rep_) {
        { pg8::Gemm g{YS, WGLUT, DSSM, DSSM, DSSM, 0, 0}; pg8::StaticOrder S; S.init(T, 2 * DSSM, G, bid);
          pg8::EpiGlu E{a.b_glu, GS, YMIX}; pg8::gemm_phase<pg8::EpiGlu, pg8::StaticOrder, true>(lds, g, S, E, wave); }
        __syncthreads();
        { pg8::Gemm g{PB, WPT, PLE, PLE, PLE, 0, 0}; pg8::StaticOrder S; S.init(T, DM, G, bid);
          pg8::EpiBf E{PPB, DM}; pg8::gemm_phase<pg8::EpiBf, pg8::StaticOrder, true>(lds, g, S, E, wave); }
    GRID_SYNC(); }


#pragma unroll
    for (int rep_ = 0; rep_ < 1 + ((REP_MASK >> 4) & 1); ++rep_) {
        pg8::Gemm g{YMIX, WOT, DM, DM, DM, 0, 0}; pg8::StaticOrder S; S.init(T, DM, G, bid);
        pg8::EpiOut E{a.x, a.out, HB, SSQ1}; pg8::gemm_phase<pg8::EpiOut, pg8::StaticOrder, true>(lds, g, S, E, wave);
    GRID_SYNC(); }


    { LANE_IDS
        pg8::StaticOrder S; S.init(T, DM, G, bid); pg8::Unit u0;
        LAS float* r2 = (LAS float*)(lds + R2_OFF);
        if (S.next(0, u0) && tid < 256) { const float* sp = SSQ1 + (size_t)(u0.pm * 256 + tid) * 32; float s = 0.f;
#pragma unroll
            for (int i = 0; i < 8; ++i) { const f32x4 v = ((const f32x4*)sp)[i]; s += (v[0] + v[1]) + (v[2] + v[3]); }
            r2[tid] = rsqrtf(s * (1.f / DM) + EPS); }
        __syncthreads();
        pg8::Gemm g{HB, WGT, DM, DM, DM, 0, 0};
        pg8::EpiGate E{a.out, PPB, SSQ2, (unsigned*)ws, a.norm_final, r2, HB}; pg8::gemm_phase<pg8::EpiGate, pg8::StaticOrder, true>(lds, g, S, E, wave);
    }
}

extern "C" void kernel_launch(void* const* d_in, const int* in_sizes, int n_in, void* d_out, int out_size, void* d_ws, size_t ws_size, hipStream_t stream) {
    static int grid = 0;
    if (grid == 0) {
        if (n_in != 21 || in_sizes[0] != T * DM || out_size != T * DM || ws_size < WS_END) { fprintf(stderr, "kernel_launch: unexpected shapes (n_in %d, in0 %d, out %d, ws %zu)\n", n_in, n_in > 0 ? in_sizes[0] : -1, out_size, ws_size); grid = -1; return; }
        int dev = 0, cus = 0, per_cu = 0;
        hipGetDevice(&dev); hipDeviceGetAttribute(&cus, hipDeviceAttributeMultiprocessorCount, dev);
        if (hipFuncSetAttribute((const void*)fwd_kernel, hipFuncAttributeMaxDynamicSharedMemorySize, LDS_BYTES) != hipSuccess) { fprintf(stderr, "kernel_launch: hipFuncSetAttribute failed\n"); grid = -1; return; }
        hipOccupancyMaxActiveBlocksPerMultiprocessor(&per_cu, (const void*)fwd_kernel, 512, LDS_BYTES);
        (void)hipGetLastError();
        if (per_cu < 1) fprintf(stderr, "kernel_launch: occupancy query reports %d blocks per CU\n", per_cu);
        grid = cus > 256 ? 256 : cus;
    }
    if (grid < 0) return;
    Args a{};
    const float** f = (const float**)&a;
    for (int i = 0; i < 21; ++i) f[i] = (const float*)d_in[i];
    a.out = (float*)d_out; a.ws = (unsigned char*)d_ws;
    if (hipMemsetAsync(d_ws, 0, WS_CTL_BYTES, stream) != hipSuccess) { fprintf(stderr, "kernel_launch: hipMemsetAsync failed\n"); return; }
    void* args[] = {&a};
    hipError_t e = hipLaunchCooperativeKernel((const void*)fwd_kernel, dim3(grid), dim3(512), args, LDS_BYTES, stream);
    if (e != hipSuccess) fprintf(stderr, "kernel_launch: cooperative launch failed: %s (grid %d)\n", hipGetErrorString(e), grid);
}
```

```cpp
#include <hip/hip_runtime.h>
#include <hip/hip_cooperative_groups.h>
#include <cstdio>
#include <cstdint>
namespace cg = cooperative_groups;

#define LAS __attribute__((address_space(3)))
typedef unsigned short bf16_t;
typedef short bf16x8 __attribute__((ext_vector_type(8)));
typedef short s16x4 __attribute__((ext_vector_type(4)));
typedef float f32x4 __attribute__((ext_vector_type(4)));
typedef float f32x16 __attribute__((ext_vector_type(16)));
typedef unsigned u32x4 __attribute__((ext_vector_type(4)));
typedef unsigned u32x2 __attribute__((ext_vector_type(2)));

constexpr int T = 8192, SEQ = 4096, DM = 2048, DIN = 4608, DATT = 1024, DKV = 256, DSSM = 1024, PLE = 256;
constexpr int NG = 64, NCH = T / 16;
constexpr float EPS = 1e-6f;
#ifndef PH_MASK
#define PH_MASK 0xff
#endif
#ifndef REP_MASK
#define REP_MASK 0
#endif

constexpr size_t MiB = 1u << 20;
constexpr size_t WS_W1T = 1 * MiB, WS_WGLUT = 19 * MiB, WS_WOT = 23 * MiB, WS_WGT = 31 * MiB, WS_WPT = 39 * MiB;
constexpr size_t WS_ROPE = 40 * MiB, WS_RINV = 40 * MiB + 65536, WS_LB16 = 40 * MiB + 131072, WS_SSQ1 = 41 * MiB, WS_SSQ2 = 42 * MiB;
constexpr size_t WS_PB = 43 * MiB, WS_WIN = 47 * MiB, WS_WBIG = 55 * MiB;
constexpr size_t WS_XB = 71 * MiB;
constexpr size_t WS_Q = 103 * MiB, WS_K = 119 * MiB, WS_V = 123 * MiB, WS_GA = 127 * MiB, WS_GS = 143 * MiB;
constexpr size_t WS_UCAT = 159 * MiB;
constexpr size_t WS_YMIX = 191 * MiB, WS_YS = 223 * MiB, WS_END = 239 * MiB;

constexpr int RING_BYTES = 131072, XCH_OFF = RING_BYTES, R2_OFF = RING_BYTES + 4096, XBST_OFF = RING_BYTES + 8192, LDS_BYTES = 147456;
constexpr size_t WS_BAR = 65536, WS_CTL_BYTES = 131072;

struct Args {
    const float *x, *p, *norm_mix, *w_in, *q_norm, *k_norm, *a_re, *a_im, *log_dt, *b_re, *b_im, *c_re, *c_im, *ssm_d, *w_glu, *b_glu, *w_out, *norm_ple, *w_ple_gate, *w_ple_proj, *norm_final;
    float* out; unsigned char* ws;
};

typedef __bf16 bf16s_;
__device__ __forceinline__ unsigned f2bf(float f) { return (unsigned)__builtin_bit_cast(unsigned short, (bf16s_)f); }
typedef float f32x2_ __attribute__((ext_vector_type(2)));
typedef __bf16 bf16x2_ __attribute__((ext_vector_type(2)));
__device__ __forceinline__ unsigned pk2(float lo, float hi) { const f32x2_ v = {lo, hi}; return __builtin_bit_cast(unsigned, __builtin_convertvector(v, bf16x2_)); }
__device__ __forceinline__ float bf2f(unsigned short b) { return __builtin_bit_cast(float, (unsigned)b << 16); }
__device__ __forceinline__ float bflo(unsigned w) { return __builtin_bit_cast(float, w << 16); }
__device__ __forceinline__ float bfhi(unsigned w) { return __builtin_bit_cast(float, w & 0xffff0000u); }
__device__ __forceinline__ unsigned cvt_pk_bf16(float lo, float hi) { unsigned r; asm volatile("v_cvt_pk_bf16_f32 %0, %1, %2" : "=v"(r) : "v"(lo), "v"(hi)); return r; }
__device__ __forceinline__ float sigmoidf_(float v) { return __builtin_amdgcn_rcpf(1.f + __builtin_amdgcn_exp2f(-1.4426950408889634f * v)); }
__device__ __forceinline__ float siluf_(float v) { return v * __builtin_amdgcn_rcpf(1.f + __builtin_amdgcn_exp2f(-1.4426950408889634f * v)); }
__device__ __forceinline__ float gelu_tanh(float v) { const float t = (-1.5957691216057308f * 1.4426950408889634f) * (v + 0.044715f * v * v * v); return v * __builtin_amdgcn_rcpf(1.f + __builtin_amdgcn_exp2f(t)); }
template <int K> __device__ __forceinline__ float swz_xor(float v) { return __int_as_float(__builtin_amdgcn_ds_swizzle(__float_as_int(v), (K << 10) | 0x1f)); }
__device__ __forceinline__ float sum_xor32(float v) { auto rr = __builtin_amdgcn_permlane32_swap(__float_as_uint(v), __float_as_uint(v), false, false); return __uint_as_float(rr[0]) + __uint_as_float(rr[1]); }
__device__ __forceinline__ float wave_sum(float v) { v += swz_xor<1>(v); v += swz_xor<2>(v); v += swz_xor<4>(v); v += swz_xor<8>(v); v += swz_xor<16>(v); return sum_xor32(v); }
#define LDS_WAIT() asm volatile("s_waitcnt lgkmcnt(0)" ::: "memory")
__device__ __forceinline__ int lane_id_opaque() { int l = __builtin_amdgcn_mbcnt_hi(~0u, __builtin_amdgcn_mbcnt_lo(~0u, 0u)); asm volatile("" : "+v"(l)); return l; }

namespace pg8 {
constexpr int BM = 256, BK = 64, HALF = 128, HTB = HALF * BK * 2, NXCD = 8, WGM = 8;
__host__ __device__ __forceinline__ int lds_byte(int r, int c) { const int st = (r >> 4) * 2 + (c >> 5), rr = r & 15, cc = c & 31, ob = rr * 64 + cc * 2; return st * 1024 + (ob ^ (((ob >> 9) & 1) << 5)); }
__host__ __device__ __forceinline__ void stage_rc(int b, int& R, int& C) { const int st = b / 1024, sb = b % 1024, swz = sb ^ (((sb >> 9) & 1) << 5); R = (st >> 1) * 16 + swz / 64; C = (st & 1) * 32 + (swz % 64) / 2; }
__host__ __device__ __forceinline__ int perm32(int rho) { const int n = rho >> 4, i = rho & 15; return 8 * (i >> 2) + 4 * n + (i & 3); }

struct Unit { int pm, pn, z; };
struct Gemm { const bf16_t* A; const bf16_t* Bt; int K, lda, ldb; size_t zA, zB; };

struct StaticOrder {
    int nM, nN, nwg, G, c;
    __device__ void init(int M, int N, int G_, int c_) { nM = M / BM; nN = N / BM; nwg = nM * nN; G = G_; c = c_; }
    __device__ bool next(int i, Unit& u) const {
        const long L = (long)i * G + c; if (L >= nwg) return false;
        int wgid = (int)L; { const int q = nwg / NXCD, r = nwg % NXCD, xcd = wgid % NXCD, off = wgid / NXCD; wgid = (xcd < r ? xcd * (q + 1) : r * (q + 1) + (xcd - r) * q) + off; }
        const int nig = WGM * nN, gid = wgid / nig, fm = gid * WGM, gsz = (nM - fm) < WGM ? (nM - fm) : WGM;
        u.pm = fm + ((wgid % nig) % gsz); u.pn = (wgid % nig) / gsz; u.z = 0; return true;
    }
};
struct BatchOrder {
    int n, G, c;
    __device__ bool next(int i, Unit& u) const { const int L = i * G + c; if (L >= n) return false; u.z = L >> 1; u.pm = L & 1; u.pn = 0; return true; }
};

struct ListOrder {
    int L0, n, stride;
    __device__ bool next(int i, Unit& u) const { const int L = L0 + i * stride; if (L < 0 || L >= n) return false;
        const int x = L & 7, j = L >> 3; u.pm = 4 * x + (j >> 2); u.pn = j & 3; u.z = 0; return true; }
};
template <class Epi, class Sched, bool ALIGN_EPI>
__device__ __forceinline__ void gemm_phase(LAS unsigned char* lds, const Gemm g, const Sched& S, const Epi& E, const int wid) {
    const int lane = lane_id_opaque(), tid = wid * 64 + lane, wr = wid >> 2, wc = wid & 3, fr = lane & 15, fq = lane >> 4;
    const int K = g.K, nt = K / BK;
    unsigned voffA[2], voffB[2];
#pragma unroll
    for (int i = 0; i < 2; ++i) { int R, C; stage_rc(tid * 16 + i * 8192, R, C); const int Rb = (R & ~31) + perm32(R & 31);
        voffA[i] = (unsigned)(R * g.lda + C) * 2u; voffB[i] = (unsigned)(Rb * g.ldb + C) * 2u; }
    const size_t kstep = (size_t)(BK * 2);
    const size_t hstepA = (size_t)HALF * g.lda * 2, hstepB = (size_t)HALF * g.ldb * 2;
    const size_t tstepA = 2 * hstepA, tstepB = 2 * hstepB;
    const unsigned ldsw = (unsigned)wid * 1024u;
    const int aoff = lds_byte(wr * 64 + fr, fq * 8), boff = lds_byte(wc * 32 + fr, fq * 8);
#define PG8_SA(b, h) (((b) * 2 + (h)) * HTB)
#define PG8_SB(b, h) ((4 + (b) * 2 + (h)) * HTB)
#define PG8_STAGE(bufoff, gbase, voff) do { _Pragma("unroll") for (int _i = 0; _i < 2; ++_i) \
        __builtin_amdgcn_global_load_lds((const unsigned*)((const char*)(gbase) + (voff)[_i]), (LAS unsigned*)(lds + (bufoff) + ldsw + _i * 8192), 16, 0, 0); } while (0)
#define PG8_LDA(dst, b, h) do { _Pragma("unroll") for (int m = 0; m < 4; ++m) _Pragma("unroll") for (int k = 0; k < 2; ++k) dst[m][k] = *(const LAS bf16x8*)(lds + PG8_SA(b, h) + aoff + m * 2048 + k * 1024); } while (0)
#define PG8_LDB(dst, b, h) do { _Pragma("unroll") for (int n = 0; n < 2; ++n) _Pragma("unroll") for (int k = 0; k < 2; ++k) dst[n][k] = *(const LAS bf16x8*)(lds + PG8_SB(b, h) + boff + n * 2048 + k * 1024); } while (0)
#define PG8_MMA(ai, bj, At, Bt) do { __builtin_amdgcn_s_setprio(1); _Pragma("unroll") for (int m = 0; m < 4; ++m) _Pragma("unroll") for (int n = 0; n < 2; ++n) _Pragma("unroll") for (int k = 0; k < 2; ++k) \
        acc[ai][bj][m][n] = __builtin_amdgcn_mfma_f32_16x16x32_bf16(Bt[n][k], At[m][k], acc[ai][bj][m][n], 0, 0, 0); __builtin_amdgcn_s_setprio(0); } while (0)
#define PG8_WAIT_V(n) asm volatile("s_waitcnt vmcnt(" #n ")" ::: "memory")
#define PG8_WAIT_L(n) asm volatile("s_waitcnt lgkmcnt(" #n ")" ::: "memory")
#define PG8_BAR __builtin_amdgcn_s_barrier()
#define PG8_SCHED __builtin_amdgcn_sched_barrier(0)
    Unit cur, nxt; int ui = 0;
    if (!S.next(0, cur)) return;
    f32x4 acc[2][2][4][2];
#pragma unroll
    for (int a = 0; a < 2; ++a)
#pragma unroll
        for (int b = 0; b < 2; ++b)
#pragma unroll
            for (int m = 0; m < 4; ++m)
#pragma unroll
                for (int n = 0; n < 2; ++n) acc[a][b][m][n] = (f32x4){0.f, 0.f, 0.f, 0.f};
    bf16x8 At[4][2], B0[2][2], B1[2][2];
    const char* cA = (const char*)g.A + (size_t)cur.z * g.zA + (size_t)cur.pm * tstepA; const char* cB = (const char*)g.Bt + (size_t)cur.z * g.zB + (size_t)cur.pn * tstepB;
    PG8_STAGE(PG8_SB(0, 0), cB, voffB); PG8_STAGE(PG8_SB(0, 1), cB + hstepB, voffB); PG8_STAGE(PG8_SA(0, 0), cA, voffA); PG8_STAGE(PG8_SA(0, 1), cA + hstepA, voffA);
    if (wr == 1) PG8_BAR;
    PG8_WAIT_V(2); PG8_BAR;
    PG8_STAGE(PG8_SB(1, 0), cB + kstep, voffB); PG8_STAGE(PG8_SA(1, 0), cA + kstep, voffA); PG8_STAGE(PG8_SB(1, 1), cB + hstepB + kstep, voffB);
    PG8_WAIT_V(6); PG8_BAR;
    for (;;) {
        const bool has_next = S.next(ui + 1, nxt);
        const char* nA = has_next ? (const char*)g.A + (size_t)nxt.z * g.zA + (size_t)nxt.pm * tstepA : cA;
        const char* nB = has_next ? (const char*)g.Bt + (size_t)nxt.z * g.zB + (size_t)nxt.pn * tstepB : cB;
        for (int t = 0; t < nt; t += 2) {
            const bool last = (t == nt - 2);
            const char* a1 = cA + (size_t)(t + 1) * kstep;
            const char* a2 = last ? nA : cA + (size_t)(t + 2) * kstep; const char* b2 = last ? nB : cB + (size_t)(t + 2) * kstep;
            const char* a3 = a2 + kstep; const char* b3 = b2 + kstep;
            PG8_LDB(B0, 0, 0); PG8_LDB(B1, 0, 1); PG8_SCHED; PG8_LDA(At, 0, 0); PG8_STAGE(PG8_SA(1, 1), a1 + hstepA, voffA);
            PG8_WAIT_V(8); PG8_WAIT_L(0); PG8_BAR; PG8_MMA(0, 0, At, B0); PG8_MMA(0, 1, At, B1); PG8_BAR; PG8_SCHED;
            PG8_LDA(At, 0, 1); PG8_STAGE(PG8_SB(0, 0), b2, voffB); PG8_STAGE(PG8_SB(0, 1), b2 + hstepB, voffB); PG8_STAGE(PG8_SA(0, 0), a2, voffA);
            PG8_WAIT_V(8); PG8_WAIT_L(0); PG8_BAR; PG8_MMA(1, 0, At, B0); PG8_MMA(1, 1, At, B1); PG8_BAR; PG8_SCHED;
            PG8_LDB(B0, 1, 0); PG8_LDB(B1, 1, 1); PG8_SCHED; PG8_LDA(At, 1, 0); PG8_STAGE(PG8_SA(0, 1), a2 + hstepA, voffA);
            PG8_WAIT_V(8); PG8_WAIT_L(0); PG8_BAR; PG8_MMA(0, 0, At, B0); PG8_MMA(0, 1, At, B1); PG8_BAR; PG8_SCHED;
            PG8_LDA(At, 1, 1); PG8_STAGE(PG8_SB(1, 0), b3, voffB); PG8_STAGE(PG8_SB(1, 1), b3 + hstepB, voffB); PG8_STAGE(PG8_SA(1, 0), a3, voffA);
            PG8_WAIT_V(8); PG8_WAIT_L(0); PG8_BAR; PG8_MMA(1, 0, At, B0); PG8_MMA(1, 1, At, B1); PG8_BAR; PG8_SCHED;
        }
        if constexpr (ALIGN_EPI) { if (wr == 0) PG8_BAR; }
        if constexpr (!Epi::AFTER_DRAIN) E(acc, cur, wr, wc, fr, fq);
        if (!has_next) break;
#pragma unroll
        for (int a = 0; a < 2; ++a)
#pragma unroll
            for (int b = 0; b < 2; ++b)
#pragma unroll
                for (int m = 0; m < 4; ++m)
#pragma unroll
                    for (int n = 0; n < 2; ++n) acc[a][b][m][n] = (f32x4){0.f, 0.f, 0.f, 0.f};
        cur = nxt; cA = nA; cB = nB; ++ui;
        if constexpr (ALIGN_EPI) { if (wr == 1) PG8_BAR; }
    }
    PG8_WAIT_V(0);
    if constexpr (!ALIGN_EPI) { if (wr == 0) PG8_BAR; }
    PG8_BAR;
    if constexpr (Epi::AFTER_DRAIN) E.fused(acc, cur, wr, wc, lds, wid);
#undef PG8_SA
#undef PG8_SB
#undef PG8_STAGE
#undef PG8_LDA
#undef PG8_LDB
#undef PG8_MMA
#undef PG8_WAIT_V
#undef PG8_WAIT_L
#undef PG8_BAR
#undef PG8_SCHED
}

#define EPI_FOR_ROWS _Pragma("unroll") for (int ai = 0; ai < 2; ++ai) _Pragma("unroll") for (int m = 0; m < 4; ++m)
#define EPI_ROWDEF const int rit = ai * HALF + wr * 64 + m * 16 + fr; const int row = u.pm * BM + rit; (void)rit; (void)row;

struct Epi1 {
    static constexpr bool AFTER_DRAIN = false;
    const float* rinv; const float* qnw; const float* knw; const float2* rope;
    bf16_t *Q, *Kb, *Vb, *GA, *GS, *UCAT; LAS float* xch; int pn0;
    __device__ __forceinline__ void operator()(const f32x4 (&acc)[2][2][4][2], const Unit& u, int wr, int wc, int, int) const {
        const int l_ = lane_id_opaque(), fr = l_ & 15, fq = l_ >> 4;
        const int pn = u.pn + pn0;
        if (pn <= 4) {
            float ss[2][4], rv[2][4];
            EPI_FOR_ROWS { EPI_ROWDEF const float r = rinv[row]; rv[ai][m] = r; float s = 0.f;
#pragma unroll
                for (int bj = 0; bj < 2; ++bj)
#pragma unroll
                    for (int n = 0; n < 2; ++n) { const f32x4 v = acc[ai][bj][m][n] * r; s += (v[0] * v[0] + v[1] * v[1]) + (v[2] * v[2] + v[3] * v[3]); }
                s += swz_xor<16>(s); s = sum_xor32(s); ss[ai][m] = s;
                if (fq == 0) xch[wc * 256 + rit] = s; }
            LDS_WAIT(); __builtin_amdgcn_s_barrier(); asm volatile("" ::: "memory");
            const int half = wc & 1, hd = wc >> 1;
            const float* nw = (pn < 4 ? qnw : knw) + 64 * half + 8 * fq;
            float w1[8], w2[8];
#pragma unroll
            for (int i = 0; i < 8; ++i) { w1[i] = nw[i]; w2[i] = nw[32 + i]; }
            EPI_FOR_ROWS { EPI_ROWDEF const float tot = ss[ai][m] + xch[(wc ^ 1) * 256 + rit];
                const float sc = rv[ai][m] * rsqrtf(tot * (1.f / 128.f) + EPS);
                const int t = row & (SEQ - 1); const int pos = half ? (t & 63) : (t >> 6);
                const float2* rp = rope + pos * 32 + 8 * fq;
                float o1[8], o2[8];
#pragma unroll
                for (int n = 0; n < 2; ++n)
#pragma unroll
                    for (int e = 0; e < 4; ++e) { const int i = 4 * n + e; const float2 cs = rp[i];
                        const float x1 = acc[ai][0][m][n][e] * sc * w1[i], x2 = acc[ai][1][m][n][e] * sc * w2[i];
                        o1[i] = x1 * cs.x - x2 * cs.y; o2[i] = x2 * cs.x + x1 * cs.y; }
                bf16_t* dst = (pn < 4) ? Q + (size_t)row * DATT + (2 * pn + hd) * 128 + 64 * half + 8 * fq : Kb + (size_t)row * DKV + hd * 128 + 64 * half + 8 * fq;
                u32x4 a; a.x = pk2(o1[0], o1[1]); a.y = pk2(o1[2], o1[3]); a.z = pk2(o1[4], o1[5]); a.w = pk2(o1[6], o1[7]);
                u32x4 b; b.x = pk2(o2[0], o2[1]); b.y = pk2(o2[2], o2[3]); b.z = pk2(o2[4], o2[5]); b.w = pk2(o2[6], o2[7]);
                *(u32x4*)dst = a; *(u32x4*)(dst + 32) = b; }
        } else {
            const int lg0 = 4 * (wc >> 1) + 2 * (wc & 1);
            EPI_FOR_ROWS { EPI_ROWDEF const float r = rinv[row];
#pragma unroll
                for (int bj = 0; bj < 2; ++bj) { const int L = 256 * pn + 32 * (lg0 + bj) + 8 * fq;
                    f32x4 v0 = acc[ai][bj][m][0] * r, v1 = acc[ai][bj][m][1] * r; bf16_t* dst;
                    if (pn == 5) dst = Vb + (size_t)row * DKV + (L - 1280);
                    else if (pn < 10) dst = GA + (size_t)row * DATT + (L - 1536);
                    else if (pn < 14) { const int Lu = L - 2560; dst = UCAT + ((size_t)(Lu >> 4) * NCH + (row >> 4)) * 512 + (row & 15) * 16 + (Lu & 15); }
                    else dst = GS + (size_t)row * DSSM + (L - 3584);
                    if ((pn >= 6 && pn < 10) || pn >= 14) {
#pragma unroll
                        for (int e = 0; e < 4; ++e) { v0[e] = siluf_(v0[e]); v1[e] = siluf_(v1[e]); } }
                    u32x4 w; w.x = pk2(v0[0], v0[1]); w.y = pk2(v0[2], v0[3]); w.z = pk2(v1[0], v1[1]); w.w = pk2(v1[2], v1[3]);
                    *(u32x4*)dst = w; } }
        }
    }
};
struct EpiS1 {
    static constexpr bool AFTER_DRAIN = true;
    const float* lb16; bf16_t* UCAT;
    __device__ __forceinline__ void operator()(const f32x4 (&)[2][2][4][2], const Unit&, int, int, int, int) const {}
    __device__ __forceinline__ void fused(const f32x4 (&acc)[2][2][4][2], const Unit& u, int wr, int wc, LAS unsigned char* lds, int wid) const {
        const int l_ = lane_id_opaque(), fr = l_ & 15, fq = l_ >> 4;
        LAS float* Tl = (LAS float*)lds;
#pragma unroll
        for (int d = 0; d < 2; ++d) {
            EPI_FOR_ROWS { const int rit = ai * HALF + wr * 64 + m * 16 + fr; LAS float* rp = Tl + rit * 128 + wc * 32 + 8 * fq;
                *(LAS f32x4*)rp = acc[ai][d][m][0]; *(LAS f32x4*)(rp + 4) = acc[ai][d][m][1]; }
            LDS_WAIT(); __builtin_amdgcn_s_barrier(); asm volatile("" ::: "memory");
            {
                const int p = l_; const float lr = lb16[((u.z * 2 + d) * 64 + p) * 2], li = lb16[((u.z * 2 + d) * 64 + p) * 2 + 1];
                LAS float* SEG = (LAS float*)(lds + XCH_OFF);
                float xr = 0.f, xi = 0.f;
#pragma unroll 8
                for (int i = 0; i < 32; ++i) { const int cc = wid * 32 + i, c = d ? 255 - cc : cc;
                    const float sr = Tl[c * 128 + p], si = Tl[c * 128 + 64 + p];
                    Tl[c * 128 + p] = xr; Tl[c * 128 + 64 + p] = xi;
                    const float nr = lr * xr - li * xi + sr; xi = lr * xi + li * xr + si; xr = nr; }
                SEG[(wid * 64 + p) * 2] = xr; SEG[(wid * 64 + p) * 2 + 1] = xi;
                LDS_WAIT(); __builtin_amdgcn_s_barrier(); asm volatile("" ::: "memory");
                float l32r = lr, l32i = li;
#pragma unroll
                for (int q = 0; q < 5; ++q) { const float t = l32r * l32r - l32i * l32i; l32i = 2.f * l32r * l32i; l32r = t; }
                float er = 0.f, ei = 0.f;
                for (int j = 0; j < wid; ++j) { const float tr = SEG[(j * 64 + p) * 2], ti = SEG[(j * 64 + p) * 2 + 1];
                    const float nr = l32r * er - l32i * ei + tr; ei = l32r * ei + l32i * er + ti; er = nr; }
#pragma unroll 8
                for (int i = 0; i < 32; ++i) { const int cc = wid * 32 + i, c = d ? 255 - cc : cc;
                    const float tr = Tl[c * 128 + p] + er, ti = Tl[c * 128 + 64 + p] + ei;
                    Tl[c * 128 + p] = __uint_as_float(pk2(tr, ti));
                    const float nr = lr * er - li * ei; ei = lr * ei + li * er; er = nr; }
            }
            LDS_WAIT(); __builtin_amdgcn_s_barrier(); asm volatile("" ::: "memory");
            {   bf16_t* ub = UCAT + ((size_t)u.z * NCH + u.pm * 256) * 512 + 256 + d * 128;
#pragma unroll
                for (int i = 0; i < 8; ++i) { const int q = wid * 64 + l_ + 512 * i, r = q >> 4, c8 = (q & 15) * 8;
                    *(u32x4*)(ub + (size_t)r * 512 + c8) = *(const LAS u32x4*)((LAS bf16_t*)(Tl + r * 128) + c8); } }
            LDS_WAIT(); __builtin_amdgcn_s_barrier(); asm volatile("" ::: "memory");
        }
    }
};
struct EpiS2 {
    static constexpr bool AFTER_DRAIN = false;
    bf16_t* YS;
    __device__ __forceinline__ void operator()(const f32x4 (&acc)[2][2][4][2], const Unit& u, int wr, int wc, int, int) const {
        const int l_ = lane_id_opaque(), fr = l_ & 15, fq = l_ >> 4;
        EPI_FOR_ROWS { EPI_ROWDEF
#pragma unroll
            for (int bj = 0; bj < 2; ++bj) { const int c = bj * HALF + wc * 32 + 8 * fq; const int j = c >> 4, h0 = c & 15;
                const f32x4 v0 = acc[ai][bj][m][0], v1 = acc[ai][bj][m][1];
                u32x4 w; w.x = pk2(gelu_tanh(v0[0]), gelu_tanh(v0[1])); w.y = pk2(gelu_tanh(v0[2]), gelu_tanh(v0[3])); w.z = pk2(gelu_tanh(v1[0]), gelu_tanh(v1[1])); w.w = pk2(gelu_tanh(v1[2]), gelu_tanh(v1[3]));
                *(u32x4*)(YS + ((size_t)row * 16 + j) * DSSM + u.z * 16 + h0) = w; } }
    }
};
struct EpiGlu {
    static constexpr bool AFTER_DRAIN = false;
    const float* bglu; const bf16_t* GS; bf16_t* YMIX;
    __device__ __forceinline__ void operator()(const f32x4 (&acc)[2][2][4][2], const Unit& u, int wr, int wc, int, int) const {
        const int l_ = lane_id_opaque(), fr = l_ & 15, fq = l_ >> 4;
        const int a0 = 128 * u.pn + 32 * wc + 8 * fq;
        float bv[8], bg[8];
#pragma unroll
        for (int i = 0; i < 8; ++i) { bv[i] = bglu[a0 + i]; bg[i] = bglu[1024 + a0 + i]; }
        u32x4 gsv[2][4];
        EPI_FOR_ROWS { EPI_ROWDEF gsv[ai][m] = __builtin_nontemporal_load((const u32x4*)(GS + (size_t)row * DSSM + a0)); }
        EPI_FOR_ROWS { EPI_ROWDEF const u32x4 gs = gsv[ai][m];
            float o[8];
#pragma unroll
            for (int n = 0; n < 2; ++n)
#pragma unroll
                for (int e = 0; e < 4; ++e) { const int i = 4 * n + e; o[i] = (acc[ai][0][m][n][e] + bv[i]) * sigmoidf_(acc[ai][1][m][n][e] + bg[i]); }
            o[0] *= bflo(gs.x); o[1] *= bfhi(gs.x); o[2] *= bflo(gs.y); o[3] *= bfhi(gs.y); o[4] *= bflo(gs.z); o[5] *= bfhi(gs.z); o[6] *= bflo(gs.w); o[7] *= bfhi(gs.w);
            u32x4 w; w.x = pk2(o[0], o[1]); w.y = pk2(o[2], o[3]); w.z = pk2(o[4], o[5]); w.w = pk2(o[6], o[7]);
            *(u32x4*)(YMIX + (size_t)row * DM + 1024 + a0) = w; }
    }
};
struct EpiBf {
    static constexpr bool AFTER_DRAIN = false;
    bf16_t* O; int ldc;
    __device__ __forceinline__ void operator()(const f32x4 (&acc)[2][2][4][2], const Unit& u, int wr, int wc, int, int) const {
        const int l_ = lane_id_opaque(), fr = l_ & 15, fq = l_ >> 4;
        EPI_FOR_ROWS { EPI_ROWDEF
#pragma unroll
            for (int bj = 0; bj < 2; ++bj) { const f32x4 v0 = acc[ai][bj][m][0], v1 = acc[ai][bj][m][1];
                u32x4 w; w.x = pk2(v0[0], v0[1]); w.y = pk2(v0[2], v0[3]); w.z = pk2(v1[0], v1[1]); w.w = pk2(v1[2], v1[3]);
                *(u32x4*)(O + (size_t)row * ldc + u.pn * BM + bj * HALF + wc * 32 + 8 * fq) = w; } }
    }
};
struct EpiOut {
    static constexpr bool AFTER_DRAIN = false;
    const float* x; float* H; bf16_t* HB; float* ssq;
    __device__ __forceinline__ void operator()(const f32x4 (&acc)[2][2][4][2], const Unit& u, int wr, int wc, int, int) const {
        const int l_ = lane_id_opaque(), fr = l_ & 15, fq = l_ >> 4;
#pragma unroll
        for (int ai = 0; ai < 2; ++ai) {
            f32x4 xv[4][2][2];
#pragma unroll
            for (int m = 0; m < 4; ++m) { EPI_ROWDEF
#pragma unroll
                for (int bj = 0; bj < 2; ++bj) { const size_t off = (size_t)row * DM + u.pn * BM + bj * HALF + wc * 32 + 8 * fq; xv[m][bj][0] = __builtin_nontemporal_load((const f32x4*)(x + off)); xv[m][bj][1] = __builtin_nontemporal_load((const f32x4*)(x + off + 4)); } }
#pragma unroll
            for (int m = 0; m < 4; ++m) { EPI_ROWDEF float s = 0.f;
#pragma unroll
                for (int bj = 0; bj < 2; ++bj) { const size_t off = (size_t)row * DM + u.pn * BM + bj * HALF + wc * 32 + 8 * fq;
                    const f32x4 v0 = acc[ai][bj][m][0] + xv[m][bj][0], v1 = acc[ai][bj][m][1] + xv[m][bj][1];
                    s += (v0[0] * v0[0] + v0[1] * v0[1]) + (v0[2] * v0[2] + v0[3] * v0[3]) + (v1[0] * v1[0] + v1[1] * v1[1]) + (v1[2] * v1[2] + v1[3] * v1[3]);
                    u32x4 w; w.x = pk2(v0[0], v0[1]); w.y = pk2(v0[2], v0[3]); w.z = pk2(v1[0], v1[1]); w.w = pk2(v1[2], v1[3]);
                    *(u32x4*)(HB + off) = w; }
                s += swz_xor<16>(s); s = sum_xor32(s);
                if (fq == 0) ssq[(size_t)row * 32 + u.pn * 4 + wc] = s; }
        }
    }
};
struct EpiGate {
    static constexpr bool AFTER_DRAIN = true;
    float* H; const bf16_t* PP; float* ssq; unsigned* cnt; const float* nf; const LAS float* r2; const bf16_t* HBr;
    __device__ __forceinline__ void operator()(const f32x4 (&)[2][2][4][2], const Unit&, int, int, int, int) const {}
    __device__ __forceinline__ void fused(f32x4 (&acc)[2][2][4][2], const Unit& u, int wr, int wc, LAS unsigned char* lds, int wid) const {
        const int l_ = lane_id_opaque(), fr = l_ & 15, fq = l_ >> 4, tid = wid * 64 + l_;
        LAS float* P = (LAS float*)lds; LAS float* Rn = P + 1024;
        EPI_FOR_ROWS { EPI_ROWDEF float s = 0.f; const float r = r2[rit];
#pragma unroll
            for (int bj = 0; bj < 2; ++bj) { const size_t off = (size_t)row * DM + u.pn * BM + bj * HALF + wc * 32 + 8 * fq;
                const u32x4 pp = __builtin_nontemporal_load((const u32x4*)(PP + off));
                const u32x4 hb = __builtin_nontemporal_load((const u32x4*)(HBr + off));
                f32x4 h0 = {bflo(hb.x), bfhi(hb.x), bflo(hb.y), bfhi(hb.y)}, h1 = {bflo(hb.z), bfhi(hb.z), bflo(hb.w), bfhi(hb.w)};
                const f32x4 a0 = acc[ai][bj][m][0] * r, a1 = acc[ai][bj][m][1] * r;
                h0[0] += sigmoidf_(a0[0]) * bflo(pp.x); h0[1] += sigmoidf_(a0[1]) * bfhi(pp.x); h0[2] += sigmoidf_(a0[2]) * bflo(pp.y); h0[3] += sigmoidf_(a0[3]) * bfhi(pp.y);
                h1[0] += sigmoidf_(a1[0]) * bflo(pp.z); h1[1] += sigmoidf_(a1[1]) * bfhi(pp.z); h1[2] += sigmoidf_(a1[2]) * bflo(pp.w); h1[3] += sigmoidf_(a1[3]) * bfhi(pp.w);
                acc[ai][bj][m][0] = h0; acc[ai][bj][m][1] = h1;
                s += (h0[0] * h0[0] + h0[1] * h0[1]) + (h0[2] * h0[2] + h0[3] * h0[3]) + (h1[0] * h1[0] + h1[1] * h1[1]) + (h1[2] * h1[2] + h1[3] * h1[3]); }
            s += swz_xor<16>(s); s = sum_xor32(s);
            if (fq == 0) P[rit * 4 + wc] = s; }
        LDS_WAIT(); __builtin_amdgcn_s_barrier(); asm volatile("" ::: "memory");
        if (tid < 256) { const float t = (P[tid * 4] + P[tid * 4 + 1]) + (P[tid * 4 + 2] + P[tid * 4 + 3]);
            __hip_atomic_store(ssq + (size_t)(u.pm * 256 + tid) * 8 + u.pn, t, __ATOMIC_RELAXED, __HIP_MEMORY_SCOPE_AGENT); }
        asm volatile("s_waitcnt vmcnt(0)" ::: "memory");
        if (wid < 4 && l_ == 0) __hip_atomic_fetch_add(cnt + 64 * u.pm, 1u, __ATOMIC_RELAXED, __HIP_MEMORY_SCOPE_AGENT);
        if (wid == 0) {
            unsigned sp = 0;
            while ((unsigned)__builtin_amdgcn_readfirstlane(__hip_atomic_load(cnt + 64 * u.pm, __ATOMIC_RELAXED, __HIP_MEMORY_SCOPE_AGENT)) < 32u) { __builtin_amdgcn_s_sleep(2); if (++sp > (1u << 22)) break; }
            __builtin_amdgcn_fence(__ATOMIC_ACQUIRE, "agent");
        }
        asm volatile("s_waitcnt vmcnt(0) lgkmcnt(0)" ::: "memory"); __builtin_amdgcn_s_barrier(); asm volatile("" ::: "memory");
        if (tid < 256) { const float* sp = ssq + (size_t)(u.pm * 256 + tid) * 8; float t = 0.f;
#pragma unroll
            for (int i = 0; i < 8; ++i) t += __hip_atomic_load(sp + i, __ATOMIC_RELAXED, __HIP_MEMORY_SCOPE_AGENT);
            Rn[tid] = rsqrtf(t * (1.f / DM) + EPS); }
        LDS_WAIT(); __builtin_amdgcn_s_barrier(); asm volatile("" ::: "memory");
        EPI_FOR_ROWS { EPI_ROWDEF const float rn = Rn[rit];
#pragma unroll
            for (int bj = 0; bj < 2; ++bj) { const int col = u.pn * BM + bj * HALF + wc * 32 + 8 * fq; const size_t off = (size_t)row * DM + col;
                *(f32x4*)(H + off) = acc[ai][bj][m][0] * rn * *(const f32x4*)(nf + col); *(f32x4*)(H + off + 4) = acc[ai][bj][m][1] * rn * *(const f32x4*)(nf + col + 4); } }
    }
};
}

namespace att {
constexpr int D = 128, NW = 8, QBLK = 32, KVBLK = 64;
constexpr float SCALE = 0.088388347648318440f;
constexpr float THR = 8.f;
constexpr int LDQ = DATT, LDK = DKV;
constexpr size_t SHM_V = KVBLK * D * 2, SHM_K = KVBLK * D * 2, SHM_ATTN = 2 * SHM_V + 2 * SHM_K + NW * 64 * 4;
#define KSWZ(row, colB) ((row) * 256 + ((colB) ^ (((row) & 7) << 4)))
#define SBAR() __builtin_amdgcn_sched_barrier(0)
__device__ __forceinline__ int crow(int r, int hi) { return (r & 3) + 8 * (r >> 2) + 4 * hi; }
__device__ __forceinline__ void partialSM(f32x16& p0, f32x16& p1, float& m_reg, float& mn, float& alpha) {
  constexpr float C = SCALE * 1.4426950408889634f;
  float pmax = p0[0]; for (int r = 1; r < 16; ++r) pmax = fmaxf(pmax, p0[r]); for (int r = 0; r < 16; ++r) pmax = fmaxf(pmax, p1[r]);
  { auto rr = __builtin_amdgcn_permlane32_swap(__float_as_uint(pmax), __float_as_uint(pmax), false, false);
    pmax = fmaxf(__uint_as_float(rr[0]), __uint_as_float(rr[1])); }
  if (__builtin_expect(__all(pmax - m_reg <= THR / SCALE), 1)) { mn = m_reg; alpha = 1.f; }
  else { mn = fmaxf(m_reg, pmax); alpha = __builtin_amdgcn_exp2f((m_reg - mn) * C); m_reg = mn; }
  float mnC = -mn * C;
  for (int r = 0; r < 16; ++r) p0[r] = fmaf(p0[r], C, mnC); for (int r = 0; r < 16; ++r) p1[r] = fmaf(p1[r], C, mnC);
  for (int r = 0; r < 16; ++r) p0[r] = __builtin_amdgcn_exp2f(p0[r]);
}
__device__ __forceinline__ void finishSM(f32x16& p0, f32x16& p1, float alpha, float& l_reg, bf16x8& pa0, bf16x8& pa1, bf16x8& pa2, bf16x8& pa3) {
  for (int r = 0; r < 16; ++r) p1[r] = __builtin_amdgcn_exp2f(p1[r]);
  float ps = 0; for (int r = 0; r < 16; ++r) ps += p0[r]; for (int r = 0; r < 16; ++r) ps += p1[r];
  { auto rr = __builtin_amdgcn_permlane32_swap(__float_as_uint(ps), __float_as_uint(ps), false, false);
    ps = __uint_as_float(rr[0]) + __uint_as_float(rr[1]); }
  l_reg = l_reg * alpha + ps;
#define PK4(P, BASE, OUT) do { unsigned a0 = cvt_pk_bf16(P[BASE + 0], P[BASE + 1]), a1 = cvt_pk_bf16(P[BASE + 2], P[BASE + 3]);   \
    unsigned b0 = cvt_pk_bf16(P[BASE + 4], P[BASE + 5]), b1 = cvt_pk_bf16(P[BASE + 6], P[BASE + 7]);                              \
    auto r0 = __builtin_amdgcn_permlane32_swap(a0, b0, false, false); auto r1 = __builtin_amdgcn_permlane32_swap(a1, b1, false, false); \
    u32x4 w = {r0[0], r1[0], r0[1], r1[1]}; OUT = *reinterpret_cast<bf16x8*>(&w); } while (0)
  PK4(p0, 0, pa0); PK4(p0, 8, pa1); PK4(p1, 0, pa2); PK4(p1, 8, pa3);
#undef PK4
}
__device__ __forceinline__ void qkt(f32x16& p0, f32x16& p1, const bf16_t* Ks, const bf16x8* qr, int r32, int hi) {
  p0 = f32x16{}; p1 = f32x16{};
  for (int d0 = 0; d0 < 8; ++d0) { int cb = (d0 * 16 + hi * 8) * 2;
    bf16x8 b0 = *reinterpret_cast<const bf16x8*>((const char*)Ks + KSWZ(r32, cb));
    bf16x8 b1 = *reinterpret_cast<const bf16x8*>((const char*)Ks + KSWZ(32 + r32, cb));
    p0 = __builtin_amdgcn_mfma_f32_32x32x16_bf16(b0, qr[d0], p0, 0, 0, 0);
    p1 = __builtin_amdgcn_mfma_f32_32x32x16_bf16(b1, qr[d0], p1, 0, 0, 0); }
}
__device__ __forceinline__ int v_st(int k, int c) { const int kk = (k & ~0xC) | ((k & 4) << 1) | ((k & 8) >> 1); return ((kk >> 3) * 4 + (c >> 5)) * 512 + ((kk & 7) * 32 + (c & 31)) * 2; }
__device__ __forceinline__ int v_rd_base(int lane) { return ((lane & 3) << 3) | (((lane >> 2) & 3) << 6) | (((lane >> 4) & 1) << 5) | (((lane >> 5) & 1) << 8); }
constexpr int v_rd_off(int d0, int ks, int half) { return d0 * 512 + ks * 4096 + half * 2048; }
template <int OFF> __device__ __forceinline__ s16x4 tr_read(int vb) {
  s16x4 r; asm volatile("ds_read_b64_tr_b16 %0, %1 offset:%2" : "=&v"(r) : "v"(vb), "i"(OFF) : "memory"); return r;
}
template <int D0> __device__ __forceinline__ void pv_one(f32x16& od, int vb, bf16x8 pa0, bf16x8 pa1, bf16x8 pa2, bf16x8 pa3) {
  const s16x4 l0 = tr_read<v_rd_off(D0, 0, 0)>(vb), h0 = tr_read<v_rd_off(D0, 0, 1)>(vb), l1 = tr_read<v_rd_off(D0, 1, 0)>(vb), h1 = tr_read<v_rd_off(D0, 1, 1)>(vb);
  const s16x4 l2 = tr_read<v_rd_off(D0, 2, 0)>(vb), h2 = tr_read<v_rd_off(D0, 2, 1)>(vb), l3 = tr_read<v_rd_off(D0, 3, 0)>(vb), h3 = tr_read<v_rd_off(D0, 3, 1)>(vb);
  asm volatile("s_waitcnt lgkmcnt(0)" ::: "memory"); SBAR();
#define PK(L, H) (bf16x8){L[0], L[1], L[2], L[3], H[0], H[1], H[2], H[3]}
  od = __builtin_amdgcn_mfma_f32_32x32x16_bf16(pa0, PK(l0, h0), od, 0, 0, 0);
  od = __builtin_amdgcn_mfma_f32_32x32x16_bf16(pa1, PK(l1, h1), od, 0, 0, 0);
  od = __builtin_amdgcn_mfma_f32_32x32x16_bf16(pa2, PK(l2, h2), od, 0, 0, 0);
  od = __builtin_amdgcn_mfma_f32_32x32x16_bf16(pa3, PK(l3, h3), od, 0, 0, 0);
#undef PK
}
__device__ __forceinline__ void pv_d0(f32x16* o, int vb, bf16x8 pa0, bf16x8 pa1, bf16x8 pa2, bf16x8 pa3) {
  pv_one<0>(o[0], vb, pa0, pa1, pa2, pa3); pv_one<1>(o[1], vb, pa0, pa1, pa2, pa3); pv_one<2>(o[2], vb, pa0, pa1, pa2, pa3); pv_one<3>(o[3], vb, pa0, pa1, pa2, pa3);
}
__device__ __forceinline__ void attn_dense_body(const bf16_t* __restrict__ Qb, const bf16_t* __restrict__ Kh, const bf16_t* __restrict__ Vh,
                                                const bf16_t* __restrict__ Gb, bf16_t* __restrict__ Yb, int seq, char* lds, const int wid) {
  const int lane = lane_id_opaque(), tid = wid * 64 + lane, r32 = lane & 31, hi = lane >> 5;
  bf16_t* V_lds = (bf16_t*)lds; bf16_t* K_lds = (bf16_t*)(lds + 2 * SHM_V);
  float* ws = (float*)(lds + 2 * SHM_V + 2 * SHM_K) + wid * 64; float* li_l = ws; float* al_l = ws + 32;
  float m_reg = -1e30f, l_reg = 0; f32x16 o[4] = {}; bf16x8 qr[8];
  const bf16_t* Qw = Qb + (long)(wid * QBLK + r32) * LDQ + hi * 8;
#pragma unroll
  for (int d0 = 0; d0 < 8; ++d0) qr[d0] = __builtin_nontemporal_load(reinterpret_cast<const bf16x8*>(Qw + d0 * 16));
  const int sr = tid >> 4, sc = (tid & 15) * 8, vst0 = v_st(sr, sc), vst1 = v_st(32 + sr, sc);
  const int vb0 = (int)(uintptr_t)V_lds + v_rd_base(lane);
  struct { bf16x8 vs0, vs1, ks0, ks1; } sr_[2];
#define SLOAD(i, k0) do { sr_[i].vs0 = *reinterpret_cast<const bf16x8*>(&Vh[(long)((k0) + sr) * LDK + sc]); sr_[i].vs1 = *reinterpret_cast<const bf16x8*>(&Vh[(long)((k0) + 32 + sr) * LDK + sc]); \
    sr_[i].ks0 = *reinterpret_cast<const bf16x8*>(&Kh[(long)((k0) + sr) * LDK + sc]); sr_[i].ks1 = *reinterpret_cast<const bf16x8*>(&Kh[(long)((k0) + 32 + sr) * LDK + sc]); } while (0)
#define SWRITE(b, i) do { *(bf16x8*)((char*)V_lds + (b) * SHM_V + vst0) = sr_[i].vs0;          \
    *(bf16x8*)((char*)V_lds + (b) * SHM_V + vst1) = sr_[i].vs1; int kc = sc * 2;               \
    *(bf16x8*)((char*)K_lds + (b) * SHM_K + KSWZ(sr, kc)) = sr_[i].ks0;                       \
    *(bf16x8*)((char*)K_lds + (b) * SHM_K + KSWZ(32 + sr, kc)) = sr_[i].ks1; } while (0)
#define SWAIT() asm volatile("s_waitcnt vmcnt(4)" ::: "memory")
#define RESC(a) do { if (__any((a) < 1.f)) { if (hi == 0) al_l[r32] = (a); asm volatile("s_waitcnt lgkmcnt(0)" ::: "memory"); \
    for (int d = 0; d < 4; ++d) for (int r = 0; r < 16; ++r) o[d][r] *= al_l[crow(r, hi)]; } } while (0)
  f32x16 pA0, pA1, pB0, pB1; float mnA, mnB, alA, alB; bf16x8 pa0, pa1, pa2, pa3; const int NT = seq / KVBLK;
  constexpr int SE = 0, SO = 1;
  SLOAD(SE, 0); asm volatile("s_waitcnt vmcnt(0)" ::: "memory"); SWRITE(0, SE); __syncthreads();
  qkt(pA0, pA1, K_lds, qr, r32, hi); partialSM(pA0, pA1, m_reg, mnA, alA);
  SLOAD(SO, KVBLK); if (2 < NT) SLOAD(SE, 2 * KVBLK);
  SWAIT(); SWRITE(1, SO); __syncthreads();
  for (int j = 1; j + 1 < NT; j += 2) {
    SBAR(); qkt(pB0, pB1, (bf16_t*)((char*)K_lds + SHM_K), qr, r32, hi);
    finishSM(pA0, pA1, alA, l_reg, pa0, pa1, pa2, pa3); SBAR();
    SLOAD(SO, (j + 2) * KVBLK); SBAR();
    pv_d0(o, vb0, pa0, pa1, pa2, pa3); partialSM(pB0, pB1, m_reg, mnB, alB);
    __syncthreads(); SWAIT(); SWRITE(0, SE);
    RESC(alB); __syncthreads();
    SBAR(); qkt(pA0, pA1, K_lds, qr, r32, hi);
    finishSM(pB0, pB1, alB, l_reg, pa0, pa1, pa2, pa3); SBAR();
    if (j + 3 < NT) SLOAD(SE, (j + 3) * KVBLK); SBAR();
    pv_d0(o, vb0 + (int)SHM_V, pa0, pa1, pa2, pa3); partialSM(pA0, pA1, m_reg, mnA, alA);
    __syncthreads(); SWAIT(); SWRITE(1, SO);
    RESC(alA); __syncthreads();
  }
  SBAR(); qkt(pB0, pB1, (bf16_t*)((char*)K_lds + SHM_K), qr, r32, hi);
  finishSM(pA0, pA1, alA, l_reg, pa0, pa1, pa2, pa3); SBAR();
  pv_d0(o, vb0, pa0, pa1, pa2, pa3); partialSM(pB0, pB1, m_reg, mnB, alB);
  __syncthreads(); RESC(alB);
  finishSM(pB0, pB1, alB, l_reg, pa0, pa1, pa2, pa3); SBAR();
  pv_d0(o, vb0 + (int)SHM_V, pa0, pa1, pa2, pa3);
  if (hi == 0) li_l[r32] = l_reg; asm volatile("s_waitcnt lgkmcnt(0)" ::: "memory");
  float rli[16];
#pragma unroll
  for (int r = 0; r < 16; ++r) rli[r] = __builtin_amdgcn_rcpf(li_l[crow(r, hi)]);
  bf16_t* Yw = Yb + (long)(wid * QBLK) * DM; const bf16_t* Gw = Gb + (long)(wid * QBLK) * DATT;
  __syncthreads();
  bf16_t* stg = (bf16_t*)(lds + wid * 8192);
#pragma unroll
  for (int r = 0; r < 16; ++r) { const int orow = crow(r, hi);
#pragma unroll
    for (int d0 = 0; d0 < 4; ++d0) stg[orow * 128 + d0 * 32 + r32] = (bf16_t)f2bf(o[d0][r] * rli[r]); }
  asm volatile("s_waitcnt lgkmcnt(0)" ::: "memory");
  const int l2 = lane_id_opaque();
#pragma unroll
  for (int i = 0; i < 8; ++i) { const int q = l2 + 64 * i, row = q >> 4, c8 = (q & 15) * 8;
    const u32x4 v = *(const u32x4*)(stg + row * 128 + c8); const u32x4 gg = __builtin_nontemporal_load((const u32x4*)(Gw + (unsigned)(row * DATT + c8)));
    u32x4 w; w.x = pk2(bflo(v.x) * bflo(gg.x), bfhi(v.x) * bfhi(gg.x)); w.y = pk2(bflo(v.y) * bflo(gg.y), bfhi(v.y) * bfhi(gg.y));
    w.z = pk2(bflo(v.z) * bflo(gg.z), bfhi(v.z) * bfhi(gg.z)); w.w = pk2(bflo(v.w) * bflo(gg.w), bfhi(v.w) * bfhi(gg.w));
    *(u32x4*)(Yw + (unsigned)(row * DM + c8)) = w; }
  __syncthreads();
#undef SLOAD
#undef SWRITE
#undef SWAIT
#undef RESC
}
#undef SBAR
}

__device__ __forceinline__ void p0_transpose_item(const float* W, int K, int N, bf16_t* WT, int wt_row0, const float* kscale, LAS float* scr, int k0, int n0, int lane) {
#pragma unroll
    for (int i = 0; i < 32; ++i) { const int kk = 2 * i + (lane >> 5); float v = W[(size_t)(k0 + kk) * N + n0 + (lane & 31)]; if (kscale) v *= kscale[k0 + kk]; scr[kk * 33 + (lane & 31)] = v; }
    LDS_WAIT(); asm volatile("" ::: "memory");
    const int c = lane & 7;
#pragma unroll
    for (int j = 0; j < 4; ++j) { const int n = (lane >> 3) + 8 * j; const LAS float* s = scr + (8 * c) * 33 + n;
        u32x4 o; o.x = pk2(s[0 * 33], s[1 * 33]); o.y = pk2(s[2 * 33], s[3 * 33]); o.z = pk2(s[4 * 33], s[5 * 33]); o.w = pk2(s[6 * 33], s[7 * 33]);
        *(u32x4*)(WT + (size_t)(wt_row0 + n) * K + k0 + 8 * c) = o; }
    LDS_WAIT(); asm volatile("" ::: "memory");
}

struct TrItem { const float* W; bf16_t* WT; const float* kscale; int K, N, wt_row0, k0, n0; };
__device__ __forceinline__ void p0_tr_load(const TrItem& d, float (&v)[32], int lane) {
#pragma unroll
    for (int i = 0; i < 32; ++i) { const int kk = 2 * i + (lane >> 5); v[i] = __builtin_nontemporal_load(d.W + (size_t)(d.k0 + kk) * d.N + d.n0 + (lane & 31)); }
    if (d.kscale) {
#pragma unroll
        for (int i = 0; i < 32; ++i) { const int kk = 2 * i + (lane >> 5); v[i] *= d.kscale[d.k0 + kk]; } }
}
__device__ __forceinline__ void p0_tr_store(const TrItem& d, const float (&v)[32], LAS float* scr, int lane) {
#pragma unroll
    for (int i = 0; i < 32; ++i) { const int kk = 2 * i + (lane >> 5); scr[kk * 33 + (lane & 31)] = v[i]; }
    LDS_WAIT(); asm volatile("" ::: "memory");
    const int c = lane & 7;
#pragma unroll
    for (int j = 0; j < 4; ++j) { const int n = (lane >> 3) + 8 * j; const LAS float* s = scr + (8 * c) * 33 + n;
        u32x4 o; o.x = pk2(s[0 * 33], s[1 * 33]); o.y = pk2(s[2 * 33], s[3 * 33]); o.z = pk2(s[4 * 33], s[5 * 33]); o.w = pk2(s[6 * 33], s[7 * 33]);
        *(u32x4*)(d.WT + (size_t)(d.wt_row0 + n) * d.K + d.k0 + 8 * c) = o; }
    LDS_WAIT(); asm volatile("" ::: "memory");
}
__device__ __forceinline__ void ssm_tables(const Args& a, int g, LAS unsigned char* lds, int tid) {
    LAS float* LD = (LAS float*)lds;
    LAS float* LBs = LD + 256;
    LAS float* BB = LBs + 256;
    LAS float* KT = BB + 4096;
    LAS float* CC = KT + 8192;
    float* lb16 = (float*)(a.ws + WS_LB16);
    bf16_t* WIN = (bf16_t*)(a.ws + WS_WIN) + (size_t)g * 256 * 256;
    bf16_t* WBIG = (bf16_t*)(a.ws + WS_WBIG) + (size_t)g * 256 * 512;
    for (int e = tid; e < 2048; e += 512) { const int d = e >> 10, r = e & 1023; const size_t ci_ = (size_t)(d * NG + g) * 1024 + r; CC[e * 2] = a.c_re[ci_]; CC[e * 2 + 1] = a.c_im[ci_]; }
    if (tid < 128) {
        const int d = tid >> 6, p = tid & 63; const int idx = (d * NG + g) * 64 + p;
        const float lr = fminf(a.a_re[idx], -1e-4f), li = a.a_im[idx];
        const float dt = expf(a.log_dt[d * NG + g]);
        const float er = expf(lr * dt); float sn, cs; sincosf(li * dt, &sn, &cs);
        const float br = er * cs, bi = er * sn;
        LD[tid * 2] = lr * dt; LD[tid * 2 + 1] = li * dt; LBs[tid * 2] = br; LBs[tid * 2 + 1] = bi;
        const float nr = br - 1.f, ni = bi, den = lr * lr + li * li;
        KT[tid * 2] = (nr * lr + ni * li) / den; KT[tid * 2 + 1] = (ni * lr - nr * li) / den;
        const float e16 = expf(16.f * lr * dt); float s16, c16; sincosf(16.f * li * dt, &s16, &c16);
        lb16[(g * 128 + tid) * 2] = e16 * c16; lb16[(g * 128 + tid) * 2 + 1] = e16 * s16;
    }
    __syncthreads();
    for (int e = tid; e < 2048; e += 512) {
        const int dp = e >> 4, h = e & 15, d = dp >> 6, p = dp & 63;
        const size_t bi_ = ((size_t)(d * NG + g) * 64 + p) * 16 + h;
        const float xr = a.b_re[bi_], xi = a.b_im[bi_], cr = KT[dp * 2], ci = KT[dp * 2 + 1];
        BB[e * 2] = cr * xr - ci * xi; BB[e * 2 + 1] = cr * xi + ci * xr;
    }
    __syncthreads();
    {
        const int d = tid >> 8, hp = (tid >> 4) & 15, h = tid & 15; float acc[16];
#pragma unroll
        for (int t = 0; t < 16; ++t) acc[t] = 0.f;
        const LAS float* cc = CC + ((d * 16 + hp) * 64) * 2;
        for (int p = 0; p < 64; ++p) {
            const float c_r = cc[p * 2], c_i = cc[p * 2 + 1], b_r = BB[((d * 64 + p) * 16 + h) * 2], b_i = BB[((d * 64 + p) * 16 + h) * 2 + 1];
            float wr = c_r * b_r - c_i * b_i, wi = c_r * b_i + c_i * b_r; const float l_r = LBs[(d * 64 + p) * 2], l_i = LBs[(d * 64 + p) * 2 + 1];
#pragma unroll
            for (int t = 0; t < 16; ++t) { acc[t] += wr; const float nr = wr * l_r - wi * l_i; wi = wr * l_i + wi * l_r; wr = nr; }
        }
#pragma unroll
        for (int t = 0; t < 16; ++t) KT[((d * 16 + t) * 16 + hp) * 16 + h] = acc[t];
    }
    __syncthreads();
    for (int q = tid; q < 8192; q += 512) {
        const int n = q >> 5, kc = q & 31, s = kc >> 1, h0 = (kc & 1) * 8, j = n >> 4, hp = n & 15;
        float v[8];
#pragma unroll
        for (int e = 0; e < 8; ++e) { const int h = h0 + e;
            if (s < j) v[e] = KT[((0 * 16 + (j - s)) * 16 + hp) * 16 + h];
            else if (s > j) v[e] = KT[((1 * 16 + (s - j)) * 16 + hp) * 16 + h];
            else v[e] = KT[((0 * 16 + 0) * 16 + hp) * 16 + h] + KT[((1 * 16 + 0) * 16 + hp) * 16 + h] + (h == hp ? a.ssm_d[g * 16 + h] : 0.f); }
        u32x4 w; w.x = pk2(v[0], v[1]); w.y = pk2(v[2], v[3]); w.z = pk2(v[4], v[5]); w.w = pk2(v[6], v[7]);
        *(u32x4*)(WBIG + (size_t)n * 512 + s * 16 + h0) = w;
    }
    for (int q = tid; q < 2048; q += 512) {
        const int p = q & 63, js = (q >> 6) & 15, d = q >> 10; const float ldr = LD[(d * 64 + p) * 2], ldi = LD[(d * 64 + p) * 2 + 1];
        {   const float pw = (float)(d == 0 ? js + 1 : 16 - js); const float er = expf(pw * ldr); float sn, cs; sincosf(pw * ldi, &sn, &cs); const float pr = er * cs, pi = er * sn;
#pragma unroll
            for (int hp = 0; hp < 16; ++hp) { const float c_r = CC[((d * 16 + hp) * 64 + p) * 2], c_i = CC[((d * 16 + hp) * 64 + p) * 2 + 1];
                *(unsigned*)(WBIG + (size_t)(js * 16 + hp) * 512 + 256 + d * 128 + 2 * p) = pk2(c_r * pr - c_i * pi, -(c_r * pi + c_i * pr)); } }
        {   const float pw = (float)(d == 0 ? 15 - js : js); const float er = expf(pw * ldr); float sn, cs; sincosf(pw * ldi, &sn, &cs); const float pr = er * cs, pi = er * sn;
            float zr[16], zi[16];
#pragma unroll
            for (int h = 0; h < 16; ++h) { const float b_r = BB[((d * 64 + p) * 16 + h) * 2], b_i = BB[((d * 64 + p) * 16 + h) * 2 + 1]; zr[h] = pr * b_r - pi * b_i; zi[h] = pr * b_i + pi * b_r; }
            bf16_t* d0 = WIN + (size_t)(d * 128 + p) * 256 + js * 16; bf16_t* d1 = d0 + (size_t)64 * 256;
            u32x4 w; w.x = pk2(zr[0], zr[1]); w.y = pk2(zr[2], zr[3]); w.z = pk2(zr[4], zr[5]); w.w = pk2(zr[6], zr[7]); *(u32x4*)d0 = w;
            w.x = pk2(zr[8], zr[9]); w.y = pk2(zr[10], zr[11]); w.z = pk2(zr[12], zr[13]); w.w = pk2(zr[14], zr[15]); *(u32x4*)(d0 + 8) = w;
            w.x = pk2(zi[0], zi[1]); w.y = pk2(zi[2], zi[3]); w.z = pk2(zi[4], zi[5]); w.w = pk2(zi[6], zi[7]); *(u32x4*)d1 = w;
            w.x = pk2(zi[8], zi[9]); w.y = pk2(zi[10], zi[11]); w.z = pk2(zi[12], zi[13]); w.w = pk2(zi[14], zi[15]); *(u32x4*)(d1 + 8) = w; }
    }
    __syncthreads();
}

#define XB_TMO      128
#define XB_XCNT(j)  (256  + 64 * (j))
#define XB_XSUB(j)  (1280 + 64 * (j))
#define XB_XGEN(j)  (2304 + 64 * (j))
#define XB_TOP      3328
#define XB_TOPGEN   3392
#define XCD_BAR_WORDS 3456
#define XB_SPIN_CAP (1u << 18)
__device__ __forceinline__ unsigned xb_ld(unsigned* p)              { return __hip_atomic_load(p, __ATOMIC_RELAXED, __HIP_MEMORY_SCOPE_AGENT); }
__device__ __forceinline__ unsigned xb_add(unsigned* p, unsigned v) { return __hip_atomic_fetch_add(p, v, __ATOMIC_RELAXED, __HIP_MEMORY_SCOPE_AGENT); }
__device__ __forceinline__ unsigned xb_xcc_id() { return (unsigned)__builtin_amdgcn_s_getreg((3 << 11) | 20) & 0xFu; }
#define XB_SPIN(cond, bar) do { unsigned _sp = 0; while (cond) { __builtin_amdgcn_s_sleep(1); \
    if ((++_sp & 255u) == 0u) { if (xb_ld(&(bar)[XB_TMO])) break; if (_sp > XB_SPIN_CAP) { atomicAdd(&(bar)[XB_TMO], 1u); break; } } } } while (0)
struct XcdBarrier { unsigned* bar; unsigned x; volatile LAS unsigned* st; };
__device__ __forceinline__ XcdBarrier xcd_barrier_post(unsigned* bar, volatile LAS unsigned* st, bool leader) {
    XcdBarrier b; b.bar = bar; b.x = xb_xcc_id(); b.st = st;
    if (leader) (void)xb_add(&bar[XB_XCNT(b.x)], 1u);
    return b;
}
__device__ __forceinline__ void xcd_barrier_complete(unsigned* bar, unsigned x, unsigned& nloc, unsigned& nx) {
    const unsigned G = gridDim.x * gridDim.y * gridDim.z;
    unsigned sum, cnt, mine, sp = 0u;
    for (;;) {
        sum = 0u; cnt = 0u; mine = 0u;
#pragma unroll
        for (unsigned j = 0; j < 16; ++j) { const unsigned c = xb_ld(&bar[XB_XCNT(j)]); sum += c; cnt += (c > 0u) ? 1u : 0u; mine = (j == x) ? c : mine; }
        if (sum == G) break;
        __builtin_amdgcn_s_sleep(1);
        if ((++sp & 255u) == 0u) { if (xb_ld(&bar[XB_TMO])) break; if (sp > XB_SPIN_CAP) { atomicAdd(&bar[XB_TMO], 1u); break; } }
    }
    nloc = mine > 0u ? mine : 1u; nx = cnt > 0u ? cnt : 1u;
}
__device__ __forceinline__ void xcd_barrier(const XcdBarrier& b, bool leader) {
    asm volatile("s_waitcnt vmcnt(0)" ::: "memory");
    __syncthreads();
    if (leader) {
        unsigned* bar = b.bar;
        __builtin_amdgcn_s_waitcnt(0);
        unsigned nloc = b.st[0], nx = b.st[1];
        if (nloc == 0u) { xcd_barrier_complete(bar, b.x, nloc, nx); b.st[0] = nloc; b.st[1] = nx; }
        const unsigned old = xb_add(&bar[XB_XSUB(b.x)], 1u);
        const unsigned gen = old / nloc;
        if (old + 1u == (gen + 1u) * nloc) {
            __builtin_amdgcn_fence(__ATOMIC_RELEASE, "agent");
            asm volatile("s_waitcnt vmcnt(0)" ::: "memory");
            const unsigned og = xb_add(&bar[XB_TOP], 1u);
            const unsigned tg = og / nx;
            if (og + 1u == (tg + 1u) * nx) xb_add(&bar[XB_TOPGEN], 1u);
            else XB_SPIN(xb_ld(&bar[XB_TOPGEN]) == tg, bar);
            __builtin_amdgcn_fence(__ATOMIC_ACQUIRE, "agent");
            xb_add(&bar[XB_XGEN(b.x)], 1u);
            asm volatile("s_waitcnt vmcnt(0)" ::: "memory");
        } else {
            XB_SPIN(xb_ld(&bar[XB_XGEN(b.x)]) == gen, bar);
            __builtin_amdgcn_fence(__ATOMIC_ACQUIRE, "agent");
            asm volatile("s_waitcnt vmcnt(0)" ::: "memory");
        }
    }
    __syncthreads();
}

__global__ void __launch_bounds__(512, 2) fwd_kernel(Args a) {
    extern __shared__ __attribute__((aligned(16))) unsigned char lds_raw[];
    LAS unsigned char* lds = (LAS unsigned char*)lds_raw;
    cg::grid_group grid = cg::this_grid();
    const int wave = __builtin_amdgcn_readfirstlane(threadIdx.x >> 6);
    const bool leader = (wave == 0) && (lane_id_opaque() == 0);
    volatile LAS unsigned* xst = (volatile LAS unsigned*)(lds + XBST_OFF);
    if (leader) { xst[0] = 0u; xst[1] = 0u; }
    __syncthreads();
    if (a.ws == nullptr) grid.sync();
    const XcdBarrier xbar = xcd_barrier_post((unsigned*)(a.ws + WS_BAR), xst, leader);
#define GRID_SYNC() xcd_barrier(xbar, (wave == 0) && (lane_id_opaque() == 0))
#define LANE_IDS const int lane = lane_id_opaque(), tid = wave * 64 + lane; (void)tid;
    const int G = gridDim.x, bid = blockIdx.x;
    unsigned char* ws = a.ws;
    bf16_t* W1T = (bf16_t*)(ws + WS_W1T); bf16_t* WGLUT = (bf16_t*)(ws + WS_WGLUT); bf16_t* WOT = (bf16_t*)(ws + WS_WOT); bf16_t* WGT = (bf16_t*)(ws + WS_WGT); bf16_t* WPT = (bf16_t*)(ws + WS_WPT);
    float2* ROPE = (float2*)(ws + WS_ROPE); float* RINV = (float*)(ws + WS_RINV); float* LB16 = (float*)(ws + WS_LB16); float* SSQ1 = (float*)(ws + WS_SSQ1); float* SSQ2 = (float*)(ws + WS_SSQ2);
    bf16_t* PB = (bf16_t*)(ws + WS_PB); bf16_t* WIN = (bf16_t*)(ws + WS_WIN); bf16_t* WBIG = (bf16_t*)(ws + WS_WBIG);
    bf16_t* XB = (bf16_t*)(ws + WS_XB); bf16_t* HB = (bf16_t*)(ws + WS_XB);
    bf16_t* Q = (bf16_t*)(ws + WS_Q); bf16_t* KB = (bf16_t*)(ws + WS_K); bf16_t* VB = (bf16_t*)(ws + WS_V); bf16_t* GA = (bf16_t*)(ws + WS_GA); bf16_t* GS = (bf16_t*)(ws + WS_GS);
    bf16_t* UCAT = (bf16_t*)(ws + WS_UCAT); bf16_t* PPB = (bf16_t*)(ws + WS_UCAT); bf16_t* YMIX = (bf16_t*)(ws + WS_YMIX); bf16_t* YS = (bf16_t*)(ws + WS_YS);

#pragma unroll
    for (int rep_ = 0; rep_ < 1 + ((REP_MASK >> 0) & 1); ++rep_) { LANE_IDS
        const int gw = bid * 8 + wave, NGW = G * 8;
        LAS float* scr = (LAS float*)(lds + wave * 16384);
        constexpr int I1 = 32 * 144, I2 = 16 * 64, I3 = 32 * 64, I4 = 32 * 64, I5 = 4 * 64, NIT = I1 + I2 + I3 + I4 + I5;
        auto item_desc = [&](int r) -> TrItem {
            if (r < I1) { const int kb = r / 144, lgg = r % 144, pn = lgg >> 3, lg = lgg & 7, wtg = pn * 8 + 4 * (lg & 1) + 2 * (lg >> 2) + ((lg >> 1) & 1);
                return TrItem{a.w_in, W1T, a.norm_mix, DM, DIN, wtg * 32, kb * 64, lgg * 32}; } r -= I1;
            if (r < I2) { const int kb = r / 64, lgg = r % 64, l2 = lgg & 31, wtg = (l2 >> 2) * 8 + 4 * (lgg >> 5) + (l2 & 3);
                return TrItem{a.w_glu, WGLUT, nullptr, DSSM, 2 * DSSM, wtg * 32, kb * 64, lgg * 32}; } r -= I2;
            if (r < I3) { const int kb = r / 64, lgg = r % 64; return TrItem{a.w_out, WOT, nullptr, DM, DM, lgg * 32, kb * 64, lgg * 32}; } r -= I3;
            if (r < I4) { const int kb = r / 64, lgg = r % 64; return TrItem{a.w_ple_gate, WGT, a.norm_ple, DM, DM, lgg * 32, kb * 64, lgg * 32}; } r -= I4;
            const int kb = r / 64, lgg = r % 64; return TrItem{a.w_ple_proj, WPT, nullptr, PLE, DM, lgg * 32, kb * 64, lgg * 32};
        };
#pragma unroll
        for (int rq_ = 0; rq_ < 1 + ((REP_MASK >> 8) & 1); ++rq_)
        for (int it = gw; it < NIT; it += 2 * NGW) {
            const bool two = it + NGW < NIT;
            const TrItem dA = item_desc(it), dB = item_desc(two ? it + NGW : it);
            float vA[32], vB[32];
            p0_tr_load(dA, vA, lane); if (two) p0_tr_load(dB, vB, lane);
            p0_tr_store(dA, vA, scr, lane); if (two) p0_tr_store(dB, vB, scr, lane);
        }
#pragma unroll
        for (int rq_ = 0; rq_ < 1 + ((REP_MASK >> 9) & 1); ++rq_)
        for (int m = gw; m < T; m += 2 * NGW) {
            const int m2 = m + NGW; const bool two = m2 < T;
            const f32x4* xr = (const f32x4*)(a.x + (size_t)m * DM) + lane; const f32x4* xr2 = (const f32x4*)(a.x + (size_t)(two ? m2 : m) * DM) + lane;
            f32x4 v[8], w2[8]; float s = 0.f, s2 = 0.f;
#pragma unroll
            for (int j = 0; j < 8; ++j) v[j] = __builtin_nontemporal_load(xr + 64 * j);
#pragma unroll
            for (int j = 0; j < 8; ++j) w2[j] = __builtin_nontemporal_load(xr2 + 64 * j);
#pragma unroll
            for (int j = 0; j < 8; ++j) { s += (v[j][0] * v[j][0] + v[j][1] * v[j][1]) + (v[j][2] * v[j][2] + v[j][3] * v[j][3]); s2 += (w2[j][0] * w2[j][0] + w2[j][1] * w2[j][1]) + (w2[j][2] * w2[j][2] + w2[j][3] * w2[j][3]); }
            s = wave_sum(s); s2 = wave_sum(s2);
            if (lane == 0) { RINV[m] = rsqrtf(s * (1.f / DM) + EPS); if (two) RINV[m2] = rsqrtf(s2 * (1.f / DM) + EPS); }
            u32x2* o = (u32x2*)(XB + (size_t)m * DM) + lane; u32x2* o2 = (u32x2*)(XB + (size_t)m2 * DM) + lane;
#pragma unroll
            for (int j = 0; j < 8; ++j) { u32x2 w; w.x = pk2(v[j][0], v[j][1]); w.y = pk2(v[j][2], v[j][3]); o[64 * j] = w; }
            if (two) {
#pragma unroll
                for (int j = 0; j < 8; ++j) { u32x2 w; w.x = pk2(w2[j][0], w2[j][1]); w.y = pk2(w2[j][2], w2[j][3]); o2[64 * j] = w; } }
        }
        for (int i = bid * 512 + tid; i < T * PLE / 4; i += G * 512) { const f32x4 v = __builtin_nontemporal_load((const f32x4*)a.p + i); u32x2 w; w.x = pk2(v[0], v[1]); w.y = pk2(v[2], v[3]); ((u32x2*)PB)[i] = w; }
        for (int i = bid * 512 + tid; i < 2048; i += G * 512) { const int pos = i >> 5, f = i & 31; const float inv = powf(10000.f, -(float)f / 32.f); float sn, cs; sincosf((float)pos * inv, &sn, &cs); ROPE[i] = make_float2(cs, sn); }
    GRID_SYNC(); }


    if constexpr ((REP_MASK >> 10) & 1) { GRID_SYNC(); GRID_SYNC(); GRID_SYNC(); GRID_SYNC(); }
#pragma unroll
    for (int rep_ = 0; rep_ < 1 + ((REP_MASK >> 1) & 1); ++rep_) { LANE_IDS
        { pg8::Gemm g{XB, W1T, DM, DM, DM, 0, 0}; pg8::StaticOrder S; S.init(T, 14 * 256, G, bid);
          pg8::Epi1 E{RINV, a.q_norm, a.k_norm, ROPE, Q, KB, VB, GA, GS, UCAT, (LAS float*)(lds + XCH_OFF), 0};
          pg8::gemm_phase<pg8::Epi1, pg8::StaticOrder, true>(lds, g, S, E, wave); }
        __syncthreads();
        for (int gi = bid - (G - NG); gi >= 0 && gi < NG; gi += NG) ssm_tables(a, gi, lds, tid);
    GRID_SYNC(); }

#pragma unroll
    for (int rep_ = 0; rep_ < 1 + ((REP_MASK >> 2) & 1); ++rep_) {
#pragma unroll
        for (int rq_ = 0; rq_ < 2; ++rq_) {
        if (bid < 2 * NG) { if (rq_ == 1 && !((REP_MASK >> 6) & 1)) break;
            pg8::BatchOrder S{2 * NG, G, bid};
            { pg8::Gemm g{UCAT, WIN, 256, 512, 256, (size_t)NCH * 512 * 2, (size_t)256 * 256 * 2};
              pg8::EpiS1 E{LB16, UCAT}; pg8::gemm_phase<pg8::EpiS1, pg8::BatchOrder, true>(lds, g, S, E, wave); }
            asm volatile("s_waitcnt vmcnt(0)\n\tbuffer_inv sc1\n\ts_waitcnt vmcnt(0)" ::: "memory"); __syncthreads();
            { pg8::Gemm g{UCAT, WBIG, 512, 512, 512, (size_t)NCH * 512 * 2, (size_t)256 * 512 * 2};
              pg8::EpiS2 E{YS}; pg8::gemm_phase<pg8::EpiS2, pg8::BatchOrder, true>(lds, g, S, E, wave); }
        } else { if (rq_ == 1 && !((REP_MASK >> 11) & 1)) break;
            pg8::Gemm g{XB, W1T + (size_t)14 * 256 * DM, DM, DM, DM, 0, 0}; pg8::ListOrder S{bid - 2 * NG, 128, G};
            pg8::Epi1 E{RINV, a.q_norm, a.k_norm, ROPE, Q, KB, VB, GA, GS, UCAT, (LAS float*)(lds + XCH_OFF), 14};
            pg8::gemm_phase<pg8::Epi1, pg8::ListOrder, true>(lds, g, S, E, wave);
        }
        __syncthreads(); }
#pragma unroll
        for (int rq_ = 0; rq_ < 1 + ((REP_MASK >> 7) & 1); ++rq_)
        for (int un = bid; un < 256; un += G) {
            const int x = un & 7, jj = un >> 3, b = x >> 2, kvh = (x >> 1) & 1, idx = (x & 1) * 32 + jj, h = kvh * 4 + (idx >> 4), qb = idx & 15;
            const size_t tok0 = (size_t)b * SEQ + qb * 256;
            att::attn_dense_body(Q + tok0 * DATT + h * 128, KB + (size_t)b * SEQ * DKV + kvh * 128, VB + (size_t)b * SEQ * DKV + kvh * 128,
                                 GA + tok0 * DATT + h * 128, YMIX + tok0 * DM + h * 128, SEQ, (char*)lds_raw, wave);
        }
    GRID_SYNC(); }

#pragma unroll
    for (int rep_ = 0; rep_ < 1 + ((REP_MASK >> 3) & 1); ++rep_) {
        { pg8::Gemm g{YS, WGLUT, DSSM, DSSM, DSSM, 0, 0}; pg8::StaticOrder S; S.init(T, 2 * DSSM, G, bid);
          pg8::EpiGlu E{a.b_glu, GS, YMIX}; pg8::gemm_phase<pg8::EpiGlu, pg8::StaticOrder, true>(lds, g, S, E, wave); }
        __syncthreads();
        { pg8::Gemm g{PB, WPT, PLE, PLE, PLE, 0, 0}; pg8::StaticOrder S; S.init(T, DM, G, bid);
          pg8::EpiBf E{PPB, DM}; pg8::gemm_phase<pg8::EpiBf, pg8::StaticOrder, true>(lds, g, S, E, wave); }
    GRID_SYNC(); }


#pragma unroll
    for (int rep_ = 0; rep_ < 1 + ((REP_MASK >> 4) & 1); ++rep_) {
        pg8::Gemm g{YMIX, WOT, DM, DM, DM, 0, 0}; pg8::StaticOrder S; S.init(T, DM, G, bid);
        pg8::EpiOut E{a.x, a.out, HB, SSQ1}; pg8::gemm_phase<pg8::EpiOut, pg8::StaticOrder, true>(lds, g, S, E, wave);
    GRID_SYNC(); }


    { LANE_IDS
        pg8::StaticOrder S; S.init(T, DM, G, bid); pg8::Unit u0;
        LAS float* r2 = (LAS float*)(lds + R2_OFF);
        if (S.next(0, u0) && tid < 256) { const float* sp = SSQ1 + (size_t)(u0.pm * 256 + tid) * 32; float s = 0.f;
#pragma unroll
            for (int i = 0; i < 8; ++i) { const f32x4 v = ((const f32x4*)sp)[i]; s += (v[0] + v[1]) + (v[2] + v[3]); }
            r2[tid] = rsqrtf(s * (1.f / DM) + EPS); }
        __syncthreads();
        pg8::Gemm g{HB, WGT, DM, DM, DM, 0, 0};
        pg8::EpiGate E{a.out, PPB, SSQ2, (unsigned*)ws, a.norm_final, r2, HB}; pg8::gemm_phase<pg8::EpiGate, pg8::StaticOrder, true>(lds, g, S, E, wave);
    }
}

extern "C" void kernel_launch(void* const* d_in, const int* in_sizes, int n_in, void* d_out, int out_size, void* d_ws, size_t ws_size, hipStream_t stream) {
    static int grid = 0;
    if (grid == 0) {
        if (n_in != 21 || in_sizes[0] != T * DM || out_size != T * DM || ws_size < WS_END) { fprintf(stderr, "kernel_launch: unexpected shapes (n_in %d, in0 %d, out %d, ws %zu)\n", n_in, n_in > 0 ? in_sizes[0] : -1, out_size, ws_size); grid = -1; return; }
        int dev = 0, cus = 0, per_cu = 0;
        hipGetDevice(&dev); hipDeviceGetAttribute(&cus, hipDeviceAttributeMultiprocessorCount, dev);
        if (hipFuncSetAttribute((const void*)fwd_kernel, hipFuncAttributeMaxDynamicSharedMemorySize, LDS_BYTES) != hipSuccess) { fprintf(stderr, "kernel_launch: hipFuncSetAttribute failed\n"); grid = -1; return; }
        hipOccupancyMaxActiveBlocksPerMultiprocessor(&per_cu, (const void*)fwd_kernel, 512, LDS_BYTES);
        (void)hipGetLastError();
        if (per_cu < 1) fprintf(stderr, "kernel_launch: occupancy query reports %d blocks per CU\n", per_cu);
        grid = cus > 256 ? 256 : cus;
    }
    if (grid < 0) return;
    Args a{};
    const float** f = (const float**)&a;
    for (int i = 0; i < 21; ++i) f[i] = (const float*)d_in[i];
    a.out = (float*)d_out; a.ws = (unsigned char*)d_ws;
    if (hipMemsetAsync(d_ws, 0, WS_CTL_BYTES, stream) != hipSuccess) { fprintf(stderr, "kernel_launch: hipMemsetAsync failed\n"); return; }
    void* args[] = {&a};
    hipError_t e = hipLaunchCooperativeKernel((const void*)fwd_kernel, dim3(grid), dim3(512), args, LDS_BYTES, stream);
    if (e != hipSuccess) fprintf(stderr, "kernel_launch: cooperative launch failed: %s (grid %d)\n", hipGetErrorString(e), grid);
}
```

```cpp
#include <hip/hip_runtime.h>
#include <hip/hip_cooperative_groups.h>
#include <cstdio>
#include <cstdint>
namespace cg = cooperative_groups;

#define LAS __attribute__((address_space(3)))
typedef unsigned short bf16_t;
typedef short bf16x8 __attribute__((ext_vector_type(8)));
typedef short s16x4 __attribute__((ext_vector_type(4)));
typedef float f32x4 __attribute__((ext_vector_type(4)));
typedef float f32x16 __attribute__((ext_vector_type(16)));
typedef unsigned u32x4 __attribute__((ext_vector_type(4)));
typedef unsigned u32x2 __attribute__((ext_vector_type(2)));

constexpr int T = 8192, SEQ = 4096, DM = 2048, DIN = 4608, DATT = 1024, DKV = 256, DSSM = 1024, PLE = 256;
constexpr int NG = 64, NCH = T / 16;
constexpr float EPS = 1e-6f;
#ifndef PH_MASK
#define PH_MASK 0xff
#endif
#ifndef GLDS_AUX
#define GLDS_AUX 0
#endif
#ifndef REP_MASK
#define REP_MASK 0
#endif

constexpr size_t MiB = 1u << 20;
constexpr size_t WS_W1T = 1 * MiB, WS_WGLUT = 19 * MiB, WS_WOT = 23 * MiB, WS_WGT = 31 * MiB, WS_WPT = 39 * MiB;
constexpr size_t WS_ROPE = 40 * MiB, WS_RINV = 40 * MiB + 65536, WS_LB16 = 40 * MiB + 131072, WS_SSQ1 = 41 * MiB, WS_SSQ2 = 42 * MiB;
constexpr size_t WS_PB = 43 * MiB, WS_WIN = 47 * MiB, WS_WBIG = 55 * MiB;
constexpr size_t WS_XB = 71 * MiB;
constexpr size_t WS_Q = 103 * MiB, WS_K = 119 * MiB, WS_V = 123 * MiB, WS_GA = 127 * MiB, WS_GS = 143 * MiB;
constexpr size_t WS_UCAT = 159 * MiB;
constexpr size_t WS_YMIX = 191 * MiB, WS_YS = 223 * MiB, WS_END = 239 * MiB;

constexpr int RING_BYTES = 131072, XCH_OFF = RING_BYTES, R2_OFF = RING_BYTES + 4096, XBST_OFF = RING_BYTES + 8192, LDS_BYTES = 147456;
constexpr size_t WS_BAR = 65536, WS_CTL_BYTES = 131072;

struct Args {
    const float *x, *p, *norm_mix, *w_in, *q_norm, *k_norm, *a_re, *a_im, *log_dt, *b_re, *b_im, *c_re, *c_im, *ssm_d, *w_glu, *b_glu, *w_out, *norm_ple, *w_ple_gate, *w_ple_proj, *norm_final;
    float* out; unsigned char* ws;
};

typedef __bf16 bf16s_;
__device__ __forceinline__ unsigned f2bf(float f) { return (unsigned)__builtin_bit_cast(unsigned short, (bf16s_)f); }
typedef float f32x2_ __attribute__((ext_vector_type(2)));
typedef __bf16 bf16x2_ __attribute__((ext_vector_type(2)));
__device__ __forceinline__ unsigned pk2(float lo, float hi) { const f32x2_ v = {lo, hi}; return __builtin_bit_cast(unsigned, __builtin_convertvector(v, bf16x2_)); }
__device__ __forceinline__ float bf2f(unsigned short b) { return __builtin_bit_cast(float, (unsigned)b << 16); }
__device__ __forceinline__ float bflo(unsigned w) { return __builtin_bit_cast(float, w << 16); }
__device__ __forceinline__ float bfhi(unsigned w) { return __builtin_bit_cast(float, w & 0xffff0000u); }
__device__ __forceinline__ unsigned cvt_pk_bf16(float lo, float hi) { unsigned r; asm volatile("v_cvt_pk_bf16_f32 %0, %1, %2" : "=v"(r) : "v"(lo), "v"(hi)); return r; }
__device__ __forceinline__ float sigmoidf_(float v) { return __builtin_amdgcn_rcpf(1.f + __builtin_amdgcn_exp2f(-1.4426950408889634f * v)); }
__device__ __forceinline__ float siluf_(float v) { return v * __builtin_amdgcn_rcpf(1.f + __builtin_amdgcn_exp2f(-1.4426950408889634f * v)); }
__device__ __forceinline__ float gelu_tanh(float v) { const float t = (-1.5957691216057308f * 1.4426950408889634f) * (v + 0.044715f * v * v * v); return v * __builtin_amdgcn_rcpf(1.f + __builtin_amdgcn_exp2f(t)); }
template <int K> __device__ __forceinline__ float swz_xor(float v) { return __int_as_float(__builtin_amdgcn_ds_swizzle(__float_as_int(v), (K << 10) | 0x1f)); }
__device__ __forceinline__ float sum_xor32(float v) { auto rr = __builtin_amdgcn_permlane32_swap(__float_as_uint(v), __float_as_uint(v), false, false); return __uint_as_float(rr[0]) + __uint_as_float(rr[1]); }
__device__ __forceinline__ float wave_sum(float v) { v += swz_xor<1>(v); v += swz_xor<2>(v); v += swz_xor<4>(v); v += swz_xor<8>(v); v += swz_xor<16>(v); return sum_xor32(v); }
#define LDS_WAIT() asm volatile("s_waitcnt lgkmcnt(0)" ::: "memory")
__device__ __forceinline__ int lane_id_opaque() { int l = __builtin_amdgcn_mbcnt_hi(~0u, __builtin_amdgcn_mbcnt_lo(~0u, 0u)); asm volatile("" : "+v"(l)); return l; }

namespace pg8 {
constexpr int BM = 256, BK = 64, HALF = 128, HTB = HALF * BK * 2, NXCD = 8, WGM = 8;
__host__ __device__ __forceinline__ int lds_byte(int r, int c) { const int st = (r >> 4) * 2 + (c >> 5), rr = r & 15, cc = c & 31, ob = rr * 64 + cc * 2; return st * 1024 + (ob ^ (((ob >> 9) & 1) << 5)); }
__host__ __device__ __forceinline__ void stage_rc(int b, int& R, int& C) { const int st = b / 1024, sb = b % 1024, swz = sb ^ (((sb >> 9) & 1) << 5); R = (st >> 1) * 16 + swz / 64; C = (st & 1) * 32 + (swz % 64) / 2; }
__host__ __device__ __forceinline__ int perm32(int rho) { const int n = rho >> 4, i = rho & 15; return 8 * (i >> 2) + 4 * n + (i & 3); }

struct Unit { int pm, pn, z; };
struct Gemm { const bf16_t* A; const bf16_t* Bt; int K, lda, ldb; size_t zA, zB; };

struct StaticOrder {
    int nM, nN, nwg, G, c;
    __device__ void init(int M, int N, int G_, int c_) { nM = M / BM; nN = N / BM; nwg = nM * nN; G = G_; c = c_; }
    __device__ bool next(int i, Unit& u) const {
        const long L = (long)i * G + c; if (L >= nwg) return false;
        int wgid = (int)L; { const int q = nwg / NXCD, r = nwg % NXCD, xcd = wgid % NXCD, off = wgid / NXCD; wgid = (xcd < r ? xcd * (q + 1) : r * (q + 1) + (xcd - r) * q) + off; }
        const int nig = WGM * nN, gid = wgid / nig, fm = gid * WGM, gsz = (nM - fm) < WGM ? (nM - fm) : WGM;
        u.pm = fm + ((wgid % nig) % gsz); u.pn = (wgid % nig) / gsz; u.z = 0; return true;
    }
};
struct BatchOrder {
    int n, G, c;
    __device__ bool next(int i, Unit& u) const { const int L = i * G + c; if (L >= n) return false; u.z = L >> 1; u.pm = L & 1; u.pn = 0; return true; }
};

struct ListOrder {
    int L0, n, stride;
    __device__ bool next(int i, Unit& u) const { const int L = L0 + i * stride; if (L < 0 || L >= n) return false;
        const int x = L & 7, j = L >> 3; u.pm = 4 * x + (j >> 2); u.pn = j & 3; u.z = 0; return true; }
};
template <class Epi, class Sched, bool ALIGN_EPI>
__device__ __forceinline__ void gemm_phase(LAS unsigned char* lds, const Gemm g, const Sched& S, const Epi& E, const int wid) {
    const int lane = lane_id_opaque(), tid = wid * 64 + lane, wr = wid >> 2, wc = wid & 3, fr = lane & 15, fq = lane >> 4;
    const int K = g.K, nt = K / BK;
    unsigned voffA[2], voffB[2];
#pragma unroll
    for (int i = 0; i < 2; ++i) { int R, C; stage_rc(tid * 16 + i * 8192, R, C); const int Rb = (R & ~31) + perm32(R & 31);
        voffA[i] = (unsigned)(R * g.lda + C) * 2u; voffB[i] = (unsigned)(Rb * g.ldb + C) * 2u; }
    const size_t kstep = (size_t)(BK * 2);
    const size_t hstepA = (size_t)HALF * g.lda * 2, hstepB = (size_t)HALF * g.ldb * 2;
    const size_t tstepA = 2 * hstepA, tstepB = 2 * hstepB;
    const unsigned ldsw = (unsigned)wid * 1024u;
    const int aoff = lds_byte(wr * 64 + fr, fq * 8), boff = lds_byte(wc * 32 + fr, fq * 8);
#define PG8_SA(b, h) (((b) * 2 + (h)) * HTB)
#define PG8_SB(b, h) ((4 + (b) * 2 + (h)) * HTB)
#define PG8_STAGE(bufoff, gbase, voff) do { _Pragma("unroll") for (int _i = 0; _i < 2; ++_i) \
        __builtin_amdgcn_global_load_lds((const unsigned*)((const char*)(gbase) + (voff)[_i]), (LAS unsigned*)(lds + (bufoff) + ldsw + _i * 8192), 16, 0, GLDS_AUX); } while (0)
#define PG8_LDA(dst, b, h) do { _Pragma("unroll") for (int m = 0; m < 4; ++m) _Pragma("unroll") for (int k = 0; k < 2; ++k) dst[m][k] = *(const LAS bf16x8*)(lds + PG8_SA(b, h) + aoff + m * 2048 + k * 1024); } while (0)
#define PG8_LDB(dst, b, h) do { _Pragma("unroll") for (int n = 0; n < 2; ++n) _Pragma("unroll") for (int k = 0; k < 2; ++k) dst[n][k] = *(const LAS bf16x8*)(lds + PG8_SB(b, h) + boff + n * 2048 + k * 1024); } while (0)
#define PG8_MMA(ai, bj, At, Bt) do { __builtin_amdgcn_s_setprio(1); _Pragma("unroll") for (int m = 0; m < 4; ++m) _Pragma("unroll") for (int n = 0; n < 2; ++n) _Pragma("unroll") for (int k = 0; k < 2; ++k) \
        acc[ai][bj][m][n] = __builtin_amdgcn_mfma_f32_16x16x32_bf16(Bt[n][k], At[m][k], acc[ai][bj][m][n], 0, 0, 0); __builtin_amdgcn_s_setprio(0); } while (0)
#define PG8_WAIT_V(n) asm volatile("s_waitcnt vmcnt(" #n ")" ::: "memory")
#define PG8_WAIT_L(n) asm volatile("s_waitcnt lgkmcnt(" #n ")" ::: "memory")
#define PG8_BAR __builtin_amdgcn_s_barrier()
#define PG8_SCHED __builtin_amdgcn_sched_barrier(0)
    Unit cur, nxt; int ui = 0;
    if (!S.next(0, cur)) return;
    f32x4 acc[2][2][4][2];
#pragma unroll
    for (int a = 0; a < 2; ++a)
#pragma unroll
        for (int b = 0; b < 2; ++b)
#pragma unroll
            for (int m = 0; m < 4; ++m)
#pragma unroll
                for (int n = 0; n < 2; ++n) acc[a][b][m][n] = (f32x4){0.f, 0.f, 0.f, 0.f};
    bf16x8 At[4][2], B0[2][2], B1[2][2];
    const char* cA = (const char*)g.A + (size_t)cur.z * g.zA + (size_t)cur.pm * tstepA; const char* cB = (const char*)g.Bt + (size_t)cur.z * g.zB + (size_t)cur.pn * tstepB;
    PG8_STAGE(PG8_SB(0, 0), cB, voffB); PG8_STAGE(PG8_SB(0, 1), cB + hstepB, voffB); PG8_STAGE(PG8_SA(0, 0), cA, voffA); PG8_STAGE(PG8_SA(0, 1), cA + hstepA, voffA);
    if (wr == 1) PG8_BAR;
    PG8_WAIT_V(2); PG8_BAR;
    PG8_STAGE(PG8_SB(1, 0), cB + kstep, voffB); PG8_STAGE(PG8_SA(1, 0), cA + kstep, voffA); PG8_STAGE(PG8_SB(1, 1), cB + hstepB + kstep, voffB);
    PG8_WAIT_V(6); PG8_BAR;
    for (;;) {
        const bool has_next = S.next(ui + 1, nxt);
        const char* nA = has_next ? (const char*)g.A + (size_t)nxt.z * g.zA + (size_t)nxt.pm * tstepA : cA;
        const char* nB = has_next ? (const char*)g.Bt + (size_t)nxt.z * g.zB + (size_t)nxt.pn * tstepB : cB;
        for (int t = 0; t < nt; t += 2) {
            const bool last = (t == nt - 2);
            const char* a1 = cA + (size_t)(t + 1) * kstep;
            const char* a2 = last ? nA : cA + (size_t)(t + 2) * kstep; const char* b2 = last ? nB : cB + (size_t)(t + 2) * kstep;
            const char* a3 = a2 + kstep; const char* b3 = b2 + kstep;
            PG8_LDB(B0, 0, 0); PG8_LDB(B1, 0, 1); PG8_SCHED; PG8_LDA(At, 0, 0); PG8_STAGE(PG8_SA(1, 1), a1 + hstepA, voffA);
            PG8_WAIT_V(8); PG8_WAIT_L(0); PG8_BAR; PG8_MMA(0, 0, At, B0); PG8_MMA(0, 1, At, B1); PG8_BAR; PG8_SCHED;
            PG8_LDA(At, 0, 1); PG8_STAGE(PG8_SB(0, 0), b2, voffB); PG8_STAGE(PG8_SB(0, 1), b2 + hstepB, voffB); PG8_STAGE(PG8_SA(0, 0), a2, voffA);
            PG8_WAIT_V(8); PG8_WAIT_L(0); PG8_BAR; PG8_MMA(1, 0, At, B0); PG8_MMA(1, 1, At, B1); PG8_BAR; PG8_SCHED;
            PG8_LDB(B0, 1, 0); PG8_LDB(B1, 1, 1); PG8_SCHED; PG8_LDA(At, 1, 0); PG8_STAGE(PG8_SA(0, 1), a2 + hstepA, voffA);
            PG8_WAIT_V(8); PG8_WAIT_L(0); PG8_BAR; PG8_MMA(0, 0, At, B0); PG8_MMA(0, 1, At, B1); PG8_BAR; PG8_SCHED;
            PG8_LDA(At, 1, 1); PG8_STAGE(PG8_SB(1, 0), b3, voffB); PG8_STAGE(PG8_SB(1, 1), b3 + hstepB, voffB); PG8_STAGE(PG8_SA(1, 0), a3, voffA);
            PG8_WAIT_V(8); PG8_WAIT_L(0); PG8_BAR; PG8_MMA(1, 0, At, B0); PG8_MMA(1, 1, At, B1); PG8_BAR; PG8_SCHED;
        }
        if constexpr (ALIGN_EPI) { if (wr == 0) PG8_BAR; }
        if constexpr (!Epi::AFTER_DRAIN) E(acc, cur, wr, wc, fr, fq);
        if (!has_next) break;
#pragma unroll
        for (int a = 0; a < 2; ++a)
#pragma unroll
            for (int b = 0; b < 2; ++b)
#pragma unroll
                for (int m = 0; m < 4; ++m)
#pragma unroll
                    for (int n = 0; n < 2; ++n) acc[a][b][m][n] = (f32x4){0.f, 0.f, 0.f, 0.f};
        cur = nxt; cA = nA; cB = nB; ++ui;
        if constexpr (ALIGN_EPI) { if (wr == 1) PG8_BAR; }
    }
    PG8_WAIT_V(0);
    if constexpr (!ALIGN_EPI) { if (wr == 0) PG8_BAR; }
    PG8_BAR;
    if constexpr (Epi::AFTER_DRAIN) E.fused(acc, cur, wr, wc, lds, wid);
#undef PG8_SA
#undef PG8_SB
#undef PG8_STAGE
#undef PG8_LDA
#undef PG8_LDB
#undef PG8_MMA
#undef PG8_WAIT_V
#undef PG8_WAIT_L
#undef PG8_BAR
#undef PG8_SCHED
}

#define EPI_FOR_ROWS _Pragma("unroll") for (int ai = 0; ai < 2; ++ai) _Pragma("unroll") for (int m = 0; m < 4; ++m)
#define EPI_ROWDEF const int rit = ai * HALF + wr * 64 + m * 16 + fr; const int row = u.pm * BM + rit; (void)rit; (void)row;

struct Epi1 {
    static constexpr bool AFTER_DRAIN = false;
    const float* rinv; const float* qnw; const float* knw; const float2* rope;
    bf16_t *Q, *Kb, *Vb, *GA, *GS, *UCAT; LAS float* xch; int pn0;
    __device__ __forceinline__ void operator()(const f32x4 (&acc)[2][2][4][2], const Unit& u, int wr, int wc, int, int) const {
        const int l_ = lane_id_opaque(), fr = l_ & 15, fq = l_ >> 4;
        const int pn = u.pn + pn0;
        if (pn <= 4) {
            float ss[2][4], rv[2][4];
            EPI_FOR_ROWS { EPI_ROWDEF const float r = rinv[row]; rv[ai][m] = r; float s = 0.f;
#pragma unroll
                for (int bj = 0; bj < 2; ++bj)
#pragma unroll
                    for (int n = 0; n < 2; ++n) { const f32x4 v = acc[ai][bj][m][n] * r; s += (v[0] * v[0] + v[1] * v[1]) + (v[2] * v[2] + v[3] * v[3]); }
                s += swz_xor<16>(s); s = sum_xor32(s); ss[ai][m] = s;
                if (fq == 0) xch[wc * 256 + rit] = s; }
            LDS_WAIT(); __builtin_amdgcn_s_barrier(); asm volatile("" ::: "memory");
            const int half = wc & 1, hd = wc >> 1;
            const float* nw = (pn < 4 ? qnw : knw) + 64 * half + 8 * fq;
            float w1[8], w2[8];
#pragma unroll
            for (int i = 0; i < 8; ++i) { w1[i] = nw[i]; w2[i] = nw[32 + i]; }
            EPI_FOR_ROWS { EPI_ROWDEF const float tot = ss[ai][m] + xch[(wc ^ 1) * 256 + rit];
                const float sc = rv[ai][m] * rsqrtf(tot * (1.f / 128.f) + EPS);
                const int t = row & (SEQ - 1); const int pos = half ? (t & 63) : (t >> 6);
                const float2* rp = rope + pos * 32 + 8 * fq;
                float o1[8], o2[8];
#pragma unroll
                for (int n = 0; n < 2; ++n)
#pragma unroll
                    for (int e = 0; e < 4; ++e) { const int i = 4 * n + e; const float2 cs = rp[i];
                        const float x1 = acc[ai][0][m][n][e] * sc * w1[i], x2 = acc[ai][1][m][n][e] * sc * w2[i];
                        o1[i] = x1 * cs.x - x2 * cs.y; o2[i] = x2 * cs.x + x1 * cs.y; }
                bf16_t* dst = (pn < 4) ? Q + (size_t)row * DATT + (2 * pn + hd) * 128 + 64 * half + 8 * fq : Kb + (size_t)row * DKV + hd * 128 + 64 * half + 8 * fq;
                u32x4 a; a.x = pk2(o1[0], o1[1]); a.y = pk2(o1[2], o1[3]); a.z = pk2(o1[4], o1[5]); a.w = pk2(o1[6], o1[7]);
                u32x4 b; b.x = pk2(o2[0], o2[1]); b.y = pk2(o2[2], o2[3]); b.z = pk2(o2[4], o2[5]); b.w = pk2(o2[6], o2[7]);
                *(u32x4*)dst = a; *(u32x4*)(dst + 32) = b; }
        } else {
            const int lg0 = 4 * (wc >> 1) + 2 * (wc & 1);
            EPI_FOR_ROWS { EPI_ROWDEF const float r = rinv[row];
#pragma unroll
                for (int bj = 0; bj < 2; ++bj) { const int L = 256 * pn + 32 * (lg0 + bj) + 8 * fq;
                    f32x4 v0 = acc[ai][bj][m][0] * r, v1 = acc[ai][bj][m][1] * r; bf16_t* dst;
                    if (pn == 5) dst = Vb + (size_t)row * DKV + (L - 1280);
                    else if (pn < 10) dst = GA + (size_t)row * DATT + (L - 1536);
                    else if (pn < 14) { const int Lu = L - 2560; dst = UCAT + ((size_t)(Lu >> 4) * NCH + (row >> 4)) * 512 + (row & 15) * 16 + (Lu & 15); }
                    else dst = GS + (size_t)row * DSSM + (L - 3584);
                    if ((pn >= 6 && pn < 10) || pn >= 14) {
#pragma unroll
                        for (int e = 0; e < 4; ++e) { v0[e] = siluf_(v0[e]); v1[e] = siluf_(v1[e]); } }
                    u32x4 w; w.x = pk2(v0[0], v0[1]); w.y = pk2(v0[2], v0[3]); w.z = pk2(v1[0], v1[1]); w.w = pk2(v1[2], v1[3]);
                    *(u32x4*)dst = w; } }
        }
    }
};
struct EpiS1 {
    static constexpr bool AFTER_DRAIN = true;
    const float* lb16; bf16_t* UCAT;
    __device__ __forceinline__ void operator()(const f32x4 (&)[2][2][4][2], const Unit&, int, int, int, int) const {}
    __device__ __forceinline__ void fused(const f32x4 (&acc)[2][2][4][2], const Unit& u, int wr, int wc, LAS unsigned char* lds, int wid) const {
        const int l_ = lane_id_opaque(), fr = l_ & 15, fq = l_ >> 4;
        LAS float* Tl = (LAS float*)lds;
#pragma unroll
        for (int d = 0; d < 2; ++d) {
            EPI_FOR_ROWS { const int rit = ai * HALF + wr * 64 + m * 16 + fr; LAS float* rp = Tl + rit * 128 + wc * 32 + 8 * fq;
                *(LAS f32x4*)rp = acc[ai][d][m][0]; *(LAS f32x4*)(rp + 4) = acc[ai][d][m][1]; }
            LDS_WAIT(); __builtin_amdgcn_s_barrier(); asm volatile("" ::: "memory");
            {
                const int p = l_; const float lr = lb16[((u.z * 2 + d) * 64 + p) * 2], li = lb16[((u.z * 2 + d) * 64 + p) * 2 + 1];
                LAS float* SEG = (LAS float*)(lds + XCH_OFF);
                float xr = 0.f, xi = 0.f;
#pragma unroll 8
                for (int i = 0; i < 32; ++i) { const int cc = wid * 32 + i, c = d ? 255 - cc : cc;
                    const float sr = Tl[c * 128 + p], si = Tl[c * 128 + 64 + p];
                    Tl[c * 128 + p] = xr; Tl[c * 128 + 64 + p] = xi;
                    const float nr = lr * xr - li * xi + sr; xi = lr * xi + li * xr + si; xr = nr; }
                SEG[(wid * 64 + p) * 2] = xr; SEG[(wid * 64 + p) * 2 + 1] = xi;
                LDS_WAIT(); __builtin_amdgcn_s_barrier(); asm volatile("" ::: "memory");
                float l32r = lr, l32i = li;
#pragma unroll
                for (int q = 0; q < 5; ++q) { const float t = l32r * l32r - l32i * l32i; l32i = 2.f * l32r * l32i; l32r = t; }
                float er = 0.f, ei = 0.f;
                for (int j = 0; j < wid; ++j) { const float tr = SEG[(j * 64 + p) * 2], ti = SEG[(j * 64 + p) * 2 + 1];
                    const float nr = l32r * er - l32i * ei + tr; ei = l32r * ei + l32i * er + ti; er = nr; }
#pragma unroll 8
                for (int i = 0; i < 32; ++i) { const int cc = wid * 32 + i, c = d ? 255 - cc : cc;
                    const float tr = Tl[c * 128 + p] + er, ti = Tl[c * 128 + 64 + p] + ei;
                    Tl[c * 128 + p] = __uint_as_float(pk2(tr, ti));
                    const float nr = lr * er - li * ei; ei = lr * ei + li * er; er = nr; }
            }
            LDS_WAIT(); __builtin_amdgcn_s_barrier(); asm volatile("" ::: "memory");
            {   bf16_t* ub = UCAT + ((size_t)u.z * NCH + u.pm * 256) * 512 + 256 + d * 128;
#pragma unroll
                for (int i = 0; i < 8; ++i) { const int q = wid * 64 + l_ + 512 * i, r = q >> 4, c8 = (q & 15) * 8;
                    *(u32x4*)(ub + (size_t)r * 512 + c8) = *(const LAS u32x4*)((LAS bf16_t*)(Tl + r * 128) + c8); } }
            LDS_WAIT(); __builtin_amdgcn_s_barrier(); asm volatile("" ::: "memory");
        }
    }
};
struct EpiS2 {
    static constexpr bool AFTER_DRAIN = false;
    bf16_t* YS;
    __device__ __forceinline__ void operator()(const f32x4 (&acc)[2][2][4][2], const Unit& u, int wr, int wc, int, int) const {
        const int l_ = lane_id_opaque(), fr = l_ & 15, fq = l_ >> 4;
        EPI_FOR_ROWS { EPI_ROWDEF
#pragma unroll
            for (int bj = 0; bj < 2; ++bj) { const int c = bj * HALF + wc * 32 + 8 * fq; const int j = c >> 4, h0 = c & 15;
                const f32x4 v0 = acc[ai][bj][m][0], v1 = acc[ai][bj][m][1];
                u32x4 w; w.x = pk2(gelu_tanh(v0[0]), gelu_tanh(v0[1])); w.y = pk2(gelu_tanh(v0[2]), gelu_tanh(v0[3])); w.z = pk2(gelu_tanh(v1[0]), gelu_tanh(v1[1])); w.w = pk2(gelu_tanh(v1[2]), gelu_tanh(v1[3]));
                *(u32x4*)(YS + ((size_t)row * 16 + j) * DSSM + u.z * 16 + h0) = w; } }
    }
};
struct EpiGlu {
    static constexpr bool AFTER_DRAIN = false;
    const float* bglu; const bf16_t* GS; bf16_t* YMIX;
    __device__ __forceinline__ void operator()(const f32x4 (&acc)[2][2][4][2], const Unit& u, int wr, int wc, int, int) const {
        const int l_ = lane_id_opaque(), fr = l_ & 15, fq = l_ >> 4;
        const int a0 = 128 * u.pn + 32 * wc + 8 * fq;
        float bv[8], bg[8];
#pragma unroll
        for (int i = 0; i < 8; ++i) { bv[i] = bglu[a0 + i]; bg[i] = bglu[1024 + a0 + i]; }
        u32x4 gsv[2][4];
        EPI_FOR_ROWS { EPI_ROWDEF gsv[ai][m] = __builtin_nontemporal_load((const u32x4*)(GS + (size_t)row * DSSM + a0)); }
        EPI_FOR_ROWS { EPI_ROWDEF const u32x4 gs = gsv[ai][m];
            float o[8];
#pragma unroll
            for (int n = 0; n < 2; ++n)
#pragma unroll
                for (int e = 0; e < 4; ++e) { const int i = 4 * n + e; o[i] = (acc[ai][0][m][n][e] + bv[i]) * sigmoidf_(acc[ai][1][m][n][e] + bg[i]); }
            o[0] *= bflo(gs.x); o[1] *= bfhi(gs.x); o[2] *= bflo(gs.y); o[3] *= bfhi(gs.y); o[4] *= bflo(gs.z); o[5] *= bfhi(gs.z); o[6] *= bflo(gs.w); o[7] *= bfhi(gs.w);
            u32x4 w; w.x = pk2(o[0], o[1]); w.y = pk2(o[2], o[3]); w.z = pk2(o[4], o[5]); w.w = pk2(o[6], o[7]);
            *(u32x4*)(YMIX + (size_t)row * DM + 1024 + a0) = w; }
    }
};
struct EpiBf {
    static constexpr bool AFTER_DRAIN = false;
    bf16_t* O; int ldc;
    __device__ __forceinline__ void operator()(const f32x4 (&acc)[2][2][4][2], const Unit& u, int wr, int wc, int, int) const {
        const int l_ = lane_id_opaque(), fr = l_ & 15, fq = l_ >> 4;
        EPI_FOR_ROWS { EPI_ROWDEF
#pragma unroll
            for (int bj = 0; bj < 2; ++bj) { const f32x4 v0 = acc[ai][bj][m][0], v1 = acc[ai][bj][m][1];
                u32x4 w; w.x = pk2(v0[0], v0[1]); w.y = pk2(v0[2], v0[3]); w.z = pk2(v1[0], v1[1]); w.w = pk2(v1[2], v1[3]);
                *(u32x4*)(O + (size_t)row * ldc + u.pn * BM + bj * HALF + wc * 32 + 8 * fq) = w; } }
    }
};
struct EpiOut {
    static constexpr bool AFTER_DRAIN = false;
    const float* x; float* H; bf16_t* HB; float* ssq;
    __device__ __forceinline__ void operator()(const f32x4 (&acc)[2][2][4][2], const Unit& u, int wr, int wc, int, int) const {
        const int l_ = lane_id_opaque(), fr = l_ & 15, fq = l_ >> 4;
#pragma unroll
        for (int ai = 0; ai < 2; ++ai) {
            f32x4 xv[4][2][2];
#pragma unroll
            for (int m = 0; m < 4; ++m) { EPI_ROWDEF
#pragma unroll
                for (int bj = 0; bj < 2; ++bj) { const size_t off = (size_t)row * DM + u.pn * BM + bj * HALF + wc * 32 + 8 * fq; xv[m][bj][0] = __builtin_nontemporal_load((const f32x4*)(x + off)); xv[m][bj][1] = __builtin_nontemporal_load((const f32x4*)(x + off + 4)); } }
#pragma unroll
            for (int m = 0; m < 4; ++m) { EPI_ROWDEF float s = 0.f;
#pragma unroll
                for (int bj = 0; bj < 2; ++bj) { const size_t off = (size_t)row * DM + u.pn * BM + bj * HALF + wc * 32 + 8 * fq;
                    const f32x4 v0 = acc[ai][bj][m][0] + xv[m][bj][0], v1 = acc[ai][bj][m][1] + xv[m][bj][1];
                    s += (v0[0] * v0[0] + v0[1] * v0[1]) + (v0[2] * v0[2] + v0[3] * v0[3]) + (v1[0] * v1[0] + v1[1] * v1[1]) + (v1[2] * v1[2] + v1[3] * v1[3]);
                    u32x4 w; w.x = pk2(v0[0], v0[1]); w.y = pk2(v0[2], v0[3]); w.z = pk2(v1[0], v1[1]); w.w = pk2(v1[2], v1[3]);
                    *(u32x4*)(HB + off) = w; }
                s += swz_xor<16>(s); s = sum_xor32(s);
                if (fq == 0) ssq[(size_t)row * 32 + u.pn * 4 + wc] = s; }
        }
    }
};
struct EpiGate {
    static constexpr bool AFTER_DRAIN = true;
    float* H; const bf16_t* PP; float* ssq; unsigned* cnt; const float* nf; const LAS float* r2; const bf16_t* HBr;
    __device__ __forceinline__ void operator()(const f32x4 (&)[2][2][4][2], const Unit&, int, int, int, int) const {}
    __device__ __forceinline__ void fused(f32x4 (&acc)[2][2][4][2], const Unit& u, int wr, int wc, LAS unsigned char* lds, int wid) const {
        const int l_ = lane_id_opaque(), fr = l_ & 15, fq = l_ >> 4, tid = wid * 64 + l_;
        LAS float* P = (LAS float*)lds; LAS float* Rn = P + 1024;
        EPI_FOR_ROWS { EPI_ROWDEF float s = 0.f; const float r = r2[rit];
#pragma unroll
            for (int bj = 0; bj < 2; ++bj) { const size_t off = (size_t)row * DM + u.pn * BM + bj * HALF + wc * 32 + 8 * fq;
                const u32x4 pp = __builtin_nontemporal_load((const u32x4*)(PP + off));
                const u32x4 hb = __builtin_nontemporal_load((const u32x4*)(HBr + off));
                f32x4 h0 = {bflo(hb.x), bfhi(hb.x), bflo(hb.y), bfhi(hb.y)}, h1 = {bflo(hb.z), bfhi(hb.z), bflo(hb.w), bfhi(hb.w)};
                const f32x4 a0 = acc[ai][bj][m][0] * r, a1 = acc[ai][bj][m][1] * r;
                h0[0] += sigmoidf_(a0[0]) * bflo(pp.x); h0[1] += sigmoidf_(a0[1]) * bfhi(pp.x); h0[2] += sigmoidf_(a0[2]) * bflo(pp.y); h0[3] += sigmoidf_(a0[3]) * bfhi(pp.y);
                h1[0] += sigmoidf_(a1[0]) * bflo(pp.z); h1[1] += sigmoidf_(a1[1]) * bfhi(pp.z); h1[2] += sigmoidf_(a1[2]) * bflo(pp.w); h1[3] += sigmoidf_(a1[3]) * bfhi(pp.w);
                acc[ai][bj][m][0] = h0; acc[ai][bj][m][1] = h1;
                s += (h0[0] * h0[0] + h0[1] * h0[1]) + (h0[2] * h0[2] + h0[3] * h0[3]) + (h1[0] * h1[0] + h1[1] * h1[1]) + (h1[2] * h1[2] + h1[3] * h1[3]); }
            s += swz_xor<16>(s); s = sum_xor32(s);
            if (fq == 0) P[rit * 4 + wc] = s; }
        LDS_WAIT(); __builtin_amdgcn_s_barrier(); asm volatile("" ::: "memory");
        if (tid < 256) { const float t = (P[tid * 4] + P[tid * 4 + 1]) + (P[tid * 4 + 2] + P[tid * 4 + 3]);
            __hip_atomic_store(ssq + (size_t)(u.pm * 256 + tid) * 8 + u.pn, t, __ATOMIC_RELAXED, __HIP_MEMORY_SCOPE_AGENT); }
        asm volatile("s_waitcnt vmcnt(0)" ::: "memory");
        if (wid < 4 && l_ == 0) __hip_atomic_fetch_add(cnt + 64 * u.pm, 1u, __ATOMIC_RELAXED, __HIP_MEMORY_SCOPE_AGENT);
        if (wid == 0) {
            unsigned sp = 0;
            while ((unsigned)__builtin_amdgcn_readfirstlane(__hip_atomic_load(cnt + 64 * u.pm, __ATOMIC_RELAXED, __HIP_MEMORY_SCOPE_AGENT)) < 32u) { __builtin_amdgcn_s_sleep(2); if (++sp > (1u << 22)) break; }
            __builtin_amdgcn_fence(__ATOMIC_ACQUIRE, "agent");
        }
        asm volatile("s_waitcnt vmcnt(0) lgkmcnt(0)" ::: "memory"); __builtin_amdgcn_s_barrier(); asm volatile("" ::: "memory");
        if (tid < 256) { const float* sp = ssq + (size_t)(u.pm * 256 + tid) * 8; float t = 0.f;
#pragma unroll
            for (int i = 0; i < 8; ++i) t += __hip_atomic_load(sp + i, __ATOMIC_RELAXED, __HIP_MEMORY_SCOPE_AGENT);
            Rn[tid] = rsqrtf(t * (1.f / DM) + EPS); }
        LDS_WAIT(); __builtin_amdgcn_s_barrier(); asm volatile("" ::: "memory");
        EPI_FOR_ROWS { EPI_ROWDEF const float rn = Rn[rit];
#pragma unroll
            for (int bj = 0; bj < 2; ++bj) { const int col = u.pn * BM + bj * HALF + wc * 32 + 8 * fq; const size_t off = (size_t)row * DM + col;
                *(f32x4*)(H + off) = acc[ai][bj][m][0] * rn * *(const f32x4*)(nf + col); *(f32x4*)(H + off + 4) = acc[ai][bj][m][1] * rn * *(const f32x4*)(nf + col + 4); } }
    }
};
}

namespace att {
constexpr int D = 128, NW = 8, QBLK = 32, KVBLK = 64;
constexpr float SCALE = 0.088388347648318440f;
constexpr float THR = 8.f;
constexpr int LDQ = DATT, LDK = DKV;
constexpr size_t SHM_V = KVBLK * D * 2, SHM_K = KVBLK * D * 2, SHM_ATTN = 2 * SHM_V + 2 * SHM_K + NW * 64 * 4;
#define KSWZ(row, colB) ((row) * 256 + ((colB) ^ (((row) & 7) << 4)))
#define SBAR() __builtin_amdgcn_sched_barrier(0)
__device__ __forceinline__ int crow(int r, int hi) { return (r & 3) + 8 * (r >> 2) + 4 * hi; }
__device__ __forceinline__ void partialSM(f32x16& p0, f32x16& p1, float& m_reg, float& mn, float& alpha) {
  constexpr float C = SCALE * 1.4426950408889634f;
  float pmax = p0[0]; for (int r = 1; r < 16; ++r) pmax = fmaxf(pmax, p0[r]); for (int r = 0; r < 16; ++r) pmax = fmaxf(pmax, p1[r]);
  { auto rr = __builtin_amdgcn_permlane32_swap(__float_as_uint(pmax), __float_as_uint(pmax), false, false);
    pmax = fmaxf(__uint_as_float(rr[0]), __uint_as_float(rr[1])); }
  if (__builtin_expect(__all(pmax - m_reg <= THR / SCALE), 1)) { mn = m_reg; alpha = 1.f; }
  else { mn = fmaxf(m_reg, pmax); alpha = __builtin_amdgcn_exp2f((m_reg - mn) * C); m_reg = mn; }
  float mnC = -mn * C;
  for (int r = 0; r < 16; ++r) p0[r] = fmaf(p0[r], C, mnC); for (int r = 0; r < 16; ++r) p1[r] = fmaf(p1[r], C, mnC);
  for (int r = 0; r < 16; ++r) p0[r] = __builtin_amdgcn_exp2f(p0[r]);
}
__device__ __forceinline__ void finishSM(f32x16& p0, f32x16& p1, float alpha, float& l_reg, bf16x8& pa0, bf16x8& pa1, bf16x8& pa2, bf16x8& pa3) {
  for (int r = 0; r < 16; ++r) p1[r] = __builtin_amdgcn_exp2f(p1[r]);
  float ps = 0; for (int r = 0; r < 16; ++r) ps += p0[r]; for (int r = 0; r < 16; ++r) ps += p1[r];
  { auto rr = __builtin_amdgcn_permlane32_swap(__float_as_uint(ps), __float_as_uint(ps), false, false);
    ps = __uint_as_float(rr[0]) + __uint_as_float(rr[1]); }
  l_reg = l_reg * alpha + ps;
#define PK4(P, BASE, OUT) do { unsigned a0 = cvt_pk_bf16(P[BASE + 0], P[BASE + 1]), a1 = cvt_pk_bf16(P[BASE + 2], P[BASE + 3]);   \
    unsigned b0 = cvt_pk_bf16(P[BASE + 4], P[BASE + 5]), b1 = cvt_pk_bf16(P[BASE + 6], P[BASE + 7]);                              \
    auto r0 = __builtin_amdgcn_permlane32_swap(a0, b0, false, false); auto r1 = __builtin_amdgcn_permlane32_swap(a1, b1, false, false); \
    u32x4 w = {r0[0], r1[0], r0[1], r1[1]}; OUT = *reinterpret_cast<bf16x8*>(&w); } while (0)
  PK4(p0, 0, pa0); PK4(p0, 8, pa1); PK4(p1, 0, pa2); PK4(p1, 8, pa3);
#undef PK4
}
__device__ __forceinline__ void qkt(f32x16& p0, f32x16& p1, const bf16_t* Ks, const bf16x8* qr, int r32, int hi) {
  p0 = f32x16{}; p1 = f32x16{};
  for (int d0 = 0; d0 < 8; ++d0) { int cb = (d0 * 16 + hi * 8) * 2;
    bf16x8 b0 = *reinterpret_cast<const bf16x8*>((const char*)Ks + KSWZ(r32, cb));
    bf16x8 b1 = *reinterpret_cast<const bf16x8*>((const char*)Ks + KSWZ(32 + r32, cb));
    p0 = __builtin_amdgcn_mfma_f32_32x32x16_bf16(b0, qr[d0], p0, 0, 0, 0);
    p1 = __builtin_amdgcn_mfma_f32_32x32x16_bf16(b1, qr[d0], p1, 0, 0, 0); }
}
__device__ __forceinline__ int v_st(int k, int c) { const int kk = (k & ~0xC) | ((k & 4) << 1) | ((k & 8) >> 1); return ((kk >> 3) * 4 + (c >> 5)) * 512 + ((kk & 7) * 32 + (c & 31)) * 2; }
__device__ __forceinline__ int v_rd_base(int lane) { return ((lane & 3) << 3) | (((lane >> 2) & 3) << 6) | (((lane >> 4) & 1) << 5) | (((lane >> 5) & 1) << 8); }
constexpr int v_rd_off(int d0, int ks, int half) { return d0 * 512 + ks * 4096 + half * 2048; }
template <int OFF> __device__ __forceinline__ s16x4 tr_read(int vb) {
  s16x4 r; asm volatile("ds_read_b64_tr_b16 %0, %1 offset:%2" : "=&v"(r) : "v"(vb), "i"(OFF) : "memory"); return r;
}
template <int D0> __device__ __forceinline__ void pv_one(f32x16& od, int vb, bf16x8 pa0, bf16x8 pa1, bf16x8 pa2, bf16x8 pa3) {
  const s16x4 l0 = tr_read<v_rd_off(D0, 0, 0)>(vb), h0 = tr_read<v_rd_off(D0, 0, 1)>(vb), l1 = tr_read<v_rd_off(D0, 1, 0)>(vb), h1 = tr_read<v_rd_off(D0, 1, 1)>(vb);
  const s16x4 l2 = tr_read<v_rd_off(D0, 2, 0)>(vb), h2 = tr_read<v_rd_off(D0, 2, 1)>(vb), l3 = tr_read<v_rd_off(D0, 3, 0)>(vb), h3 = tr_read<v_rd_off(D0, 3, 1)>(vb);
  asm volatile("s_waitcnt lgkmcnt(0)" ::: "memory"); SBAR();
#define PK(L, H) (bf16x8){L[0], L[1], L[2], L[3], H[0], H[1], H[2], H[3]}
  od = __builtin_amdgcn_mfma_f32_32x32x16_bf16(pa0, PK(l0, h0), od, 0, 0, 0);
  od = __builtin_amdgcn_mfma_f32_32x32x16_bf16(pa1, PK(l1, h1), od, 0, 0, 0);
  od = __builtin_amdgcn_mfma_f32_32x32x16_bf16(pa2, PK(l2, h2), od, 0, 0, 0);
  od = __builtin_amdgcn_mfma_f32_32x32x16_bf16(pa3, PK(l3, h3), od, 0, 0, 0);
#undef PK
}
__device__ __forceinline__ void pv_d0(f32x16* o, int vb, bf16x8 pa0, bf16x8 pa1, bf16x8 pa2, bf16x8 pa3) {
  pv_one<0>(o[0], vb, pa0, pa1, pa2, pa3); pv_one<1>(o[1], vb, pa0, pa1, pa2, pa3); pv_one<2>(o[2], vb, pa0, pa1, pa2, pa3); pv_one<3>(o[3], vb, pa0, pa1, pa2, pa3);
}
__device__ __forceinline__ void attn_dense_body(const bf16_t* __restrict__ Qb, const bf16_t* __restrict__ Kh, const bf16_t* __restrict__ Vh,
                                                const bf16_t* __restrict__ Gb, bf16_t* __restrict__ Yb, int seq, char* lds, const int wid) {
  const int lane = lane_id_opaque(), tid = wid * 64 + lane, r32 = lane & 31, hi = lane >> 5;
  bf16_t* V_lds = (bf16_t*)lds; bf16_t* K_lds = (bf16_t*)(lds + 2 * SHM_V);
  float* ws = (float*)(lds + 2 * SHM_V + 2 * SHM_K) + wid * 64; float* li_l = ws; float* al_l = ws + 32;
  float m_reg = -1e30f, l_reg = 0; f32x16 o[4] = {}; bf16x8 qr[8];
  const bf16_t* Qw = Qb + (long)(wid * QBLK + r32) * LDQ + hi * 8;
#pragma unroll
  for (int d0 = 0; d0 < 8; ++d0) qr[d0] = __builtin_nontemporal_load(reinterpret_cast<const bf16x8*>(Qw + d0 * 16));
  const int sr = tid >> 4, sc = (tid & 15) * 8, vst0 = v_st(sr, sc), vst1 = v_st(32 + sr, sc);
  const int vb0 = (int)(uintptr_t)V_lds + v_rd_base(lane);
  struct { bf16x8 vs0, vs1, ks0, ks1; } sr_[2];
#define SLOAD(i, k0) do { sr_[i].vs0 = *reinterpret_cast<const bf16x8*>(&Vh[(long)((k0) + sr) * LDK + sc]); sr_[i].vs1 = *reinterpret_cast<const bf16x8*>(&Vh[(long)((k0) + 32 + sr) * LDK + sc]); \
    sr_[i].ks0 = *reinterpret_cast<const bf16x8*>(&Kh[(long)((k0) + sr) * LDK + sc]); sr_[i].ks1 = *reinterpret_cast<const bf16x8*>(&Kh[(long)((k0) + 32 + sr) * LDK + sc]); } while (0)
#define SWRITE(b, i) do { *(bf16x8*)((char*)V_lds + (b) * SHM_V + vst0) = sr_[i].vs0;          \
    *(bf16x8*)((char*)V_lds + (b) * SHM_V + vst1) = sr_[i].vs1; int kc = sc * 2;               \
    *(bf16x8*)((char*)K_lds + (b) * SHM_K + KSWZ(sr, kc)) = sr_[i].ks0;                       \
    *(bf16x8*)((char*)K_lds + (b) * SHM_K + KSWZ(32 + sr, kc)) = sr_[i].ks1; } while (0)
#define SWAIT() asm volatile("s_waitcnt vmcnt(4)" ::: "memory")
#define RESC(a) do { if (__any((a) < 1.f)) { if (hi == 0) al_l[r32] = (a); asm volatile("s_waitcnt lgkmcnt(0)" ::: "memory"); \
    for (int d = 0; d < 4; ++d) for (int r = 0; r < 16; ++r) o[d][r] *= al_l[crow(r, hi)]; } } while (0)
  f32x16 pA0, pA1, pB0, pB1; float mnA, mnB, alA, alB; bf16x8 pa0, pa1, pa2, pa3; const int NT = seq / KVBLK;
  constexpr int SE = 0, SO = 1;
  SLOAD(SE, 0); asm volatile("s_waitcnt vmcnt(0)" ::: "memory"); SWRITE(0, SE); __syncthreads();
  qkt(pA0, pA1, K_lds, qr, r32, hi); partialSM(pA0, pA1, m_reg, mnA, alA);
  SLOAD(SO, KVBLK); if (2 < NT) SLOAD(SE, 2 * KVBLK);
  SWAIT(); SWRITE(1, SO); __syncthreads();
  for (int j = 1; j + 1 < NT; j += 2) {
    SBAR(); qkt(pB0, pB1, (bf16_t*)((char*)K_lds + SHM_K), qr, r32, hi);
    finishSM(pA0, pA1, alA, l_reg, pa0, pa1, pa2, pa3); SBAR();
    SLOAD(SO, (j + 2) * KVBLK); SBAR();
    pv_d0(o, vb0, pa0, pa1, pa2, pa3); partialSM(pB0, pB1, m_reg, mnB, alB);
    __syncthreads(); SWAIT(); SWRITE(0, SE);
    RESC(alB); __syncthreads();
    SBAR(); qkt(pA0, pA1, K_lds, qr, r32, hi);
    finishSM(pB0, pB1, alB, l_reg, pa0, pa1, pa2, pa3); SBAR();
    if (j + 3 < NT) SLOAD(SE, (j + 3) * KVBLK); SBAR();
    pv_d0(o, vb0 + (int)SHM_V, pa0, pa1, pa2, pa3); partialSM(pA0, pA1, m_reg, mnA, alA);
    __syncthreads(); SWAIT(); SWRITE(1, SO);
    RESC(alA); __syncthreads();
  }
  SBAR(); qkt(pB0, pB1, (bf16_t*)((char*)K_lds + SHM_K), qr, r32, hi);
  finishSM(pA0, pA1, alA, l_reg, pa0, pa1, pa2, pa3); SBAR();
  pv_d0(o, vb0, pa0, pa1, pa2, pa3); partialSM(pB0, pB1, m_reg, mnB, alB);
  __syncthreads(); RESC(alB);
  finishSM(pB0, pB1, alB, l_reg, pa0, pa1, pa2, pa3); SBAR();
  pv_d0(o, vb0 + (int)SHM_V, pa0, pa1, pa2, pa3);
  if (hi == 0) li_l[r32] = l_reg; asm volatile("s_waitcnt lgkmcnt(0)" ::: "memory");
  float rli[16];
#pragma unroll
  for (int r = 0; r < 16; ++r) rli[r] = __builtin_amdgcn_rcpf(li_l[crow(r, hi)]);
  bf16_t* Yw = Yb + (long)(wid * QBLK) * DM; const bf16_t* Gw = Gb + (long)(wid * QBLK) * DATT;
  __syncthreads();
  bf16_t* stg = (bf16_t*)(lds + wid * 8192);
#pragma unroll
  for (int r = 0; r < 16; ++r) { const int orow = crow(r, hi);
#pragma unroll
    for (int d0 = 0; d0 < 4; ++d0) stg[orow * 128 + d0 * 32 + r32] = (bf16_t)f2bf(o[d0][r] * rli[r]); }
  asm volatile("s_waitcnt lgkmcnt(0)" ::: "memory");
  const int l2 = lane_id_opaque();
#pragma unroll
  for (int i = 0; i < 8; ++i) { const int q = l2 + 64 * i, row = q >> 4, c8 = (q & 15) * 8;
    const u32x4 v = *(const u32x4*)(stg + row * 128 + c8); const u32x4 gg = __builtin_nontemporal_load((const u32x4*)(Gw + (unsigned)(row * DATT + c8)));
    u32x4 w; w.x = pk2(bflo(v.x) * bflo(gg.x), bfhi(v.x) * bfhi(gg.x)); w.y = pk2(bflo(v.y) * bflo(gg.y), bfhi(v.y) * bfhi(gg.y));
    w.z = pk2(bflo(v.z) * bflo(gg.z), bfhi(v.z) * bfhi(gg.z)); w.w = pk2(bflo(v.w) * bflo(gg.w), bfhi(v.w) * bfhi(gg.w));
    *(u32x4*)(Yw + (unsigned)(row * DM + c8)) = w; }
  __syncthreads();
#undef SLOAD
#undef SWRITE
#undef SWAIT
#undef RESC
}
#undef SBAR
}

__device__ __forceinline__ void p0_transpose_item(const float* W, int K, int N, bf16_t* WT, int wt_row0, const float* kscale, LAS float* scr, int k0, int n0, int lane) {
#pragma unroll
    for (int i = 0; i < 32; ++i) { const int kk = 2 * i + (lane >> 5); float v = W[(size_t)(k0 + kk) * N + n0 + (lane & 31)]; if (kscale) v *= kscale[k0 + kk]; scr[kk * 33 + (lane & 31)] = v; }
    LDS_WAIT(); asm volatile("" ::: "memory");
    const int c = lane & 7;
#pragma unroll
    for (int j = 0; j < 4; ++j) { const int n = (lane >> 3) + 8 * j; const LAS float* s = scr + (8 * c) * 33 + n;
        u32x4 o; o.x = pk2(s[0 * 33], s[1 * 33]); o.y = pk2(s[2 * 33], s[3 * 33]); o.z = pk2(s[4 * 33], s[5 * 33]); o.w = pk2(s[6 * 33], s[7 * 33]);
        *(u32x4*)(WT + (size_t)(wt_row0 + n) * K + k0 + 8 * c) = o; }
    LDS_WAIT(); asm volatile("" ::: "memory");
}

struct TrItem { const float* W; bf16_t* WT; const float* kscale; int K, N, wt_row0, k0, n0; };
__device__ __forceinline__ void p0_tr_load(const TrItem& d, float (&v)[32], int lane) {
#pragma unroll
    for (int i = 0; i < 32; ++i) { const int kk = 2 * i + (lane >> 5); v[i] = __builtin_nontemporal_load(d.W + (size_t)(d.k0 + kk) * d.N + d.n0 + (lane & 31)); }
    if (d.kscale) {
#pragma unroll
        for (int i = 0; i < 32; ++i) { const int kk = 2 * i + (lane >> 5); v[i] *= d.kscale[d.k0 + kk]; } }
}
__device__ __forceinline__ void p0_tr_store(const TrItem& d, const float (&v)[32], LAS float* scr, int lane) {
#pragma unroll
    for (int i = 0; i < 32; ++i) { const int kk = 2 * i + (lane >> 5); scr[kk * 33 + (lane & 31)] = v[i]; }
    LDS_WAIT(); asm volatile("" ::: "memory");
    const int c = lane & 7;
#pragma unroll
    for (int j = 0; j < 4; ++j) { const int n = (lane >> 3) + 8 * j; const LAS float* s = scr + (8 * c) * 33 + n;
        u32x4 o; o.x = pk2(s[0 * 33], s[1 * 33]); o.y = pk2(s[2 * 33], s[3 * 33]); o.z = pk2(s[4 * 33], s[5 * 33]); o.w = pk2(s[6 * 33], s[7 * 33]);
        *(u32x4*)(d.WT + (size_t)(d.wt_row0 + n) * d.K + d.k0 + 8 * c) = o; }
    LDS_WAIT(); asm volatile("" ::: "memory");
}
__device__ __forceinline__ void ssm_tables(const Args& a, int g, LAS unsigned char* lds, int tid) {
    LAS float* LD = (LAS float*)lds;
    LAS float* LBs = LD + 256;
    LAS float* BB = LBs + 256;
    LAS float* KT = BB + 4096;
    LAS float* CC = KT + 8192;
    float* lb16 = (float*)(a.ws + WS_LB16);
    bf16_t* WIN = (bf16_t*)(a.ws + WS_WIN) + (size_t)g * 256 * 256;
    bf16_t* WBIG = (bf16_t*)(a.ws + WS_WBIG) + (size_t)g * 256 * 512;
    for (int e = tid; e < 2048; e += 512) { const int d = e >> 10, r = e & 1023; const size_t ci_ = (size_t)(d * NG + g) * 1024 + r; CC[e * 2] = a.c_re[ci_]; CC[e * 2 + 1] = a.c_im[ci_]; }
    if (tid < 128) {
        const int d = tid >> 6, p = tid & 63; const int idx = (d * NG + g) * 64 + p;
        const float lr = fminf(a.a_re[idx], -1e-4f), li = a.a_im[idx];
        const float dt = expf(a.log_dt[d * NG + g]);
        const float er = expf(lr * dt); float sn, cs; sincosf(li * dt, &sn, &cs);
        const float br = er * cs, bi = er * sn;
        LD[tid * 2] = lr * dt; LD[tid * 2 + 1] = li * dt; LBs[tid * 2] = br; LBs[tid * 2 + 1] = bi;
        const float nr = br - 1.f, ni = bi, den = lr * lr + li * li;
        KT[tid * 2] = (nr * lr + ni * li) / den; KT[tid * 2 + 1] = (ni * lr - nr * li) / den;
        const float e16 = expf(16.f * lr * dt); float s16, c16; sincosf(16.f * li * dt, &s16, &c16);
        lb16[(g * 128 + tid) * 2] = e16 * c16; lb16[(g * 128 + tid) * 2 + 1] = e16 * s16;
    }
    __syncthreads();
    for (int e = tid; e < 2048; e += 512) {
        const int dp = e >> 4, h = e & 15, d = dp >> 6, p = dp & 63;
        const size_t bi_ = ((size_t)(d * NG + g) * 64 + p) * 16 + h;
        const float xr = a.b_re[bi_], xi = a.b_im[bi_], cr = KT[dp * 2], ci = KT[dp * 2 + 1];
        BB[e * 2] = cr * xr - ci * xi; BB[e * 2 + 1] = cr * xi + ci * xr;
    }
    __syncthreads();
    {
        const int d = tid >> 8, hp = (tid >> 4) & 15, h = tid & 15; float acc[16];
#pragma unroll
        for (int t = 0; t < 16; ++t) acc[t] = 0.f;
        const LAS float* cc = CC + ((d * 16 + hp) * 64) * 2;
        for (int p = 0; p < 64; ++p) {
            const float c_r = cc[p * 2], c_i = cc[p * 2 + 1], b_r = BB[((d * 64 + p) * 16 + h) * 2], b_i = BB[((d * 64 + p) * 16 + h) * 2 + 1];
            float wr = c_r * b_r - c_i * b_i, wi = c_r * b_i + c_i * b_r; const float l_r = LBs[(d * 64 + p) * 2], l_i = LBs[(d * 64 + p) * 2 + 1];
#pragma unroll
            for (int t = 0; t < 16; ++t) { acc[t] += wr; const float nr = wr * l_r - wi * l_i; wi = wr * l_i + wi * l_r; wr = nr; }
        }
#pragma unroll
        for (int t = 0; t < 16; ++t) KT[((d * 16 + t) * 16 + hp) * 16 + h] = acc[t];
    }
    __syncthreads();
    for (int q = tid; q < 8192; q += 512) {
        const int n = q >> 5, kc = q & 31, s = kc >> 1, h0 = (kc & 1) * 8, j = n >> 4, hp = n & 15;
        float v[8];
#pragma unroll
        for (int e = 0; e < 8; ++e) { const int h = h0 + e;
            if (s < j) v[e] = KT[((0 * 16 + (j - s)) * 16 + hp) * 16 + h];
            else if (s > j) v[e] = KT[((1 * 16 + (s - j)) * 16 + hp) * 16 + h];
            else v[e] = KT[((0 * 16 + 0) * 16 + hp) * 16 + h] + KT[((1 * 16 + 0) * 16 + hp) * 16 + h] + (h == hp ? a.ssm_d[g * 16 + h] : 0.f); }
        u32x4 w; w.x = pk2(v[0], v[1]); w.y = pk2(v[2], v[3]); w.z = pk2(v[4], v[5]); w.w = pk2(v[6], v[7]);
        *(u32x4*)(WBIG + (size_t)n * 512 + s * 16 + h0) = w;
    }
    for (int q = tid; q < 2048; q += 512) {
        const int p = q & 63, js = (q >> 6) & 15, d = q >> 10; const float ldr = LD[(d * 64 + p) * 2], ldi = LD[(d * 64 + p) * 2 + 1];
        {   const float pw = (float)(d == 0 ? js + 1 : 16 - js); const float er = expf(pw * ldr); float sn, cs; sincosf(pw * ldi, &sn, &cs); const float pr = er * cs, pi = er * sn;
#pragma unroll
            for (int hp = 0; hp < 16; ++hp) { const float c_r = CC[((d * 16 + hp) * 64 + p) * 2], c_i = CC[((d * 16 + hp) * 64 + p) * 2 + 1];
                *(unsigned*)(WBIG + (size_t)(js * 16 + hp) * 512 + 256 + d * 128 + 2 * p) = pk2(c_r * pr - c_i * pi, -(c_r * pi + c_i * pr)); } }
        {   const float pw = (float)(d == 0 ? 15 - js : js); const float er = expf(pw * ldr); float sn, cs; sincosf(pw * ldi, &sn, &cs); const float pr = er * cs, pi = er * sn;
            float zr[16], zi[16];
#pragma unroll
            for (int h = 0; h < 16; ++h) { const float b_r = BB[((d * 64 + p) * 16 + h) * 2], b_i = BB[((d * 64 + p) * 16 + h) * 2 + 1]; zr[h] = pr * b_r - pi * b_i; zi[h] = pr * b_i + pi * b_r; }
            bf16_t* d0 = WIN + (size_t)(d * 128 + p) * 256 + js * 16; bf16_t* d1 = d0 + (size_t)64 * 256;
            u32x4 w; w.x = pk2(zr[0], zr[1]); w.y = pk2(zr[2], zr[3]); w.z = pk2(zr[4], zr[5]); w.w = pk2(zr[6], zr[7]); *(u32x4*)d0 = w;
            w.x = pk2(zr[8], zr[9]); w.y = pk2(zr[10], zr[11]); w.z = pk2(zr[12], zr[13]); w.w = pk2(zr[14], zr[15]); *(u32x4*)(d0 + 8) = w;
            w.x = pk2(zi[0], zi[1]); w.y = pk2(zi[2], zi[3]); w.z = pk2(zi[4], zi[5]); w.w = pk2(zi[6], zi[7]); *(u32x4*)d1 = w;
            w.x = pk2(zi[8], zi[9]); w.y = pk2(zi[10], zi[11]); w.z = pk2(zi[12], zi[13]); w.w = pk2(zi[14], zi[15]); *(u32x4*)(d1 + 8) = w; }
    }
    __syncthreads();
}

#define XB_TMO      128
#define XB_XCNT(j)  (256  + 64 * (j))
#define XB_XSUB(j)  (1280 + 64 * (j))
#define XB_XGEN(j)  (2304 + 64 * (j))
#define XB_TOP      3328
#define XB_TOPGEN   3392
#define XCD_BAR_WORDS 3456
#define XB_SPIN_CAP (1u << 18)
__device__ __forceinline__ unsigned xb_ld(unsigned* p)              { return __hip_atomic_load(p, __ATOMIC_RELAXED, __HIP_MEMORY_SCOPE_AGENT); }
__device__ __forceinline__ unsigned xb_add(unsigned* p, unsigned v) { return __hip_atomic_fetch_add(p, v, __ATOMIC_RELAXED, __HIP_MEMORY_SCOPE_AGENT); }
__device__ __forceinline__ unsigned xb_xcc_id() { return (unsigned)__builtin_amdgcn_s_getreg((3 << 11) | 20) & 0xFu; }
#define XB_SPIN(cond, bar) do { unsigned _sp = 0; while (cond) { __builtin_amdgcn_s_sleep(1); \
    if ((++_sp & 255u) == 0u) { if (xb_ld(&(bar)[XB_TMO])) break; if (_sp > XB_SPIN_CAP) { atomicAdd(&(bar)[XB_TMO], 1u); break; } } } } while (0)
struct XcdBarrier { unsigned* bar; unsigned x; volatile LAS unsigned* st; };
__device__ __forceinline__ XcdBarrier xcd_barrier_post(unsigned* bar, volatile LAS unsigned* st, bool leader) {
    XcdBarrier b; b.bar = bar; b.x = xb_xcc_id(); b.st = st;
    if (leader) (void)xb_add(&bar[XB_XCNT(b.x)], 1u);
    return b;
}
__device__ __forceinline__ void xcd_barrier_complete(unsigned* bar, unsigned x, unsigned& nloc, unsigned& nx) {
    const unsigned G = gridDim.x * gridDim.y * gridDim.z;
    unsigned sum, cnt, mine, sp = 0u;
    for (;;) {
        sum = 0u; cnt = 0u; mine = 0u;
#pragma unroll
        for (unsigned j = 0; j < 16; ++j) { const unsigned c = xb_ld(&bar[XB_XCNT(j)]); sum += c; cnt += (c > 0u) ? 1u : 0u; mine = (j == x) ? c : mine; }
        if (sum == G) break;
        __builtin_amdgcn_s_sleep(1);
        if ((++sp & 255u) == 0u) { if (xb_ld(&bar[XB_TMO])) break; if (sp > XB_SPIN_CAP) { atomicAdd(&bar[XB_TMO], 1u); break; } }
    }
    nloc = mine > 0u ? mine : 1u; nx = cnt > 0u ? cnt : 1u;
}
__device__ __forceinline__ void xcd_barrier(const XcdBarrier& b, bool leader) {
    asm volatile("s_waitcnt vmcnt(0)" ::: "memory");
    __syncthreads();
    if (leader) {
        unsigned* bar = b.bar;
        __builtin_amdgcn_s_waitcnt(0);
        unsigned nloc = b.st[0], nx = b.st[1];
        if (nloc == 0u) { xcd_barrier_complete(bar, b.x, nloc, nx); b.st[0] = nloc; b.st[1] = nx; }
        const unsigned old = xb_add(&bar[XB_XSUB(b.x)], 1u);
        const unsigned gen = old / nloc;
        if (old + 1u == (gen + 1u) * nloc) {
            __builtin_amdgcn_fence(__ATOMIC_RELEASE, "agent");
            asm volatile("s_waitcnt vmcnt(0)" ::: "memory");
            const unsigned og = xb_add(&bar[XB_TOP], 1u);
            const unsigned tg = og / nx;
            if (og + 1u == (tg + 1u) * nx) xb_add(&bar[XB_TOPGEN], 1u);
            else XB_SPIN(xb_ld(&bar[XB_TOPGEN]) == tg, bar);
            __builtin_amdgcn_fence(__ATOMIC_ACQUIRE, "agent");
            xb_add(&bar[XB_XGEN(b.x)], 1u);
            asm volatile("s_waitcnt vmcnt(0)" ::: "memory");
        } else {
            XB_SPIN(xb_ld(&bar[XB_XGEN(b.x)]) == gen, bar);
            __builtin_amdgcn_fence(__ATOMIC_ACQUIRE, "agent");
            asm volatile("s_waitcnt vmcnt(0)" ::: "memory");
        }
    }
    __syncthreads();
}

__global__ void __launch_bounds__(512, 2) fwd_kernel(Args a) {
    extern __shared__ __attribute__((aligned(16))) unsigned char lds_raw[];
    LAS unsigned char* lds = (LAS unsigned char*)lds_raw;
    cg::grid_group grid = cg::this_grid();
    const int wave = __builtin_amdgcn_readfirstlane(threadIdx.x >> 6);
    const bool leader = (wave == 0) && (lane_id_opaque() == 0);
    volatile LAS unsigned* xst = (volatile LAS unsigned*)(lds + XBST_OFF);
    if (leader) { xst[0] = 0u; xst[1] = 0u; }
    __syncthreads();
    if (a.ws == nullptr) grid.sync();
    const XcdBarrier xbar = xcd_barrier_post((unsigned*)(a.ws + WS_BAR), xst, leader);
#define GRID_SYNC() xcd_barrier(xbar, (wave == 0) && (lane_id_opaque() == 0))
#define LANE_IDS const int lane = lane_id_opaque(), tid = wave * 64 + lane; (void)tid;
    const int G = gridDim.x, bid = blockIdx.x;
    unsigned char* ws = a.ws;
    bf16_t* W1T = (bf16_t*)(ws + WS_W1T); bf16_t* WGLUT = (bf16_t*)(ws + WS_WGLUT); bf16_t* WOT = (bf16_t*)(ws + WS_WOT); bf16_t* WGT = (bf16_t*)(ws + WS_WGT); bf16_t* WPT = (bf16_t*)(ws + WS_WPT);
    float2* ROPE = (float2*)(ws + WS_ROPE); float* RINV = (float*)(ws + WS_RINV); float* LB16 = (float*)(ws + WS_LB16); float* SSQ1 = (float*)(ws + WS_SSQ1); float* SSQ2 = (float*)(ws + WS_SSQ2);
    bf16_t* PB = (bf16_t*)(ws + WS_PB); bf16_t* WIN = (bf16_t*)(ws + WS_WIN); bf16_t* WBIG = (bf16_t*)(ws + WS_WBIG);
    bf16_t* XB = (bf16_t*)(ws + WS_XB); bf16_t* HB = (bf16_t*)(ws + WS_XB);
    bf16_t* Q = (bf16_t*)(ws + WS_Q); bf16_t* KB = (bf16_t*)(ws + WS_K); bf16_t* VB = (bf16_t*)(ws + WS_V); bf16_t* GA = (bf16_t*)(ws + WS_GA); bf16_t* GS = (bf16_t*)(ws + WS_GS);
    bf16_t* UCAT = (bf16_t*)(ws + WS_UCAT); bf16_t* PPB = (bf16_t*)(ws + WS_UCAT); bf16_t* YMIX = (bf16_t*)(ws + WS_YMIX); bf16_t* YS = (bf16_t*)(ws + WS_YS);

#pragma unroll
    for (int rep_ = 0; rep_ < 1 + ((REP_MASK >> 0) & 1); ++rep_) { LANE_IDS
        const int gw = bid * 8 + wave, NGW = G * 8;
        LAS float* scr = (LAS float*)(lds + wave * 16384);
        constexpr int I1 = 32 * 144, I2 = 16 * 64, I3 = 32 * 64, I4 = 32 * 64, I5 = 4 * 64, NIT = I1 + I2 + I3 + I4 + I5;
        auto item_desc = [&](int r) -> TrItem {
            if (r < I1) { const int kb = r / 144, lgg = r % 144, pn = lgg >> 3, lg = lgg & 7, wtg = pn * 8 + 4 * (lg & 1) + 2 * (lg >> 2) + ((lg >> 1) & 1);
                return TrItem{a.w_in, W1T, a.norm_mix, DM, DIN, wtg * 32, kb * 64, lgg * 32}; } r -= I1;
            if (r < I2) { const int kb = r / 64, lgg = r % 64, l2 = lgg & 31, wtg = (l2 >> 2) * 8 + 4 * (lgg >> 5) + (l2 & 3);
                return TrItem{a.w_glu, WGLUT, nullptr, DSSM, 2 * DSSM, wtg * 32, kb * 64, lgg * 32}; } r -= I2;
            if (r < I3) { const int kb = r / 64, lgg = r % 64; return TrItem{a.w_out, WOT, nullptr, DM, DM, lgg * 32, kb * 64, lgg * 32}; } r -= I3;
            if (r < I4) { const int kb = r / 64, lgg = r % 64; return TrItem{a.w_ple_gate, WGT, a.norm_ple, DM, DM, lgg * 32, kb * 64, lgg * 32}; } r -= I4;
            const int kb = r / 64, lgg = r % 64; return TrItem{a.w_ple_proj, WPT, nullptr, PLE, DM, lgg * 32, kb * 64, lgg * 32};
        };
#pragma unroll
        for (int rq_ = 0; rq_ < 1 + ((REP_MASK >> 8) & 1); ++rq_)
        for (int it = gw; it < NIT; it += 2 * NGW) {
            const bool two = it + NGW < NIT;
            const TrItem dA = item_desc(it), dB = item_desc(two ? it + NGW : it);
            float vA[32], vB[32];
            p0_tr_load(dA, vA, lane); if (two) p0_tr_load(dB, vB, lane);
            p0_tr_store(dA, vA, scr, lane); if (two) p0_tr_store(dB, vB, scr, lane);
        }
#pragma unroll
        for (int rq_ = 0; rq_ < 1 + ((REP_MASK >> 9) & 1); ++rq_)
        for (int m = gw; m < T; m += 2 * NGW) {
            const int m2 = m + NGW; const bool two = m2 < T;
            const f32x4* xr = (const f32x4*)(a.x + (size_t)m * DM) + lane; const f32x4* xr2 = (const f32x4*)(a.x + (size_t)(two ? m2 : m) * DM) + lane;
            f32x4 v[8], w2[8]; float s = 0.f, s2 = 0.f;
#pragma unroll
            for (int j = 0; j < 8; ++j) v[j] = __builtin_nontemporal_load(xr + 64 * j);
#pragma unroll
            for (int j = 0; j < 8; ++j) w2[j] = __builtin_nontemporal_load(xr2 + 64 * j);
#pragma unroll
            for (int j = 0; j < 8; ++j) { s += (v[j][0] * v[j][0] + v[j][1] * v[j][1]) + (v[j][2] * v[j][2] + v[j][3] * v[j][3]); s2 += (w2[j][0] * w2[j][0] + w2[j][1] * w2[j][1]) + (w2[j][2] * w2[j][2] + w2[j][3] * w2[j][3]); }
            s = wave_sum(s); s2 = wave_sum(s2);
            if (lane == 0) { RINV[m] = rsqrtf(s * (1.f / DM) + EPS); if (two) RINV[m2] = rsqrtf(s2 * (1.f / DM) + EPS); }
            u32x2* o = (u32x2*)(XB + (size_t)m * DM) + lane; u32x2* o2 = (u32x2*)(XB + (size_t)m2 * DM) + lane;
#pragma unroll
            for (int j = 0; j < 8; ++j) { u32x2 w; w.x = pk2(v[j][0], v[j][1]); w.y = pk2(v[j][2], v[j][3]); o[64 * j] = w; }
            if (two) {
#pragma unroll
                for (int j = 0; j < 8; ++j) { u32x2 w; w.x = pk2(w2[j][0], w2[j][1]); w.y = pk2(w2[j][2], w2[j][3]); o2[64 * j] = w; } }
        }
        for (int i = bid * 512 + tid; i < T * PLE / 4; i += G * 512) { const f32x4 v = __builtin_nontemporal_load((const f32x4*)a.p + i); u32x2 w; w.x = pk2(v[0], v[1]); w.y = pk2(v[2], v[3]); ((u32x2*)PB)[i] = w; }
        for (int i = bid * 512 + tid; i < 2048; i += G * 512) { const int pos = i >> 5, f = i & 31; const float inv = powf(10000.f, -(float)f / 32.f); float sn, cs; sincosf((float)pos * inv, &sn, &cs); ROPE[i] = make_float2(cs, sn); }
    GRID_SYNC(); }


    if constexpr ((REP_MASK >> 10) & 1) { GRID_SYNC(); GRID_SYNC(); GRID_SYNC(); GRID_SYNC(); }
#pragma unroll
    for (int rep_ = 0; rep_ < 1 + ((REP_MASK >> 1) & 1); ++rep_) { LANE_IDS
        { pg8::Gemm g{XB, W1T, DM, DM, DM, 0, 0}; pg8::StaticOrder S; S.init(T, 14 * 256, G, bid);
          pg8::Epi1 E{RINV, a.q_norm, a.k_norm, ROPE, Q, KB, VB, GA, GS, UCAT, (LAS float*)(lds + XCH_OFF), 0};
          pg8::gemm_phase<pg8::Epi1, pg8::StaticOrder, true>(lds, g, S, E, wave); }
        __syncthreads();
        for (int gi = bid - (G - NG); gi >= 0 && gi < NG; gi += NG) ssm_tables(a, gi, lds, tid);
    GRID_SYNC(); }

#pragma unroll
    for (int rep_ = 0; rep_ < 1 + ((REP_MASK >> 2) & 1); ++rep_) {
#pragma unroll
        for (int rq_ = 0; rq_ < 2; ++rq_) {
        if (bid < 2 * NG) { if (rq_ == 1 && !((REP_MASK >> 6) & 1)) break;
            pg8::BatchOrder S{2 * NG, G, bid};
            { pg8::Gemm g{UCAT, WIN, 256, 512, 256, (size_t)NCH * 512 * 2, (size_t)256 * 256 * 2};
              pg8::EpiS1 E{LB16, UCAT}; pg8::gemm_phase<pg8::EpiS1, pg8::BatchOrder, true>(lds, g, S, E, wave); }
            asm volatile("s_waitcnt vmcnt(0)\n\tbuffer_inv sc1\n\ts_waitcnt vmcnt(0)" ::: "memory"); __syncthreads();
            { pg8::Gemm g{UCAT, WBIG, 512, 512, 512, (size_t)NCH * 512 * 2, (size_t)256 * 512 * 2};
              pg8::EpiS2 E{YS}; pg8::gemm_phase<pg8::EpiS2, pg8::BatchOrder, true>(lds, g, S, E, wave); }
        } else { if (rq_ == 1 && !((REP_MASK >> 11) & 1)) break;
            pg8::Gemm g{XB, W1T + (size_t)14 * 256 * DM, DM, DM, DM, 0, 0}; pg8::ListOrder S{bid - 2 * NG, 128, G};
            pg8::Epi1 E{RINV, a.q_norm, a.k_norm, ROPE, Q, KB, VB, GA, GS, UCAT, (LAS float*)(lds + XCH_OFF), 14};
            pg8::gemm_phase<pg8::Epi1, pg8::ListOrder, true>(lds, g, S, E, wave);
        }
        __syncthreads(); }
#pragma unroll
        for (int rq_ = 0; rq_ < 1 + ((REP_MASK >> 7) & 1); ++rq_)
        for (int un = bid; un < 256; un += G) {
            const int x = un & 7, jj = un >> 3, b = x >> 2, kvh = (x >> 1) & 1, idx = (x & 1) * 32 + jj, h = kvh * 4 + (idx >> 4), qb = idx & 15;
            const size_t tok0 = (size_t)b * SEQ + qb * 256;
            att::attn_dense_body(Q + tok0 * DATT + h * 128, KB + (size_t)b * SEQ * DKV + kvh * 128, VB + (size_t)b * SEQ * DKV + kvh * 128,
                                 GA + tok0 * DATT + h * 128, YMIX + tok0 * DM + h * 128, SEQ, (char*)lds_raw, wave);
        }
    GRID_SYNC(); }

#pragma unroll
    for (int rep_ = 0; rep_ < 1 + ((REP_MASK >> 3) & 1); ++rep_) {
        { pg8::Gemm g{YS, WGLUT, DSSM, DSSM, DSSM, 0, 0}; pg8::StaticOrder S; S.init(T, 2 * DSSM, G, bid);
          pg8::EpiGlu E{a.b_glu, GS, YMIX}; pg8::gemm_phase<pg8::EpiGlu, pg8::StaticOrder, true>(lds, g, S, E, wave); }
        __syncthreads();
        { pg8::Gemm g{PB, WPT, PLE, PLE, PLE, 0, 0}; pg8::StaticOrder S; S.init(T, DM, G, bid);
          pg8::EpiBf E{PPB, DM}; pg8::gemm_phase<pg8::EpiBf, pg8::StaticOrder, true>(lds, g, S, E, wave); }
    GRID_SYNC(); }


#pragma unroll
    for (int rep_ = 0; rep_ < 1 + ((REP_MASK >> 4) & 1); ++rep_) {
        pg8::Gemm g{YMIX, WOT, DM, DM, DM, 0, 0}; pg8::StaticOrder S; S.init(T, DM, G, bid);
        pg8::EpiOut E{a.x, a.out, HB, SSQ1}; pg8::gemm_phase<pg8::EpiOut, pg8::StaticOrder, true>(lds, g, S, E, wave);
    GRID_SYNC(); }


    { LANE_IDS
        pg8::StaticOrder S; S.init(T, DM, G, bid); pg8::Unit u0;
        LAS float* r2 = (LAS float*)(lds + R2_OFF);
        if (S.next(0, u0) && tid < 256) { const float* sp = SSQ1 + (size_t)(u0.pm * 256 + tid) * 32; float s = 0.f;
#pragma unroll
            for (int i = 0; i < 8; ++i) { const f32x4 v = ((const f32x4*)sp)[i]; s += (v[0] + v[1]) + (v[2] + v[3]); }
            r2[tid] = rsqrtf(s * (1.f / DM) + EPS); }
        __syncthreads();
        pg8::Gemm g{HB, WGT, DM, DM, DM, 0, 0};
        pg8::EpiGate E{a.out, PPB, SSQ2, (unsigned*)ws, a.norm_final, r2, HB}; pg8::gemm_phase<pg8::EpiGate, pg8::StaticOrder, true>(lds, g, S, E, wave);
    }
}

extern "C" void kernel_launch(void* const* d_in, const int* in_sizes, int n_in, void* d_out, int out_size, void* d_ws, size_t ws_size, hipStream_t stream) {
    static int grid = 0;
    if (grid == 0) {
        if (n_in != 21 || in_sizes[0] != T * DM || out_size != T * DM || ws_size < WS_END) { fprintf(stderr, "kernel_launch: unexpected shapes (n_in %d, in0 %d, out %d, ws %zu)\n", n_in, n_in > 0 ? in_sizes[0] : -1, out_size, ws_size); grid = -1; return; }
        int dev = 0, cus = 0, per_cu = 0;
        hipGetDevice(&dev); hipDeviceGetAttribute(&cus, hipDeviceAttributeMultiprocessorCount, dev);
        if (hipFuncSetAttribute((const void*)fwd_kernel, hipFuncAttributeMaxDynamicSharedMemorySize, LDS_BYTES) != hipSuccess) { fprintf(stderr, "kernel_launch: hipFuncSetAttribute failed\n"); grid = -1; return; }
        hipOccupancyMaxActiveBlocksPerMultiprocessor(&per_cu, (const void*)fwd_kernel, 512, LDS_BYTES);
        (void)hipGetLastError();
        if (per_cu < 1) fprintf(stderr, "kernel_launch: occupancy query reports %d blocks per CU\n", per_cu);
        grid = cus > 256 ? 256 : cus;
    }
    if (grid < 0) return;
    Args a{};
    const float** f = (const float**)&a;
    for (int i = 0; i < 21; ++i) f[i] = (const float*)d_in[i];
    a.out = (float*)d_out; a.ws = (unsigned char*)d_ws;
    if (hipMemsetAsync(d_ws, 0, WS_CTL_BYTES, stream) != hipSuccess) { fprintf(stderr, "kernel_launch: hipMemsetAsync failed\n"); return; }
    void* args[] = {&a};
    hipError_t e = hipLaunchCooperativeKernel((const void*)fwd_kernel, dim3(grid), dim3(512), args, LDS_BYTES, stream);
    if (e != hipSuccess) fprintf(stderr, "kernel_launch: cooperative launch failed: %s (grid %d)\n", hipGetErrorString(e), grid);
}
```

```cpp
#include <hip/hip_runtime.h>
#include <hip/hip_cooperative_groups.h>
#include <cstdio>
#include <cstdint>
namespace cg = cooperative_groups;

#define LAS __attribute__((address_space(3)))
typedef unsigned short bf16_t;
typedef short bf16x8 __attribute__((ext_vector_type(8)));
typedef short s16x4 __attribute__((ext_vector_type(4)));
typedef float f32x4 __attribute__((ext_vector_type(4)));
typedef float f32x16 __attribute__((ext_vector_type(16)));
typedef unsigned u32x4 __attribute__((ext_vector_type(4)));
typedef unsigned u32x2 __attribute__((ext_vector_type(2)));

constexpr int T = 8192, SEQ = 4096, DM = 2048, DIN = 4608, DATT = 1024, DKV = 256, DSSM = 1024, PLE = 256;
constexpr int NG = 64, NCH = T / 16;
constexpr float EPS = 1e-6f;
#ifndef PH_MASK
#define PH_MASK 0xff
#endif
#ifndef GLDS_AUX
#define GLDS_AUX 0
#endif
#ifndef REP_MASK
#define REP_MASK 0
#endif

constexpr size_t MiB = 1u << 20;
constexpr size_t WS_W1T = 1 * MiB, WS_WGLUT = 19 * MiB, WS_WOT = 23 * MiB, WS_WGT = 31 * MiB, WS_WPT = 39 * MiB;
constexpr size_t WS_ROPE = 40 * MiB, WS_RINV = 40 * MiB + 65536, WS_LB16 = 40 * MiB + 131072, WS_SSQ1 = 41 * MiB, WS_SSQ2 = 42 * MiB;
constexpr size_t WS_PB = 43 * MiB, WS_WIN = 47 * MiB, WS_WBIG = 55 * MiB;
constexpr size_t WS_XB = 71 * MiB;
constexpr size_t WS_Q = 103 * MiB, WS_K = 119 * MiB, WS_V = 123 * MiB, WS_GA = 127 * MiB, WS_GS = 143 * MiB;
constexpr size_t WS_UCAT = 159 * MiB;
constexpr size_t WS_YMIX = 191 * MiB, WS_YS = 223 * MiB, WS_END = 239 * MiB;

constexpr int RING_BYTES = 131072, XCH_OFF = RING_BYTES, R2_OFF = RING_BYTES + 4096, XBST_OFF = RING_BYTES + 8192, LDS_BYTES = 147456;
constexpr size_t WS_BAR = 65536, WS_CTL_BYTES = 131072;

struct Args {
    const float *x, *p, *norm_mix, *w_in, *q_norm, *k_norm, *a_re, *a_im, *log_dt, *b_re, *b_im, *c_re, *c_im, *ssm_d, *w_glu, *b_glu, *w_out, *norm_ple, *w_ple_gate, *w_ple_proj, *norm_final;
    float* out; unsigned char* ws;
};

typedef __bf16 bf16s_;
__device__ __forceinline__ unsigned f2bf(float f) { return (unsigned)__builtin_bit_cast(unsigned short, (bf16s_)f); }
typedef float f32x2_ __attribute__((ext_vector_type(2)));
typedef __bf16 bf16x2_ __attribute__((ext_vector_type(2)));
__device__ __forceinline__ unsigned pk2(float lo, float hi) { const f32x2_ v = {lo, hi}; return __builtin_bit_cast(unsigned, __builtin_convertvector(v, bf16x2_)); }
__device__ __forceinline__ float bf2f(unsigned short b) { return __builtin_bit_cast(float, (unsigned)b << 16); }
__device__ __forceinline__ float bflo(unsigned w) { return __builtin_bit_cast(float, w << 16); }
__device__ __forceinline__ float bfhi(unsigned w) { return __builtin_bit_cast(float, w & 0xffff0000u); }
__device__ __forceinline__ unsigned cvt_pk_bf16(float lo, float hi) { unsigned r; asm volatile("v_cvt_pk_bf16_f32 %0, %1, %2" : "=v"(r) : "v"(lo), "v"(hi)); return r; }
__device__ __forceinline__ float sigmoidf_(float v) { return __builtin_amdgcn_rcpf(1.f + __builtin_amdgcn_exp2f(-1.4426950408889634f * v)); }
__device__ __forceinline__ float siluf_(float v) { return v * __builtin_amdgcn_rcpf(1.f + __builtin_amdgcn_exp2f(-1.4426950408889634f * v)); }
__device__ __forceinline__ float gelu_tanh(float v) { const float t = (-1.5957691216057308f * 1.4426950408889634f) * (v + 0.044715f * v * v * v); return v * __builtin_amdgcn_rcpf(1.f + __builtin_amdgcn_exp2f(t)); }
template <int K> __device__ __forceinline__ float swz_xor(float v) { return __int_as_float(__builtin_amdgcn_ds_swizzle(__float_as_int(v), (K << 10) | 0x1f)); }
__device__ __forceinline__ float sum_xor32(float v) { auto rr = __builtin_amdgcn_permlane32_swap(__float_as_uint(v), __float_as_uint(v), false, false); return __uint_as_float(rr[0]) + __uint_as_float(rr[1]); }
__device__ __forceinline__ float wave_sum(float v) { v += swz_xor<1>(v); v += swz_xor<2>(v); v += swz_xor<4>(v); v += swz_xor<8>(v); v += swz_xor<16>(v); return sum_xor32(v); }
#define LDS_WAIT() asm volatile("s_waitcnt lgkmcnt(0)" ::: "memory")
__device__ __forceinline__ int lane_id_opaque() { int l = __builtin_amdgcn_mbcnt_hi(~0u, __builtin_amdgcn_mbcnt_lo(~0u, 0u)); asm volatile("" : "+v"(l)); return l; }

namespace pg8 {
constexpr int BM = 256, BK = 64, HALF = 128, HTB = HALF * BK * 2, NXCD = 8, WGM = 8;
__host__ __device__ __forceinline__ int lds_byte(int r, int c) { const int st = (r >> 4) * 2 + (c >> 5), rr = r & 15, cc = c & 31, ob = rr * 64 + cc * 2; return st * 1024 + (ob ^ (((ob >> 9) & 1) << 5)); }
__host__ __device__ __forceinline__ void stage_rc(int b, int& R, int& C) { const int st = b / 1024, sb = b % 1024, swz = sb ^ (((sb >> 9) & 1) << 5); R = (st >> 1) * 16 + swz / 64; C = (st & 1) * 32 + (swz % 64) / 2; }
__host__ __device__ __forceinline__ int perm32(int rho) { const int n = rho >> 4, i = rho & 15; return 8 * (i >> 2) + 4 * n + (i & 3); }

struct Unit { int pm, pn, z; };
struct Gemm { const bf16_t* A; const bf16_t* Bt; int K, lda, ldb; size_t zA, zB; };

struct StaticOrder {
    int nM, nN, nwg, G, c;
    __device__ void init(int M, int N, int G_, int c_) { nM = M / BM; nN = N / BM; nwg = nM * nN; G = G_; c = c_; }
    __device__ bool next(int i, Unit& u) const {
        const long L = (long)i * G + c; if (L >= nwg) return false;
        int wgid = (int)L; { const int q = nwg / NXCD, r = nwg % NXCD, xcd = wgid % NXCD, off = wgid / NXCD; wgid = (xcd < r ? xcd * (q + 1) : r * (q + 1) + (xcd - r) * q) + off; }
        const int nig = WGM * nN, gid = wgid / nig, fm = gid * WGM, gsz = (nM - fm) < WGM ? (nM - fm) : WGM;
        u.pm = fm + ((wgid % nig) % gsz); u.pn = (wgid % nig) / gsz; u.z = 0; return true;
    }
};
struct BatchOrder {
    int n, G, c;
    __device__ bool next(int i, Unit& u) const { const int L = i * G + c; if (L >= n) return false; u.z = L >> 1; u.pm = L & 1; u.pn = 0; return true; }
};

struct ListOrder {
    int L0, n, stride;
    __device__ bool next(int i, Unit& u) const { const int L = L0 + i * stride; if (L < 0 || L >= n) return false;
        const int x = L & 7, j = L >> 3; u.pm = 4 * x + (j >> 2); u.pn = j & 3; u.z = 0; return true; }
};
template <class Epi, class Sched, bool ALIGN_EPI>
__device__ __forceinline__ void gemm_phase(LAS unsigned char* lds, const Gemm g, const Sched& S, const Epi& E, const int wid) {
    const int lane = lane_id_opaque(), tid = wid * 64 + lane, wr = wid >> 2, wc = wid & 3, fr = lane & 15, fq = lane >> 4;
    const int K = g.K, nt = K / BK;
    unsigned voffA[2], voffB[2];
#pragma unroll
    for (int i = 0; i < 2; ++i) { int R, C; stage_rc(tid * 16 + i * 8192, R, C); const int Rb = (R & ~31) + perm32(R & 31);
        voffA[i] = (unsigned)(R * g.lda + C) * 2u; voffB[i] = (unsigned)(Rb * g.ldb + C) * 2u; }
    const size_t kstep = (size_t)(BK * 2);
    const size_t hstepA = (size_t)HALF * g.lda * 2, hstepB = (size_t)HALF * g.ldb * 2;
    const size_t tstepA = 2 * hstepA, tstepB = 2 * hstepB;
    const unsigned ldsw = (unsigned)wid * 1024u;
    const int aoff = lds_byte(wr * 64 + fr, fq * 8), boff = lds_byte(wc * 32 + fr, fq * 8);
#define PG8_SA(b, h) (((b) * 2 + (h)) * HTB)
#define PG8_SB(b, h) ((4 + (b) * 2 + (h)) * HTB)
#define PG8_STAGE(bufoff, gbase, voff) do { _Pragma("unroll") for (int _i = 0; _i < 2; ++_i) \
        __builtin_amdgcn_global_load_lds((const unsigned*)((const char*)(gbase) + (voff)[_i]), (LAS unsigned*)(lds + (bufoff) + ldsw + _i * 8192), 16, 0, GLDS_AUX); } while (0)
#define PG8_LDA(dst, b, h) do { _Pragma("unroll") for (int m = 0; m < 4; ++m) _Pragma("unroll") for (int k = 0; k < 2; ++k) dst[m][k] = *(const LAS bf16x8*)(lds + PG8_SA(b, h) + aoff + m * 2048 + k * 1024); } while (0)
#define PG8_LDB(dst, b, h) do { _Pragma("unroll") for (int n = 0; n < 2; ++n) _Pragma("unroll") for (int k = 0; k < 2; ++k) dst[n][k] = *(const LAS bf16x8*)(lds + PG8_SB(b, h) + boff + n * 2048 + k * 1024); } while (0)
#define PG8_MMA(ai, bj, At, Bt) do { __builtin_amdgcn_s_setprio(1); _Pragma("unroll") for (int m = 0; m < 4; ++m) _Pragma("unroll") for (int n = 0; n < 2; ++n) _Pragma("unroll") for (int k = 0; k < 2; ++k) \
        acc[ai][bj][m][n] = __builtin_amdgcn_mfma_f32_16x16x32_bf16(Bt[n][k], At[m][k], acc[ai][bj][m][n], 0, 0, 0); __builtin_amdgcn_s_setprio(0); } while (0)
#define PG8_WAIT_V(n) asm volatile("s_waitcnt vmcnt(" #n ")" ::: "memory")
#define PG8_WAIT_L(n) asm volatile("s_waitcnt lgkmcnt(" #n ")" ::: "memory")
#define PG8_BAR __builtin_amdgcn_s_barrier()
#define PG8_SCHED __builtin_amdgcn_sched_barrier(0)
    Unit cur, nxt; int ui = 0;
    if (!S.next(0, cur)) return;
    f32x4 acc[2][2][4][2];
#pragma unroll
    for (int a = 0; a < 2; ++a)
#pragma unroll
        for (int b = 0; b < 2; ++b)
#pragma unroll
            for (int m = 0; m < 4; ++m)
#pragma unroll
                for (int n = 0; n < 2; ++n) acc[a][b][m][n] = (f32x4){0.f, 0.f, 0.f, 0.f};
    bf16x8 At[4][2], B0[2][2], B1[2][2];
    const char* cA = (const char*)g.A + (size_t)cur.z * g.zA + (size_t)cur.pm * tstepA; const char* cB = (const char*)g.Bt + (size_t)cur.z * g.zB + (size_t)cur.pn * tstepB;
    PG8_STAGE(PG8_SB(0, 0), cB, voffB); PG8_STAGE(PG8_SB(0, 1), cB + hstepB, voffB); PG8_STAGE(PG8_SA(0, 0), cA, voffA); PG8_STAGE(PG8_SA(0, 1), cA + hstepA, voffA);
    if (wr == 1) PG8_BAR;
    PG8_WAIT_V(2); PG8_BAR;
    PG8_STAGE(PG8_SB(1, 0), cB + kstep, voffB); PG8_STAGE(PG8_SA(1, 0), cA + kstep, voffA); PG8_STAGE(PG8_SB(1, 1), cB + hstepB + kstep, voffB);
    PG8_WAIT_V(6); PG8_BAR;
    for (;;) {
        const bool has_next = S.next(ui + 1, nxt);
        const char* nA = has_next ? (const char*)g.A + (size_t)nxt.z * g.zA + (size_t)nxt.pm * tstepA : cA;
        const char* nB = has_next ? (const char*)g.Bt + (size_t)nxt.z * g.zB + (size_t)nxt.pn * tstepB : cB;
        for (int t = 0; t < nt; t += 2) {
            const bool last = (t == nt - 2);
            const char* a1 = cA + (size_t)(t + 1) * kstep;
            const char* a2 = last ? nA : cA + (size_t)(t + 2) * kstep; const char* b2 = last ? nB : cB + (size_t)(t + 2) * kstep;
            const char* a3 = a2 + kstep; const char* b3 = b2 + kstep;
            PG8_LDB(B0, 0, 0); PG8_LDB(B1, 0, 1); PG8_SCHED; PG8_LDA(At, 0, 0); PG8_STAGE(PG8_SA(1, 1), a1 + hstepA, voffA);
            PG8_WAIT_V(8); PG8_WAIT_L(0); PG8_BAR; PG8_MMA(0, 0, At, B0); PG8_MMA(0, 1, At, B1); PG8_BAR; PG8_SCHED;
            PG8_LDA(At, 0, 1); PG8_STAGE(PG8_SB(0, 0), b2, voffB); PG8_STAGE(PG8_SB(0, 1), b2 + hstepB, voffB); PG8_STAGE(PG8_SA(0, 0), a2, voffA);
            PG8_WAIT_V(8); PG8_WAIT_L(0); PG8_BAR; PG8_MMA(1, 0, At, B0); PG8_MMA(1, 1, At, B1); PG8_BAR; PG8_SCHED;
            PG8_LDB(B0, 1, 0); PG8_LDB(B1, 1, 1); PG8_SCHED; PG8_LDA(At, 1, 0); PG8_STAGE(PG8_SA(0, 1), a2 + hstepA, voffA);
            PG8_WAIT_V(8); PG8_WAIT_L(0); PG8_BAR; PG8_MMA(0, 0, At, B0); PG8_MMA(0, 1, At, B1); PG8_BAR; PG8_SCHED;
            PG8_LDA(At, 1, 1); PG8_STAGE(PG8_SB(1, 0), b3, voffB); PG8_STAGE(PG8_SB(1, 1), b3 + hstepB, voffB); PG8_STAGE(PG8_SA(1, 0), a3, voffA);
            PG8_WAIT_V(8); PG8_WAIT_L(0); PG8_BAR; PG8_MMA(1, 0, At, B0); PG8_MMA(1, 1, At, B1); PG8_BAR; PG8_SCHED;
        }
        if constexpr (ALIGN_EPI) { if (wr == 0) PG8_BAR; }
        if constexpr (!Epi::AFTER_DRAIN) E(acc, cur, wr, wc, fr, fq);
        if (!has_next) break;
#pragma unroll
        for (int a = 0; a < 2; ++a)
#pragma unroll
            for (int b = 0; b < 2; ++b)
#pragma unroll
                for (int m = 0; m < 4; ++m)
#pragma unroll
                    for (int n = 0; n < 2; ++n) acc[a][b][m][n] = (f32x4){0.f, 0.f, 0.f, 0.f};
        cur = nxt; cA = nA; cB = nB; ++ui;
        if constexpr (ALIGN_EPI) { if (wr == 1) PG8_BAR; }
    }
    PG8_WAIT_V(0);
    if constexpr (!ALIGN_EPI) { if (wr == 0) PG8_BAR; }
    PG8_BAR;
    if constexpr (Epi::AFTER_DRAIN) E.fused(acc, cur, wr, wc, lds, wid);
#undef PG8_SA
#undef PG8_SB
#undef PG8_STAGE
#undef PG8_LDA
#undef PG8_LDB
#undef PG8_MMA
#undef PG8_WAIT_V
#undef PG8_WAIT_L
#undef PG8_BAR
#undef PG8_SCHED
}

template <class EpiA, class EpiB>
__device__ __forceinline__ void gemm_phase2(LAS unsigned char* lds, const Gemm g0, const Unit u0, const EpiA& E0, const Gemm g1, const Unit u1, const EpiB& E1, const int wid) {
    const int lane = lane_id_opaque(), tid = wid * 64 + lane, wr = wid >> 2, wc = wid & 3, fr = lane & 15, fq = lane >> 4;
    unsigned vA0[2], vB0[2], vA1[2], vB1[2];
#pragma unroll
    for (int i = 0; i < 2; ++i) { int R, C; stage_rc(tid * 16 + i * 8192, R, C); const int Rb = (R & ~31) + perm32(R & 31);
        vA0[i] = (unsigned)(R * g0.lda + C) * 2u; vB0[i] = (unsigned)(Rb * g0.ldb + C) * 2u; vA1[i] = (unsigned)(R * g1.lda + C) * 2u; vB1[i] = (unsigned)(Rb * g1.ldb + C) * 2u; }
    const size_t kstep = (size_t)(BK * 2);
    const size_t hA0 = (size_t)HALF * g0.lda * 2, hB0 = (size_t)HALF * g0.ldb * 2, hA1 = (size_t)HALF * g1.lda * 2, hB1 = (size_t)HALF * g1.ldb * 2;
    const unsigned ldsw = (unsigned)wid * 1024u;
    const int aoff = lds_byte(wr * 64 + fr, fq * 8), boff = lds_byte(wc * 32 + fr, fq * 8);
#define PG8_SA(b, h) (((b) * 2 + (h)) * HTB)
#define PG8_SB(b, h) ((4 + (b) * 2 + (h)) * HTB)
#define PG8_STAGE(bufoff, gbase, voff) do { _Pragma("unroll") for (int _i = 0; _i < 2; ++_i) \
        __builtin_amdgcn_global_load_lds((const unsigned*)((const char*)(gbase) + (voff)[_i]), (LAS unsigned*)(lds + (bufoff) + ldsw + _i * 8192), 16, 0, 0); } while (0)
#define PG8_LDA(dst, b, h) do { _Pragma("unroll") for (int m = 0; m < 4; ++m) _Pragma("unroll") for (int k = 0; k < 2; ++k) dst[m][k] = *(const LAS bf16x8*)(lds + PG8_SA(b, h) + aoff + m * 2048 + k * 1024); } while (0)
#define PG8_LDB(dst, b, h) do { _Pragma("unroll") for (int n = 0; n < 2; ++n) _Pragma("unroll") for (int k = 0; k < 2; ++k) dst[n][k] = *(const LAS bf16x8*)(lds + PG8_SB(b, h) + boff + n * 2048 + k * 1024); } while (0)
#define PG8_MMA(ai, bj, At, Bt) do { __builtin_amdgcn_s_setprio(1); _Pragma("unroll") for (int m = 0; m < 4; ++m) _Pragma("unroll") for (int n = 0; n < 2; ++n) _Pragma("unroll") for (int k = 0; k < 2; ++k) \
        acc[ai][bj][m][n] = __builtin_amdgcn_mfma_f32_16x16x32_bf16(Bt[n][k], At[m][k], acc[ai][bj][m][n], 0, 0, 0); __builtin_amdgcn_s_setprio(0); } while (0)
#define PG8_WAIT_V(n) asm volatile("s_waitcnt vmcnt(" #n ")" ::: "memory")
#define PG8_WAIT_L(n) asm volatile("s_waitcnt lgkmcnt(" #n ")" ::: "memory")
#define PG8_BAR __builtin_amdgcn_s_barrier()
#define PG8_SCHED __builtin_amdgcn_sched_barrier(0)
    f32x4 acc[2][2][4][2];
#pragma unroll
    for (int a = 0; a < 2; ++a)
#pragma unroll
        for (int b = 0; b < 2; ++b)
#pragma unroll
            for (int m = 0; m < 4; ++m)
#pragma unroll
                for (int n = 0; n < 2; ++n) acc[a][b][m][n] = (f32x4){0.f, 0.f, 0.f, 0.f};
    bf16x8 At[4][2], B0[2][2], B1[2][2];
    const char* A0 = (const char*)g0.A + (size_t)u0.pm * 2 * hA0; const char* Bp0 = (const char*)g0.Bt + (size_t)u0.pn * 2 * hB0;
    const char* A1 = (const char*)g1.A + (size_t)u1.pm * 2 * hA1; const char* Bp1 = (const char*)g1.Bt + (size_t)u1.pn * 2 * hB1;
    PG8_STAGE(PG8_SB(0, 0), Bp0, vB0); PG8_STAGE(PG8_SB(0, 1), Bp0 + hB0, vB0); PG8_STAGE(PG8_SA(0, 0), A0, vA0); PG8_STAGE(PG8_SA(0, 1), A0 + hA0, vA0);
    if (wr == 1) PG8_BAR;
    PG8_WAIT_V(2); PG8_BAR;
    PG8_STAGE(PG8_SB(1, 0), Bp0 + kstep, vB0); PG8_STAGE(PG8_SA(1, 0), A0 + kstep, vA0); PG8_STAGE(PG8_SB(1, 1), Bp0 + hB0 + kstep, vB0);
    PG8_WAIT_V(6); PG8_BAR;
#pragma unroll
    for (int ui = 0; ui < 2; ++ui) {
        const char* cA = ui == 0 ? A0 : A1; const char* cB = ui == 0 ? Bp0 : Bp1;
        const size_t hAc = ui == 0 ? hA0 : hA1, hBc = ui == 0 ? hB0 : hB1;
        const int nt = (ui == 0 ? g0.K : g1.K) / BK;
        unsigned vAc[2], vBc[2];
#pragma unroll
        for (int i = 0; i < 2; ++i) { vAc[i] = ui == 0 ? vA0[i] : vA1[i]; vBc[i] = ui == 0 ? vB0[i] : vB1[i]; }
        for (int t = 0; t < nt; t += 2) {
            const bool last = (t == nt - 2);
            const char* a1 = cA + (size_t)(t + 1) * kstep;
            const char* a2 = last ? A1 : cA + (size_t)(t + 2) * kstep; const char* b2 = last ? Bp1 : cB + (size_t)(t + 2) * kstep;
            const char* a3 = a2 + kstep; const char* b3 = b2 + kstep;
            const size_t hA2 = last ? hA1 : hAc, hB2 = last ? hB1 : hBc;
            unsigned vA2[2], vB2[2];
#pragma unroll
            for (int i = 0; i < 2; ++i) { vA2[i] = last ? vA1[i] : vAc[i]; vB2[i] = last ? vB1[i] : vBc[i]; }
            PG8_LDB(B0, 0, 0); PG8_LDB(B1, 0, 1); PG8_SCHED; PG8_LDA(At, 0, 0); PG8_STAGE(PG8_SA(1, 1), a1 + hAc, vAc);
            PG8_WAIT_V(8); PG8_WAIT_L(0); PG8_BAR; PG8_MMA(0, 0, At, B0); PG8_MMA(0, 1, At, B1); PG8_BAR; PG8_SCHED;
            PG8_LDA(At, 0, 1); PG8_STAGE(PG8_SB(0, 0), b2, vB2); PG8_STAGE(PG8_SB(0, 1), b2 + hB2, vB2); PG8_STAGE(PG8_SA(0, 0), a2, vA2);
            PG8_WAIT_V(8); PG8_WAIT_L(0); PG8_BAR; PG8_MMA(1, 0, At, B0); PG8_MMA(1, 1, At, B1); PG8_BAR; PG8_SCHED;
            PG8_LDB(B0, 1, 0); PG8_LDB(B1, 1, 1); PG8_SCHED; PG8_LDA(At, 1, 0); PG8_STAGE(PG8_SA(0, 1), a2 + hA2, vA2);
            PG8_WAIT_V(8); PG8_WAIT_L(0); PG8_BAR; PG8_MMA(0, 0, At, B0); PG8_MMA(0, 1, At, B1); PG8_BAR; PG8_SCHED;
            PG8_LDA(At, 1, 1); PG8_STAGE(PG8_SB(1, 0), b3, vB2); PG8_STAGE(PG8_SB(1, 1), b3 + hB2, vB2); PG8_STAGE(PG8_SA(1, 0), a3, vA2);
            PG8_WAIT_V(8); PG8_WAIT_L(0); PG8_BAR; PG8_MMA(1, 0, At, B0); PG8_MMA(1, 1, At, B1); PG8_BAR; PG8_SCHED;
        }
        if (wr == 0) PG8_BAR;
        if (ui == 0) {
            E0(acc, u0, wr, wc, fr, fq);
#pragma unroll
            for (int a = 0; a < 2; ++a)
#pragma unroll
                for (int b = 0; b < 2; ++b)
#pragma unroll
                    for (int m = 0; m < 4; ++m)
#pragma unroll
                        for (int n = 0; n < 2; ++n) acc[a][b][m][n] = (f32x4){0.f, 0.f, 0.f, 0.f};
            if (wr == 1) PG8_BAR;
        } else E1(acc, u1, wr, wc, fr, fq);
    }
    PG8_WAIT_V(0);
    PG8_BAR;
#undef PG8_SA
#undef PG8_SB
#undef PG8_STAGE
#undef PG8_LDA
#undef PG8_LDB
#undef PG8_MMA
#undef PG8_WAIT_V
#undef PG8_WAIT_L
#undef PG8_BAR
#undef PG8_SCHED
}

#define EPI_FOR_ROWS _Pragma("unroll") for (int ai = 0; ai < 2; ++ai) _Pragma("unroll") for (int m = 0; m < 4; ++m)
#define EPI_ROWDEF const int rit = ai * HALF + wr * 64 + m * 16 + fr; const int row = u.pm * BM + rit; (void)rit; (void)row;

struct Epi1 {
    static constexpr bool AFTER_DRAIN = false;
    const float* rinv; const float* qnw; const float* knw; const float2* rope;
    bf16_t *Q, *Kb, *Vb, *GA, *GS, *UCAT; LAS float* xch; int pn0;
    __device__ __forceinline__ void operator()(const f32x4 (&acc)[2][2][4][2], const Unit& u, int wr, int wc, int, int) const {
        const int l_ = lane_id_opaque(), fr = l_ & 15, fq = l_ >> 4;
        const int pn = u.pn + pn0;
        if (pn <= 4) {
            float ss[2][4], rv[2][4];
            EPI_FOR_ROWS { EPI_ROWDEF const float r = rinv[row]; rv[ai][m] = r; float s = 0.f;
#pragma unroll
                for (int bj = 0; bj < 2; ++bj)
#pragma unroll
                    for (int n = 0; n < 2; ++n) { const f32x4 v = acc[ai][bj][m][n] * r; s += (v[0] * v[0] + v[1] * v[1]) + (v[2] * v[2] + v[3] * v[3]); }
                s += swz_xor<16>(s); s = sum_xor32(s); ss[ai][m] = s;
                if (fq == 0) xch[wc * 256 + rit] = s; }
            LDS_WAIT(); __builtin_amdgcn_s_barrier(); asm volatile("" ::: "memory");
            const int half = wc & 1, hd = wc >> 1;
            const float* nw = (pn < 4 ? qnw : knw) + 64 * half + 8 * fq;
            float w1[8], w2[8];
#pragma unroll
            for (int i = 0; i < 8; ++i) { w1[i] = nw[i]; w2[i] = nw[32 + i]; }
            EPI_FOR_ROWS { EPI_ROWDEF const float tot = ss[ai][m] + xch[(wc ^ 1) * 256 + rit];
                const float sc = rv[ai][m] * rsqrtf(tot * (1.f / 128.f) + EPS);
                const int t = row & (SEQ - 1); const int pos = half ? (t & 63) : (t >> 6);
                const float2* rp = rope + pos * 32 + 8 * fq;
                float o1[8], o2[8];
#pragma unroll
                for (int n = 0; n < 2; ++n)
#pragma unroll
                    for (int e = 0; e < 4; ++e) { const int i = 4 * n + e; const float2 cs = rp[i];
                        const float x1 = acc[ai][0][m][n][e] * sc * w1[i], x2 = acc[ai][1][m][n][e] * sc * w2[i];
                        o1[i] = x1 * cs.x - x2 * cs.y; o2[i] = x2 * cs.x + x1 * cs.y; }
                bf16_t* dst = (pn < 4) ? Q + (size_t)row * DATT + (2 * pn + hd) * 128 + 64 * half + 8 * fq : Kb + (size_t)row * DKV + hd * 128 + 64 * half + 8 * fq;
                u32x4 a; a.x = pk2(o1[0], o1[1]); a.y = pk2(o1[2], o1[3]); a.z = pk2(o1[4], o1[5]); a.w = pk2(o1[6], o1[7]);
                u32x4 b; b.x = pk2(o2[0], o2[1]); b.y = pk2(o2[2], o2[3]); b.z = pk2(o2[4], o2[5]); b.w = pk2(o2[6], o2[7]);
                *(u32x4*)dst = a; *(u32x4*)(dst + 32) = b; }
        } else {
            const int lg0 = 4 * (wc >> 1) + 2 * (wc & 1);
            EPI_FOR_ROWS { EPI_ROWDEF const float r = rinv[row];
#pragma unroll
                for (int bj = 0; bj < 2; ++bj) { const int L = 256 * pn + 32 * (lg0 + bj) + 8 * fq;
                    f32x4 v0 = acc[ai][bj][m][0] * r, v1 = acc[ai][bj][m][1] * r; bf16_t* dst;
                    if (pn == 5) dst = Vb + (size_t)row * DKV + (L - 1280);
                    else if (pn < 10) dst = GA + (size_t)row * DATT + (L - 1536);
                    else if (pn < 14) { const int Lu = L - 2560; dst = UCAT + ((size_t)(Lu >> 4) * NCH + (row >> 4)) * 512 + (row & 15) * 16 + (Lu & 15); }
                    else dst = GS + (size_t)row * DSSM + (L - 3584);
                    if ((pn >= 6 && pn < 10) || pn >= 14) {
#pragma unroll
                        for (int e = 0; e < 4; ++e) { v0[e] = siluf_(v0[e]); v1[e] = siluf_(v1[e]); } }
                    u32x4 w; w.x = pk2(v0[0], v0[1]); w.y = pk2(v0[2], v0[3]); w.z = pk2(v1[0], v1[1]); w.w = pk2(v1[2], v1[3]);
                    *(u32x4*)dst = w; } }
        }
    }
};
struct EpiS1 {
    static constexpr bool AFTER_DRAIN = true;
    const float* lb16; bf16_t* UCAT;
    __device__ __forceinline__ void operator()(const f32x4 (&)[2][2][4][2], const Unit&, int, int, int, int) const {}
    __device__ __forceinline__ void fused(const f32x4 (&acc)[2][2][4][2], const Unit& u, int wr, int wc, LAS unsigned char* lds, int wid) const {
        const int l_ = lane_id_opaque(), fr = l_ & 15, fq = l_ >> 4;
        LAS float* Tl = (LAS float*)lds;
#pragma unroll
        for (int d = 0; d < 2; ++d) {
            EPI_FOR_ROWS { const int rit = ai * HALF + wr * 64 + m * 16 + fr; LAS float* rp = Tl + rit * 128 + wc * 32 + 8 * fq;
                *(LAS f32x4*)rp = acc[ai][d][m][0]; *(LAS f32x4*)(rp + 4) = acc[ai][d][m][1]; }
            LDS_WAIT(); __builtin_amdgcn_s_barrier(); asm volatile("" ::: "memory");
            {
                const int p = l_; const float lr = lb16[((u.z * 2 + d) * 64 + p) * 2], li = lb16[((u.z * 2 + d) * 64 + p) * 2 + 1];
                LAS float* SEG = (LAS float*)(lds + XCH_OFF);
                float xr = 0.f, xi = 0.f;
#pragma unroll 8
                for (int i = 0; i < 32; ++i) { const int cc = wid * 32 + i, c = d ? 255 - cc : cc;
                    const float sr = Tl[c * 128 + p], si = Tl[c * 128 + 64 + p];
                    Tl[c * 128 + p] = xr; Tl[c * 128 + 64 + p] = xi;
                    const float nr = lr * xr - li * xi + sr; xi = lr * xi + li * xr + si; xr = nr; }
                SEG[(wid * 64 + p) * 2] = xr; SEG[(wid * 64 + p) * 2 + 1] = xi;
                LDS_WAIT(); __builtin_amdgcn_s_barrier(); asm volatile("" ::: "memory");
                float l32r = lr, l32i = li;
#pragma unroll
                for (int q = 0; q < 5; ++q) { const float t = l32r * l32r - l32i * l32i; l32i = 2.f * l32r * l32i; l32r = t; }
                float er = 0.f, ei = 0.f;
                for (int j = 0; j < wid; ++j) { const float tr = SEG[(j * 64 + p) * 2], ti = SEG[(j * 64 + p) * 2 + 1];
                    const float nr = l32r * er - l32i * ei + tr; ei = l32r * ei + l32i * er + ti; er = nr; }
#pragma unroll 8
                for (int i = 0; i < 32; ++i) { const int cc = wid * 32 + i, c = d ? 255 - cc : cc;
                    const float tr = Tl[c * 128 + p] + er, ti = Tl[c * 128 + 64 + p] + ei;
                    Tl[c * 128 + p] = __uint_as_float(pk2(tr, ti));
                    const float nr = lr * er - li * ei; ei = lr * ei + li * er; er = nr; }
            }
            LDS_WAIT(); __builtin_amdgcn_s_barrier(); asm volatile("" ::: "memory");
            {   bf16_t* ub = UCAT + ((size_t)u.z * NCH + u.pm * 256) * 512 + 256 + d * 128;
#pragma unroll
                for (int i = 0; i < 8; ++i) { const int q = wid * 64 + l_ + 512 * i, r = q >> 4, c8 = (q & 15) * 8;
                    *(u32x4*)(ub + (size_t)r * 512 + c8) = *(const LAS u32x4*)((LAS bf16_t*)(Tl + r * 128) + c8); } }
            LDS_WAIT(); __builtin_amdgcn_s_barrier(); asm volatile("" ::: "memory");
        }
    }
};
struct EpiS2 {
    static constexpr bool AFTER_DRAIN = false;
    bf16_t* YS;
    __device__ __forceinline__ void operator()(const f32x4 (&acc)[2][2][4][2], const Unit& u, int wr, int wc, int, int) const {
        const int l_ = lane_id_opaque(), fr = l_ & 15, fq = l_ >> 4;
        EPI_FOR_ROWS { EPI_ROWDEF
#pragma unroll
            for (int bj = 0; bj < 2; ++bj) { const int c = bj * HALF + wc * 32 + 8 * fq; const int j = c >> 4, h0 = c & 15;
                const f32x4 v0 = acc[ai][bj][m][0], v1 = acc[ai][bj][m][1];
                u32x4 w; w.x = pk2(gelu_tanh(v0[0]), gelu_tanh(v0[1])); w.y = pk2(gelu_tanh(v0[2]), gelu_tanh(v0[3])); w.z = pk2(gelu_tanh(v1[0]), gelu_tanh(v1[1])); w.w = pk2(gelu_tanh(v1[2]), gelu_tanh(v1[3]));
                *(u32x4*)(YS + ((size_t)row * 16 + j) * DSSM + u.z * 16 + h0) = w; } }
    }
};
struct EpiGlu {
    static constexpr bool AFTER_DRAIN = false;
    const float* bglu; const bf16_t* GS; bf16_t* YMIX;
    __device__ __forceinline__ void operator()(const f32x4 (&acc)[2][2][4][2], const Unit& u, int wr, int wc, int, int) const {
        const int l_ = lane_id_opaque(), fr = l_ & 15, fq = l_ >> 4;
        const int a0 = 128 * u.pn + 32 * wc + 8 * fq;
        float bv[8], bg[8];
#pragma unroll
        for (int i = 0; i < 8; ++i) { bv[i] = bglu[a0 + i]; bg[i] = bglu[1024 + a0 + i]; }
        u32x4 gsv[2][4];
        EPI_FOR_ROWS { EPI_ROWDEF gsv[ai][m] = __builtin_nontemporal_load((const u32x4*)(GS + (size_t)row * DSSM + a0)); }
        EPI_FOR_ROWS { EPI_ROWDEF const u32x4 gs = gsv[ai][m];
            float o[8];
#pragma unroll
            for (int n = 0; n < 2; ++n)
#pragma unroll
                for (int e = 0; e < 4; ++e) { const int i = 4 * n + e; o[i] = (acc[ai][0][m][n][e] + bv[i]) * sigmoidf_(acc[ai][1][m][n][e] + bg[i]); }
            o[0] *= bflo(gs.x); o[1] *= bfhi(gs.x); o[2] *= bflo(gs.y); o[3] *= bfhi(gs.y); o[4] *= bflo(gs.z); o[5] *= bfhi(gs.z); o[6] *= bflo(gs.w); o[7] *= bfhi(gs.w);
            u32x4 w; w.x = pk2(o[0], o[1]); w.y = pk2(o[2], o[3]); w.z = pk2(o[4], o[5]); w.w = pk2(o[6], o[7]);
            *(u32x4*)(YMIX + (size_t)row * DM + 1024 + a0) = w; }
    }
};
struct EpiBf {
    static constexpr bool AFTER_DRAIN = false;
    bf16_t* O; int ldc;
    __device__ __forceinline__ void operator()(const f32x4 (&acc)[2][2][4][2], const Unit& u, int wr, int wc, int, int) const {
        const int l_ = lane_id_opaque(), fr = l_ & 15, fq = l_ >> 4;
        EPI_FOR_ROWS { EPI_ROWDEF
#pragma unroll
            for (int bj = 0; bj < 2; ++bj) { const f32x4 v0 = acc[ai][bj][m][0], v1 = acc[ai][bj][m][1];
                u32x4 w; w.x = pk2(v0[0], v0[1]); w.y = pk2(v0[2], v0[3]); w.z = pk2(v1[0], v1[1]); w.w = pk2(v1[2], v1[3]);
                *(u32x4*)(O + (size_t)row * ldc + u.pn * BM + bj * HALF + wc * 32 + 8 * fq) = w; } }
    }
};
struct EpiOut {
    static constexpr bool AFTER_DRAIN = false;
    const float* x; float* H; bf16_t* HB; float* ssq;
    __device__ __forceinline__ void operator()(const f32x4 (&acc)[2][2][4][2], const Unit& u, int wr, int wc, int, int) const {
        const int l_ = lane_id_opaque(), fr = l_ & 15, fq = l_ >> 4;
#pragma unroll
        for (int ai = 0; ai < 2; ++ai) {
            f32x4 xv[4][2][2];
#pragma unroll
            for (int m = 0; m < 4; ++m) { EPI_ROWDEF
#pragma unroll
                for (int bj = 0; bj < 2; ++bj) { const size_t off = (size_t)row * DM + u.pn * BM + bj * HALF + wc * 32 + 8 * fq; xv[m][bj][0] = __builtin_nontemporal_load((const f32x4*)(x + off)); xv[m][bj][1] = __builtin_nontemporal_load((const f32x4*)(x + off + 4)); } }
#pragma unroll
            for (int m = 0; m < 4; ++m) { EPI_ROWDEF float s = 0.f;
#pragma unroll
                for (int bj = 0; bj < 2; ++bj) { const size_t off = (size_t)row * DM + u.pn * BM + bj * HALF + wc * 32 + 8 * fq;
                    const f32x4 v0 = acc[ai][bj][m][0] + xv[m][bj][0], v1 = acc[ai][bj][m][1] + xv[m][bj][1];
                    s += (v0[0] * v0[0] + v0[1] * v0[1]) + (v0[2] * v0[2] + v0[3] * v0[3]) + (v1[0] * v1[0] + v1[1] * v1[1]) + (v1[2] * v1[2] + v1[3] * v1[3]);
                    u32x4 w; w.x = pk2(v0[0], v0[1]); w.y = pk2(v0[2], v0[3]); w.z = pk2(v1[0], v1[1]); w.w = pk2(v1[2], v1[3]);
                    *(u32x4*)(HB + off) = w; }
                s += swz_xor<16>(s); s = sum_xor32(s);
                if (fq == 0) ssq[(size_t)row * 32 + u.pn * 4 + wc] = s; }
        }
    }
};
struct EpiGate {
    static constexpr bool AFTER_DRAIN = true;
    float* H; const bf16_t* PP; float* ssq; unsigned* cnt; const float* nf; const LAS float* r2; const bf16_t* HBr;
    __device__ __forceinline__ void operator()(const f32x4 (&)[2][2][4][2], const Unit&, int, int, int, int) const {}
    __device__ __forceinline__ void fused(f32x4 (&acc)[2][2][4][2], const Unit& u, int wr, int wc, LAS unsigned char* lds, int wid) const {
        const int l_ = lane_id_opaque(), fr = l_ & 15, fq = l_ >> 4, tid = wid * 64 + l_;
        LAS float* P = (LAS float*)lds; LAS float* Rn = P + 1024;
        EPI_FOR_ROWS { EPI_ROWDEF float s = 0.f; const float r = r2[rit];
#pragma unroll
            for (int bj = 0; bj < 2; ++bj) { const size_t off = (size_t)row * DM + u.pn * BM + bj * HALF + wc * 32 + 8 * fq;
                const u32x4 pp = __builtin_nontemporal_load((const u32x4*)(PP + off));
                const u32x4 hb = __builtin_nontemporal_load((const u32x4*)(HBr + off));
                f32x4 h0 = {bflo(hb.x), bfhi(hb.x), bflo(hb.y), bfhi(hb.y)}, h1 = {bflo(hb.z), bfhi(hb.z), bflo(hb.w), bfhi(hb.w)};
                const f32x4 a0 = acc[ai][bj][m][0] * r, a1 = acc[ai][bj][m][1] * r;
                h0[0] += sigmoidf_(a0[0]) * bflo(pp.x); h0[1] += sigmoidf_(a0[1]) * bfhi(pp.x); h0[2] += sigmoidf_(a0[2]) * bflo(pp.y); h0[3] += sigmoidf_(a0[3]) * bfhi(pp.y);
                h1[0] += sigmoidf_(a1[0]) * bflo(pp.z); h1[1] += sigmoidf_(a1[1]) * bfhi(pp.z); h1[2] += sigmoidf_(a1[2]) * bflo(pp.w); h1[3] += sigmoidf_(a1[3]) * bfhi(pp.w);
                acc[ai][bj][m][0] = h0; acc[ai][bj][m][1] = h1;
                s += (h0[0] * h0[0] + h0[1] * h0[1]) + (h0[2] * h0[2] + h0[3] * h0[3]) + (h1[0] * h1[0] + h1[1] * h1[1]) + (h1[2] * h1[2] + h1[3] * h1[3]); }
            s += swz_xor<16>(s); s = sum_xor32(s);
            if (fq == 0) P[rit * 4 + wc] = s; }
        LDS_WAIT(); __builtin_amdgcn_s_barrier(); asm volatile("" ::: "memory");
        if (tid < 256) { const float t = (P[tid * 4] + P[tid * 4 + 1]) + (P[tid * 4 + 2] + P[tid * 4 + 3]);
            __hip_atomic_store(ssq + (size_t)(u.pm * 256 + tid) * 8 + u.pn, t, __ATOMIC_RELAXED, __HIP_MEMORY_SCOPE_AGENT); }
        asm volatile("s_waitcnt vmcnt(0)" ::: "memory");
        if (wid < 4 && l_ == 0) __hip_atomic_fetch_add(cnt + 64 * u.pm, 1u, __ATOMIC_RELAXED, __HIP_MEMORY_SCOPE_AGENT);
        if (wid == 0) {
            unsigned sp = 0;
            while ((unsigned)__builtin_amdgcn_readfirstlane(__hip_atomic_load(cnt + 64 * u.pm, __ATOMIC_RELAXED, __HIP_MEMORY_SCOPE_AGENT)) < 32u) { __builtin_amdgcn_s_sleep(2); if (++sp > (1u << 22)) break; }
            __builtin_amdgcn_fence(__ATOMIC_ACQUIRE, "agent");
        }
        asm volatile("s_waitcnt vmcnt(0) lgkmcnt(0)" ::: "memory"); __builtin_amdgcn_s_barrier(); asm volatile("" ::: "memory");
        if (tid < 256) { const float* sp = ssq + (size_t)(u.pm * 256 + tid) * 8; float t = 0.f;
#pragma unroll
            for (int i = 0; i < 8; ++i) t += __hip_atomic_load(sp + i, __ATOMIC_RELAXED, __HIP_MEMORY_SCOPE_AGENT);
            Rn[tid] = rsqrtf(t * (1.f / DM) + EPS); }
        LDS_WAIT(); __builtin_amdgcn_s_barrier(); asm volatile("" ::: "memory");
        EPI_FOR_ROWS { EPI_ROWDEF const float rn = Rn[rit];
#pragma unroll
            for (int bj = 0; bj < 2; ++bj) { const int col = u.pn * BM + bj * HALF + wc * 32 + 8 * fq; const size_t off = (size_t)row * DM + col;
                *(f32x4*)(H + off) = acc[ai][bj][m][0] * rn * *(const f32x4*)(nf + col); *(f32x4*)(H + off + 4) = acc[ai][bj][m][1] * rn * *(const f32x4*)(nf + col + 4); } }
    }
};
}

namespace att {
constexpr int D = 128, NW = 8, QBLK = 32, KVBLK = 64;
constexpr float SCALE = 0.088388347648318440f;
constexpr float THR = 8.f;
constexpr int LDQ = DATT, LDK = DKV;
constexpr size_t SHM_V = KVBLK * D * 2, SHM_K = KVBLK * D * 2, SHM_ATTN = 2 * SHM_V + 2 * SHM_K + NW * 64 * 4;
#define KSWZ(row, colB) ((row) * 256 + ((colB) ^ (((row) & 7) << 4)))
#define SBAR() __builtin_amdgcn_sched_barrier(0)
__device__ __forceinline__ int crow(int r, int hi) { return (r & 3) + 8 * (r >> 2) + 4 * hi; }
__device__ __forceinline__ void partialSM(f32x16& p0, f32x16& p1, float& m_reg, float& mn, float& alpha) {
  constexpr float C = SCALE * 1.4426950408889634f;
  float pmax = p0[0]; for (int r = 1; r < 16; ++r) pmax = fmaxf(pmax, p0[r]); for (int r = 0; r < 16; ++r) pmax = fmaxf(pmax, p1[r]);
  { auto rr = __builtin_amdgcn_permlane32_swap(__float_as_uint(pmax), __float_as_uint(pmax), false, false);
    pmax = fmaxf(__uint_as_float(rr[0]), __uint_as_float(rr[1])); }
  if (__builtin_expect(__all(pmax - m_reg <= THR / SCALE), 1)) { mn = m_reg; alpha = 1.f; }
  else { mn = fmaxf(m_reg, pmax); alpha = __builtin_amdgcn_exp2f((m_reg - mn) * C); m_reg = mn; }
  float mnC = -mn * C;
  for (int r = 0; r < 16; ++r) p0[r] = fmaf(p0[r], C, mnC); for (int r = 0; r < 16; ++r) p1[r] = fmaf(p1[r], C, mnC);
  for (int r = 0; r < 16; ++r) p0[r] = __builtin_amdgcn_exp2f(p0[r]);
}
__device__ __forceinline__ void finishSM(f32x16& p0, f32x16& p1, float alpha, float& l_reg, bf16x8& pa0, bf16x8& pa1, bf16x8& pa2, bf16x8& pa3) {
  for (int r = 0; r < 16; ++r) p1[r] = __builtin_amdgcn_exp2f(p1[r]);
  float ps = 0; for (int r = 0; r < 16; ++r) ps += p0[r]; for (int r = 0; r < 16; ++r) ps += p1[r];
  { auto rr = __builtin_amdgcn_permlane32_swap(__float_as_uint(ps), __float_as_uint(ps), false, false);
    ps = __uint_as_float(rr[0]) + __uint_as_float(rr[1]); }
  l_reg = l_reg * alpha + ps;
#define PK4(P, BASE, OUT) do { unsigned a0 = cvt_pk_bf16(P[BASE + 0], P[BASE + 1]), a1 = cvt_pk_bf16(P[BASE + 2], P[BASE + 3]);   \
    unsigned b0 = cvt_pk_bf16(P[BASE + 4], P[BASE + 5]), b1 = cvt_pk_bf16(P[BASE + 6], P[BASE + 7]);                              \
    auto r0 = __builtin_amdgcn_permlane32_swap(a0, b0, false, false); auto r1 = __builtin_amdgcn_permlane32_swap(a1, b1, false, false); \
    u32x4 w = {r0[0], r1[0], r0[1], r1[1]}; OUT = *reinterpret_cast<bf16x8*>(&w); } while (0)
  PK4(p0, 0, pa0); PK4(p0, 8, pa1); PK4(p1, 0, pa2); PK4(p1, 8, pa3);
#undef PK4
}
__device__ __forceinline__ void qkt(f32x16& p0, f32x16& p1, const bf16_t* Ks, const bf16x8* qr, int r32, int hi) {
  p0 = f32x16{}; p1 = f32x16{};
  for (int d0 = 0; d0 < 8; ++d0) { int cb = (d0 * 16 + hi * 8) * 2;
    bf16x8 b0 = *reinterpret_cast<const bf16x8*>((const char*)Ks + KSWZ(r32, cb));
    bf16x8 b1 = *reinterpret_cast<const bf16x8*>((const char*)Ks + KSWZ(32 + r32, cb));
    p0 = __builtin_amdgcn_mfma_f32_32x32x16_bf16(b0, qr[d0], p0, 0, 0, 0);
    p1 = __builtin_amdgcn_mfma_f32_32x32x16_bf16(b1, qr[d0], p1, 0, 0, 0); }
}
__device__ __forceinline__ int v_st(int k, int c) { const int kk = (k & ~0xC) | ((k & 4) << 1) | ((k & 8) >> 1); return ((kk >> 3) * 4 + (c >> 5)) * 512 + ((kk & 7) * 32 + (c & 31)) * 2; }
__device__ __forceinline__ int v_rd_base(int lane) { return ((lane & 3) << 3) | (((lane >> 2) & 3) << 6) | (((lane >> 4) & 1) << 5) | (((lane >> 5) & 1) << 8); }
constexpr int v_rd_off(int d0, int ks, int half) { return d0 * 512 + ks * 4096 + half * 2048; }
template <int OFF> __device__ __forceinline__ s16x4 tr_read(int vb) {
  s16x4 r; asm volatile("ds_read_b64_tr_b16 %0, %1 offset:%2" : "=&v"(r) : "v"(vb), "i"(OFF) : "memory"); return r;
}
template <int D0> __device__ __forceinline__ void pv_one(f32x16& od, int vb, bf16x8 pa0, bf16x8 pa1, bf16x8 pa2, bf16x8 pa3) {
  const s16x4 l0 = tr_read<v_rd_off(D0, 0, 0)>(vb), h0 = tr_read<v_rd_off(D0, 0, 1)>(vb), l1 = tr_read<v_rd_off(D0, 1, 0)>(vb), h1 = tr_read<v_rd_off(D0, 1, 1)>(vb);
  const s16x4 l2 = tr_read<v_rd_off(D0, 2, 0)>(vb), h2 = tr_read<v_rd_off(D0, 2, 1)>(vb), l3 = tr_read<v_rd_off(D0, 3, 0)>(vb), h3 = tr_read<v_rd_off(D0, 3, 1)>(vb);
  asm volatile("s_waitcnt lgkmcnt(0)" ::: "memory"); SBAR();
#define PK(L, H) (bf16x8){L[0], L[1], L[2], L[3], H[0], H[1], H[2], H[3]}
  od = __builtin_amdgcn_mfma_f32_32x32x16_bf16(pa0, PK(l0, h0), od, 0, 0, 0);
  od = __builtin_amdgcn_mfma_f32_32x32x16_bf16(pa1, PK(l1, h1), od, 0, 0, 0);
  od = __builtin_amdgcn_mfma_f32_32x32x16_bf16(pa2, PK(l2, h2), od, 0, 0, 0);
  od = __builtin_amdgcn_mfma_f32_32x32x16_bf16(pa3, PK(l3, h3), od, 0, 0, 0);
#undef PK
}
__device__ __forceinline__ void pv_d0(f32x16* o, int vb, bf16x8 pa0, bf16x8 pa1, bf16x8 pa2, bf16x8 pa3) {
  pv_one<0>(o[0], vb, pa0, pa1, pa2, pa3); pv_one<1>(o[1], vb, pa0, pa1, pa2, pa3); pv_one<2>(o[2], vb, pa0, pa1, pa2, pa3); pv_one<3>(o[3], vb, pa0, pa1, pa2, pa3);
}
__device__ __forceinline__ void attn_dense_body(const bf16_t* __restrict__ Qb, const bf16_t* __restrict__ Kh, const bf16_t* __restrict__ Vh,
                                                const bf16_t* __restrict__ Gb, bf16_t* __restrict__ Yb, int seq, char* lds, const int wid) {
  const int lane = lane_id_opaque(), tid = wid * 64 + lane, r32 = lane & 31, hi = lane >> 5;
  bf16_t* V_lds = (bf16_t*)lds; bf16_t* K_lds = (bf16_t*)(lds + 2 * SHM_V);
  float* ws = (float*)(lds + 2 * SHM_V + 2 * SHM_K) + wid * 64; float* li_l = ws; float* al_l = ws + 32;
  float m_reg = -1e30f, l_reg = 0; f32x16 o[4] = {}; bf16x8 qr[8];
  const bf16_t* Qw = Qb + (long)(wid * QBLK + r32) * LDQ + hi * 8;
#pragma unroll
  for (int d0 = 0; d0 < 8; ++d0) qr[d0] = __builtin_nontemporal_load(reinterpret_cast<const bf16x8*>(Qw + d0 * 16));
  const int sr = tid >> 4, sc = (tid & 15) * 8, vst0 = v_st(sr, sc), vst1 = v_st(32 + sr, sc);
  const int vb0 = (int)(uintptr_t)V_lds + v_rd_base(lane);
  struct { bf16x8 vs0, vs1, ks0, ks1; } sr_[2];
#define SLOAD(i, k0) do { sr_[i].vs0 = *reinterpret_cast<const bf16x8*>(&Vh[(long)((k0) + sr) * LDK + sc]); sr_[i].vs1 = *reinterpret_cast<const bf16x8*>(&Vh[(long)((k0) + 32 + sr) * LDK + sc]); \
    sr_[i].ks0 = *reinterpret_cast<const bf16x8*>(&Kh[(long)((k0) + sr) * LDK + sc]); sr_[i].ks1 = *reinterpret_cast<const bf16x8*>(&Kh[(long)((k0) + 32 + sr) * LDK + sc]); } while (0)
#define SWRITE(b, i) do { *(bf16x8*)((char*)V_lds + (b) * SHM_V + vst0) = sr_[i].vs0;          \
    *(bf16x8*)((char*)V_lds + (b) * SHM_V + vst1) = sr_[i].vs1; int kc = sc * 2;               \
    *(bf16x8*)((char*)K_lds + (b) * SHM_K + KSWZ(sr, kc)) = sr_[i].ks0;                       \
    *(bf16x8*)((char*)K_lds + (b) * SHM_K + KSWZ(32 + sr, kc)) = sr_[i].ks1; } while (0)
#define SWAIT() asm volatile("s_waitcnt vmcnt(4)" ::: "memory")
#define RESC(a) do { if (__any((a) < 1.f)) { if (hi == 0) al_l[r32] = (a); asm volatile("s_waitcnt lgkmcnt(0)" ::: "memory"); \
    for (int d = 0; d < 4; ++d) for (int r = 0; r < 16; ++r) o[d][r] *= al_l[crow(r, hi)]; } } while (0)
  f32x16 pA0, pA1, pB0, pB1; float mnA, mnB, alA, alB; bf16x8 pa0, pa1, pa2, pa3; const int NT = seq / KVBLK;
  constexpr int SE = 0, SO = 1;
  SLOAD(SE, 0); asm volatile("s_waitcnt vmcnt(0)" ::: "memory"); SWRITE(0, SE); __syncthreads();
  qkt(pA0, pA1, K_lds, qr, r32, hi); partialSM(pA0, pA1, m_reg, mnA, alA);
  SLOAD(SO, KVBLK); if (2 < NT) SLOAD(SE, 2 * KVBLK);
  SWAIT(); SWRITE(1, SO); __syncthreads();
  for (int j = 1; j + 1 < NT; j += 2) {
    SBAR(); qkt(pB0, pB1, (bf16_t*)((char*)K_lds + SHM_K), qr, r32, hi);
    finishSM(pA0, pA1, alA, l_reg, pa0, pa1, pa2, pa3); SBAR();
    SLOAD(SO, (j + 2) * KVBLK); SBAR();
    pv_d0(o, vb0, pa0, pa1, pa2, pa3); partialSM(pB0, pB1, m_reg, mnB, alB);
    __syncthreads(); SWAIT(); SWRITE(0, SE);
    RESC(alB); __syncthreads();
    SBAR(); qkt(pA0, pA1, K_lds, qr, r32, hi);
    finishSM(pB0, pB1, alB, l_reg, pa0, pa1, pa2, pa3); SBAR();
    if (j + 3 < NT) SLOAD(SE, (j + 3) * KVBLK); SBAR();
    pv_d0(o, vb0 + (int)SHM_V, pa0, pa1, pa2, pa3); partialSM(pA0, pA1, m_reg, mnA, alA);
    __syncthreads(); SWAIT(); SWRITE(1, SO);
    RESC(alA); __syncthreads();
  }
  SBAR(); qkt(pB0, pB1, (bf16_t*)((char*)K_lds + SHM_K), qr, r32, hi);
  finishSM(pA0, pA1, alA, l_reg, pa0, pa1, pa2, pa3); SBAR();
  pv_d0(o, vb0, pa0, pa1, pa2, pa3); partialSM(pB0, pB1, m_reg, mnB, alB);
  __syncthreads(); RESC(alB);
  finishSM(pB0, pB1, alB, l_reg, pa0, pa1, pa2, pa3); SBAR();
  pv_d0(o, vb0 + (int)SHM_V, pa0, pa1, pa2, pa3);
  if (hi == 0) li_l[r32] = l_reg; asm volatile("s_waitcnt lgkmcnt(0)" ::: "memory");
  float rli[16];
#pragma unroll
  for (int r = 0; r < 16; ++r) rli[r] = __builtin_amdgcn_rcpf(li_l[crow(r, hi)]);
  bf16_t* Yw = Yb + (long)(wid * QBLK) * DM; const bf16_t* Gw = Gb + (long)(wid * QBLK) * DATT;
  __syncthreads();
  bf16_t* stg = (bf16_t*)(lds + wid * 8192);
#pragma unroll
  for (int r = 0; r < 16; ++r) { const int orow = crow(r, hi);
#pragma unroll
    for (int d0 = 0; d0 < 4; ++d0) stg[orow * 128 + d0 * 32 + r32] = (bf16_t)f2bf(o[d0][r] * rli[r]); }
  asm volatile("s_waitcnt lgkmcnt(0)" ::: "memory");
  const int l2 = lane_id_opaque();
#pragma unroll
  for (int i = 0; i < 8; ++i) { const int q = l2 + 64 * i, row = q >> 4, c8 = (q & 15) * 8;
    const u32x4 v = *(const u32x4*)(stg + row * 128 + c8); const u32x4 gg = __builtin_nontemporal_load((const u32x4*)(Gw + (unsigned)(row * DATT + c8)));
    u32x4 w; w.x = pk2(bflo(v.x) * bflo(gg.x), bfhi(v.x) * bfhi(gg.x)); w.y = pk2(bflo(v.y) * bflo(gg.y), bfhi(v.y) * bfhi(gg.y));
    w.z = pk2(bflo(v.z) * bflo(gg.z), bfhi(v.z) * bfhi(gg.z)); w.w = pk2(bflo(v.w) * bflo(gg.w), bfhi(v.w) * bfhi(gg.w));
    *(u32x4*)(Yw + (unsigned)(row * DM + c8)) = w; }
  __syncthreads();
#undef SLOAD
#undef SWRITE
#undef SWAIT
#undef RESC
}
#undef SBAR
}

__device__ __forceinline__ void p0_transpose_item(const float* W, int K, int N, bf16_t* WT, int wt_row0, const float* kscale, LAS float* scr, int k0, int n0, int lane) {
#pragma unroll
    for (int i = 0; i < 32; ++i) { const int kk = 2 * i + (lane >> 5); float v = W[(size_t)(k0 + kk) * N + n0 + (lane & 31)]; if (kscale) v *= kscale[k0 + kk]; scr[kk * 33 + (lane & 31)] = v; }
    LDS_WAIT(); asm volatile("" ::: "memory");
    const int c = lane & 7;
#pragma unroll
    for (int j = 0; j < 4; ++j) { const int n = (lane >> 3) + 8 * j; const LAS float* s = scr + (8 * c) * 33 + n;
        u32x4 o; o.x = pk2(s[0 * 33], s[1 * 33]); o.y = pk2(s[2 * 33], s[3 * 33]); o.z = pk2(s[4 * 33], s[5 * 33]); o.w = pk2(s[6 * 33], s[7 * 33]);
        *(u32x4*)(WT + (size_t)(wt_row0 + n) * K + k0 + 8 * c) = o; }
    LDS_WAIT(); asm volatile("" ::: "memory");
}

struct TrItem { const float* W; bf16_t* WT; const float* kscale; int K, N, wt_row0, k0, n0; };
__device__ __forceinline__ void p0_tr_load(const TrItem& d, float (&v)[32], int lane) {
#pragma unroll
    for (int i = 0; i < 32; ++i) { const int kk = 2 * i + (lane >> 5); v[i] = __builtin_nontemporal_load(d.W + (size_t)(d.k0 + kk) * d.N + d.n0 + (lane & 31)); }
    if (d.kscale) {
#pragma unroll
        for (int i = 0; i < 32; ++i) { const int kk = 2 * i + (lane >> 5); v[i] *= d.kscale[d.k0 + kk]; } }
}
__device__ __forceinline__ void p0_tr_store(const TrItem& d, const float (&v)[32], LAS float* scr, int lane) {
#pragma unroll
    for (int i = 0; i < 32; ++i) { const int kk = 2 * i + (lane >> 5); scr[kk * 33 + (lane & 31)] = v[i]; }
    LDS_WAIT(); asm volatile("" ::: "memory");
    const int c = lane & 7;
#pragma unroll
    for (int j = 0; j < 4; ++j) { const int n = (lane >> 3) + 8 * j; const LAS float* s = scr + (8 * c) * 33 + n;
        u32x4 o; o.x = pk2(s[0 * 33], s[1 * 33]); o.y = pk2(s[2 * 33], s[3 * 33]); o.z = pk2(s[4 * 33], s[5 * 33]); o.w = pk2(s[6 * 33], s[7 * 33]);
        *(u32x4*)(d.WT + (size_t)(d.wt_row0 + n) * d.K + d.k0 + 8 * c) = o; }
    LDS_WAIT(); asm volatile("" ::: "memory");
}
__device__ __forceinline__ void ssm_tables(const Args& a, int g, LAS unsigned char* lds, int tid) {
    LAS float* LD = (LAS float*)lds;
    LAS float* LBs = LD + 256;
    LAS float* BB = LBs + 256;
    LAS float* KT = BB + 4096;
    LAS float* CC = KT + 8192;
    float* lb16 = (float*)(a.ws + WS_LB16);
    bf16_t* WIN = (bf16_t*)(a.ws + WS_WIN) + (size_t)g * 256 * 256;
    bf16_t* WBIG = (bf16_t*)(a.ws + WS_WBIG) + (size_t)g * 256 * 512;
    for (int e = tid; e < 2048; e += 512) { const int d = e >> 10, r = e & 1023; const size_t ci_ = (size_t)(d * NG + g) * 1024 + r; CC[e * 2] = a.c_re[ci_]; CC[e * 2 + 1] = a.c_im[ci_]; }
    if (tid < 128) {
        const int d = tid >> 6, p = tid & 63; const int idx = (d * NG + g) * 64 + p;
        const float lr = fminf(a.a_re[idx], -1e-4f), li = a.a_im[idx];
        const float dt = expf(a.log_dt[d * NG + g]);
        const float er = expf(lr * dt); float sn, cs; sincosf(li * dt, &sn, &cs);
        const float br = er * cs, bi = er * sn;
        LD[tid * 2] = lr * dt; LD[tid * 2 + 1] = li * dt; LBs[tid * 2] = br; LBs[tid * 2 + 1] = bi;
        const float nr = br - 1.f, ni = bi, den = lr * lr + li * li;
        KT[tid * 2] = (nr * lr + ni * li) / den; KT[tid * 2 + 1] = (ni * lr - nr * li) / den;
        const float e16 = expf(16.f * lr * dt); float s16, c16; sincosf(16.f * li * dt, &s16, &c16);
        lb16[(g * 128 + tid) * 2] = e16 * c16; lb16[(g * 128 + tid) * 2 + 1] = e16 * s16;
    }
    __syncthreads();
    for (int e = tid; e < 2048; e += 512) {
        const int dp = e >> 4, h = e & 15, d = dp >> 6, p = dp & 63;
        const size_t bi_ = ((size_t)(d * NG + g) * 64 + p) * 16 + h;
        const float xr = a.b_re[bi_], xi = a.b_im[bi_], cr = KT[dp * 2], ci = KT[dp * 2 + 1];
        BB[e * 2] = cr * xr - ci * xi; BB[e * 2 + 1] = cr * xi + ci * xr;
    }
    __syncthreads();
    {
        const int d = tid >> 8, hp = (tid >> 4) & 15, h = tid & 15; float acc[16];
#pragma unroll
        for (int t = 0; t < 16; ++t) acc[t] = 0.f;
        const LAS float* cc = CC + ((d * 16 + hp) * 64) * 2;
        for (int p = 0; p < 64; ++p) {
            const float c_r = cc[p * 2], c_i = cc[p * 2 + 1], b_r = BB[((d * 64 + p) * 16 + h) * 2], b_i = BB[((d * 64 + p) * 16 + h) * 2 + 1];
            float wr = c_r * b_r - c_i * b_i, wi = c_r * b_i + c_i * b_r; const float l_r = LBs[(d * 64 + p) * 2], l_i = LBs[(d * 64 + p) * 2 + 1];
#pragma unroll
            for (int t = 0; t < 16; ++t) { acc[t] += wr; const float nr = wr * l_r - wi * l_i; wi = wr * l_i + wi * l_r; wr = nr; }
        }
#pragma unroll
        for (int t = 0; t < 16; ++t) KT[((d * 16 + t) * 16 + hp) * 16 + h] = acc[t];
    }
    __syncthreads();
    for (int q = tid; q < 8192; q += 512) {
        const int n = q >> 5, kc = q & 31, s = kc >> 1, h0 = (kc & 1) * 8, j = n >> 4, hp = n & 15;
        float v[8];
#pragma unroll
        for (int e = 0; e < 8; ++e) { const int h = h0 + e;
            if (s < j) v[e] = KT[((0 * 16 + (j - s)) * 16 + hp) * 16 + h];
            else if (s > j) v[e] = KT[((1 * 16 + (s - j)) * 16 + hp) * 16 + h];
            else v[e] = KT[((0 * 16 + 0) * 16 + hp) * 16 + h] + KT[((1 * 16 + 0) * 16 + hp) * 16 + h] + (h == hp ? a.ssm_d[g * 16 + h] : 0.f); }
        u32x4 w; w.x = pk2(v[0], v[1]); w.y = pk2(v[2], v[3]); w.z = pk2(v[4], v[5]); w.w = pk2(v[6], v[7]);
        *(u32x4*)(WBIG + (size_t)n * 512 + s * 16 + h0) = w;
    }
    for (int q = tid; q < 2048; q += 512) {
        const int p = q & 63, js = (q >> 6) & 15, d = q >> 10; const float ldr = LD[(d * 64 + p) * 2], ldi = LD[(d * 64 + p) * 2 + 1];
        {   const float pw = (float)(d == 0 ? js + 1 : 16 - js); const float er = expf(pw * ldr); float sn, cs; sincosf(pw * ldi, &sn, &cs); const float pr = er * cs, pi = er * sn;
#pragma unroll
            for (int hp = 0; hp < 16; ++hp) { const float c_r = CC[((d * 16 + hp) * 64 + p) * 2], c_i = CC[((d * 16 + hp) * 64 + p) * 2 + 1];
                *(unsigned*)(WBIG + (size_t)(js * 16 + hp) * 512 + 256 + d * 128 + 2 * p) = pk2(c_r * pr - c_i * pi, -(c_r * pi + c_i * pr)); } }
        {   const float pw = (float)(d == 0 ? 15 - js : js); const float er = expf(pw * ldr); float sn, cs; sincosf(pw * ldi, &sn, &cs); const float pr = er * cs, pi = er * sn;
            float zr[16], zi[16];
#pragma unroll
            for (int h = 0; h < 16; ++h) { const float b_r = BB[((d * 64 + p) * 16 + h) * 2], b_i = BB[((d * 64 + p) * 16 + h) * 2 + 1]; zr[h] = pr * b_r - pi * b_i; zi[h] = pr * b_i + pi * b_r; }
            bf16_t* d0 = WIN + (size_t)(d * 128 + p) * 256 + js * 16; bf16_t* d1 = d0 + (size_t)64 * 256;
            u32x4 w; w.x = pk2(zr[0], zr[1]); w.y = pk2(zr[2], zr[3]); w.z = pk2(zr[4], zr[5]); w.w = pk2(zr[6], zr[7]); *(u32x4*)d0 = w;
            w.x = pk2(zr[8], zr[9]); w.y = pk2(zr[10], zr[11]); w.z = pk2(zr[12], zr[13]); w.w = pk2(zr[14], zr[15]); *(u32x4*)(d0 + 8) = w;
            w.x = pk2(zi[0], zi[1]); w.y = pk2(zi[2], zi[3]); w.z = pk2(zi[4], zi[5]); w.w = pk2(zi[6], zi[7]); *(u32x4*)d1 = w;
            w.x = pk2(zi[8], zi[9]); w.y = pk2(zi[10], zi[11]); w.z = pk2(zi[12], zi[13]); w.w = pk2(zi[14], zi[15]); *(u32x4*)(d1 + 8) = w; }
    }
    __syncthreads();
}

#define XB_TMO      128
#define XB_XCNT(j)  (256  + 64 * (j))
#define XB_XSUB(j)  (1280 + 64 * (j))
#define XB_XGEN(j)  (2304 + 64 * (j))
#define XB_TOP      3328
#define XB_TOPGEN   3392
#define XCD_BAR_WORDS 3456
#define XB_SPIN_CAP (1u << 18)
__device__ __forceinline__ unsigned xb_ld(unsigned* p)              { return __hip_atomic_load(p, __ATOMIC_RELAXED, __HIP_MEMORY_SCOPE_AGENT); }
__device__ __forceinline__ unsigned xb_add(unsigned* p, unsigned v) { return __hip_atomic_fetch_add(p, v, __ATOMIC_RELAXED, __HIP_MEMORY_SCOPE_AGENT); }
__device__ __forceinline__ unsigned xb_xcc_id() { return (unsigned)__builtin_amdgcn_s_getreg((3 << 11) | 20) & 0xFu; }
#define XB_SPIN(cond, bar) do { unsigned _sp = 0; while (cond) { __builtin_amdgcn_s_sleep(1); \
    if ((++_sp & 255u) == 0u) { if (xb_ld(&(bar)[XB_TMO])) break; if (_sp > XB_SPIN_CAP) { atomicAdd(&(bar)[XB_TMO], 1u); break; } } } } while (0)
struct XcdBarrier { unsigned* bar; unsigned x; volatile LAS unsigned* st; };
__device__ __forceinline__ XcdBarrier xcd_barrier_post(unsigned* bar, volatile LAS unsigned* st, bool leader) {
    XcdBarrier b; b.bar = bar; b.x = xb_xcc_id(); b.st = st;
    if (leader) (void)xb_add(&bar[XB_XCNT(b.x)], 1u);
    return b;
}
__device__ __forceinline__ void xcd_barrier_complete(unsigned* bar, unsigned x, unsigned& nloc, unsigned& nx) {
    const unsigned G = gridDim.x * gridDim.y * gridDim.z;
    unsigned sum, cnt, mine, sp = 0u;
    for (;;) {
        sum = 0u; cnt = 0u; mine = 0u;
#pragma unroll
        for (unsigned j = 0; j < 16; ++j) { const unsigned c = xb_ld(&bar[XB_XCNT(j)]); sum += c; cnt += (c > 0u) ? 1u : 0u; mine = (j == x) ? c : mine; }
        if (sum == G) break;
        __builtin_amdgcn_s_sleep(1);
        if ((++sp & 255u) == 0u) { if (xb_ld(&bar[XB_TMO])) break; if (sp > XB_SPIN_CAP) { atomicAdd(&bar[XB_TMO], 1u); break; } }
    }
    nloc = mine > 0u ? mine : 1u; nx = cnt > 0u ? cnt : 1u;
}
__device__ __forceinline__ void xcd_barrier(const XcdBarrier& b, bool leader) {
    asm volatile("s_waitcnt vmcnt(0)" ::: "memory");
    __syncthreads();
    if (leader) {
        unsigned* bar = b.bar;
        __builtin_amdgcn_s_waitcnt(0);
        unsigned nloc = b.st[0], nx = b.st[1];
        if (nloc == 0u) { xcd_barrier_complete(bar, b.x, nloc, nx); b.st[0] = nloc; b.st[1] = nx; }
        const unsigned old = xb_add(&bar[XB_XSUB(b.x)], 1u);
        const unsigned gen = old / nloc;
        if (old + 1u == (gen + 1u) * nloc) {
            __builtin_amdgcn_fence(__ATOMIC_RELEASE, "agent");
            asm volatile("s_waitcnt vmcnt(0)" ::: "memory");
            const unsigned og = xb_add(&bar[XB_TOP], 1u);
            const unsigned tg = og / nx;
            if (og + 1u == (tg + 1u) * nx) xb_add(&bar[XB_TOPGEN], 1u);
            else XB_SPIN(xb_ld(&bar[XB_TOPGEN]) == tg, bar);
            __builtin_amdgcn_fence(__ATOMIC_ACQUIRE, "agent");
            xb_add(&bar[XB_XGEN(b.x)], 1u);
            asm volatile("s_waitcnt vmcnt(0)" ::: "memory");
        } else {
            XB_SPIN(xb_ld(&bar[XB_XGEN(b.x)]) == gen, bar);
            __builtin_amdgcn_fence(__ATOMIC_ACQUIRE, "agent");
            asm volatile("s_waitcnt vmcnt(0)" ::: "memory");
        }
    }
    __syncthreads();
}

__global__ void __launch_bounds__(512, 2) fwd_kernel(Args a) {
    extern __shared__ __attribute__((aligned(16))) unsigned char lds_raw[];
    LAS unsigned char* lds = (LAS unsigned char*)lds_raw;
    cg::grid_group grid = cg::this_grid();
    const int wave = __builtin_amdgcn_readfirstlane(threadIdx.x >> 6);
    const bool leader = (wave == 0) && (lane_id_opaque() == 0);
    volatile LAS unsigned* xst = (volatile LAS unsigned*)(lds + XBST_OFF);
    if (leader) { xst[0] = 0u; xst[1] = 0u; }
    __syncthreads();
    if (a.ws == nullptr) grid.sync();
    const XcdBarrier xbar = xcd_barrier_post((unsigned*)(a.ws + WS_BAR), xst, leader);
#define GRID_SYNC() xcd_barrier(xbar, (wave == 0) && (lane_id_opaque() == 0))
#define LANE_IDS const int lane = lane_id_opaque(), tid = wave * 64 + lane; (void)tid;
    const int G = gridDim.x, bid = blockIdx.x;
    unsigned char* ws = a.ws;
    bf16_t* W1T = (bf16_t*)(ws + WS_W1T); bf16_t* WGLUT = (bf16_t*)(ws + WS_WGLUT); bf16_t* WOT = (bf16_t*)(ws + WS_WOT); bf16_t* WGT = (bf16_t*)(ws + WS_WGT); bf16_t* WPT = (bf16_t*)(ws + WS_WPT);
    float2* ROPE = (float2*)(ws + WS_ROPE); float* RINV = (float*)(ws + WS_RINV); float* LB16 = (float*)(ws + WS_LB16); float* SSQ1 = (float*)(ws + WS_SSQ1); float* SSQ2 = (float*)(ws + WS_SSQ2);
    bf16_t* PB = (bf16_t*)(ws + WS_PB); bf16_t* WIN = (bf16_t*)(ws + WS_WIN); bf16_t* WBIG = (bf16_t*)(ws + WS_WBIG);
    bf16_t* XB = (bf16_t*)(ws + WS_XB); bf16_t* HB = (bf16_t*)(ws + WS_XB);
    bf16_t* Q = (bf16_t*)(ws + WS_Q); bf16_t* KB = (bf16_t*)(ws + WS_K); bf16_t* VB = (bf16_t*)(ws + WS_V); bf16_t* GA = (bf16_t*)(ws + WS_GA); bf16_t* GS = (bf16_t*)(ws + WS_GS);
    bf16_t* UCAT = (bf16_t*)(ws + WS_UCAT); bf16_t* PPB = (bf16_t*)(ws + WS_UCAT); bf16_t* YMIX = (bf16_t*)(ws + WS_YMIX); bf16_t* YS = (bf16_t*)(ws + WS_YS);

#pragma unroll
    for (int rep_ = 0; rep_ < 1 + ((REP_MASK >> 0) & 1); ++rep_) { LANE_IDS
        const int gw = bid * 8 + wave, NGW = G * 8;
        LAS float* scr = (LAS float*)(lds + wave * 16384);
        constexpr int I1 = 32 * 144, I2 = 16 * 64, I3 = 32 * 64, I4 = 32 * 64, I5 = 4 * 64, NIT = I1 + I2 + I3 + I4 + I5;
        auto item_desc = [&](int r) -> TrItem {
            if (r < I1) { const int kb = r / 144, lgg = r % 144, pn = lgg >> 3, lg = lgg & 7, wtg = pn * 8 + 4 * (lg & 1) + 2 * (lg >> 2) + ((lg >> 1) & 1);
                return TrItem{a.w_in, W1T, a.norm_mix, DM, DIN, wtg * 32, kb * 64, lgg * 32}; } r -= I1;
            if (r < I2) { const int kb = r / 64, lgg = r % 64, l2 = lgg & 31, wtg = (l2 >> 2) * 8 + 4 * (lgg >> 5) + (l2 & 3);
                return TrItem{a.w_glu, WGLUT, nullptr, DSSM, 2 * DSSM, wtg * 32, kb * 64, lgg * 32}; } r -= I2;
            if (r < I3) { const int kb = r / 64, lgg = r % 64; return TrItem{a.w_out, WOT, nullptr, DM, DM, lgg * 32, kb * 64, lgg * 32}; } r -= I3;
            if (r < I4) { const int kb = r / 64, lgg = r % 64; return TrItem{a.w_ple_gate, WGT, a.norm_ple, DM, DM, lgg * 32, kb * 64, lgg * 32}; } r -= I4;
            const int kb = r / 64, lgg = r % 64; return TrItem{a.w_ple_proj, WPT, nullptr, PLE, DM, lgg * 32, kb * 64, lgg * 32};
        };
#pragma unroll
        for (int rq_ = 0; rq_ < 1 + ((REP_MASK >> 8) & 1); ++rq_)
        for (int it = gw; it < NIT; it += 2 * NGW) {
            const bool two = it + NGW < NIT;
            const TrItem dA = item_desc(it), dB = item_desc(two ? it + NGW : it);
            float vA[32], vB[32];
            p0_tr_load(dA, vA, lane); if (two) p0_tr_load(dB, vB, lane);
            p0_tr_store(dA, vA, scr, lane); if (two) p0_tr_store(dB, vB, scr, lane);
        }
#pragma unroll
        for (int rq_ = 0; rq_ < 1 + ((REP_MASK >> 9) & 1); ++rq_)
        for (int m = gw; m < T; m += 2 * NGW) {
            const int m2 = m + NGW; const bool two = m2 < T;
            const f32x4* xr = (const f32x4*)(a.x + (size_t)m * DM) + lane; const f32x4* xr2 = (const f32x4*)(a.x + (size_t)(two ? m2 : m) * DM) + lane;
            f32x4 v[8], w2[8]; float s = 0.f, s2 = 0.f;
#pragma unroll
            for (int j = 0; j < 8; ++j) v[j] = __builtin_nontemporal_load(xr + 64 * j);
#pragma unroll
            for (int j = 0; j < 8; ++j) w2[j] = __builtin_nontemporal_load(xr2 + 64 * j);
#pragma unroll
            for (int j = 0; j < 8; ++j) { s += (v[j][0] * v[j][0] + v[j][1] * v[j][1]) + (v[j][2] * v[j][2] + v[j][3] * v[j][3]); s2 += (w2[j][0] * w2[j][0] + w2[j][1] * w2[j][1]) + (w2[j][2] * w2[j][2] + w2[j][3] * w2[j][3]); }
            s = wave_sum(s); s2 = wave_sum(s2);
            if (lane == 0) { RINV[m] = rsqrtf(s * (1.f / DM) + EPS); if (two) RINV[m2] = rsqrtf(s2 * (1.f / DM) + EPS); }
            u32x2* o = (u32x2*)(XB + (size_t)m * DM) + lane; u32x2* o2 = (u32x2*)(XB + (size_t)m2 * DM) + lane;
#pragma unroll
            for (int j = 0; j < 8; ++j) { u32x2 w; w.x = pk2(v[j][0], v[j][1]); w.y = pk2(v[j][2], v[j][3]); o[64 * j] = w; }
            if (two) {
#pragma unroll
                for (int j = 0; j < 8; ++j) { u32x2 w; w.x = pk2(w2[j][0], w2[j][1]); w.y = pk2(w2[j][2], w2[j][3]); o2[64 * j] = w; } }
        }
        for (int i = bid * 512 + tid; i < T * PLE / 4; i += G * 512) { const f32x4 v = __builtin_nontemporal_load((const f32x4*)a.p + i); u32x2 w; w.x = pk2(v[0], v[1]); w.y = pk2(v[2], v[3]); ((u32x2*)PB)[i] = w; }
        for (int i = bid * 512 + tid; i < 2048; i += G * 512) { const int pos = i >> 5, f = i & 31; const float inv = powf(10000.f, -(float)f / 32.f); float sn, cs; sincosf((float)pos * inv, &sn, &cs); ROPE[i] = make_float2(cs, sn); }
    GRID_SYNC(); }


    if constexpr ((REP_MASK >> 10) & 1) { GRID_SYNC(); GRID_SYNC(); GRID_SYNC(); GRID_SYNC(); }
#pragma unroll
    for (int rep_ = 0; rep_ < 1 + ((REP_MASK >> 1) & 1); ++rep_) { LANE_IDS
        { pg8::Gemm g{XB, W1T, DM, DM, DM, 0, 0}; pg8::StaticOrder S; S.init(T, 14 * 256, G, bid);
          pg8::Epi1 E{RINV, a.q_norm, a.k_norm, ROPE, Q, KB, VB, GA, GS, UCAT, (LAS float*)(lds + XCH_OFF), 0};
          pg8::gemm_phase<pg8::Epi1, pg8::StaticOrder, true>(lds, g, S, E, wave); }
        __syncthreads();
        for (int gi = bid - (G - NG); gi >= 0 && gi < NG; gi += NG) ssm_tables(a, gi, lds, tid);
    GRID_SYNC(); }

#pragma unroll
    for (int rep_ = 0; rep_ < 1 + ((REP_MASK >> 2) & 1); ++rep_) {
#pragma unroll
        for (int rq_ = 0; rq_ < 2; ++rq_) {
        if (bid < 2 * NG) { if (rq_ == 1 && !((REP_MASK >> 6) & 1)) break;
            pg8::BatchOrder S{2 * NG, G, bid};
            { pg8::Gemm g{UCAT, WIN, 256, 512, 256, (size_t)NCH * 512 * 2, (size_t)256 * 256 * 2};
              pg8::EpiS1 E{LB16, UCAT}; pg8::gemm_phase<pg8::EpiS1, pg8::BatchOrder, true>(lds, g, S, E, wave); }
            asm volatile("s_waitcnt vmcnt(0)\n\tbuffer_inv sc1\n\ts_waitcnt vmcnt(0)" ::: "memory"); __syncthreads();
            { pg8::Gemm g{UCAT, WBIG, 512, 512, 512, (size_t)NCH * 512 * 2, (size_t)256 * 512 * 2};
              pg8::EpiS2 E{YS}; pg8::gemm_phase<pg8::EpiS2, pg8::BatchOrder, true>(lds, g, S, E, wave); }
        } else { if (rq_ == 1 && !((REP_MASK >> 11) & 1)) break;
            pg8::Gemm g{XB, W1T + (size_t)14 * 256 * DM, DM, DM, DM, 0, 0}; pg8::ListOrder S{bid - 2 * NG, 128, G};
            pg8::Epi1 E{RINV, a.q_norm, a.k_norm, ROPE, Q, KB, VB, GA, GS, UCAT, (LAS float*)(lds + XCH_OFF), 14};
            pg8::gemm_phase<pg8::Epi1, pg8::ListOrder, true>(lds, g, S, E, wave);
        }
        __syncthreads(); }
#pragma unroll
        for (int rq_ = 0; rq_ < 1 + ((REP_MASK >> 7) & 1); ++rq_)
        for (int un = bid; un < 256; un += G) {
            const int x = un & 7, jj = un >> 3, b = x >> 2, kvh = (x >> 1) & 1, idx = (x & 1) * 32 + jj, h = kvh * 4 + (idx >> 4), qb = idx & 15;
            const size_t tok0 = (size_t)b * SEQ + qb * 256;
            att::attn_dense_body(Q + tok0 * DATT + h * 128, KB + (size_t)b * SEQ * DKV + kvh * 128, VB + (size_t)b * SEQ * DKV + kvh * 128,
                                 GA + tok0 * DATT + h * 128, YMIX + tok0 * DM + h * 128, SEQ, (char*)lds_raw, wave);
        }
    GRID_SYNC(); }

#pragma unroll
    for (int rep_ = 0; rep_ < 1 + ((REP_MASK >> 3) & 1); ++rep_) {
        { pg8::StaticOrder S; S.init(T, 2 * DSSM, G, bid); pg8::Unit ua, ub;
          if (S.next(0, ua)) { ub = ua;
            pg8::Gemm ga{YS, WGLUT, DSSM, DSSM, DSSM, 0, 0}; pg8::EpiGlu Ea{a.b_glu, GS, YMIX};
            pg8::Gemm gb{PB, WPT, PLE, PLE, PLE, 0, 0}; pg8::EpiBf Eb{PPB, DM};
            pg8::gemm_phase2<pg8::EpiGlu, pg8::EpiBf>(lds, ga, ua, Ea, gb, ub, Eb, wave); } }
    GRID_SYNC(); }

#pragma unroll
    for (int rep_ = 0; rep_ < 1 + ((REP_MASK >> 4) & 1); ++rep_) {
        pg8::Gemm g{YMIX, WOT, DM, DM, DM, 0, 0}; pg8::StaticOrder S; S.init(T, DM, G, bid);
        pg8::EpiOut E{a.x, a.out, HB, SSQ1}; pg8::gemm_phase<pg8::EpiOut, pg8::StaticOrder, true>(lds, g, S, E, wave);
    GRID_SYNC(); }


    { LANE_IDS
        pg8::StaticOrder S; S.init(T, DM, G, bid); pg8::Unit u0;
        LAS float* r2 = (LAS float*)(lds + R2_OFF);
        if (S.next(0, u0) && tid < 256) { const float* sp = SSQ1 + (size_t)(u0.pm * 256 + tid) * 32; float s = 0.f;
#pragma unroll
            for (int i = 0; i < 8; ++i) { const f32x4 v = ((const f32x4*)sp)[i]; s += (v[0] + v[1]) + (v[2] + v[3]); }
            r2[tid] = rsqrtf(s * (1.f / DM) + EPS); }
        __syncthreads();
        pg8::Gemm g{HB, WGT, DM, DM, DM, 0, 0};
        pg8::EpiGate E{a.out, PPB, SSQ2, (unsigned*)ws, a.norm_final, r2, HB}; pg8::gemm_phase<pg8::EpiGate, pg8::StaticOrder, true>(lds, g, S, E, wave);
    }
}

extern "C" void kernel_launch(void* const* d_in, const int* in_sizes, int n_in, void* d_out, int out_size, void* d_ws, size_t ws_size, hipStream_t stream) {
    static int grid = 0;
    if (grid == 0) {
        if (n_in != 21 || in_sizes[0] != T * DM || out_size != T * DM || ws_size < WS_END) { fprintf(stderr, "kernel_launch: unexpected shapes (n_in %d, in0 %d, out %d, ws %zu)\n", n_in, n_in > 0 ? in_sizes[0] : -1, out_size, ws_size); grid = -1; return; }
        int dev = 0, cus = 0, per_cu = 0;
        hipGetDevice(&dev); hipDeviceGetAttribute(&cus, hipDeviceAttributeMultiprocessorCount, dev);
        if (hipFuncSetAttribute((const void*)fwd_kernel, hipFuncAttributeMaxDynamicSharedMemorySize, LDS_BYTES) != hipSuccess) { fprintf(stderr, "kernel_launch: hipFuncSetAttribute failed\n"); grid = -1; return; }
        hipOccupancyMaxActiveBlocksPerMultiprocessor(&per_cu, (const void*)fwd_kernel, 512, LDS_BYTES);
        (void)hipGetLastError();
        if (per_cu < 1) fprintf(stderr, "kernel_launch: occupancy query reports %d blocks per CU\n", per_cu);
        grid = cus > 256 ? 256 : cus;
    }
    if (grid < 0) return;
    Args a{};
    const float** f = (const float**)&a;
    for (int i = 0; i < 21; ++i) f[i] = (const float*)d_in[i];
    a.out = (float*)d_out; a.ws = (unsigned char*)d_ws;
    if (hipMemsetAsync(d_ws, 0, WS_CTL_BYTES, stream) != hipSuccess) { fprintf(stderr, "kernel_launch: hipMemsetAsync failed\n"); return; }
    void* args[] = {&a};
    hipError_t e = hipLaunchCooperativeKernel((const void*)fwd_kernel, dim3(grid), dim3(512), args, LDS_BYTES, stream);
    if (e != hipSuccess) fprintf(stderr, "kernel_launch: cooperative launch failed: %s (grid %d)\n", hipGetErrorString(e), grid);
}
```

```cpp
#include <hip/hip_runtime.h>
#include <hip/hip_cooperative_groups.h>
#include <cstdio>
#include <cstdint>
namespace cg = cooperative_groups;

#define LAS __attribute__((address_space(3)))
typedef unsigned short bf16_t;
typedef short bf16x8 __attribute__((ext_vector_type(8)));
typedef short s16x4 __attribute__((ext_vector_type(4)));
typedef float f32x4 __attribute__((ext_vector_type(4)));
typedef float f32x16 __attribute__((ext_vector_type(16)));
typedef unsigned u32x4 __attribute__((ext_vector_type(4)));
typedef unsigned u32x2 __attribute__((ext_vector_type(2)));

constexpr int T = 8192, SEQ = 4096, DM = 2048, DIN = 4608, DATT = 1024, DKV = 256, DSSM = 1024, PLE = 256;
constexpr int NG = 64, NCH = T / 16;
constexpr float EPS = 1e-6f;
#ifndef PH_MASK
#define PH_MASK 0xff
#endif
#ifndef GLDS_AUX
#define GLDS_AUX 0
#endif
#ifndef REP_MASK
#define REP_MASK 0
#endif

constexpr size_t MiB = 1u << 20;
constexpr size_t WS_W1T = 1 * MiB, WS_WGLUT = 19 * MiB, WS_WOT = 23 * MiB, WS_WGT = 31 * MiB, WS_WPT = 39 * MiB;
constexpr size_t WS_ROPE = 40 * MiB, WS_RINV = 40 * MiB + 65536, WS_LB16 = 40 * MiB + 131072, WS_SSQ1 = 41 * MiB, WS_SSQ2 = 42 * MiB;
constexpr size_t WS_PB = 43 * MiB, WS_WIN = 47 * MiB, WS_WBIG = 55 * MiB;
constexpr size_t WS_XB = 71 * MiB;
constexpr size_t WS_Q = 103 * MiB, WS_K = 119 * MiB, WS_V = 123 * MiB, WS_GA = 127 * MiB, WS_GS = 143 * MiB;
constexpr size_t WS_UCAT = 159 * MiB;
constexpr size_t WS_YMIX = 191 * MiB, WS_YS = 223 * MiB, WS_END = 239 * MiB;

constexpr int RING_BYTES = 131072, XCH_OFF = RING_BYTES, R2_OFF = RING_BYTES + 4096, XBST_OFF = RING_BYTES + 8192, LDS_BYTES = 147456;
constexpr size_t WS_BAR = 65536, WS_CTL_BYTES = 131072;

struct Args {
    const float *x, *p, *norm_mix, *w_in, *q_norm, *k_norm, *a_re, *a_im, *log_dt, *b_re, *b_im, *c_re, *c_im, *ssm_d, *w_glu, *b_glu, *w_out, *norm_ple, *w_ple_gate, *w_ple_proj, *norm_final;
    float* out; unsigned char* ws;
};

typedef __bf16 bf16s_;
__device__ __forceinline__ unsigned f2bf(float f) { return (unsigned)__builtin_bit_cast(unsigned short, (bf16s_)f); }
typedef float f32x2_ __attribute__((ext_vector_type(2)));
typedef __bf16 bf16x2_ __attribute__((ext_vector_type(2)));
__device__ __forceinline__ unsigned pk2(float lo, float hi) { const f32x2_ v = {lo, hi}; return __builtin_bit_cast(unsigned, __builtin_convertvector(v, bf16x2_)); }
__device__ __forceinline__ float bf2f(unsigned short b) { return __builtin_bit_cast(float, (unsigned)b << 16); }
__device__ __forceinline__ float bflo(unsigned w) { return __builtin_bit_cast(float, w << 16); }
__device__ __forceinline__ float bfhi(unsigned w) { return __builtin_bit_cast(float, w & 0xffff0000u); }
__device__ __forceinline__ unsigned cvt_pk_bf16(float lo, float hi) { unsigned r; asm volatile("v_cvt_pk_bf16_f32 %0, %1, %2" : "=v"(r) : "v"(lo), "v"(hi)); return r; }
__device__ __forceinline__ float sigmoidf_(float v) { return __builtin_amdgcn_rcpf(1.f + __builtin_amdgcn_exp2f(-1.4426950408889634f * v)); }
__device__ __forceinline__ float siluf_(float v) { return v * __builtin_amdgcn_rcpf(1.f + __builtin_amdgcn_exp2f(-1.4426950408889634f * v)); }
__device__ __forceinline__ float gelu_tanh(float v) { const float t = (-1.5957691216057308f * 1.4426950408889634f) * (v + 0.044715f * v * v * v); return v * __builtin_amdgcn_rcpf(1.f + __builtin_amdgcn_exp2f(t)); }
template <int K> __device__ __forceinline__ float swz_xor(float v) { return __int_as_float(__builtin_amdgcn_ds_swizzle(__float_as_int(v), (K << 10) | 0x1f)); }
__device__ __forceinline__ float sum_xor32(float v) { auto rr = __builtin_amdgcn_permlane32_swap(__float_as_uint(v), __float_as_uint(v), false, false); return __uint_as_float(rr[0]) + __uint_as_float(rr[1]); }
__device__ __forceinline__ float wave_sum(float v) { v += swz_xor<1>(v); v += swz_xor<2>(v); v += swz_xor<4>(v); v += swz_xor<8>(v); v += swz_xor<16>(v); return sum_xor32(v); }
#define LDS_WAIT() asm volatile("s_waitcnt lgkmcnt(0)" ::: "memory")
__device__ __forceinline__ int lane_id_opaque() { int l = __builtin_amdgcn_mbcnt_hi(~0u, __builtin_amdgcn_mbcnt_lo(~0u, 0u)); asm volatile("" : "+v"(l)); return l; }

namespace pg8 {
constexpr int BM = 256, BK = 64, HALF = 128, HTB = HALF * BK * 2, NXCD = 8, WGM = 8;
__host__ __device__ __forceinline__ int lds_byte(int r, int c) { const int st = (r >> 4) * 2 + (c >> 5), rr = r & 15, cc = c & 31, ob = rr * 64 + cc * 2; return st * 1024 + (ob ^ (((ob >> 9) & 1) << 5)); }
__host__ __device__ __forceinline__ void stage_rc(int b, int& R, int& C) { const int st = b / 1024, sb = b % 1024, swz = sb ^ (((sb >> 9) & 1) << 5); R = (st >> 1) * 16 + swz / 64; C = (st & 1) * 32 + (swz % 64) / 2; }
__host__ __device__ __forceinline__ int perm32(int rho) { const int n = rho >> 4, i = rho & 15; return 8 * (i >> 2) + 4 * n + (i & 3); }

struct Unit { int pm, pn, z; };
struct Gemm { const bf16_t* A; const bf16_t* Bt; int K, lda, ldb; size_t zA, zB; };

struct StaticOrder {
    int nM, nN, nwg, G, c;
    __device__ void init(int M, int N, int G_, int c_) { nM = M / BM; nN = N / BM; nwg = nM * nN; G = G_; c = c_; }
    __device__ bool next(int i, Unit& u) const {
        const long L = (long)i * G + c; if (L >= nwg) return false;
        int wgid = (int)L; { const int q = nwg / NXCD, r = nwg % NXCD, xcd = wgid % NXCD, off = wgid / NXCD; wgid = (xcd < r ? xcd * (q + 1) : r * (q + 1) + (xcd - r) * q) + off; }
        const int nig = WGM * nN, gid = wgid / nig, fm = gid * WGM, gsz = (nM - fm) < WGM ? (nM - fm) : WGM;
        u.pm = fm + ((wgid % nig) % gsz); u.pn = (wgid % nig) / gsz; u.z = 0; return true;
    }
};
struct BatchOrder {
    int n, G, c;
    __device__ bool next(int i, Unit& u) const { const int L = i * G + c; if (L >= n) return false; u.z = L >> 1; u.pm = L & 1; u.pn = 0; return true; }
};

struct ListOrder {
    int L0, n, stride;
    __device__ bool next(int i, Unit& u) const { const int L = L0 + i * stride; if (L < 0 || L >= n) return false;
        const int x = L & 7, j = L >> 3; u.pm = 4 * x + (j >> 2); u.pn = j & 3; u.z = 0; return true; }
};
template <class Epi, class Sched, bool ALIGN_EPI>
__device__ __forceinline__ void gemm_phase(LAS unsigned char* lds, const Gemm g, const Sched& S, const Epi& E, const int wid) {
    const int lane = lane_id_opaque(), tid = wid * 64 + lane, wr = wid >> 2, wc = wid & 3, fr = lane & 15, fq = lane >> 4;
    const int K = g.K, nt = K / BK;
    unsigned voffA[2], voffB[2];
#pragma unroll
    for (int i = 0; i < 2; ++i) { int R, C; stage_rc(tid * 16 + i * 8192, R, C); const int Rb = (R & ~31) + perm32(R & 31);
        voffA[i] = (unsigned)(R * g.lda + C) * 2u; voffB[i] = (unsigned)(Rb * g.ldb + C) * 2u; }
    const size_t kstep = (size_t)(BK * 2);
    const size_t hstepA = (size_t)HALF * g.lda * 2, hstepB = (size_t)HALF * g.ldb * 2;
    const size_t tstepA = 2 * hstepA, tstepB = 2 * hstepB;
    const unsigned ldsw = (unsigned)wid * 1024u;
    const int aoff = lds_byte(wr * 64 + fr, fq * 8), boff = lds_byte(wc * 32 + fr, fq * 8);
#define PG8_SA(b, h) (((b) * 2 + (h)) * HTB)
#define PG8_SB(b, h) ((4 + (b) * 2 + (h)) * HTB)
#define PG8_STAGE(bufoff, gbase, voff) do { _Pragma("unroll") for (int _i = 0; _i < 2; ++_i) \
        __builtin_amdgcn_global_load_lds((const unsigned*)((const char*)(gbase) + (voff)[_i]), (LAS unsigned*)(lds + (bufoff) + ldsw + _i * 8192), 16, 0, GLDS_AUX); } while (0)
#define PG8_LDA(dst, b, h) do { _Pragma("unroll") for (int m = 0; m < 4; ++m) _Pragma("unroll") for (int k = 0; k < 2; ++k) dst[m][k] = *(const LAS bf16x8*)(lds + PG8_SA(b, h) + aoff + m * 2048 + k * 1024); } while (0)
#define PG8_LDB(dst, b, h) do { _Pragma("unroll") for (int n = 0; n < 2; ++n) _Pragma("unroll") for (int k = 0; k < 2; ++k) dst[n][k] = *(const LAS bf16x8*)(lds + PG8_SB(b, h) + boff + n * 2048 + k * 1024); } while (0)
#define PG8_MMA(ai, bj, At, Bt) do { __builtin_amdgcn_s_setprio(1); _Pragma("unroll") for (int m = 0; m < 4; ++m) _Pragma("unroll") for (int n = 0; n < 2; ++n) _Pragma("unroll") for (int k = 0; k < 2; ++k) \
        acc[ai][bj][m][n] = __builtin_amdgcn_mfma_f32_16x16x32_bf16(Bt[n][k], At[m][k], acc[ai][bj][m][n], 0, 0, 0); __builtin_amdgcn_s_setprio(0); } while (0)
#define PG8_WAIT_V(n) asm volatile("s_waitcnt vmcnt(" #n ")" ::: "memory")
#define PG8_WAIT_L(n) asm volatile("s_waitcnt lgkmcnt(" #n ")" ::: "memory")
#define PG8_BAR __builtin_amdgcn_s_barrier()
#define PG8_SCHED __builtin_amdgcn_sched_barrier(0)
    Unit cur, nxt; int ui = 0;
    if (!S.next(0, cur)) return;
    f32x4 acc[2][2][4][2];
#pragma unroll
    for (int a = 0; a < 2; ++a)
#pragma unroll
        for (int b = 0; b < 2; ++b)
#pragma unroll
            for (int m = 0; m < 4; ++m)
#pragma unroll
                for (int n = 0; n < 2; ++n) acc[a][b][m][n] = (f32x4){0.f, 0.f, 0.f, 0.f};
    bf16x8 At[4][2], B0[2][2], B1[2][2];
    const char* cA = (const char*)g.A + (size_t)cur.z * g.zA + (size_t)cur.pm * tstepA; const char* cB = (const char*)g.Bt + (size_t)cur.z * g.zB + (size_t)cur.pn * tstepB;
    PG8_STAGE(PG8_SB(0, 0), cB, voffB); PG8_STAGE(PG8_SB(0, 1), cB + hstepB, voffB); PG8_STAGE(PG8_SA(0, 0), cA, voffA); PG8_STAGE(PG8_SA(0, 1), cA + hstepA, voffA);
    if (wr == 1) PG8_BAR;
    PG8_WAIT_V(2); PG8_BAR;
    PG8_STAGE(PG8_SB(1, 0), cB + kstep, voffB); PG8_STAGE(PG8_SA(1, 0), cA + kstep, voffA); PG8_STAGE(PG8_SB(1, 1), cB + hstepB + kstep, voffB);
    PG8_WAIT_V(6); PG8_BAR;
    for (;;) {
        const bool has_next = S.next(ui + 1, nxt);
        const char* nA = has_next ? (const char*)g.A + (size_t)nxt.z * g.zA + (size_t)nxt.pm * tstepA : cA;
        const char* nB = has_next ? (const char*)g.Bt + (size_t)nxt.z * g.zB + (size_t)nxt.pn * tstepB : cB;
        for (int t = 0; t < nt; t += 2) {
            const bool last = (t == nt - 2);
            const char* a1 = cA + (size_t)(t + 1) * kstep;
            const char* a2 = last ? nA : cA + (size_t)(t + 2) * kstep; const char* b2 = last ? nB : cB + (size_t)(t + 2) * kstep;
            const char* a3 = a2 + kstep; const char* b3 = b2 + kstep;
            PG8_LDB(B0, 0, 0); PG8_LDB(B1, 0, 1); PG8_SCHED; PG8_LDA(At, 0, 0); PG8_STAGE(PG8_SA(1, 1), a1 + hstepA, voffA);
            PG8_WAIT_V(8); PG8_WAIT_L(0); PG8_BAR; PG8_MMA(0, 0, At, B0); PG8_MMA(0, 1, At, B1); PG8_BAR; PG8_SCHED;
            PG8_LDA(At, 0, 1); PG8_STAGE(PG8_SB(0, 0), b2, voffB); PG8_STAGE(PG8_SB(0, 1), b2 + hstepB, voffB); PG8_STAGE(PG8_SA(0, 0), a2, voffA);
            PG8_WAIT_V(8); PG8_WAIT_L(0); PG8_BAR; PG8_MMA(1, 0, At, B0); PG8_MMA(1, 1, At, B1); PG8_BAR; PG8_SCHED;
            PG8_LDB(B0, 1, 0); PG8_LDB(B1, 1, 1); PG8_SCHED; PG8_LDA(At, 1, 0); PG8_STAGE(PG8_SA(0, 1), a2 + hstepA, voffA);
            PG8_WAIT_V(8); PG8_WAIT_L(0); PG8_BAR; PG8_MMA(0, 0, At, B0); PG8_MMA(0, 1, At, B1); PG8_BAR; PG8_SCHED;
            PG8_LDA(At, 1, 1); PG8_STAGE(PG8_SB(1, 0), b3, voffB); PG8_STAGE(PG8_SB(1, 1), b3 + hstepB, voffB); PG8_STAGE(PG8_SA(1, 0), a3, voffA);
            PG8_WAIT_V(8); PG8_WAIT_L(0); PG8_BAR; PG8_MMA(1, 0, At, B0); PG8_MMA(1, 1, At, B1); PG8_BAR; PG8_SCHED;
        }
        if constexpr (ALIGN_EPI) { if (wr == 0) PG8_BAR; }
        if constexpr (!Epi::AFTER_DRAIN) E(acc, cur, wr, wc, fr, fq);
        if (!has_next) break;
#pragma unroll
        for (int a = 0; a < 2; ++a)
#pragma unroll
            for (int b = 0; b < 2; ++b)
#pragma unroll
                for (int m = 0; m < 4; ++m)
#pragma unroll
                    for (int n = 0; n < 2; ++n) acc[a][b][m][n] = (f32x4){0.f, 0.f, 0.f, 0.f};
        cur = nxt; cA = nA; cB = nB; ++ui;
        if constexpr (ALIGN_EPI) { if (wr == 1) PG8_BAR; }
    }
    PG8_WAIT_V(0);
    if constexpr (!ALIGN_EPI) { if (wr == 0) PG8_BAR; }
    PG8_BAR;
    if constexpr (Epi::AFTER_DRAIN) E.fused(acc, cur, wr, wc, lds, wid);
#undef PG8_SA
#undef PG8_SB
#undef PG8_STAGE
#undef PG8_LDA
#undef PG8_LDB
#undef PG8_MMA
#undef PG8_WAIT_V
#undef PG8_WAIT_L
#undef PG8_BAR
#undef PG8_SCHED
}

template <class EpiA, class EpiB>
__device__ __forceinline__ void gemm_phase2(LAS unsigned char* lds, const Gemm g0, const Unit u0, const EpiA& E0, const Gemm g1, const Unit u1, const EpiB& E1, const int wid) {
    const int lane = lane_id_opaque(), tid = wid * 64 + lane, wr = wid >> 2, wc = wid & 3, fr = lane & 15, fq = lane >> 4;
    unsigned vA0[2], vB0[2], vA1[2], vB1[2];
#pragma unroll
    for (int i = 0; i < 2; ++i) { int R, C; stage_rc(tid * 16 + i * 8192, R, C); const int Rb = (R & ~31) + perm32(R & 31);
        vA0[i] = (unsigned)(R * g0.lda + C) * 2u; vB0[i] = (unsigned)(Rb * g0.ldb + C) * 2u; vA1[i] = (unsigned)(R * g1.lda + C) * 2u; vB1[i] = (unsigned)(Rb * g1.ldb + C) * 2u; }
    const size_t kstep = (size_t)(BK * 2);
    const size_t hA0 = (size_t)HALF * g0.lda * 2, hB0 = (size_t)HALF * g0.ldb * 2, hA1 = (size_t)HALF * g1.lda * 2, hB1 = (size_t)HALF * g1.ldb * 2;
    const unsigned ldsw = (unsigned)wid * 1024u;
    const int aoff = lds_byte(wr * 64 + fr, fq * 8), boff = lds_byte(wc * 32 + fr, fq * 8);
#define PG8_SA(b, h) (((b) * 2 + (h)) * HTB)
#define PG8_SB(b, h) ((4 + (b) * 2 + (h)) * HTB)
#define PG8_STAGE(bufoff, gbase, voff) do { _Pragma("unroll") for (int _i = 0; _i < 2; ++_i) \
        __builtin_amdgcn_global_load_lds((const unsigned*)((const char*)(gbase) + (voff)[_i]), (LAS unsigned*)(lds + (bufoff) + ldsw + _i * 8192), 16, 0, 0); } while (0)
#define PG8_LDA(dst, b, h) do { _Pragma("unroll") for (int m = 0; m < 4; ++m) _Pragma("unroll") for (int k = 0; k < 2; ++k) dst[m][k] = *(const LAS bf16x8*)(lds + PG8_SA(b, h) + aoff + m * 2048 + k * 1024); } while (0)
#define PG8_LDB(dst, b, h) do { _Pragma("unroll") for (int n = 0; n < 2; ++n) _Pragma("unroll") for (int k = 0; k < 2; ++k) dst[n][k] = *(const LAS bf16x8*)(lds + PG8_SB(b, h) + boff + n * 2048 + k * 1024); } while (0)
#define PG8_MMA(ai, bj, At, Bt) do { __builtin_amdgcn_s_setprio(1); _Pragma("unroll") for (int m = 0; m < 4; ++m) _Pragma("unroll") for (int n = 0; n < 2; ++n) _Pragma("unroll") for (int k = 0; k < 2; ++k) \
        acc[ai][bj][m][n] = __builtin_amdgcn_mfma_f32_16x16x32_bf16(Bt[n][k], At[m][k], acc[ai][bj][m][n], 0, 0, 0); __builtin_amdgcn_s_setprio(0); } while (0)
#define PG8_WAIT_V(n) asm volatile("s_waitcnt vmcnt(" #n ")" ::: "memory")
#define PG8_WAIT_L(n) asm volatile("s_waitcnt lgkmcnt(" #n ")" ::: "memory")
#define PG8_BAR __builtin_amdgcn_s_barrier()
#define PG8_SCHED __builtin_amdgcn_sched_barrier(0)
    f32x4 acc[2][2][4][2];
#pragma unroll
    for (int a = 0; a < 2; ++a)
#pragma unroll
        for (int b = 0; b < 2; ++b)
#pragma unroll
            for (int m = 0; m < 4; ++m)
#pragma unroll
                for (int n = 0; n < 2; ++n) acc[a][b][m][n] = (f32x4){0.f, 0.f, 0.f, 0.f};
    bf16x8 At[4][2], B0[2][2], B1[2][2];
    const char* A0 = (const char*)g0.A + (size_t)u0.pm * 2 * hA0; const char* Bp0 = (const char*)g0.Bt + (size_t)u0.pn * 2 * hB0;
    const char* A1 = (const char*)g1.A + (size_t)u1.pm * 2 * hA1; const char* Bp1 = (const char*)g1.Bt + (size_t)u1.pn * 2 * hB1;
    PG8_STAGE(PG8_SB(0, 0), Bp0, vB0); PG8_STAGE(PG8_SB(0, 1), Bp0 + hB0, vB0); PG8_STAGE(PG8_SA(0, 0), A0, vA0); PG8_STAGE(PG8_SA(0, 1), A0 + hA0, vA0);
    if (wr == 1) PG8_BAR;
    PG8_WAIT_V(2); PG8_BAR;
    PG8_STAGE(PG8_SB(1, 0), Bp0 + kstep, vB0); PG8_STAGE(PG8_SA(1, 0), A0 + kstep, vA0); PG8_STAGE(PG8_SB(1, 1), Bp0 + hB0 + kstep, vB0);
    PG8_WAIT_V(6); PG8_BAR;
#pragma unroll
    for (int ui = 0; ui < 2; ++ui) {
        const char* cA = ui == 0 ? A0 : A1; const char* cB = ui == 0 ? Bp0 : Bp1;
        const size_t hAc = ui == 0 ? hA0 : hA1, hBc = ui == 0 ? hB0 : hB1;
        const int nt = (ui == 0 ? g0.K : g1.K) / BK;
        unsigned vAc[2], vBc[2];
#pragma unroll
        for (int i = 0; i < 2; ++i) { vAc[i] = ui == 0 ? vA0[i] : vA1[i]; vBc[i] = ui == 0 ? vB0[i] : vB1[i]; }
        for (int t = 0; t < nt; t += 2) {
            const bool last = (t == nt - 2);
            const char* a1 = cA + (size_t)(t + 1) * kstep;
            const char* a2 = last ? A1 : cA + (size_t)(t + 2) * kstep; const char* b2 = last ? Bp1 : cB + (size_t)(t + 2) * kstep;
            const char* a3 = a2 + kstep; const char* b3 = b2 + kstep;
            const size_t hA2 = last ? hA1 : hAc, hB2 = last ? hB1 : hBc;
            unsigned vA2[2], vB2[2];
#pragma unroll
            for (int i = 0; i < 2; ++i) { vA2[i] = last ? vA1[i] : vAc[i]; vB2[i] = last ? vB1[i] : vBc[i]; }
            PG8_LDB(B0, 0, 0); PG8_LDB(B1, 0, 1); PG8_SCHED; PG8_LDA(At, 0, 0); PG8_STAGE(PG8_SA(1, 1), a1 + hAc, vAc);
            PG8_WAIT_V(8); PG8_WAIT_L(0); PG8_BAR; PG8_MMA(0, 0, At, B0); PG8_MMA(0, 1, At, B1); PG8_BAR; PG8_SCHED;
            PG8_LDA(At, 0, 1); PG8_STAGE(PG8_SB(0, 0), b2, vB2); PG8_STAGE(PG8_SB(0, 1), b2 + hB2, vB2); PG8_STAGE(PG8_SA(0, 0), a2, vA2);
            PG8_WAIT_V(8); PG8_WAIT_L(0); PG8_BAR; PG8_MMA(1, 0, At, B0); PG8_MMA(1, 1, At, B1); PG8_BAR; PG8_SCHED;
            PG8_LDB(B0, 1, 0); PG8_LDB(B1, 1, 1); PG8_SCHED; PG8_LDA(At, 1, 0); PG8_STAGE(PG8_SA(0, 1), a2 + hA2, vA2);
            PG8_WAIT_V(8); PG8_WAIT_L(0); PG8_BAR; PG8_MMA(0, 0, At, B0); PG8_MMA(0, 1, At, B1); PG8_BAR; PG8_SCHED;
            PG8_LDA(At, 1, 1); PG8_STAGE(PG8_SB(1, 0), b3, vB2); PG8_STAGE(PG8_SB(1, 1), b3 + hB2, vB2); PG8_STAGE(PG8_SA(1, 0), a3, vA2);
            PG8_WAIT_V(8); PG8_WAIT_L(0); PG8_BAR; PG8_MMA(1, 0, At, B0); PG8_MMA(1, 1, At, B1); PG8_BAR; PG8_SCHED;
        }
        if (wr == 0) PG8_BAR;
        if (ui == 0) {
            E0(acc, u0, wr, wc, fr, fq);
#pragma unroll
            for (int a = 0; a < 2; ++a)
#pragma unroll
                for (int b = 0; b < 2; ++b)
#pragma unroll
                    for (int m = 0; m < 4; ++m)
#pragma unroll
                        for (int n = 0; n < 2; ++n) acc[a][b][m][n] = (f32x4){0.f, 0.f, 0.f, 0.f};
            if (wr == 1) PG8_BAR;
        } else E1(acc, u1, wr, wc, fr, fq);
    }
    PG8_WAIT_V(0);
    PG8_BAR;
#undef PG8_SA
#undef PG8_SB
#undef PG8_STAGE
#undef PG8_LDA
#undef PG8_LDB
#undef PG8_MMA
#undef PG8_WAIT_V
#undef PG8_WAIT_L
#undef PG8_BAR
#undef PG8_SCHED
}

#define EPI_FOR_ROWS _Pragma("unroll") for (int ai = 0; ai < 2; ++ai) _Pragma("unroll") for (int m = 0; m < 4; ++m)
#define EPI_ROWDEF const int rit = ai * HALF + wr * 64 + m * 16 + fr; const int row = u.pm * BM + rit; (void)rit; (void)row;

struct Epi1 {
    static constexpr bool AFTER_DRAIN = false;
    const float* rinv; const float* qnw; const float* knw; const float2* rope;
    bf16_t *Q, *Kb, *Vb, *GA, *GS, *UCAT; LAS float* xch; int pn0;
    __device__ __forceinline__ void operator()(const f32x4 (&acc)[2][2][4][2], const Unit& u, int wr, int wc, int, int) const {
        const int l_ = lane_id_opaque(), fr = l_ & 15, fq = l_ >> 4;
        const int pn = u.pn + pn0;
        if (pn <= 4) {
            float ss[2][4], rv[2][4];
            EPI_FOR_ROWS { EPI_ROWDEF const float r = rinv[row]; rv[ai][m] = r; float s = 0.f;
#pragma unroll
                for (int bj = 0; bj < 2; ++bj)
#pragma unroll
                    for (int n = 0; n < 2; ++n) { const f32x4 v = acc[ai][bj][m][n] * r; s += (v[0] * v[0] + v[1] * v[1]) + (v[2] * v[2] + v[3] * v[3]); }
                s += swz_xor<16>(s); s = sum_xor32(s); ss[ai][m] = s;
                if (fq == 0) xch[wc * 256 + rit] = s; }
            LDS_WAIT(); __builtin_amdgcn_s_barrier(); asm volatile("" ::: "memory");
            const int half = wc & 1, hd = wc >> 1;
            const float* nw = (pn < 4 ? qnw : knw) + 64 * half + 8 * fq;
            float w1[8], w2[8];
#pragma unroll
            for (int i = 0; i < 8; ++i) { w1[i] = nw[i]; w2[i] = nw[32 + i]; }
            EPI_FOR_ROWS { EPI_ROWDEF const float tot = ss[ai][m] + xch[(wc ^ 1) * 256 + rit];
                const float sc = rv[ai][m] * rsqrtf(tot * (1.f / 128.f) + EPS);
                const int t = row & (SEQ - 1); const int pos = half ? (t & 63) : (t >> 6);
                const float2* rp = rope + pos * 32 + 8 * fq;
                float o1[8], o2[8];
#pragma unroll
                for (int n = 0; n < 2; ++n)
#pragma unroll
                    for (int e = 0; e < 4; ++e) { const int i = 4 * n + e; const float2 cs = rp[i];
                        const float x1 = acc[ai][0][m][n][e] * sc * w1[i], x2 = acc[ai][1][m][n][e] * sc * w2[i];
                        o1[i] = x1 * cs.x - x2 * cs.y; o2[i] = x2 * cs.x + x1 * cs.y; }
                bf16_t* dst = (pn < 4) ? Q + (size_t)row * DATT + (2 * pn + hd) * 128 + 64 * half + 8 * fq : Kb + (size_t)row * DKV + hd * 128 + 64 * half + 8 * fq;
                u32x4 a; a.x = pk2(o1[0], o1[1]); a.y = pk2(o1[2], o1[3]); a.z = pk2(o1[4], o1[5]); a.w = pk2(o1[6], o1[7]);
                u32x4 b; b.x = pk2(o2[0], o2[1]); b.y = pk2(o2[2], o2[3]); b.z = pk2(o2[4], o2[5]); b.w = pk2(o2[6], o2[7]);
                *(u32x4*)dst = a; *(u32x4*)(dst + 32) = b; }
        } else {
            const int lg0 = 4 * (wc >> 1) + 2 * (wc & 1);
            EPI_FOR_ROWS { EPI_ROWDEF const float r = rinv[row];
#pragma unroll
                for (int bj = 0; bj < 2; ++bj) { const int L = 256 * pn + 32 * (lg0 + bj) + 8 * fq;
                    f32x4 v0 = acc[ai][bj][m][0] * r, v1 = acc[ai][bj][m][1] * r; bf16_t* dst;
                    if (pn == 5) dst = Vb + (size_t)row * DKV + (L - 1280);
                    else if (pn < 10) dst = GA + (size_t)row * DATT + (L - 1536);
                    else if (pn < 14) { const int Lu = L - 2560; dst = UCAT + ((size_t)(Lu >> 4) * NCH + (row >> 4)) * 512 + (row & 15) * 16 + (Lu & 15); }
                    else dst = GS + (size_t)row * DSSM + (L - 3584);
                    if ((pn >= 6 && pn < 10) || pn >= 14) {
#pragma unroll
                        for (int e = 0; e < 4; ++e) { v0[e] = siluf_(v0[e]); v1[e] = siluf_(v1[e]); } }
                    u32x4 w; w.x = pk2(v0[0], v0[1]); w.y = pk2(v0[2], v0[3]); w.z = pk2(v1[0], v1[1]); w.w = pk2(v1[2], v1[3]);
                    *(u32x4*)dst = w; } }
        }
    }
};
struct EpiS1 {
    static constexpr bool AFTER_DRAIN = true;
    const float* lb16; bf16_t* UCAT;
    __device__ __forceinline__ void operator()(const f32x4 (&)[2][2][4][2], const Unit&, int, int, int, int) const {}
    __device__ __forceinline__ void fused(const f32x4 (&acc)[2][2][4][2], const Unit& u, int wr, int wc, LAS unsigned char* lds, int wid) const {
        const int l_ = lane_id_opaque(), fr = l_ & 15, fq = l_ >> 4;
        LAS float* Tl = (LAS float*)lds;
#pragma unroll
        for (int d = 0; d < 2; ++d) {
            EPI_FOR_ROWS { const int rit = ai * HALF + wr * 64 + m * 16 + fr; LAS float* rp = Tl + rit * 128 + wc * 32 + 8 * fq;
                *(LAS f32x4*)rp = acc[ai][d][m][0]; *(LAS f32x4*)(rp + 4) = acc[ai][d][m][1]; }
            LDS_WAIT(); __builtin_amdgcn_s_barrier(); asm volatile("" ::: "memory");
            {
                const int p = l_; const float lr = lb16[((u.z * 2 + d) * 64 + p) * 2], li = lb16[((u.z * 2 + d) * 64 + p) * 2 + 1];
                LAS float* SEG = (LAS float*)(lds + XCH_OFF);
                float xr = 0.f, xi = 0.f;
#pragma unroll 8
                for (int i = 0; i < 32; ++i) { const int cc = wid * 32 + i, c = d ? 255 - cc : cc;
                    const float sr = Tl[c * 128 + p], si = Tl[c * 128 + 64 + p];
                    Tl[c * 128 + p] = xr; Tl[c * 128 + 64 + p] = xi;
                    const float nr = lr * xr - li * xi + sr; xi = lr * xi + li * xr + si; xr = nr; }
                SEG[(wid * 64 + p) * 2] = xr; SEG[(wid * 64 + p) * 2 + 1] = xi;
                LDS_WAIT(); __builtin_amdgcn_s_barrier(); asm volatile("" ::: "memory");
                float l32r = lr, l32i = li;
#pragma unroll
                for (int q = 0; q < 5; ++q) { const float t = l32r * l32r - l32i * l32i; l32i = 2.f * l32r * l32i; l32r = t; }
                float er = 0.f, ei = 0.f;
                for (int j = 0; j < wid; ++j) { const float tr = SEG[(j * 64 + p) * 2], ti = SEG[(j * 64 + p) * 2 + 1];
                    const float nr = l32r * er - l32i * ei + tr; ei = l32r * ei + l32i * er + ti; er = nr; }
#pragma unroll 8
                for (int i = 0; i < 32; ++i) { const int cc = wid * 32 + i, c = d ? 255 - cc : cc;
                    const float tr = Tl[c * 128 + p] + er, ti = Tl[c * 128 + 64 + p] + ei;
                    Tl[c * 128 + p] = __uint_as_float(pk2(tr, ti));
                    const float nr = lr * er - li * ei; ei = lr * ei + li * er; er = nr; }
            }
            LDS_WAIT(); __builtin_amdgcn_s_barrier(); asm volatile("" ::: "memory");
            {   bf16_t* ub = UCAT + ((size_t)u.z * NCH + u.pm * 256) * 512 + 256 + d * 128;
#pragma unroll
                for (int i = 0; i < 8; ++i) { const int q = wid * 64 + l_ + 512 * i, r = q >> 4, c8 = (q & 15) * 8;
                    *(u32x4*)(ub + (size_t)r * 512 + c8) = *(const LAS u32x4*)((LAS bf16_t*)(Tl + r * 128) + c8); } }
            LDS_WAIT(); __builtin_amdgcn_s_barrier(); asm volatile("" ::: "memory");
        }
    }
};
struct EpiS2 {
    static constexpr bool AFTER_DRAIN = false;
    bf16_t* YS;
    __device__ __forceinline__ void operator()(const f32x4 (&acc)[2][2][4][2], const Unit& u, int wr, int wc, int, int) const {
        const int l_ = lane_id_opaque(), fr = l_ & 15, fq = l_ >> 4;
        EPI_FOR_ROWS { EPI_ROWDEF
#pragma unroll
            for (int bj = 0; bj < 2; ++bj) { const int c = bj * HALF + wc * 32 + 8 * fq; const int j = c >> 4, h0 = c & 15;
                const f32x4 v0 = acc[ai][bj][m][0], v1 = acc[ai][bj][m][1];
                u32x4 w; w.x = pk2(gelu_tanh(v0[0]), gelu_tanh(v0[1])); w.y = pk2(gelu_tanh(v0[2]), gelu_tanh(v0[3])); w.z = pk2(gelu_tanh(v1[0]), gelu_tanh(v1[1])); w.w = pk2(gelu_tanh(v1[2]), gelu_tanh(v1[3]));
                *(u32x4*)(YS + ((size_t)row * 16 + j) * DSSM + u.z * 16 + h0) = w; } }
    }
};
struct EpiGlu {
    static constexpr bool AFTER_DRAIN = false;
    const float* bglu; const bf16_t* GS; bf16_t* YMIX;
    __device__ __forceinline__ void operator()(const f32x4 (&acc)[2][2][4][2], const Unit& u, int wr, int wc, int, int) const {
        const int l_ = lane_id_opaque(), fr = l_ & 15, fq = l_ >> 4;
        const int a0 = 128 * u.pn + 32 * wc + 8 * fq;
        float bv[8], bg[8];
#pragma unroll
        for (int i = 0; i < 8; ++i) { bv[i] = bglu[a0 + i]; bg[i] = bglu[1024 + a0 + i]; }
        u32x4 gsv[2][4];
        EPI_FOR_ROWS { EPI_ROWDEF gsv[ai][m] = __builtin_nontemporal_load((const u32x4*)(GS + (size_t)row * DSSM + a0)); }
        EPI_FOR_ROWS { EPI_ROWDEF const u32x4 gs = gsv[ai][m];
            float o[8];
#pragma unroll
            for (int n = 0; n < 2; ++n)
#pragma unroll
                for (int e = 0; e < 4; ++e) { const int i = 4 * n + e; o[i] = (acc[ai][0][m][n][e] + bv[i]) * sigmoidf_(acc[ai][1][m][n][e] + bg[i]); }
            o[0] *= bflo(gs.x); o[1] *= bfhi(gs.x); o[2] *= bflo(gs.y); o[3] *= bfhi(gs.y); o[4] *= bflo(gs.z); o[5] *= bfhi(gs.z); o[6] *= bflo(gs.w); o[7] *= bfhi(gs.w);
            u32x4 w; w.x = pk2(o[0], o[1]); w.y = pk2(o[2], o[3]); w.z = pk2(o[4], o[5]); w.w = pk2(o[6], o[7]);
            *(u32x4*)(YMIX + (size_t)row * DM + 1024 + a0) = w; }
    }
};
struct EpiBf {
    static constexpr bool AFTER_DRAIN = false;
    bf16_t* O; int ldc;
    __device__ __forceinline__ void operator()(const f32x4 (&acc)[2][2][4][2], const Unit& u, int wr, int wc, int, int) const {
        const int l_ = lane_id_opaque(), fr = l_ & 15, fq = l_ >> 4;
        EPI_FOR_ROWS { EPI_ROWDEF
#pragma unroll
            for (int bj = 0; bj < 2; ++bj) { const f32x4 v0 = acc[ai][bj][m][0], v1 = acc[ai][bj][m][1];
                u32x4 w; w.x = pk2(v0[0], v0[1]); w.y = pk2(v0[2], v0[3]); w.z = pk2(v1[0], v1[1]); w.w = pk2(v1[2], v1[3]);
                *(u32x4*)(O + (size_t)row * ldc + u.pn * BM + bj * HALF + wc * 32 + 8 * fq) = w; } }
    }
};
struct EpiOut {
    static constexpr bool AFTER_DRAIN = false;
    const float* x; float* H; bf16_t* HB; float* ssq;
    __device__ __forceinline__ void operator()(const f32x4 (&acc)[2][2][4][2], const Unit& u, int wr, int wc, int, int) const {
        const int l_ = lane_id_opaque(), fr = l_ & 15, fq = l_ >> 4;
#pragma unroll
        for (int ai = 0; ai < 2; ++ai) {
            f32x4 xv[4][2][2];
#pragma unroll
            for (int m = 0; m < 4; ++m) { EPI_ROWDEF
#pragma unroll
                for (int bj = 0; bj < 2; ++bj) { const size_t off = (size_t)row * DM + u.pn * BM + bj * HALF + wc * 32 + 8 * fq; xv[m][bj][0] = __builtin_nontemporal_load((const f32x4*)(x + off)); xv[m][bj][1] = __builtin_nontemporal_load((const f32x4*)(x + off + 4)); } }
#pragma unroll
            for (int m = 0; m < 4; ++m) { EPI_ROWDEF float s = 0.f;
#pragma unroll
                for (int bj = 0; bj < 2; ++bj) { const size_t off = (size_t)row * DM + u.pn * BM + bj * HALF + wc * 32 + 8 * fq;
                    const f32x4 v0 = acc[ai][bj][m][0] + xv[m][bj][0], v1 = acc[ai][bj][m][1] + xv[m][bj][1];
                    s += (v0[0] * v0[0] + v0[1] * v0[1]) + (v0[2] * v0[2] + v0[3] * v0[3]) + (v1[0] * v1[0] + v1[1] * v1[1]) + (v1[2] * v1[2] + v1[3] * v1[3]);
                    u32x4 w; w.x = pk2(v0[0], v0[1]); w.y = pk2(v0[2], v0[3]); w.z = pk2(v1[0], v1[1]); w.w = pk2(v1[2], v1[3]);
                    *(u32x4*)(HB + off) = w; }
                s += swz_xor<16>(s); s = sum_xor32(s);
                if (fq == 0) ssq[(size_t)row * 32 + u.pn * 4 + wc] = s; }
        }
    }
};
struct EpiGate {
    static constexpr bool AFTER_DRAIN = true;
    float* H; const bf16_t* PP; float* ssq; unsigned* cnt; const float* nf; const LAS float* r2; const bf16_t* HBr;
    __device__ __forceinline__ void operator()(const f32x4 (&)[2][2][4][2], const Unit&, int, int, int, int) const {}
    __device__ __forceinline__ void fused(f32x4 (&acc)[2][2][4][2], const Unit& u, int wr, int wc, LAS unsigned char* lds, int wid) const {
        const int l_ = lane_id_opaque(), fr = l_ & 15, fq = l_ >> 4, tid = wid * 64 + l_;
        LAS float* P = (LAS float*)lds; LAS float* Rn = P + 1024;
        EPI_FOR_ROWS { EPI_ROWDEF float s = 0.f; const float r = r2[rit];
#pragma unroll
            for (int bj = 0; bj < 2; ++bj) { const size_t off = (size_t)row * DM + u.pn * BM + bj * HALF + wc * 32 + 8 * fq;
                const u32x4 pp = __builtin_nontemporal_load((const u32x4*)(PP + off));
                const u32x4 hb = __builtin_nontemporal_load((const u32x4*)(HBr + off));
                f32x4 h0 = {bflo(hb.x), bfhi(hb.x), bflo(hb.y), bfhi(hb.y)}, h1 = {bflo(hb.z), bfhi(hb.z), bflo(hb.w), bfhi(hb.w)};
                const f32x4 a0 = acc[ai][bj][m][0] * r, a1 = acc[ai][bj][m][1] * r;
                h0[0] += sigmoidf_(a0[0]) * bflo(pp.x); h0[1] += sigmoidf_(a0[1]) * bfhi(pp.x); h0[2] += sigmoidf_(a0[2]) * bflo(pp.y); h0[3] += sigmoidf_(a0[3]) * bfhi(pp.y);
                h1[0] += sigmoidf_(a1[0]) * bflo(pp.z); h1[1] += sigmoidf_(a1[1]) * bfhi(pp.z); h1[2] += sigmoidf_(a1[2]) * bflo(pp.w); h1[3] += sigmoidf_(a1[3]) * bfhi(pp.w);
                acc[ai][bj][m][0] = h0; acc[ai][bj][m][1] = h1;
                s += (h0[0] * h0[0] + h0[1] * h0[1]) + (h0[2] * h0[2] + h0[3] * h0[3]) + (h1[0] * h1[0] + h1[1] * h1[1]) + (h1[2] * h1[2] + h1[3] * h1[3]); }
            s += swz_xor<16>(s); s = sum_xor32(s);
            if (fq == 0) P[rit * 4 + wc] = s; }
        LDS_WAIT(); __builtin_amdgcn_s_barrier(); asm volatile("" ::: "memory");
        if (tid < 256) { const float t = (P[tid * 4] + P[tid * 4 + 1]) + (P[tid * 4 + 2] + P[tid * 4 + 3]);
            __hip_atomic_store(ssq + (size_t)(u.pm * 256 + tid) * 8 + u.pn, t, __ATOMIC_RELAXED, __HIP_MEMORY_SCOPE_AGENT); }
        asm volatile("s_waitcnt vmcnt(0)" ::: "memory");
        if (wid < 4 && l_ == 0) __hip_atomic_fetch_add(cnt + 64 * u.pm, 1u, __ATOMIC_RELAXED, __HIP_MEMORY_SCOPE_AGENT);
        if (wid == 0) {
            unsigned sp = 0;
            while ((unsigned)__builtin_amdgcn_readfirstlane(__hip_atomic_load(cnt + 64 * u.pm, __ATOMIC_RELAXED, __HIP_MEMORY_SCOPE_AGENT)) < 32u) { __builtin_amdgcn_s_sleep(2); if (++sp > (1u << 22)) break; }
            __builtin_amdgcn_fence(__ATOMIC_ACQUIRE, "agent");
        }
        asm volatile("s_waitcnt vmcnt(0) lgkmcnt(0)" ::: "memory"); __builtin_amdgcn_s_barrier(); asm volatile("" ::: "memory");
        if (tid < 256) { const float* sp = ssq + (size_t)(u.pm * 256 + tid) * 8; float t = 0.f;
#pragma unroll
            for (int i = 0; i < 8; ++i) t += __hip_atomic_load(sp + i, __ATOMIC_RELAXED, __HIP_MEMORY_SCOPE_AGENT);
            Rn[tid] = rsqrtf(t * (1.f / DM) + EPS); }
        LDS_WAIT(); __builtin_amdgcn_s_barrier(); asm volatile("" ::: "memory");
        EPI_FOR_ROWS { EPI_ROWDEF const float rn = Rn[rit];
#pragma unroll
            for (int bj = 0; bj < 2; ++bj) { const int col = u.pn * BM + bj * HALF + wc * 32 + 8 * fq; const size_t off = (size_t)row * DM + col;
                *(f32x4*)(H + off) = acc[ai][bj][m][0] * rn * *(const f32x4*)(nf + col); *(f32x4*)(H + off + 4) = acc[ai][bj][m][1] * rn * *(const f32x4*)(nf + col + 4); } }
    }
};
}

namespace att {
constexpr int D = 128, NW = 8, QBLK = 32, KVBLK = 64;
constexpr float SCALE = 0.088388347648318440f;
constexpr float THR = 8.f;
constexpr int LDQ = DATT, LDK = DKV;
constexpr size_t SHM_V = KVBLK * D * 2, SHM_K = KVBLK * D * 2, SHM_ATTN = 2 * SHM_V + 2 * SHM_K + NW * 64 * 4;
#define KSWZ(row, colB) ((row) * 256 + ((colB) ^ (((row) & 7) << 4)))
#define SBAR() __builtin_amdgcn_sched_barrier(0)
__device__ __forceinline__ int crow(int r, int hi) { return (r & 3) + 8 * (r >> 2) + 4 * hi; }
__device__ __forceinline__ void partialSM(f32x16& p0, f32x16& p1, float& m_reg, float& mn, float& alpha) {
  constexpr float C = SCALE * 1.4426950408889634f;
  float pmax = p0[0]; for (int r = 1; r < 16; ++r) pmax = fmaxf(pmax, p0[r]); for (int r = 0; r < 16; ++r) pmax = fmaxf(pmax, p1[r]);
  { auto rr = __builtin_amdgcn_permlane32_swap(__float_as_uint(pmax), __float_as_uint(pmax), false, false);
    pmax = fmaxf(__uint_as_float(rr[0]), __uint_as_float(rr[1])); }
  if (__builtin_expect(__all(pmax - m_reg <= THR / SCALE), 1)) { mn = m_reg; alpha = 1.f; }
  else { mn = fmaxf(m_reg, pmax); alpha = __builtin_amdgcn_exp2f((m_reg - mn) * C); m_reg = mn; }
  float mnC = -mn * C;
  for (int r = 0; r < 16; ++r) p0[r] = fmaf(p0[r], C, mnC); for (int r = 0; r < 16; ++r) p1[r] = fmaf(p1[r], C, mnC);
  for (int r = 0; r < 16; ++r) p0[r] = __builtin_amdgcn_exp2f(p0[r]);
}
__device__ __forceinline__ void finishSM(f32x16& p0, f32x16& p1, float alpha, float& l_reg, bf16x8& pa0, bf16x8& pa1, bf16x8& pa2, bf16x8& pa3) {
  for (int r = 0; r < 16; ++r) p1[r] = __builtin_amdgcn_exp2f(p1[r]);
  float ps = 0; for (int r = 0; r < 16; ++r) ps += p0[r]; for (int r = 0; r < 16; ++r) ps += p1[r];
  { auto rr = __builtin_amdgcn_permlane32_swap(__float_as_uint(ps), __float_as_uint(ps), false, false);
    ps = __uint_as_float(rr[0]) + __uint_as_float(rr[1]); }
  l_reg = l_reg * alpha + ps;
#define PK4(P, BASE, OUT) do { unsigned a0 = cvt_pk_bf16(P[BASE + 0], P[BASE + 1]), a1 = cvt_pk_bf16(P[BASE + 2], P[BASE + 3]);   \
    unsigned b0 = cvt_pk_bf16(P[BASE + 4], P[BASE + 5]), b1 = cvt_pk_bf16(P[BASE + 6], P[BASE + 7]);                              \
    auto r0 = __builtin_amdgcn_permlane32_swap(a0, b0, false, false); auto r1 = __builtin_amdgcn_permlane32_swap(a1, b1, false, false); \
    u32x4 w = {r0[0], r1[0], r0[1], r1[1]}; OUT = *reinterpret_cast<bf16x8*>(&w); } while (0)
  PK4(p0, 0, pa0); PK4(p0, 8, pa1); PK4(p1, 0, pa2); PK4(p1, 8, pa3);
#undef PK4
}
__device__ __forceinline__ void qkt(f32x16& p0, f32x16& p1, const bf16_t* Ks, const bf16x8* qr, int r32, int hi) {
  p0 = f32x16{}; p1 = f32x16{};
  for (int d0 = 0; d0 < 8; ++d0) { int cb = (d0 * 16 + hi * 8) * 2;
    bf16x8 b0 = *reinterpret_cast<const bf16x8*>((const char*)Ks + KSWZ(r32, cb));
    bf16x8 b1 = *reinterpret_cast<const bf16x8*>((const char*)Ks + KSWZ(32 + r32, cb));
    p0 = __builtin_amdgcn_mfma_f32_32x32x16_bf16(b0, qr[d0], p0, 0, 0, 0);
    p1 = __builtin_amdgcn_mfma_f32_32x32x16_bf16(b1, qr[d0], p1, 0, 0, 0); }
}
__device__ __forceinline__ int v_st(int k, int c) { const int kk = (k & ~0xC) | ((k & 4) << 1) | ((k & 8) >> 1); return ((kk >> 3) * 4 + (c >> 5)) * 512 + ((kk & 7) * 32 + (c & 31)) * 2; }
__device__ __forceinline__ int v_rd_base(int lane) { return ((lane & 3) << 3) | (((lane >> 2) & 3) << 6) | (((lane >> 4) & 1) << 5) | (((lane >> 5) & 1) << 8); }
constexpr int v_rd_off(int d0, int ks, int half) { return d0 * 512 + ks * 4096 + half * 2048; }
template <int OFF> __device__ __forceinline__ s16x4 tr_read(int vb) {
  s16x4 r; asm volatile("ds_read_b64_tr_b16 %0, %1 offset:%2" : "=&v"(r) : "v"(vb), "i"(OFF) : "memory"); return r;
}
template <int D0> __device__ __forceinline__ void pv_one(f32x16& od, int vb, bf16x8 pa0, bf16x8 pa1, bf16x8 pa2, bf16x8 pa3) {
  const s16x4 l0 = tr_read<v_rd_off(D0, 0, 0)>(vb), h0 = tr_read<v_rd_off(D0, 0, 1)>(vb), l1 = tr_read<v_rd_off(D0, 1, 0)>(vb), h1 = tr_read<v_rd_off(D0, 1, 1)>(vb);
  const s16x4 l2 = tr_read<v_rd_off(D0, 2, 0)>(vb), h2 = tr_read<v_rd_off(D0, 2, 1)>(vb), l3 = tr_read<v_rd_off(D0, 3, 0)>(vb), h3 = tr_read<v_rd_off(D0, 3, 1)>(vb);
  asm volatile("s_waitcnt lgkmcnt(0)" ::: "memory"); SBAR();
#define PK(L, H) (bf16x8){L[0], L[1], L[2], L[3], H[0], H[1], H[2], H[3]}
  od = __builtin_amdgcn_mfma_f32_32x32x16_bf16(pa0, PK(l0, h0), od, 0, 0, 0);
  od = __builtin_amdgcn_mfma_f32_32x32x16_bf16(pa1, PK(l1, h1), od, 0, 0, 0);
  od = __builtin_amdgcn_mfma_f32_32x32x16_bf16(pa2, PK(l2, h2), od, 0, 0, 0);
  od = __builtin_amdgcn_mfma_f32_32x32x16_bf16(pa3, PK(l3, h3), od, 0, 0, 0);
#undef PK
}
__device__ __forceinline__ void pv_d0(f32x16* o, int vb, bf16x8 pa0, bf16x8 pa1, bf16x8 pa2, bf16x8 pa3) {
  pv_one<0>(o[0], vb, pa0, pa1, pa2, pa3); pv_one<1>(o[1], vb, pa0, pa1, pa2, pa3); pv_one<2>(o[2], vb, pa0, pa1, pa2, pa3); pv_one<3>(o[3], vb, pa0, pa1, pa2, pa3);
}
__device__ __forceinline__ void attn_dense_body(const bf16_t* __restrict__ Qb, const bf16_t* __restrict__ Kh, const bf16_t* __restrict__ Vh,
                                                const bf16_t* __restrict__ Gb, bf16_t* __restrict__ Yb, int seq, char* lds, const int wid) {
  const int lane = lane_id_opaque(), tid = wid * 64 + lane, r32 = lane & 31, hi = lane >> 5;
  bf16_t* V_lds = (bf16_t*)lds; bf16_t* K_lds = (bf16_t*)(lds + 2 * SHM_V);
  float* ws = (float*)(lds + 2 * SHM_V + 2 * SHM_K) + wid * 64; float* li_l = ws; float* al_l = ws + 32;
  float m_reg = -1e30f, l_reg = 0; f32x16 o[4] = {}; bf16x8 qr[8];
  const bf16_t* Qw = Qb + (long)(wid * QBLK + r32) * LDQ + hi * 8;
#pragma unroll
  for (int d0 = 0; d0 < 8; ++d0) qr[d0] = __builtin_nontemporal_load(reinterpret_cast<const bf16x8*>(Qw + d0 * 16));
  const int sr = tid >> 4, sc = (tid & 15) * 8, vst0 = v_st(sr, sc), vst1 = v_st(32 + sr, sc);
  const int vb0 = (int)(uintptr_t)V_lds + v_rd_base(lane);
  struct { bf16x8 vs0, vs1, ks0, ks1; } sr_[2];
#define SLOAD(i, k0) do { sr_[i].vs0 = *reinterpret_cast<const bf16x8*>(&Vh[(long)((k0) + sr) * LDK + sc]); sr_[i].vs1 = *reinterpret_cast<const bf16x8*>(&Vh[(long)((k0) + 32 + sr) * LDK + sc]); \
    sr_[i].ks0 = *reinterpret_cast<const bf16x8*>(&Kh[(long)((k0) + sr) * LDK + sc]); sr_[i].ks1 = *reinterpret_cast<const bf16x8*>(&Kh[(long)((k0) + 32 + sr) * LDK + sc]); } while (0)
#define SWRITE(b, i) do { *(bf16x8*)((char*)V_lds + (b) * SHM_V + vst0) = sr_[i].vs0;          \
    *(bf16x8*)((char*)V_lds + (b) * SHM_V + vst1) = sr_[i].vs1; int kc = sc * 2;               \
    *(bf16x8*)((char*)K_lds + (b) * SHM_K + KSWZ(sr, kc)) = sr_[i].ks0;                       \
    *(bf16x8*)((char*)K_lds + (b) * SHM_K + KSWZ(32 + sr, kc)) = sr_[i].ks1; } while (0)
#define SWAIT() asm volatile("s_waitcnt vmcnt(4)" ::: "memory")
#define RESC(a) do { if (__any((a) < 1.f)) { if (hi == 0) al_l[r32] = (a); asm volatile("s_waitcnt lgkmcnt(0)" ::: "memory"); \
    for (int d = 0; d < 4; ++d) for (int r = 0; r < 16; ++r) o[d][r] *= al_l[crow(r, hi)]; } } while (0)
  f32x16 pA0, pA1, pB0, pB1; float mnA, mnB, alA, alB; bf16x8 pa0, pa1, pa2, pa3; const int NT = seq / KVBLK;
  constexpr int SE = 0, SO = 1;
  SLOAD(SE, 0); asm volatile("s_waitcnt vmcnt(0)" ::: "memory"); SWRITE(0, SE); __syncthreads();
  qkt(pA0, pA1, K_lds, qr, r32, hi); partialSM(pA0, pA1, m_reg, mnA, alA);
  SLOAD(SO, KVBLK); if (2 < NT) SLOAD(SE, 2 * KVBLK);
  SWAIT(); SWRITE(1, SO); __syncthreads();
  for (int j = 1; j + 1 < NT; j += 2) {
    SBAR(); qkt(pB0, pB1, (bf16_t*)((char*)K_lds + SHM_K), qr, r32, hi);
    finishSM(pA0, pA1, alA, l_reg, pa0, pa1, pa2, pa3); SBAR();
    SLOAD(SO, (j + 2) * KVBLK); SBAR();
    pv_d0(o, vb0, pa0, pa1, pa2, pa3); partialSM(pB0, pB1, m_reg, mnB, alB);
    __syncthreads(); SWAIT(); SWRITE(0, SE);
    RESC(alB); __syncthreads();
    SBAR(); qkt(pA0, pA1, K_lds, qr, r32, hi);
    finishSM(pB0, pB1, alB, l_reg, pa0, pa1, pa2, pa3); SBAR();
    if (j + 3 < NT) SLOAD(SE, (j + 3) * KVBLK); SBAR();
    pv_d0(o, vb0 + (int)SHM_V, pa0, pa1, pa2, pa3); partialSM(pA0, pA1, m_reg, mnA, alA);
    __syncthreads(); SWAIT(); SWRITE(1, SO);
    RESC(alA); __syncthreads();
  }
  SBAR(); qkt(pB0, pB1, (bf16_t*)((char*)K_lds + SHM_K), qr, r32, hi);
  finishSM(pA0, pA1, alA, l_reg, pa0, pa1, pa2, pa3); SBAR();
  pv_d0(o, vb0, pa0, pa1, pa2, pa3); partialSM(pB0, pB1, m_reg, mnB, alB);
  __syncthreads(); RESC(alB);
  finishSM(pB0, pB1, alB, l_reg, pa0, pa1, pa2, pa3); SBAR();
  pv_d0(o, vb0 + (int)SHM_V, pa0, pa1, pa2, pa3);
  if (hi == 0) li_l[r32] = l_reg; asm volatile("s_waitcnt lgkmcnt(0)" ::: "memory");
  float rli[16];
#pragma unroll
  for (int r = 0; r < 16; ++r) rli[r] = __builtin_amdgcn_rcpf(li_l[crow(r, hi)]);
  bf16_t* Yw = Yb + (long)(wid * QBLK) * DM; const bf16_t* Gw = Gb + (long)(wid * QBLK) * DATT;
  __syncthreads();
  bf16_t* stg = (bf16_t*)(lds + wid * 8192);
#pragma unroll
  for (int r = 0; r < 16; ++r) { const int orow = crow(r, hi);
#pragma unroll
    for (int d0 = 0; d0 < 4; ++d0) stg[orow * 128 + d0 * 32 + r32] = (bf16_t)f2bf(o[d0][r] * rli[r]); }
  asm volatile("s_waitcnt lgkmcnt(0)" ::: "memory");
  const int l2 = lane_id_opaque();
#pragma unroll
  for (int i = 0; i < 8; ++i) { const int q = l2 + 64 * i, row = q >> 4, c8 = (q & 15) * 8;
    const u32x4 v = *(const u32x4*)(stg + row * 128 + c8); const u32x4 gg = __builtin_nontemporal_load((const u32x4*)(Gw + (unsigned)(row * DATT + c8)));
    u32x4 w; w.x = pk2(bflo(v.x) * bflo(gg.x), bfhi(v.x) * bfhi(gg.x)); w.y = pk2(bflo(v.y) * bflo(gg.y), bfhi(v.y) * bfhi(gg.y));
    w.z = pk2(bflo(v.z) * bflo(gg.z), bfhi(v.z) * bfhi(gg.z)); w.w = pk2(bflo(v.w) * bflo(gg.w), bfhi(v.w) * bfhi(gg.w));
    *(u32x4*)(Yw + (unsigned)(row * DM + c8)) = w; }
  __syncthreads();
#undef SLOAD
#undef SWRITE
#undef SWAIT
#undef RESC
}
#undef SBAR
}

__device__ __forceinline__ void p0_transpose_item(const float* W, int K, int N, bf16_t* WT, int wt_row0, const float* kscale, LAS float* scr, int k0, int n0, int lane) {
#pragma unroll
    for (int i = 0; i < 32; ++i) { const int kk = 2 * i + (lane >> 5); float v = W[(size_t)(k0 + kk) * N + n0 + (lane & 31)]; if (kscale) v *= kscale[k0 + kk]; scr[kk * 33 + (lane & 31)] = v; }
    LDS_WAIT(); asm volatile("" ::: "memory");
    const int c = lane & 7;
#pragma unroll
    for (int j = 0; j < 4; ++j) { const int n = (lane >> 3) + 8 * j; const LAS float* s = scr + (8 * c) * 33 + n;
        u32x4 o; o.x = pk2(s[0 * 33], s[1 * 33]); o.y = pk2(s[2 * 33], s[3 * 33]); o.z = pk2(s[4 * 33], s[5 * 33]); o.w = pk2(s[6 * 33], s[7 * 33]);
        *(u32x4*)(WT + (size_t)(wt_row0 + n) * K + k0 + 8 * c) = o; }
    LDS_WAIT(); asm volatile("" ::: "memory");
}

struct TrItem { const float* W; bf16_t* WT; const float* kscale; int K, N, wt_row0, k0, n0; };
__device__ __forceinline__ void p0_tr_load(const TrItem& d, float (&v)[32], int lane) {
#pragma unroll
    for (int i = 0; i < 32; ++i) { const int kk = 2 * i + (lane >> 5); v[i] = __builtin_nontemporal_load(d.W + (size_t)(d.k0 + kk) * d.N + d.n0 + (lane & 31)); }
    if (d.kscale) {
#pragma unroll
        for (int i = 0; i < 32; ++i) { const int kk = 2 * i + (lane >> 5); v[i] *= d.kscale[d.k0 + kk]; } }
}
__device__ __forceinline__ void p0_tr_store(const TrItem& d, const float (&v)[32], LAS float* scr, int lane) {
#pragma unroll
    for (int i = 0; i < 32; ++i) { const int kk = 2 * i + (lane >> 5); scr[kk * 33 + (lane & 31)] = v[i]; }
    LDS_WAIT(); asm volatile("" ::: "memory");
    const int c = lane & 7;
#pragma unroll
    for (int j = 0; j < 4; ++j) { const int n = (lane >> 3) + 8 * j; const LAS float* s = scr + (8 * c) * 33 + n;
        u32x4 o; o.x = pk2(s[0 * 33], s[1 * 33]); o.y = pk2(s[2 * 33], s[3 * 33]); o.z = pk2(s[4 * 33], s[5 * 33]); o.w = pk2(s[6 * 33], s[7 * 33]);
        *(u32x4*)(d.WT + (size_t)(d.wt_row0 + n) * d.K + d.k0 + 8 * c) = o; }
    LDS_WAIT(); asm volatile("" ::: "memory");
}
__device__ __forceinline__ void ssm_tables(const Args& a, int g, LAS unsigned char* lds, int tid) {
    LAS float* LD = (LAS float*)lds;
    LAS float* LBs = LD + 256;
    LAS float* BB = LBs + 256;
    LAS float* KT = BB + 4096;
    LAS float* CC = KT + 8192;
    float* lb16 = (float*)(a.ws + WS_LB16);
    bf16_t* WIN = (bf16_t*)(a.ws + WS_WIN) + (size_t)g * 256 * 256;
    bf16_t* WBIG = (bf16_t*)(a.ws + WS_WBIG) + (size_t)g * 256 * 512;
    for (int e = tid; e < 2048; e += 512) { const int d = e >> 10, r = e & 1023; const size_t ci_ = (size_t)(d * NG + g) * 1024 + r; CC[e * 2] = a.c_re[ci_]; CC[e * 2 + 1] = a.c_im[ci_]; }
    if (tid < 128) {
        const int d = tid >> 6, p = tid & 63; const int idx = (d * NG + g) * 64 + p;
        const float lr = fminf(a.a_re[idx], -1e-4f), li = a.a_im[idx];
        const float dt = expf(a.log_dt[d * NG + g]);
        const float er = expf(lr * dt); float sn, cs; sincosf(li * dt, &sn, &cs);
        const float br = er * cs, bi = er * sn;
        LD[tid * 2] = lr * dt; LD[tid * 2 + 1] = li * dt; LBs[tid * 2] = br; LBs[tid * 2 + 1] = bi;
        const float nr = br - 1.f, ni = bi, den = lr * lr + li * li;
        KT[tid * 2] = (nr * lr + ni * li) / den; KT[tid * 2 + 1] = (ni * lr - nr * li) / den;
        const float e16 = expf(16.f * lr * dt); float s16, c16; sincosf(16.f * li * dt, &s16, &c16);
        lb16[(g * 128 + tid) * 2] = e16 * c16; lb16[(g * 128 + tid) * 2 + 1] = e16 * s16;
    }
    __syncthreads();
    for (int e = tid; e < 2048; e += 512) {
        const int dp = e >> 4, h = e & 15, d = dp >> 6, p = dp & 63;
        const size_t bi_ = ((size_t)(d * NG + g) * 64 + p) * 16 + h;
        const float xr = a.b_re[bi_], xi = a.b_im[bi_], cr = KT[dp * 2], ci = KT[dp * 2 + 1];
        BB[e * 2] = cr * xr - ci * xi; BB[e * 2 + 1] = cr * xi + ci * xr;
    }
    __syncthreads();
    {
        const int d = tid >> 8, hp = (tid >> 4) & 15, h = tid & 15; float acc[16];
#pragma unroll
        for (int t = 0; t < 16; ++t) acc[t] = 0.f;
        const LAS float* cc = CC + ((d * 16 + hp) * 64) * 2;
        for (int p = 0; p < 64; ++p) {
            const float c_r = cc[p * 2], c_i = cc[p * 2 + 1], b_r = BB[((d * 64 + p) * 16 + h) * 2], b_i = BB[((d * 64 + p) * 16 + h) * 2 + 1];
            float wr = c_r * b_r - c_i * b_i, wi = c_r * b_i + c_i * b_r; const float l_r = LBs[(d * 64 + p) * 2], l_i = LBs[(d * 64 + p) * 2 + 1];
#pragma unroll
            for (int t = 0; t < 16; ++t) { acc[t] += wr; const float nr = wr * l_r - wi * l_i; wi = wr * l_i + wi * l_r; wr = nr; }
        }
#pragma unroll
        for (int t = 0; t < 16; ++t) KT[((d * 16 + t) * 16 + hp) * 16 + h] = acc[t];
    }
    __syncthreads();
    for (int q = tid; q < 8192; q += 512) {
        const int n = q >> 5, kc = q & 31, s = kc >> 1, h0 = (kc & 1) * 8, j = n >> 4, hp = n & 15;
        float v[8];
#pragma unroll
        for (int e = 0; e < 8; ++e) { const int h = h0 + e;
            if (s < j) v[e] = KT[((0 * 16 + (j - s)) * 16 + hp) * 16 + h];
            else if (s > j) v[e] = KT[((1 * 16 + (s - j)) * 16 + hp) * 16 + h];
            else v[e] = KT[((0 * 16 + 0) * 16 + hp) * 16 + h] + KT[((1 * 16 + 0) * 16 + hp) * 16 + h] + (h == hp ? a.ssm_d[g * 16 + h] : 0.f); }
        u32x4 w; w.x = pk2(v[0], v[1]); w.y = pk2(v[2], v[3]); w.z = pk2(v[4], v[5]); w.w = pk2(v[6], v[7]);
        *(u32x4*)(WBIG + (size_t)n * 512 + s * 16 + h0) = w;
    }
    for (int q = tid; q < 2048; q += 512) {
        const int p = q & 63, js = (q >> 6) & 15, d = q >> 10; const float ldr = LD[(d * 64 + p) * 2], ldi = LD[(d * 64 + p) * 2 + 1];
        {   const float pw = (float)(d == 0 ? js + 1 : 16 - js); const float er = expf(pw * ldr); float sn, cs; sincosf(pw * ldi, &sn, &cs); const float pr = er * cs, pi = er * sn;
#pragma unroll
            for (int hp = 0; hp < 16; ++hp) { const float c_r = CC[((d * 16 + hp) * 64 + p) * 2], c_i = CC[((d * 16 + hp) * 64 + p) * 2 + 1];
                *(unsigned*)(WBIG + (size_t)(js * 16 + hp) * 512 + 256 + d * 128 + 2 * p) = pk2(c_r * pr - c_i * pi, -(c_r * pi + c_i * pr)); } }
        {   const float pw = (float)(d == 0 ? 15 - js : js); const float er = expf(pw * ldr); float sn, cs; sincosf(pw * ldi, &sn, &cs); const float pr = er * cs, pi = er * sn;
            float zr[16], zi[16];
#pragma unroll
            for (int h = 0; h < 16; ++h) { const float b_r = BB[((d * 64 + p) * 16 + h) * 2], b_i = BB[((d * 64 + p) * 16 + h) * 2 + 1]; zr[h] = pr * b_r - pi * b_i; zi[h] = pr * b_i + pi * b_r; }
            bf16_t* d0 = WIN + (size_t)(d * 128 + p) * 256 + js * 16; bf16_t* d1 = d0 + (size_t)64 * 256;
            u32x4 w; w.x = pk2(zr[0], zr[1]); w.y = pk2(zr[2], zr[3]); w.z = pk2(zr[4], zr[5]); w.w = pk2(zr[6], zr[7]); *(u32x4*)d0 = w;
            w.x = pk2(zr[8], zr[9]); w.y = pk2(zr[10], zr[11]); w.z = pk2(zr[12], zr[13]); w.w = pk2(zr[14], zr[15]); *(u32x4*)(d0 + 8) = w;
            w.x = pk2(zi[0], zi[1]); w.y = pk2(zi[2], zi[3]); w.z = pk2(zi[4], zi[5]); w.w = pk2(zi[6], zi[7]); *(u32x4*)d1 = w;
            w.x = pk2(zi[8], zi[9]); w.y = pk2(zi[10], zi[11]); w.z = pk2(zi[12], zi[13]); w.w = pk2(zi[14], zi[15]); *(u32x4*)(d1 + 8) = w; }
    }
    __syncthreads();
}

#define XB_TMO      128
#define XB_XCNT(j)  (256  + 64 * (j))
#define XB_XSUB(j)  (1280 + 64 * (j))
#define XB_XGEN(j)  (2304 + 64 * (j))
#define XB_TOP      3328
#define XB_TOPGEN   3392
#define XCD_BAR_WORDS 3456
#define XB_SPIN_CAP (1u << 18)
__device__ __forceinline__ unsigned xb_ld(unsigned* p)              { return __hip_atomic_load(p, __ATOMIC_RELAXED, __HIP_MEMORY_SCOPE_AGENT); }
__device__ __forceinline__ unsigned xb_add(unsigned* p, unsigned v) { return __hip_atomic_fetch_add(p, v, __ATOMIC_RELAXED, __HIP_MEMORY_SCOPE_AGENT); }
__device__ __forceinline__ unsigned xb_xcc_id() { return (unsigned)__builtin_amdgcn_s_getreg((3 << 11) | 20) & 0xFu; }
#define XB_SPIN(cond, bar) do { unsigned _sp = 0; while (cond) { __builtin_amdgcn_s_sleep(1); \
    if ((++_sp & 255u) == 0u) { if (xb_ld(&(bar)[XB_TMO])) break; if (_sp > XB_SPIN_CAP) { atomicAdd(&(bar)[XB_TMO], 1u); break; } } } } while (0)
struct XcdBarrier { unsigned* bar; unsigned x; volatile LAS unsigned* st; };
__device__ __forceinline__ XcdBarrier xcd_barrier_post(unsigned* bar, volatile LAS unsigned* st, bool leader) {
    XcdBarrier b; b.bar = bar; b.x = xb_xcc_id(); b.st = st;
    if (leader) (void)xb_add(&bar[XB_XCNT(b.x)], 1u);
    return b;
}
__device__ __forceinline__ void xcd_barrier_complete(unsigned* bar, unsigned x, unsigned& nloc, unsigned& nx) {
    const unsigned G = gridDim.x * gridDim.y * gridDim.z;
    unsigned sum, cnt, mine, sp = 0u;
    for (;;) {
        sum = 0u; cnt = 0u; mine = 0u;
#pragma unroll
        for (unsigned j = 0; j < 16; ++j) { const unsigned c = xb_ld(&bar[XB_XCNT(j)]); sum += c; cnt += (c > 0u) ? 1u : 0u; mine = (j == x) ? c : mine; }
        if (sum == G) break;
        __builtin_amdgcn_s_sleep(1);
        if ((++sp & 255u) == 0u) { if (xb_ld(&bar[XB_TMO])) break; if (sp > XB_SPIN_CAP) { atomicAdd(&bar[XB_TMO], 1u); break; } }
    }
    nloc = mine > 0u ? mine : 1u; nx = cnt > 0u ? cnt : 1u;
}
__device__ __forceinline__ void xcd_barrier(const XcdBarrier& b, bool leader) {
    asm volatile("s_waitcnt vmcnt(0)" ::: "memory");
    __syncthreads();
    if (leader) {
        unsigned* bar = b.bar;
        __builtin_amdgcn_s_waitcnt(0);
        unsigned nloc = b.st[0], nx = b.st[1];
        if (nloc == 0u) { xcd_barrier_complete(bar, b.x, nloc, nx); b.st[0] = nloc; b.st[1] = nx; }
        const unsigned old = xb_add(&bar[XB_XSUB(b.x)], 1u);
        const unsigned gen = old / nloc;
        if (old + 1u == (gen + 1u) * nloc) {
            __builtin_amdgcn_fence(__ATOMIC_RELEASE, "agent");
            asm volatile("s_waitcnt vmcnt(0)" ::: "memory");
            const unsigned og = xb_add(&bar[XB_TOP], 1u);
            const unsigned tg = og / nx;
            if (og + 1u == (tg + 1u) * nx) xb_add(&bar[XB_TOPGEN], 1u);
            else XB_SPIN(xb_ld(&bar[XB_TOPGEN]) == tg, bar);
            __builtin_amdgcn_fence(__ATOMIC_ACQUIRE, "agent");
            xb_add(&bar[XB_XGEN(b.x)], 1u);
            asm volatile("s_waitcnt vmcnt(0)" ::: "memory");
        } else {
            XB_SPIN(xb_ld(&bar[XB_XGEN(b.x)]) == gen, bar);
            __builtin_amdgcn_fence(__ATOMIC_ACQUIRE, "agent");
            asm volatile("s_waitcnt vmcnt(0)" ::: "memory");
        }
    }
    __syncthreads();
}

__device__ __forceinline__ void xcd_barrier_arrive(const XcdBarrier& b, bool leader) {
    asm volatile("s_waitcnt vmcnt(0)" ::: "memory");
    __syncthreads();
    if (leader) {
        unsigned* bar = b.bar;
        __builtin_amdgcn_s_waitcnt(0);
        unsigned nloc = b.st[0], nx = b.st[1];
        if (nloc == 0u) { xcd_barrier_complete(bar, b.x, nloc, nx); b.st[0] = nloc; b.st[1] = nx; }
        const unsigned old = xb_add(&bar[XB_XSUB(b.x)], 1u);
        const unsigned gen = old / nloc;
        if (old + 1u == (gen + 1u) * nloc) {
            __builtin_amdgcn_fence(__ATOMIC_RELEASE, "agent");
            asm volatile("s_waitcnt vmcnt(0)" ::: "memory");
            const unsigned og = xb_add(&bar[XB_TOP], 1u);
            const unsigned tg = og / nx;
            if (og + 1u == (tg + 1u) * nx) { xb_add(&bar[XB_TOPGEN], 1u); b.st[5] = 3u; } else b.st[5] = 2u;
            b.st[6] = tg;
        } else { b.st[5] = 1u; b.st[6] = gen; }
    }
}
__device__ __forceinline__ void xcd_barrier_wait(const XcdBarrier& b, bool leader) {
    if (leader) {
        unsigned* bar = b.bar; const unsigned role = b.st[5], g = b.st[6];
        if (role >= 2u) {
            if (role == 2u) XB_SPIN(xb_ld(&bar[XB_TOPGEN]) == g, bar);
            __builtin_amdgcn_fence(__ATOMIC_ACQUIRE, "agent");
            xb_add(&bar[XB_XGEN(b.x)], 1u);
            asm volatile("s_waitcnt vmcnt(0)" ::: "memory");
        } else {
            XB_SPIN(xb_ld(&bar[XB_XGEN(b.x)]) == g, bar);
            __builtin_amdgcn_fence(__ATOMIC_ACQUIRE, "agent");
            asm volatile("s_waitcnt vmcnt(0)" ::: "memory");
        }
    }
    __syncthreads();
}

__global__ void __launch_bounds__(512, 2) fwd_kernel(Args a) {
    extern __shared__ __attribute__((aligned(16))) unsigned char lds_raw[];
    LAS unsigned char* lds = (LAS unsigned char*)lds_raw;
    cg::grid_group grid = cg::this_grid();
    const int wave = __builtin_amdgcn_readfirstlane(threadIdx.x >> 6);
    const bool leader = (wave == 0) && (lane_id_opaque() == 0);
    volatile LAS unsigned* xst = (volatile LAS unsigned*)(lds + XBST_OFF);
    if (leader) { xst[0] = 0u; xst[1] = 0u; }
    __syncthreads();
    if (a.ws == nullptr) grid.sync();
    const XcdBarrier xbar = xcd_barrier_post((unsigned*)(a.ws + WS_BAR), xst, leader);
#define GRID_SYNC() xcd_barrier(xbar, (wave == 0) && (lane_id_opaque() == 0))
#define LANE_IDS const int lane = lane_id_opaque(), tid = wave * 64 + lane; (void)tid;
    const int G = gridDim.x, bid = blockIdx.x;
    unsigned char* ws = a.ws;
    bf16_t* W1T = (bf16_t*)(ws + WS_W1T); bf16_t* WGLUT = (bf16_t*)(ws + WS_WGLUT); bf16_t* WOT = (bf16_t*)(ws + WS_WOT); bf16_t* WGT = (bf16_t*)(ws + WS_WGT); bf16_t* WPT = (bf16_t*)(ws + WS_WPT);
    float2* ROPE = (float2*)(ws + WS_ROPE); float* RINV = (float*)(ws + WS_RINV); float* LB16 = (float*)(ws + WS_LB16); float* SSQ1 = (float*)(ws + WS_SSQ1); float* SSQ2 = (float*)(ws + WS_SSQ2);
    bf16_t* PB = (bf16_t*)(ws + WS_PB); bf16_t* WIN = (bf16_t*)(ws + WS_WIN); bf16_t* WBIG = (bf16_t*)(ws + WS_WBIG);
    bf16_t* XB = (bf16_t*)(ws + WS_XB); bf16_t* HB = (bf16_t*)(ws + WS_XB);
    bf16_t* Q = (bf16_t*)(ws + WS_Q); bf16_t* KB = (bf16_t*)(ws + WS_K); bf16_t* VB = (bf16_t*)(ws + WS_V); bf16_t* GA = (bf16_t*)(ws + WS_GA); bf16_t* GS = (bf16_t*)(ws + WS_GS);
    bf16_t* UCAT = (bf16_t*)(ws + WS_UCAT); bf16_t* PPB = (bf16_t*)(ws + WS_UCAT); bf16_t* YMIX = (bf16_t*)(ws + WS_YMIX); bf16_t* YS = (bf16_t*)(ws + WS_YS);

#pragma unroll
    for (int rep_ = 0; rep_ < 1 + ((REP_MASK >> 0) & 1); ++rep_) { LANE_IDS
        const int gw = bid * 8 + wave, NGW = G * 8;
        LAS float* scr = (LAS float*)(lds + wave * 16384);
        constexpr int I1 = 32 * 144, I2 = 16 * 64, I3 = 32 * 64, I4 = 32 * 64, I5 = 4 * 64, NIT = I1 + I2 + I3 + I4 + I5;
        auto item_desc = [&](int r) -> TrItem {
            if (r < I1) { const int kb = r / 144, lgg = r % 144, pn = lgg >> 3, lg = lgg & 7, wtg = pn * 8 + 4 * (lg & 1) + 2 * (lg >> 2) + ((lg >> 1) & 1);
                return TrItem{a.w_in, W1T, a.norm_mix, DM, DIN, wtg * 32, kb * 64, lgg * 32}; } r -= I1;
            if (r < I2) { const int kb = r / 64, lgg = r % 64, l2 = lgg & 31, wtg = (l2 >> 2) * 8 + 4 * (lgg >> 5) + (l2 & 3);
                return TrItem{a.w_glu, WGLUT, nullptr, DSSM, 2 * DSSM, wtg * 32, kb * 64, lgg * 32}; } r -= I2;
            if (r < I3) { const int kb = r / 64, lgg = r % 64; return TrItem{a.w_out, WOT, nullptr, DM, DM, lgg * 32, kb * 64, lgg * 32}; } r -= I3;
            if (r < I4) { const int kb = r / 64, lgg = r % 64; return TrItem{a.w_ple_gate, WGT, a.norm_ple, DM, DM, lgg * 32, kb * 64, lgg * 32}; } r -= I4;
            const int kb = r / 64, lgg = r % 64; return TrItem{a.w_ple_proj, WPT, nullptr, PLE, DM, lgg * 32, kb * 64, lgg * 32};
        };
#pragma unroll
        for (int rq_ = 0; rq_ < 1 + ((REP_MASK >> 8) & 1); ++rq_)
        for (int it = gw; it < I1; it += 2 * NGW) {
            const bool two = it + NGW < I1;
            const TrItem dA = item_desc(it), dB = item_desc(two ? it + NGW : it);
            float vA[32], vB[32];
            p0_tr_load(dA, vA, lane); if (two) p0_tr_load(dB, vB, lane);
            p0_tr_store(dA, vA, scr, lane); if (two) p0_tr_store(dB, vB, scr, lane);
        }
#pragma unroll
        for (int rq_ = 0; rq_ < 1 + ((REP_MASK >> 9) & 1); ++rq_)
        for (int m = gw; m < T; m += 2 * NGW) {
            const int m2 = m + NGW; const bool two = m2 < T;
            const f32x4* xr = (const f32x4*)(a.x + (size_t)m * DM) + lane; const f32x4* xr2 = (const f32x4*)(a.x + (size_t)(two ? m2 : m) * DM) + lane;
            f32x4 v[8], w2[8]; float s = 0.f, s2 = 0.f;
#pragma unroll
            for (int j = 0; j < 8; ++j) v[j] = __builtin_nontemporal_load(xr + 64 * j);
#pragma unroll
            for (int j = 0; j < 8; ++j) w2[j] = __builtin_nontemporal_load(xr2 + 64 * j);
#pragma unroll
            for (int j = 0; j < 8; ++j) { s += (v[j][0] * v[j][0] + v[j][1] * v[j][1]) + (v[j][2] * v[j][2] + v[j][3] * v[j][3]); s2 += (w2[j][0] * w2[j][0] + w2[j][1] * w2[j][1]) + (w2[j][2] * w2[j][2] + w2[j][3] * w2[j][3]); }
            s = wave_sum(s); s2 = wave_sum(s2);
            if (lane == 0) { RINV[m] = rsqrtf(s * (1.f / DM) + EPS); if (two) RINV[m2] = rsqrtf(s2 * (1.f / DM) + EPS); }
            u32x2* o = (u32x2*)(XB + (size_t)m * DM) + lane; u32x2* o2 = (u32x2*)(XB + (size_t)m2 * DM) + lane;
#pragma unroll
            for (int j = 0; j < 8; ++j) { u32x2 w; w.x = pk2(v[j][0], v[j][1]); w.y = pk2(v[j][2], v[j][3]); o[64 * j] = w; }
            if (two) {
#pragma unroll
                for (int j = 0; j < 8; ++j) { u32x2 w; w.x = pk2(w2[j][0], w2[j][1]); w.y = pk2(w2[j][2], w2[j][3]); o2[64 * j] = w; } }
        }
        for (int i = bid * 512 + tid; i < T * PLE / 4; i += G * 512) { const f32x4 v = __builtin_nontemporal_load((const f32x4*)a.p + i); u32x2 w; w.x = pk2(v[0], v[1]); w.y = pk2(v[2], v[3]); ((u32x2*)PB)[i] = w; }
        for (int i = bid * 512 + tid; i < 2048; i += G * 512) { const int pos = i >> 5, f = i & 31; const float inv = powf(10000.f, -(float)f / 32.f); float sn, cs; sincosf((float)pos * inv, &sn, &cs); ROPE[i] = make_float2(cs, sn); }
        xcd_barrier_arrive(xbar, (wave == 0) && (lane_id_opaque() == 0));
        for (int it = I1 + gw; it < NIT; it += 2 * NGW) {
            const bool two = it + NGW < NIT;
            const TrItem dA = item_desc(it), dB = item_desc(two ? it + NGW : it);
            float vA[32], vB[32];
            p0_tr_load(dA, vA, lane); if (two) p0_tr_load(dB, vB, lane);
            p0_tr_store(dA, vA, scr, lane); if (two) p0_tr_store(dB, vB, scr, lane);
        }
        xcd_barrier_wait(xbar, (wave == 0) && (lane_id_opaque() == 0)); }


    if constexpr ((REP_MASK >> 10) & 1) { GRID_SYNC(); GRID_SYNC(); GRID_SYNC(); GRID_SYNC(); }
#pragma unroll
    for (int rep_ = 0; rep_ < 1 + ((REP_MASK >> 1) & 1); ++rep_) { LANE_IDS
        { pg8::Gemm g{XB, W1T, DM, DM, DM, 0, 0}; pg8::StaticOrder S; S.init(T, 14 * 256, G, bid);
          pg8::Epi1 E{RINV, a.q_norm, a.k_norm, ROPE, Q, KB, VB, GA, GS, UCAT, (LAS float*)(lds + XCH_OFF), 0};
          pg8::gemm_phase<pg8::Epi1, pg8::StaticOrder, true>(lds, g, S, E, wave); }
        __syncthreads();
        for (int gi = bid - (G - NG); gi >= 0 && gi < NG; gi += NG) ssm_tables(a, gi, lds, tid);
    GRID_SYNC(); }

#pragma unroll
    for (int rep_ = 0; rep_ < 1 + ((REP_MASK >> 2) & 1); ++rep_) {
#pragma unroll
        for (int rq_ = 0; rq_ < 2; ++rq_) {
        if (bid < 2 * NG) { if (rq_ == 1 && !((REP_MASK >> 6) & 1)) break;
            pg8::BatchOrder S{2 * NG, G, bid};
            { pg8::Gemm g{UCAT, WIN, 256, 512, 256, (size_t)NCH * 512 * 2, (size_t)256 * 256 * 2};
              pg8::EpiS1 E{LB16, UCAT}; pg8::gemm_phase<pg8::EpiS1, pg8::BatchOrder, true>(lds, g, S, E, wave); }
            asm volatile("s_waitcnt vmcnt(0)\n\tbuffer_inv sc1\n\ts_waitcnt vmcnt(0)" ::: "memory"); __syncthreads();
            { pg8::Gemm g{UCAT, WBIG, 512, 512, 512, (size_t)NCH * 512 * 2, (size_t)256 * 512 * 2};
              pg8::EpiS2 E{YS}; pg8::gemm_phase<pg8::EpiS2, pg8::BatchOrder, true>(lds, g, S, E, wave); }
        } else { if (rq_ == 1 && !((REP_MASK >> 11) & 1)) break;
            pg8::Gemm g{XB, W1T + (size_t)14 * 256 * DM, DM, DM, DM, 0, 0}; pg8::ListOrder S{bid - 2 * NG, 128, G};
            pg8::Epi1 E{RINV, a.q_norm, a.k_norm, ROPE, Q, KB, VB, GA, GS, UCAT, (LAS float*)(lds + XCH_OFF), 14};
            pg8::gemm_phase<pg8::Epi1, pg8::ListOrder, true>(lds, g, S, E, wave);
        }
        __syncthreads(); }
#pragma unroll
        for (int rq_ = 0; rq_ < 1 + ((REP_MASK >> 7) & 1); ++rq_)
        for (int un = bid; un < 256; un += G) {
            const int x = un & 7, jj = un >> 3, b = x >> 2, kvh = (x >> 1) & 1, idx = (x & 1) * 32 + jj, h = kvh * 4 + (idx >> 4), qb = idx & 15;
            const size_t tok0 = (size_t)b * SEQ + qb * 256;
            att::attn_dense_body(Q + tok0 * DATT + h * 128, KB + (size_t)b * SEQ * DKV + kvh * 128, VB + (size_t)b * SEQ * DKV + kvh * 128,
                                 GA + tok0 * DATT + h * 128, YMIX + tok0 * DM + h * 128, SEQ, (char*)lds_raw, wave);
        }
    GRID_SYNC(); }

#pragma unroll
    for (int rep_ = 0; rep_ < 1 + ((REP_MASK >> 3) & 1); ++rep_) {
        { pg8::StaticOrder S; S.init(T, 2 * DSSM, G, bid); pg8::Unit ua, ub;
          if (S.next(0, ua)) { ub = ua;
            pg8::Gemm ga{YS, WGLUT, DSSM, DSSM, DSSM, 0, 0}; pg8::EpiGlu Ea{a.b_glu, GS, YMIX};
            pg8::Gemm gb{PB, WPT, PLE, PLE, PLE, 0, 0}; pg8::EpiBf Eb{PPB, DM};
            pg8::gemm_phase2<pg8::EpiGlu, pg8::EpiBf>(lds, ga, ua, Ea, gb, ub, Eb, wave); } }
    GRID_SYNC(); }

#pragma unroll
    for (int rep_ = 0; rep_ < 1 + ((REP_MASK >> 4) & 1); ++rep_) {
        pg8::Gemm g{YMIX, WOT, DM, DM, DM, 0, 0}; pg8::StaticOrder S; S.init(T, DM, G, bid);
        pg8::EpiOut E{a.x, a.out, HB, SSQ1}; pg8::gemm_phase<pg8::EpiOut, pg8::StaticOrder, true>(lds, g, S, E, wave);
    GRID_SYNC(); }


    { LANE_IDS
        pg8::StaticOrder S; S.init(T, DM, G, bid); pg8::Unit u0;
        LAS float* r2 = (LAS float*)(lds + R2_OFF);
        if (S.next(0, u0) && tid < 256) { const float* sp = SSQ1 + (size_t)(u0.pm * 256 + tid) * 32; float s = 0.f;
#pragma unroll
            for (int i = 0; i < 8; ++i) { const f32x4 v = ((const f32x4*)sp)[i]; s += (v[0] + v[1]) + (v[2] + v[3]); }
            r2[tid] = rsqrtf(s * (1.f / DM) + EPS); }
        __syncthreads();
        pg8::Gemm g{HB, WGT, DM, DM, DM, 0, 0};
        pg8::EpiGate E{a.out, PPB, SSQ2, (unsigned*)ws, a.norm_final, r2, HB}; pg8::gemm_phase<pg8::EpiGate, pg8::StaticOrder, true>(lds, g, S, E, wave);
    }
}

extern "C" void kernel_launch(void* const* d_in, const int* in_sizes, int n_in, void* d_out, int out_size, void* d_ws, size_t ws_size, hipStream_t stream) {
    static int grid = 0;
    if (grid == 0) {
        if (n_in != 21 || in_sizes[0] != T * DM || out_size != T * DM || ws_size < WS_END) { fprintf(stderr, "kernel_launch: unexpected shapes (n_in %d, in0 %d, out %d, ws %zu)\n", n_in, n_in > 0 ? in_sizes[0] : -1, out_size, ws_size); grid = -1; return; }
        int dev = 0, cus = 0, per_cu = 0;
        hipGetDevice(&dev); hipDeviceGetAttribute(&cus, hipDeviceAttributeMultiprocessorCount, dev);
        if (hipFuncSetAttribute((const void*)fwd_kernel, hipFuncAttributeMaxDynamicSharedMemorySize, LDS_BYTES) != hipSuccess) { fprintf(stderr, "kernel_launch: hipFuncSetAttribute failed\n"); grid = -1; return; }
        hipOccupancyMaxActiveBlocksPerMultiprocessor(&per_cu, (const void*)fwd_kernel, 512, LDS_BYTES);
        (void)hipGetLastError();
        if (per_cu < 1) fprintf(stderr, "kernel_launch: occupancy query reports %d blocks per CU\n", per_cu);
        grid = cus > 256 ? 256 : cus;
    }
    if (grid < 0) return;
    Args a{};
    const float** f = (const float**)&a;
    for (int i = 0; i < 21; ++i) f[i] = (const float*)d_in[i];
    a.out = (float*)d_out; a.ws = (unsigned char*)d_ws;
    if (hipMemsetAsync(d_ws, 0, WS_CTL_BYTES, stream) != hipSuccess) { fprintf(stderr, "kernel_launch: hipMemsetAsync failed\n"); return; }
    void* args[] = {&a};
    hipError_t e = hipLaunchCooperativeKernel((const void*)fwd_kernel, dim3(grid), dim3(512), args, LDS_BYTES, stream);
    if (e != hipSuccess) fprintf(stderr, "kernel_launch: cooperative launch failed: %s (grid %d)\n", hipGetErrorString(e), grid);
}
```

```cpp
#include <hip/hip_runtime.h>
#include <hip/hip_cooperative_groups.h>
#include <cstdio>
#include <cstdint>
namespace cg = cooperative_groups;

#define LAS __attribute__((address_space(3)))
typedef unsigned short bf16_t;
typedef short bf16x8 __attribute__((ext_vector_type(8)));
typedef short s16x4 __attribute__((ext_vector_type(4)));
typedef float f32x4 __attribute__((ext_vector_type(4)));
typedef float f32x16 __attribute__((ext_vector_type(16)));
typedef unsigned u32x4 __attribute__((ext_vector_type(4)));
typedef unsigned u32x2 __attribute__((ext_vector_type(2)));

constexpr int T = 8192, SEQ = 4096, DM = 2048, DIN = 4608, DATT = 1024, DKV = 256, DSSM = 1024, PLE = 256;
constexpr int NG = 64, NCH = T / 16;
constexpr float EPS = 1e-6f;
#ifndef PH_MASK
#define PH_MASK 0xff
#endif
#ifndef GLDS_AUX
#define GLDS_AUX 0
#endif
#ifndef REP_MASK
#define REP_MASK 0
#endif

constexpr size_t MiB = 1u << 20;
constexpr size_t WS_W1T = 1 * MiB, WS_WGLUT = 19 * MiB, WS_WOT = 23 * MiB, WS_WGT = 31 * MiB, WS_WPT = 39 * MiB;
constexpr size_t WS_ROPE = 40 * MiB, WS_RINV = 40 * MiB + 65536, WS_LB16 = 40 * MiB + 131072, WS_SSQ1 = 41 * MiB, WS_SSQ2 = 42 * MiB;
constexpr size_t WS_PB = 43 * MiB, WS_WIN = 47 * MiB, WS_WBIG = 55 * MiB;
constexpr size_t WS_XB = 71 * MiB;
constexpr size_t WS_Q = 103 * MiB, WS_K = 119 * MiB, WS_V = 123 * MiB, WS_GA = 127 * MiB, WS_GS = 143 * MiB;
constexpr size_t WS_UCAT = 159 * MiB;
constexpr size_t WS_YMIX = 191 * MiB, WS_YS = 223 * MiB, WS_END = 239 * MiB;

constexpr int RING_BYTES = 131072, XCH_OFF = RING_BYTES, R2_OFF = RING_BYTES + 4096, XBST_OFF = RING_BYTES + 8192, LDS_BYTES = 147456;
constexpr size_t WS_BAR = 65536, WS_CTL_BYTES = 131072;

struct Args {
    const float *x, *p, *norm_mix, *w_in, *q_norm, *k_norm, *a_re, *a_im, *log_dt, *b_re, *b_im, *c_re, *c_im, *ssm_d, *w_glu, *b_glu, *w_out, *norm_ple, *w_ple_gate, *w_ple_proj, *norm_final;
    float* out; unsigned char* ws;
};

typedef __bf16 bf16s_;
__device__ __forceinline__ unsigned f2bf(float f) { return (unsigned)__builtin_bit_cast(unsigned short, (bf16s_)f); }
typedef float f32x2_ __attribute__((ext_vector_type(2)));
typedef __bf16 bf16x2_ __attribute__((ext_vector_type(2)));
__device__ __forceinline__ unsigned pk2(float lo, float hi) { const f32x2_ v = {lo, hi}; return __builtin_bit_cast(unsigned, __builtin_convertvector(v, bf16x2_)); }
__device__ __forceinline__ float bf2f(unsigned short b) { return __builtin_bit_cast(float, (unsigned)b << 16); }
__device__ __forceinline__ float bflo(unsigned w) { return __builtin_bit_cast(float, w << 16); }
__device__ __forceinline__ float bfhi(unsigned w) { return __builtin_bit_cast(float, w & 0xffff0000u); }
__device__ __forceinline__ unsigned cvt_pk_bf16(float lo, float hi) { unsigned r; asm volatile("v_cvt_pk_bf16_f32 %0, %1, %2" : "=v"(r) : "v"(lo), "v"(hi)); return r; }
__device__ __forceinline__ float sigmoidf_(float v) { return __builtin_amdgcn_rcpf(1.f + __builtin_amdgcn_exp2f(-1.4426950408889634f * v)); }
__device__ __forceinline__ float siluf_(float v) { return v * __builtin_amdgcn_rcpf(1.f + __builtin_amdgcn_exp2f(-1.4426950408889634f * v)); }
__device__ __forceinline__ float gelu_tanh(float v) { const float t = (-1.5957691216057308f * 1.4426950408889634f) * (v + 0.044715f * v * v * v); return v * __builtin_amdgcn_rcpf(1.f + __builtin_amdgcn_exp2f(t)); }
template <int K> __device__ __forceinline__ float swz_xor(float v) { return __int_as_float(__builtin_amdgcn_ds_swizzle(__float_as_int(v), (K << 10) | 0x1f)); }
__device__ __forceinline__ float sum_xor32(float v) { auto rr = __builtin_amdgcn_permlane32_swap(__float_as_uint(v), __float_as_uint(v), false, false); return __uint_as_float(rr[0]) + __uint_as_float(rr[1]); }
__device__ __forceinline__ float wave_sum(float v) { v += swz_xor<1>(v); v += swz_xor<2>(v); v += swz_xor<4>(v); v += swz_xor<8>(v); v += swz_xor<16>(v); return sum_xor32(v); }
#define LDS_WAIT() asm volatile("s_waitcnt lgkmcnt(0)" ::: "memory")
__device__ __forceinline__ int lane_id_opaque() { int l = __builtin_amdgcn_mbcnt_hi(~0u, __builtin_amdgcn_mbcnt_lo(~0u, 0u)); asm volatile("" : "+v"(l)); return l; }

namespace pg8 {
constexpr int BM = 256, BK = 64, HALF = 128, HTB = HALF * BK * 2, NXCD = 8, WGM = 8;
__host__ __device__ __forceinline__ int lds_byte(int r, int c) { const int st = (r >> 4) * 2 + (c >> 5), rr = r & 15, cc = c & 31, ob = rr * 64 + cc * 2; return st * 1024 + (ob ^ (((ob >> 9) & 1) << 5)); }
__host__ __device__ __forceinline__ void stage_rc(int b, int& R, int& C) { const int st = b / 1024, sb = b % 1024, swz = sb ^ (((sb >> 9) & 1) << 5); R = (st >> 1) * 16 + swz / 64; C = (st & 1) * 32 + (swz % 64) / 2; }
__host__ __device__ __forceinline__ int perm32(int rho) { const int n = rho >> 4, i = rho & 15; return 8 * (i >> 2) + 4 * n + (i & 3); }

struct Unit { int pm, pn, z; };
struct Gemm { const bf16_t* A; const bf16_t* Bt; int K, lda, ldb; size_t zA, zB; };

struct StaticOrder {
    int nM, nN, nwg, G, c;
    __device__ void init(int M, int N, int G_, int c_) { nM = M / BM; nN = N / BM; nwg = nM * nN; G = G_; c = c_; }
    __device__ bool next(int i, Unit& u) const {
        const long L = (long)i * G + c; if (L >= nwg) return false;
        int wgid = (int)L; { const int q = nwg / NXCD, r = nwg % NXCD, xcd = wgid % NXCD, off = wgid / NXCD; wgid = (xcd < r ? xcd * (q + 1) : r * (q + 1) + (xcd - r) * q) + off; }
        const int nig = WGM * nN, gid = wgid / nig, fm = gid * WGM, gsz = (nM - fm) < WGM ? (nM - fm) : WGM;
        u.pm = fm + ((wgid % nig) % gsz); u.pn = (wgid % nig) / gsz; u.z = 0; return true;
    }
};
struct BatchOrder {
    int n, G, c;
    __device__ bool next(int i, Unit& u) const { const int L = i * G + c; if (L >= n) return false; u.z = L >> 1; u.pm = L & 1; u.pn = 0; return true; }
};

struct ListOrder {
    int L0, n, stride;
    __device__ bool next(int i, Unit& u) const { const int L = L0 + i * stride; if (L < 0 || L >= n) return false;
        const int x = L & 7, j = L >> 3; u.pm = 4 * x + (j >> 2); u.pn = j & 3; u.z = 0; return true; }
};
template <class Epi, class Sched, bool ALIGN_EPI>
__device__ __forceinline__ void gemm_phase(LAS unsigned char* lds, const Gemm g, const Sched& S, const Epi& E, const int wid) {
    const int lane = lane_id_opaque(), tid = wid * 64 + lane, wr = wid >> 2, wc = wid & 3, fr = lane & 15, fq = lane >> 4;
    const int K = g.K, nt = K / BK;
    unsigned voffA[2], voffB[2];
#pragma unroll
    for (int i = 0; i < 2; ++i) { int R, C; stage_rc(tid * 16 + i * 8192, R, C); const int Rb = (R & ~31) + perm32(R & 31);
        voffA[i] = (unsigned)(R * g.lda + C) * 2u; voffB[i] = (unsigned)(Rb * g.ldb + C) * 2u; }
    const size_t kstep = (size_t)(BK * 2);
    const size_t hstepA = (size_t)HALF * g.lda * 2, hstepB = (size_t)HALF * g.ldb * 2;
    const size_t tstepA = 2 * hstepA, tstepB = 2 * hstepB;
    const unsigned ldsw = (unsigned)wid * 1024u;
    const int aoff = lds_byte(wr * 64 + fr, fq * 8), boff = lds_byte(wc * 32 + fr, fq * 8);
#define PG8_SA(b, h) (((b) * 2 + (h)) * HTB)
#define PG8_SB(b, h) ((4 + (b) * 2 + (h)) * HTB)
#define PG8_STAGE(bufoff, gbase, voff) do { _Pragma("unroll") for (int _i = 0; _i < 2; ++_i) \
        __builtin_amdgcn_global_load_lds((const unsigned*)((const char*)(gbase) + (voff)[_i]), (LAS unsigned*)(lds + (bufoff) + ldsw + _i * 8192), 16, 0, GLDS_AUX); } while (0)
#define PG8_LDA(dst, b, h) do { _Pragma("unroll") for (int m = 0; m < 4; ++m) _Pragma("unroll") for (int k = 0; k < 2; ++k) dst[m][k] = *(const LAS bf16x8*)(lds + PG8_SA(b, h) + aoff + m * 2048 + k * 1024); } while (0)
#define PG8_LDB(dst, b, h) do { _Pragma("unroll") for (int n = 0; n < 2; ++n) _Pragma("unroll") for (int k = 0; k < 2; ++k) dst[n][k] = *(const LAS bf16x8*)(lds + PG8_SB(b, h) + boff + n * 2048 + k * 1024); } while (0)
#define PG8_MMA(ai, bj, At, Bt) do { __builtin_amdgcn_s_setprio(1); _Pragma("unroll") for (int m = 0; m < 4; ++m) _Pragma("unroll") for (int n = 0; n < 2; ++n) _Pragma("unroll") for (int k = 0; k < 2; ++k) \
        acc[ai][bj][m][n] = __builtin_amdgcn_mfma_f32_16x16x32_bf16(Bt[n][k], At[m][k], acc[ai][bj][m][n], 0, 0, 0); __builtin_amdgcn_s_setprio(0); } while (0)
#define PG8_WAIT_V(n) asm volatile("s_waitcnt vmcnt(" #n ")" ::: "memory")
#define PG8_WAIT_L(n) asm volatile("s_waitcnt lgkmcnt(" #n ")" ::: "memory")
#define PG8_BAR __builtin_amdgcn_s_barrier()
#define PG8_SCHED __builtin_amdgcn_sched_barrier(0)
    Unit cur, nxt; int ui = 0;
    if (!S.next(0, cur)) return;
    f32x4 acc[2][2][4][2];
#pragma unroll
    for (int a = 0; a < 2; ++a)
#pragma unroll
        for (int b = 0; b < 2; ++b)
#pragma unroll
            for (int m = 0; m < 4; ++m)
#pragma unroll
                for (int n = 0; n < 2; ++n) acc[a][b][m][n] = (f32x4){0.f, 0.f, 0.f, 0.f};
    bf16x8 At[4][2], B0[2][2], B1[2][2];
    const char* cA = (const char*)g.A + (size_t)cur.z * g.zA + (size_t)cur.pm * tstepA; const char* cB = (const char*)g.Bt + (size_t)cur.z * g.zB + (size_t)cur.pn * tstepB;
    PG8_STAGE(PG8_SB(0, 0), cB, voffB); PG8_STAGE(PG8_SB(0, 1), cB + hstepB, voffB); PG8_STAGE(PG8_SA(0, 0), cA, voffA); PG8_STAGE(PG8_SA(0, 1), cA + hstepA, voffA);
    if (wr == 1) PG8_BAR;
    PG8_WAIT_V(2); PG8_BAR;
    PG8_STAGE(PG8_SB(1, 0), cB + kstep, voffB); PG8_STAGE(PG8_SA(1, 0), cA + kstep, voffA); PG8_STAGE(PG8_SB(1, 1), cB + hstepB + kstep, voffB);
    PG8_WAIT_V(6); PG8_BAR;
    for (;;) {
        const bool has_next = S.next(ui + 1, nxt);
        const char* nA = has_next ? (const char*)g.A + (size_t)nxt.z * g.zA + (size_t)nxt.pm * tstepA : cA;
        const char* nB = has_next ? (const char*)g.Bt + (size_t)nxt.z * g.zB + (size_t)nxt.pn * tstepB : cB;
        for (int t = 0; t < nt; t += 2) {
            const bool last = (t == nt - 2);
            const char* a1 = cA + (size_t)(t + 1) * kstep;
            const char* a2 = last ? nA : cA + (size_t)(t + 2) * kstep; const char* b2 = last ? nB : cB + (size_t)(t + 2) * kstep;
            const char* a3 = a2 + kstep; const char* b3 = b2 + kstep;
            PG8_LDB(B0, 0, 0); PG8_LDB(B1, 0, 1); PG8_SCHED; PG8_LDA(At, 0, 0); PG8_STAGE(PG8_SA(1, 1), a1 + hstepA, voffA);
            PG8_WAIT_V(8); PG8_WAIT_L(0); PG8_BAR; PG8_MMA(0, 0, At, B0); PG8_MMA(0, 1, At, B1); PG8_BAR; PG8_SCHED;
            PG8_LDA(At, 0, 1); PG8_STAGE(PG8_SB(0, 0), b2, voffB); PG8_STAGE(PG8_SB(0, 1), b2 + hstepB, voffB); PG8_STAGE(PG8_SA(0, 0), a2, voffA);
            PG8_WAIT_V(8); PG8_WAIT_L(0); PG8_BAR; PG8_MMA(1, 0, At, B0); PG8_MMA(1, 1, At, B1); PG8_BAR; PG8_SCHED;
            PG8_LDB(B0, 1, 0); PG8_LDB(B1, 1, 1); PG8_SCHED; PG8_LDA(At, 1, 0); PG8_STAGE(PG8_SA(0, 1), a2 + hstepA, voffA);
            PG8_WAIT_V(8); PG8_WAIT_L(0); PG8_BAR; PG8_MMA(0, 0, At, B0); PG8_MMA(0, 1, At, B1); PG8_BAR; PG8_SCHED;
            PG8_LDA(At, 1, 1); PG8_STAGE(PG8_SB(1, 0), b3, voffB); PG8_STAGE(PG8_SB(1, 1), b3 + hstepB, voffB); PG8_STAGE(PG8_SA(1, 0), a3, voffA);
            PG8_WAIT_V(8); PG8_WAIT_L(0); PG8_BAR; PG8_MMA(1, 0, At, B0); PG8_MMA(1, 1, At, B1); PG8_BAR; PG8_SCHED;
        }
        if constexpr (ALIGN_EPI) { if (wr == 0) PG8_BAR; }
        if constexpr (!Epi::AFTER_DRAIN) E(acc, cur, wr, wc, fr, fq);
        if (!has_next) break;
#pragma unroll
        for (int a = 0; a < 2; ++a)
#pragma unroll
            for (int b = 0; b < 2; ++b)
#pragma unroll
                for (int m = 0; m < 4; ++m)
#pragma unroll
                    for (int n = 0; n < 2; ++n) acc[a][b][m][n] = (f32x4){0.f, 0.f, 0.f, 0.f};
        cur = nxt; cA = nA; cB = nB; ++ui;
        if constexpr (ALIGN_EPI) { if (wr == 1) PG8_BAR; }
    }
    PG8_WAIT_V(0);
    if constexpr (!ALIGN_EPI) { if (wr == 0) PG8_BAR; }
    PG8_BAR;
    if constexpr (Epi::AFTER_DRAIN) E.fused(acc, cur, wr, wc, lds, wid);
#undef PG8_SA
#undef PG8_SB
#undef PG8_STAGE
#undef PG8_LDA
#undef PG8_LDB
#undef PG8_MMA
#undef PG8_WAIT_V
#undef PG8_WAIT_L
#undef PG8_BAR
#undef PG8_SCHED
}

template <class EpiA, class EpiB>
__device__ __forceinline__ void gemm_phase2(LAS unsigned char* lds, const Gemm g0, const Unit u0, const EpiA& E0, const Gemm g1, const Unit u1, const EpiB& E1, const int wid) {
    const int lane = lane_id_opaque(), tid = wid * 64 + lane, wr = wid >> 2, wc = wid & 3, fr = lane & 15, fq = lane >> 4;
    unsigned vA0[2], vB0[2], vA1[2], vB1[2];
#pragma unroll
    for (int i = 0; i < 2; ++i) { int R, C; stage_rc(tid * 16 + i * 8192, R, C); const int Rb = (R & ~31) + perm32(R & 31);
        vA0[i] = (unsigned)(R * g0.lda + C) * 2u; vB0[i] = (unsigned)(Rb * g0.ldb + C) * 2u; vA1[i] = (unsigned)(R * g1.lda + C) * 2u; vB1[i] = (unsigned)(Rb * g1.ldb + C) * 2u; }
    const size_t kstep = (size_t)(BK * 2);
    const size_t hA0 = (size_t)HALF * g0.lda * 2, hB0 = (size_t)HALF * g0.ldb * 2, hA1 = (size_t)HALF * g1.lda * 2, hB1 = (size_t)HALF * g1.ldb * 2;
    const unsigned ldsw = (unsigned)wid * 1024u;
    const int aoff = lds_byte(wr * 64 + fr, fq * 8), boff = lds_byte(wc * 32 + fr, fq * 8);
#define PG8_SA(b, h) (((b) * 2 + (h)) * HTB)
#define PG8_SB(b, h) ((4 + (b) * 2 + (h)) * HTB)
#define PG8_STAGE(bufoff, gbase, voff) do { _Pragma("unroll") for (int _i = 0; _i < 2; ++_i) \
        __builtin_amdgcn_global_load_lds((const unsigned*)((const char*)(gbase) + (voff)[_i]), (LAS unsigned*)(lds + (bufoff) + ldsw + _i * 8192), 16, 0, 0); } while (0)
#define PG8_LDA(dst, b, h) do { _Pragma("unroll") for (int m = 0; m < 4; ++m) _Pragma("unroll") for (int k = 0; k < 2; ++k) dst[m][k] = *(const LAS bf16x8*)(lds + PG8_SA(b, h) + aoff + m * 2048 + k * 1024); } while (0)
#define PG8_LDB(dst, b, h) do { _Pragma("unroll") for (int n = 0; n < 2; ++n) _Pragma("unroll") for (int k = 0; k < 2; ++k) dst[n][k] = *(const LAS bf16x8*)(lds + PG8_SB(b, h) + boff + n * 2048 + k * 1024); } while (0)
#define PG8_MMA(ai, bj, At, Bt) do { __builtin_amdgcn_s_setprio(1); _Pragma("unroll") for (int m = 0; m < 4; ++m) _Pragma("unroll") for (int n = 0; n < 2; ++n) _Pragma("unroll") for (int k = 0; k < 2; ++k) \
        acc[ai][bj][m][n] = __builtin_amdgcn_mfma_f32_16x16x32_bf16(Bt[n][k], At[m][k], acc[ai][bj][m][n], 0, 0, 0); __builtin_amdgcn_s_setprio(0); } while (0)
#define PG8_WAIT_V(n) asm volatile("s_waitcnt vmcnt(" #n ")" ::: "memory")
#define PG8_WAIT_L(n) asm volatile("s_waitcnt lgkmcnt(" #n ")" ::: "memory")
#define PG8_BAR __builtin_amdgcn_s_barrier()
#define PG8_SCHED __builtin_amdgcn_sched_barrier(0)
    f32x4 acc[2][2][4][2];
#pragma unroll
    for (int a = 0; a < 2; ++a)
#pragma unroll
        for (int b = 0; b < 2; ++b)
#pragma unroll
            for (int m = 0; m < 4; ++m)
#pragma unroll
                for (int n = 0; n < 2; ++n) acc[a][b][m][n] = (f32x4){0.f, 0.f, 0.f, 0.f};
    bf16x8 At[4][2], B0[2][2], B1[2][2];
    const char* A0 = (const char*)g0.A + (size_t)u0.pm * 2 * hA0; const char* Bp0 = (const char*)g0.Bt + (size_t)u0.pn * 2 * hB0;
    const char* A1 = (const char*)g1.A + (size_t)u1.pm * 2 * hA1; const char* Bp1 = (const char*)g1.Bt + (size_t)u1.pn * 2 * hB1;
    PG8_STAGE(PG8_SB(0, 0), Bp0, vB0); PG8_STAGE(PG8_SB(0, 1), Bp0 + hB0, vB0); PG8_STAGE(PG8_SA(0, 0), A0, vA0); PG8_STAGE(PG8_SA(0, 1), A0 + hA0, vA0);
    if (wr == 1) PG8_BAR;
    PG8_WAIT_V(2); PG8_BAR;
    PG8_STAGE(PG8_SB(1, 0), Bp0 + kstep, vB0); PG8_STAGE(PG8_SA(1, 0), A0 + kstep, vA0); PG8_STAGE(PG8_SB(1, 1), Bp0 + hB0 + kstep, vB0);
    PG8_WAIT_V(6); PG8_BAR;
#pragma unroll
    for (int ui = 0; ui < 2; ++ui) {
        const char* cA = ui == 0 ? A0 : A1; const char* cB = ui == 0 ? Bp0 : Bp1;
        const size_t hAc = ui == 0 ? hA0 : hA1, hBc = ui == 0 ? hB0 : hB1;
        const int nt = (ui == 0 ? g0.K : g1.K) / BK;
        unsigned vAc[2], vBc[2];
#pragma unroll
        for (int i = 0; i < 2; ++i) { vAc[i] = ui == 0 ? vA0[i] : vA1[i]; vBc[i] = ui == 0 ? vB0[i] : vB1[i]; }
        for (int t = 0; t < nt; t += 2) {
            const bool last = (t == nt - 2);
            const char* a1 = cA + (size_t)(t + 1) * kstep;
            const char* a2 = last ? A1 : cA + (size_t)(t + 2) * kstep; const char* b2 = last ? Bp1 : cB + (size_t)(t + 2) * kstep;
            const char* a3 = a2 + kstep; const char* b3 = b2 + kstep;
            const size_t hA2 = last ? hA1 : hAc, hB2 = last ? hB1 : hBc;
            unsigned vA2[2], vB2[2];
#pragma unroll
            for (int i = 0; i < 2; ++i) { vA2[i] = last ? vA1[i] : vAc[i]; vB2[i] = last ? vB1[i] : vBc[i]; }
            PG8_LDB(B0, 0, 0); PG8_LDB(B1, 0, 1); PG8_SCHED; PG8_LDA(At, 0, 0); PG8_STAGE(PG8_SA(1, 1), a1 + hAc, vAc);
            PG8_WAIT_V(8); PG8_WAIT_L(0); PG8_BAR; PG8_MMA(0, 0, At, B0); PG8_MMA(0, 1, At, B1); PG8_BAR; PG8_SCHED;
            PG8_LDA(At, 0, 1); PG8_STAGE(PG8_SB(0, 0), b2, vB2); PG8_STAGE(PG8_SB(0, 1), b2 + hB2, vB2); PG8_STAGE(PG8_SA(0, 0), a2, vA2);
            PG8_WAIT_V(8); PG8_WAIT_L(0); PG8_BAR; PG8_MMA(1, 0, At, B0); PG8_MMA(1, 1, At, B1); PG8_BAR; PG8_SCHED;
            PG8_LDB(B0, 1, 0); PG8_LDB(B1, 1, 1); PG8_SCHED; PG8_LDA(At, 1, 0); PG8_STAGE(PG8_SA(0, 1), a2 + hA2, vA2);
            PG8_WAIT_V(8); PG8_WAIT_L(0); PG8_BAR; PG8_MMA(0, 0, At, B0); PG8_MMA(0, 1, At, B1); PG8_BAR; PG8_SCHED;
            PG8_LDA(At, 1, 1); PG8_STAGE(PG8_SB(1, 0), b3, vB2); PG8_STAGE(PG8_SB(1, 1), b3 + hB2, vB2); PG8_STAGE(PG8_SA(1, 0), a3, vA2);
            PG8_WAIT_V(8); PG8_WAIT_L(0); PG8_BAR; PG8_MMA(1, 0, At, B0); PG8_MMA(1, 1, At, B1); PG8_BAR; PG8_SCHED;
        }
        if (wr == 0) PG8_BAR;
        if (ui == 0) {
            E0(acc, u0, wr, wc, fr, fq);
#pragma unroll
            for (int a = 0; a < 2; ++a)
#pragma unroll
                for (int b = 0; b < 2; ++b)
#pragma unroll
                    for (int m = 0; m < 4; ++m)
#pragma unroll
                        for (int n = 0; n < 2; ++n) acc[a][b][m][n] = (f32x4){0.f, 0.f, 0.f, 0.f};
            if (wr == 1) PG8_BAR;
        } else E1(acc, u1, wr, wc, fr, fq);
    }
    PG8_WAIT_V(0);
    PG8_BAR;
#undef PG8_SA
#undef PG8_SB
#undef PG8_STAGE
#undef PG8_LDA
#undef PG8_LDB
#undef PG8_MMA
#undef PG8_WAIT_V
#undef PG8_WAIT_L
#undef PG8_BAR
#undef PG8_SCHED
}

#define EPI_FOR_ROWS _Pragma("unroll") for (int ai = 0; ai < 2; ++ai) _Pragma("unroll") for (int m = 0; m < 4; ++m)
#define EPI_ROWDEF const int rit = ai * HALF + wr * 64 + m * 16 + fr; const int row = u.pm * BM + rit; (void)rit; (void)row;

struct Epi1 {
    static constexpr bool AFTER_DRAIN = false;
    const float* rinv; const float* qnw; const float* knw; const float2* rope;
    bf16_t *Q, *Kb, *Vb, *GA, *GS, *UCAT; LAS float* xch; int pn0;
    __device__ __forceinline__ void operator()(const f32x4 (&acc)[2][2][4][2], const Unit& u, int wr, int wc, int, int) const {
        const int l_ = lane_id_opaque(), fr = l_ & 15, fq = l_ >> 4;
        const int pn = u.pn + pn0;
        if (pn <= 4) {
            float ss[2][4], rv[2][4];
            EPI_FOR_ROWS { EPI_ROWDEF const float r = rinv[row]; rv[ai][m] = r; float s = 0.f;
#pragma unroll
                for (int bj = 0; bj < 2; ++bj)
#pragma unroll
                    for (int n = 0; n < 2; ++n) { const f32x4 v = acc[ai][bj][m][n] * r; s += (v[0] * v[0] + v[1] * v[1]) + (v[2] * v[2] + v[3] * v[3]); }
                s += swz_xor<16>(s); s = sum_xor32(s); ss[ai][m] = s;
                if (fq == 0) xch[wc * 256 + rit] = s; }
            LDS_WAIT(); __builtin_amdgcn_s_barrier(); asm volatile("" ::: "memory");
            const int half = wc & 1, hd = wc >> 1;
            const float* nw = (pn < 4 ? qnw : knw) + 64 * half + 8 * fq;
            float w1[8], w2[8];
#pragma unroll
            for (int i = 0; i < 8; ++i) { w1[i] = nw[i]; w2[i] = nw[32 + i]; }
            EPI_FOR_ROWS { EPI_ROWDEF const float tot = ss[ai][m] + xch[(wc ^ 1) * 256 + rit];
                const float sc = rv[ai][m] * rsqrtf(tot * (1.f / 128.f) + EPS);
                const int t = row & (SEQ - 1); const int pos = half ? (t & 63) : (t >> 6);
                const float2* rp = rope + pos * 32 + 8 * fq;
                float o1[8], o2[8];
#pragma unroll
                for (int n = 0; n < 2; ++n)
#pragma unroll
                    for (int e = 0; e < 4; ++e) { const int i = 4 * n + e; const float2 cs = rp[i];
                        const float x1 = acc[ai][0][m][n][e] * sc * w1[i], x2 = acc[ai][1][m][n][e] * sc * w2[i];
                        o1[i] = x1 * cs.x - x2 * cs.y; o2[i] = x2 * cs.x + x1 * cs.y; }
                bf16_t* dst = (pn < 4) ? Q + (size_t)row * DATT + (2 * pn + hd) * 128 + 64 * half + 8 * fq : Kb + (size_t)row * DKV + hd * 128 + 64 * half + 8 * fq;
                u32x4 a; a.x = pk2(o1[0], o1[1]); a.y = pk2(o1[2], o1[3]); a.z = pk2(o1[4], o1[5]); a.w = pk2(o1[6], o1[7]);
                u32x4 b; b.x = pk2(o2[0], o2[1]); b.y = pk2(o2[2], o2[3]); b.z = pk2(o2[4], o2[5]); b.w = pk2(o2[6], o2[7]);
                *(u32x4*)dst = a; *(u32x4*)(dst + 32) = b; }
        } else {
            const int lg0 = 4 * (wc >> 1) + 2 * (wc & 1);
            EPI_FOR_ROWS { EPI_ROWDEF const float r = rinv[row];
#pragma unroll
                for (int bj = 0; bj < 2; ++bj) { const int L = 256 * pn + 32 * (lg0 + bj) + 8 * fq;
                    f32x4 v0 = acc[ai][bj][m][0] * r, v1 = acc[ai][bj][m][1] * r; bf16_t* dst;
                    if (pn == 5) dst = Vb + (size_t)row * DKV + (L - 1280);
                    else if (pn < 10) dst = GA + (size_t)row * DATT + (L - 1536);
                    else if (pn < 14) { const int Lu = L - 2560; dst = UCAT + ((size_t)(Lu >> 4) * NCH + (row >> 4)) * 512 + (row & 15) * 16 + (Lu & 15); }
                    else dst = GS + (size_t)row * DSSM + (L - 3584);
                    if ((pn >= 6 && pn < 10) || pn >= 14) {
#pragma unroll
                        for (int e = 0; e < 4; ++e) { v0[e] = siluf_(v0[e]); v1[e] = siluf_(v1[e]); } }
                    u32x4 w; w.x = pk2(v0[0], v0[1]); w.y = pk2(v0[2], v0[3]); w.z = pk2(v1[0], v1[1]); w.w = pk2(v1[2], v1[3]);
                    *(u32x4*)dst = w; } }
        }
    }
};
struct EpiS1 {
    static constexpr bool AFTER_DRAIN = true;
    const float* lb16; bf16_t* UCAT;
    __device__ __forceinline__ void operator()(const f32x4 (&)[2][2][4][2], const Unit&, int, int, int, int) const {}
    __device__ __forceinline__ void fused(const f32x4 (&acc)[2][2][4][2], const Unit& u, int wr, int wc, LAS unsigned char* lds, int wid) const {
        const int l_ = lane_id_opaque(), fr = l_ & 15, fq = l_ >> 4;
        LAS float* Tl = (LAS float*)lds;
#pragma unroll
        for (int d = 0; d < 2; ++d) {
            EPI_FOR_ROWS { const int rit = ai * HALF + wr * 64 + m * 16 + fr; LAS float* rp = Tl + rit * 128 + wc * 32 + 8 * fq;
                *(LAS f32x4*)rp = acc[ai][d][m][0]; *(LAS f32x4*)(rp + 4) = acc[ai][d][m][1]; }
            LDS_WAIT(); __builtin_amdgcn_s_barrier(); asm volatile("" ::: "memory");
            {
                const int p = l_; const float lr = lb16[((u.z * 2 + d) * 64 + p) * 2], li = lb16[((u.z * 2 + d) * 64 + p) * 2 + 1];
                LAS float* SEG = (LAS float*)(lds + XCH_OFF);
                float xr = 0.f, xi = 0.f;
#pragma unroll 8
                for (int i = 0; i < 32; ++i) { const int cc = wid * 32 + i, c = d ? 255 - cc : cc;
                    const float sr = Tl[c * 128 + p], si = Tl[c * 128 + 64 + p];
                    Tl[c * 128 + p] = xr; Tl[c * 128 + 64 + p] = xi;
                    const float nr = lr * xr - li * xi + sr; xi = lr * xi + li * xr + si; xr = nr; }
                SEG[(wid * 64 + p) * 2] = xr; SEG[(wid * 64 + p) * 2 + 1] = xi;
                LDS_WAIT(); __builtin_amdgcn_s_barrier(); asm volatile("" ::: "memory");
                float l32r = lr, l32i = li;
#pragma unroll
                for (int q = 0; q < 5; ++q) { const float t = l32r * l32r - l32i * l32i; l32i = 2.f * l32r * l32i; l32r = t; }
                float er = 0.f, ei = 0.f;
                for (int j = 0; j < wid; ++j) { const float tr = SEG[(j * 64 + p) * 2], ti = SEG[(j * 64 + p) * 2 + 1];
                    const float nr = l32r * er - l32i * ei + tr; ei = l32r * ei + l32i * er + ti; er = nr; }
#pragma unroll 8
                for (int i = 0; i < 32; ++i) { const int cc = wid * 32 + i, c = d ? 255 - cc : cc;
                    const float tr = Tl[c * 128 + p] + er, ti = Tl[c * 128 + 64 + p] + ei;
                    Tl[c * 128 + p] = __uint_as_float(pk2(tr, ti));
                    const float nr = lr * er - li * ei; ei = lr * ei + li * er; er = nr; }
            }
            LDS_WAIT(); __builtin_amdgcn_s_barrier(); asm volatile("" ::: "memory");
            {   bf16_t* ub = UCAT + ((size_t)u.z * NCH + u.pm * 256) * 512 + 256 + d * 128;
#pragma unroll
                for (int i = 0; i < 8; ++i) { const int q = wid * 64 + l_ + 512 * i, r = q >> 4, c8 = (q & 15) * 8;
                    *(u32x4*)(ub + (size_t)r * 512 + c8) = *(const LAS u32x4*)((LAS bf16_t*)(Tl + r * 128) + c8); } }
            LDS_WAIT(); __builtin_amdgcn_s_barrier(); asm volatile("" ::: "memory");
        }
    }
};
struct EpiS2 {
    static constexpr bool AFTER_DRAIN = false;
    bf16_t* YS;
    __device__ __forceinline__ void operator()(const f32x4 (&acc)[2][2][4][2], const Unit& u, int wr, int wc, int, int) const {
        const int l_ = lane_id_opaque(), fr = l_ & 15, fq = l_ >> 4;
        EPI_FOR_ROWS { EPI_ROWDEF
#pragma unroll
            for (int bj = 0; bj < 2; ++bj) { const int c = bj * HALF + wc * 32 + 8 * fq; const int j = c >> 4, h0 = c & 15;
                const f32x4 v0 = acc[ai][bj][m][0], v1 = acc[ai][bj][m][1];
                u32x4 w; w.x = pk2(gelu_tanh(v0[0]), gelu_tanh(v0[1])); w.y = pk2(gelu_tanh(v0[2]), gelu_tanh(v0[3])); w.z = pk2(gelu_tanh(v1[0]), gelu_tanh(v1[1])); w.w = pk2(gelu_tanh(v1[2]), gelu_tanh(v1[3]));
                *(u32x4*)(YS + ((size_t)row * 16 + j) * DSSM + u.z * 16 + h0) = w; } }
    }
};
struct EpiGlu {
    static constexpr bool AFTER_DRAIN = false;
    const float* bglu; const bf16_t* GS; bf16_t* YMIX;
    __device__ __forceinline__ void operator()(const f32x4 (&acc)[2][2][4][2], const Unit& u, int wr, int wc, int, int) const {
        const int l_ = lane_id_opaque(), fr = l_ & 15, fq = l_ >> 4;
        const int a0 = 128 * u.pn + 32 * wc + 8 * fq;
        float bv[8], bg[8];
#pragma unroll
        for (int i = 0; i < 8; ++i) { bv[i] = bglu[a0 + i]; bg[i] = bglu[1024 + a0 + i]; }
        u32x4 gsv[2][4];
        EPI_FOR_ROWS { EPI_ROWDEF gsv[ai][m] = __builtin_nontemporal_load((const u32x4*)(GS + (size_t)row * DSSM + a0)); }
        EPI_FOR_ROWS { EPI_ROWDEF const u32x4 gs = gsv[ai][m];
            float o[8];
#pragma unroll
            for (int n = 0; n < 2; ++n)
#pragma unroll
                for (int e = 0; e < 4; ++e) { const int i = 4 * n + e; o[i] = (acc[ai][0][m][n][e] + bv[i]) * sigmoidf_(acc[ai][1][m][n][e] + bg[i]); }
            o[0] *= bflo(gs.x); o[1] *= bfhi(gs.x); o[2] *= bflo(gs.y); o[3] *= bfhi(gs.y); o[4] *= bflo(gs.z); o[5] *= bfhi(gs.z); o[6] *= bflo(gs.w); o[7] *= bfhi(gs.w);
            u32x4 w; w.x = pk2(o[0], o[1]); w.y = pk2(o[2], o[3]); w.z = pk2(o[4], o[5]); w.w = pk2(o[6], o[7]);
            *(u32x4*)(YMIX + (size_t)row * DM + 1024 + a0) = w; }
    }
};
struct EpiBf {
    static constexpr bool AFTER_DRAIN = false;
    bf16_t* O; int ldc;
    __device__ __forceinline__ void operator()(const f32x4 (&acc)[2][2][4][2], const Unit& u, int wr, int wc, int, int) const {
        const int l_ = lane_id_opaque(), fr = l_ & 15, fq = l_ >> 4;
        EPI_FOR_ROWS { EPI_ROWDEF
#pragma unroll
            for (int bj = 0; bj < 2; ++bj) { const f32x4 v0 = acc[ai][bj][m][0], v1 = acc[ai][bj][m][1];
                u32x4 w; w.x = pk2(v0[0], v0[1]); w.y = pk2(v0[2], v0[3]); w.z = pk2(v1[0], v1[1]); w.w = pk2(v1[2], v1[3]);
                *(u32x4*)(O + (size_t)row * ldc + u.pn * BM + bj * HALF + wc * 32 + 8 * fq) = w; } }
    }
};
struct EpiOut {
    static constexpr bool AFTER_DRAIN = false;
    const float* x; float* H; bf16_t* HB; float* ssq;
    __device__ __forceinline__ void operator()(const f32x4 (&acc)[2][2][4][2], const Unit& u, int wr, int wc, int, int) const {
        const int l_ = lane_id_opaque(), fr = l_ & 15, fq = l_ >> 4;
#pragma unroll
        for (int ai = 0; ai < 2; ++ai) {
            f32x4 xv[4][2][2];
#pragma unroll
            for (int m = 0; m < 4; ++m) { EPI_ROWDEF
#pragma unroll
                for (int bj = 0; bj < 2; ++bj) { const size_t off = (size_t)row * DM + u.pn * BM + bj * HALF + wc * 32 + 8 * fq; xv[m][bj][0] = __builtin_nontemporal_load((const f32x4*)(x + off)); xv[m][bj][1] = __builtin_nontemporal_load((const f32x4*)(x + off + 4)); } }
#pragma unroll
            for (int m = 0; m < 4; ++m) { EPI_ROWDEF float s = 0.f;
#pragma unroll
                for (int bj = 0; bj < 2; ++bj) { const size_t off = (size_t)row * DM + u.pn * BM + bj * HALF + wc * 32 + 8 * fq;
                    const f32x4 v0 = acc[ai][bj][m][0] + xv[m][bj][0], v1 = acc[ai][bj][m][1] + xv[m][bj][1];
                    s += (v0[0] * v0[0] + v0[1] * v0[1]) + (v0[2] * v0[2] + v0[3] * v0[3]) + (v1[0] * v1[0] + v1[1] * v1[1]) + (v1[2] * v1[2] + v1[3] * v1[3]);
                    u32x4 w; w.x = pk2(v0[0], v0[1]); w.y = pk2(v0[2], v0[3]); w.z = pk2(v1[0], v1[1]); w.w = pk2(v1[2], v1[3]);
                    *(u32x4*)(HB + off) = w; }
                s += swz_xor<16>(s); s = sum_xor32(s);
                if (fq == 0) ssq[(size_t)row * 32 + u.pn * 4 + wc] = s; }
        }
    }
};
struct EpiGate {
    static constexpr bool AFTER_DRAIN = true;
    float* H; const bf16_t* PP; float* ssq; unsigned* cnt; const float* nf; const LAS float* r2; const bf16_t* HBr;
    __device__ __forceinline__ void operator()(const f32x4 (&)[2][2][4][2], const Unit&, int, int, int, int) const {}
    __device__ __forceinline__ void fused(f32x4 (&acc)[2][2][4][2], const Unit& u, int wr, int wc, LAS unsigned char* lds, int wid) const {
        const int l_ = lane_id_opaque(), fr = l_ & 15, fq = l_ >> 4, tid = wid * 64 + l_;
        LAS float* P = (LAS float*)lds; LAS float* Rn = P + 1024;
        EPI_FOR_ROWS { EPI_ROWDEF float s = 0.f; const float r = r2[rit];
#pragma unroll
            for (int bj = 0; bj < 2; ++bj) { const size_t off = (size_t)row * DM + u.pn * BM + bj * HALF + wc * 32 + 8 * fq;
                const u32x4 pp = __builtin_nontemporal_load((const u32x4*)(PP + off));
                const u32x4 hb = __builtin_nontemporal_load((const u32x4*)(HBr + off));
                f32x4 h0 = {bflo(hb.x), bfhi(hb.x), bflo(hb.y), bfhi(hb.y)}, h1 = {bflo(hb.z), bfhi(hb.z), bflo(hb.w), bfhi(hb.w)};
                const f32x4 a0 = acc[ai][bj][m][0] * r, a1 = acc[ai][bj][m][1] * r;
                h0[0] += sigmoidf_(a0[0]) * bflo(pp.x); h0[1] += sigmoidf_(a0[1]) * bfhi(pp.x); h0[2] += sigmoidf_(a0[2]) * bflo(pp.y); h0[3] += sigmoidf_(a0[3]) * bfhi(pp.y);
                h1[0] += sigmoidf_(a1[0]) * bflo(pp.z); h1[1] += sigmoidf_(a1[1]) * bfhi(pp.z); h1[2] += sigmoidf_(a1[2]) * bflo(pp.w); h1[3] += sigmoidf_(a1[3]) * bfhi(pp.w);
                acc[ai][bj][m][0] = h0; acc[ai][bj][m][1] = h1;
                s += (h0[0] * h0[0] + h0[1] * h0[1]) + (h0[2] * h0[2] + h0[3] * h0[3]) + (h1[0] * h1[0] + h1[1] * h1[1]) + (h1[2] * h1[2] + h1[3] * h1[3]); }
            s += swz_xor<16>(s); s = sum_xor32(s);
            if (fq == 0) P[rit * 4 + wc] = s; }
        LDS_WAIT(); __builtin_amdgcn_s_barrier(); asm volatile("" ::: "memory");
        if (tid < 256) { const float t = (P[tid * 4] + P[tid * 4 + 1]) + (P[tid * 4 + 2] + P[tid * 4 + 3]);
            __hip_atomic_store(ssq + (size_t)(u.pm * 256 + tid) * 8 + u.pn, t, __ATOMIC_RELAXED, __HIP_MEMORY_SCOPE_AGENT); }
        asm volatile("s_waitcnt vmcnt(0)" ::: "memory");
        if (wid < 4 && l_ == 0) __hip_atomic_fetch_add(cnt + 64 * u.pm, 1u, __ATOMIC_RELAXED, __HIP_MEMORY_SCOPE_AGENT);
        if (wid == 0) {
            unsigned sp = 0;
            while ((unsigned)__builtin_amdgcn_readfirstlane(__hip_atomic_load(cnt + 64 * u.pm, __ATOMIC_RELAXED, __HIP_MEMORY_SCOPE_AGENT)) < 32u) { __builtin_amdgcn_s_sleep(2); if (++sp > (1u << 22)) break; }
            __builtin_amdgcn_fence(__ATOMIC_ACQUIRE, "agent");
        }
        asm volatile("s_waitcnt vmcnt(0) lgkmcnt(0)" ::: "memory"); __builtin_amdgcn_s_barrier(); asm volatile("" ::: "memory");
        if (tid < 256) { const float* sp = ssq + (size_t)(u.pm * 256 + tid) * 8; float t = 0.f;
#pragma unroll
            for (int i = 0; i < 8; ++i) t += __hip_atomic_load(sp + i, __ATOMIC_RELAXED, __HIP_MEMORY_SCOPE_AGENT);
            Rn[tid] = rsqrtf(t * (1.f / DM) + EPS); }
        LDS_WAIT(); __builtin_amdgcn_s_barrier(); asm volatile("" ::: "memory");
        EPI_FOR_ROWS { EPI_ROWDEF const float rn = Rn[rit];
#pragma unroll
            for (int bj = 0; bj < 2; ++bj) { const int col = u.pn * BM + bj * HALF + wc * 32 + 8 * fq; const size_t off = (size_t)row * DM + col;
                *(f32x4*)(H + off) = acc[ai][bj][m][0] * rn * *(const f32x4*)(nf + col); *(f32x4*)(H + off + 4) = acc[ai][bj][m][1] * rn * *(const f32x4*)(nf + col + 4); } }
    }
};
}

namespace att {
constexpr int D = 128, NW = 8, QBLK = 32, KVBLK = 64;
constexpr float SCALE = 0.088388347648318440f;
constexpr float THR = 8.f;
constexpr int LDQ = DATT, LDK = DKV;
constexpr size_t SHM_V = KVBLK * D * 2, SHM_K = KVBLK * D * 2, SHM_ATTN = 2 * SHM_V + 2 * SHM_K + NW * 64 * 4;
#define KSWZ(row, colB) ((row) * 256 + ((colB) ^ (((row) & 7) << 4)))
#define SBAR() __builtin_amdgcn_sched_barrier(0)
__device__ __forceinline__ int crow(int r, int hi) { return (r & 3) + 8 * (r >> 2) + 4 * hi; }
__device__ __forceinline__ void partialSM(f32x16& p0, f32x16& p1, float& m_reg, float& mn, float& alpha) {
  constexpr float C = SCALE * 1.4426950408889634f;
  float pmax = p0[0]; for (int r = 1; r < 16; ++r) pmax = fmaxf(pmax, p0[r]); for (int r = 0; r < 16; ++r) pmax = fmaxf(pmax, p1[r]);
  { auto rr = __builtin_amdgcn_permlane32_swap(__float_as_uint(pmax), __float_as_uint(pmax), false, false);
    pmax = fmaxf(__uint_as_float(rr[0]), __uint_as_float(rr[1])); }
  if (__builtin_expect(__all(pmax - m_reg <= THR / SCALE), 1)) { mn = m_reg; alpha = 1.f; }
  else { mn = fmaxf(m_reg, pmax); alpha = __builtin_amdgcn_exp2f((m_reg - mn) * C); m_reg = mn; }
  float mnC = -mn * C;
  for (int r = 0; r < 16; ++r) p0[r] = fmaf(p0[r], C, mnC); for (int r = 0; r < 16; ++r) p1[r] = fmaf(p1[r], C, mnC);
  for (int r = 0; r < 16; ++r) p0[r] = __builtin_amdgcn_exp2f(p0[r]);
}
__device__ __forceinline__ void finishSM(f32x16& p0, f32x16& p1, float alpha, float& l_reg, bf16x8& pa0, bf16x8& pa1, bf16x8& pa2, bf16x8& pa3) {
  for (int r = 0; r < 16; ++r) p1[r] = __builtin_amdgcn_exp2f(p1[r]);
  float ps = 0; for (int r = 0; r < 16; ++r) ps += p0[r]; for (int r = 0; r < 16; ++r) ps += p1[r];
  { auto rr = __builtin_amdgcn_permlane32_swap(__float_as_uint(ps), __float_as_uint(ps), false, false);
    ps = __uint_as_float(rr[0]) + __uint_as_float(rr[1]); }
  l_reg = l_reg * alpha + ps;
#define PK4(P, BASE, OUT) do { unsigned a0 = cvt_pk_bf16(P[BASE + 0], P[BASE + 1]), a1 = cvt_pk_bf16(P[BASE + 2], P[BASE + 3]);   \
    unsigned b0 = cvt_pk_bf16(P[BASE + 4], P[BASE + 5]), b1 = cvt_pk_bf16(P[BASE + 6], P[BASE + 7]);                              \
    auto r0 = __builtin_amdgcn_permlane32_swap(a0, b0, false, false); auto r1 = __builtin_amdgcn_permlane32_swap(a1, b1, false, false); \
    u32x4 w = {r0[0], r1[0], r0[1], r1[1]}; OUT = *reinterpret_cast<bf16x8*>(&w); } while (0)
  PK4(p0, 0, pa0); PK4(p0, 8, pa1); PK4(p1, 0, pa2); PK4(p1, 8, pa3);
#undef PK4
}
__device__ __forceinline__ void qkt(f32x16& p0, f32x16& p1, const bf16_t* Ks, const bf16x8* qr, int r32, int hi) {
  p0 = f32x16{}; p1 = f32x16{};
  for (int d0 = 0; d0 < 8; ++d0) { int cb = (d0 * 16 + hi * 8) * 2;
    bf16x8 b0 = *reinterpret_cast<const bf16x8*>((const char*)Ks + KSWZ(r32, cb));
    bf16x8 b1 = *reinterpret_cast<const bf16x8*>((const char*)Ks + KSWZ(32 + r32, cb));
    p0 = __builtin_amdgcn_mfma_f32_32x32x16_bf16(b0, qr[d0], p0, 0, 0, 0);
    p1 = __builtin_amdgcn_mfma_f32_32x32x16_bf16(b1, qr[d0], p1, 0, 0, 0); }
}
__device__ __forceinline__ int v_st(int k, int c) { const int kk = (k & ~0xC) | ((k & 4) << 1) | ((k & 8) >> 1); return ((kk >> 3) * 4 + (c >> 5)) * 512 + ((kk & 7) * 32 + (c & 31)) * 2; }
__device__ __forceinline__ int v_rd_base(int lane) { return ((lane & 3) << 3) | (((lane >> 2) & 3) << 6) | (((lane >> 4) & 1) << 5) | (((lane >> 5) & 1) << 8); }
constexpr int v_rd_off(int d0, int ks, int half) { return d0 * 512 + ks * 4096 + half * 2048; }
template <int OFF> __device__ __forceinline__ s16x4 tr_read(int vb) {
  s16x4 r; asm volatile("ds_read_b64_tr_b16 %0, %1 offset:%2" : "=&v"(r) : "v"(vb), "i"(OFF) : "memory"); return r;
}
template <int D0> __device__ __forceinline__ void pv_one(f32x16& od, int vb, bf16x8 pa0, bf16x8 pa1, bf16x8 pa2, bf16x8 pa3) {
  const s16x4 l0 = tr_read<v_rd_off(D0, 0, 0)>(vb), h0 = tr_read<v_rd_off(D0, 0, 1)>(vb), l1 = tr_read<v_rd_off(D0, 1, 0)>(vb), h1 = tr_read<v_rd_off(D0, 1, 1)>(vb);
  const s16x4 l2 = tr_read<v_rd_off(D0, 2, 0)>(vb), h2 = tr_read<v_rd_off(D0, 2, 1)>(vb), l3 = tr_read<v_rd_off(D0, 3, 0)>(vb), h3 = tr_read<v_rd_off(D0, 3, 1)>(vb);
  asm volatile("s_waitcnt lgkmcnt(0)" ::: "memory"); SBAR();
#define PK(L, H) (bf16x8){L[0], L[1], L[2], L[3], H[0], H[1], H[2], H[3]}
  od = __builtin_amdgcn_mfma_f32_32x32x16_bf16(pa0, PK(l0, h0), od, 0, 0, 0);
  od = __builtin_amdgcn_mfma_f32_32x32x16_bf16(pa1, PK(l1, h1), od, 0, 0, 0);
  od = __builtin_amdgcn_mfma_f32_32x32x16_bf16(pa2, PK(l2, h2), od, 0, 0, 0);
  od = __builtin_amdgcn_mfma_f32_32x32x16_bf16(pa3, PK(l3, h3), od, 0, 0, 0);
#undef PK
}
__device__ __forceinline__ void pv_d0(f32x16* o, int vb, bf16x8 pa0, bf16x8 pa1, bf16x8 pa2, bf16x8 pa3) {
  pv_one<0>(o[0], vb, pa0, pa1, pa2, pa3); pv_one<1>(o[1], vb, pa0, pa1, pa2, pa3); pv_one<2>(o[2], vb, pa0, pa1, pa2, pa3); pv_one<3>(o[3], vb, pa0, pa1, pa2, pa3);
}
__device__ __forceinline__ void attn_dense_body(const bf16_t* __restrict__ Qb, const bf16_t* __restrict__ Kh, const bf16_t* __restrict__ Vh,
                                                const bf16_t* __restrict__ Gb, bf16_t* __restrict__ Yb, int seq, char* lds, const int wid) {
  const int lane = lane_id_opaque(), tid = wid * 64 + lane, r32 = lane & 31, hi = lane >> 5;
  bf16_t* V_lds = (bf16_t*)lds; bf16_t* K_lds = (bf16_t*)(lds + 2 * SHM_V);
  float* ws = (float*)(lds + 2 * SHM_V + 2 * SHM_K) + wid * 64; float* li_l = ws; float* al_l = ws + 32;
  float m_reg = -1e30f, l_reg = 0; f32x16 o[4] = {}; bf16x8 qr[8];
  const bf16_t* Qw = Qb + (long)(wid * QBLK + r32) * LDQ + hi * 8;
#pragma unroll
  for (int d0 = 0; d0 < 8; ++d0) qr[d0] = __builtin_nontemporal_load(reinterpret_cast<const bf16x8*>(Qw + d0 * 16));
  const int sr = tid >> 4, sc = (tid & 15) * 8, vst0 = v_st(sr, sc), vst1 = v_st(32 + sr, sc);
  const int vb0 = (int)(uintptr_t)V_lds + v_rd_base(lane);
  struct { bf16x8 vs0, vs1, ks0, ks1; } sr_[2];
#define SLOAD(i, k0) do { sr_[i].vs0 = *reinterpret_cast<const bf16x8*>(&Vh[(long)((k0) + sr) * LDK + sc]); sr_[i].vs1 = *reinterpret_cast<const bf16x8*>(&Vh[(long)((k0) + 32 + sr) * LDK + sc]); \
    sr_[i].ks0 = *reinterpret_cast<const bf16x8*>(&Kh[(long)((k0) + sr) * LDK + sc]); sr_[i].ks1 = *reinterpret_cast<const bf16x8*>(&Kh[(long)((k0) + 32 + sr) * LDK + sc]); } while (0)
#define SWRITE(b, i) do { *(bf16x8*)((char*)V_lds + (b) * SHM_V + vst0) = sr_[i].vs0;          \
    *(bf16x8*)((char*)V_lds + (b) * SHM_V + vst1) = sr_[i].vs1; int kc = sc * 2;               \
    *(bf16x8*)((char*)K_lds + (b) * SHM_K + KSWZ(sr, kc)) = sr_[i].ks0;                       \
    *(bf16x8*)((char*)K_lds + (b) * SHM_K + KSWZ(32 + sr, kc)) = sr_[i].ks1; } while (0)
#define SWAIT() asm volatile("s_waitcnt vmcnt(4)" ::: "memory")
#define RESC(a) do { if (__any((a) < 1.f)) { if (hi == 0) al_l[r32] = (a); asm volatile("s_waitcnt lgkmcnt(0)" ::: "memory"); \
    for (int d = 0; d < 4; ++d) for (int r = 0; r < 16; ++r) o[d][r] *= al_l[crow(r, hi)]; } } while (0)
  f32x16 pA0, pA1, pB0, pB1; float mnA, mnB, alA, alB; bf16x8 pa0, pa1, pa2, pa3; const int NT = seq / KVBLK;
  constexpr int SE = 0, SO = 1;
  SLOAD(SE, 0); asm volatile("s_waitcnt vmcnt(0)" ::: "memory"); SWRITE(0, SE); __syncthreads();
  qkt(pA0, pA1, K_lds, qr, r32, hi); partialSM(pA0, pA1, m_reg, mnA, alA);
  SLOAD(SO, KVBLK); if (2 < NT) SLOAD(SE, 2 * KVBLK);
  SWAIT(); SWRITE(1, SO); __syncthreads();
  for (int j = 1; j + 1 < NT; j += 2) {
    SBAR(); qkt(pB0, pB1, (bf16_t*)((char*)K_lds + SHM_K), qr, r32, hi);
    finishSM(pA0, pA1, alA, l_reg, pa0, pa1, pa2, pa3); SBAR();
    SLOAD(SO, (j + 2) * KVBLK); SBAR();
    pv_d0(o, vb0, pa0, pa1, pa2, pa3); partialSM(pB0, pB1, m_reg, mnB, alB);
    __syncthreads(); SWAIT(); SWRITE(0, SE);
    RESC(alB); __syncthreads();
    SBAR(); qkt(pA0, pA1, K_lds, qr, r32, hi);
    finishSM(pB0, pB1, alB, l_reg, pa0, pa1, pa2, pa3); SBAR();
    if (j + 3 < NT) SLOAD(SE, (j + 3) * KVBLK); SBAR();
    pv_d0(o, vb0 + (int)SHM_V, pa0, pa1, pa2, pa3); partialSM(pA0, pA1, m_reg, mnA, alA);
    __syncthreads(); SWAIT(); SWRITE(1, SO);
    RESC(alA); __syncthreads();
  }
  SBAR(); qkt(pB0, pB1, (bf16_t*)((char*)K_lds + SHM_K), qr, r32, hi);
  finishSM(pA0, pA1, alA, l_reg, pa0, pa1, pa2, pa3); SBAR();
  pv_d0(o, vb0, pa0, pa1, pa2, pa3); partialSM(pB0, pB1, m_reg, mnB, alB);
  __syncthreads(); RESC(alB);
  finishSM(pB0, pB1, alB, l_reg, pa0, pa1, pa2, pa3); SBAR();
  pv_d0(o, vb0 + (int)SHM_V, pa0, pa1, pa2, pa3);
  if (hi == 0) li_l[r32] = l_reg; asm volatile("s_waitcnt lgkmcnt(0)" ::: "memory");
  float rli[16];
#pragma unroll
  for (int r = 0; r < 16; ++r) rli[r] = __builtin_amdgcn_rcpf(li_l[crow(r, hi)]);
  bf16_t* Yw = Yb + (long)(wid * QBLK) * DM; const bf16_t* Gw = Gb + (long)(wid * QBLK) * DATT;
  __syncthreads();
  bf16_t* stg = (bf16_t*)(lds + wid * 8192);
#pragma unroll
  for (int r = 0; r < 16; ++r) { const int orow = crow(r, hi);
#pragma unroll
    for (int d0 = 0; d0 < 4; ++d0) stg[orow * 128 + d0 * 32 + r32] = (bf16_t)f2bf(o[d0][r] * rli[r]); }
  asm volatile("s_waitcnt lgkmcnt(0)" ::: "memory");
  const int l2 = lane_id_opaque();
#pragma unroll
  for (int i = 0; i < 8; ++i) { const int q = l2 + 64 * i, row = q >> 4, c8 = (q & 15) * 8;
    const u32x4 v = *(const u32x4*)(stg + row * 128 + c8); const u32x4 gg = __builtin_nontemporal_load((const u32x4*)(Gw + (unsigned)(row * DATT + c8)));
    u32x4 w; w.x = pk2(bflo(v.x) * bflo(gg.x), bfhi(v.x) * bfhi(gg.x)); w.y = pk2(bflo(v.y) * bflo(gg.y), bfhi(v.y) * bfhi(gg.y));
    w.z = pk2(bflo(v.z) * bflo(gg.z), bfhi(v.z) * bfhi(gg.z)); w.w = pk2(bflo(v.w) * bflo(gg.w), bfhi(v.w) * bfhi(gg.w));
    *(u32x4*)(Yw + (unsigned)(row * DM + c8)) = w; }
  __syncthreads();
#undef SLOAD
#undef SWRITE
#undef SWAIT
#undef RESC
}
#undef SBAR
}

__device__ __forceinline__ void p0_transpose_item(const float* W, int K, int N, bf16_t* WT, int wt_row0, const float* kscale, LAS float* scr, int k0, int n0, int lane) {
#pragma unroll
    for (int i = 0; i < 32; ++i) { const int kk = 2 * i + (lane >> 5); float v = W[(size_t)(k0 + kk) * N + n0 + (lane & 31)]; if (kscale) v *= kscale[k0 + kk]; scr[kk * 33 + (lane & 31)] = v; }
    LDS_WAIT(); asm volatile("" ::: "memory");
    const int c = lane & 7;
#pragma unroll
    for (int j = 0; j < 4; ++j) { const int n = (lane >> 3) + 8 * j; const LAS float* s = scr + (8 * c) * 33 + n;
        u32x4 o; o.x = pk2(s[0 * 33], s[1 * 33]); o.y = pk2(s[2 * 33], s[3 * 33]); o.z = pk2(s[4 * 33], s[5 * 33]); o.w = pk2(s[6 * 33], s[7 * 33]);
        *(u32x4*)(WT + (size_t)(wt_row0 + n) * K + k0 + 8 * c) = o; }
    LDS_WAIT(); asm volatile("" ::: "memory");
}

struct TrItem { const float* W; bf16_t* WT; const float* kscale; int K, N, wt_row0, k0, n0; };
__device__ __forceinline__ void p0_tr_load(const TrItem& d, float (&v)[32], int lane) {
#pragma unroll
    for (int i = 0; i < 32; ++i) { const int kk = 2 * i + (lane >> 5); v[i] = __builtin_nontemporal_load(d.W + (size_t)(d.k0 + kk) * d.N + d.n0 + (lane & 31)); }
    if (d.kscale) {
#pragma unroll
        for (int i = 0; i < 32; ++i) { const int kk = 2 * i + (lane >> 5); v[i] *= d.kscale[d.k0 + kk]; } }
}
__device__ __forceinline__ void p0_tr_store(const TrItem& d, const float (&v)[32], LAS float* scr, int lane) {
#pragma unroll
    for (int i = 0; i < 32; ++i) { const int kk = 2 * i + (lane >> 5); scr[kk * 33 + (lane & 31)] = v[i]; }
    LDS_WAIT(); asm volatile("" ::: "memory");
    const int c = lane & 7;
#pragma unroll
    for (int j = 0; j < 4; ++j) { const int n = (lane >> 3) + 8 * j; const LAS float* s = scr + (8 * c) * 33 + n;
        u32x4 o; o.x = pk2(s[0 * 33], s[1 * 33]); o.y = pk2(s[2 * 33], s[3 * 33]); o.z = pk2(s[4 * 33], s[5 * 33]); o.w = pk2(s[6 * 33], s[7 * 33]);
        *(u32x4*)(d.WT + (size_t)(d.wt_row0 + n) * d.K + d.k0 + 8 * c) = o; }
    LDS_WAIT(); asm volatile("" ::: "memory");
}
__device__ __forceinline__ void ssm_tables(const Args& a, int g, LAS unsigned char* lds, int tid) {
    LAS float* LD = (LAS float*)lds;
    LAS float* LBs = LD + 256;
    LAS float* BB = LBs + 256;
    LAS float* KT = BB + 4096;
    LAS float* CC = KT + 8192;
    float* lb16 = (float*)(a.ws + WS_LB16);
    bf16_t* WIN = (bf16_t*)(a.ws + WS_WIN) + (size_t)g * 256 * 256;
    bf16_t* WBIG = (bf16_t*)(a.ws + WS_WBIG) + (size_t)g * 256 * 512;
    for (int e = tid; e < 2048; e += 512) { const int d = e >> 10, r = e & 1023; const size_t ci_ = (size_t)(d * NG + g) * 1024 + r; CC[e * 2] = a.c_re[ci_]; CC[e * 2 + 1] = a.c_im[ci_]; }
    if (tid < 128) {
        const int d = tid >> 6, p = tid & 63; const int idx = (d * NG + g) * 64 + p;
        const float lr = fminf(a.a_re[idx], -1e-4f), li = a.a_im[idx];
        const float dt = expf(a.log_dt[d * NG + g]);
        const float er = expf(lr * dt); float sn, cs; sincosf(li * dt, &sn, &cs);
        const float br = er * cs, bi = er * sn;
        LD[tid * 2] = lr * dt; LD[tid * 2 + 1] = li * dt; LBs[tid * 2] = br; LBs[tid * 2 + 1] = bi;
        const float nr = br - 1.f, ni = bi, den = lr * lr + li * li;
        KT[tid * 2] = (nr * lr + ni * li) / den; KT[tid * 2 + 1] = (ni * lr - nr * li) / den;
        const float e16 = expf(16.f * lr * dt); float s16, c16; sincosf(16.f * li * dt, &s16, &c16);
        lb16[(g * 128 + tid) * 2] = e16 * c16; lb16[(g * 128 + tid) * 2 + 1] = e16 * s16;
    }
    __syncthreads();
    for (int e = tid; e < 2048; e += 512) {
        const int dp = e >> 4, h = e & 15, d = dp >> 6, p = dp & 63;
        const size_t bi_ = ((size_t)(d * NG + g) * 64 + p) * 16 + h;
        const float xr = a.b_re[bi_], xi = a.b_im[bi_], cr = KT[dp * 2], ci = KT[dp * 2 + 1];
        BB[e * 2] = cr * xr - ci * xi; BB[e * 2 + 1] = cr * xi + ci * xr;
    }
    __syncthreads();
    {
        const int d = tid >> 8, hp = (tid >> 4) & 15, h = tid & 15; float acc[16];
#pragma unroll
        for (int t = 0; t < 16; ++t) acc[t] = 0.f;
        const LAS float* cc = CC + ((d * 16 + hp) * 64) * 2;
        for (int p = 0; p < 64; ++p) {
            const float c_r = cc[p * 2], c_i = cc[p * 2 + 1], b_r = BB[((d * 64 + p) * 16 + h) * 2], b_i = BB[((d * 64 + p) * 16 + h) * 2 + 1];
            float wr = c_r * b_r - c_i * b_i, wi = c_r * b_i + c_i * b_r; const float l_r = LBs[(d * 64 + p) * 2], l_i = LBs[(d * 64 + p) * 2 + 1];
#pragma unroll
            for (int t = 0; t < 16; ++t) { acc[t] += wr; const float nr = wr * l_r - wi * l_i; wi = wr * l_i + wi * l_r; wr = nr; }
        }
#pragma unroll
        for (int t = 0; t < 16; ++t) KT[((d * 16 + t) * 16 + hp) * 16 + h] = acc[t];
    }
    __syncthreads();
    for (int q = tid; q < 8192; q += 512) {
        const int n = q >> 5, kc = q & 31, s = kc >> 1, h0 = (kc & 1) * 8, j = n >> 4, hp = n & 15;
        const int dsel = s < j ? 0 : 1, tau = s < j ? j - s : s - j;
        const LAS float* k0 = KT + ((dsel * 16 + tau) * 16 + hp) * 16 + h0;
        const LAS float* kf = KT + ((0 * 16 + 0) * 16 + hp) * 16 + h0; const LAS float* kb = KT + ((1 * 16 + 0) * 16 + hp) * 16 + h0;
        const bool diag = (s == j); const float dval = a.ssm_d[g * 16 + hp];
        float v[8];
#pragma unroll
        for (int e = 0; e < 8; ++e) { const float off = k0[e], dg = kf[e] + kb[e] + ((h0 + e) == hp ? dval : 0.f); v[e] = diag ? dg : off; }
        u32x4 w; w.x = pk2(v[0], v[1]); w.y = pk2(v[2], v[3]); w.z = pk2(v[4], v[5]); w.w = pk2(v[6], v[7]);
        *(u32x4*)(WBIG + (size_t)n * 512 + s * 16 + h0) = w;
    }
    for (int q = tid; q < 2048; q += 512) {
        const int p = q & 63, js = (q >> 6) & 15, d = q >> 10; const float ldr = LD[(d * 64 + p) * 2], ldi = LD[(d * 64 + p) * 2 + 1];
        {   const float pw = (float)(d == 0 ? js + 1 : 16 - js); const float er = expf(pw * ldr); float sn, cs; sincosf(pw * ldi, &sn, &cs); const float pr = er * cs, pi = er * sn;
#pragma unroll
            for (int hp = 0; hp < 16; ++hp) { const float c_r = CC[((d * 16 + hp) * 64 + p) * 2], c_i = CC[((d * 16 + hp) * 64 + p) * 2 + 1];
                *(unsigned*)(WBIG + (size_t)(js * 16 + hp) * 512 + 256 + d * 128 + 2 * p) = pk2(c_r * pr - c_i * pi, -(c_r * pi + c_i * pr)); } }
        {   const float pw = (float)(d == 0 ? 15 - js : js); const float er = expf(pw * ldr); float sn, cs; sincosf(pw * ldi, &sn, &cs); const float pr = er * cs, pi = er * sn;
            float zr[16], zi[16];
#pragma unroll
            for (int h = 0; h < 16; ++h) { const float b_r = BB[((d * 64 + p) * 16 + h) * 2], b_i = BB[((d * 64 + p) * 16 + h) * 2 + 1]; zr[h] = pr * b_r - pi * b_i; zi[h] = pr * b_i + pi * b_r; }
            bf16_t* d0 = WIN + (size_t)(d * 128 + p) * 256 + js * 16; bf16_t* d1 = d0 + (size_t)64 * 256;
            u32x4 w; w.x = pk2(zr[0], zr[1]); w.y = pk2(zr[2], zr[3]); w.z = pk2(zr[4], zr[5]); w.w = pk2(zr[6], zr[7]); *(u32x4*)d0 = w;
            w.x = pk2(zr[8], zr[9]); w.y = pk2(zr[10], zr[11]); w.z = pk2(zr[12], zr[13]); w.w = pk2(zr[14], zr[15]); *(u32x4*)(d0 + 8) = w;
            w.x = pk2(zi[0], zi[1]); w.y = pk2(zi[2], zi[3]); w.z = pk2(zi[4], zi[5]); w.w = pk2(zi[6], zi[7]); *(u32x4*)d1 = w;
            w.x = pk2(zi[8], zi[9]); w.y = pk2(zi[10], zi[11]); w.z = pk2(zi[12], zi[13]); w.w = pk2(zi[14], zi[15]); *(u32x4*)(d1 + 8) = w; }
    }
    __syncthreads();
}

#define XB_TMO      128
#define XB_XCNT(j)  (256  + 64 * (j))
#define XB_XSUB(j)  (1280 + 64 * (j))
#define XB_XGEN(j)  (2304 + 64 * (j))
#define XB_TOP      3328
#define XB_TOPGEN   3392
#define XCD_BAR_WORDS 3456
#define XB_SPIN_CAP (1u << 18)
__device__ __forceinline__ unsigned xb_ld(unsigned* p)              { return __hip_atomic_load(p, __ATOMIC_RELAXED, __HIP_MEMORY_SCOPE_AGENT); }
__device__ __forceinline__ unsigned xb_add(unsigned* p, unsigned v) { return __hip_atomic_fetch_add(p, v, __ATOMIC_RELAXED, __HIP_MEMORY_SCOPE_AGENT); }
__device__ __forceinline__ unsigned xb_xcc_id() { return (unsigned)__builtin_amdgcn_s_getreg((3 << 11) | 20) & 0xFu; }
#define XB_SPIN(cond, bar) do { unsigned _sp = 0; while (cond) { __builtin_amdgcn_s_sleep(1); \
    if ((++_sp & 255u) == 0u) { if (xb_ld(&(bar)[XB_TMO])) break; if (_sp > XB_SPIN_CAP) { atomicAdd(&(bar)[XB_TMO], 1u); break; } } } } while (0)
struct XcdBarrier { unsigned* bar; unsigned x; volatile LAS unsigned* st; };
__device__ __forceinline__ XcdBarrier xcd_barrier_post(unsigned* bar, volatile LAS unsigned* st, bool leader) {
    XcdBarrier b; b.bar = bar; b.x = xb_xcc_id(); b.st = st;
    if (leader) (void)xb_add(&bar[XB_XCNT(b.x)], 1u);
    return b;
}
__device__ __forceinline__ void xcd_barrier_complete(unsigned* bar, unsigned x, unsigned& nloc, unsigned& nx) {
    const unsigned G = gridDim.x * gridDim.y * gridDim.z;
    unsigned sum, cnt, mine, sp = 0u;
    for (;;) {
        sum = 0u; cnt = 0u; mine = 0u;
#pragma unroll
        for (unsigned j = 0; j < 16; ++j) { const unsigned c = xb_ld(&bar[XB_XCNT(j)]); sum += c; cnt += (c > 0u) ? 1u : 0u; mine = (j == x) ? c : mine; }
        if (sum == G) break;
        __builtin_amdgcn_s_sleep(1);
        if ((++sp & 255u) == 0u) { if (xb_ld(&bar[XB_TMO])) break; if (sp > XB_SPIN_CAP) { atomicAdd(&bar[XB_TMO], 1u); break; } }
    }
    nloc = mine > 0u ? mine : 1u; nx = cnt > 0u ? cnt : 1u;
}
__device__ __forceinline__ void xcd_barrier(const XcdBarrier& b, bool leader) {
    asm volatile("s_waitcnt vmcnt(0)" ::: "memory");
    __syncthreads();
    if (leader) {
        unsigned* bar = b.bar;
        __builtin_amdgcn_s_waitcnt(0);
        unsigned nloc = b.st[0], nx = b.st[1];
        if (nloc == 0u) { xcd_barrier_complete(bar, b.x, nloc, nx); b.st[0] = nloc; b.st[1] = nx; }
        const unsigned old = xb_add(&bar[XB_XSUB(b.x)], 1u);
        const unsigned gen = old / nloc;
        if (old + 1u == (gen + 1u) * nloc) {
            __builtin_amdgcn_fence(__ATOMIC_RELEASE, "agent");
            asm volatile("s_waitcnt vmcnt(0)" ::: "memory");
            const unsigned og = xb_add(&bar[XB_TOP], 1u);
            const unsigned tg = og / nx;
            if (og + 1u == (tg + 1u) * nx) xb_add(&bar[XB_TOPGEN], 1u);
            else XB_SPIN(xb_ld(&bar[XB_TOPGEN]) == tg, bar);
            __builtin_amdgcn_fence(__ATOMIC_ACQUIRE, "agent");
            xb_add(&bar[XB_XGEN(b.x)], 1u);
            asm volatile("s_waitcnt vmcnt(0)" ::: "memory");
        } else {
            XB_SPIN(xb_ld(&bar[XB_XGEN(b.x)]) == gen, bar);
            __builtin_amdgcn_fence(__ATOMIC_ACQUIRE, "agent");
            asm volatile("s_waitcnt vmcnt(0)" ::: "memory");
        }
    }
    __syncthreads();
}

__device__ __forceinline__ void xcd_barrier_arrive(const XcdBarrier& b, bool leader) {
    asm volatile("s_waitcnt vmcnt(0)" ::: "memory");
    __syncthreads();
    if (leader) {
        unsigned* bar = b.bar;
        __builtin_amdgcn_s_waitcnt(0);
        unsigned nloc = b.st[0], nx = b.st[1];
        if (nloc == 0u) { xcd_barrier_complete(bar, b.x, nloc, nx); b.st[0] = nloc; b.st[1] = nx; }
        const unsigned old = xb_add(&bar[XB_XSUB(b.x)], 1u);
        const unsigned gen = old / nloc;
        if (old + 1u == (gen + 1u) * nloc) {
            __builtin_amdgcn_fence(__ATOMIC_RELEASE, "agent");
            asm volatile("s_waitcnt vmcnt(0)" ::: "memory");
            const unsigned og = xb_add(&bar[XB_TOP], 1u);
            const unsigned tg = og / nx;
            if (og + 1u == (tg + 1u) * nx) { xb_add(&bar[XB_TOPGEN], 1u); b.st[5] = 3u; } else b.st[5] = 2u;
            b.st[6] = tg;
        } else { b.st[5] = 1u; b.st[6] = gen; }
    }
}
__device__ __forceinline__ void xcd_barrier_wait(const XcdBarrier& b, bool leader) {
    if (leader) {
        unsigned* bar = b.bar; const unsigned role = b.st[5], g = b.st[6];
        if (role >= 2u) {
            if (role == 2u) XB_SPIN(xb_ld(&bar[XB_TOPGEN]) == g, bar);
            __builtin_amdgcn_fence(__ATOMIC_ACQUIRE, "agent");
            xb_add(&bar[XB_XGEN(b.x)], 1u);
            asm volatile("s_waitcnt vmcnt(0)" ::: "memory");
        } else {
            XB_SPIN(xb_ld(&bar[XB_XGEN(b.x)]) == g, bar);
            __builtin_amdgcn_fence(__ATOMIC_ACQUIRE, "agent");
            asm volatile("s_waitcnt vmcnt(0)" ::: "memory");
        }
    }
    __syncthreads();
}

__global__ void __launch_bounds__(512, 2) fwd_kernel(Args a) {
    extern __shared__ __attribute__((aligned(16))) unsigned char lds_raw[];
    LAS unsigned char* lds = (LAS unsigned char*)lds_raw;
    cg::grid_group grid = cg::this_grid();
    const int wave = __builtin_amdgcn_readfirstlane(threadIdx.x >> 6);
    const bool leader = (wave == 0) && (lane_id_opaque() == 0);
    volatile LAS unsigned* xst = (volatile LAS unsigned*)(lds + XBST_OFF);
    if (leader) { xst[0] = 0u; xst[1] = 0u; }
    __syncthreads();
    if (a.ws == nullptr) grid.sync();
    const XcdBarrier xbar = xcd_barrier_post((unsigned*)(a.ws + WS_BAR), xst, leader);
#define GRID_SYNC() xcd_barrier(xbar, (wave == 0) && (lane_id_opaque() == 0))
#define LANE_IDS const int lane = lane_id_opaque(), tid = wave * 64 + lane; (void)tid;
    const int G = gridDim.x, bid = blockIdx.x;
    unsigned char* ws = a.ws;
    bf16_t* W1T = (bf16_t*)(ws + WS_W1T); bf16_t* WGLUT = (bf16_t*)(ws + WS_WGLUT); bf16_t* WOT = (bf16_t*)(ws + WS_WOT); bf16_t* WGT = (bf16_t*)(ws + WS_WGT); bf16_t* WPT = (bf16_t*)(ws + WS_WPT);
    float2* ROPE = (float2*)(ws + WS_ROPE); float* RINV = (float*)(ws + WS_RINV); float* LB16 = (float*)(ws + WS_LB16); float* SSQ1 = (float*)(ws + WS_SSQ1); float* SSQ2 = (float*)(ws + WS_SSQ2);
    bf16_t* PB = (bf16_t*)(ws + WS_PB); bf16_t* WIN = (bf16_t*)(ws + WS_WIN); bf16_t* WBIG = (bf16_t*)(ws + WS_WBIG);
    bf16_t* XB = (bf16_t*)(ws + WS_XB); bf16_t* HB = (bf16_t*)(ws + WS_XB);
    bf16_t* Q = (bf16_t*)(ws + WS_Q); bf16_t* KB = (bf16_t*)(ws + WS_K); bf16_t* VB = (bf16_t*)(ws + WS_V); bf16_t* GA = (bf16_t*)(ws + WS_GA); bf16_t* GS = (bf16_t*)(ws + WS_GS);
    bf16_t* UCAT = (bf16_t*)(ws + WS_UCAT); bf16_t* PPB = (bf16_t*)(ws + WS_UCAT); bf16_t* YMIX = (bf16_t*)(ws + WS_YMIX); bf16_t* YS = (bf16_t*)(ws + WS_YS);

#pragma unroll
    for (int rep_ = 0; rep_ < 1 + ((REP_MASK >> 0) & 1); ++rep_) { LANE_IDS
        const int gw = bid * 8 + wave, NGW = G * 8;
        LAS float* scr = (LAS float*)(lds + wave * 16384);
        constexpr int I1 = 32 * 144, I2 = 16 * 64, I3 = 32 * 64, I4 = 32 * 64, I5 = 4 * 64, NIT = I1 + I2 + I3 + I4 + I5;
        auto item_desc = [&](int r) -> TrItem {
            if (r < I1) { const int kb = r / 144, lgg = r % 144, pn = lgg >> 3, lg = lgg & 7, wtg = pn * 8 + 4 * (lg & 1) + 2 * (lg >> 2) + ((lg >> 1) & 1);
                return TrItem{a.w_in, W1T, a.norm_mix, DM, DIN, wtg * 32, kb * 64, lgg * 32}; } r -= I1;
            if (r < I2) { const int kb = r / 64, lgg = r % 64, l2 = lgg & 31, wtg = (l2 >> 2) * 8 + 4 * (lgg >> 5) + (l2 & 3);
                return TrItem{a.w_glu, WGLUT, nullptr, DSSM, 2 * DSSM, wtg * 32, kb * 64, lgg * 32}; } r -= I2;
            if (r < I3) { const int kb = r / 64, lgg = r % 64; return TrItem{a.w_out, WOT, nullptr, DM, DM, lgg * 32, kb * 64, lgg * 32}; } r -= I3;
            if (r < I4) { const int kb = r / 64, lgg = r % 64; return TrItem{a.w_ple_gate, WGT, a.norm_ple, DM, DM, lgg * 32, kb * 64, lgg * 32}; } r -= I4;
            const int kb = r / 64, lgg = r % 64; return TrItem{a.w_ple_proj, WPT, nullptr, PLE, DM, lgg * 32, kb * 64, lgg * 32};
        };
#pragma unroll
        for (int rq_ = 0; rq_ < 1 + ((REP_MASK >> 8) & 1); ++rq_)
        for (int it = gw; it < I1; it += 2 * NGW) {
            const bool two = it + NGW < I1;
            const TrItem dA = item_desc(it), dB = item_desc(two ? it + NGW : it);
            float vA[32], vB[32];
            p0_tr_load(dA, vA, lane); if (two) p0_tr_load(dB, vB, lane);
            p0_tr_store(dA, vA, scr, lane); if (two) p0_tr_store(dB, vB, scr, lane);
        }
#pragma unroll
        for (int rq_ = 0; rq_ < 1 + ((REP_MASK >> 9) & 1); ++rq_)
        for (int m = gw; m < T; m += 2 * NGW) {
            const int m2 = m + NGW; const bool two = m2 < T;
            const f32x4* xr = (const f32x4*)(a.x + (size_t)m * DM) + lane; const f32x4* xr2 = (const f32x4*)(a.x + (size_t)(two ? m2 : m) * DM) + lane;
            f32x4 v[8], w2[8]; float s = 0.f, s2 = 0.f;
#pragma unroll
            for (int j = 0; j < 8; ++j) v[j] = __builtin_nontemporal_load(xr + 64 * j);
#pragma unroll
            for (int j = 0; j < 8; ++j) w2[j] = __builtin_nontemporal_load(xr2 + 64 * j);
#pragma unroll
            for (int j = 0; j < 8; ++j) { s += (v[j][0] * v[j][0] + v[j][1] * v[j][1]) + (v[j][2] * v[j][2] + v[j][3] * v[j][3]); s2 += (w2[j][0] * w2[j][0] + w2[j][1] * w2[j][1]) + (w2[j][2] * w2[j][2] + w2[j][3] * w2[j][3]); }
            s = wave_sum(s); s2 = wave_sum(s2);
            if (lane == 0) { RINV[m] = rsqrtf(s * (1.f / DM) + EPS); if (two) RINV[m2] = rsqrtf(s2 * (1.f / DM) + EPS); }
            u32x2* o = (u32x2*)(XB + (size_t)m * DM) + lane; u32x2* o2 = (u32x2*)(XB + (size_t)m2 * DM) + lane;
#pragma unroll
            for (int j = 0; j < 8; ++j) { u32x2 w; w.x = pk2(v[j][0], v[j][1]); w.y = pk2(v[j][2], v[j][3]); o[64 * j] = w; }
            if (two) {
#pragma unroll
                for (int j = 0; j < 8; ++j) { u32x2 w; w.x = pk2(w2[j][0], w2[j][1]); w.y = pk2(w2[j][2], w2[j][3]); o2[64 * j] = w; } }
        }
        for (int i = bid * 512 + tid; i < T * PLE / 4; i += G * 512) { const f32x4 v = __builtin_nontemporal_load((const f32x4*)a.p + i); u32x2 w; w.x = pk2(v[0], v[1]); w.y = pk2(v[2], v[3]); ((u32x2*)PB)[i] = w; }
        for (int i = bid * 512 + tid; i < 2048; i += G * 512) { const int pos = i >> 5, f = i & 31; const float inv = powf(10000.f, -(float)f / 32.f); float sn, cs; sincosf((float)pos * inv, &sn, &cs); ROPE[i] = make_float2(cs, sn); }
        xcd_barrier_arrive(xbar, (wave == 0) && (lane_id_opaque() == 0));
        for (int it = I1 + gw; it < NIT; it += 2 * NGW) {
            const bool two = it + NGW < NIT;
            const TrItem dA = item_desc(it), dB = item_desc(two ? it + NGW : it);
            float vA[32], vB[32];
            p0_tr_load(dA, vA, lane); if (two) p0_tr_load(dB, vB, lane);
            p0_tr_store(dA, vA, scr, lane); if (two) p0_tr_store(dB, vB, scr, lane);
        }
        xcd_barrier_wait(xbar, (wave == 0) && (lane_id_opaque() == 0)); }


    if constexpr ((REP_MASK >> 10) & 1) { GRID_SYNC(); GRID_SYNC(); GRID_SYNC(); GRID_SYNC(); }
#pragma unroll
    for (int rep_ = 0; rep_ < 1 + ((REP_MASK >> 1) & 1); ++rep_) { LANE_IDS
        { pg8::Gemm g{XB, W1T, DM, DM, DM, 0, 0}; pg8::StaticOrder S; S.init(T, 14 * 256, G, bid);
          pg8::Epi1 E{RINV, a.q_norm, a.k_norm, ROPE, Q, KB, VB, GA, GS, UCAT, (LAS float*)(lds + XCH_OFF), 0};
          pg8::gemm_phase<pg8::Epi1, pg8::StaticOrder, true>(lds, g, S, E, wave); }
        __syncthreads();
        for (int gi = bid - (G - NG); gi >= 0 && gi < NG; gi += NG) ssm_tables(a, gi, lds, tid);
    GRID_SYNC(); }

#pragma unroll
    for (int rep_ = 0; rep_ < 1 + ((REP_MASK >> 2) & 1); ++rep_) {
#pragma unroll
        for (int rq_ = 0; rq_ < 2; ++rq_) {
        if (bid < 2 * NG) { if (rq_ == 1 && !((REP_MASK >> 6) & 1)) break;
            pg8::BatchOrder S{2 * NG, G, bid};
            { pg8::Gemm g{UCAT, WIN, 256, 512, 256, (size_t)NCH * 512 * 2, (size_t)256 * 256 * 2};
              pg8::EpiS1 E{LB16, UCAT}; pg8::gemm_phase<pg8::EpiS1, pg8::BatchOrder, true>(lds, g, S, E, wave); }
            asm volatile("s_waitcnt vmcnt(0)\n\tbuffer_inv sc1\n\ts_waitcnt vmcnt(0)" ::: "memory"); __syncthreads();
            { pg8::Gemm g{UCAT, WBIG, 512, 512, 512, (size_t)NCH * 512 * 2, (size_t)256 * 512 * 2};
              pg8::EpiS2 E{YS}; pg8::gemm_phase<pg8::EpiS2, pg8::BatchOrder, true>(lds, g, S, E, wave); }
        } else { if (rq_ == 1 && !((REP_MASK >> 11) & 1)) break;
            pg8::Gemm g{XB, W1T + (size_t)14 * 256 * DM, DM, DM, DM, 0, 0}; pg8::ListOrder S{bid - 2 * NG, 128, G};
            pg8::Epi1 E{RINV, a.q_norm, a.k_norm, ROPE, Q, KB, VB, GA, GS, UCAT, (LAS float*)(lds + XCH_OFF), 14};
            pg8::gemm_phase<pg8::Epi1, pg8::ListOrder, true>(lds, g, S, E, wave);
        }
        __syncthreads(); }
#pragma unroll
        for (int rq_ = 0; rq_ < 1 + ((REP_MASK >> 7) & 1); ++rq_)
        for (int un = bid; un < 256; un += G) {
            const int x = un & 7, jj = un >> 3, b = x >> 2, kvh = (x >> 1) & 1, idx = (x & 1) * 32 + jj, h = kvh * 4 + (idx >> 4), qb = idx & 15;
            const size_t tok0 = (size_t)b * SEQ + qb * 256;
            att::attn_dense_body(Q + tok0 * DATT + h * 128, KB + (size_t)b * SEQ * DKV + kvh * 128, VB + (size_t)b * SEQ * DKV + kvh * 128,
                                 GA + tok0 * DATT + h * 128, YMIX + tok0 * DM + h * 128, SEQ, (char*)lds_raw, wave);
        }
    GRID_SYNC(); }

#pragma unroll
    for (int rep_ = 0; rep_ < 1 + ((REP_MASK >> 3) & 1); ++rep_) {
        { pg8::StaticOrder S; S.init(T, 2 * DSSM, G, bid); pg8::Unit ua, ub;
          if (S.next(0, ua)) { ub = ua;
            pg8::Gemm ga{YS, WGLUT, DSSM, DSSM, DSSM, 0, 0}; pg8::EpiGlu Ea{a.b_glu, GS, YMIX};
            pg8::Gemm gb{PB, WPT, PLE, PLE, PLE, 0, 0}; pg8::EpiBf Eb{PPB, DM};
            pg8::gemm_phase2<pg8::EpiGlu, pg8::EpiBf>(lds, ga, ua, Ea, gb, ub, Eb, wave); } }
    GRID_SYNC(); }

#pragma unroll
    for (int rep_ = 0; rep_ < 1 + ((REP_MASK >> 4) & 1); ++rep_) {
        pg8::Gemm g{YMIX, WOT, DM, DM, DM, 0, 0}; pg8::StaticOrder S; S.init(T, DM, G, bid);
        pg8::EpiOut E{a.x, a.out, HB, SSQ1}; pg8::gemm_phase<pg8::EpiOut, pg8::StaticOrder, true>(lds, g, S, E, wave);
    GRID_SYNC(); }


    { LANE_IDS
        pg8::StaticOrder S; S.init(T, DM, G, bid); pg8::Unit u0;
        LAS float* r2 = (LAS float*)(lds + R2_OFF);
        if (S.next(0, u0) && tid < 256) { const float* sp = SSQ1 + (size_t)(u0.pm * 256 + tid) * 32; float s = 0.f;
#pragma unroll
            for (int i = 0; i < 8; ++i) { const f32x4 v = ((const f32x4*)sp)[i]; s += (v[0] + v[1]) + (v[2] + v[3]); }
            r2[tid] = rsqrtf(s * (1.f / DM) + EPS); }
        __syncthreads();
        pg8::Gemm g{HB, WGT, DM, DM, DM, 0, 0};
        pg8::EpiGate E{a.out, PPB, SSQ2, (unsigned*)ws, a.norm_final, r2, HB}; pg8::gemm_phase<pg8::EpiGate, pg8::StaticOrder, true>(lds, g, S, E, wave);
    }
}

extern "C" void kernel_launch(void* const* d_in, const int* in_sizes, int n_in, void* d_out, int out_size, void* d_ws, size_t ws_size, hipStream_t stream) {
    static int grid = 0;
    if (grid == 0) {
        if (n_in != 21 || in_sizes[0] != T * DM || out_size != T * DM || ws_size < WS_END) { fprintf(stderr, "kernel_launch: unexpected shapes (n_in %d, in0 %d, out %d, ws %zu)\n", n_in, n_in > 0 ? in_sizes[0] : -1, out_size, ws_size); grid = -1; return; }
        int dev = 0, cus = 0, per_cu = 0;
        hipGetDevice(&dev); hipDeviceGetAttribute(&cus, hipDeviceAttributeMultiprocessorCount, dev);
        if (hipFuncSetAttribute((const void*)fwd_kernel, hipFuncAttributeMaxDynamicSharedMemorySize, LDS_BYTES) != hipSuccess) { fprintf(stderr, "kernel_launch: hipFuncSetAttribute failed\n"); grid = -1; return; }
        hipOccupancyMaxActiveBlocksPerMultiprocessor(&per_cu, (const void*)fwd_kernel, 512, LDS_BYTES);
        (void)hipGetLastError();
        if (per_cu < 1) fprintf(stderr, "kernel_launch: occupancy query reports %d blocks per CU\n", per_cu);
        grid = cus > 256 ? 256 : cus;
    }
    if (grid < 0) return;
    Args a{};
    const float** f = (const float**)&a;
    for (int i = 0; i < 21; ++i) f[i] = (const float*)d_in[i];
    a.out = (float*)d_out; a.ws = (unsigned char*)d_ws;
    if (hipMemsetAsync(d_ws, 0, WS_CTL_BYTES, stream) != hipSuccess) { fprintf(stderr, "kernel_launch: hipMemsetAsync failed\n"); return; }
    void* args[] = {&a};
    hipError_t e = hipLaunchCooperativeKernel((const void*)fwd_kernel, dim3(grid), dim3(512), args, LDS_BYTES, stream);
    if (e != hipSuccess) fprintf(stderr, "kernel_launch: cooperative launch failed: %s (grid %d)\n", hipGetErrorString(e), grid);
}
```

```cpp
#include <hip/hip_runtime.h>
#include <hip/hip_cooperative_groups.h>
#include <cstdio>
#include <cstdint>
namespace cg = cooperative_groups;

#define LAS __attribute__((address_space(3)))
typedef unsigned short bf16_t;
typedef short bf16x8 __attribute__((ext_vector_type(8)));
typedef short s16x4 __attribute__((ext_vector_type(4)));
typedef float f32x4 __attribute__((ext_vector_type(4)));
typedef float f32x16 __attribute__((ext_vector_type(16)));
typedef unsigned u32x4 __attribute__((ext_vector_type(4)));
typedef unsigned u32x2 __attribute__((ext_vector_type(2)));

constexpr int T = 8192, SEQ = 4096, DM = 2048, DIN = 4608, DATT = 1024, DKV = 256, DSSM = 1024, PLE = 256;
constexpr int NG = 64, NCH = T / 16;
constexpr float EPS = 1e-6f;
#ifndef PH_MASK
#define PH_MASK 0xff
#endif
#ifndef GLDS_AUX
#define GLDS_AUX 0
#endif
#ifndef REP_MASK
#define REP_MASK 0
#endif

constexpr size_t MiB = 1u << 20;
constexpr size_t WS_W1T = 1 * MiB, WS_WGLUT = 19 * MiB, WS_WOT = 23 * MiB, WS_WGT = 31 * MiB, WS_WPT = 39 * MiB;
constexpr size_t WS_ROPE = 40 * MiB, WS_RINV = 40 * MiB + 65536, WS_LB16 = 40 * MiB + 131072, WS_SSQ1 = 41 * MiB, WS_SSQ2 = 42 * MiB;
constexpr size_t WS_PB = 43 * MiB, WS_WIN = 47 * MiB, WS_WBIG = 55 * MiB;
constexpr size_t WS_XB = 71 * MiB;
constexpr size_t WS_Q = 103 * MiB, WS_K = 119 * MiB, WS_V = 123 * MiB, WS_GA = 127 * MiB, WS_GS = 143 * MiB;
constexpr size_t WS_UCAT = 159 * MiB;
constexpr size_t WS_YMIX = 191 * MiB, WS_YS = 223 * MiB, WS_END = 239 * MiB;

constexpr int RING_BYTES = 131072, XCH_OFF = RING_BYTES, R2_OFF = RING_BYTES + 4096, XBST_OFF = RING_BYTES + 8192, LDS_BYTES = 147456;
constexpr size_t WS_BAR = 65536, WS_CTL_BYTES = 131072;

struct Args {
    const float *x, *p, *norm_mix, *w_in, *q_norm, *k_norm, *a_re, *a_im, *log_dt, *b_re, *b_im, *c_re, *c_im, *ssm_d, *w_glu, *b_glu, *w_out, *norm_ple, *w_ple_gate, *w_ple_proj, *norm_final;
    float* out; unsigned char* ws;
};

typedef __bf16 bf16s_;
__device__ __forceinline__ unsigned f2bf(float f) { return (unsigned)__builtin_bit_cast(unsigned short, (bf16s_)f); }
typedef float f32x2_ __attribute__((ext_vector_type(2)));
typedef __bf16 bf16x2_ __attribute__((ext_vector_type(2)));
__device__ __forceinline__ unsigned pk2(float lo, float hi) { const f32x2_ v = {lo, hi}; return __builtin_bit_cast(unsigned, __builtin_convertvector(v, bf16x2_)); }
__device__ __forceinline__ float bf2f(unsigned short b) { return __builtin_bit_cast(float, (unsigned)b << 16); }
__device__ __forceinline__ float bflo(unsigned w) { return __builtin_bit_cast(float, w << 16); }
__device__ __forceinline__ float bfhi(unsigned w) { return __builtin_bit_cast(float, w & 0xffff0000u); }
__device__ __forceinline__ unsigned cvt_pk_bf16(float lo, float hi) { unsigned r; asm volatile("v_cvt_pk_bf16_f32 %0, %1, %2" : "=v"(r) : "v"(lo), "v"(hi)); return r; }
__device__ __forceinline__ float sigmoidf_(float v) { return __builtin_amdgcn_rcpf(1.f + __builtin_amdgcn_exp2f(-1.4426950408889634f * v)); }
__device__ __forceinline__ float siluf_(float v) { return v * __builtin_amdgcn_rcpf(1.f + __builtin_amdgcn_exp2f(-1.4426950408889634f * v)); }
__device__ __forceinline__ float gelu_tanh(float v) { const float t = (-1.5957691216057308f * 1.4426950408889634f) * (v + 0.044715f * v * v * v); return v * __builtin_amdgcn_rcpf(1.f + __builtin_amdgcn_exp2f(t)); }
template <int K> __device__ __forceinline__ float swz_xor(float v) { return __int_as_float(__builtin_amdgcn_ds_swizzle(__float_as_int(v), (K << 10) | 0x1f)); }
__device__ __forceinline__ float sum_xor32(float v) { auto rr = __builtin_amdgcn_permlane32_swap(__float_as_uint(v), __float_as_uint(v), false, false); return __uint_as_float(rr[0]) + __uint_as_float(rr[1]); }
__device__ __forceinline__ float wave_sum(float v) { v += swz_xor<1>(v); v += swz_xor<2>(v); v += swz_xor<4>(v); v += swz_xor<8>(v); v += swz_xor<16>(v); return sum_xor32(v); }
#define LDS_WAIT() asm volatile("s_waitcnt lgkmcnt(0)" ::: "memory")
__device__ __forceinline__ int lane_id_opaque() { int l = __builtin_amdgcn_mbcnt_hi(~0u, __builtin_amdgcn_mbcnt_lo(~0u, 0u)); asm volatile("" : "+v"(l)); return l; }

namespace pg8 {
constexpr int BM = 256, BK = 64, HALF = 128, HTB = HALF * BK * 2, NXCD = 8, WGM = 8;
__host__ __device__ __forceinline__ int lds_byte(int r, int c) { const int st = (r >> 4) * 2 + (c >> 5), rr = r & 15, cc = c & 31, ob = rr * 64 + cc * 2; return st * 1024 + (ob ^ (((ob >> 9) & 1) << 5)); }
__host__ __device__ __forceinline__ void stage_rc(int b, int& R, int& C) { const int st = b / 1024, sb = b % 1024, swz = sb ^ (((sb >> 9) & 1) << 5); R = (st >> 1) * 16 + swz / 64; C = (st & 1) * 32 + (swz % 64) / 2; }
__host__ __device__ __forceinline__ int perm32(int rho) { const int n = rho >> 4, i = rho & 15; return 8 * (i >> 2) + 4 * n + (i & 3); }

struct Unit { int pm, pn, z; };
struct Gemm { const bf16_t* A; const bf16_t* Bt; int K, lda, ldb; size_t zA, zB; };

struct StaticOrder {
    int nM, nN, nwg, G, c;
    __device__ void init(int M, int N, int G_, int c_) { nM = M / BM; nN = N / BM; nwg = nM * nN; G = G_; c = c_; }
    __device__ bool next(int i, Unit& u) const {
        const long L = (long)i * G + c; if (L >= nwg) return false;
        int wgid = (int)L; { const int q = nwg / NXCD, r = nwg % NXCD, xcd = wgid % NXCD, off = wgid / NXCD; wgid = (xcd < r ? xcd * (q + 1) : r * (q + 1) + (xcd - r) * q) + off; }
        const int nig = WGM * nN, gid = wgid / nig, fm = gid * WGM, gsz = (nM - fm) < WGM ? (nM - fm) : WGM;
        u.pm = fm + ((wgid % nig) % gsz); u.pn = (wgid % nig) / gsz; u.z = 0; return true;
    }
};
struct BatchOrder {
    int n, G, c;
    __device__ bool next(int i, Unit& u) const { const int L = i * G + c; if (L >= n) return false; u.z = L >> 1; u.pm = L & 1; u.pn = 0; return true; }
};

struct ListOrder {
    int L0, n, stride;
    __device__ bool next(int i, Unit& u) const { const int L = L0 + i * stride; if (L < 0 || L >= n) return false;
        const int x = L & 7, j = L >> 3; u.pm = 4 * x + (j >> 2); u.pn = j & 3; u.z = 0; return true; }
};
template <class Epi, class Sched, bool ALIGN_EPI>
__device__ __forceinline__ void gemm_phase(LAS unsigned char* lds, const Gemm g, const Sched& S, const Epi& E, const int wid) {
    const int lane = lane_id_opaque(), tid = wid * 64 + lane, wr = wid >> 2, wc = wid & 3, fr = lane & 15, fq = lane >> 4;
    const int K = g.K, nt = K / BK;
    unsigned voffA[2], voffB[2];
#pragma unroll
    for (int i = 0; i < 2; ++i) { int R, C; stage_rc(tid * 16 + i * 8192, R, C); const int Rb = (R & ~31) + perm32(R & 31);
        voffA[i] = (unsigned)(R * g.lda + C) * 2u; voffB[i] = (unsigned)(Rb * g.ldb + C) * 2u; }
    const size_t kstep = (size_t)(BK * 2);
    const size_t hstepA = (size_t)HALF * g.lda * 2, hstepB = (size_t)HALF * g.ldb * 2;
    const size_t tstepA = 2 * hstepA, tstepB = 2 * hstepB;
    const unsigned ldsw = (unsigned)wid * 1024u;
    const int aoff = lds_byte(wr * 64 + fr, fq * 8), boff = lds_byte(wc * 32 + fr, fq * 8);
#define PG8_SA(b, h) (((b) * 2 + (h)) * HTB)
#define PG8_SB(b, h) ((4 + (b) * 2 + (h)) * HTB)
#define PG8_STAGE(bufoff, gbase, voff) do { _Pragma("unroll") for (int _i = 0; _i < 2; ++_i) \
        __builtin_amdgcn_global_load_lds((const unsigned*)((const char*)(gbase) + (voff)[_i]), (LAS unsigned*)(lds + (bufoff) + ldsw + _i * 8192), 16, 0, GLDS_AUX); } while (0)
#define PG8_LDA(dst, b, h) do { _Pragma("unroll") for (int m = 0; m < 4; ++m) _Pragma("unroll") for (int k = 0; k < 2; ++k) dst[m][k] = *(const LAS bf16x8*)(lds + PG8_SA(b, h) + aoff + m * 2048 + k * 1024); } while (0)
#define PG8_LDB(dst, b, h) do { _Pragma("unroll") for (int n = 0; n < 2; ++n) _Pragma("unroll") for (int k = 0; k < 2; ++k) dst[n][k] = *(const LAS bf16x8*)(lds + PG8_SB(b, h) + boff + n * 2048 + k * 1024); } while (0)
#define PG8_MMA(ai, bj, At, Bt) do { __builtin_amdgcn_s_setprio(1); _Pragma("unroll") for (int m = 0; m < 4; ++m) _Pragma("unroll") for (int n = 0; n < 2; ++n) _Pragma("unroll") for (int k = 0; k < 2; ++k) \
        acc[ai][bj][m][n] = __builtin_amdgcn_mfma_f32_16x16x32_bf16(Bt[n][k], At[m][k], acc[ai][bj][m][n], 0, 0, 0); __builtin_amdgcn_s_setprio(0); } while (0)
#define PG8_WAIT_V(n) asm volatile("s_waitcnt vmcnt(" #n ")" ::: "memory")
#define PG8_WAIT_L(n) asm volatile("s_waitcnt lgkmcnt(" #n ")" ::: "memory")
#define PG8_BAR __builtin_amdgcn_s_barrier()
#define PG8_SCHED __builtin_amdgcn_sched_barrier(0)
    Unit cur, nxt; int ui = 0;
    if (!S.next(0, cur)) return;
    f32x4 acc[2][2][4][2];
#pragma unroll
    for (int a = 0; a < 2; ++a)
#pragma unroll
        for (int b = 0; b < 2; ++b)
#pragma unroll
            for (int m = 0; m < 4; ++m)
#pragma unroll
                for (int n = 0; n < 2; ++n) acc[a][b][m][n] = (f32x4){0.f, 0.f, 0.f, 0.f};
    bf16x8 At[4][2], B0[2][2], B1[2][2];
    const char* cA = (const char*)g.A + (size_t)cur.z * g.zA + (size_t)cur.pm * tstepA; const char* cB = (const char*)g.Bt + (size_t)cur.z * g.zB + (size_t)cur.pn * tstepB;
    PG8_STAGE(PG8_SB(0, 0), cB, voffB); PG8_STAGE(PG8_SB(0, 1), cB + hstepB, voffB); PG8_STAGE(PG8_SA(0, 0), cA, voffA); PG8_STAGE(PG8_SA(0, 1), cA + hstepA, voffA);
    if (wr == 1) PG8_BAR;
    PG8_WAIT_V(2); PG8_BAR;
    PG8_STAGE(PG8_SB(1, 0), cB + kstep, voffB); PG8_STAGE(PG8_SA(1, 0), cA + kstep, voffA); PG8_STAGE(PG8_SB(1, 1), cB + hstepB + kstep, voffB);
    PG8_WAIT_V(6); PG8_BAR;
    for (;;) {
        const bool has_next = S.next(ui + 1, nxt);
        const char* nA = has_next ? (const char*)g.A + (size_t)nxt.z * g.zA + (size_t)nxt.pm * tstepA : cA;
        const char* nB = has_next ? (const char*)g.Bt + (size_t)nxt.z * g.zB + (size_t)nxt.pn * tstepB : cB;
        for (int t = 0; t < nt; t += 2) {
            const bool last = (t == nt - 2);
            const char* a1 = cA + (size_t)(t + 1) * kstep;
            const char* a2 = last ? nA : cA + (size_t)(t + 2) * kstep; const char* b2 = last ? nB : cB + (size_t)(t + 2) * kstep;
            const char* a3 = a2 + kstep; const char* b3 = b2 + kstep;
            PG8_LDB(B0, 0, 0); PG8_LDB(B1, 0, 1); PG8_SCHED; PG8_LDA(At, 0, 0); PG8_STAGE(PG8_SA(1, 1), a1 + hstepA, voffA);
            PG8_WAIT_V(8); PG8_WAIT_L(0); PG8_BAR; PG8_MMA(0, 0, At, B0); PG8_MMA(0, 1, At, B1); PG8_BAR; PG8_SCHED;
            PG8_LDA(At, 0, 1); PG8_STAGE(PG8_SB(0, 0), b2, voffB); PG8_STAGE(PG8_SB(0, 1), b2 + hstepB, voffB); PG8_STAGE(PG8_SA(0, 0), a2, voffA);
            PG8_WAIT_V(8); PG8_WAIT_L(0); PG8_BAR; PG8_MMA(1, 0, At, B0); PG8_MMA(1, 1, At, B1); PG8_BAR; PG8_SCHED;
            PG8_LDB(B0, 1, 0); PG8_LDB(B1, 1, 1); PG8_SCHED; PG8_LDA(At, 1, 0); PG8_STAGE(PG8_SA(0, 1), a2 + hstepA, voffA);
            PG8_WAIT_V(8); PG8_WAIT_L(0); PG8_BAR; PG8_MMA(0, 0, At, B0); PG8_MMA(0, 1, At, B1); PG8_BAR; PG8_SCHED;
            PG8_LDA(At, 1, 1); PG8_STAGE(PG8_SB(1, 0), b3, voffB); PG8_STAGE(PG8_SB(1, 1), b3 + hstepB, voffB); PG8_STAGE(PG8_SA(1, 0), a3, voffA);
            PG8_WAIT_V(8); PG8_WAIT_L(0); PG8_BAR; PG8_MMA(1, 0, At, B0); PG8_MMA(1, 1, At, B1); PG8_BAR; PG8_SCHED;
        }
        if constexpr (ALIGN_EPI) { if (wr == 0) PG8_BAR; }
        if constexpr (!Epi::AFTER_DRAIN) E(acc, cur, wr, wc, fr, fq);
        if (!has_next) break;
#pragma unroll
        for (int a = 0; a < 2; ++a)
#pragma unroll
            for (int b = 0; b < 2; ++b)
#pragma unroll
                for (int m = 0; m < 4; ++m)
#pragma unroll
                    for (int n = 0; n < 2; ++n) acc[a][b][m][n] = (f32x4){0.f, 0.f, 0.f, 0.f};
        cur = nxt; cA = nA; cB = nB; ++ui;
        if constexpr (ALIGN_EPI) { if (wr == 1) PG8_BAR; }
    }
    PG8_WAIT_V(0);
    if constexpr (!ALIGN_EPI) { if (wr == 0) PG8_BAR; }
    PG8_BAR;
    if constexpr (Epi::AFTER_DRAIN) E.fused(acc, cur, wr, wc, lds, wid);
#undef PG8_SA
#undef PG8_SB
#undef PG8_STAGE
#undef PG8_LDA
#undef PG8_LDB
#undef PG8_MMA
#undef PG8_WAIT_V
#undef PG8_WAIT_L
#undef PG8_BAR
#undef PG8_SCHED
}

template <class EpiA, class EpiB>
__device__ __forceinline__ void gemm_phase2(LAS unsigned char* lds, const Gemm g0, const Unit u0, const EpiA& E0, const Gemm g1, const Unit u1, const EpiB& E1, const int wid) {
    const int lane = lane_id_opaque(), tid = wid * 64 + lane, wr = wid >> 2, wc = wid & 3, fr = lane & 15, fq = lane >> 4;
    unsigned vA0[2], vB0[2], vA1[2], vB1[2];
#pragma unroll
    for (int i = 0; i < 2; ++i) { int R, C; stage_rc(tid * 16 + i * 8192, R, C); const int Rb = (R & ~31) + perm32(R & 31);
        vA0[i] = (unsigned)(R * g0.lda + C) * 2u; vB0[i] = (unsigned)(Rb * g0.ldb + C) * 2u; vA1[i] = (unsigned)(R * g1.lda + C) * 2u; vB1[i] = (unsigned)(Rb * g1.ldb + C) * 2u; }
    const size_t kstep = (size_t)(BK * 2);
    const size_t hA0 = (size_t)HALF * g0.lda * 2, hB0 = (size_t)HALF * g0.ldb * 2, hA1 = (size_t)HALF * g1.lda * 2, hB1 = (size_t)HALF * g1.ldb * 2;
    const unsigned ldsw = (unsigned)wid * 1024u;
    const int aoff = lds_byte(wr * 64 + fr, fq * 8), boff = lds_byte(wc * 32 + fr, fq * 8);
#define PG8_SA(b, h) (((b) * 2 + (h)) * HTB)
#define PG8_SB(b, h) ((4 + (b) * 2 + (h)) * HTB)
#define PG8_STAGE(bufoff, gbase, voff) do { _Pragma("unroll") for (int _i = 0; _i < 2; ++_i) \
        __builtin_amdgcn_global_load_lds((const unsigned*)((const char*)(gbase) + (voff)[_i]), (LAS unsigned*)(lds + (bufoff) + ldsw + _i * 8192), 16, 0, 0); } while (0)
#define PG8_LDA(dst, b, h) do { _Pragma("unroll") for (int m = 0; m < 4; ++m) _Pragma("unroll") for (int k = 0; k < 2; ++k) dst[m][k] = *(const LAS bf16x8*)(lds + PG8_SA(b, h) + aoff + m * 2048 + k * 1024); } while (0)
#define PG8_LDB(dst, b, h) do { _Pragma("unroll") for (int n = 0; n < 2; ++n) _Pragma("unroll") for (int k = 0; k < 2; ++k) dst[n][k] = *(const LAS bf16x8*)(lds + PG8_SB(b, h) + boff + n * 2048 + k * 1024); } while (0)
#define PG8_MMA(ai, bj, At, Bt) do { __builtin_amdgcn_s_setprio(1); _Pragma("unroll") for (int m = 0; m < 4; ++m) _Pragma("unroll") for (int n = 0; n < 2; ++n) _Pragma("unroll") for (int k = 0; k < 2; ++k) \
        acc[ai][bj][m][n] = __builtin_amdgcn_mfma_f32_16x16x32_bf16(Bt[n][k], At[m][k], acc[ai][bj][m][n], 0, 0, 0); __builtin_amdgcn_s_setprio(0); } while (0)
#define PG8_WAIT_V(n) asm volatile("s_waitcnt vmcnt(" #n ")" ::: "memory")
#define PG8_WAIT_L(n) asm volatile("s_waitcnt lgkmcnt(" #n ")" ::: "memory")
#define PG8_BAR __builtin_amdgcn_s_barrier()
#define PG8_SCHED __builtin_amdgcn_sched_barrier(0)
    f32x4 acc[2][2][4][2];
#pragma unroll
    for (int a = 0; a < 2; ++a)
#pragma unroll
        for (int b = 0; b < 2; ++b)
#pragma unroll
            for (int m = 0; m < 4; ++m)
#pragma unroll
                for (int n = 0; n < 2; ++n) acc[a][b][m][n] = (f32x4){0.f, 0.f, 0.f, 0.f};
    bf16x8 At[4][2], B0[2][2], B1[2][2];
    const char* A0 = (const char*)g0.A + (size_t)u0.pm * 2 * hA0; const char* Bp0 = (const char*)g0.Bt + (size_t)u0.pn * 2 * hB0;
    const char* A1 = (const char*)g1.A + (size_t)u1.pm * 2 * hA1; const char* Bp1 = (const char*)g1.Bt + (size_t)u1.pn * 2 * hB1;
    PG8_STAGE(PG8_SB(0, 0), Bp0, vB0); PG8_STAGE(PG8_SB(0, 1), Bp0 + hB0, vB0); PG8_STAGE(PG8_SA(0, 0), A0, vA0); PG8_STAGE(PG8_SA(0, 1), A0 + hA0, vA0);
    if (wr == 1) PG8_BAR;
    PG8_WAIT_V(2); PG8_BAR;
    PG8_STAGE(PG8_SB(1, 0), Bp0 + kstep, vB0); PG8_STAGE(PG8_SA(1, 0), A0 + kstep, vA0); PG8_STAGE(PG8_SB(1, 1), Bp0 + hB0 + kstep, vB0);
    PG8_WAIT_V(6); PG8_BAR;
#pragma unroll
    for (int ui = 0; ui < 2; ++ui) {
        const char* cA = ui == 0 ? A0 : A1; const char* cB = ui == 0 ? Bp0 : Bp1;
        const size_t hAc = ui == 0 ? hA0 : hA1, hBc = ui == 0 ? hB0 : hB1;
        const int nt = (ui == 0 ? g0.K : g1.K) / BK;
        unsigned vAc[2], vBc[2];
#pragma unroll
        for (int i = 0; i < 2; ++i) { vAc[i] = ui == 0 ? vA0[i] : vA1[i]; vBc[i] = ui == 0 ? vB0[i] : vB1[i]; }
        for (int t = 0; t < nt; t += 2) {
            const bool last = (t == nt - 2);
            const char* a1 = cA + (size_t)(t + 1) * kstep;
            const char* a2 = last ? A1 : cA + (size_t)(t + 2) * kstep; const char* b2 = last ? Bp1 : cB + (size_t)(t + 2) * kstep;
            const char* a3 = a2 + kstep; const char* b3 = b2 + kstep;
            const size_t hA2 = last ? hA1 : hAc, hB2 = last ? hB1 : hBc;
            unsigned vA2[2], vB2[2];
#pragma unroll
            for (int i = 0; i < 2; ++i) { vA2[i] = last ? vA1[i] : vAc[i]; vB2[i] = last ? vB1[i] : vBc[i]; }
            PG8_LDB(B0, 0, 0); PG8_LDB(B1, 0, 1); PG8_SCHED; PG8_LDA(At, 0, 0); PG8_STAGE(PG8_SA(1, 1), a1 + hAc, vAc);
            PG8_WAIT_V(8); PG8_WAIT_L(0); PG8_BAR; PG8_MMA(0, 0, At, B0); PG8_MMA(0, 1, At, B1); PG8_BAR; PG8_SCHED;
            PG8_LDA(At, 0, 1); PG8_STAGE(PG8_SB(0, 0), b2, vB2); PG8_STAGE(PG8_SB(0, 1), b2 + hB2, vB2); PG8_STAGE(PG8_SA(0, 0), a2, vA2);
            PG8_WAIT_V(8); PG8_WAIT_L(0); PG8_BAR; PG8_MMA(1, 0, At, B0); PG8_MMA(1, 1, At, B1); PG8_BAR; PG8_SCHED;
            PG8_LDB(B0, 1, 0); PG8_LDB(B1, 1, 1); PG8_SCHED; PG8_LDA(At, 1, 0); PG8_STAGE(PG8_SA(0, 1), a2 + hA2, vA2);
            PG8_WAIT_V(8); PG8_WAIT_L(0); PG8_BAR; PG8_MMA(0, 0, At, B0); PG8_MMA(0, 1, At, B1); PG8_BAR; PG8_SCHED;
            PG8_LDA(At, 1, 1); PG8_STAGE(PG8_SB(1, 0), b3, vB2); PG8_STAGE(PG8_SB(1, 1), b3 + hB2, vB2); PG8_STAGE(PG8_SA(1, 0), a3, vA2);
            PG8_WAIT_V(8); PG8_WAIT_L(0); PG8_BAR; PG8_MMA(1, 0, At, B0); PG8_MMA(1, 1, At, B1); PG8_BAR; PG8_SCHED;
        }
        if (wr == 0) PG8_BAR;
        if (ui == 0) {
            E0(acc, u0, wr, wc, fr, fq);
#pragma unroll
            for (int a = 0; a < 2; ++a)
#pragma unroll
                for (int b = 0; b < 2; ++b)
#pragma unroll
                    for (int m = 0; m < 4; ++m)
#pragma unroll
                        for (int n = 0; n < 2; ++n) acc[a][b][m][n] = (f32x4){0.f, 0.f, 0.f, 0.f};
            if (wr == 1) PG8_BAR;
        } else E1(acc, u1, wr, wc, fr, fq);
    }
    PG8_WAIT_V(0);
    PG8_BAR;
#undef PG8_SA
#undef PG8_SB
#undef PG8_STAGE
#undef PG8_LDA
#undef PG8_LDB
#undef PG8_MMA
#undef PG8_WAIT_V
#undef PG8_WAIT_L
#undef PG8_BAR
#undef PG8_SCHED
}

#define EPI_FOR_ROWS _Pragma("unroll") for (int ai = 0; ai < 2; ++ai) _Pragma("unroll") for (int m = 0; m < 4; ++m)
#define EPI_ROWDEF const int rit = ai * HALF + wr * 64 + m * 16 + fr; const int row = u.pm * BM + rit; (void)rit; (void)row;

struct Epi1 {
    static constexpr bool AFTER_DRAIN = false;
    const float* rinv; const float* qnw; const float* knw; const float2* rope;
    bf16_t *Q, *Kb, *Vb, *GA, *GS, *UCAT; LAS float* xch; int pn0;
    __device__ __forceinline__ void operator()(const f32x4 (&acc)[2][2][4][2], const Unit& u, int wr, int wc, int, int) const {
        const int l_ = lane_id_opaque(), fr = l_ & 15, fq = l_ >> 4;
        const int pn = u.pn + pn0;
        if (pn <= 4) {
            float ss[2][4], rv[2][4];
            EPI_FOR_ROWS { EPI_ROWDEF const float r = rinv[row]; rv[ai][m] = r; float s = 0.f;
#pragma unroll
                for (int bj = 0; bj < 2; ++bj)
#pragma unroll
                    for (int n = 0; n < 2; ++n) { const f32x4 v = acc[ai][bj][m][n] * r; s += (v[0] * v[0] + v[1] * v[1]) + (v[2] * v[2] + v[3] * v[3]); }
                s += swz_xor<16>(s); s = sum_xor32(s); ss[ai][m] = s;
                if (fq == 0) xch[wc * 256 + rit] = s; }
            LDS_WAIT(); __builtin_amdgcn_s_barrier(); asm volatile("" ::: "memory");
            const int half = wc & 1, hd = wc >> 1;
            const float* nw = (pn < 4 ? qnw : knw) + 64 * half + 8 * fq;
            float w1[8], w2[8];
#pragma unroll
            for (int i = 0; i < 8; ++i) { w1[i] = nw[i]; w2[i] = nw[32 + i]; }
            EPI_FOR_ROWS { EPI_ROWDEF const float tot = ss[ai][m] + xch[(wc ^ 1) * 256 + rit];
                const float sc = rv[ai][m] * rsqrtf(tot * (1.f / 128.f) + EPS);
                const int t = row & (SEQ - 1); const int pos = half ? (t & 63) : (t >> 6);
                const float2* rp = rope + pos * 32 + 8 * fq;
                float o1[8], o2[8];
#pragma unroll
                for (int n = 0; n < 2; ++n)
#pragma unroll
                    for (int e = 0; e < 4; ++e) { const int i = 4 * n + e; const float2 cs = rp[i];
                        const float x1 = acc[ai][0][m][n][e] * sc * w1[i], x2 = acc[ai][1][m][n][e] * sc * w2[i];
                        o1[i] = x1 * cs.x - x2 * cs.y; o2[i] = x2 * cs.x + x1 * cs.y; }
                bf16_t* dst = (pn < 4) ? Q + (size_t)row * DATT + (2 * pn + hd) * 128 + 64 * half + 8 * fq : Kb + (size_t)row * DKV + hd * 128 + 64 * half + 8 * fq;
                u32x4 a; a.x = pk2(o1[0], o1[1]); a.y = pk2(o1[2], o1[3]); a.z = pk2(o1[4], o1[5]); a.w = pk2(o1[6], o1[7]);
                u32x4 b; b.x = pk2(o2[0], o2[1]); b.y = pk2(o2[2], o2[3]); b.z = pk2(o2[4], o2[5]); b.w = pk2(o2[6], o2[7]);
                *(u32x4*)dst = a; *(u32x4*)(dst + 32) = b; }
        } else {
            const int lg0 = 4 * (wc >> 1) + 2 * (wc & 1);
            EPI_FOR_ROWS { EPI_ROWDEF const float r = rinv[row];
#pragma unroll
                for (int bj = 0; bj < 2; ++bj) { const int L = 256 * pn + 32 * (lg0 + bj) + 8 * fq;
                    f32x4 v0 = acc[ai][bj][m][0] * r, v1 = acc[ai][bj][m][1] * r; bf16_t* dst;
                    if (pn == 5) dst = Vb + (size_t)row * DKV + (L - 1280);
                    else if (pn < 10) dst = GA + (size_t)row * DATT + (L - 1536);
                    else if (pn < 14) { const int Lu = L - 2560; dst = UCAT + ((size_t)(Lu >> 4) * NCH + (row >> 4)) * 512 + (row & 15) * 16 + (Lu & 15); }
                    else dst = GS + (size_t)row * DSSM + (L - 3584);
                    if ((pn >= 6 && pn < 10) || pn >= 14) {
#pragma unroll
                        for (int e = 0; e < 4; ++e) { v0[e] = siluf_(v0[e]); v1[e] = siluf_(v1[e]); } }
                    u32x4 w; w.x = pk2(v0[0], v0[1]); w.y = pk2(v0[2], v0[3]); w.z = pk2(v1[0], v1[1]); w.w = pk2(v1[2], v1[3]);
                    *(u32x4*)dst = w; } }
        }
    }
};
struct EpiS1 {
    static constexpr bool AFTER_DRAIN = true;
    const float* lb16; bf16_t* UCAT;
    __device__ __forceinline__ void operator()(const f32x4 (&)[2][2][4][2], const Unit&, int, int, int, int) const {}
    __device__ __forceinline__ void fused(const f32x4 (&acc)[2][2][4][2], const Unit& u, int wr, int wc, LAS unsigned char* lds, int wid) const {
        const int l_ = lane_id_opaque(), fr = l_ & 15, fq = l_ >> 4;
        LAS float* Tl = (LAS float*)lds;
#pragma unroll
        for (int d = 0; d < 2; ++d) {
            EPI_FOR_ROWS { const int rit = ai * HALF + wr * 64 + m * 16 + fr; LAS float* rp = Tl + rit * 128 + wc * 32 + 8 * fq;
                *(LAS f32x4*)rp = acc[ai][d][m][0]; *(LAS f32x4*)(rp + 4) = acc[ai][d][m][1]; }
            LDS_WAIT(); __builtin_amdgcn_s_barrier(); asm volatile("" ::: "memory");
            {
                const int p = l_; const float lr = lb16[((u.z * 2 + d) * 64 + p) * 2], li = lb16[((u.z * 2 + d) * 64 + p) * 2 + 1];
                LAS float* SEG = (LAS float*)(lds + XCH_OFF);
                float xr = 0.f, xi = 0.f;
#pragma unroll 8
                for (int i = 0; i < 32; ++i) { const int cc = wid * 32 + i, c = d ? 255 - cc : cc;
                    const float sr = Tl[c * 128 + p], si = Tl[c * 128 + 64 + p];
                    Tl[c * 128 + p] = xr; Tl[c * 128 + 64 + p] = xi;
                    const float nr = lr * xr - li * xi + sr; xi = lr * xi + li * xr + si; xr = nr; }
                SEG[(wid * 64 + p) * 2] = xr; SEG[(wid * 64 + p) * 2 + 1] = xi;
                LDS_WAIT(); __builtin_amdgcn_s_barrier(); asm volatile("" ::: "memory");
                float l32r = lr, l32i = li;
#pragma unroll
                for (int q = 0; q < 5; ++q) { const float t = l32r * l32r - l32i * l32i; l32i = 2.f * l32r * l32i; l32r = t; }
                float er = 0.f, ei = 0.f;
                for (int j = 0; j < wid; ++j) { const float tr = SEG[(j * 64 + p) * 2], ti = SEG[(j * 64 + p) * 2 + 1];
                    const float nr = l32r * er - l32i * ei + tr; ei = l32r * ei + l32i * er + ti; er = nr; }
#pragma unroll 8
                for (int i = 0; i < 32; ++i) { const int cc = wid * 32 + i, c = d ? 255 - cc : cc;
                    const float tr = Tl[c * 128 + p] + er, ti = Tl[c * 128 + 64 + p] + ei;
                    Tl[c * 128 + p] = __uint_as_float(pk2(tr, ti));
                    const float nr = lr * er - li * ei; ei = lr * ei + li * er; er = nr; }
            }
            LDS_WAIT(); __builtin_amdgcn_s_barrier(); asm volatile("" ::: "memory");
            {   bf16_t* ub = UCAT + ((size_t)u.z * NCH + u.pm * 256) * 512 + 256 + d * 128;
#pragma unroll
                for (int i = 0; i < 8; ++i) { const int q = wid * 64 + l_ + 512 * i, r = q >> 4, c8 = (q & 15) * 8;
                    *(u32x4*)(ub + (size_t)r * 512 + c8) = *(const LAS u32x4*)((LAS bf16_t*)(Tl + r * 128) + c8); } }
            LDS_WAIT(); __builtin_amdgcn_s_barrier(); asm volatile("" ::: "memory");
        }
    }
};
struct EpiS2 {
    static constexpr bool AFTER_DRAIN = false;
    bf16_t* YS;
    __device__ __forceinline__ void operator()(const f32x4 (&acc)[2][2][4][2], const Unit& u, int wr, int wc, int, int) const {
        const int l_ = lane_id_opaque(), fr = l_ & 15, fq = l_ >> 4;
        EPI_FOR_ROWS { EPI_ROWDEF
#pragma unroll
            for (int bj = 0; bj < 2; ++bj) { const int c = bj * HALF + wc * 32 + 8 * fq; const int j = c >> 4, h0 = c & 15;
                const f32x4 v0 = acc[ai][bj][m][0], v1 = acc[ai][bj][m][1];
                u32x4 w; w.x = pk2(gelu_tanh(v0[0]), gelu_tanh(v0[1])); w.y = pk2(gelu_tanh(v0[2]), gelu_tanh(v0[3])); w.z = pk2(gelu_tanh(v1[0]), gelu_tanh(v1[1])); w.w = pk2(gelu_tanh(v1[2]), gelu_tanh(v1[3]));
                *(u32x4*)(YS + ((size_t)row * 16 + j) * DSSM + u.z * 16 + h0) = w; } }
    }
};
struct EpiGlu {
    static constexpr bool AFTER_DRAIN = false;
    const float* bglu; const bf16_t* GS; bf16_t* YMIX;
    __device__ __forceinline__ void operator()(const f32x4 (&acc)[2][2][4][2], const Unit& u, int wr, int wc, int, int) const {
        const int l_ = lane_id_opaque(), fr = l_ & 15, fq = l_ >> 4;
        const int a0 = 128 * u.pn + 32 * wc + 8 * fq;
        float bv[8], bg[8];
#pragma unroll
        for (int i = 0; i < 8; ++i) { bv[i] = bglu[a0 + i]; bg[i] = bglu[1024 + a0 + i]; }
        u32x4 gsv[2][4];
        EPI_FOR_ROWS { EPI_ROWDEF gsv[ai][m] = __builtin_nontemporal_load((const u32x4*)(GS + (size_t)row * DSSM + a0)); }
        EPI_FOR_ROWS { EPI_ROWDEF const u32x4 gs = gsv[ai][m];
            float o[8];
#pragma unroll
            for (int n = 0; n < 2; ++n)
#pragma unroll
                for (int e = 0; e < 4; ++e) { const int i = 4 * n + e; o[i] = (acc[ai][0][m][n][e] + bv[i]) * sigmoidf_(acc[ai][1][m][n][e] + bg[i]); }
            o[0] *= bflo(gs.x); o[1] *= bfhi(gs.x); o[2] *= bflo(gs.y); o[3] *= bfhi(gs.y); o[4] *= bflo(gs.z); o[5] *= bfhi(gs.z); o[6] *= bflo(gs.w); o[7] *= bfhi(gs.w);
            u32x4 w; w.x = pk2(o[0], o[1]); w.y = pk2(o[2], o[3]); w.z = pk2(o[4], o[5]); w.w = pk2(o[6], o[7]);
            *(u32x4*)(YMIX + (size_t)row * DM + 1024 + a0) = w; }
    }
};
struct EpiBf {
    static constexpr bool AFTER_DRAIN = false;
    bf16_t* O; int ldc;
    __device__ __forceinline__ void operator()(const f32x4 (&acc)[2][2][4][2], const Unit& u, int wr, int wc, int, int) const {
        const int l_ = lane_id_opaque(), fr = l_ & 15, fq = l_ >> 4;
        EPI_FOR_ROWS { EPI_ROWDEF
#pragma unroll
            for (int bj = 0; bj < 2; ++bj) { const f32x4 v0 = acc[ai][bj][m][0], v1 = acc[ai][bj][m][1];
                u32x4 w; w.x = pk2(v0[0], v0[1]); w.y = pk2(v0[2], v0[3]); w.z = pk2(v1[0], v1[1]); w.w = pk2(v1[2], v1[3]);
                *(u32x4*)(O + (size_t)row * ldc + u.pn * BM + bj * HALF + wc * 32 + 8 * fq) = w; } }
    }
};
struct EpiOut {
    static constexpr bool AFTER_DRAIN = false;
    const float* x; float* H; bf16_t* HB; float* ssq;
    __device__ __forceinline__ void operator()(const f32x4 (&acc)[2][2][4][2], const Unit& u, int wr, int wc, int, int) const {
        const int l_ = lane_id_opaque(), fr = l_ & 15, fq = l_ >> 4;
#pragma unroll
        for (int ai = 0; ai < 2; ++ai) {
            f32x4 xv[4][2][2];
#pragma unroll
            for (int m = 0; m < 4; ++m) { EPI_ROWDEF
#pragma unroll
                for (int bj = 0; bj < 2; ++bj) { const size_t off = (size_t)row * DM + u.pn * BM + bj * HALF + wc * 32 + 8 * fq; xv[m][bj][0] = __builtin_nontemporal_load((const f32x4*)(x + off)); xv[m][bj][1] = __builtin_nontemporal_load((const f32x4*)(x + off + 4)); } }
#pragma unroll
            for (int m = 0; m < 4; ++m) { EPI_ROWDEF float s = 0.f;
#pragma unroll
                for (int bj = 0; bj < 2; ++bj) { const size_t off = (size_t)row * DM + u.pn * BM + bj * HALF + wc * 32 + 8 * fq;
                    const f32x4 v0 = acc[ai][bj][m][0] + xv[m][bj][0], v1 = acc[ai][bj][m][1] + xv[m][bj][1];
                    s += (v0[0] * v0[0] + v0[1] * v0[1]) + (v0[2] * v0[2] + v0[3] * v0[3]) + (v1[0] * v1[0] + v1[1] * v1[1]) + (v1[2] * v1[2] + v1[3] * v1[3]);
                    u32x4 w; w.x = pk2(v0[0], v0[1]); w.y = pk2(v0[2], v0[3]); w.z = pk2(v1[0], v1[1]); w.w = pk2(v1[2], v1[3]);
                    *(u32x4*)(HB + off) = w; }
                s += swz_xor<16>(s); s = sum_xor32(s);
                if (fq == 0) ssq[(size_t)row * 32 + u.pn * 4 + wc] = s; }
        }
    }
};
struct EpiGate {
    static constexpr bool AFTER_DRAIN = true;
    float* H; const bf16_t* PP; float* ssq; unsigned* cnt; const float* nf; const LAS float* r2; const bf16_t* HBr;
    __device__ __forceinline__ void operator()(const f32x4 (&)[2][2][4][2], const Unit&, int, int, int, int) const {}
    __device__ __forceinline__ void fused(f32x4 (&acc)[2][2][4][2], const Unit& u, int wr, int wc, LAS unsigned char* lds, int wid) const {
        const int l_ = lane_id_opaque(), fr = l_ & 15, fq = l_ >> 4, tid = wid * 64 + l_;
        LAS float* P = (LAS float*)lds; LAS float* Rn = P + 1024;
        EPI_FOR_ROWS { EPI_ROWDEF float s = 0.f; const float r = r2[rit];
#pragma unroll
            for (int bj = 0; bj < 2; ++bj) { const size_t off = (size_t)row * DM + u.pn * BM + bj * HALF + wc * 32 + 8 * fq;
                const u32x4 pp = __builtin_nontemporal_load((const u32x4*)(PP + off));
                const u32x4 hb = __builtin_nontemporal_load((const u32x4*)(HBr + off));
                f32x4 h0 = {bflo(hb.x), bfhi(hb.x), bflo(hb.y), bfhi(hb.y)}, h1 = {bflo(hb.z), bfhi(hb.z), bflo(hb.w), bfhi(hb.w)};
                const f32x4 a0 = acc[ai][bj][m][0] * r, a1 = acc[ai][bj][m][1] * r;
                h0[0] += sigmoidf_(a0[0]) * bflo(pp.x); h0[1] += sigmoidf_(a0[1]) * bfhi(pp.x); h0[2] += sigmoidf_(a0[2]) * bflo(pp.y); h0[3] += sigmoidf_(a0[3]) * bfhi(pp.y);
                h1[0] += sigmoidf_(a1[0]) * bflo(pp.z); h1[1] += sigmoidf_(a1[1]) * bfhi(pp.z); h1[2] += sigmoidf_(a1[2]) * bflo(pp.w); h1[3] += sigmoidf_(a1[3]) * bfhi(pp.w);
                acc[ai][bj][m][0] = h0; acc[ai][bj][m][1] = h1;
                s += (h0[0] * h0[0] + h0[1] * h0[1]) + (h0[2] * h0[2] + h0[3] * h0[3]) + (h1[0] * h1[0] + h1[1] * h1[1]) + (h1[2] * h1[2] + h1[3] * h1[3]); }
            s += swz_xor<16>(s); s = sum_xor32(s);
            if (fq == 0) P[rit * 4 + wc] = s; }
        LDS_WAIT(); __builtin_amdgcn_s_barrier(); asm volatile("" ::: "memory");
        if (tid < 256) { const float t = (P[tid * 4] + P[tid * 4 + 1]) + (P[tid * 4 + 2] + P[tid * 4 + 3]);
            __hip_atomic_store(ssq + (size_t)(u.pm * 256 + tid) * 8 + u.pn, t, __ATOMIC_RELAXED, __HIP_MEMORY_SCOPE_AGENT); }
        asm volatile("s_waitcnt vmcnt(0)" ::: "memory");
        if (wid < 4 && l_ == 0) __hip_atomic_fetch_add(cnt + 64 * u.pm, 1u, __ATOMIC_RELAXED, __HIP_MEMORY_SCOPE_AGENT);
        if (wid == 0) {
            unsigned sp = 0;
            while ((unsigned)__builtin_amdgcn_readfirstlane(__hip_atomic_load(cnt + 64 * u.pm, __ATOMIC_RELAXED, __HIP_MEMORY_SCOPE_AGENT)) < 32u) { __builtin_amdgcn_s_sleep(2); if (++sp > (1u << 22)) break; }
            __builtin_amdgcn_fence(__ATOMIC_ACQUIRE, "agent");
        }
        asm volatile("s_waitcnt vmcnt(0) lgkmcnt(0)" ::: "memory"); __builtin_amdgcn_s_barrier(); asm volatile("" ::: "memory");
        if (tid < 256) { const float* sp = ssq + (size_t)(u.pm * 256 + tid) * 8; float t = 0.f;
#pragma unroll
            for (int i = 0; i < 8; ++i) t += __hip_atomic_load(sp + i, __ATOMIC_RELAXED, __HIP_MEMORY_SCOPE_AGENT);
            Rn[tid] = rsqrtf(t * (1.f / DM) + EPS); }
        LDS_WAIT(); __builtin_amdgcn_s_barrier(); asm volatile("" ::: "memory");
        EPI_FOR_ROWS { EPI_ROWDEF const float rn = Rn[rit];
#pragma unroll
            for (int bj = 0; bj < 2; ++bj) { const int col = u.pn * BM + bj * HALF + wc * 32 + 8 * fq; const size_t off = (size_t)row * DM + col;
                *(f32x4*)(H + off) = acc[ai][bj][m][0] * rn * *(const f32x4*)(nf + col); *(f32x4*)(H + off + 4) = acc[ai][bj][m][1] * rn * *(const f32x4*)(nf + col + 4); } }
    }
};
}

namespace att {
constexpr int D = 128, NW = 8, QBLK = 32, KVBLK = 64;
constexpr float SCALE = 0.088388347648318440f;
constexpr float THR = 8.f;
constexpr int LDQ = DATT, LDK = DKV;
constexpr size_t SHM_V = KVBLK * D * 2, SHM_K = KVBLK * D * 2, SHM_ATTN = 2 * SHM_V + 2 * SHM_K + NW * 64 * 4;
#define KSWZ(row, colB) ((row) * 256 + ((colB) ^ (((row) & 7) << 4)))
#define SBAR() __builtin_amdgcn_sched_barrier(0)
__device__ __forceinline__ int crow(int r, int hi) { return (r & 3) + 8 * (r >> 2) + 4 * hi; }
__device__ __forceinline__ void partialSM(f32x16& p0, f32x16& p1, float& m_reg, float& mn, float& alpha) {
  constexpr float C = SCALE * 1.4426950408889634f;
  float pmax = p0[0]; for (int r = 1; r < 16; ++r) pmax = fmaxf(pmax, p0[r]); for (int r = 0; r < 16; ++r) pmax = fmaxf(pmax, p1[r]);
  { auto rr = __builtin_amdgcn_permlane32_swap(__float_as_uint(pmax), __float_as_uint(pmax), false, false);
    pmax = fmaxf(__uint_as_float(rr[0]), __uint_as_float(rr[1])); }
  if (__builtin_expect(__all(pmax - m_reg <= THR / SCALE), 1)) { mn = m_reg; alpha = 1.f; }
  else { mn = fmaxf(m_reg, pmax); alpha = __builtin_amdgcn_exp2f((m_reg - mn) * C); m_reg = mn; }
  float mnC = -mn * C;
  for (int r = 0; r < 16; ++r) p0[r] = fmaf(p0[r], C, mnC); for (int r = 0; r < 16; ++r) p1[r] = fmaf(p1[r], C, mnC);
  for (int r = 0; r < 16; ++r) p0[r] = __builtin_amdgcn_exp2f(p0[r]);
}
__device__ __forceinline__ void finishSM(f32x16& p0, f32x16& p1, float alpha, float& l_reg, bf16x8& pa0, bf16x8& pa1, bf16x8& pa2, bf16x8& pa3) {
  for (int r = 0; r < 16; ++r) p1[r] = __builtin_amdgcn_exp2f(p1[r]);
  float ps = 0; for (int r = 0; r < 16; ++r) ps += p0[r]; for (int r = 0; r < 16; ++r) ps += p1[r];
  { auto rr = __builtin_amdgcn_permlane32_swap(__float_as_uint(ps), __float_as_uint(ps), false, false);
    ps = __uint_as_float(rr[0]) + __uint_as_float(rr[1]); }
  l_reg = l_reg * alpha + ps;
#define PK4(P, BASE, OUT) do { unsigned a0 = cvt_pk_bf16(P[BASE + 0], P[BASE + 1]), a1 = cvt_pk_bf16(P[BASE + 2], P[BASE + 3]);   \
    unsigned b0 = cvt_pk_bf16(P[BASE + 4], P[BASE + 5]), b1 = cvt_pk_bf16(P[BASE + 6], P[BASE + 7]);                              \
    auto r0 = __builtin_amdgcn_permlane32_swap(a0, b0, false, false); auto r1 = __builtin_amdgcn_permlane32_swap(a1, b1, false, false); \
    u32x4 w = {r0[0], r1[0], r0[1], r1[1]}; OUT = *reinterpret_cast<bf16x8*>(&w); } while (0)
  PK4(p0, 0, pa0); PK4(p0, 8, pa1); PK4(p1, 0, pa2); PK4(p1, 8, pa3);
#undef PK4
}
__device__ __forceinline__ void qkt(f32x16& p0, f32x16& p1, const bf16_t* Ks, const bf16x8* qr, int r32, int hi) {
  p0 = f32x16{}; p1 = f32x16{};
  for (int d0 = 0; d0 < 8; ++d0) { int cb = (d0 * 16 + hi * 8) * 2;
    bf16x8 b0 = *reinterpret_cast<const bf16x8*>((const char*)Ks + KSWZ(r32, cb));
    bf16x8 b1 = *reinterpret_cast<const bf16x8*>((const char*)Ks + KSWZ(32 + r32, cb));
    p0 = __builtin_amdgcn_mfma_f32_32x32x16_bf16(b0, qr[d0], p0, 0, 0, 0);
    p1 = __builtin_amdgcn_mfma_f32_32x32x16_bf16(b1, qr[d0], p1, 0, 0, 0); }
}
__device__ __forceinline__ int v_st(int k, int c) { const int kk = (k & ~0xC) | ((k & 4) << 1) | ((k & 8) >> 1); return ((kk >> 3) * 4 + (c >> 5)) * 512 + ((kk & 7) * 32 + (c & 31)) * 2; }
__device__ __forceinline__ int v_rd_base(int lane) { return ((lane & 3) << 3) | (((lane >> 2) & 3) << 6) | (((lane >> 4) & 1) << 5) | (((lane >> 5) & 1) << 8); }
constexpr int v_rd_off(int d0, int ks, int half) { return d0 * 512 + ks * 4096 + half * 2048; }
template <int OFF> __device__ __forceinline__ s16x4 tr_read(int vb) {
  s16x4 r; asm volatile("ds_read_b64_tr_b16 %0, %1 offset:%2" : "=&v"(r) : "v"(vb), "i"(OFF) : "memory"); return r;
}
template <int D0> __device__ __forceinline__ void pv_one(f32x16& od, int vb, bf16x8 pa0, bf16x8 pa1, bf16x8 pa2, bf16x8 pa3) {
  const s16x4 l0 = tr_read<v_rd_off(D0, 0, 0)>(vb), h0 = tr_read<v_rd_off(D0, 0, 1)>(vb), l1 = tr_read<v_rd_off(D0, 1, 0)>(vb), h1 = tr_read<v_rd_off(D0, 1, 1)>(vb);
  const s16x4 l2 = tr_read<v_rd_off(D0, 2, 0)>(vb), h2 = tr_read<v_rd_off(D0, 2, 1)>(vb), l3 = tr_read<v_rd_off(D0, 3, 0)>(vb), h3 = tr_read<v_rd_off(D0, 3, 1)>(vb);
  asm volatile("s_waitcnt lgkmcnt(0)" ::: "memory"); SBAR();
#define PK(L, H) (bf16x8){L[0], L[1], L[2], L[3], H[0], H[1], H[2], H[3]}
  od = __builtin_amdgcn_mfma_f32_32x32x16_bf16(pa0, PK(l0, h0), od, 0, 0, 0);
  od = __builtin_amdgcn_mfma_f32_32x32x16_bf16(pa1, PK(l1, h1), od, 0, 0, 0);
  od = __builtin_amdgcn_mfma_f32_32x32x16_bf16(pa2, PK(l2, h2), od, 0, 0, 0);
  od = __builtin_amdgcn_mfma_f32_32x32x16_bf16(pa3, PK(l3, h3), od, 0, 0, 0);
#undef PK
}
__device__ __forceinline__ void pv_d0(f32x16* o, int vb, bf16x8 pa0, bf16x8 pa1, bf16x8 pa2, bf16x8 pa3) {
  pv_one<0>(o[0], vb, pa0, pa1, pa2, pa3); pv_one<1>(o[1], vb, pa0, pa1, pa2, pa3); pv_one<2>(o[2], vb, pa0, pa1, pa2, pa3); pv_one<3>(o[3], vb, pa0, pa1, pa2, pa3);
}
__device__ __forceinline__ void attn_dense_body(const bf16_t* __restrict__ Qb, const bf16_t* __restrict__ Kh, const bf16_t* __restrict__ Vh,
                                                const bf16_t* __restrict__ Gb, bf16_t* __restrict__ Yb, int seq, char* lds, const int wid) {
  const int lane = lane_id_opaque(), tid = wid * 64 + lane, r32 = lane & 31, hi = lane >> 5;
  bf16_t* V_lds = (bf16_t*)lds; bf16_t* K_lds = (bf16_t*)(lds + 2 * SHM_V);
  float* ws = (float*)(lds + 2 * SHM_V + 2 * SHM_K) + wid * 64; float* li_l = ws; float* al_l = ws + 32;
  float m_reg = -1e30f, l_reg = 0; f32x16 o[4] = {}; bf16x8 qr[8];
  const bf16_t* Qw = Qb + (long)(wid * QBLK + r32) * LDQ + hi * 8;
#pragma unroll
  for (int d0 = 0; d0 < 8; ++d0) qr[d0] = __builtin_nontemporal_load(reinterpret_cast<const bf16x8*>(Qw + d0 * 16));
  const int sr = tid >> 4, sc = (tid & 15) * 8, vst0 = v_st(sr, sc), vst1 = v_st(32 + sr, sc);
  const int vb0 = (int)(uintptr_t)V_lds + v_rd_base(lane);
  struct { bf16x8 vs0, vs1, ks0, ks1; } sr_[2];
#define SLOAD(i, k0) do { sr_[i].vs0 = *reinterpret_cast<const bf16x8*>(&Vh[(long)((k0) + sr) * LDK + sc]); sr_[i].vs1 = *reinterpret_cast<const bf16x8*>(&Vh[(long)((k0) + 32 + sr) * LDK + sc]); \
    sr_[i].ks0 = *reinterpret_cast<const bf16x8*>(&Kh[(long)((k0) + sr) * LDK + sc]); sr_[i].ks1 = *reinterpret_cast<const bf16x8*>(&Kh[(long)((k0) + 32 + sr) * LDK + sc]); } while (0)
#define SWRITE(b, i) do { *(bf16x8*)((char*)V_lds + (b) * SHM_V + vst0) = sr_[i].vs0;          \
    *(bf16x8*)((char*)V_lds + (b) * SHM_V + vst1) = sr_[i].vs1; int kc = sc * 2;               \
    *(bf16x8*)((char*)K_lds + (b) * SHM_K + KSWZ(sr, kc)) = sr_[i].ks0;                       \
    *(bf16x8*)((char*)K_lds + (b) * SHM_K + KSWZ(32 + sr, kc)) = sr_[i].ks1; } while (0)
#define SWAIT() asm volatile("s_waitcnt vmcnt(4)" ::: "memory")
#define RESC(a) do { if (__any((a) < 1.f)) { if (hi == 0) al_l[r32] = (a); asm volatile("s_waitcnt lgkmcnt(0)" ::: "memory"); \
    for (int d = 0; d < 4; ++d) for (int r = 0; r < 16; ++r) o[d][r] *= al_l[crow(r, hi)]; } } while (0)
  f32x16 pA0, pA1, pB0, pB1; float mnA, mnB, alA, alB; bf16x8 pa0, pa1, pa2, pa3; const int NT = seq / KVBLK;
  constexpr int SE = 0, SO = 1;
  SLOAD(SE, 0); asm volatile("s_waitcnt vmcnt(0)" ::: "memory"); SWRITE(0, SE); __syncthreads();
  qkt(pA0, pA1, K_lds, qr, r32, hi); partialSM(pA0, pA1, m_reg, mnA, alA);
  SLOAD(SO, KVBLK); if (2 < NT) SLOAD(SE, 2 * KVBLK);
  SWAIT(); SWRITE(1, SO); __syncthreads();
  for (int j = 1; j + 1 < NT; j += 2) {
    SBAR(); qkt(pB0, pB1, (bf16_t*)((char*)K_lds + SHM_K), qr, r32, hi);
    finishSM(pA0, pA1, alA, l_reg, pa0, pa1, pa2, pa3); SBAR();
    SLOAD(SO, (j + 2) * KVBLK); SBAR();
    pv_d0(o, vb0, pa0, pa1, pa2, pa3); partialSM(pB0, pB1, m_reg, mnB, alB);
    __syncthreads(); SWAIT(); SWRITE(0, SE);
    RESC(alB); __syncthreads();
    SBAR(); qkt(pA0, pA1, K_lds, qr, r32, hi);
    finishSM(pB0, pB1, alB, l_reg, pa0, pa1, pa2, pa3); SBAR();
    if (j + 3 < NT) SLOAD(SE, (j + 3) * KVBLK); SBAR();
    pv_d0(o, vb0 + (int)SHM_V, pa0, pa1, pa2, pa3); partialSM(pA0, pA1, m_reg, mnA, alA);
    __syncthreads(); SWAIT(); SWRITE(1, SO);
    RESC(alA); __syncthreads();
  }
  SBAR(); qkt(pB0, pB1, (bf16_t*)((char*)K_lds + SHM_K), qr, r32, hi);
  finishSM(pA0, pA1, alA, l_reg, pa0, pa1, pa2, pa3); SBAR();
  pv_d0(o, vb0, pa0, pa1, pa2, pa3); partialSM(pB0, pB1, m_reg, mnB, alB);
  __syncthreads(); RESC(alB);
  finishSM(pB0, pB1, alB, l_reg, pa0, pa1, pa2, pa3); SBAR();
  pv_d0(o, vb0 + (int)SHM_V, pa0, pa1, pa2, pa3);
  if (hi == 0) li_l[r32] = l_reg; asm volatile("s_waitcnt lgkmcnt(0)" ::: "memory");
  float rli[16];
#pragma unroll
  for (int r = 0; r < 16; ++r) rli[r] = __builtin_amdgcn_rcpf(li_l[crow(r, hi)]);
  bf16_t* Yw = Yb + (long)(wid * QBLK) * DM; const bf16_t* Gw = Gb + (long)(wid * QBLK) * DATT;
  __syncthreads();
  bf16_t* stg = (bf16_t*)(lds + wid * 8192);
#pragma unroll
  for (int r = 0; r < 16; ++r) { const int orow = crow(r, hi);
#pragma unroll
    for (int d0 = 0; d0 < 4; ++d0) stg[orow * 128 + d0 * 32 + r32] = (bf16_t)f2bf(o[d0][r] * rli[r]); }
  asm volatile("s_waitcnt lgkmcnt(0)" ::: "memory");
  const int l2 = lane_id_opaque();
#pragma unroll
  for (int i = 0; i < 8; ++i) { const int q = l2 + 64 * i, row = q >> 4, c8 = (q & 15) * 8;
    const u32x4 v = *(const u32x4*)(stg + row * 128 + c8); const u32x4 gg = __builtin_nontemporal_load((const u32x4*)(Gw + (unsigned)(row * DATT + c8)));
    u32x4 w; w.x = pk2(bflo(v.x) * bflo(gg.x), bfhi(v.x) * bfhi(gg.x)); w.y = pk2(bflo(v.y) * bflo(gg.y), bfhi(v.y) * bfhi(gg.y));
    w.z = pk2(bflo(v.z) * bflo(gg.z), bfhi(v.z) * bfhi(gg.z)); w.w = pk2(bflo(v.w) * bflo(gg.w), bfhi(v.w) * bfhi(gg.w));
    *(u32x4*)(Yw + (unsigned)(row * DM + c8)) = w; }
  __syncthreads();
#undef SLOAD
#undef SWRITE
#undef SWAIT
#undef RESC
}
#undef SBAR
}

__device__ __forceinline__ void p0_transpose_item(const float* W, int K, int N, bf16_t* WT, int wt_row0, const float* kscale, LAS float* scr, int k0, int n0, int lane) {
#pragma unroll
    for (int i = 0; i < 32; ++i) { const int kk = 2 * i + (lane >> 5); float v = W[(size_t)(k0 + kk) * N + n0 + (lane & 31)]; if (kscale) v *= kscale[k0 + kk]; scr[kk * 33 + (lane & 31)] = v; }
    LDS_WAIT(); asm volatile("" ::: "memory");
    const int c = lane & 7;
#pragma unroll
    for (int j = 0; j < 4; ++j) { const int n = (lane >> 3) + 8 * j; const LAS float* s = scr + (8 * c) * 33 + n;
        u32x4 o; o.x = pk2(s[0 * 33], s[1 * 33]); o.y = pk2(s[2 * 33], s[3 * 33]); o.z = pk2(s[4 * 33], s[5 * 33]); o.w = pk2(s[6 * 33], s[7 * 33]);
        *(u32x4*)(WT + (size_t)(wt_row0 + n) * K + k0 + 8 * c) = o; }
    LDS_WAIT(); asm volatile("" ::: "memory");
}

struct TrItem { const float* W; bf16_t* WT; const float* kscale; int K, N, wt_row0, k0, n0; };
__device__ __forceinline__ void p0_tr_load(const TrItem& d, float (&v)[32], int lane) {
#pragma unroll
    for (int i = 0; i < 32; ++i) { const int kk = 2 * i + (lane >> 5); v[i] = __builtin_nontemporal_load(d.W + (size_t)(d.k0 + kk) * d.N + d.n0 + (lane & 31)); }
    if (d.kscale) {
#pragma unroll
        for (int i = 0; i < 32; ++i) { const int kk = 2 * i + (lane >> 5); v[i] *= d.kscale[d.k0 + kk]; } }
}
__device__ __forceinline__ void p0_tr_store(const TrItem& d, const float (&v)[32], LAS float* scr, int lane) {
#pragma unroll
    for (int i = 0; i < 32; ++i) { const int kk = 2 * i + (lane >> 5); scr[kk * 33 + (lane & 31)] = v[i]; }
    LDS_WAIT(); asm volatile("" ::: "memory");
    const int c = lane & 7;
#pragma unroll
    for (int j = 0; j < 4; ++j) { const int n = (lane >> 3) + 8 * j; const LAS float* s = scr + (8 * c) * 33 + n;
        u32x4 o; o.x = pk2(s[0 * 33], s[1 * 33]); o.y = pk2(s[2 * 33], s[3 * 33]); o.z = pk2(s[4 * 33], s[5 * 33]); o.w = pk2(s[6 * 33], s[7 * 33]);
        *(u32x4*)(d.WT + (size_t)(d.wt_row0 + n) * d.K + d.k0 + 8 * c) = o; }
    LDS_WAIT(); asm volatile("" ::: "memory");
}
__device__ __forceinline__ void ssm_tables(const Args& a, int g, LAS unsigned char* lds, int tid) {
    LAS float* LD = (LAS float*)lds;
    LAS float* LBs = LD + 256;
    LAS float* BB = LBs + 256;
    LAS float* KT = BB + 4096;
    LAS float* CC = KT + 8192;
    float* lb16 = (float*)(a.ws + WS_LB16);
    bf16_t* WIN = (bf16_t*)(a.ws + WS_WIN) + (size_t)g * 256 * 256;
    bf16_t* WBIG = (bf16_t*)(a.ws + WS_WBIG) + (size_t)g * 256 * 512;
    for (int e = tid; e < 2048; e += 512) { const int d = e >> 10, r = e & 1023; const size_t ci_ = (size_t)(d * NG + g) * 1024 + r; CC[e * 2] = a.c_re[ci_]; CC[e * 2 + 1] = a.c_im[ci_]; }
    if (tid < 128) {
        const int d = tid >> 6, p = tid & 63; const int idx = (d * NG + g) * 64 + p;
        const float lr = fminf(a.a_re[idx], -1e-4f), li = a.a_im[idx];
        const float dt = expf(a.log_dt[d * NG + g]);
        const float er = expf(lr * dt); float sn, cs; sincosf(li * dt, &sn, &cs);
        const float br = er * cs, bi = er * sn;
        LD[tid * 2] = lr * dt; LD[tid * 2 + 1] = li * dt; LBs[tid * 2] = br; LBs[tid * 2 + 1] = bi;
        const float nr = br - 1.f, ni = bi, den = lr * lr + li * li;
        KT[tid * 2] = (nr * lr + ni * li) / den; KT[tid * 2 + 1] = (ni * lr - nr * li) / den;
        const float e16 = expf(16.f * lr * dt); float s16, c16; sincosf(16.f * li * dt, &s16, &c16);
        lb16[(g * 128 + tid) * 2] = e16 * c16; lb16[(g * 128 + tid) * 2 + 1] = e16 * s16;
    }
    __syncthreads();
    for (int e = tid; e < 2048; e += 512) {
        const int dp = e >> 4, h = e & 15, d = dp >> 6, p = dp & 63;
        const size_t bi_ = ((size_t)(d * NG + g) * 64 + p) * 16 + h;
        const float xr = a.b_re[bi_], xi = a.b_im[bi_], cr = KT[dp * 2], ci = KT[dp * 2 + 1];
        BB[e * 2] = cr * xr - ci * xi; BB[e * 2 + 1] = cr * xi + ci * xr;
    }
    __syncthreads();
    {
        const int d = tid >> 8, hp = (tid >> 4) & 15, h = tid & 15; float acc[16];
#pragma unroll
        for (int t = 0; t < 16; ++t) acc[t] = 0.f;
        const LAS float* cc = CC + ((d * 16 + hp) * 64) * 2;
#pragma unroll 4
        for (int p = 0; p < 64; ++p) {
            const float c_r = cc[p * 2], c_i = cc[p * 2 + 1], b_r = BB[((d * 64 + p) * 16 + h) * 2], b_i = BB[((d * 64 + p) * 16 + h) * 2 + 1];
            float wr = c_r * b_r - c_i * b_i, wi = c_r * b_i + c_i * b_r; const float l_r = LBs[(d * 64 + p) * 2], l_i = LBs[(d * 64 + p) * 2 + 1];
#pragma unroll
            for (int t = 0; t < 16; ++t) { acc[t] += wr; const float nr = wr * l_r - wi * l_i; wi = wr * l_i + wi * l_r; wr = nr; }
        }
#pragma unroll
        for (int t = 0; t < 16; ++t) KT[((d * 16 + t) * 16 + hp) * 16 + h] = acc[t];
    }
    __syncthreads();
    for (int q = tid; q < 8192; q += 512) {
        const int n = q >> 5, kc = q & 31, s = kc >> 1, h0 = (kc & 1) * 8, j = n >> 4, hp = n & 15;
        const int dsel = s < j ? 0 : 1, tau = s < j ? j - s : s - j;
        const LAS float* k0 = KT + ((dsel * 16 + tau) * 16 + hp) * 16 + h0;
        const LAS float* kf = KT + ((0 * 16 + 0) * 16 + hp) * 16 + h0; const LAS float* kb = KT + ((1 * 16 + 0) * 16 + hp) * 16 + h0;
        const bool diag = (s == j); const float dval = a.ssm_d[g * 16 + hp];
        float v[8];
#pragma unroll
        for (int e = 0; e < 8; ++e) { const float off = k0[e], dg = kf[e] + kb[e] + ((h0 + e) == hp ? dval : 0.f); v[e] = diag ? dg : off; }
        u32x4 w; w.x = pk2(v[0], v[1]); w.y = pk2(v[2], v[3]); w.z = pk2(v[4], v[5]); w.w = pk2(v[6], v[7]);
        *(u32x4*)(WBIG + (size_t)n * 512 + s * 16 + h0) = w;
    }
    for (int q = tid; q < 2048; q += 512) {
        const int p = q & 63, js = (q >> 6) & 15, d = q >> 10; const float ldr = LD[(d * 64 + p) * 2], ldi = LD[(d * 64 + p) * 2 + 1];
        {   const float pw = (float)(d == 0 ? js + 1 : 16 - js); const float er = __expf(pw * ldr); float sn, cs; __sincosf(pw * ldi, &sn, &cs); const float pr = er * cs, pi = er * sn;
#pragma unroll
            for (int hp = 0; hp < 16; ++hp) { const float c_r = CC[((d * 16 + hp) * 64 + p) * 2], c_i = CC[((d * 16 + hp) * 64 + p) * 2 + 1];
                *(unsigned*)(WBIG + (size_t)(js * 16 + hp) * 512 + 256 + d * 128 + 2 * p) = pk2(c_r * pr - c_i * pi, -(c_r * pi + c_i * pr)); } }
        {   const float pw = (float)(d == 0 ? 15 - js : js); const float er = __expf(pw * ldr); float sn, cs; __sincosf(pw * ldi, &sn, &cs); const float pr = er * cs, pi = er * sn;
            float zr[16], zi[16];
#pragma unroll
            for (int h = 0; h < 16; ++h) { const float b_r = BB[((d * 64 + p) * 16 + h) * 2], b_i = BB[((d * 64 + p) * 16 + h) * 2 + 1]; zr[h] = pr * b_r - pi * b_i; zi[h] = pr * b_i + pi * b_r; }
            bf16_t* d0 = WIN + (size_t)(d * 128 + p) * 256 + js * 16; bf16_t* d1 = d0 + (size_t)64 * 256;
            u32x4 w; w.x = pk2(zr[0], zr[1]); w.y = pk2(zr[2], zr[3]); w.z = pk2(zr[4], zr[5]); w.w = pk2(zr[6], zr[7]); *(u32x4*)d0 = w;
            w.x = pk2(zr[8], zr[9]); w.y = pk2(zr[10], zr[11]); w.z = pk2(zr[12], zr[13]); w.w = pk2(zr[14], zr[15]); *(u32x4*)(d0 + 8) = w;
            w.x = pk2(zi[0], zi[1]); w.y = pk2(zi[2], zi[3]); w.z = pk2(zi[4], zi[5]); w.w = pk2(zi[6], zi[7]); *(u32x4*)d1 = w;
            w.x = pk2(zi[8], zi[9]); w.y = pk2(zi[10], zi[11]); w.z = pk2(zi[12], zi[13]); w.w = pk2(zi[14], zi[15]); *(u32x4*)(d1 + 8) = w; }
    }
    __syncthreads();
}

#define XB_TMO      128
#define XB_XCNT(j)  (256  + 64 * (j))
#define XB_XSUB(j)  (1280 + 64 * (j))
#define XB_XGEN(j)  (2304 + 64 * (j))
#define XB_TOP      3328
#define XB_TOPGEN   3392
#define XCD_BAR_WORDS 3456
#define XB_SPIN_CAP (1u << 18)
__device__ __forceinline__ unsigned xb_ld(unsigned* p)              { return __hip_atomic_load(p, __ATOMIC_RELAXED, __HIP_MEMORY_SCOPE_AGENT); }
__device__ __forceinline__ unsigned xb_add(unsigned* p, unsigned v) { return __hip_atomic_fetch_add(p, v, __ATOMIC_RELAXED, __HIP_MEMORY_SCOPE_AGENT); }
__device__ __forceinline__ unsigned xb_xcc_id() { return (unsigned)__builtin_amdgcn_s_getreg((3 << 11) | 20) & 0xFu; }
#define XB_SPIN(cond, bar) do { unsigned _sp = 0; while (cond) { __builtin_amdgcn_s_sleep(1); \
    if ((++_sp & 255u) == 0u) { if (xb_ld(&(bar)[XB_TMO])) break; if (_sp > XB_SPIN_CAP) { atomicAdd(&(bar)[XB_TMO], 1u); break; } } } } while (0)
struct XcdBarrier { unsigned* bar; unsigned x; volatile LAS unsigned* st; };
__device__ __forceinline__ XcdBarrier xcd_barrier_post(unsigned* bar, volatile LAS unsigned* st, bool leader) {
    XcdBarrier b; b.bar = bar; b.x = xb_xcc_id(); b.st = st;
    if (leader) (void)xb_add(&bar[XB_XCNT(b.x)], 1u);
    return b;
}
__device__ __forceinline__ void xcd_barrier_complete(unsigned* bar, unsigned x, unsigned& nloc, unsigned& nx) {
    const unsigned G = gridDim.x * gridDim.y * gridDim.z;
    unsigned sum, cnt, mine, sp = 0u;
    for (;;) {
        sum = 0u; cnt = 0u; mine = 0u;
#pragma unroll
        for (unsigned j = 0; j < 16; ++j) { const unsigned c = xb_ld(&bar[XB_XCNT(j)]); sum += c; cnt += (c > 0u) ? 1u : 0u; mine = (j == x) ? c : mine; }
        if (sum == G) break;
        __builtin_amdgcn_s_sleep(1);
        if ((++sp & 255u) == 0u) { if (xb_ld(&bar[XB_TMO])) break; if (sp > XB_SPIN_CAP) { atomicAdd(&bar[XB_TMO], 1u); break; } }
    }
    nloc = mine > 0u ? mine : 1u; nx = cnt > 0u ? cnt : 1u;
}
__device__ __forceinline__ void xcd_barrier(const XcdBarrier& b, bool leader) {
    asm volatile("s_waitcnt vmcnt(0)" ::: "memory");
    __syncthreads();
    if (leader) {
        unsigned* bar = b.bar;
        __builtin_amdgcn_s_waitcnt(0);
        unsigned nloc = b.st[0], nx = b.st[1];
        if (nloc == 0u) { xcd_barrier_complete(bar, b.x, nloc, nx); b.st[0] = nloc; b.st[1] = nx; }
        const unsigned old = xb_add(&bar[XB_XSUB(b.x)], 1u);
        const unsigned gen = old / nloc;
        if (old + 1u == (gen + 1u) * nloc) {
            __builtin_amdgcn_fence(__ATOMIC_RELEASE, "agent");
            asm volatile("s_waitcnt vmcnt(0)" ::: "memory");
            const unsigned og = xb_add(&bar[XB_TOP], 1u);
            const unsigned tg = og / nx;
            if (og + 1u == (tg + 1u) * nx) xb_add(&bar[XB_TOPGEN], 1u);
            else XB_SPIN(xb_ld(&bar[XB_TOPGEN]) == tg, bar);
            __builtin_amdgcn_fence(__ATOMIC_ACQUIRE, "agent");
            xb_add(&bar[XB_XGEN(b.x)], 1u);
            asm volatile("s_waitcnt vmcnt(0)" ::: "memory");
        } else {
            XB_SPIN(xb_ld(&bar[XB_XGEN(b.x)]) == gen, bar);
            __builtin_amdgcn_fence(__ATOMIC_ACQUIRE, "agent");
            asm volatile("s_waitcnt vmcnt(0)" ::: "memory");
        }
    }
    __syncthreads();
}

__device__ __forceinline__ void xcd_barrier_arrive(const XcdBarrier& b, bool leader) {
    asm volatile("s_waitcnt vmcnt(0)" ::: "memory");
    __syncthreads();
    if (leader) {
        unsigned* bar = b.bar;
        __builtin_amdgcn_s_waitcnt(0);
        unsigned nloc = b.st[0], nx = b.st[1];
        if (nloc == 0u) { xcd_barrier_complete(bar, b.x, nloc, nx); b.st[0] = nloc; b.st[1] = nx; }
        const unsigned old = xb_add(&bar[XB_XSUB(b.x)], 1u);
        const unsigned gen = old / nloc;
        if (old + 1u == (gen + 1u) * nloc) {
            __builtin_amdgcn_fence(__ATOMIC_RELEASE, "agent");
            asm volatile("s_waitcnt vmcnt(0)" ::: "memory");
            const unsigned og = xb_add(&bar[XB_TOP], 1u);
            const unsigned tg = og / nx;
            if (og + 1u == (tg + 1u) * nx) { xb_add(&bar[XB_TOPGEN], 1u); b.st[5] = 3u; } else b.st[5] = 2u;
            b.st[6] = tg;
        } else { b.st[5] = 1u; b.st[6] = gen; }
    }
}
__device__ __forceinline__ void xcd_barrier_wait(const XcdBarrier& b, bool leader) {
    if (leader) {
        unsigned* bar = b.bar; const unsigned role = b.st[5], g = b.st[6];
        if (role >= 2u) {
            if (role == 2u) XB_SPIN(xb_ld(&bar[XB_TOPGEN]) == g, bar);
            __builtin_amdgcn_fence(__ATOMIC_ACQUIRE, "agent");
            xb_add(&bar[XB_XGEN(b.x)], 1u);
            asm volatile("s_waitcnt vmcnt(0)" ::: "memory");
        } else {
            XB_SPIN(xb_ld(&bar[XB_XGEN(b.x)]) == g, bar);
            __builtin_amdgcn_fence(__ATOMIC_ACQUIRE, "agent");
            asm volatile("s_waitcnt vmcnt(0)" ::: "memory");
        }
    }
    __syncthreads();
}

__global__ void __launch_bounds__(512, 2) fwd_kernel(Args a) {
    extern __shared__ __attribute__((aligned(16))) unsigned char lds_raw[];
    LAS unsigned char* lds = (LAS unsigned char*)lds_raw;
    cg::grid_group grid = cg::this_grid();
    const int wave = __builtin_amdgcn_readfirstlane(threadIdx.x >> 6);
    const bool leader = (wave == 0) && (lane_id_opaque() == 0);
    volatile LAS unsigned* xst = (volatile LAS unsigned*)(lds + XBST_OFF);
    if (leader) { xst[0] = 0u; xst[1] = 0u; }
    __syncthreads();
    if (a.ws == nullptr) grid.sync();
    const XcdBarrier xbar = xcd_barrier_post((unsigned*)(a.ws + WS_BAR), xst, leader);
#define GRID_SYNC() xcd_barrier(xbar, (wave == 0) && (lane_id_opaque() == 0))
#define LANE_IDS const int lane = lane_id_opaque(), tid = wave * 64 + lane; (void)tid;
    const int G = gridDim.x, bid = blockIdx.x;
    unsigned char* ws = a.ws;
    bf16_t* W1T = (bf16_t*)(ws + WS_W1T); bf16_t* WGLUT = (bf16_t*)(ws + WS_WGLUT); bf16_t* WOT = (bf16_t*)(ws + WS_WOT); bf16_t* WGT = (bf16_t*)(ws + WS_WGT); bf16_t* WPT = (bf16_t*)(ws + WS_WPT);
    float2* ROPE = (float2*)(ws + WS_ROPE); float* RINV = (float*)(ws + WS_RINV); float* LB16 = (float*)(ws + WS_LB16); float* SSQ1 = (float*)(ws + WS_SSQ1); float* SSQ2 = (float*)(ws + WS_SSQ2);
    bf16_t* PB = (bf16_t*)(ws + WS_PB); bf16_t* WIN = (bf16_t*)(ws + WS_WIN); bf16_t* WBIG = (bf16_t*)(ws + WS_WBIG);
    bf16_t* XB = (bf16_t*)(ws + WS_XB); bf16_t* HB = (bf16_t*)(ws + WS_XB);
    bf16_t* Q = (bf16_t*)(ws + WS_Q); bf16_t* KB = (bf16_t*)(ws + WS_K); bf16_t* VB = (bf16_t*)(ws + WS_V); bf16_t* GA = (bf16_t*)(ws + WS_GA); bf16_t* GS = (bf16_t*)(ws + WS_GS);
    bf16_t* UCAT = (bf16_t*)(ws + WS_UCAT); bf16_t* PPB = (bf16_t*)(ws + WS_UCAT); bf16_t* YMIX = (bf16_t*)(ws + WS_YMIX); bf16_t* YS = (bf16_t*)(ws + WS_YS);

#pragma unroll
    for (int rep_ = 0; rep_ < 1 + ((REP_MASK >> 0) & 1); ++rep_) { LANE_IDS
        const int gw = bid * 8 + wave, NGW = G * 8;
        LAS float* scr = (LAS float*)(lds + wave * 16384);
        constexpr int I1 = 32 * 144, I2 = 16 * 64, I3 = 32 * 64, I4 = 32 * 64, I5 = 4 * 64, NIT = I1 + I2 + I3 + I4 + I5;
        auto item_desc = [&](int r) -> TrItem {
            if (r < I1) { const int kb = r / 144, lgg = r % 144, pn = lgg >> 3, lg = lgg & 7, wtg = pn * 8 + 4 * (lg & 1) + 2 * (lg >> 2) + ((lg >> 1) & 1);
                return TrItem{a.w_in, W1T, a.norm_mix, DM, DIN, wtg * 32, kb * 64, lgg * 32}; } r -= I1;
            if (r < I2) { const int kb = r / 64, lgg = r % 64, l2 = lgg & 31, wtg = (l2 >> 2) * 8 + 4 * (lgg >> 5) + (l2 & 3);
                return TrItem{a.w_glu, WGLUT, nullptr, DSSM, 2 * DSSM, wtg * 32, kb * 64, lgg * 32}; } r -= I2;
            if (r < I3) { const int kb = r / 64, lgg = r % 64; return TrItem{a.w_out, WOT, nullptr, DM, DM, lgg * 32, kb * 64, lgg * 32}; } r -= I3;
            if (r < I4) { const int kb = r / 64, lgg = r % 64; return TrItem{a.w_ple_gate, WGT, a.norm_ple, DM, DM, lgg * 32, kb * 64, lgg * 32}; } r -= I4;
            const int kb = r / 64, lgg = r % 64; return TrItem{a.w_ple_proj, WPT, nullptr, PLE, DM, lgg * 32, kb * 64, lgg * 32};
        };
#pragma unroll
        for (int rq_ = 0; rq_ < 1 + ((REP_MASK >> 8) & 1); ++rq_)
        for (int it = gw; it < I1; it += 2 * NGW) {
            const bool two = it + NGW < I1;
            const TrItem dA = item_desc(it), dB = item_desc(two ? it + NGW : it);
            float vA[32], vB[32];
            p0_tr_load(dA, vA, lane); if (two) p0_tr_load(dB, vB, lane);
            p0_tr_store(dA, vA, scr, lane); if (two) p0_tr_store(dB, vB, scr, lane);
        }
#pragma unroll
        for (int rq_ = 0; rq_ < 1 + ((REP_MASK >> 9) & 1); ++rq_)
        for (int m = gw; m < T; m += 2 * NGW) {
            const int m2 = m + NGW; const bool two = m2 < T;
            const f32x4* xr = (const f32x4*)(a.x + (size_t)m * DM) + lane; const f32x4* xr2 = (const f32x4*)(a.x + (size_t)(two ? m2 : m) * DM) + lane;
            f32x4 v[8], w2[8]; float s = 0.f, s2 = 0.f;
#pragma unroll
            for (int j = 0; j < 8; ++j) v[j] = __builtin_nontemporal_load(xr + 64 * j);
#pragma unroll
            for (int j = 0; j < 8; ++j) w2[j] = __builtin_nontemporal_load(xr2 + 64 * j);
#pragma unroll
            for (int j = 0; j < 8; ++j) { s += (v[j][0] * v[j][0] + v[j][1] * v[j][1]) + (v[j][2] * v[j][2] + v[j][3] * v[j][3]); s2 += (w2[j][0] * w2[j][0] + w2[j][1] * w2[j][1]) + (w2[j][2] * w2[j][2] + w2[j][3] * w2[j][3]); }
            s = wave_sum(s); s2 = wave_sum(s2);
            if (lane == 0) { RINV[m] = rsqrtf(s * (1.f / DM) + EPS); if (two) RINV[m2] = rsqrtf(s2 * (1.f / DM) + EPS); }
            u32x2* o = (u32x2*)(XB + (size_t)m * DM) + lane; u32x2* o2 = (u32x2*)(XB + (size_t)m2 * DM) + lane;
#pragma unroll
            for (int j = 0; j < 8; ++j) { u32x2 w; w.x = pk2(v[j][0], v[j][1]); w.y = pk2(v[j][2], v[j][3]); o[64 * j] = w; }
            if (two) {
#pragma unroll
                for (int j = 0; j < 8; ++j) { u32x2 w; w.x = pk2(w2[j][0], w2[j][1]); w.y = pk2(w2[j][2], w2[j][3]); o2[64 * j] = w; } }
        }
        for (int i = bid * 512 + tid; i < T * PLE / 4; i += G * 512) { const f32x4 v = __builtin_nontemporal_load((const f32x4*)a.p + i); u32x2 w; w.x = pk2(v[0], v[1]); w.y = pk2(v[2], v[3]); ((u32x2*)PB)[i] = w; }
        for (int i = bid * 512 + tid; i < 2048; i += G * 512) { const int pos = i >> 5, f = i & 31; const float inv = powf(10000.f, -(float)f / 32.f); float sn, cs; sincosf((float)pos * inv, &sn, &cs); ROPE[i] = make_float2(cs, sn); }
        xcd_barrier_arrive(xbar, (wave == 0) && (lane_id_opaque() == 0));
        for (int it = I1 + gw; it < NIT; it += 2 * NGW) {
            const bool two = it + NGW < NIT;
            const TrItem dA = item_desc(it), dB = item_desc(two ? it + NGW : it);
            float vA[32], vB[32];
            p0_tr_load(dA, vA, lane); if (two) p0_tr_load(dB, vB, lane);
            p0_tr_store(dA, vA, scr, lane); if (two) p0_tr_store(dB, vB, scr, lane);
        }
        xcd_barrier_wait(xbar, (wave == 0) && (lane_id_opaque() == 0)); }


    if constexpr ((REP_MASK >> 10) & 1) { GRID_SYNC(); GRID_SYNC(); GRID_SYNC(); GRID_SYNC(); }
#pragma unroll
    for (int rep_ = 0; rep_ < 1 + ((REP_MASK >> 1) & 1); ++rep_) { LANE_IDS
        { pg8::Gemm g{XB, W1T, DM, DM, DM, 0, 0}; pg8::StaticOrder S; S.init(T, 14 * 256, G, bid);
          pg8::Epi1 E{RINV, a.q_norm, a.k_norm, ROPE, Q, KB, VB, GA, GS, UCAT, (LAS float*)(lds + XCH_OFF), 0};
          pg8::gemm_phase<pg8::Epi1, pg8::StaticOrder, true>(lds, g, S, E, wave); }
        __syncthreads();
        for (int gi = bid - (G - NG); gi >= 0 && gi < NG; gi += NG) ssm_tables(a, gi, lds, tid);
    GRID_SYNC(); }

#pragma unroll
    for (int rep_ = 0; rep_ < 1 + ((REP_MASK >> 2) & 1); ++rep_) {
#pragma unroll
        for (int rq_ = 0; rq_ < 2; ++rq_) {
        if (bid < 2 * NG) { if (rq_ == 1 && !((REP_MASK >> 6) & 1)) break;
            pg8::BatchOrder S{2 * NG, G, bid};
            { pg8::Gemm g{UCAT, WIN, 256, 512, 256, (size_t)NCH * 512 * 2, (size_t)256 * 256 * 2};
              pg8::EpiS1 E{LB16, UCAT}; pg8::gemm_phase<pg8::EpiS1, pg8::BatchOrder, true>(lds, g, S, E, wave); }
            asm volatile("s_waitcnt vmcnt(0)\n\tbuffer_inv sc1\n\ts_waitcnt vmcnt(0)" ::: "memory"); __syncthreads();
            { pg8::Gemm g{UCAT, WBIG, 512, 512, 512, (size_t)NCH * 512 * 2, (size_t)256 * 512 * 2};
              pg8::EpiS2 E{YS}; pg8::gemm_phase<pg8::EpiS2, pg8::BatchOrder, true>(lds, g, S, E, wave); }
        } else { if (rq_ == 1 && !((REP_MASK >> 11) & 1)) break;
            pg8::Gemm g{XB, W1T + (size_t)14 * 256 * DM, DM, DM, DM, 0, 0}; pg8::ListOrder S{bid - 2 * NG, 128, G};
            pg8::Epi1 E{RINV, a.q_norm, a.k_norm, ROPE, Q, KB, VB, GA, GS, UCAT, (LAS float*)(lds + XCH_OFF), 14};
            pg8::gemm_phase<pg8::Epi1, pg8::ListOrder, true>(lds, g, S, E, wave);
        }
        __syncthreads(); }
#pragma unroll
        for (int rq_ = 0; rq_ < 1 + ((REP_MASK >> 7) & 1); ++rq_)
        for (int un = bid; un < 256; un += G) {
            const int x = un & 7, jj = un >> 3, b = x >> 2, kvh = (x >> 1) & 1, idx = (x & 1) * 32 + jj, h = kvh * 4 + (idx >> 4), qb = idx & 15;
            const size_t tok0 = (size_t)b * SEQ + qb * 256;
            att::attn_dense_body(Q + tok0 * DATT + h * 128, KB + (size_t)b * SEQ * DKV + kvh * 128, VB + (size_t)b * SEQ * DKV + kvh * 128,
                                 GA + tok0 * DATT + h * 128, YMIX + tok0 * DM + h * 128, SEQ, (char*)lds_raw, wave);
        }
    GRID_SYNC(); }

#pragma unroll
    for (int rep_ = 0; rep_ < 1 + ((REP_MASK >> 3) & 1); ++rep_) {
        { pg8::StaticOrder S; S.init(T, 2 * DSSM, G, bid); pg8::Unit ua, ub;
          if (S.next(0, ua)) { ub = ua;
            pg8::Gemm ga{YS, WGLUT, DSSM, DSSM, DSSM, 0, 0}; pg8::EpiGlu Ea{a.b_glu, GS, YMIX};
            pg8::Gemm gb{PB, WPT, PLE, PLE, PLE, 0, 0}; pg8::EpiBf Eb{PPB, DM};
            pg8::gemm_phase2<pg8::EpiGlu, pg8::EpiBf>(lds, ga, ua, Ea, gb, ub, Eb, wave); } }
    GRID_SYNC(); }

#pragma unroll
    for (int rep_ = 0; rep_ < 1 + ((REP_MASK >> 4) & 1); ++rep_) {
        pg8::Gemm g{YMIX, WOT, DM, DM, DM, 0, 0}; pg8::StaticOrder S; S.init(T, DM, G, bid);
        pg8::EpiOut E{a.x, a.out, HB, SSQ1}; pg8::gemm_phase<pg8::EpiOut, pg8::StaticOrder, true>(lds, g, S, E, wave);
    GRID_SYNC(); }


    { LANE_IDS
        pg8::StaticOrder S; S.init(T, DM, G, bid); pg8::Unit u0;
        LAS float* r2 = (LAS float*)(lds + R2_OFF);
        if (S.next(0, u0) && tid < 256) { const float* sp = SSQ1 + (size_t)(u0.pm * 256 + tid) * 32; float s = 0.f;
#pragma unroll
            for (int i = 0; i < 8; ++i) { const f32x4 v = ((const f32x4*)sp)[i]; s += (v[0] + v[1]) + (v[2] + v[3]); }
            r2[tid] = rsqrtf(s * (1.f / DM) + EPS); }
        __syncthreads();
        pg8::Gemm g{HB, WGT, DM, DM, DM, 0, 0};
        pg8::EpiGate E{a.out, PPB, SSQ2, (unsigned*)ws, a.norm_final, r2, HB}; pg8::gemm_phase<pg8::EpiGate, pg8::StaticOrder, true>(lds, g, S, E, wave);
    }
}

extern "C" void kernel_launch(void* const* d_in, const int* in_sizes, int n_in, void* d_out, int out_size, void* d_ws, size_t ws_size, hipStream_t stream) {
    static int grid = 0;
    if (grid == 0) {
        if (n_in != 21 || in_sizes[0] != T * DM || out_size != T * DM || ws_size < WS_END) { fprintf(stderr, "kernel_launch: unexpected shapes (n_in %d, in0 %d, out %d, ws %zu)\n", n_in, n_in > 0 ? in_sizes[0] : -1, out_size, ws_size); grid = -1; return; }
        int dev = 0, cus = 0, per_cu = 0;
        hipGetDevice(&dev); hipDeviceGetAttribute(&cus, hipDeviceAttributeMultiprocessorCount, dev);
        if (hipFuncSetAttribute((const void*)fwd_kernel, hipFuncAttributeMaxDynamicSharedMemorySize, LDS_BYTES) != hipSuccess) { fprintf(stderr, "kernel_launch: hipFuncSetAttribute failed\n"); grid = -1; return; }
        hipOccupancyMaxActiveBlocksPerMultiprocessor(&per_cu, (const void*)fwd_kernel, 512, LDS_BYTES);
        (void)hipGetLastError();
        if (per_cu < 1) fprintf(stderr, "kernel_launch: occupancy query reports %d blocks per CU\n", per_cu);
        grid = cus > 256 ? 256 : cus;
    }
    if (grid < 0) return;
    Args a{};
    const float** f = (const float**)&a;
    for (int i = 0; i < 21; ++i) f[i] = (const float*)d_in[i];
    a.out = (float*)d_out; a.ws = (unsigned char*)d_ws;
    if (hipMemsetAsync(d_ws, 0, WS_CTL_BYTES, stream) != hipSuccess) { fprintf(stderr, "kernel_launch: hipMemsetAsync failed\n"); return; }
    void* args[] = {&a};
    hipError_t e = hipLaunchCooperativeKernel((const void*)fwd_kernel, dim3(grid), dim3(512), args, LDS_BYTES, stream);
    if (e != hipSuccess) fprintf(stderr, "kernel_launch: cooperative launch failed: %s (grid %d)\n", hipGetErrorString(e), grid);
}
```

```cpp
#include <hip/hip_runtime.h>
#include <hip/hip_cooperative_groups.h>
#include <cstdio>
#include <cstdint>
namespace cg = cooperative_groups;

#define LAS __attribute__((address_space(3)))
typedef unsigned short bf16_t;
typedef short bf16x8 __attribute__((ext_vector_type(8)));
typedef short s16x4 __attribute__((ext_vector_type(4)));
typedef float f32x4 __attribute__((ext_vector_type(4)));
typedef float f32x16 __attribute__((ext_vector_type(16)));
typedef unsigned u32x4 __attribute__((ext_vector_type(4)));
typedef unsigned u32x2 __attribute__((ext_vector_type(2)));

constexpr int T = 8192, SEQ = 4096, DM = 2048, DIN = 4608, DATT = 1024, DKV = 256, DSSM = 1024, PLE = 256;
constexpr int NG = 64, NCH = T / 16;
constexpr float EPS = 1e-6f;
#ifndef PH_MASK
#define PH_MASK 0xff
#endif
#ifndef GLDS_AUX
#define GLDS_AUX 0
#endif
#ifndef REP_MASK
#define REP_MASK 0
#endif

constexpr size_t MiB = 1u << 20;
constexpr size_t WS_W1T = 1 * MiB, WS_WGLUT = 19 * MiB, WS_WOT = 23 * MiB, WS_WGT = 31 * MiB, WS_WPT = 39 * MiB;
constexpr size_t WS_ROPE = 40 * MiB, WS_RINV = 40 * MiB + 65536, WS_LB16 = 40 * MiB + 131072, WS_SSQ1 = 41 * MiB, WS_SSQ2 = 42 * MiB;
constexpr size_t WS_PB = 43 * MiB, WS_WIN = 47 * MiB, WS_WBIG = 55 * MiB;
constexpr size_t WS_XB = 71 * MiB;
constexpr size_t WS_Q = 103 * MiB, WS_K = 119 * MiB, WS_V = 123 * MiB, WS_GA = 127 * MiB, WS_GS = 143 * MiB;
constexpr size_t WS_UCAT = 159 * MiB;
constexpr size_t WS_YMIX = 191 * MiB, WS_YS = 223 * MiB, WS_END = 239 * MiB;

constexpr int RING_BYTES = 131072, XCH_OFF = RING_BYTES, R2_OFF = RING_BYTES + 4096, XBST_OFF = RING_BYTES + 8192, LDS_BYTES = 147456;
constexpr size_t WS_BAR = 65536, WS_CTL_BYTES = 131072;

struct Args {
    const float *x, *p, *norm_mix, *w_in, *q_norm, *k_norm, *a_re, *a_im, *log_dt, *b_re, *b_im, *c_re, *c_im, *ssm_d, *w_glu, *b_glu, *w_out, *norm_ple, *w_ple_gate, *w_ple_proj, *norm_final;
    float* out; unsigned char* ws;
};

typedef __bf16 bf16s_;
__device__ __forceinline__ unsigned f2bf(float f) { return (unsigned)__builtin_bit_cast(unsigned short, (bf16s_)f); }
typedef float f32x2_ __attribute__((ext_vector_type(2)));
typedef __bf16 bf16x2_ __attribute__((ext_vector_type(2)));
__device__ __forceinline__ unsigned pk2(float lo, float hi) { const f32x2_ v = {lo, hi}; return __builtin_bit_cast(unsigned, __builtin_convertvector(v, bf16x2_)); }
__device__ __forceinline__ float bf2f(unsigned short b) { return __builtin_bit_cast(float, (unsigned)b << 16); }
__device__ __forceinline__ float bflo(unsigned w) { return __builtin_bit_cast(float, w << 16); }
__device__ __forceinline__ float bfhi(unsigned w) { return __builtin_bit_cast(float, w & 0xffff0000u); }
__device__ __forceinline__ unsigned cvt_pk_bf16(float lo, float hi) { unsigned r; asm volatile("v_cvt_pk_bf16_f32 %0, %1, %2" : "=v"(r) : "v"(lo), "v"(hi)); return r; }
__device__ __forceinline__ float sigmoidf_(float v) { return __builtin_amdgcn_rcpf(1.f + __builtin_amdgcn_exp2f(-1.4426950408889634f * v)); }
__device__ __forceinline__ float siluf_(float v) { return v * __builtin_amdgcn_rcpf(1.f + __builtin_amdgcn_exp2f(-1.4426950408889634f * v)); }
__device__ __forceinline__ float gelu_tanh(float v) { const float t = (-1.5957691216057308f * 1.4426950408889634f) * (v + 0.044715f * v * v * v); return v * __builtin_amdgcn_rcpf(1.f + __builtin_amdgcn_exp2f(t)); }
template <int K> __device__ __forceinline__ float swz_xor(float v) { return __int_as_float(__builtin_amdgcn_ds_swizzle(__float_as_int(v), (K << 10) | 0x1f)); }
__device__ __forceinline__ float sum_xor32(float v) { auto rr = __builtin_amdgcn_permlane32_swap(__float_as_uint(v), __float_as_uint(v), false, false); return __uint_as_float(rr[0]) + __uint_as_float(rr[1]); }
__device__ __forceinline__ float wave_sum(float v) { v += swz_xor<1>(v); v += swz_xor<2>(v); v += swz_xor<4>(v); v += swz_xor<8>(v); v += swz_xor<16>(v); return sum_xor32(v); }
#define LDS_WAIT() asm volatile("s_waitcnt lgkmcnt(0)" ::: "memory")
__device__ __forceinline__ int lane_id_opaque() { int l = __builtin_amdgcn_mbcnt_hi(~0u, __builtin_amdgcn_mbcnt_lo(~0u, 0u)); asm volatile("" : "+v"(l)); return l; }

namespace pg8 {
constexpr int BM = 256, BK = 64, HALF = 128, HTB = HALF * BK * 2, NXCD = 8, WGM = 8;
__host__ __device__ __forceinline__ int lds_byte(int r, int c) { const int st = (r >> 4) * 2 + (c >> 5), rr = r & 15, cc = c & 31, ob = rr * 64 + cc * 2; return st * 1024 + (ob ^ (((ob >> 9) & 1) << 5)); }
__host__ __device__ __forceinline__ void stage_rc(int b, int& R, int& C) { const int st = b / 1024, sb = b % 1024, swz = sb ^ (((sb >> 9) & 1) << 5); R = (st >> 1) * 16 + swz / 64; C = (st & 1) * 32 + (swz % 64) / 2; }
__host__ __device__ __forceinline__ int perm32(int rho) { const int n = rho >> 4, i = rho & 15; return 8 * (i >> 2) + 4 * n + (i & 3); }

struct Unit { int pm, pn, z; };
struct Gemm { const bf16_t* A; const bf16_t* Bt; int K, lda, ldb; size_t zA, zB; };

struct StaticOrder {
    int nM, nN, nwg, G, c;
    __device__ void init(int M, int N, int G_, int c_) { nM = M / BM; nN = N / BM; nwg = nM * nN; G = G_; c = c_; }
    __device__ bool next(int i, Unit& u) const {
        const long L = (long)i * G + c; if (L >= nwg) return false;
        int wgid = (int)L; { const int q = nwg / NXCD, r = nwg % NXCD, xcd = wgid % NXCD, off = wgid / NXCD; wgid = (xcd < r ? xcd * (q + 1) : r * (q + 1) + (xcd - r) * q) + off; }
        const int nig = WGM * nN, gid = wgid / nig, fm = gid * WGM, gsz = (nM - fm) < WGM ? (nM - fm) : WGM;
        u.pm = fm + ((wgid % nig) % gsz); u.pn = (wgid % nig) / gsz; u.z = 0; return true;
    }
};
struct BatchOrder {
    int n, G, c;
    __device__ bool next(int i, Unit& u) const { const int L = i * G + c; if (L >= n) return false; u.z = L >> 1; u.pm = L & 1; u.pn = 0; return true; }
};

struct ListOrder {
    int L0, n, stride;
    __device__ bool next(int i, Unit& u) const { const int L = L0 + i * stride; if (L < 0 || L >= n) return false;
        const int x = L & 7, j = L >> 3; u.pm = 4 * x + (j >> 2); u.pn = j & 3; u.z = 0; return true; }
};
template <class Epi, class Sched, bool ALIGN_EPI>
__device__ __forceinline__ void gemm_phase(LAS unsigned char* lds, const Gemm g, const Sched& S, const Epi& E, const int wid) {
    const int lane = lane_id_opaque(), tid = wid * 64 + lane, wr = wid >> 2, wc = wid & 3, fr = lane & 15, fq = lane >> 4;
    const int K = g.K, nt = K / BK;
    unsigned voffA[2], voffB[2];
#pragma unroll
    for (int i = 0; i < 2; ++i) { int R, C; stage_rc(tid * 16 + i * 8192, R, C); const int Rb = (R & ~31) + perm32(R & 31);
        voffA[i] = (unsigned)(R * g.lda + C) * 2u; voffB[i] = (unsigned)(Rb * g.ldb + C) * 2u; }
    const size_t kstep = (size_t)(BK * 2);
    const size_t hstepA = (size_t)HALF * g.lda * 2, hstepB = (size_t)HALF * g.ldb * 2;
    const size_t tstepA = 2 * hstepA, tstepB = 2 * hstepB;
    const unsigned ldsw = (unsigned)wid * 1024u;
    const int aoff = lds_byte(wr * 64 + fr, fq * 8), boff = lds_byte(wc * 32 + fr, fq * 8);
#define PG8_SA(b, h) (((b) * 2 + (h)) * HTB)
#define PG8_SB(b, h) ((4 + (b) * 2 + (h)) * HTB)
#define PG8_STAGE(bufoff, gbase, voff) do { _Pragma("unroll") for (int _i = 0; _i < 2; ++_i) \
        __builtin_amdgcn_global_load_lds((const unsigned*)((const char*)(gbase) + (voff)[_i]), (LAS unsigned*)(lds + (bufoff) + ldsw + _i * 8192), 16, 0, GLDS_AUX); } while (0)
#define PG8_LDA(dst, b, h) do { _Pragma("unroll") for (int m = 0; m < 4; ++m) _Pragma("unroll") for (int k = 0; k < 2; ++k) dst[m][k] = *(const LAS bf16x8*)(lds + PG8_SA(b, h) + aoff + m * 2048 + k * 1024); } while (0)
#define PG8_LDB(dst, b, h) do { _Pragma("unroll") for (int n = 0; n < 2; ++n) _Pragma("unroll") for (int k = 0; k < 2; ++k) dst[n][k] = *(const LAS bf16x8*)(lds + PG8_SB(b, h) + boff + n * 2048 + k * 1024); } while (0)
#define PG8_MMA(ai, bj, At, Bt) do { __builtin_amdgcn_s_setprio(1); _Pragma("unroll") for (int m = 0; m < 4; ++m) _Pragma("unroll") for (int n = 0; n < 2; ++n) _Pragma("unroll") for (int k = 0; k < 2; ++k) \
        acc[ai][bj][m][n] = __builtin_amdgcn_mfma_f32_16x16x32_bf16(Bt[n][k], At[m][k], acc[ai][bj][m][n], 0, 0, 0); __builtin_amdgcn_s_setprio(0); } while (0)
#define PG8_WAIT_V(n) asm volatile("s_waitcnt vmcnt(" #n ")" ::: "memory")
#define PG8_WAIT_L(n) asm volatile("s_waitcnt lgkmcnt(" #n ")" ::: "memory")
#define PG8_BAR __builtin_amdgcn_s_barrier()
#define PG8_SCHED __builtin_amdgcn_sched_barrier(0)
    Unit cur, nxt; int ui = 0;
    if (!S.next(0, cur)) return;
    f32x4 acc[2][2][4][2];
#pragma unroll
    for (int a = 0; a < 2; ++a)
#pragma unroll
        for (int b = 0; b < 2; ++b)
#pragma unroll
            for (int m = 0; m < 4; ++m)
#pragma unroll
                for (int n = 0; n < 2; ++n) acc[a][b][m][n] = (f32x4){0.f, 0.f, 0.f, 0.f};
    bf16x8 At[4][2], B0[2][2], B1[2][2];
    const char* cA = (const char*)g.A + (size_t)cur.z * g.zA + (size_t)cur.pm * tstepA; const char* cB = (const char*)g.Bt + (size_t)cur.z * g.zB + (size_t)cur.pn * tstepB;
    PG8_STAGE(PG8_SB(0, 0), cB, voffB); PG8_STAGE(PG8_SB(0, 1), cB + hstepB, voffB); PG8_STAGE(PG8_SA(0, 0), cA, voffA); PG8_STAGE(PG8_SA(0, 1), cA + hstepA, voffA);
    if (wr == 1) PG8_BAR;
    PG8_WAIT_V(2); PG8_BAR;
    PG8_STAGE(PG8_SB(1, 0), cB + kstep, voffB); PG8_STAGE(PG8_SA(1, 0), cA + kstep, voffA); PG8_STAGE(PG8_SB(1, 1), cB + hstepB + kstep, voffB);
    PG8_WAIT_V(6); PG8_BAR;
    for (;;) {
        const bool has_next = S.next(ui + 1, nxt);
        const char* nA = has_next ? (const char*)g.A + (size_t)nxt.z * g.zA + (size_t)nxt.pm * tstepA : cA;
        const char* nB = has_next ? (const char*)g.Bt + (size_t)nxt.z * g.zB + (size_t)nxt.pn * tstepB : cB;
        for (int t = 0; t < nt; t += 2) {
            const bool last = (t == nt - 2);
            const char* a1 = cA + (size_t)(t + 1) * kstep;
            const char* a2 = last ? nA : cA + (size_t)(t + 2) * kstep; const char* b2 = last ? nB : cB + (size_t)(t + 2) * kstep;
            const char* a3 = a2 + kstep; const char* b3 = b2 + kstep;
            PG8_LDB(B0, 0, 0); PG8_LDB(B1, 0, 1); PG8_SCHED; PG8_LDA(At, 0, 0); PG8_STAGE(PG8_SA(1, 1), a1 + hstepA, voffA);
            PG8_WAIT_V(8); PG8_WAIT_L(0); PG8_BAR; PG8_MMA(0, 0, At, B0); PG8_MMA(0, 1, At, B1); PG8_BAR; PG8_SCHED;
            PG8_LDA(At, 0, 1); PG8_STAGE(PG8_SB(0, 0), b2, voffB); PG8_STAGE(PG8_SB(0, 1), b2 + hstepB, voffB); PG8_STAGE(PG8_SA(0, 0), a2, voffA);
            PG8_WAIT_V(8); PG8_WAIT_L(0); PG8_BAR; PG8_MMA(1, 0, At, B0); PG8_MMA(1, 1, At, B1); PG8_BAR; PG8_SCHED;
            PG8_LDB(B0, 1, 0); PG8_LDB(B1, 1, 1); PG8_SCHED; PG8_LDA(At, 1, 0); PG8_STAGE(PG8_SA(0, 1), a2 + hstepA, voffA);
            PG8_WAIT_V(8); PG8_WAIT_L(0); PG8_BAR; PG8_MMA(0, 0, At, B0); PG8_MMA(0, 1, At, B1); PG8_BAR; PG8_SCHED;
            PG8_LDA(At, 1, 1); PG8_STAGE(PG8_SB(1, 0), b3, voffB); PG8_STAGE(PG8_SB(1, 1), b3 + hstepB, voffB); PG8_STAGE(PG8_SA(1, 0), a3, voffA);
            PG8_WAIT_V(8); PG8_WAIT_L(0); PG8_BAR; PG8_MMA(1, 0, At, B0); PG8_MMA(1, 1, At, B1); PG8_BAR; PG8_SCHED;
        }
        if constexpr (ALIGN_EPI) { if (wr == 0) PG8_BAR; }
        if constexpr (!Epi::AFTER_DRAIN) E(acc, cur, wr, wc, fr, fq);
        if (!has_next) break;
#pragma unroll
        for (int a = 0; a < 2; ++a)
#pragma unroll
            for (int b = 0; b < 2; ++b)
#pragma unroll
                for (int m = 0; m < 4; ++m)
#pragma unroll
                    for (int n = 0; n < 2; ++n) acc[a][b][m][n] = (f32x4){0.f, 0.f, 0.f, 0.f};
        cur = nxt; cA = nA; cB = nB; ++ui;
        if constexpr (ALIGN_EPI) { if (wr == 1) PG8_BAR; }
    }
    PG8_WAIT_V(0);
    if constexpr (!ALIGN_EPI) { if (wr == 0) PG8_BAR; }
    PG8_BAR;
    if constexpr (Epi::AFTER_DRAIN) E.fused(acc, cur, wr, wc, lds, wid);
#undef PG8_SA
#undef PG8_SB
#undef PG8_STAGE
#undef PG8_LDA
#undef PG8_LDB
#undef PG8_MMA
#undef PG8_WAIT_V
#undef PG8_WAIT_L
#undef PG8_BAR
#undef PG8_SCHED
}

template <class EpiA, class EpiB>
__device__ __forceinline__ void gemm_phase2(LAS unsigned char* lds, const Gemm g0, const Unit u0, const EpiA& E0, const Gemm g1, const Unit u1, const EpiB& E1, const int wid) {
    const int lane = lane_id_opaque(), tid = wid * 64 + lane, wr = wid >> 2, wc = wid & 3, fr = lane & 15, fq = lane >> 4;
    unsigned vA0[2], vB0[2], vA1[2], vB1[2];
#pragma unroll
    for (int i = 0; i < 2; ++i) { int R, C; stage_rc(tid * 16 + i * 8192, R, C); const int Rb = (R & ~31) + perm32(R & 31);
        vA0[i] = (unsigned)(R * g0.lda + C) * 2u; vB0[i] = (unsigned)(Rb * g0.ldb + C) * 2u; vA1[i] = (unsigned)(R * g1.lda + C) * 2u; vB1[i] = (unsigned)(Rb * g1.ldb + C) * 2u; }
    const size_t kstep = (size_t)(BK * 2);
    const size_t hA0 = (size_t)HALF * g0.lda * 2, hB0 = (size_t)HALF * g0.ldb * 2, hA1 = (size_t)HALF * g1.lda * 2, hB1 = (size_t)HALF * g1.ldb * 2;
    const unsigned ldsw = (unsigned)wid * 1024u;
    const int aoff = lds_byte(wr * 64 + fr, fq * 8), boff = lds_byte(wc * 32 + fr, fq * 8);
#define PG8_SA(b, h) (((b) * 2 + (h)) * HTB)
#define PG8_SB(b, h) ((4 + (b) * 2 + (h)) * HTB)
#define PG8_STAGE(bufoff, gbase, voff) do { _Pragma("unroll") for (int _i = 0; _i < 2; ++_i) \
        __builtin_amdgcn_global_load_lds((const unsigned*)((const char*)(gbase) + (voff)[_i]), (LAS unsigned*)(lds + (bufoff) + ldsw + _i * 8192), 16, 0, 0); } while (0)
#define PG8_LDA(dst, b, h) do { _Pragma("unroll") for (int m = 0; m < 4; ++m) _Pragma("unroll") for (int k = 0; k < 2; ++k) dst[m][k] = *(const LAS bf16x8*)(lds + PG8_SA(b, h) + aoff + m * 2048 + k * 1024); } while (0)
#define PG8_LDB(dst, b, h) do { _Pragma("unroll") for (int n = 0; n < 2; ++n) _Pragma("unroll") for (int k = 0; k < 2; ++k) dst[n][k] = *(const LAS bf16x8*)(lds + PG8_SB(b, h) + boff + n * 2048 + k * 1024); } while (0)
#define PG8_MMA(ai, bj, At, Bt) do { __builtin_amdgcn_s_setprio(1); _Pragma("unroll") for (int m = 0; m < 4; ++m) _Pragma("unroll") for (int n = 0; n < 2; ++n) _Pragma("unroll") for (int k = 0; k < 2; ++k) \
        acc[ai][bj][m][n] = __builtin_amdgcn_mfma_f32_16x16x32_bf16(Bt[n][k], At[m][k], acc[ai][bj][m][n], 0, 0, 0); __builtin_amdgcn_s_setprio(0); } while (0)
#define PG8_WAIT_V(n) asm volatile("s_waitcnt vmcnt(" #n ")" ::: "memory")
#define PG8_WAIT_L(n) asm volatile("s_waitcnt lgkmcnt(" #n ")" ::: "memory")
#define PG8_BAR __builtin_amdgcn_s_barrier()
#define PG8_SCHED __builtin_amdgcn_sched_barrier(0)
    f32x4 acc[2][2][4][2];
#pragma unroll
    for (int a = 0; a < 2; ++a)
#pragma unroll
        for (int b = 0; b < 2; ++b)
#pragma unroll
            for (int m = 0; m < 4; ++m)
#pragma unroll
                for (int n = 0; n < 2; ++n) acc[a][b][m][n] = (f32x4){0.f, 0.f, 0.f, 0.f};
    bf16x8 At[4][2], B0[2][2], B1[2][2];
    const char* A0 = (const char*)g0.A + (size_t)u0.pm * 2 * hA0; const char* Bp0 = (const char*)g0.Bt + (size_t)u0.pn * 2 * hB0;
    const char* A1 = (const char*)g1.A + (size_t)u1.pm * 2 * hA1; const char* Bp1 = (const char*)g1.Bt + (size_t)u1.pn * 2 * hB1;
    PG8_STAGE(PG8_SB(0, 0), Bp0, vB0); PG8_STAGE(PG8_SB(0, 1), Bp0 + hB0, vB0); PG8_STAGE(PG8_SA(0, 0), A0, vA0); PG8_STAGE(PG8_SA(0, 1), A0 + hA0, vA0);
    if (wr == 1) PG8_BAR;
    PG8_WAIT_V(2); PG8_BAR;
    PG8_STAGE(PG8_SB(1, 0), Bp0 + kstep, vB0); PG8_STAGE(PG8_SA(1, 0), A0 + kstep, vA0); PG8_STAGE(PG8_SB(1, 1), Bp0 + hB0 + kstep, vB0);
    PG8_WAIT_V(6); PG8_BAR;
#pragma unroll
    for (int ui = 0; ui < 2; ++ui) {
        const char* cA = ui == 0 ? A0 : A1; const char* cB = ui == 0 ? Bp0 : Bp1;
        const size_t hAc = ui == 0 ? hA0 : hA1, hBc = ui == 0 ? hB0 : hB1;
        const int nt = (ui == 0 ? g0.K : g1.K) / BK;
        unsigned vAc[2], vBc[2];
#pragma unroll
        for (int i = 0; i < 2; ++i) { vAc[i] = ui == 0 ? vA0[i] : vA1[i]; vBc[i] = ui == 0 ? vB0[i] : vB1[i]; }
        for (int t = 0; t < nt; t += 2) {
            const bool last = (t == nt - 2);
            const char* a1 = cA + (size_t)(t + 1) * kstep;
            const char* a2 = last ? A1 : cA + (size_t)(t + 2) * kstep; const char* b2 = last ? Bp1 : cB + (size_t)(t + 2) * kstep;
            const char* a3 = a2 + kstep; const char* b3 = b2 + kstep;
            const size_t hA2 = last ? hA1 : hAc, hB2 = last ? hB1 : hBc;
            unsigned vA2[2], vB2[2];
#pragma unroll
            for (int i = 0; i < 2; ++i) { vA2[i] = last ? vA1[i] : vAc[i]; vB2[i] = last ? vB1[i] : vBc[i]; }
            PG8_LDB(B0, 0, 0); PG8_LDB(B1, 0, 1); PG8_SCHED; PG8_LDA(At, 0, 0); PG8_STAGE(PG8_SA(1, 1), a1 + hAc, vAc);
            PG8_WAIT_V(8); PG8_WAIT_L(0); PG8_BAR; PG8_MMA(0, 0, At, B0); PG8_MMA(0, 1, At, B1); PG8_BAR; PG8_SCHED;
            PG8_LDA(At, 0, 1); PG8_STAGE(PG8_SB(0, 0), b2, vB2); PG8_STAGE(PG8_SB(0, 1), b2 + hB2, vB2); PG8_STAGE(PG8_SA(0, 0), a2, vA2);
            PG8_WAIT_V(8); PG8_WAIT_L(0); PG8_BAR; PG8_MMA(1, 0, At, B0); PG8_MMA(1, 1, At, B1); PG8_BAR; PG8_SCHED;
            PG8_LDB(B0, 1, 0); PG8_LDB(B1, 1, 1); PG8_SCHED; PG8_LDA(At, 1, 0); PG8_STAGE(PG8_SA(0, 1), a2 + hA2, vA2);
            PG8_WAIT_V(8); PG8_WAIT_L(0); PG8_BAR; PG8_MMA(0, 0, At, B0); PG8_MMA(0, 1, At, B1); PG8_BAR; PG8_SCHED;
            PG8_LDA(At, 1, 1); PG8_STAGE(PG8_SB(1, 0), b3, vB2); PG8_STAGE(PG8_SB(1, 1), b3 + hB2, vB2); PG8_STAGE(PG8_SA(1, 0), a3, vA2);
            PG8_WAIT_V(8); PG8_WAIT_L(0); PG8_BAR; PG8_MMA(1, 0, At, B0); PG8_MMA(1, 1, At, B1); PG8_BAR; PG8_SCHED;
        }
        if (wr == 0) PG8_BAR;
        if (ui == 0) {
            E0(acc, u0, wr, wc, fr, fq);
#pragma unroll
            for (int a = 0; a < 2; ++a)
#pragma unroll
                for (int b = 0; b < 2; ++b)
#pragma unroll
                    for (int m = 0; m < 4; ++m)
#pragma unroll
                        for (int n = 0; n < 2; ++n) acc[a][b][m][n] = (f32x4){0.f, 0.f, 0.f, 0.f};
            if (wr == 1) PG8_BAR;
        } else E1(acc, u1, wr, wc, fr, fq);
    }
    PG8_WAIT_V(0);
    PG8_BAR;
#undef PG8_SA
#undef PG8_SB
#undef PG8_STAGE
#undef PG8_LDA
#undef PG8_LDB
#undef PG8_MMA
#undef PG8_WAIT_V
#undef PG8_WAIT_L
#undef PG8_BAR
#undef PG8_SCHED
}

#define EPI_FOR_ROWS _Pragma("unroll") for (int ai = 0; ai < 2; ++ai) _Pragma("unroll") for (int m = 0; m < 4; ++m)
#define EPI_ROWDEF const int rit = ai * HALF + wr * 64 + m * 16 + fr; const int row = u.pm * BM + rit; (void)rit; (void)row;

struct Epi1 {
    static constexpr bool AFTER_DRAIN = false;
    const float* rinv; const float* qnw; const float* knw; const float2* rope;
    bf16_t *Q, *Kb, *Vb, *GA, *GS, *UCAT; LAS float* xch; int pn0;
    __device__ __forceinline__ void operator()(const f32x4 (&acc)[2][2][4][2], const Unit& u, int wr, int wc, int, int) const {
        const int l_ = lane_id_opaque(), fr = l_ & 15, fq = l_ >> 4;
        const int pn = u.pn + pn0;
        if (pn <= 4) {
            float ss[2][4], rv[2][4];
            EPI_FOR_ROWS { EPI_ROWDEF const float r = rinv[row]; rv[ai][m] = r; float s = 0.f;
#pragma unroll
                for (int bj = 0; bj < 2; ++bj)
#pragma unroll
                    for (int n = 0; n < 2; ++n) { const f32x4 v = acc[ai][bj][m][n] * r; s += (v[0] * v[0] + v[1] * v[1]) + (v[2] * v[2] + v[3] * v[3]); }
                s += swz_xor<16>(s); s = sum_xor32(s); ss[ai][m] = s;
                if (fq == 0) xch[wc * 256 + rit] = s; }
            LDS_WAIT(); __builtin_amdgcn_s_barrier(); asm volatile("" ::: "memory");
            const int half = wc & 1, hd = wc >> 1;
            const float* nw = (pn < 4 ? qnw : knw) + 64 * half + 8 * fq;
            float w1[8], w2[8];
#pragma unroll
            for (int i = 0; i < 8; ++i) { w1[i] = nw[i]; w2[i] = nw[32 + i]; }
            EPI_FOR_ROWS { EPI_ROWDEF const float tot = ss[ai][m] + xch[(wc ^ 1) * 256 + rit];
                const float sc = rv[ai][m] * rsqrtf(tot * (1.f / 128.f) + EPS);
                const int t = row & (SEQ - 1); const int pos = half ? (t & 63) : (t >> 6);
                const float2* rp = rope + pos * 32 + 8 * fq;
                float o1[8], o2[8];
#pragma unroll
                for (int n = 0; n < 2; ++n)
#pragma unroll
                    for (int e = 0; e < 4; ++e) { const int i = 4 * n + e; const float2 cs = rp[i];
                        const float x1 = acc[ai][0][m][n][e] * sc * w1[i], x2 = acc[ai][1][m][n][e] * sc * w2[i];
                        o1[i] = x1 * cs.x - x2 * cs.y; o2[i] = x2 * cs.x + x1 * cs.y; }
                bf16_t* dst = (pn < 4) ? Q + (size_t)row * DATT + (2 * pn + hd) * 128 + 64 * half + 8 * fq : Kb + (size_t)row * DKV + hd * 128 + 64 * half + 8 * fq;
                u32x4 a; a.x = pk2(o1[0], o1[1]); a.y = pk2(o1[2], o1[3]); a.z = pk2(o1[4], o1[5]); a.w = pk2(o1[6], o1[7]);
                u32x4 b; b.x = pk2(o2[0], o2[1]); b.y = pk2(o2[2], o2[3]); b.z = pk2(o2[4], o2[5]); b.w = pk2(o2[6], o2[7]);
                *(u32x4*)dst = a; *(u32x4*)(dst + 32) = b; }
        } else {
            const int lg0 = 4 * (wc >> 1) + 2 * (wc & 1);
            EPI_FOR_ROWS { EPI_ROWDEF const float r = rinv[row];
#pragma unroll
                for (int bj = 0; bj < 2; ++bj) { const int L = 256 * pn + 32 * (lg0 + bj) + 8 * fq;
                    f32x4 v0 = acc[ai][bj][m][0] * r, v1 = acc[ai][bj][m][1] * r; bf16_t* dst;
                    if (pn == 5) dst = Vb + (size_t)row * DKV + (L - 1280);
                    else if (pn < 10) dst = GA + (size_t)row * DATT + (L - 1536);
                    else if (pn < 14) { const int Lu = L - 2560; dst = UCAT + ((size_t)(Lu >> 4) * NCH + (row >> 4)) * 512 + (row & 15) * 16 + (Lu & 15); }
                    else dst = GS + (size_t)row * DSSM + (L - 3584);
                    if ((pn >= 6 && pn < 10) || pn >= 14) {
#pragma unroll
                        for (int e = 0; e < 4; ++e) { v0[e] = siluf_(v0[e]); v1[e] = siluf_(v1[e]); } }
                    u32x4 w; w.x = pk2(v0[0], v0[1]); w.y = pk2(v0[2], v0[3]); w.z = pk2(v1[0], v1[1]); w.w = pk2(v1[2], v1[3]);
                    *(u32x4*)dst = w; } }
        }
    }
};
struct EpiS1 {
    static constexpr bool AFTER_DRAIN = true;
    const float* lb16; bf16_t* UCAT;
    __device__ __forceinline__ void operator()(const f32x4 (&)[2][2][4][2], const Unit&, int, int, int, int) const {}
    __device__ __forceinline__ void fused(const f32x4 (&acc)[2][2][4][2], const Unit& u, int wr, int wc, LAS unsigned char* lds, int wid) const {
        const int l_ = lane_id_opaque(), fr = l_ & 15, fq = l_ >> 4;
        LAS float* Tl = (LAS float*)lds;
#pragma unroll
        for (int d = 0; d < 2; ++d) {
            EPI_FOR_ROWS { const int rit = ai * HALF + wr * 64 + m * 16 + fr; LAS float* rp = Tl + rit * 128 + wc * 32 + 8 * fq;
                *(LAS f32x4*)rp = acc[ai][d][m][0]; *(LAS f32x4*)(rp + 4) = acc[ai][d][m][1]; }
            LDS_WAIT(); __builtin_amdgcn_s_barrier(); asm volatile("" ::: "memory");
            {
                const int p = l_; const float lr = lb16[((u.z * 2 + d) * 64 + p) * 2], li = lb16[((u.z * 2 + d) * 64 + p) * 2 + 1];
                LAS float* SEG = (LAS float*)(lds + XCH_OFF);
                float xr = 0.f, xi = 0.f;
#pragma unroll 8
                for (int i = 0; i < 32; ++i) { const int cc = wid * 32 + i, c = d ? 255 - cc : cc;
                    const float sr = Tl[c * 128 + p], si = Tl[c * 128 + 64 + p];
                    Tl[c * 128 + p] = xr; Tl[c * 128 + 64 + p] = xi;
                    const float nr = lr * xr - li * xi + sr; xi = lr * xi + li * xr + si; xr = nr; }
                SEG[(wid * 64 + p) * 2] = xr; SEG[(wid * 64 + p) * 2 + 1] = xi;
                LDS_WAIT(); __builtin_amdgcn_s_barrier(); asm volatile("" ::: "memory");
                float l32r = lr, l32i = li;
#pragma unroll
                for (int q = 0; q < 5; ++q) { const float t = l32r * l32r - l32i * l32i; l32i = 2.f * l32r * l32i; l32r = t; }
                float er = 0.f, ei = 0.f;
                for (int j = 0; j < wid; ++j) { const float tr = SEG[(j * 64 + p) * 2], ti = SEG[(j * 64 + p) * 2 + 1];
                    const float nr = l32r * er - l32i * ei + tr; ei = l32r * ei + l32i * er + ti; er = nr; }
#pragma unroll 8
                for (int i = 0; i < 32; ++i) { const int cc = wid * 32 + i, c = d ? 255 - cc : cc;
                    const float tr = Tl[c * 128 + p] + er, ti = Tl[c * 128 + 64 + p] + ei;
                    Tl[c * 128 + p] = __uint_as_float(pk2(tr, ti));
                    const float nr = lr * er - li * ei; ei = lr * ei + li * er; er = nr; }
            }
            LDS_WAIT(); __builtin_amdgcn_s_barrier(); asm volatile("" ::: "memory");
            {   bf16_t* ub = UCAT + ((size_t)u.z * NCH + u.pm * 256) * 512 + 256 + d * 128;
#pragma unroll
                for (int i = 0; i < 8; ++i) { const int q = wid * 64 + l_ + 512 * i, r = q >> 4, c8 = (q & 15) * 8;
                    *(u32x4*)(ub + (size_t)r * 512 + c8) = *(const LAS u32x4*)((LAS bf16_t*)(Tl + r * 128) + c8); } }
            LDS_WAIT(); __builtin_amdgcn_s_barrier(); asm volatile("" ::: "memory");
        }
    }
};
struct EpiS2 {
    static constexpr bool AFTER_DRAIN = false;
    bf16_t* YS;
    __device__ __forceinline__ void operator()(const f32x4 (&acc)[2][2][4][2], const Unit& u, int wr, int wc, int, int) const {
        const int l_ = lane_id_opaque(), fr = l_ & 15, fq = l_ >> 4;
        EPI_FOR_ROWS { EPI_ROWDEF
#pragma unroll
            for (int bj = 0; bj < 2; ++bj) { const int c = bj * HALF + wc * 32 + 8 * fq; const int j = c >> 4, h0 = c & 15;
                const f32x4 v0 = acc[ai][bj][m][0], v1 = acc[ai][bj][m][1];
                u32x4 w; w.x = pk2(gelu_tanh(v0[0]), gelu_tanh(v0[1])); w.y = pk2(gelu_tanh(v0[2]), gelu_tanh(v0[3])); w.z = pk2(gelu_tanh(v1[0]), gelu_tanh(v1[1])); w.w = pk2(gelu_tanh(v1[2]), gelu_tanh(v1[3]));
                *(u32x4*)(YS + ((size_t)row * 16 + j) * DSSM + u.z * 16 + h0) = w; } }
    }
};
struct EpiGlu {
    static constexpr bool AFTER_DRAIN = false;
    const float* bglu; const bf16_t* GS; bf16_t* YMIX;
    __device__ __forceinline__ void operator()(const f32x4 (&acc)[2][2][4][2], const Unit& u, int wr, int wc, int, int) const {
        const int l_ = lane_id_opaque(), fr = l_ & 15, fq = l_ >> 4;
        const int a0 = 128 * u.pn + 32 * wc + 8 * fq;
        float bv[8], bg[8];
#pragma unroll
        for (int i = 0; i < 8; ++i) { bv[i] = bglu[a0 + i]; bg[i] = bglu[1024 + a0 + i]; }
        u32x4 gsv[2][4];
        EPI_FOR_ROWS { EPI_ROWDEF gsv[ai][m] = __builtin_nontemporal_load((const u32x4*)(GS + (size_t)row * DSSM + a0)); }
        EPI_FOR_ROWS { EPI_ROWDEF const u32x4 gs = gsv[ai][m];
            float o[8];
#pragma unroll
            for (int n = 0; n < 2; ++n)
#pragma unroll
                for (int e = 0; e < 4; ++e) { const int i = 4 * n + e; o[i] = (acc[ai][0][m][n][e] + bv[i]) * sigmoidf_(acc[ai][1][m][n][e] + bg[i]); }
            o[0] *= bflo(gs.x); o[1] *= bfhi(gs.x); o[2] *= bflo(gs.y); o[3] *= bfhi(gs.y); o[4] *= bflo(gs.z); o[5] *= bfhi(gs.z); o[6] *= bflo(gs.w); o[7] *= bfhi(gs.w);
            u32x4 w; w.x = pk2(o[0], o[1]); w.y = pk2(o[2], o[3]); w.z = pk2(o[4], o[5]); w.w = pk2(o[6], o[7]);
            *(u32x4*)(YMIX + (size_t)row * DM + 1024 + a0) = w; }
    }
};
struct EpiBf {
    static constexpr bool AFTER_DRAIN = false;
    bf16_t* O; int ldc;
    __device__ __forceinline__ void operator()(const f32x4 (&acc)[2][2][4][2], const Unit& u, int wr, int wc, int, int) const {
        const int l_ = lane_id_opaque(), fr = l_ & 15, fq = l_ >> 4;
        EPI_FOR_ROWS { EPI_ROWDEF
#pragma unroll
            for (int bj = 0; bj < 2; ++bj) { const f32x4 v0 = acc[ai][bj][m][0], v1 = acc[ai][bj][m][1];
                u32x4 w; w.x = pk2(v0[0], v0[1]); w.y = pk2(v0[2], v0[3]); w.z = pk2(v1[0], v1[1]); w.w = pk2(v1[2], v1[3]);
                *(u32x4*)(O + (size_t)row * ldc + u.pn * BM + bj * HALF + wc * 32 + 8 * fq) = w; } }
    }
};
struct EpiOut {
    static constexpr bool AFTER_DRAIN = false;
    const float* x; float* H; bf16_t* HB; float* ssq;
    __device__ __forceinline__ void operator()(const f32x4 (&acc)[2][2][4][2], const Unit& u, int wr, int wc, int, int) const {
        const int l_ = lane_id_opaque(), fr = l_ & 15, fq = l_ >> 4;
#pragma unroll
        for (int ai = 0; ai < 2; ++ai) {
            f32x4 xv[4][2][2];
#pragma unroll
            for (int m = 0; m < 4; ++m) { EPI_ROWDEF
#pragma unroll
                for (int bj = 0; bj < 2; ++bj) { const size_t off = (size_t)row * DM + u.pn * BM + bj * HALF + wc * 32 + 8 * fq; xv[m][bj][0] = __builtin_nontemporal_load((const f32x4*)(x + off)); xv[m][bj][1] = __builtin_nontemporal_load((const f32x4*)(x + off + 4)); } }
#pragma unroll
            for (int m = 0; m < 4; ++m) { EPI_ROWDEF float s = 0.f;
#pragma unroll
                for (int bj = 0; bj < 2; ++bj) { const size_t off = (size_t)row * DM + u.pn * BM + bj * HALF + wc * 32 + 8 * fq;
                    const f32x4 v0 = acc[ai][bj][m][0] + xv[m][bj][0], v1 = acc[ai][bj][m][1] + xv[m][bj][1];
                    s += (v0[0] * v0[0] + v0[1] * v0[1]) + (v0[2] * v0[2] + v0[3] * v0[3]) + (v1[0] * v1[0] + v1[1] * v1[1]) + (v1[2] * v1[2] + v1[3] * v1[3]);
                    u32x4 w; w.x = pk2(v0[0], v0[1]); w.y = pk2(v0[2], v0[3]); w.z = pk2(v1[0], v1[1]); w.w = pk2(v1[2], v1[3]);
                    *(u32x4*)(HB + off) = w; }
                s += swz_xor<16>(s); s = sum_xor32(s);
                if (fq == 0) ssq[(size_t)row * 32 + u.pn * 4 + wc] = s; }
        }
    }
};
struct EpiGate {
    static constexpr bool AFTER_DRAIN = true;
    float* H; const bf16_t* PP; float* ssq; unsigned* cnt; const float* nf; const LAS float* r2; const bf16_t* HBr;
    __device__ __forceinline__ void operator()(const f32x4 (&)[2][2][4][2], const Unit&, int, int, int, int) const {}
    __device__ __forceinline__ void fused(f32x4 (&acc)[2][2][4][2], const Unit& u, int wr, int wc, LAS unsigned char* lds, int wid) const {
        const int l_ = lane_id_opaque(), fr = l_ & 15, fq = l_ >> 4, tid = wid * 64 + l_;
        LAS float* P = (LAS float*)lds; LAS float* Rn = P + 1024;
        EPI_FOR_ROWS { EPI_ROWDEF float s = 0.f; const float r = r2[rit];
#pragma unroll
            for (int bj = 0; bj < 2; ++bj) { const size_t off = (size_t)row * DM + u.pn * BM + bj * HALF + wc * 32 + 8 * fq;
                const u32x4 pp = __builtin_nontemporal_load((const u32x4*)(PP + off));
                const u32x4 hb = __builtin_nontemporal_load((const u32x4*)(HBr + off));
                f32x4 h0 = {bflo(hb.x), bfhi(hb.x), bflo(hb.y), bfhi(hb.y)}, h1 = {bflo(hb.z), bfhi(hb.z), bflo(hb.w), bfhi(hb.w)};
                const f32x4 a0 = acc[ai][bj][m][0] * r, a1 = acc[ai][bj][m][1] * r;
                h0[0] += sigmoidf_(a0[0]) * bflo(pp.x); h0[1] += sigmoidf_(a0[1]) * bfhi(pp.x); h0[2] += sigmoidf_(a0[2]) * bflo(pp.y); h0[3] += sigmoidf_(a0[3]) * bfhi(pp.y);
                h1[0] += sigmoidf_(a1[0]) * bflo(pp.z); h1[1] += sigmoidf_(a1[1]) * bfhi(pp.z); h1[2] += sigmoidf_(a1[2]) * bflo(pp.w); h1[3] += sigmoidf_(a1[3]) * bfhi(pp.w);
                acc[ai][bj][m][0] = h0; acc[ai][bj][m][1] = h1;
                s += (h0[0] * h0[0] + h0[1] * h0[1]) + (h0[2] * h0[2] + h0[3] * h0[3]) + (h1[0] * h1[0] + h1[1] * h1[1]) + (h1[2] * h1[2] + h1[3] * h1[3]); }
            s += swz_xor<16>(s); s = sum_xor32(s);
            if (fq == 0) P[rit * 4 + wc] = s; }
        LDS_WAIT(); __builtin_amdgcn_s_barrier(); asm volatile("" ::: "memory");
        if (tid < 256) { const float t = (P[tid * 4] + P[tid * 4 + 1]) + (P[tid * 4 + 2] + P[tid * 4 + 3]);
            __hip_atomic_store(ssq + (size_t)(u.pm * 256 + tid) * 8 + u.pn, t, __ATOMIC_RELAXED, __HIP_MEMORY_SCOPE_AGENT); }
        asm volatile("s_waitcnt vmcnt(0)" ::: "memory");
        if (wid < 4 && l_ == 0) __hip_atomic_fetch_add(cnt + 64 * u.pm, 1u, __ATOMIC_RELAXED, __HIP_MEMORY_SCOPE_AGENT);
        if (wid == 0) {
            unsigned sp = 0;
            while ((unsigned)__builtin_amdgcn_readfirstlane(__hip_atomic_load(cnt + 64 * u.pm, __ATOMIC_RELAXED, __HIP_MEMORY_SCOPE_AGENT)) < 32u) { __builtin_amdgcn_s_sleep(2); if (++sp > (1u << 22)) break; }
            __builtin_amdgcn_fence(__ATOMIC_ACQUIRE, "agent");
        }
        asm volatile("s_waitcnt vmcnt(0) lgkmcnt(0)" ::: "memory"); __builtin_amdgcn_s_barrier(); asm volatile("" ::: "memory");
        if (tid < 256) { const float* sp = ssq + (size_t)(u.pm * 256 + tid) * 8; float t = 0.f;
#pragma unroll
            for (int i = 0; i < 8; ++i) t += __hip_atomic_load(sp + i, __ATOMIC_RELAXED, __HIP_MEMORY_SCOPE_AGENT);
            Rn[tid] = rsqrtf(t * (1.f / DM) + EPS); }
        LDS_WAIT(); __builtin_amdgcn_s_barrier(); asm volatile("" ::: "memory");
        EPI_FOR_ROWS { EPI_ROWDEF const float rn = Rn[rit];
#pragma unroll
            for (int bj = 0; bj < 2; ++bj) { const int col = u.pn * BM + bj * HALF + wc * 32 + 8 * fq; const size_t off = (size_t)row * DM + col;
                *(f32x4*)(H + off) = acc[ai][bj][m][0] * rn * *(const f32x4*)(nf + col); *(f32x4*)(H + off + 4) = acc[ai][bj][m][1] * rn * *(const f32x4*)(nf + col + 4); } }
    }
};
}

namespace att {
constexpr int D = 128, NW = 8, QBLK = 32, KVBLK = 64;
constexpr float SCALE = 0.088388347648318440f;
constexpr float THR = 8.f;
constexpr int LDQ = DATT, LDK = DKV;
constexpr size_t SHM_V = KVBLK * D * 2, SHM_K = KVBLK * D * 2, SHM_ATTN = 2 * SHM_V + 2 * SHM_K + NW * 64 * 4;
#define KSWZ(row, colB) ((row) * 256 + ((colB) ^ (((row) & 7) << 4)))
#define SBAR() __builtin_amdgcn_sched_barrier(0)
__device__ __forceinline__ int crow(int r, int hi) { return (r & 3) + 8 * (r >> 2) + 4 * hi; }
__device__ __forceinline__ void partialSM(f32x16& p0, f32x16& p1, float& m_reg, float& mn, float& alpha) {
  constexpr float C = SCALE * 1.4426950408889634f;
  float pmax = p0[0]; for (int r = 1; r < 16; ++r) pmax = fmaxf(pmax, p0[r]); for (int r = 0; r < 16; ++r) pmax = fmaxf(pmax, p1[r]);
  { auto rr = __builtin_amdgcn_permlane32_swap(__float_as_uint(pmax), __float_as_uint(pmax), false, false);
    pmax = fmaxf(__uint_as_float(rr[0]), __uint_as_float(rr[1])); }
  if (__builtin_expect(__all(pmax - m_reg <= THR / SCALE), 1)) { mn = m_reg; alpha = 1.f; }
  else { mn = fmaxf(m_reg, pmax); alpha = __builtin_amdgcn_exp2f((m_reg - mn) * C); m_reg = mn; }
  float mnC = -mn * C;
  for (int r = 0; r < 16; ++r) p0[r] = fmaf(p0[r], C, mnC); for (int r = 0; r < 16; ++r) p1[r] = fmaf(p1[r], C, mnC);
  for (int r = 0; r < 16; ++r) p0[r] = __builtin_amdgcn_exp2f(p0[r]);
}
__device__ __forceinline__ void finishSM(f32x16& p0, f32x16& p1, float alpha, float& l_reg, bf16x8& pa0, bf16x8& pa1, bf16x8& pa2, bf16x8& pa3) {
  for (int r = 0; r < 16; ++r) p1[r] = __builtin_amdgcn_exp2f(p1[r]);
  float ps = 0; for (int r = 0; r < 16; ++r) ps += p0[r]; for (int r = 0; r < 16; ++r) ps += p1[r];
  { auto rr = __builtin_amdgcn_permlane32_swap(__float_as_uint(ps), __float_as_uint(ps), false, false);
    ps = __uint_as_float(rr[0]) + __uint_as_float(rr[1]); }
  l_reg = l_reg * alpha + ps;
#define PK4(P, BASE, OUT) do { unsigned a0 = cvt_pk_bf16(P[BASE + 0], P[BASE + 1]), a1 = cvt_pk_bf16(P[BASE + 2], P[BASE + 3]);   \
    unsigned b0 = cvt_pk_bf16(P[BASE + 4], P[BASE + 5]), b1 = cvt_pk_bf16(P[BASE + 6], P[BASE + 7]);                              \
    auto r0 = __builtin_amdgcn_permlane32_swap(a0, b0, false, false); auto r1 = __builtin_amdgcn_permlane32_swap(a1, b1, false, false); \
    u32x4 w = {r0[0], r1[0], r0[1], r1[1]}; OUT = *reinterpret_cast<bf16x8*>(&w); } while (0)
  PK4(p0, 0, pa0); PK4(p0, 8, pa1); PK4(p1, 0, pa2); PK4(p1, 8, pa3);
#undef PK4
}
__device__ __forceinline__ void qkt(f32x16& p0, f32x16& p1, const bf16_t* Ks, const bf16x8* qr, int r32, int hi) {
  p0 = f32x16{}; p1 = f32x16{};
  for (int d0 = 0; d0 < 8; ++d0) { int cb = (d0 * 16 + hi * 8) * 2;
    bf16x8 b0 = *reinterpret_cast<const bf16x8*>((const char*)Ks + KSWZ(r32, cb));
    bf16x8 b1 = *reinterpret_cast<const bf16x8*>((const char*)Ks + KSWZ(32 + r32, cb));
    p0 = __builtin_amdgcn_mfma_f32_32x32x16_bf16(b0, qr[d0], p0, 0, 0, 0);
    p1 = __builtin_amdgcn_mfma_f32_32x32x16_bf16(b1, qr[d0], p1, 0, 0, 0); }
}
__device__ __forceinline__ int v_st(int k, int c) { const int kk = (k & ~0xC) | ((k & 4) << 1) | ((k & 8) >> 1); return ((kk >> 3) * 4 + (c >> 5)) * 512 + ((kk & 7) * 32 + (c & 31)) * 2; }
__device__ __forceinline__ int v_rd_base(int lane) { return ((lane & 3) << 3) | (((lane >> 2) & 3) << 6) | (((lane >> 4) & 1) << 5) | (((lane >> 5) & 1) << 8); }
constexpr int v_rd_off(int d0, int ks, int half) { return d0 * 512 + ks * 4096 + half * 2048; }
template <int OFF> __device__ __forceinline__ s16x4 tr_read(int vb) {
  s16x4 r; asm volatile("ds_read_b64_tr_b16 %0, %1 offset:%2" : "=&v"(r) : "v"(vb), "i"(OFF) : "memory"); return r;
}
template <int D0> __device__ __forceinline__ void pv_one(f32x16& od, int vb, bf16x8 pa0, bf16x8 pa1, bf16x8 pa2, bf16x8 pa3) {
  const s16x4 l0 = tr_read<v_rd_off(D0, 0, 0)>(vb), h0 = tr_read<v_rd_off(D0, 0, 1)>(vb), l1 = tr_read<v_rd_off(D0, 1, 0)>(vb), h1 = tr_read<v_rd_off(D0, 1, 1)>(vb);
  const s16x4 l2 = tr_read<v_rd_off(D0, 2, 0)>(vb), h2 = tr_read<v_rd_off(D0, 2, 1)>(vb), l3 = tr_read<v_rd_off(D0, 3, 0)>(vb), h3 = tr_read<v_rd_off(D0, 3, 1)>(vb);
  asm volatile("s_waitcnt lgkmcnt(0)" ::: "memory"); SBAR();
#define PK(L, H) (bf16x8){L[0], L[1], L[2], L[3], H[0], H[1], H[2], H[3]}
  od = __builtin_amdgcn_mfma_f32_32x32x16_bf16(pa0, PK(l0, h0), od, 0, 0, 0);
  od = __builtin_amdgcn_mfma_f32_32x32x16_bf16(pa1, PK(l1, h1), od, 0, 0, 0);
  od = __builtin_amdgcn_mfma_f32_32x32x16_bf16(pa2, PK(l2, h2), od, 0, 0, 0);
  od = __builtin_amdgcn_mfma_f32_32x32x16_bf16(pa3, PK(l3, h3), od, 0, 0, 0);
#undef PK
}
__device__ __forceinline__ void pv_d0(f32x16* o, int vb, bf16x8 pa0, bf16x8 pa1, bf16x8 pa2, bf16x8 pa3) {
  pv_one<0>(o[0], vb, pa0, pa1, pa2, pa3); pv_one<1>(o[1], vb, pa0, pa1, pa2, pa3); pv_one<2>(o[2], vb, pa0, pa1, pa2, pa3); pv_one<3>(o[3], vb, pa0, pa1, pa2, pa3);
}
__device__ __forceinline__ void attn_dense_body(const bf16_t* __restrict__ Qb, const bf16_t* __restrict__ Kh, const bf16_t* __restrict__ Vh,
                                                const bf16_t* __restrict__ Gb, bf16_t* __restrict__ Yb, int seq, char* lds, const int wid) {
  const int lane = lane_id_opaque(), tid = wid * 64 + lane, r32 = lane & 31, hi = lane >> 5;
  bf16_t* V_lds = (bf16_t*)lds; bf16_t* K_lds = (bf16_t*)(lds + 2 * SHM_V);
  float* ws = (float*)(lds + 2 * SHM_V + 2 * SHM_K) + wid * 64; float* li_l = ws; float* al_l = ws + 32;
  float m_reg = -1e30f, l_reg = 0; f32x16 o[4] = {}; bf16x8 qr[8];
  const bf16_t* Qw = Qb + (long)(wid * QBLK + r32) * LDQ + hi * 8;
#pragma unroll
  for (int d0 = 0; d0 < 8; ++d0) qr[d0] = __builtin_nontemporal_load(reinterpret_cast<const bf16x8*>(Qw + d0 * 16));
  const int sr = tid >> 4, sc = (tid & 15) * 8, vst0 = v_st(sr, sc), vst1 = v_st(32 + sr, sc);
  const int vb0 = (int)(uintptr_t)V_lds + v_rd_base(lane);
  struct { bf16x8 vs0, vs1, ks0, ks1; } sr_[2];
#define SLOAD(i, k0) do { sr_[i].vs0 = *reinterpret_cast<const bf16x8*>(&Vh[(long)((k0) + sr) * LDK + sc]); sr_[i].vs1 = *reinterpret_cast<const bf16x8*>(&Vh[(long)((k0) + 32 + sr) * LDK + sc]); \
    sr_[i].ks0 = *reinterpret_cast<const bf16x8*>(&Kh[(long)((k0) + sr) * LDK + sc]); sr_[i].ks1 = *reinterpret_cast<const bf16x8*>(&Kh[(long)((k0) + 32 + sr) * LDK + sc]); } while (0)
#define SWRITE(b, i) do { *(bf16x8*)((char*)V_lds + (b) * SHM_V + vst0) = sr_[i].vs0;          \
    *(bf16x8*)((char*)V_lds + (b) * SHM_V + vst1) = sr_[i].vs1; int kc = sc * 2;               \
    *(bf16x8*)((char*)K_lds + (b) * SHM_K + KSWZ(sr, kc)) = sr_[i].ks0;                       \
    *(bf16x8*)((char*)K_lds + (b) * SHM_K + KSWZ(32 + sr, kc)) = sr_[i].ks1; } while (0)
#define SWAIT() asm volatile("s_waitcnt vmcnt(4)" ::: "memory")
#define RESC(a) do { if (__any((a) < 1.f)) { if (hi == 0) al_l[r32] = (a); asm volatile("s_waitcnt lgkmcnt(0)" ::: "memory"); \
    for (int d = 0; d < 4; ++d) for (int r = 0; r < 16; ++r) o[d][r] *= al_l[crow(r, hi)]; } } while (0)
  f32x16 pA0, pA1, pB0, pB1; float mnA, mnB, alA, alB; bf16x8 pa0, pa1, pa2, pa3; const int NT = seq / KVBLK;
  constexpr int SE = 0, SO = 1;
  SLOAD(SE, 0); asm volatile("s_waitcnt vmcnt(0)" ::: "memory"); SWRITE(0, SE); __syncthreads();
  qkt(pA0, pA1, K_lds, qr, r32, hi); partialSM(pA0, pA1, m_reg, mnA, alA);
  SLOAD(SO, KVBLK); if (2 < NT) SLOAD(SE, 2 * KVBLK);
  SWAIT(); SWRITE(1, SO); __syncthreads();
  for (int j = 1; j + 1 < NT; j += 2) {
    SBAR(); qkt(pB0, pB1, (bf16_t*)((char*)K_lds + SHM_K), qr, r32, hi);
    finishSM(pA0, pA1, alA, l_reg, pa0, pa1, pa2, pa3); SBAR();
    SLOAD(SO, (j + 2) * KVBLK); SBAR();
    pv_d0(o, vb0, pa0, pa1, pa2, pa3); partialSM(pB0, pB1, m_reg, mnB, alB);
    __syncthreads(); SWAIT(); SWRITE(0, SE);
    RESC(alB); __syncthreads();
    SBAR(); qkt(pA0, pA1, K_lds, qr, r32, hi);
    finishSM(pB0, pB1, alB, l_reg, pa0, pa1, pa2, pa3); SBAR();
    if (j + 3 < NT) SLOAD(SE, (j + 3) * KVBLK); SBAR();
    pv_d0(o, vb0 + (int)SHM_V, pa0, pa1, pa2, pa3); partialSM(pA0, pA1, m_reg, mnA, alA);
    __syncthreads(); SWAIT(); SWRITE(1, SO);
    RESC(alA); __syncthreads();
  }
  SBAR(); qkt(pB0, pB1, (bf16_t*)((char*)K_lds + SHM_K), qr, r32, hi);
  finishSM(pA0, pA1, alA, l_reg, pa0, pa1, pa2, pa3); SBAR();
  pv_d0(o, vb0, pa0, pa1, pa2, pa3); partialSM(pB0, pB1, m_reg, mnB, alB);
  __syncthreads(); RESC(alB);
  finishSM(pB0, pB1, alB, l_reg, pa0, pa1, pa2, pa3); SBAR();
  pv_d0(o, vb0 + (int)SHM_V, pa0, pa1, pa2, pa3);
  if (hi == 0) li_l[r32] = l_reg; asm volatile("s_waitcnt lgkmcnt(0)" ::: "memory");
  float rli[16];
#pragma unroll
  for (int r = 0; r < 16; ++r) rli[r] = __builtin_amdgcn_rcpf(li_l[crow(r, hi)]);
  bf16_t* Yw = Yb + (long)(wid * QBLK) * DM; const bf16_t* Gw = Gb + (long)(wid * QBLK) * DATT;
  __syncthreads();
  bf16_t* stg = (bf16_t*)(lds + wid * 8192);
#pragma unroll
  for (int r = 0; r < 16; ++r) { const int orow = crow(r, hi);
#pragma unroll
    for (int d0 = 0; d0 < 4; ++d0) stg[orow * 128 + d0 * 32 + r32] = (bf16_t)f2bf(o[d0][r] * rli[r]); }
  asm volatile("s_waitcnt lgkmcnt(0)" ::: "memory");
  const int l2 = lane_id_opaque();
#pragma unroll
  for (int i = 0; i < 8; ++i) { const int q = l2 + 64 * i, row = q >> 4, c8 = (q & 15) * 8;
    const u32x4 v = *(const u32x4*)(stg + row * 128 + c8); const u32x4 gg = __builtin_nontemporal_load((const u32x4*)(Gw + (unsigned)(row * DATT + c8)));
    u32x4 w; w.x = pk2(bflo(v.x) * bflo(gg.x), bfhi(v.x) * bfhi(gg.x)); w.y = pk2(bflo(v.y) * bflo(gg.y), bfhi(v.y) * bfhi(gg.y));
    w.z = pk2(bflo(v.z) * bflo(gg.z), bfhi(v.z) * bfhi(gg.z)); w.w = pk2(bflo(v.w) * bflo(gg.w), bfhi(v.w) * bfhi(gg.w));
    *(u32x4*)(Yw + (unsigned)(row * DM + c8)) = w; }
  __syncthreads();
#undef SLOAD
#undef SWRITE
#undef SWAIT
#undef RESC
}
#undef SBAR
}

__device__ __forceinline__ void p0_transpose_item(const float* W, int K, int N, bf16_t* WT, int wt_row0, const float* kscale, LAS float* scr, int k0, int n0, int lane) {
#pragma unroll
    for (int i = 0; i < 32; ++i) { const int kk = 2 * i + (lane >> 5); float v = W[(size_t)(k0 + kk) * N + n0 + (lane & 31)]; if (kscale) v *= kscale[k0 + kk]; scr[kk * 33 + (lane & 31)] = v; }
    LDS_WAIT(); asm volatile("" ::: "memory");
    const int c = lane & 7;
#pragma unroll
    for (int j = 0; j < 4; ++j) { const int n = (lane >> 3) + 8 * j; const LAS float* s = scr + (8 * c) * 33 + n;
        u32x4 o; o.x = pk2(s[0 * 33], s[1 * 33]); o.y = pk2(s[2 * 33], s[3 * 33]); o.z = pk2(s[4 * 33], s[5 * 33]); o.w = pk2(s[6 * 33], s[7 * 33]);
        *(u32x4*)(WT + (size_t)(wt_row0 + n) * K + k0 + 8 * c) = o; }
    LDS_WAIT(); asm volatile("" ::: "memory");
}

struct TrItem { const float* W; bf16_t* WT; const float* kscale; int K, N, wt_row0, k0, n0; };
__device__ __forceinline__ void p0_tr_load(const TrItem& d, float (&v)[32], int lane) {
#pragma unroll
    for (int i = 0; i < 32; ++i) { const int kk = 2 * i + (lane >> 5); v[i] = __builtin_nontemporal_load(d.W + (size_t)(d.k0 + kk) * d.N + d.n0 + (lane & 31)); }
    if (d.kscale) {
#pragma unroll
        for (int i = 0; i < 32; ++i) { const int kk = 2 * i + (lane >> 5); v[i] *= d.kscale[d.k0 + kk]; } }
}
__device__ __forceinline__ void p0_tr_store(const TrItem& d, const float (&v)[32], LAS float* scr, int lane) {
#pragma unroll
    for (int i = 0; i < 32; ++i) { const int kk = 2 * i + (lane >> 5); scr[kk * 33 + (lane & 31)] = v[i]; }
    LDS_WAIT(); asm volatile("" ::: "memory");
    const int c = lane & 7;
#pragma unroll
    for (int j = 0; j < 4; ++j) { const int n = (lane >> 3) + 8 * j; const LAS float* s = scr + (8 * c) * 33 + n;
        u32x4 o; o.x = pk2(s[0 * 33], s[1 * 33]); o.y = pk2(s[2 * 33], s[3 * 33]); o.z = pk2(s[4 * 33], s[5 * 33]); o.w = pk2(s[6 * 33], s[7 * 33]);
        *(u32x4*)(d.WT + (size_t)(d.wt_row0 + n) * d.K + d.k0 + 8 * c) = o; }
    LDS_WAIT(); asm volatile("" ::: "memory");
}
__device__ __forceinline__ void ssm_tables(const Args& a, int g, LAS unsigned char* lds, int tid) {
    LAS float* LD = (LAS float*)lds;
    LAS float* LBs = LD + 256;
    LAS float* BB = LBs + 256;
    LAS float* KT = BB + 4096;
    LAS float* CC = KT + 8192;
    float* lb16 = (float*)(a.ws + WS_LB16);
    bf16_t* WIN = (bf16_t*)(a.ws + WS_WIN) + (size_t)g * 256 * 256;
    bf16_t* WBIG = (bf16_t*)(a.ws + WS_WBIG) + (size_t)g * 256 * 512;
    LAS float* DD = CC + 4096;
    float cre_[4], cim_[4], bre_[4], bim_[4];
#pragma unroll
    for (int k = 0; k < 4; ++k) { const int e = tid + 512 * k; const int d = e >> 10, r = e & 1023; const size_t ci_ = (size_t)(d * NG + g) * 1024 + r; cre_[k] = a.c_re[ci_]; cim_[k] = a.c_im[ci_];
        const int dp = e >> 4, h = e & 15, d2 = dp >> 6, p2 = dp & 63; const size_t bi_ = ((size_t)(d2 * NG + g) * 64 + p2) * 16 + h; bre_[k] = a.b_re[bi_]; bim_[k] = a.b_im[bi_]; }
    const float dld = a.ssm_d[g * 16 + (tid & 15)];
    const int d_a = (tid >> 6) & 1, p_a = tid & 63, idx_a = (d_a * NG + g) * 64 + p_a;
    const float are_ = a.a_re[idx_a], aim_ = a.a_im[idx_a], ldt_ = a.log_dt[d_a * NG + g];
#pragma unroll
    for (int k = 0; k < 4; ++k) { const int e = tid + 512 * k; CC[e * 2] = cre_[k]; CC[e * 2 + 1] = cim_[k]; }
    if (tid < 16) DD[tid] = dld;
    if (tid < 128) {
        const float lr = fminf(are_, -1e-4f), li = aim_;
        const float dt = expf(ldt_);
        const float er = expf(lr * dt); float sn, cs; sincosf(li * dt, &sn, &cs);
        const float br = er * cs, bi = er * sn;
        LD[tid * 2] = lr * dt; LD[tid * 2 + 1] = li * dt; LBs[tid * 2] = br; LBs[tid * 2 + 1] = bi;
        const float nr = br - 1.f, ni = bi, den = lr * lr + li * li;
        KT[tid * 2] = (nr * lr + ni * li) / den; KT[tid * 2 + 1] = (ni * lr - nr * li) / den;
        const float e16 = expf(16.f * lr * dt); float s16, c16; sincosf(16.f * li * dt, &s16, &c16);
        lb16[(g * 128 + tid) * 2] = e16 * c16; lb16[(g * 128 + tid) * 2 + 1] = e16 * s16;
    }
    __syncthreads();
#pragma unroll
    for (int k = 0; k < 4; ++k) { const int e = tid + 512 * k; const int dp = e >> 4;
        const float xr = bre_[k], xi = bim_[k], cr = KT[dp * 2], ci = KT[dp * 2 + 1];
        BB[e * 2] = cr * xr - ci * xi; BB[e * 2 + 1] = cr * xi + ci * xr;
    }
    __syncthreads();
    {
        const int d = tid >> 8, hp = (tid >> 4) & 15, h = tid & 15; float acc[16];
#pragma unroll
        for (int t = 0; t < 16; ++t) acc[t] = 0.f;
        const LAS float* cc = CC + ((d * 16 + hp) * 64) * 2;
#pragma unroll 4
        for (int p = 0; p < 64; ++p) {
            const float c_r = cc[p * 2], c_i = cc[p * 2 + 1], b_r = BB[((d * 64 + p) * 16 + h) * 2], b_i = BB[((d * 64 + p) * 16 + h) * 2 + 1];
            float wr = c_r * b_r - c_i * b_i, wi = c_r * b_i + c_i * b_r; const float l_r = LBs[(d * 64 + p) * 2], l_i = LBs[(d * 64 + p) * 2 + 1];
#pragma unroll
            for (int t = 0; t < 16; ++t) { acc[t] += wr; const float nr = wr * l_r - wi * l_i; wi = wr * l_i + wi * l_r; wr = nr; }
        }
#pragma unroll
        for (int t = 0; t < 16; ++t) KT[((d * 16 + t) * 16 + hp) * 16 + h] = acc[t];
    }
    __syncthreads();
    for (int q = tid; q < 8192; q += 512) {
        const int n = q >> 5, kc = q & 31, s = kc >> 1, h0 = (kc & 1) * 8, j = n >> 4, hp = n & 15;
        const int dsel = s < j ? 0 : 1, tau = s < j ? j - s : s - j;
        const LAS float* k0 = KT + ((dsel * 16 + tau) * 16 + hp) * 16 + h0;
        const LAS float* kf = KT + ((0 * 16 + 0) * 16 + hp) * 16 + h0; const LAS float* kb = KT + ((1 * 16 + 0) * 16 + hp) * 16 + h0;
        const bool diag = (s == j); const float dval = DD[hp];
        float v[8];
#pragma unroll
        for (int e = 0; e < 8; ++e) { const float off = k0[e], dg = kf[e] + kb[e] + ((h0 + e) == hp ? dval : 0.f); v[e] = diag ? dg : off; }
        u32x4 w; w.x = pk2(v[0], v[1]); w.y = pk2(v[2], v[3]); w.z = pk2(v[4], v[5]); w.w = pk2(v[6], v[7]);
        *(u32x4*)(WBIG + (size_t)n * 512 + s * 16 + h0) = w;
    }
    for (int q = tid; q < 2048; q += 512) {
        const int p = q & 63, js = (q >> 6) & 15, d = q >> 10; const float ldr = LD[(d * 64 + p) * 2], ldi = LD[(d * 64 + p) * 2 + 1];
        {   const float pw = (float)(d == 0 ? js + 1 : 16 - js); const float er = __expf(pw * ldr); float sn, cs; __sincosf(pw * ldi, &sn, &cs); const float pr = er * cs, pi = er * sn;
#pragma unroll
            for (int hp = 0; hp < 16; ++hp) { const float c_r = CC[((d * 16 + hp) * 64 + p) * 2], c_i = CC[((d * 16 + hp) * 64 + p) * 2 + 1];
                *(unsigned*)(WBIG + (size_t)(js * 16 + hp) * 512 + 256 + d * 128 + 2 * p) = pk2(c_r * pr - c_i * pi, -(c_r * pi + c_i * pr)); } }
        {   const float pw = (float)(d == 0 ? 15 - js : js); const float er = __expf(pw * ldr); float sn, cs; __sincosf(pw * ldi, &sn, &cs); const float pr = er * cs, pi = er * sn;
            float zr[16], zi[16];
#pragma unroll
            for (int h = 0; h < 16; ++h) { const float b_r = BB[((d * 64 + p) * 16 + h) * 2], b_i = BB[((d * 64 + p) * 16 + h) * 2 + 1]; zr[h] = pr * b_r - pi * b_i; zi[h] = pr * b_i + pi * b_r; }
            bf16_t* d0 = WIN + (size_t)(d * 128 + p) * 256 + js * 16; bf16_t* d1 = d0 + (size_t)64 * 256;
            u32x4 w; w.x = pk2(zr[0], zr[1]); w.y = pk2(zr[2], zr[3]); w.z = pk2(zr[4], zr[5]); w.w = pk2(zr[6], zr[7]); *(u32x4*)d0 = w;
            w.x = pk2(zr[8], zr[9]); w.y = pk2(zr[10], zr[11]); w.z = pk2(zr[12], zr[13]); w.w = pk2(zr[14], zr[15]); *(u32x4*)(d0 + 8) = w;
            w.x = pk2(zi[0], zi[1]); w.y = pk2(zi[2], zi[3]); w.z = pk2(zi[4], zi[5]); w.w = pk2(zi[6], zi[7]); *(u32x4*)d1 = w;
            w.x = pk2(zi[8], zi[9]); w.y = pk2(zi[10], zi[11]); w.z = pk2(zi[12], zi[13]); w.w = pk2(zi[14], zi[15]); *(u32x4*)(d1 + 8) = w; }
    }
    __syncthreads();
}

#define XB_TMO      128
#define XB_XCNT(j)  (256  + 64 * (j))
#define XB_XSUB(j)  (1280 + 64 * (j))
#define XB_XGEN(j)  (2304 + 64 * (j))
#define XB_TOP      3328
#define XB_TOPGEN   3392
#define XCD_BAR_WORDS 3456
#define XB_SPIN_CAP (1u << 18)
__device__ __forceinline__ unsigned xb_ld(unsigned* p)              { return __hip_atomic_load(p, __ATOMIC_RELAXED, __HIP_MEMORY_SCOPE_AGENT); }
__device__ __forceinline__ unsigned xb_add(unsigned* p, unsigned v) { return __hip_atomic_fetch_add(p, v, __ATOMIC_RELAXED, __HIP_MEMORY_SCOPE_AGENT); }
__device__ __forceinline__ unsigned xb_xcc_id() { return (unsigned)__builtin_amdgcn_s_getreg((3 << 11) | 20) & 0xFu; }
#define XB_SPIN(cond, bar) do { unsigned _sp = 0; while (cond) { __builtin_amdgcn_s_sleep(1); \
    if ((++_sp & 255u) == 0u) { if (xb_ld(&(bar)[XB_TMO])) break; if (_sp > XB_SPIN_CAP) { atomicAdd(&(bar)[XB_TMO], 1u); break; } } } } while (0)
struct XcdBarrier { unsigned* bar; unsigned x; volatile LAS unsigned* st; };
__device__ __forceinline__ XcdBarrier xcd_barrier_post(unsigned* bar, volatile LAS unsigned* st, bool leader) {
    XcdBarrier b; b.bar = bar; b.x = xb_xcc_id(); b.st = st;
    if (leader) (void)xb_add(&bar[XB_XCNT(b.x)], 1u);
    return b;
}
__device__ __forceinline__ void xcd_barrier_complete(unsigned* bar, unsigned x, unsigned& nloc, unsigned& nx) {
    const unsigned G = gridDim.x * gridDim.y * gridDim.z;
    unsigned sum, cnt, mine, sp = 0u;
    for (;;) {
        sum = 0u; cnt = 0u; mine = 0u;
#pragma unroll
        for (unsigned j = 0; j < 16; ++j) { const unsigned c = xb_ld(&bar[XB_XCNT(j)]); sum += c; cnt += (c > 0u) ? 1u : 0u; mine = (j == x) ? c : mine; }
        if (sum == G) break;
        __builtin_amdgcn_s_sleep(1);
        if ((++sp & 255u) == 0u) { if (xb_ld(&bar[XB_TMO])) break; if (sp > XB_SPIN_CAP) { atomicAdd(&bar[XB_TMO], 1u); break; } }
    }
    nloc = mine > 0u ? mine : 1u; nx = cnt > 0u ? cnt : 1u;
}
__device__ __forceinline__ void xcd_barrier(const XcdBarrier& b, bool leader) {
    asm volatile("s_waitcnt vmcnt(0)" ::: "memory");
    __syncthreads();
    if (leader) {
        unsigned* bar = b.bar;
        __builtin_amdgcn_s_waitcnt(0);
        unsigned nloc = b.st[0], nx = b.st[1];
        if (nloc == 0u) { xcd_barrier_complete(bar, b.x, nloc, nx); b.st[0] = nloc; b.st[1] = nx; }
        const unsigned old = xb_add(&bar[XB_XSUB(b.x)], 1u);
        const unsigned gen = old / nloc;
        if (old + 1u == (gen + 1u) * nloc) {
            __builtin_amdgcn_fence(__ATOMIC_RELEASE, "agent");
            asm volatile("s_waitcnt vmcnt(0)" ::: "memory");
            const unsigned og = xb_add(&bar[XB_TOP], 1u);
            const unsigned tg = og / nx;
            if (og + 1u == (tg + 1u) * nx) xb_add(&bar[XB_TOPGEN], 1u);
            else XB_SPIN(xb_ld(&bar[XB_TOPGEN]) == tg, bar);
            __builtin_amdgcn_fence(__ATOMIC_ACQUIRE, "agent");
            xb_add(&bar[XB_XGEN(b.x)], 1u);
            asm volatile("s_waitcnt vmcnt(0)" ::: "memory");
        } else {
            XB_SPIN(xb_ld(&bar[XB_XGEN(b.x)]) == gen, bar);
            __builtin_amdgcn_fence(__ATOMIC_ACQUIRE, "agent");
            asm volatile("s_waitcnt vmcnt(0)" ::: "memory");
        }
    }
    __syncthreads();
}

__device__ __forceinline__ void xcd_barrier_arrive(const XcdBarrier& b, bool leader) {
    asm volatile("s_waitcnt vmcnt(0)" ::: "memory");
    __syncthreads();
    if (leader) {
        unsigned* bar = b.bar;
        __builtin_amdgcn_s_waitcnt(0);
        unsigned nloc = b.st[0], nx = b.st[1];
        if (nloc == 0u) { xcd_barrier_complete(bar, b.x, nloc, nx); b.st[0] = nloc; b.st[1] = nx; }
        const unsigned old = xb_add(&bar[XB_XSUB(b.x)], 1u);
        const unsigned gen = old / nloc;
        if (old + 1u == (gen + 1u) * nloc) {
            __builtin_amdgcn_fence(__ATOMIC_RELEASE, "agent");
            asm volatile("s_waitcnt vmcnt(0)" ::: "memory");
            const unsigned og = xb_add(&bar[XB_TOP], 1u);
            const unsigned tg = og / nx;
            if (og + 1u == (tg + 1u) * nx) { xb_add(&bar[XB_TOPGEN], 1u); b.st[5] = 3u; } else b.st[5] = 2u;
            b.st[6] = tg;
        } else { b.st[5] = 1u; b.st[6] = gen; }
    }
}
__device__ __forceinline__ void xcd_barrier_wait(const XcdBarrier& b, bool leader) {
    if (leader) {
        unsigned* bar = b.bar; const unsigned role = b.st[5], g = b.st[6];
        if (role >= 2u) {
            if (role == 2u) XB_SPIN(xb_ld(&bar[XB_TOPGEN]) == g, bar);
            __builtin_amdgcn_fence(__ATOMIC_ACQUIRE, "agent");
            xb_add(&bar[XB_XGEN(b.x)], 1u);
            asm volatile("s_waitcnt vmcnt(0)" ::: "memory");
        } else {
            XB_SPIN(xb_ld(&bar[XB_XGEN(b.x)]) == g, bar);
            __builtin_amdgcn_fence(__ATOMIC_ACQUIRE, "agent");
            asm volatile("s_waitcnt vmcnt(0)" ::: "memory");
        }
    }
    __syncthreads();
}

__global__ void __launch_bounds__(512, 2) fwd_kernel(Args a) {
    extern __shared__ __attribute__((aligned(16))) unsigned char lds_raw[];
    LAS unsigned char* lds = (LAS unsigned char*)lds_raw;
    cg::grid_group grid = cg::this_grid();
    const int wave = __builtin_amdgcn_readfirstlane(threadIdx.x >> 6);
    const bool leader = (wave == 0) && (lane_id_opaque() == 0);
    volatile LAS unsigned* xst = (volatile LAS unsigned*)(lds + XBST_OFF);
    if (leader) { xst[0] = 0u; xst[1] = 0u; }
    __syncthreads();
    if (a.ws == nullptr) grid.sync();
    const XcdBarrier xbar = xcd_barrier_post((unsigned*)(a.ws + WS_BAR), xst, leader);
#define GRID_SYNC() xcd_barrier(xbar, (wave == 0) && (lane_id_opaque() == 0))
#define LANE_IDS const int lane = lane_id_opaque(), tid = wave * 64 + lane; (void)tid;
    const int G = gridDim.x, bid = blockIdx.x;
    unsigned char* ws = a.ws;
    bf16_t* W1T = (bf16_t*)(ws + WS_W1T); bf16_t* WGLUT = (bf16_t*)(ws + WS_WGLUT); bf16_t* WOT = (bf16_t*)(ws + WS_WOT); bf16_t* WGT = (bf16_t*)(ws + WS_WGT); bf16_t* WPT = (bf16_t*)(ws + WS_WPT);
    float2* ROPE = (float2*)(ws + WS_ROPE); float* RINV = (float*)(ws + WS_RINV); float* LB16 = (float*)(ws + WS_LB16); float* SSQ1 = (float*)(ws + WS_SSQ1); float* SSQ2 = (float*)(ws + WS_SSQ2);
    bf16_t* PB = (bf16_t*)(ws + WS_PB); bf16_t* WIN = (bf16_t*)(ws + WS_WIN); bf16_t* WBIG = (bf16_t*)(ws + WS_WBIG);
    bf16_t* XB = (bf16_t*)(ws + WS_XB); bf16_t* HB = (bf16_t*)(ws + WS_XB);
    bf16_t* Q = (bf16_t*)(ws + WS_Q); bf16_t* KB = (bf16_t*)(ws + WS_K); bf16_t* VB = (bf16_t*)(ws + WS_V); bf16_t* GA = (bf16_t*)(ws + WS_GA); bf16_t* GS = (bf16_t*)(ws + WS_GS);
    bf16_t* UCAT = (bf16_t*)(ws + WS_UCAT); bf16_t* PPB = (bf16_t*)(ws + WS_UCAT); bf16_t* YMIX = (bf16_t*)(ws + WS_YMIX); bf16_t* YS = (bf16_t*)(ws + WS_YS);

#pragma unroll
    for (int rep_ = 0; rep_ < 1 + ((REP_MASK >> 0) & 1); ++rep_) { LANE_IDS
        const int gw = bid * 8 + wave, NGW = G * 8;
        LAS float* scr = (LAS float*)(lds + wave * 16384);
        constexpr int I1 = 32 * 144, I2 = 16 * 64, I3 = 32 * 64, I4 = 32 * 64, I5 = 4 * 64, NIT = I1 + I2 + I3 + I4 + I5;
        auto item_desc = [&](int r) -> TrItem {
            if (r < I1) { const int kb = r / 144, lgg = r % 144, pn = lgg >> 3, lg = lgg & 7, wtg = pn * 8 + 4 * (lg & 1) + 2 * (lg >> 2) + ((lg >> 1) & 1);
                return TrItem{a.w_in, W1T, a.norm_mix, DM, DIN, wtg * 32, kb * 64, lgg * 32}; } r -= I1;
            if (r < I2) { const int kb = r / 64, lgg = r % 64, l2 = lgg & 31, wtg = (l2 >> 2) * 8 + 4 * (lgg >> 5) + (l2 & 3);
                return TrItem{a.w_glu, WGLUT, nullptr, DSSM, 2 * DSSM, wtg * 32, kb * 64, lgg * 32}; } r -= I2;
            if (r < I3) { const int kb = r / 64, lgg = r % 64; return TrItem{a.w_out, WOT, nullptr, DM, DM, lgg * 32, kb * 64, lgg * 32}; } r -= I3;
            if (r < I4) { const int kb = r / 64, lgg = r % 64; return TrItem{a.w_ple_gate, WGT, a.norm_ple, DM, DM, lgg * 32, kb * 64, lgg * 32}; } r -= I4;
            const int kb = r / 64, lgg = r % 64; return TrItem{a.w_ple_proj, WPT, nullptr, PLE, DM, lgg * 32, kb * 64, lgg * 32};
        };
#pragma unroll
        for (int rq_ = 0; rq_ < 1 + ((REP_MASK >> 8) & 1); ++rq_)
        for (int it = gw; it < I1; it += 2 * NGW) {
            const bool two = it + NGW < I1;
            const TrItem dA = item_desc(it), dB = item_desc(two ? it + NGW : it);
            float vA[32], vB[32];
            p0_tr_load(dA, vA, lane); if (two) p0_tr_load(dB, vB, lane);
            p0_tr_store(dA, vA, scr, lane); if (two) p0_tr_store(dB, vB, scr, lane);
        }
#pragma unroll
        for (int rq_ = 0; rq_ < 1 + ((REP_MASK >> 9) & 1); ++rq_)
        for (int m = gw; m < T; m += 2 * NGW) {
            const int m2 = m + NGW; const bool two = m2 < T;
            const f32x4* xr = (const f32x4*)(a.x + (size_t)m * DM) + lane; const f32x4* xr2 = (const f32x4*)(a.x + (size_t)(two ? m2 : m) * DM) + lane;
            f32x4 v[8], w2[8]; float s = 0.f, s2 = 0.f;
#pragma unroll
            for (int j = 0; j < 8; ++j) v[j] = __builtin_nontemporal_load(xr + 64 * j);
#pragma unroll
            for (int j = 0; j < 8; ++j) w2[j] = __builtin_nontemporal_load(xr2 + 64 * j);
#pragma unroll
            for (int j = 0; j < 8; ++j) { s += (v[j][0] * v[j][0] + v[j][1] * v[j][1]) + (v[j][2] * v[j][2] + v[j][3] * v[j][3]); s2 += (w2[j][0] * w2[j][0] + w2[j][1] * w2[j][1]) + (w2[j][2] * w2[j][2] + w2[j][3] * w2[j][3]); }
            s = wave_sum(s); s2 = wave_sum(s2);
            if (lane == 0) { RINV[m] = rsqrtf(s * (1.f / DM) + EPS); if (two) RINV[m2] = rsqrtf(s2 * (1.f / DM) + EPS); }
            u32x2* o = (u32x2*)(XB + (size_t)m * DM) + lane; u32x2* o2 = (u32x2*)(XB + (size_t)m2 * DM) + lane;
#pragma unroll
            for (int j = 0; j < 8; ++j) { u32x2 w; w.x = pk2(v[j][0], v[j][1]); w.y = pk2(v[j][2], v[j][3]); o[64 * j] = w; }
            if (two) {
#pragma unroll
                for (int j = 0; j < 8; ++j) { u32x2 w; w.x = pk2(w2[j][0], w2[j][1]); w.y = pk2(w2[j][2], w2[j][3]); o2[64 * j] = w; } }
        }
        for (int i = bid * 512 + tid; i < T * PLE / 4; i += G * 512) { const f32x4 v = __builtin_nontemporal_load((const f32x4*)a.p + i); u32x2 w; w.x = pk2(v[0], v[1]); w.y = pk2(v[2], v[3]); ((u32x2*)PB)[i] = w; }
        for (int i = bid * 512 + tid; i < 2048; i += G * 512) { const int pos = i >> 5, f = i & 31; const float inv = powf(10000.f, -(float)f / 32.f); float sn, cs; sincosf((float)pos * inv, &sn, &cs); ROPE[i] = make_float2(cs, sn); }
        xcd_barrier_arrive(xbar, (wave == 0) && (lane_id_opaque() == 0));
        for (int it = I1 + gw; it < NIT; it += 2 * NGW) {
            const bool two = it + NGW < NIT;
            const TrItem dA = item_desc(it), dB = item_desc(two ? it + NGW : it);
            float vA[32], vB[32];
            p0_tr_load(dA, vA, lane); if (two) p0_tr_load(dB, vB, lane);
            p0_tr_store(dA, vA, scr, lane); if (two) p0_tr_store(dB, vB, scr, lane);
        }
        xcd_barrier_wait(xbar, (wave == 0) && (lane_id_opaque() == 0)); }


    if constexpr ((REP_MASK >> 10) & 1) { GRID_SYNC(); GRID_SYNC(); GRID_SYNC(); GRID_SYNC(); }
#pragma unroll
    for (int rep_ = 0; rep_ < 1 + ((REP_MASK >> 1) & 1); ++rep_) { LANE_IDS
        { pg8::Gemm g{XB, W1T, DM, DM, DM, 0, 0}; pg8::StaticOrder S; S.init(T, 14 * 256, G, bid);
          pg8::Epi1 E{RINV, a.q_norm, a.k_norm, ROPE, Q, KB, VB, GA, GS, UCAT, (LAS float*)(lds + XCH_OFF), 0};
          pg8::gemm_phase<pg8::Epi1, pg8::StaticOrder, true>(lds, g, S, E, wave); }
        __syncthreads();
        for (int gi = bid - (G - NG); gi >= 0 && gi < NG; gi += NG) ssm_tables(a, gi, lds, tid);
    GRID_SYNC(); }

#pragma unroll
    for (int rep_ = 0; rep_ < 1 + ((REP_MASK >> 2) & 1); ++rep_) {
#pragma unroll
        for (int rq_ = 0; rq_ < 2; ++rq_) {
        if (bid < 2 * NG) { if (rq_ == 1 && !((REP_MASK >> 6) & 1)) break;
            pg8::BatchOrder S{2 * NG, G, bid};
            { pg8::Gemm g{UCAT, WIN, 256, 512, 256, (size_t)NCH * 512 * 2, (size_t)256 * 256 * 2};
              pg8::EpiS1 E{LB16, UCAT}; pg8::gemm_phase<pg8::EpiS1, pg8::BatchOrder, true>(lds, g, S, E, wave); }
            asm volatile("s_waitcnt vmcnt(0)\n\tbuffer_inv sc1\n\ts_waitcnt vmcnt(0)" ::: "memory"); __syncthreads();
            { pg8::Gemm g{UCAT, WBIG, 512, 512, 512, (size_t)NCH * 512 * 2, (size_t)256 * 512 * 2};
              pg8::EpiS2 E{YS}; pg8::gemm_phase<pg8::EpiS2, pg8::BatchOrder, true>(lds, g, S, E, wave); }
        } else { if (rq_ == 1 && !((REP_MASK >> 11) & 1)) break;
            pg8::Gemm g{XB, W1T + (size_t)14 * 256 * DM, DM, DM, DM, 0, 0}; pg8::ListOrder S{bid - 2 * NG, 128, G};
            pg8::Epi1 E{RINV, a.q_norm, a.k_norm, ROPE, Q, KB, VB, GA, GS, UCAT, (LAS float*)(lds + XCH_OFF), 14};
            pg8::gemm_phase<pg8::Epi1, pg8::ListOrder, true>(lds, g, S, E, wave);
        }
        __syncthreads(); }
#pragma unroll
        for (int rq_ = 0; rq_ < 1 + ((REP_MASK >> 7) & 1); ++rq_)
        for (int un = bid; un < 256; un += G) {
            const int x = un & 7, jj = un >> 3, b = x >> 2, kvh = (x >> 1) & 1, idx = (x & 1) * 32 + jj, h = kvh * 4 + (idx >> 4), qb = idx & 15;
            const size_t tok0 = (size_t)b * SEQ + qb * 256;
            att::attn_dense_body(Q + tok0 * DATT + h * 128, KB + (size_t)b * SEQ * DKV + kvh * 128, VB + (size_t)b * SEQ * DKV + kvh * 128,
                                 GA + tok0 * DATT + h * 128, YMIX + tok0 * DM + h * 128, SEQ, (char*)lds_raw, wave);
        }
    GRID_SYNC(); }

#pragma unroll
    for (int rep_ = 0; rep_ < 1 + ((REP_MASK >> 3) & 1); ++rep_) {
        { pg8::StaticOrder S; S.init(T, 2 * DSSM, G, bid); pg8::Unit ua, ub;
          if (S.next(0, ua)) { ub = ua;
            pg8::Gemm ga{YS, WGLUT, DSSM, DSSM, DSSM, 0, 0}; pg8::EpiGlu Ea{a.b_glu, GS, YMIX};
            pg8::Gemm gb{PB, WPT, PLE, PLE, PLE, 0, 0}; pg8::EpiBf Eb{PPB, DM};
            pg8::gemm_phase2<pg8::EpiGlu, pg8::EpiBf>(lds, ga, ua, Ea, gb, ub, Eb, wave); } }
    GRID_SYNC(); }

#pragma unroll
    for (int rep_ = 0; rep_ < 1 + ((REP_MASK >> 4) & 1); ++rep_) {
        pg8::Gemm g{YMIX, WOT, DM, DM, DM, 0, 0}; pg8::StaticOrder S; S.init(T, DM, G, bid);
        pg8::EpiOut E{a.x, a.out, HB, SSQ1}; pg8::gemm_phase<pg8::EpiOut, pg8::StaticOrder, true>(lds, g, S, E, wave);
    GRID_SYNC(); }


    { LANE_IDS
        pg8::StaticOrder S; S.init(T, DM, G, bid); pg8::Unit u0;
        LAS float* r2 = (LAS float*)(lds + R2_OFF);
        if (S.next(0, u0) && tid < 256) { const float* sp = SSQ1 + (size_t)(u0.pm * 256 + tid) * 32; float s = 0.f;
#pragma unroll
            for (int i = 0; i < 8; ++i) { const f32x4 v = ((const f32x4*)sp)[i]; s += (v[0] + v[1]) + (v[2] + v[3]); }
            r2[tid] = rsqrtf(s * (1.f / DM) + EPS); }
        __syncthreads();
        pg8::Gemm g{HB, WGT, DM, DM, DM, 0, 0};
        pg8::EpiGate E{a.out, PPB, SSQ2, (unsigned*)ws, a.norm_final, r2, HB}; pg8::gemm_phase<pg8::EpiGate, pg8::StaticOrder, true>(lds, g, S, E, wave);
    }
}

extern "C" void kernel_launch(void* const* d_in, const int* in_sizes, int n_in, void* d_out, int out_size, void* d_ws, size_t ws_size, hipStream_t stream) {
    static int grid = 0;
    if (grid == 0) {
        if (n_in != 21 || in_sizes[0] != T * DM || out_size != T * DM || ws_size < WS_END) { fprintf(stderr, "kernel_launch: unexpected shapes (n_in %d, in0 %d, out %d, ws %zu)\n", n_in, n_in > 0 ? in_sizes[0] : -1, out_size, ws_size); grid = -1; return; }
        int dev = 0, cus = 0, per_cu = 0;
        hipGetDevice(&dev); hipDeviceGetAttribute(&cus, hipDeviceAttributeMultiprocessorCount, dev);
        if (hipFuncSetAttribute((const void*)fwd_kernel, hipFuncAttributeMaxDynamicSharedMemorySize, LDS_BYTES) != hipSuccess) { fprintf(stderr, "kernel_launch: hipFuncSetAttribute failed\n"); grid = -1; return; }
        hipOccupancyMaxActiveBlocksPerMultiprocessor(&per_cu, (const void*)fwd_kernel, 512, LDS_BYTES);
        (void)hipGetLastError();
        if (per_cu < 1) fprintf(stderr, "kernel_launch: occupancy query reports %d blocks per CU\n", per_cu);
        grid = cus > 256 ? 256 : cus;
    }
    if (grid < 0) return;
    Args a{};
    const float** f = (const float**)&a;
    for (int i = 0; i < 21; ++i) f[i] = (const float*)d_in[i];
    a.out = (float*)d_out; a.ws = (unsigned char*)d_ws;
    if (hipMemsetAsync(d_ws, 0, WS_CTL_BYTES, stream) != hipSuccess) { fprintf(stderr, "kernel_launch: hipMemsetAsync failed\n"); return; }
    void* args[] = {&a};
    hipError_t e = hipLaunchCooperativeKernel((const void*)fwd_kernel, dim3(grid), dim3(512), args, LDS_BYTES, stream);
    if (e != hipSuccess) fprintf(stderr, "kernel_launch: cooperative launch failed: %s (grid %d)\n", hipGetErrorString(e), grid);
}
```

```cpp
#include <hip/hip_runtime.h>
#include <hip/hip_cooperative_groups.h>
#include <cstdio>
#include <cstdint>
namespace cg = cooperative_groups;

#define LAS __attribute__((address_space(3)))
typedef unsigned short bf16_t;
typedef short bf16x8 __attribute__((ext_vector_type(8)));
typedef short s16x4 __attribute__((ext_vector_type(4)));
typedef float f32x4 __attribute__((ext_vector_type(4)));
typedef float f32x16 __attribute__((ext_vector_type(16)));
typedef unsigned u32x4 __attribute__((ext_vector_type(4)));
typedef unsigned u32x2 __attribute__((ext_vector_type(2)));

constexpr int T = 8192, SEQ = 4096, DM = 2048, DIN = 4608, DATT = 1024, DKV = 256, DSSM = 1024, PLE = 256;
constexpr int NG = 64, NCH = T / 16;
constexpr float EPS = 1e-6f;
#ifndef PH_MASK
#define PH_MASK 0xff
#endif
#ifndef GLDS_AUX
#define GLDS_AUX 0
#endif
#ifndef REP_MASK
#define REP_MASK 0
#endif

constexpr size_t MiB = 1u << 20;
constexpr size_t WS_W1T = 1 * MiB, WS_WGLUT = 19 * MiB, WS_WOT = 23 * MiB, WS_WGT = 31 * MiB, WS_WPT = 39 * MiB;
constexpr size_t WS_ROPE = 40 * MiB, WS_RINV = 40 * MiB + 65536, WS_LB16 = 40 * MiB + 131072, WS_SSQ1 = 41 * MiB, WS_SSQ2 = 42 * MiB;
constexpr size_t WS_PB = 43 * MiB, WS_WIN = 47 * MiB, WS_WBIG = 55 * MiB;
constexpr size_t WS_XB = 71 * MiB;
constexpr size_t WS_Q = 103 * MiB, WS_K = 119 * MiB, WS_V = 123 * MiB, WS_GA = 127 * MiB, WS_GS = 143 * MiB;
constexpr size_t WS_UCAT = 159 * MiB;
constexpr size_t WS_YMIX = 191 * MiB, WS_YS = 223 * MiB, WS_END = 239 * MiB;

constexpr int RING_BYTES = 131072, XCH_OFF = RING_BYTES, R2_OFF = RING_BYTES + 4096, XBST_OFF = RING_BYTES + 8192, LDS_BYTES = 147456;
constexpr size_t WS_BAR = 65536, WS_CTL_BYTES = 131072;

struct Args {
    const float *x, *p, *norm_mix, *w_in, *q_norm, *k_norm, *a_re, *a_im, *log_dt, *b_re, *b_im, *c_re, *c_im, *ssm_d, *w_glu, *b_glu, *w_out, *norm_ple, *w_ple_gate, *w_ple_proj, *norm_final;
    float* out; unsigned char* ws;
};

typedef __bf16 bf16s_;
__device__ __forceinline__ unsigned f2bf(float f) { return (unsigned)__builtin_bit_cast(unsigned short, (bf16s_)f); }
typedef float f32x2_ __attribute__((ext_vector_type(2)));
typedef __bf16 bf16x2_ __attribute__((ext_vector_type(2)));
__device__ __forceinline__ unsigned pk2(float lo, float hi) { const f32x2_ v = {lo, hi}; return __builtin_bit_cast(unsigned, __builtin_convertvector(v, bf16x2_)); }
__device__ __forceinline__ float bf2f(unsigned short b) { return __builtin_bit_cast(float, (unsigned)b << 16); }
__device__ __forceinline__ float bflo(unsigned w) { return __builtin_bit_cast(float, w << 16); }
__device__ __forceinline__ float bfhi(unsigned w) { return __builtin_bit_cast(float, w & 0xffff0000u); }
__device__ __forceinline__ unsigned cvt_pk_bf16(float lo, float hi) { unsigned r; asm volatile("v_cvt_pk_bf16_f32 %0, %1, %2" : "=v"(r) : "v"(lo), "v"(hi)); return r; }
__device__ __forceinline__ float sigmoidf_(float v) { return __builtin_amdgcn_rcpf(1.f + __builtin_amdgcn_exp2f(-1.4426950408889634f * v)); }
__device__ __forceinline__ float siluf_(float v) { return v * __builtin_amdgcn_rcpf(1.f + __builtin_amdgcn_exp2f(-1.4426950408889634f * v)); }
__device__ __forceinline__ float gelu_tanh(float v) { const float t = (-1.5957691216057308f * 1.4426950408889634f) * (v + 0.044715f * v * v * v); return v * __builtin_amdgcn_rcpf(1.f + __builtin_amdgcn_exp2f(t)); }
template <int K> __device__ __forceinline__ float swz_xor(float v) { return __int_as_float(__builtin_amdgcn_ds_swizzle(__float_as_int(v), (K << 10) | 0x1f)); }
__device__ __forceinline__ float sum_xor32(float v) { auto rr = __builtin_amdgcn_permlane32_swap(__float_as_uint(v), __float_as_uint(v), false, false); return __uint_as_float(rr[0]) + __uint_as_float(rr[1]); }
__device__ __forceinline__ float wave_sum(float v) { v += swz_xor<1>(v); v += swz_xor<2>(v); v += swz_xor<4>(v); v += swz_xor<8>(v); v += swz_xor<16>(v); return sum_xor32(v); }
#define LDS_WAIT() asm volatile("s_waitcnt lgkmcnt(0)" ::: "memory")
__device__ __forceinline__ int lane_id_opaque() { int l = __builtin_amdgcn_mbcnt_hi(~0u, __builtin_amdgcn_mbcnt_lo(~0u, 0u)); asm volatile("" : "+v"(l)); return l; }

namespace pg8 {
constexpr int BM = 256, BK = 64, HALF = 128, HTB = HALF * BK * 2, NXCD = 8, WGM = 8;
__host__ __device__ __forceinline__ int lds_byte(int r, int c) { const int st = (r >> 4) * 2 + (c >> 5), rr = r & 15, cc = c & 31, ob = rr * 64 + cc * 2; return st * 1024 + (ob ^ (((ob >> 9) & 1) << 5)); }
__host__ __device__ __forceinline__ void stage_rc(int b, int& R, int& C) { const int st = b / 1024, sb = b % 1024, swz = sb ^ (((sb >> 9) & 1) << 5); R = (st >> 1) * 16 + swz / 64; C = (st & 1) * 32 + (swz % 64) / 2; }
__host__ __device__ __forceinline__ int perm32(int rho) { const int n = rho >> 4, i = rho & 15; return 8 * (i >> 2) + 4 * n + (i & 3); }

struct Unit { int pm, pn, z; };
struct Gemm { const bf16_t* A; const bf16_t* Bt; int K, lda, ldb; size_t zA, zB; };

struct StaticOrder {
    int nM, nN, nwg, G, c;
    __device__ void init(int M, int N, int G_, int c_) { nM = M / BM; nN = N / BM; nwg = nM * nN; G = G_; c = c_; }
    __device__ bool next(int i, Unit& u) const {
        const long L = (long)i * G + c; if (L >= nwg) return false;
        int wgid = (int)L; { const int q = nwg / NXCD, r = nwg % NXCD, xcd = wgid % NXCD, off = wgid / NXCD; wgid = (xcd < r ? xcd * (q + 1) : r * (q + 1) + (xcd - r) * q) + off; }
        const int nig = WGM * nN, gid = wgid / nig, fm = gid * WGM, gsz = (nM - fm) < WGM ? (nM - fm) : WGM;
        u.pm = fm + ((wgid % nig) % gsz); u.pn = (wgid % nig) / gsz; u.z = 0; return true;
    }
};
struct BatchOrder {
    int n, G, c;
    __device__ bool next(int i, Unit& u) const { const int L = i * G + c; if (L >= n) return false;
        if ((n & 15) == 0) { const int x = L & 7, j = L >> 3; u.z = x + 8 * (j >> 1); u.pm = j & 1; }
        else { u.z = L >> 1; u.pm = L & 1; }
        u.pn = 0; return true; }
};

struct ListOrder {
    int L0, n, stride;
    __device__ bool next(int i, Unit& u) const { const int L = L0 + i * stride; if (L < 0 || L >= n) return false;
        const int x = L & 7, j = L >> 3; u.pm = 4 * x + (j >> 2); u.pn = j & 3; u.z = 0; return true; }
};
template <class Epi, class Sched, bool ALIGN_EPI>
__device__ __forceinline__ void gemm_phase(LAS unsigned char* lds, const Gemm g, const Sched& S, const Epi& E, const int wid) {
    const int lane = lane_id_opaque(), tid = wid * 64 + lane, wr = wid >> 2, wc = wid & 3, fr = lane & 15, fq = lane >> 4;
    const int K = g.K, nt = K / BK;
    unsigned voffA[2], voffB[2];
#pragma unroll
    for (int i = 0; i < 2; ++i) { int R, C; stage_rc(tid * 16 + i * 8192, R, C); const int Rb = (R & ~31) + perm32(R & 31);
        voffA[i] = (unsigned)(R * g.lda + C) * 2u; voffB[i] = (unsigned)(Rb * g.ldb + C) * 2u; }
    const size_t kstep = (size_t)(BK * 2);
    const size_t hstepA = (size_t)HALF * g.lda * 2, hstepB = (size_t)HALF * g.ldb * 2;
    const size_t tstepA = 2 * hstepA, tstepB = 2 * hstepB;
    const unsigned ldsw = (unsigned)wid * 1024u;
    const int aoff = lds_byte(wr * 64 + fr, fq * 8), boff = lds_byte(wc * 32 + fr, fq * 8);
#define PG8_SA(b, h) (((b) * 2 + (h)) * HTB)
#define PG8_SB(b, h) ((4 + (b) * 2 + (h)) * HTB)
#define PG8_STAGE(bufoff, gbase, voff) do { _Pragma("unroll") for (int _i = 0; _i < 2; ++_i) \
        __builtin_amdgcn_global_load_lds((const unsigned*)((const char*)(gbase) + (voff)[_i]), (LAS unsigned*)(lds + (bufoff) + ldsw + _i * 8192), 16, 0, GLDS_AUX); } while (0)
#define PG8_LDA(dst, b, h) do { _Pragma("unroll") for (int m = 0; m < 4; ++m) _Pragma("unroll") for (int k = 0; k < 2; ++k) dst[m][k] = *(const LAS bf16x8*)(lds + PG8_SA(b, h) + aoff + m * 2048 + k * 1024); } while (0)
#define PG8_LDB(dst, b, h) do { _Pragma("unroll") for (int n = 0; n < 2; ++n) _Pragma("unroll") for (int k = 0; k < 2; ++k) dst[n][k] = *(const LAS bf16x8*)(lds + PG8_SB(b, h) + boff + n * 2048 + k * 1024); } while (0)
#define PG8_MMA(ai, bj, At, Bt) do { __builtin_amdgcn_s_setprio(1); _Pragma("unroll") for (int m = 0; m < 4; ++m) _Pragma("unroll") for (int n = 0; n < 2; ++n) _Pragma("unroll") for (int k = 0; k < 2; ++k) \
        acc[ai][bj][m][n] = __builtin_amdgcn_mfma_f32_16x16x32_bf16(Bt[n][k], At[m][k], acc[ai][bj][m][n], 0, 0, 0); __builtin_amdgcn_s_setprio(0); } while (0)
#define PG8_WAIT_V(n) asm volatile("s_waitcnt vmcnt(" #n ")" ::: "memory")
#define PG8_WAIT_L(n) asm volatile("s_waitcnt lgkmcnt(" #n ")" ::: "memory")
#define PG8_BAR __builtin_amdgcn_s_barrier()
#define PG8_SCHED __builtin_amdgcn_sched_barrier(0)
    Unit cur, nxt; int ui = 0;
    if (!S.next(0, cur)) return;
    f32x4 acc[2][2][4][2];
#pragma unroll
    for (int a = 0; a < 2; ++a)
#pragma unroll
        for (int b = 0; b < 2; ++b)
#pragma unroll
            for (int m = 0; m < 4; ++m)
#pragma unroll
                for (int n = 0; n < 2; ++n) acc[a][b][m][n] = (f32x4){0.f, 0.f, 0.f, 0.f};
    bf16x8 At[4][2], B0[2][2], B1[2][2];
    const char* cA = (const char*)g.A + (size_t)cur.z * g.zA + (size_t)cur.pm * tstepA; const char* cB = (const char*)g.Bt + (size_t)cur.z * g.zB + (size_t)cur.pn * tstepB;
    PG8_STAGE(PG8_SB(0, 0), cB, voffB); PG8_STAGE(PG8_SB(0, 1), cB + hstepB, voffB); PG8_STAGE(PG8_SA(0, 0), cA, voffA); PG8_STAGE(PG8_SA(0, 1), cA + hstepA, voffA);
    if (wr == 1) PG8_BAR;
    PG8_WAIT_V(2); PG8_BAR;
    PG8_STAGE(PG8_SB(1, 0), cB + kstep, voffB); PG8_STAGE(PG8_SA(1, 0), cA + kstep, voffA); PG8_STAGE(PG8_SB(1, 1), cB + hstepB + kstep, voffB);
    PG8_WAIT_V(6); PG8_BAR;
    for (;;) {
        const bool has_next = S.next(ui + 1, nxt);
        const char* nA = has_next ? (const char*)g.A + (size_t)nxt.z * g.zA + (size_t)nxt.pm * tstepA : cA;
        const char* nB = has_next ? (const char*)g.Bt + (size_t)nxt.z * g.zB + (size_t)nxt.pn * tstepB : cB;
        for (int t = 0; t < nt; t += 2) {
            const bool last = (t == nt - 2);
            const char* a1 = cA + (size_t)(t + 1) * kstep;
            const char* a2 = last ? nA : cA + (size_t)(t + 2) * kstep; const char* b2 = last ? nB : cB + (size_t)(t + 2) * kstep;
            const char* a3 = a2 + kstep; const char* b3 = b2 + kstep;
            PG8_LDB(B0, 0, 0); PG8_LDB(B1, 0, 1); PG8_SCHED; PG8_LDA(At, 0, 0); PG8_STAGE(PG8_SA(1, 1), a1 + hstepA, voffA);
            PG8_WAIT_V(8); PG8_WAIT_L(0); PG8_BAR; PG8_MMA(0, 0, At, B0); PG8_MMA(0, 1, At, B1); PG8_BAR; PG8_SCHED;
            PG8_LDA(At, 0, 1); PG8_STAGE(PG8_SB(0, 0), b2, voffB); PG8_STAGE(PG8_SB(0, 1), b2 + hstepB, voffB); PG8_STAGE(PG8_SA(0, 0), a2, voffA);
            PG8_WAIT_V(8); PG8_WAIT_L(0); PG8_BAR; PG8_MMA(1, 0, At, B0); PG8_MMA(1, 1, At, B1); PG8_BAR; PG8_SCHED;
            PG8_LDB(B0, 1, 0); PG8_LDB(B1, 1, 1); PG8_SCHED; PG8_LDA(At, 1, 0); PG8_STAGE(PG8_SA(0, 1), a2 + hstepA, voffA);
            PG8_WAIT_V(8); PG8_WAIT_L(0); PG8_BAR; PG8_MMA(0, 0, At, B0); PG8_MMA(0, 1, At, B1); PG8_BAR; PG8_SCHED;
            PG8_LDA(At, 1, 1); PG8_STAGE(PG8_SB(1, 0), b3, voffB); PG8_STAGE(PG8_SB(1, 1), b3 + hstepB, voffB); PG8_STAGE(PG8_SA(1, 0), a3, voffA);
            PG8_WAIT_V(8); PG8_WAIT_L(0); PG8_BAR; PG8_MMA(1, 0, At, B0); PG8_MMA(1, 1, At, B1); PG8_BAR; PG8_SCHED;
        }
        if constexpr (ALIGN_EPI) { if (wr == 0) PG8_BAR; }
        if constexpr (!Epi::AFTER_DRAIN) E(acc, cur, wr, wc, fr, fq);
        if (!has_next) break;
#pragma unroll
        for (int a = 0; a < 2; ++a)
#pragma unroll
            for (int b = 0; b < 2; ++b)
#pragma unroll
                for (int m = 0; m < 4; ++m)
#pragma unroll
                    for (int n = 0; n < 2; ++n) acc[a][b][m][n] = (f32x4){0.f, 0.f, 0.f, 0.f};
        cur = nxt; cA = nA; cB = nB; ++ui;
        if constexpr (ALIGN_EPI) { if (wr == 1) PG8_BAR; }
    }
    PG8_WAIT_V(0);
    if constexpr (!ALIGN_EPI) { if (wr == 0) PG8_BAR; }
    PG8_BAR;
    if constexpr (Epi::AFTER_DRAIN) E.fused(acc, cur, wr, wc, lds, wid);
#undef PG8_SA
#undef PG8_SB
#undef PG8_STAGE
#undef PG8_LDA
#undef PG8_LDB
#undef PG8_MMA
#undef PG8_WAIT_V
#undef PG8_WAIT_L
#undef PG8_BAR
#undef PG8_SCHED
}

template <class EpiA, class EpiB>
__device__ __forceinline__ void gemm_phase2(LAS unsigned char* lds, const Gemm g0, const Unit u0, const EpiA& E0, const Gemm g1, const Unit u1, const EpiB& E1, const int wid) {
    const int lane = lane_id_opaque(), tid = wid * 64 + lane, wr = wid >> 2, wc = wid & 3, fr = lane & 15, fq = lane >> 4;
    unsigned vA0[2], vB0[2], vA1[2], vB1[2];
#pragma unroll
    for (int i = 0; i < 2; ++i) { int R, C; stage_rc(tid * 16 + i * 8192, R, C); const int Rb = (R & ~31) + perm32(R & 31);
        vA0[i] = (unsigned)(R * g0.lda + C) * 2u; vB0[i] = (unsigned)(Rb * g0.ldb + C) * 2u; vA1[i] = (unsigned)(R * g1.lda + C) * 2u; vB1[i] = (unsigned)(Rb * g1.ldb + C) * 2u; }
    const size_t kstep = (size_t)(BK * 2);
    const size_t hA0 = (size_t)HALF * g0.lda * 2, hB0 = (size_t)HALF * g0.ldb * 2, hA1 = (size_t)HALF * g1.lda * 2, hB1 = (size_t)HALF * g1.ldb * 2;
    const unsigned ldsw = (unsigned)wid * 1024u;
    const int aoff = lds_byte(wr * 64 + fr, fq * 8), boff = lds_byte(wc * 32 + fr, fq * 8);
#define PG8_SA(b, h) (((b) * 2 + (h)) * HTB)
#define PG8_SB(b, h) ((4 + (b) * 2 + (h)) * HTB)
#define PG8_STAGE(bufoff, gbase, voff) do { _Pragma("unroll") for (int _i = 0; _i < 2; ++_i) \
        __builtin_amdgcn_global_load_lds((const unsigned*)((const char*)(gbase) + (voff)[_i]), (LAS unsigned*)(lds + (bufoff) + ldsw + _i * 8192), 16, 0, 0); } while (0)
#define PG8_LDA(dst, b, h) do { _Pragma("unroll") for (int m = 0; m < 4; ++m) _Pragma("unroll") for (int k = 0; k < 2; ++k) dst[m][k] = *(const LAS bf16x8*)(lds + PG8_SA(b, h) + aoff + m * 2048 + k * 1024); } while (0)
#define PG8_LDB(dst, b, h) do { _Pragma("unroll") for (int n = 0; n < 2; ++n) _Pragma("unroll") for (int k = 0; k < 2; ++k) dst[n][k] = *(const LAS bf16x8*)(lds + PG8_SB(b, h) + boff + n * 2048 + k * 1024); } while (0)
#define PG8_MMA(ai, bj, At, Bt) do { __builtin_amdgcn_s_setprio(1); _Pragma("unroll") for (int m = 0; m < 4; ++m) _Pragma("unroll") for (int n = 0; n < 2; ++n) _Pragma("unroll") for (int k = 0; k < 2; ++k) \
        acc[ai][bj][m][n] = __builtin_amdgcn_mfma_f32_16x16x32_bf16(Bt[n][k], At[m][k], acc[ai][bj][m][n], 0, 0, 0); __builtin_amdgcn_s_setprio(0); } while (0)
#define PG8_WAIT_V(n) asm volatile("s_waitcnt vmcnt(" #n ")" ::: "memory")
#define PG8_WAIT_L(n) asm volatile("s_waitcnt lgkmcnt(" #n ")" ::: "memory")
#define PG8_BAR __builtin_amdgcn_s_barrier()
#define PG8_SCHED __builtin_amdgcn_sched_barrier(0)
    f32x4 acc[2][2][4][2];
#pragma unroll
    for (int a = 0; a < 2; ++a)
#pragma unroll
        for (int b = 0; b < 2; ++b)
#pragma unroll
            for (int m = 0; m < 4; ++m)
#pragma unroll
                for (int n = 0; n < 2; ++n) acc[a][b][m][n] = (f32x4){0.f, 0.f, 0.f, 0.f};
    bf16x8 At[4][2], B0[2][2], B1[2][2];
    const char* A0 = (const char*)g0.A + (size_t)u0.pm * 2 * hA0; const char* Bp0 = (const char*)g0.Bt + (size_t)u0.pn * 2 * hB0;
    const char* A1 = (const char*)g1.A + (size_t)u1.pm * 2 * hA1; const char* Bp1 = (const char*)g1.Bt + (size_t)u1.pn * 2 * hB1;
    PG8_STAGE(PG8_SB(0, 0), Bp0, vB0); PG8_STAGE(PG8_SB(0, 1), Bp0 + hB0, vB0); PG8_STAGE(PG8_SA(0, 0), A0, vA0); PG8_STAGE(PG8_SA(0, 1), A0 + hA0, vA0);
    if (wr == 1) PG8_BAR;
    PG8_WAIT_V(2); PG8_BAR;
    PG8_STAGE(PG8_SB(1, 0), Bp0 + kstep, vB0); PG8_STAGE(PG8_SA(1, 0), A0 + kstep, vA0); PG8_STAGE(PG8_SB(1, 1), Bp0 + hB0 + kstep, vB0);
    PG8_WAIT_V(6); PG8_BAR;
#pragma unroll
    for (int ui = 0; ui < 2; ++ui) {
        const char* cA = ui == 0 ? A0 : A1; const char* cB = ui == 0 ? Bp0 : Bp1;
        const size_t hAc = ui == 0 ? hA0 : hA1, hBc = ui == 0 ? hB0 : hB1;
        const int nt = (ui == 0 ? g0.K : g1.K) / BK;
        unsigned vAc[2], vBc[2];
#pragma unroll
        for (int i = 0; i < 2; ++i) { vAc[i] = ui == 0 ? vA0[i] : vA1[i]; vBc[i] = ui == 0 ? vB0[i] : vB1[i]; }
        for (int t = 0; t < nt; t += 2) {
            const bool last = (t == nt - 2);
            const char* a1 = cA + (size_t)(t + 1) * kstep;
            const char* a2 = last ? A1 : cA + (size_t)(t + 2) * kstep; const char* b2 = last ? Bp1 : cB + (size_t)(t + 2) * kstep;
            const char* a3 = a2 + kstep; const char* b3 = b2 + kstep;
            const size_t hA2 = last ? hA1 : hAc, hB2 = last ? hB1 : hBc;
            unsigned vA2[2], vB2[2];
#pragma unroll
            for (int i = 0; i < 2; ++i) { vA2[i] = last ? vA1[i] : vAc[i]; vB2[i] = last ? vB1[i] : vBc[i]; }
            PG8_LDB(B0, 0, 0); PG8_LDB(B1, 0, 1); PG8_SCHED; PG8_LDA(At, 0, 0); PG8_STAGE(PG8_SA(1, 1), a1 + hAc, vAc);
            PG8_WAIT_V(8); PG8_WAIT_L(0); PG8_BAR; PG8_MMA(0, 0, At, B0); PG8_MMA(0, 1, At, B1); PG8_BAR; PG8_SCHED;
            PG8_LDA(At, 0, 1); PG8_STAGE(PG8_SB(0, 0), b2, vB2); PG8_STAGE(PG8_SB(0, 1), b2 + hB2, vB2); PG8_STAGE(PG8_SA(0, 0), a2, vA2);
            PG8_WAIT_V(8); PG8_WAIT_L(0); PG8_BAR; PG8_MMA(1, 0, At, B0); PG8_MMA(1, 1, At, B1); PG8_BAR; PG8_SCHED;
            PG8_LDB(B0, 1, 0); PG8_LDB(B1, 1, 1); PG8_SCHED; PG8_LDA(At, 1, 0); PG8_STAGE(PG8_SA(0, 1), a2 + hA2, vA2);
            PG8_WAIT_V(8); PG8_WAIT_L(0); PG8_BAR; PG8_MMA(0, 0, At, B0); PG8_MMA(0, 1, At, B1); PG8_BAR; PG8_SCHED;
            PG8_LDA(At, 1, 1); PG8_STAGE(PG8_SB(1, 0), b3, vB2); PG8_STAGE(PG8_SB(1, 1), b3 + hB2, vB2); PG8_STAGE(PG8_SA(1, 0), a3, vA2);
            PG8_WAIT_V(8); PG8_WAIT_L(0); PG8_BAR; PG8_MMA(1, 0, At, B0); PG8_MMA(1, 1, At, B1); PG8_BAR; PG8_SCHED;
        }
        if (wr == 0) PG8_BAR;
        if (ui == 0) {
            E0(acc, u0, wr, wc, fr, fq);
#pragma unroll
            for (int a = 0; a < 2; ++a)
#pragma unroll
                for (int b = 0; b < 2; ++b)
#pragma unroll
                    for (int m = 0; m < 4; ++m)
#pragma unroll
                        for (int n = 0; n < 2; ++n) acc[a][b][m][n] = (f32x4){0.f, 0.f, 0.f, 0.f};
            if (wr == 1) PG8_BAR;
        } else E1(acc, u1, wr, wc, fr, fq);
    }
    PG8_WAIT_V(0);
    PG8_BAR;
#undef PG8_SA
#undef PG8_SB
#undef PG8_STAGE
#undef PG8_LDA
#undef PG8_LDB
#undef PG8_MMA
#undef PG8_WAIT_V
#undef PG8_WAIT_L
#undef PG8_BAR
#undef PG8_SCHED
}

#define EPI_FOR_ROWS _Pragma("unroll") for (int ai = 0; ai < 2; ++ai) _Pragma("unroll") for (int m = 0; m < 4; ++m)
#define EPI_ROWDEF const int rit = ai * HALF + wr * 64 + m * 16 + fr; const int row = u.pm * BM + rit; (void)rit; (void)row;

struct Epi1 {
    static constexpr bool AFTER_DRAIN = false;
    const float* rinv; const float* qnw; const float* knw; const float2* rope;
    bf16_t *Q, *Kb, *Vb, *GA, *GS, *UCAT; LAS float* xch; int pn0;
    __device__ __forceinline__ void operator()(const f32x4 (&acc)[2][2][4][2], const Unit& u, int wr, int wc, int, int) const {
        const int l_ = lane_id_opaque(), fr = l_ & 15, fq = l_ >> 4;
        const int pn = u.pn + pn0;
        if (pn <= 4) {
            float ss[2][4], rv[2][4];
            EPI_FOR_ROWS { EPI_ROWDEF const float r = rinv[row]; rv[ai][m] = r; float s = 0.f;
#pragma unroll
                for (int bj = 0; bj < 2; ++bj)
#pragma unroll
                    for (int n = 0; n < 2; ++n) { const f32x4 v = acc[ai][bj][m][n] * r; s += (v[0] * v[0] + v[1] * v[1]) + (v[2] * v[2] + v[3] * v[3]); }
                s += swz_xor<16>(s); s = sum_xor32(s); ss[ai][m] = s;
                if (fq == 0) xch[wc * 256 + rit] = s; }
            LDS_WAIT(); __builtin_amdgcn_s_barrier(); asm volatile("" ::: "memory");
            const int half = wc & 1, hd = wc >> 1;
            const float* nw = (pn < 4 ? qnw : knw) + 64 * half + 8 * fq;
            float w1[8], w2[8];
#pragma unroll
            for (int i = 0; i < 8; ++i) { w1[i] = nw[i]; w2[i] = nw[32 + i]; }
            EPI_FOR_ROWS { EPI_ROWDEF const float tot = ss[ai][m] + xch[(wc ^ 1) * 256 + rit];
                const float sc = rv[ai][m] * rsqrtf(tot * (1.f / 128.f) + EPS);
                const int t = row & (SEQ - 1); const int pos = half ? (t & 63) : (t >> 6);
                const float2* rp = rope + pos * 32 + 8 * fq;
                float o1[8], o2[8];
#pragma unroll
                for (int n = 0; n < 2; ++n)
#pragma unroll
                    for (int e = 0; e < 4; ++e) { const int i = 4 * n + e; const float2 cs = rp[i];
                        const float x1 = acc[ai][0][m][n][e] * sc * w1[i], x2 = acc[ai][1][m][n][e] * sc * w2[i];
                        o1[i] = x1 * cs.x - x2 * cs.y; o2[i] = x2 * cs.x + x1 * cs.y; }
                bf16_t* dst = (pn < 4) ? Q + (size_t)row * DATT + (2 * pn + hd) * 128 + 64 * half + 8 * fq : Kb + (size_t)row * DKV + hd * 128 + 64 * half + 8 * fq;
                u32x4 a; a.x = pk2(o1[0], o1[1]); a.y = pk2(o1[2], o1[3]); a.z = pk2(o1[4], o1[5]); a.w = pk2(o1[6], o1[7]);
                u32x4 b; b.x = pk2(o2[0], o2[1]); b.y = pk2(o2[2], o2[3]); b.z = pk2(o2[4], o2[5]); b.w = pk2(o2[6], o2[7]);
                *(u32x4*)dst = a; *(u32x4*)(dst + 32) = b; }
        } else {
            const int lg0 = 4 * (wc >> 1) + 2 * (wc & 1);
            EPI_FOR_ROWS { EPI_ROWDEF const float r = rinv[row];
#pragma unroll
                for (int bj = 0; bj < 2; ++bj) { const int L = 256 * pn + 32 * (lg0 + bj) + 8 * fq;
                    f32x4 v0 = acc[ai][bj][m][0] * r, v1 = acc[ai][bj][m][1] * r; bf16_t* dst;
                    if (pn == 5) dst = Vb + (size_t)row * DKV + (L - 1280);
                    else if (pn < 10) dst = GA + (size_t)row * DATT + (L - 1536);
                    else if (pn < 14) { const int Lu = L - 2560; dst = UCAT + ((size_t)(Lu >> 4) * NCH + (row >> 4)) * 512 + (row & 15) * 16 + (Lu & 15); }
                    else dst = GS + (size_t)row * DSSM + (L - 3584);
                    if ((pn >= 6 && pn < 10) || pn >= 14) {
#pragma unroll
                        for (int e = 0; e < 4; ++e) { v0[e] = siluf_(v0[e]); v1[e] = siluf_(v1[e]); } }
                    u32x4 w; w.x = pk2(v0[0], v0[1]); w.y = pk2(v0[2], v0[3]); w.z = pk2(v1[0], v1[1]); w.w = pk2(v1[2], v1[3]);
                    *(u32x4*)dst = w; } }
        }
    }
};
struct EpiS1 {
    static constexpr bool AFTER_DRAIN = true;
    const float* lb16; bf16_t* UCAT;
    __device__ __forceinline__ void operator()(const f32x4 (&)[2][2][4][2], const Unit&, int, int, int, int) const {}
    __device__ __forceinline__ void fused(const f32x4 (&acc)[2][2][4][2], const Unit& u, int wr, int wc, LAS unsigned char* lds, int wid) const {
        const int l_ = lane_id_opaque(), fr = l_ & 15, fq = l_ >> 4;
        LAS float* Tl = (LAS float*)lds;
#pragma unroll
        for (int d = 0; d < 2; ++d) {
            EPI_FOR_ROWS { const int rit = ai * HALF + wr * 64 + m * 16 + fr; LAS float* rp = Tl + rit * 128 + wc * 32 + 8 * fq;
                *(LAS f32x4*)rp = acc[ai][d][m][0]; *(LAS f32x4*)(rp + 4) = acc[ai][d][m][1]; }
            LDS_WAIT(); __builtin_amdgcn_s_barrier(); asm volatile("" ::: "memory");
            {
                const int p = l_; const float lr = lb16[((u.z * 2 + d) * 64 + p) * 2], li = lb16[((u.z * 2 + d) * 64 + p) * 2 + 1];
                LAS float* SEG = (LAS float*)(lds + XCH_OFF);
                float xr = 0.f, xi = 0.f;
#pragma unroll 8
                for (int i = 0; i < 32; ++i) { const int cc = wid * 32 + i, c = d ? 255 - cc : cc;
                    const float sr = Tl[c * 128 + p], si = Tl[c * 128 + 64 + p];
                    Tl[c * 128 + p] = xr; Tl[c * 128 + 64 + p] = xi;
                    const float nr = lr * xr - li * xi + sr; xi = lr * xi + li * xr + si; xr = nr; }
                SEG[(wid * 64 + p) * 2] = xr; SEG[(wid * 64 + p) * 2 + 1] = xi;
                LDS_WAIT(); __builtin_amdgcn_s_barrier(); asm volatile("" ::: "memory");
                float l32r = lr, l32i = li;
#pragma unroll
                for (int q = 0; q < 5; ++q) { const float t = l32r * l32r - l32i * l32i; l32i = 2.f * l32r * l32i; l32r = t; }
                float er = 0.f, ei = 0.f;
                for (int j = 0; j < wid; ++j) { const float tr = SEG[(j * 64 + p) * 2], ti = SEG[(j * 64 + p) * 2 + 1];
                    const float nr = l32r * er - l32i * ei + tr; ei = l32r * ei + l32i * er + ti; er = nr; }
#pragma unroll 8
                for (int i = 0; i < 32; ++i) { const int cc = wid * 32 + i, c = d ? 255 - cc : cc;
                    const float tr = Tl[c * 128 + p] + er, ti = Tl[c * 128 + 64 + p] + ei;
                    Tl[c * 128 + p] = __uint_as_float(pk2(tr, ti));
                    const float nr = lr * er - li * ei; ei = lr * ei + li * er; er = nr; }
            }
            LDS_WAIT(); __builtin_amdgcn_s_barrier(); asm volatile("" ::: "memory");
            {   bf16_t* ub = UCAT + ((size_t)u.z * NCH + u.pm * 256) * 512 + 256 + d * 128;
#pragma unroll
                for (int i = 0; i < 8; ++i) { const int q = wid * 64 + l_ + 512 * i, r = q >> 4, c8 = (q & 15) * 8;
                    *(u32x4*)(ub + (size_t)r * 512 + c8) = *(const LAS u32x4*)((LAS bf16_t*)(Tl + r * 128) + c8); } }
            LDS_WAIT(); __builtin_amdgcn_s_barrier(); asm volatile("" ::: "memory");
        }
    }
};
struct EpiS2 {
    static constexpr bool AFTER_DRAIN = false;
    bf16_t* YS;
    __device__ __forceinline__ void operator()(const f32x4 (&acc)[2][2][4][2], const Unit& u, int wr, int wc, int, int) const {
        const int l_ = lane_id_opaque(), fr = l_ & 15, fq = l_ >> 4;
        EPI_FOR_ROWS { EPI_ROWDEF
#pragma unroll
            for (int bj = 0; bj < 2; ++bj) { const int c = bj * HALF + wc * 32 + 8 * fq; const int j = c >> 4, h0 = c & 15;
                const f32x4 v0 = acc[ai][bj][m][0], v1 = acc[ai][bj][m][1];
                u32x4 w; w.x = pk2(gelu_tanh(v0[0]), gelu_tanh(v0[1])); w.y = pk2(gelu_tanh(v0[2]), gelu_tanh(v0[3])); w.z = pk2(gelu_tanh(v1[0]), gelu_tanh(v1[1])); w.w = pk2(gelu_tanh(v1[2]), gelu_tanh(v1[3]));
                *(u32x4*)(YS + ((size_t)row * 16 + j) * DSSM + u.z * 16 + h0) = w; } }
    }
};
struct EpiGlu {
    static constexpr bool AFTER_DRAIN = false;
    const float* bglu; const bf16_t* GS; bf16_t* YMIX;
    __device__ __forceinline__ void operator()(const f32x4 (&acc)[2][2][4][2], const Unit& u, int wr, int wc, int, int) const {
        const int l_ = lane_id_opaque(), fr = l_ & 15, fq = l_ >> 4;
        const int a0 = 128 * u.pn + 32 * wc + 8 * fq;
        float bv[8], bg[8];
#pragma unroll
        for (int i = 0; i < 8; ++i) { bv[i] = bglu[a0 + i]; bg[i] = bglu[1024 + a0 + i]; }
        u32x4 gsv[2][4];
        EPI_FOR_ROWS { EPI_ROWDEF gsv[ai][m] = __builtin_nontemporal_load((const u32x4*)(GS + (size_t)row * DSSM + a0)); }
        EPI_FOR_ROWS { EPI_ROWDEF const u32x4 gs = gsv[ai][m];
            float o[8];
#pragma unroll
            for (int n = 0; n < 2; ++n)
#pragma unroll
                for (int e = 0; e < 4; ++e) { const int i = 4 * n + e; o[i] = (acc[ai][0][m][n][e] + bv[i]) * sigmoidf_(acc[ai][1][m][n][e] + bg[i]); }
            o[0] *= bflo(gs.x); o[1] *= bfhi(gs.x); o[2] *= bflo(gs.y); o[3] *= bfhi(gs.y); o[4] *= bflo(gs.z); o[5] *= bfhi(gs.z); o[6] *= bflo(gs.w); o[7] *= bfhi(gs.w);
            u32x4 w; w.x = pk2(o[0], o[1]); w.y = pk2(o[2], o[3]); w.z = pk2(o[4], o[5]); w.w = pk2(o[6], o[7]);
            *(u32x4*)(YMIX + (size_t)row * DM + 1024 + a0) = w; }
    }
};
struct EpiBf {
    static constexpr bool AFTER_DRAIN = false;
    bf16_t* O; int ldc;
    __device__ __forceinline__ void operator()(const f32x4 (&acc)[2][2][4][2], const Unit& u, int wr, int wc, int, int) const {
        const int l_ = lane_id_opaque(), fr = l_ & 15, fq = l_ >> 4;
        EPI_FOR_ROWS { EPI_ROWDEF
#pragma unroll
            for (int bj = 0; bj < 2; ++bj) { const f32x4 v0 = acc[ai][bj][m][0], v1 = acc[ai][bj][m][1];
                u32x4 w; w.x = pk2(v0[0], v0[1]); w.y = pk2(v0[2], v0[3]); w.z = pk2(v1[0], v1[1]); w.w = pk2(v1[2], v1[3]);
                *(u32x4*)(O + (size_t)row * ldc + u.pn * BM + bj * HALF + wc * 32 + 8 * fq) = w; } }
    }
};
struct EpiOut {
    static constexpr bool AFTER_DRAIN = false;
    const float* x; float* H; bf16_t* HB; float* ssq;
    __device__ __forceinline__ void operator()(const f32x4 (&acc)[2][2][4][2], const Unit& u, int wr, int wc, int, int) const {
        const int l_ = lane_id_opaque(), fr = l_ & 15, fq = l_ >> 4;
#pragma unroll
        for (int ai = 0; ai < 2; ++ai) {
            f32x4 xv[4][2][2];
#pragma unroll
            for (int m = 0; m < 4; ++m) { EPI_ROWDEF
#pragma unroll
                for (int bj = 0; bj < 2; ++bj) { const size_t off = (size_t)row * DM + u.pn * BM + bj * HALF + wc * 32 + 8 * fq; xv[m][bj][0] = __builtin_nontemporal_load((const f32x4*)(x + off)); xv[m][bj][1] = __builtin_nontemporal_load((const f32x4*)(x + off + 4)); } }
#pragma unroll
            for (int m = 0; m < 4; ++m) { EPI_ROWDEF float s = 0.f;
#pragma unroll
                for (int bj = 0; bj < 2; ++bj) { const size_t off = (size_t)row * DM + u.pn * BM + bj * HALF + wc * 32 + 8 * fq;
                    const f32x4 v0 = acc[ai][bj][m][0] + xv[m][bj][0], v1 = acc[ai][bj][m][1] + xv[m][bj][1];
                    s += (v0[0] * v0[0] + v0[1] * v0[1]) + (v0[2] * v0[2] + v0[3] * v0[3]) + (v1[0] * v1[0] + v1[1] * v1[1]) + (v1[2] * v1[2] + v1[3] * v1[3]);
                    u32x4 w; w.x = pk2(v0[0], v0[1]); w.y = pk2(v0[2], v0[3]); w.z = pk2(v1[0], v1[1]); w.w = pk2(v1[2], v1[3]);
                    *(u32x4*)(HB + off) = w; }
                s += swz_xor<16>(s); s = sum_xor32(s);
                if (fq == 0) ssq[(size_t)row * 32 + u.pn * 4 + wc] = s; }
        }
    }
};
struct EpiGate {
    static constexpr bool AFTER_DRAIN = true;
    float* H; const bf16_t* PP; float* ssq; unsigned* cnt; const float* nf; const LAS float* r2; const bf16_t* HBr;
    __device__ __forceinline__ void operator()(const f32x4 (&)[2][2][4][2], const Unit&, int, int, int, int) const {}
    __device__ __forceinline__ void fused(f32x4 (&acc)[2][2][4][2], const Unit& u, int wr, int wc, LAS unsigned char* lds, int wid) const {
        const int l_ = lane_id_opaque(), fr = l_ & 15, fq = l_ >> 4, tid = wid * 64 + l_;
        LAS float* P = (LAS float*)lds; LAS float* Rn = P + 1024;
        EPI_FOR_ROWS { EPI_ROWDEF float s = 0.f; const float r = r2[rit];
#pragma unroll
            for (int bj = 0; bj < 2; ++bj) { const size_t off = (size_t)row * DM + u.pn * BM + bj * HALF + wc * 32 + 8 * fq;
                const u32x4 pp = __builtin_nontemporal_load((const u32x4*)(PP + off));
                const u32x4 hb = __builtin_nontemporal_load((const u32x4*)(HBr + off));
                f32x4 h0 = {bflo(hb.x), bfhi(hb.x), bflo(hb.y), bfhi(hb.y)}, h1 = {bflo(hb.z), bfhi(hb.z), bflo(hb.w), bfhi(hb.w)};
                const f32x4 a0 = acc[ai][bj][m][0] * r, a1 = acc[ai][bj][m][1] * r;
                h0[0] += sigmoidf_(a0[0]) * bflo(pp.x); h0[1] += sigmoidf_(a0[1]) * bfhi(pp.x); h0[2] += sigmoidf_(a0[2]) * bflo(pp.y); h0[3] += sigmoidf_(a0[3]) * bfhi(pp.y);
                h1[0] += sigmoidf_(a1[0]) * bflo(pp.z); h1[1] += sigmoidf_(a1[1]) * bfhi(pp.z); h1[2] += sigmoidf_(a1[2]) * bflo(pp.w); h1[3] += sigmoidf_(a1[3]) * bfhi(pp.w);
                acc[ai][bj][m][0] = h0; acc[ai][bj][m][1] = h1;
                s += (h0[0] * h0[0] + h0[1] * h0[1]) + (h0[2] * h0[2] + h0[3] * h0[3]) + (h1[0] * h1[0] + h1[1] * h1[1]) + (h1[2] * h1[2] + h1[3] * h1[3]); }
            s += swz_xor<16>(s); s = sum_xor32(s);
            if (fq == 0) P[rit * 4 + wc] = s; }
        LDS_WAIT(); __builtin_amdgcn_s_barrier(); asm volatile("" ::: "memory");
        if (tid < 256) { const float t = (P[tid * 4] + P[tid * 4 + 1]) + (P[tid * 4 + 2] + P[tid * 4 + 3]);
            __hip_atomic_store(ssq + (size_t)(u.pm * 256 + tid) * 8 + u.pn, t, __ATOMIC_RELAXED, __HIP_MEMORY_SCOPE_AGENT); }
        asm volatile("s_waitcnt vmcnt(0)" ::: "memory");
        if (wid < 4 && l_ == 0) __hip_atomic_fetch_add(cnt + 64 * u.pm, 1u, __ATOMIC_RELAXED, __HIP_MEMORY_SCOPE_AGENT);
        if (wid == 0) {
            unsigned sp = 0;
            while ((unsigned)__builtin_amdgcn_readfirstlane(__hip_atomic_load(cnt + 64 * u.pm, __ATOMIC_RELAXED, __HIP_MEMORY_SCOPE_AGENT)) < 32u) { __builtin_amdgcn_s_sleep(2); if (++sp > (1u << 22)) break; }
            __builtin_amdgcn_fence(__ATOMIC_ACQUIRE, "agent");
        }
        asm volatile("s_waitcnt vmcnt(0) lgkmcnt(0)" ::: "memory"); __builtin_amdgcn_s_barrier(); asm volatile("" ::: "memory");
        if (tid < 256) { const float* sp = ssq + (size_t)(u.pm * 256 + tid) * 8; float t = 0.f;
#pragma unroll
            for (int i = 0; i < 8; ++i) t += __hip_atomic_load(sp + i, __ATOMIC_RELAXED, __HIP_MEMORY_SCOPE_AGENT);
            Rn[tid] = rsqrtf(t * (1.f / DM) + EPS); }
        LDS_WAIT(); __builtin_amdgcn_s_barrier(); asm volatile("" ::: "memory");
        EPI_FOR_ROWS { EPI_ROWDEF const float rn = Rn[rit];
#pragma unroll
            for (int bj = 0; bj < 2; ++bj) { const int col = u.pn * BM + bj * HALF + wc * 32 + 8 * fq; const size_t off = (size_t)row * DM + col;
                *(f32x4*)(H + off) = acc[ai][bj][m][0] * rn * *(const f32x4*)(nf + col); *(f32x4*)(H + off + 4) = acc[ai][bj][m][1] * rn * *(const f32x4*)(nf + col + 4); } }
    }
};
}

namespace att {
constexpr int D = 128, NW = 8, QBLK = 32, KVBLK = 64;
constexpr float SCALE = 0.088388347648318440f;
constexpr float THR = 8.f;
constexpr int LDQ = DATT, LDK = DKV;
constexpr size_t SHM_V = KVBLK * D * 2, SHM_K = KVBLK * D * 2, SHM_ATTN = 2 * SHM_V + 2 * SHM_K + NW * 64 * 4;
#define KSWZ(row, colB) ((row) * 256 + ((colB) ^ (((row) & 7) << 4)))
#define SBAR() __builtin_amdgcn_sched_barrier(0)
__device__ __forceinline__ int crow(int r, int hi) { return (r & 3) + 8 * (r >> 2) + 4 * hi; }
__device__ __forceinline__ void partialSM(f32x16& p0, f32x16& p1, float& m_reg, float& mn, float& alpha) {
  constexpr float C = SCALE * 1.4426950408889634f;
  float pmax = p0[0]; for (int r = 1; r < 16; ++r) pmax = fmaxf(pmax, p0[r]); for (int r = 0; r < 16; ++r) pmax = fmaxf(pmax, p1[r]);
  { auto rr = __builtin_amdgcn_permlane32_swap(__float_as_uint(pmax), __float_as_uint(pmax), false, false);
    pmax = fmaxf(__uint_as_float(rr[0]), __uint_as_float(rr[1])); }
  if (__builtin_expect(__all(pmax - m_reg <= THR / SCALE), 1)) { mn = m_reg; alpha = 1.f; }
  else { mn = fmaxf(m_reg, pmax); alpha = __builtin_amdgcn_exp2f((m_reg - mn) * C); m_reg = mn; }
  float mnC = -mn * C;
  for (int r = 0; r < 16; ++r) p0[r] = fmaf(p0[r], C, mnC); for (int r = 0; r < 16; ++r) p1[r] = fmaf(p1[r], C, mnC);
  for (int r = 0; r < 16; ++r) p0[r] = __builtin_amdgcn_exp2f(p0[r]);
}
__device__ __forceinline__ void finishSM(f32x16& p0, f32x16& p1, float alpha, float& l_reg, bf16x8& pa0, bf16x8& pa1, bf16x8& pa2, bf16x8& pa3) {
  for (int r = 0; r < 16; ++r) p1[r] = __builtin_amdgcn_exp2f(p1[r]);
  float ps = 0; for (int r = 0; r < 16; ++r) ps += p0[r]; for (int r = 0; r < 16; ++r) ps += p1[r];
  { auto rr = __builtin_amdgcn_permlane32_swap(__float_as_uint(ps), __float_as_uint(ps), false, false);
    ps = __uint_as_float(rr[0]) + __uint_as_float(rr[1]); }
  l_reg = l_reg * alpha + ps;
#define PK4(P, BASE, OUT) do { unsigned a0 = cvt_pk_bf16(P[BASE + 0], P[BASE + 1]), a1 = cvt_pk_bf16(P[BASE + 2], P[BASE + 3]);   \
    unsigned b0 = cvt_pk_bf16(P[BASE + 4], P[BASE + 5]), b1 = cvt_pk_bf16(P[BASE + 6], P[BASE + 7]);                              \
    auto r0 = __builtin_amdgcn_permlane32_swap(a0, b0, false, false); auto r1 = __builtin_amdgcn_permlane32_swap(a1, b1, false, false); \
    u32x4 w = {r0[0], r1[0], r0[1], r1[1]}; OUT = *reinterpret_cast<bf16x8*>(&w); } while (0)
  PK4(p0, 0, pa0); PK4(p0, 8, pa1); PK4(p1, 0, pa2); PK4(p1, 8, pa3);
#undef PK4
}
__device__ __forceinline__ void qkt(f32x16& p0, f32x16& p1, const bf16_t* Ks, const bf16x8* qr, int r32, int hi) {
  p0 = f32x16{}; p1 = f32x16{};
  for (int d0 = 0; d0 < 8; ++d0) { int cb = (d0 * 16 + hi * 8) * 2;
    bf16x8 b0 = *reinterpret_cast<const bf16x8*>((const char*)Ks + KSWZ(r32, cb));
    bf16x8 b1 = *reinterpret_cast<const bf16x8*>((const char*)Ks + KSWZ(32 + r32, cb));
    p0 = __builtin_amdgcn_mfma_f32_32x32x16_bf16(b0, qr[d0], p0, 0, 0, 0);
    p1 = __builtin_amdgcn_mfma_f32_32x32x16_bf16(b1, qr[d0], p1, 0, 0, 0); }
}
__device__ __forceinline__ int v_st(int k, int c) { const int kk = (k & ~0xC) | ((k & 4) << 1) | ((k & 8) >> 1); return ((kk >> 3) * 4 + (c >> 5)) * 512 + ((kk & 7) * 32 + (c & 31)) * 2; }
__device__ __forceinline__ int v_rd_base(int lane) { return ((lane & 3) << 3) | (((lane >> 2) & 3) << 6) | (((lane >> 4) & 1) << 5) | (((lane >> 5) & 1) << 8); }
constexpr int v_rd_off(int d0, int ks, int half) { return d0 * 512 + ks * 4096 + half * 2048; }
template <int OFF> __device__ __forceinline__ s16x4 tr_read(int vb) {
  s16x4 r; asm volatile("ds_read_b64_tr_b16 %0, %1 offset:%2" : "=&v"(r) : "v"(vb), "i"(OFF) : "memory"); return r;
}
template <int D0> __device__ __forceinline__ void pv_one(f32x16& od, int vb, bf16x8 pa0, bf16x8 pa1, bf16x8 pa2, bf16x8 pa3) {
  const s16x4 l0 = tr_read<v_rd_off(D0, 0, 0)>(vb), h0 = tr_read<v_rd_off(D0, 0, 1)>(vb), l1 = tr_read<v_rd_off(D0, 1, 0)>(vb), h1 = tr_read<v_rd_off(D0, 1, 1)>(vb);
  const s16x4 l2 = tr_read<v_rd_off(D0, 2, 0)>(vb), h2 = tr_read<v_rd_off(D0, 2, 1)>(vb), l3 = tr_read<v_rd_off(D0, 3, 0)>(vb), h3 = tr_read<v_rd_off(D0, 3, 1)>(vb);
  asm volatile("s_waitcnt lgkmcnt(0)" ::: "memory"); SBAR();
#define PK(L, H) (bf16x8){L[0], L[1], L[2], L[3], H[0], H[1], H[2], H[3]}
  od = __builtin_amdgcn_mfma_f32_32x32x16_bf16(pa0, PK(l0, h0), od, 0, 0, 0);
  od = __builtin_amdgcn_mfma_f32_32x32x16_bf16(pa1, PK(l1, h1), od, 0, 0, 0);
  od = __builtin_amdgcn_mfma_f32_32x32x16_bf16(pa2, PK(l2, h2), od, 0, 0, 0);
  od = __builtin_amdgcn_mfma_f32_32x32x16_bf16(pa3, PK(l3, h3), od, 0, 0, 0);
#undef PK
}
__device__ __forceinline__ void pv_d0(f32x16* o, int vb, bf16x8 pa0, bf16x8 pa1, bf16x8 pa2, bf16x8 pa3) {
  pv_one<0>(o[0], vb, pa0, pa1, pa2, pa3); pv_one<1>(o[1], vb, pa0, pa1, pa2, pa3); pv_one<2>(o[2], vb, pa0, pa1, pa2, pa3); pv_one<3>(o[3], vb, pa0, pa1, pa2, pa3);
}
__device__ __forceinline__ void attn_dense_body(const bf16_t* __restrict__ Qb, const bf16_t* __restrict__ Kh, const bf16_t* __restrict__ Vh,
                                                const bf16_t* __restrict__ Gb, bf16_t* __restrict__ Yb, int seq, char* lds, const int wid) {
  const int lane = lane_id_opaque(), tid = wid * 64 + lane, r32 = lane & 31, hi = lane >> 5;
  bf16_t* V_lds = (bf16_t*)lds; bf16_t* K_lds = (bf16_t*)(lds + 2 * SHM_V);
  float* ws = (float*)(lds + 2 * SHM_V + 2 * SHM_K) + wid * 64; float* li_l = ws; float* al_l = ws + 32;
  float m_reg = -1e30f, l_reg = 0; f32x16 o[4] = {}; bf16x8 qr[8];
  const bf16_t* Qw = Qb + (long)(wid * QBLK + r32) * LDQ + hi * 8;
#pragma unroll
  for (int d0 = 0; d0 < 8; ++d0) qr[d0] = __builtin_nontemporal_load(reinterpret_cast<const bf16x8*>(Qw + d0 * 16));
  const int sr = tid >> 4, sc = (tid & 15) * 8, vst0 = v_st(sr, sc), vst1 = v_st(32 + sr, sc);
  const int vb0 = (int)(uintptr_t)V_lds + v_rd_base(lane);
  struct { bf16x8 vs0, vs1, ks0, ks1; } sr_[2];
#define SLOAD(i, k0) do { sr_[i].vs0 = *reinterpret_cast<const bf16x8*>(&Vh[(long)((k0) + sr) * LDK + sc]); sr_[i].vs1 = *reinterpret_cast<const bf16x8*>(&Vh[(long)((k0) + 32 + sr) * LDK + sc]); \
    sr_[i].ks0 = *reinterpret_cast<const bf16x8*>(&Kh[(long)((k0) + sr) * LDK + sc]); sr_[i].ks1 = *reinterpret_cast<const bf16x8*>(&Kh[(long)((k0) + 32 + sr) * LDK + sc]); } while (0)
#define SWRITE(b, i) do { *(bf16x8*)((char*)V_lds + (b) * SHM_V + vst0) = sr_[i].vs0;          \
    *(bf16x8*)((char*)V_lds + (b) * SHM_V + vst1) = sr_[i].vs1; int kc = sc * 2;               \
    *(bf16x8*)((char*)K_lds + (b) * SHM_K + KSWZ(sr, kc)) = sr_[i].ks0;                       \
    *(bf16x8*)((char*)K_lds + (b) * SHM_K + KSWZ(32 + sr, kc)) = sr_[i].ks1; } while (0)
#define SWAIT() asm volatile("s_waitcnt vmcnt(4)" ::: "memory")
#define RESC(a) do { if (__any((a) < 1.f)) { if (hi == 0) al_l[r32] = (a); asm volatile("s_waitcnt lgkmcnt(0)" ::: "memory"); \
    for (int d = 0; d < 4; ++d) for (int r = 0; r < 16; ++r) o[d][r] *= al_l[crow(r, hi)]; } } while (0)
  f32x16 pA0, pA1, pB0, pB1; float mnA, mnB, alA, alB; bf16x8 pa0, pa1, pa2, pa3; const int NT = seq / KVBLK;
  constexpr int SE = 0, SO = 1;
  SLOAD(SE, 0); asm volatile("s_waitcnt vmcnt(0)" ::: "memory"); SWRITE(0, SE); __syncthreads();
  qkt(pA0, pA1, K_lds, qr, r32, hi); partialSM(pA0, pA1, m_reg, mnA, alA);
  SLOAD(SO, KVBLK); if (2 < NT) SLOAD(SE, 2 * KVBLK);
  SWAIT(); SWRITE(1, SO); __syncthreads();
  for (int j = 1; j + 1 < NT; j += 2) {
    SBAR(); qkt(pB0, pB1, (bf16_t*)((char*)K_lds + SHM_K), qr, r32, hi);
    finishSM(pA0, pA1, alA, l_reg, pa0, pa1, pa2, pa3); SBAR();
    SLOAD(SO, (j + 2) * KVBLK); SBAR();
    pv_d0(o, vb0, pa0, pa1, pa2, pa3); partialSM(pB0, pB1, m_reg, mnB, alB);
    __syncthreads(); SWAIT(); SWRITE(0, SE);
    RESC(alB); __syncthreads();
    SBAR(); qkt(pA0, pA1, K_lds, qr, r32, hi);
    finishSM(pB0, pB1, alB, l_reg, pa0, pa1, pa2, pa3); SBAR();
    if (j + 3 < NT) SLOAD(SE, (j + 3) * KVBLK); SBAR();
    pv_d0(o, vb0 + (int)SHM_V, pa0, pa1, pa2, pa3); partialSM(pA0, pA1, m_reg, mnA, alA);
    __syncthreads(); SWAIT(); SWRITE(1, SO);
    RESC(alA); __syncthreads();
  }
  SBAR(); qkt(pB0, pB1, (bf16_t*)((char*)K_lds + SHM_K), qr, r32, hi);
  finishSM(pA0, pA1, alA, l_reg, pa0, pa1, pa2, pa3); SBAR();
  pv_d0(o, vb0, pa0, pa1, pa2, pa3); partialSM(pB0, pB1, m_reg, mnB, alB);
  __syncthreads(); RESC(alB);
  finishSM(pB0, pB1, alB, l_reg, pa0, pa1, pa2, pa3); SBAR();
  pv_d0(o, vb0 + (int)SHM_V, pa0, pa1, pa2, pa3);
  if (hi == 0) li_l[r32] = l_reg; asm volatile("s_waitcnt lgkmcnt(0)" ::: "memory");
  float rli[16];
#pragma unroll
  for (int r = 0; r < 16; ++r) rli[r] = __builtin_amdgcn_rcpf(li_l[crow(r, hi)]);
  bf16_t* Yw = Yb + (long)(wid * QBLK) * DM; const bf16_t* Gw = Gb + (long)(wid * QBLK) * DATT;
  __syncthreads();
  bf16_t* stg = (bf16_t*)(lds + wid * 8192);
#pragma unroll
  for (int r = 0; r < 16; ++r) { const int orow = crow(r, hi);
#pragma unroll
    for (int d0 = 0; d0 < 4; ++d0) stg[orow * 128 + d0 * 32 + r32] = (bf16_t)f2bf(o[d0][r] * rli[r]); }
  asm volatile("s_waitcnt lgkmcnt(0)" ::: "memory");
  const int l2 = lane_id_opaque();
#pragma unroll
  for (int i = 0; i < 8; ++i) { const int q = l2 + 64 * i, row = q >> 4, c8 = (q & 15) * 8;
    const u32x4 v = *(const u32x4*)(stg + row * 128 + c8); const u32x4 gg = __builtin_nontemporal_load((const u32x4*)(Gw + (unsigned)(row * DATT + c8)));
    u32x4 w; w.x = pk2(bflo(v.x) * bflo(gg.x), bfhi(v.x) * bfhi(gg.x)); w.y = pk2(bflo(v.y) * bflo(gg.y), bfhi(v.y) * bfhi(gg.y));
    w.z = pk2(bflo(v.z) * bflo(gg.z), bfhi(v.z) * bfhi(gg.z)); w.w = pk2(bflo(v.w) * bflo(gg.w), bfhi(v.w) * bfhi(gg.w));
    *(u32x4*)(Yw + (unsigned)(row * DM + c8)) = w; }
  __syncthreads();
#undef SLOAD
#undef SWRITE
#undef SWAIT
#undef RESC
}
#undef SBAR
}

__device__ __forceinline__ void p0_transpose_item(const float* W, int K, int N, bf16_t* WT, int wt_row0, const float* kscale, LAS float* scr, int k0, int n0, int lane) {
#pragma unroll
    for (int i = 0; i < 32; ++i) { const int kk = 2 * i + (lane >> 5); float v = W[(size_t)(k0 + kk) * N + n0 + (lane & 31)]; if (kscale) v *= kscale[k0 + kk]; scr[kk * 33 + (lane & 31)] = v; }
    LDS_WAIT(); asm volatile("" ::: "memory");
    const int c = lane & 7;
#pragma unroll
    for (int j = 0; j < 4; ++j) { const int n = (lane >> 3) + 8 * j; const LAS float* s = scr + (8 * c) * 33 + n;
        u32x4 o; o.x = pk2(s[0 * 33], s[1 * 33]); o.y = pk2(s[2 * 33], s[3 * 33]); o.z = pk2(s[4 * 33], s[5 * 33]); o.w = pk2(s[6 * 33], s[7 * 33]);
        *(u32x4*)(WT + (size_t)(wt_row0 + n) * K + k0 + 8 * c) = o; }
    LDS_WAIT(); asm volatile("" ::: "memory");
}

struct TrItem { const float* W; bf16_t* WT; const float* kscale; int K, N, wt_row0, k0, n0; };
__device__ __forceinline__ void p0_tr_load(const TrItem& d, float (&v)[32], int lane) {
#pragma unroll
    for (int i = 0; i < 32; ++i) { const int kk = 2 * i + (lane >> 5); v[i] = __builtin_nontemporal_load(d.W + (size_t)(d.k0 + kk) * d.N + d.n0 + (lane & 31)); }
    if (d.kscale) {
#pragma unroll
        for (int i = 0; i < 32; ++i) { const int kk = 2 * i + (lane >> 5); v[i] *= d.kscale[d.k0 + kk]; } }
}
__device__ __forceinline__ void p0_tr_store(const TrItem& d, const float (&v)[32], LAS float* scr, int lane) {
#pragma unroll
    for (int i = 0; i < 32; ++i) { const int kk = 2 * i + (lane >> 5); scr[kk * 33 + (lane & 31)] = v[i]; }
    LDS_WAIT(); asm volatile("" ::: "memory");
    const int c = lane & 7;
#pragma unroll
    for (int j = 0; j < 4; ++j) { const int n = (lane >> 3) + 8 * j; const LAS float* s = scr + (8 * c) * 33 + n;
        u32x4 o; o.x = pk2(s[0 * 33], s[1 * 33]); o.y = pk2(s[2 * 33], s[3 * 33]); o.z = pk2(s[4 * 33], s[5 * 33]); o.w = pk2(s[6 * 33], s[7 * 33]);
        *(u32x4*)(d.WT + (size_t)(d.wt_row0 + n) * d.K + d.k0 + 8 * c) = o; }
    LDS_WAIT(); asm volatile("" ::: "memory");
}
__device__ __forceinline__ void ssm_tables(const Args& a, int g, LAS unsigned char* lds, int tid) {
    LAS float* LD = (LAS float*)lds;
    LAS float* LBs = LD + 256;
    LAS float* BB = LBs + 256;
    LAS float* KT = BB + 4096;
    LAS float* CC = KT + 8192;
    float* lb16 = (float*)(a.ws + WS_LB16);
    bf16_t* WIN = (bf16_t*)(a.ws + WS_WIN) + (size_t)g * 256 * 256;
    bf16_t* WBIG = (bf16_t*)(a.ws + WS_WBIG) + (size_t)g * 256 * 512;
    LAS float* DD = CC + 4096;
    float cre_[4], cim_[4], bre_[4], bim_[4];
#pragma unroll
    for (int k = 0; k < 4; ++k) { const int e = tid + 512 * k; const int d = e >> 10, r = e & 1023; const size_t ci_ = (size_t)(d * NG + g) * 1024 + r; cre_[k] = a.c_re[ci_]; cim_[k] = a.c_im[ci_];
        const int dp = e >> 4, h = e & 15, d2 = dp >> 6, p2 = dp & 63; const size_t bi_ = ((size_t)(d2 * NG + g) * 64 + p2) * 16 + h; bre_[k] = a.b_re[bi_]; bim_[k] = a.b_im[bi_]; }
    const float dld = a.ssm_d[g * 16 + (tid & 15)];
    const int d_a = (tid >> 6) & 1, p_a = tid & 63, idx_a = (d_a * NG + g) * 64 + p_a;
    const float are_ = a.a_re[idx_a], aim_ = a.a_im[idx_a], ldt_ = a.log_dt[d_a * NG + g];
#pragma unroll
    for (int k = 0; k < 4; ++k) { const int e = tid + 512 * k; CC[e * 2] = cre_[k]; CC[e * 2 + 1] = cim_[k]; }
    if (tid < 16) DD[tid] = dld;
    if (tid < 128) {
        const float lr = fminf(are_, -1e-4f), li = aim_;
        const float dt = expf(ldt_);
        const float er = expf(lr * dt); float sn, cs; sincosf(li * dt, &sn, &cs);
        const float br = er * cs, bi = er * sn;
        LD[tid * 2] = lr * dt; LD[tid * 2 + 1] = li * dt; LBs[tid * 2] = br; LBs[tid * 2 + 1] = bi;
        const float nr = br - 1.f, ni = bi, den = lr * lr + li * li;
        KT[tid * 2] = (nr * lr + ni * li) / den; KT[tid * 2 + 1] = (ni * lr - nr * li) / den;
        const float e16 = expf(16.f * lr * dt); float s16, c16; sincosf(16.f * li * dt, &s16, &c16);
        lb16[(g * 128 + tid) * 2] = e16 * c16; lb16[(g * 128 + tid) * 2 + 1] = e16 * s16;
    }
    __syncthreads();
#pragma unroll
    for (int k = 0; k < 4; ++k) { const int e = tid + 512 * k; const int dp = e >> 4;
        const float xr = bre_[k], xi = bim_[k], cr = KT[dp * 2], ci = KT[dp * 2 + 1];
        BB[e * 2] = cr * xr - ci * xi; BB[e * 2 + 1] = cr * xi + ci * xr;
    }
    __syncthreads();
    {
        const int d = tid >> 8, hp = (tid >> 4) & 15, h = tid & 15; float acc[16];
#pragma unroll
        for (int t = 0; t < 16; ++t) acc[t] = 0.f;
        const LAS float* cc = CC + ((d * 16 + hp) * 64) * 2;
#pragma unroll 4
        for (int p = 0; p < 64; ++p) {
            const float c_r = cc[p * 2], c_i = cc[p * 2 + 1], b_r = BB[((d * 64 + p) * 16 + h) * 2], b_i = BB[((d * 64 + p) * 16 + h) * 2 + 1];
            float wr = c_r * b_r - c_i * b_i, wi = c_r * b_i + c_i * b_r; const float l_r = LBs[(d * 64 + p) * 2], l_i = LBs[(d * 64 + p) * 2 + 1];
#pragma unroll
            for (int t = 0; t < 16; ++t) { acc[t] += wr; const float nr = wr * l_r - wi * l_i; wi = wr * l_i + wi * l_r; wr = nr; }
        }
#pragma unroll
        for (int t = 0; t < 16; ++t) KT[((d * 16 + t) * 16 + hp) * 16 + h] = acc[t];
    }
    __syncthreads();
    for (int q = tid; q < 8192; q += 512) {
        const int n = q >> 5, kc = q & 31, s = kc >> 1, h0 = (kc & 1) * 8, j = n >> 4, hp = n & 15;
        const int dsel = s < j ? 0 : 1, tau = s < j ? j - s : s - j;
        const LAS float* k0 = KT + ((dsel * 16 + tau) * 16 + hp) * 16 + h0;
        const LAS float* kf = KT + ((0 * 16 + 0) * 16 + hp) * 16 + h0; const LAS float* kb = KT + ((1 * 16 + 0) * 16 + hp) * 16 + h0;
        const bool diag = (s == j); const float dval = DD[hp];
        float v[8];
#pragma unroll
        for (int e = 0; e < 8; ++e) { const float off = k0[e], dg = kf[e] + kb[e] + ((h0 + e) == hp ? dval : 0.f); v[e] = diag ? dg : off; }
        u32x4 w; w.x = pk2(v[0], v[1]); w.y = pk2(v[2], v[3]); w.z = pk2(v[4], v[5]); w.w = pk2(v[6], v[7]);
        *(u32x4*)(WBIG + (size_t)n * 512 + s * 16 + h0) = w;
    }
    for (int q = tid; q < 2048; q += 512) {
        const int p = q & 63, js = (q >> 6) & 15, d = q >> 10; const float ldr = LD[(d * 64 + p) * 2], ldi = LD[(d * 64 + p) * 2 + 1];
        {   const float pw = (float)(d == 0 ? js + 1 : 16 - js); const float er = __expf(pw * ldr); float sn, cs; __sincosf(pw * ldi, &sn, &cs); const float pr = er * cs, pi = er * sn;
#pragma unroll
            for (int hp = 0; hp < 16; ++hp) { const float c_r = CC[((d * 16 + hp) * 64 + p) * 2], c_i = CC[((d * 16 + hp) * 64 + p) * 2 + 1];
                *(unsigned*)(WBIG + (size_t)(js * 16 + hp) * 512 + 256 + d * 128 + 2 * p) = pk2(c_r * pr - c_i * pi, -(c_r * pi + c_i * pr)); } }
        {   const float pw = (float)(d == 0 ? 15 - js : js); const float er = __expf(pw * ldr); float sn, cs; __sincosf(pw * ldi, &sn, &cs); const float pr = er * cs, pi = er * sn;
            float zr[16], zi[16];
#pragma unroll
            for (int h = 0; h < 16; ++h) { const float b_r = BB[((d * 64 + p) * 16 + h) * 2], b_i = BB[((d * 64 + p) * 16 + h) * 2 + 1]; zr[h] = pr * b_r - pi * b_i; zi[h] = pr * b_i + pi * b_r; }
            bf16_t* d0 = WIN + (size_t)(d * 128 + p) * 256 + js * 16; bf16_t* d1 = d0 + (size_t)64 * 256;
            u32x4 w; w.x = pk2(zr[0], zr[1]); w.y = pk2(zr[2], zr[3]); w.z = pk2(zr[4], zr[5]); w.w = pk2(zr[6], zr[7]); *(u32x4*)d0 = w;
            w.x = pk2(zr[8], zr[9]); w.y = pk2(zr[10], zr[11]); w.z = pk2(zr[12], zr[13]); w.w = pk2(zr[14], zr[15]); *(u32x4*)(d0 + 8) = w;
            w.x = pk2(zi[0], zi[1]); w.y = pk2(zi[2], zi[3]); w.z = pk2(zi[4], zi[5]); w.w = pk2(zi[6], zi[7]); *(u32x4*)d1 = w;
            w.x = pk2(zi[8], zi[9]); w.y = pk2(zi[10], zi[11]); w.z = pk2(zi[12], zi[13]); w.w = pk2(zi[14], zi[15]); *(u32x4*)(d1 + 8) = w; }
    }
    __syncthreads();
}

#define XB_TMO      128
#define XB_XCNT(j)  (256  + 64 * (j))
#define XB_XSUB(j)  (1280 + 64 * (j))
#define XB_XGEN(j)  (2304 + 64 * (j))
#define XB_TOP      3328
#define XB_TOPGEN   3392
#define XCD_BAR_WORDS 3456
#define XB_SPIN_CAP (1u << 18)
__device__ __forceinline__ unsigned xb_ld(unsigned* p)              { return __hip_atomic_load(p, __ATOMIC_RELAXED, __HIP_MEMORY_SCOPE_AGENT); }
__device__ __forceinline__ unsigned xb_add(unsigned* p, unsigned v) { return __hip_atomic_fetch_add(p, v, __ATOMIC_RELAXED, __HIP_MEMORY_SCOPE_AGENT); }
__device__ __forceinline__ unsigned xb_xcc_id() { return (unsigned)__builtin_amdgcn_s_getreg((3 << 11) | 20) & 0xFu; }
#define XB_SPIN(cond, bar) do { unsigned _sp = 0; while (cond) { __builtin_amdgcn_s_sleep(1); \
    if ((++_sp & 255u) == 0u) { if (xb_ld(&(bar)[XB_TMO])) break; if (_sp > XB_SPIN_CAP) { atomicAdd(&(bar)[XB_TMO], 1u); break; } } } } while (0)
struct XcdBarrier { unsigned* bar; unsigned x; volatile LAS unsigned* st; };
__device__ __forceinline__ XcdBarrier xcd_barrier_post(unsigned* bar, volatile LAS unsigned* st, bool leader) {
    XcdBarrier b; b.bar = bar; b.x = xb_xcc_id(); b.st = st;
    if (leader) (void)xb_add(&bar[XB_XCNT(b.x)], 1u);
    return b;
}
__device__ __forceinline__ void xcd_barrier_complete(unsigned* bar, unsigned x, unsigned& nloc, unsigned& nx) {
    const unsigned G = gridDim.x * gridDim.y * gridDim.z;
    unsigned sum, cnt, mine, sp = 0u;
    for (;;) {
        sum = 0u; cnt = 0u; mine = 0u;
#pragma unroll
        for (unsigned j = 0; j < 16; ++j) { const unsigned c = xb_ld(&bar[XB_XCNT(j)]); sum += c; cnt += (c > 0u) ? 1u : 0u; mine = (j == x) ? c : mine; }
        if (sum == G) break;
        __builtin_amdgcn_s_sleep(1);
        if ((++sp & 255u) == 0u) { if (xb_ld(&bar[XB_TMO])) break; if (sp > XB_SPIN_CAP) { atomicAdd(&bar[XB_TMO], 1u); break; } }
    }
    nloc = mine > 0u ? mine : 1u; nx = cnt > 0u ? cnt : 1u;
}
__device__ __forceinline__ void xcd_barrier(const XcdBarrier& b, bool leader) {
    asm volatile("s_waitcnt vmcnt(0)" ::: "memory");
    __syncthreads();
    if (leader) {
        unsigned* bar = b.bar;
        __builtin_amdgcn_s_waitcnt(0);
        unsigned nloc = b.st[0], nx = b.st[1];
        if (nloc == 0u) { xcd_barrier_complete(bar, b.x, nloc, nx); b.st[0] = nloc; b.st[1] = nx; }
        const unsigned old = xb_add(&bar[XB_XSUB(b.x)], 1u);
        const unsigned gen = old / nloc;
        if (old + 1u == (gen + 1u) * nloc) {
            __builtin_amdgcn_fence(__ATOMIC_RELEASE, "agent");
            asm volatile("s_waitcnt vmcnt(0)" ::: "memory");
            const unsigned og = xb_add(&bar[XB_TOP], 1u);
            const unsigned tg = og / nx;
            if (og + 1u == (tg + 1u) * nx) xb_add(&bar[XB_TOPGEN], 1u);
            else XB_SPIN(xb_ld(&bar[XB_TOPGEN]) == tg, bar);
            __builtin_amdgcn_fence(__ATOMIC_ACQUIRE, "agent");
            xb_add(&bar[XB_XGEN(b.x)], 1u);
            asm volatile("s_waitcnt vmcnt(0)" ::: "memory");
        } else {
            XB_SPIN(xb_ld(&bar[XB_XGEN(b.x)]) == gen, bar);
            __builtin_amdgcn_fence(__ATOMIC_ACQUIRE, "agent");
            asm volatile("s_waitcnt vmcnt(0)" ::: "memory");
        }
    }
    __syncthreads();
}

__device__ __forceinline__ void xcd_barrier_arrive(const XcdBarrier& b, bool leader) {
    asm volatile("s_waitcnt vmcnt(0)" ::: "memory");
    __syncthreads();
    if (leader) {
        unsigned* bar = b.bar;
        __builtin_amdgcn_s_waitcnt(0);
        unsigned nloc = b.st[0], nx = b.st[1];
        if (nloc == 0u) { xcd_barrier_complete(bar, b.x, nloc, nx); b.st[0] = nloc; b.st[1] = nx; }
        const unsigned old = xb_add(&bar[XB_XSUB(b.x)], 1u);
        const unsigned gen = old / nloc;
        if (old + 1u == (gen + 1u) * nloc) {
            __builtin_amdgcn_fence(__ATOMIC_RELEASE, "agent");
            asm volatile("s_waitcnt vmcnt(0)" ::: "memory");
            const unsigned og = xb_add(&bar[XB_TOP], 1u);
            const unsigned tg = og / nx;
            if (og + 1u == (tg + 1u) * nx) { xb_add(&bar[XB_TOPGEN], 1u); b.st[5] = 3u; } else b.st[5] = 2u;
            b.st[6] = tg;
        } else { b.st[5] = 1u; b.st[6] = gen; }
    }
}
__device__ __forceinline__ void xcd_barrier_wait(const XcdBarrier& b, bool leader) {
    if (leader) {
        unsigned* bar = b.bar; const unsigned role = b.st[5], g = b.st[6];
        if (role >= 2u) {
            if (role == 2u) XB_SPIN(xb_ld(&bar[XB_TOPGEN]) == g, bar);
            __builtin_amdgcn_fence(__ATOMIC_ACQUIRE, "agent");
            xb_add(&bar[XB_XGEN(b.x)], 1u);
            asm volatile("s_waitcnt vmcnt(0)" ::: "memory");
        } else {
            XB_SPIN(xb_ld(&bar[XB_XGEN(b.x)]) == g, bar);
            __builtin_amdgcn_fence(__ATOMIC_ACQUIRE, "agent");
            asm volatile("s_waitcnt vmcnt(0)" ::: "memory");
        }
    }
    __syncthreads();
}

__global__ void __launch_bounds__(512, 2) fwd_kernel(Args a) {
    extern __shared__ __attribute__((aligned(16))) unsigned char lds_raw[];
    LAS unsigned char* lds = (LAS unsigned char*)lds_raw;
    cg::grid_group grid = cg::this_grid();
    const int wave = __builtin_amdgcn_readfirstlane(threadIdx.x >> 6);
    const bool leader = (wave == 0) && (lane_id_opaque() == 0);
    volatile LAS unsigned* xst = (volatile LAS unsigned*)(lds + XBST_OFF);
    if (leader) { xst[0] = 0u; xst[1] = 0u; }
    __syncthreads();
    if (a.ws == nullptr) grid.sync();
    const XcdBarrier xbar = xcd_barrier_post((unsigned*)(a.ws + WS_BAR), xst, leader);
#define GRID_SYNC() xcd_barrier(xbar, (wave == 0) && (lane_id_opaque() == 0))
#define LANE_IDS const int lane = lane_id_opaque(), tid = wave * 64 + lane; (void)tid;
    const int G = gridDim.x, bid = blockIdx.x;
    unsigned char* ws = a.ws;
    bf16_t* W1T = (bf16_t*)(ws + WS_W1T); bf16_t* WGLUT = (bf16_t*)(ws + WS_WGLUT); bf16_t* WOT = (bf16_t*)(ws + WS_WOT); bf16_t* WGT = (bf16_t*)(ws + WS_WGT); bf16_t* WPT = (bf16_t*)(ws + WS_WPT);
    float2* ROPE = (float2*)(ws + WS_ROPE); float* RINV = (float*)(ws + WS_RINV); float* LB16 = (float*)(ws + WS_LB16); float* SSQ1 = (float*)(ws + WS_SSQ1); float* SSQ2 = (float*)(ws + WS_SSQ2);
    bf16_t* PB = (bf16_t*)(ws + WS_PB); bf16_t* WIN = (bf16_t*)(ws + WS_WIN); bf16_t* WBIG = (bf16_t*)(ws + WS_WBIG);
    bf16_t* XB = (bf16_t*)(ws + WS_XB); bf16_t* HB = (bf16_t*)(ws + WS_XB);
    bf16_t* Q = (bf16_t*)(ws + WS_Q); bf16_t* KB = (bf16_t*)(ws + WS_K); bf16_t* VB = (bf16_t*)(ws + WS_V); bf16_t* GA = (bf16_t*)(ws + WS_GA); bf16_t* GS = (bf16_t*)(ws + WS_GS);
    bf16_t* UCAT = (bf16_t*)(ws + WS_UCAT); bf16_t* PPB = (bf16_t*)(ws + WS_UCAT); bf16_t* YMIX = (bf16_t*)(ws + WS_YMIX); bf16_t* YS = (bf16_t*)(ws + WS_YS);

#pragma unroll
    for (int rep_ = 0; rep_ < 1 + ((REP_MASK >> 0) & 1); ++rep_) { LANE_IDS
        const int gw = bid * 8 + wave, NGW = G * 8;
        LAS float* scr = (LAS float*)(lds + wave * 16384);
        constexpr int I1 = 32 * 144, I2 = 16 * 64, I3 = 32 * 64, I4 = 32 * 64, I5 = 4 * 64, NIT = I1 + I2 + I3 + I4 + I5;
        auto item_desc = [&](int r) -> TrItem {
            if (r < I1) { const int kb = r / 144, lgg = r % 144, pn = lgg >> 3, lg = lgg & 7, wtg = pn * 8 + 4 * (lg & 1) + 2 * (lg >> 2) + ((lg >> 1) & 1);
                return TrItem{a.w_in, W1T, a.norm_mix, DM, DIN, wtg * 32, kb * 64, lgg * 32}; } r -= I1;
            if (r < I2) { const int kb = r / 64, lgg = r % 64, l2 = lgg & 31, wtg = (l2 >> 2) * 8 + 4 * (lgg >> 5) + (l2 & 3);
                return TrItem{a.w_glu, WGLUT, nullptr, DSSM, 2 * DSSM, wtg * 32, kb * 64, lgg * 32}; } r -= I2;
            if (r < I3) { const int kb = r / 64, lgg = r % 64; return TrItem{a.w_out, WOT, nullptr, DM, DM, lgg * 32, kb * 64, lgg * 32}; } r -= I3;
            if (r < I4) { const int kb = r / 64, lgg = r % 64; return TrItem{a.w_ple_gate, WGT, a.norm_ple, DM, DM, lgg * 32, kb * 64, lgg * 32}; } r -= I4;
            const int kb = r / 64, lgg = r % 64; return TrItem{a.w_ple_proj, WPT, nullptr, PLE, DM, lgg * 32, kb * 64, lgg * 32};
        };
#pragma unroll
        for (int rq_ = 0; rq_ < 1 + ((REP_MASK >> 8) & 1); ++rq_)
        for (int it = gw; it < I1; it += 2 * NGW) {
            const bool two = it + NGW < I1;
            const TrItem dA = item_desc(it), dB = item_desc(two ? it + NGW : it);
            float vA[32], vB[32];
            p0_tr_load(dA, vA, lane); if (two) p0_tr_load(dB, vB, lane);
            p0_tr_store(dA, vA, scr, lane); if (two) p0_tr_store(dB, vB, scr, lane);
        }
#pragma unroll
        for (int rq_ = 0; rq_ < 1 + ((REP_MASK >> 9) & 1); ++rq_)
        for (int m = gw; m < T; m += 2 * NGW) {
            const int m2 = m + NGW; const bool two = m2 < T;
            const f32x4* xr = (const f32x4*)(a.x + (size_t)m * DM) + lane; const f32x4* xr2 = (const f32x4*)(a.x + (size_t)(two ? m2 : m) * DM) + lane;
            f32x4 v[8], w2[8]; float s = 0.f, s2 = 0.f;
#pragma unroll
            for (int j = 0; j < 8; ++j) v[j] = __builtin_nontemporal_load(xr + 64 * j);
#pragma unroll
            for (int j = 0; j < 8; ++j) w2[j] = __builtin_nontemporal_load(xr2 + 64 * j);
#pragma unroll
            for (int j = 0; j < 8; ++j) { s += (v[j][0] * v[j][0] + v[j][1] * v[j][1]) + (v[j][2] * v[j][2] + v[j][3] * v[j][3]); s2 += (w2[j][0] * w2[j][0] + w2[j][1] * w2[j][1]) + (w2[j][2] * w2[j][2] + w2[j][3] * w2[j][3]); }
            s = wave_sum(s); s2 = wave_sum(s2);
            if (lane == 0) { RINV[m] = rsqrtf(s * (1.f / DM) + EPS); if (two) RINV[m2] = rsqrtf(s2 * (1.f / DM) + EPS); }
            u32x2* o = (u32x2*)(XB + (size_t)m * DM) + lane; u32x2* o2 = (u32x2*)(XB + (size_t)m2 * DM) + lane;
#pragma unroll
            for (int j = 0; j < 8; ++j) { u32x2 w; w.x = pk2(v[j][0], v[j][1]); w.y = pk2(v[j][2], v[j][3]); o[64 * j] = w; }
            if (two) {
#pragma unroll
                for (int j = 0; j < 8; ++j) { u32x2 w; w.x = pk2(w2[j][0], w2[j][1]); w.y = pk2(w2[j][2], w2[j][3]); o2[64 * j] = w; } }
        }
        for (int i = bid * 512 + tid; i < T * PLE / 4; i += G * 512) { const f32x4 v = __builtin_nontemporal_load((const f32x4*)a.p + i); u32x2 w; w.x = pk2(v[0], v[1]); w.y = pk2(v[2], v[3]); ((u32x2*)PB)[i] = w; }
        for (int i = bid * 512 + tid; i < 2048; i += G * 512) { const int pos = i >> 5, f = i & 31; const float inv = powf(10000.f, -(float)f / 32.f); float sn, cs; sincosf((float)pos * inv, &sn, &cs); ROPE[i] = make_float2(cs, sn); }
        xcd_barrier_arrive(xbar, (wave == 0) && (lane_id_opaque() == 0));
        for (int it = I1 + gw; it < NIT; it += 2 * NGW) {
            const bool two = it + NGW < NIT;
            const TrItem dA = item_desc(it), dB = item_desc(two ? it + NGW : it);
            float vA[32], vB[32];
            p0_tr_load(dA, vA, lane); if (two) p0_tr_load(dB, vB, lane);
            p0_tr_store(dA, vA, scr, lane); if (two) p0_tr_store(dB, vB, scr, lane);
        }
        xcd_barrier_wait(xbar, (wave == 0) && (lane_id_opaque() == 0)); }


    if constexpr ((REP_MASK >> 10) & 1) { GRID_SYNC(); GRID_SYNC(); GRID_SYNC(); GRID_SYNC(); }
#pragma unroll
    for (int rep_ = 0; rep_ < 1 + ((REP_MASK >> 1) & 1); ++rep_) { LANE_IDS
        { pg8::Gemm g{XB, W1T, DM, DM, DM, 0, 0}; pg8::StaticOrder S; S.init(T, 14 * 256, G, bid);
          pg8::Epi1 E{RINV, a.q_norm, a.k_norm, ROPE, Q, KB, VB, GA, GS, UCAT, (LAS float*)(lds + XCH_OFF), 0};
          pg8::gemm_phase<pg8::Epi1, pg8::StaticOrder, true>(lds, g, S, E, wave); }
        __syncthreads();
        for (int gi = bid - (G - NG); gi >= 0 && gi < NG; gi += NG) ssm_tables(a, gi, lds, tid);
    GRID_SYNC(); }

#pragma unroll
    for (int rep_ = 0; rep_ < 1 + ((REP_MASK >> 2) & 1); ++rep_) {
#pragma unroll
        for (int rq_ = 0; rq_ < 2; ++rq_) {
        if (bid < 2 * NG) { if (rq_ == 1 && !((REP_MASK >> 6) & 1)) break;
            pg8::BatchOrder S{2 * NG, G, bid};
            { pg8::Gemm g{UCAT, WIN, 256, 512, 256, (size_t)NCH * 512 * 2, (size_t)256 * 256 * 2};
              pg8::EpiS1 E{LB16, UCAT}; pg8::gemm_phase<pg8::EpiS1, pg8::BatchOrder, true>(lds, g, S, E, wave); }
            asm volatile("s_waitcnt vmcnt(0)\n\tbuffer_inv sc1\n\ts_waitcnt vmcnt(0)" ::: "memory"); __syncthreads();
            { pg8::Gemm g{UCAT, WBIG, 512, 512, 512, (size_t)NCH * 512 * 2, (size_t)256 * 512 * 2};
              pg8::EpiS2 E{YS}; pg8::gemm_phase<pg8::EpiS2, pg8::BatchOrder, true>(lds, g, S, E, wave); }
        } else { if (rq_ == 1 && !((REP_MASK >> 11) & 1)) break;
            pg8::Gemm g{XB, W1T + (size_t)14 * 256 * DM, DM, DM, DM, 0, 0}; pg8::ListOrder S{bid - 2 * NG, 128, G};
            pg8::Epi1 E{RINV, a.q_norm, a.k_norm, ROPE, Q, KB, VB, GA, GS, UCAT, (LAS float*)(lds + XCH_OFF), 14};
            pg8::gemm_phase<pg8::Epi1, pg8::ListOrder, true>(lds, g, S, E, wave);
        }
        __syncthreads(); }
#pragma unroll
        for (int rq_ = 0; rq_ < 1 + ((REP_MASK >> 7) & 1); ++rq_)
        for (int un = bid; un < 256; un += G) {
            const int x = un & 7, jj = un >> 3, b = x >> 2, kvh = (x >> 1) & 1, idx = (x & 1) * 32 + jj, h = kvh * 4 + (idx >> 4), qb = idx & 15;
            const size_t tok0 = (size_t)b * SEQ + qb * 256;
            att::attn_dense_body(Q + tok0 * DATT + h * 128, KB + (size_t)b * SEQ * DKV + kvh * 128, VB + (size_t)b * SEQ * DKV + kvh * 128,
                                 GA + tok0 * DATT + h * 128, YMIX + tok0 * DM + h * 128, SEQ, (char*)lds_raw, wave);
        }
    GRID_SYNC(); }

#pragma unroll
    for (int rep_ = 0; rep_ < 1 + ((REP_MASK >> 3) & 1); ++rep_) {
        { pg8::StaticOrder S; S.init(T, 2 * DSSM, G, bid); pg8::Unit ua, ub;
          if (S.next(0, ua)) { ub = ua;
            pg8::Gemm ga{YS, WGLUT, DSSM, DSSM, DSSM, 0, 0}; pg8::EpiGlu Ea{a.b_glu, GS, YMIX};
            pg8::Gemm gb{PB, WPT, PLE, PLE, PLE, 0, 0}; pg8::EpiBf Eb{PPB, DM};
            pg8::gemm_phase2<pg8::EpiGlu, pg8::EpiBf>(lds, ga, ua, Ea, gb, ub, Eb, wave); } }
    GRID_SYNC(); }

#pragma unroll
    for (int rep_ = 0; rep_ < 1 + ((REP_MASK >> 4) & 1); ++rep_) {
        pg8::Gemm g{YMIX, WOT, DM, DM, DM, 0, 0}; pg8::StaticOrder S; S.init(T, DM, G, bid);
        pg8::EpiOut E{a.x, a.out, HB, SSQ1}; pg8::gemm_phase<pg8::EpiOut, pg8::StaticOrder, true>(lds, g, S, E, wave);
    GRID_SYNC(); }


    { LANE_IDS
        pg8::StaticOrder S; S.init(T, DM, G, bid); pg8::Unit u0;
        LAS float* r2 = (LAS float*)(lds + R2_OFF);
        if (S.next(0, u0) && tid < 256) { const float* sp = SSQ1 + (size_t)(u0.pm * 256 + tid) * 32; float s = 0.f;
#pragma unroll
            for (int i = 0; i < 8; ++i) { const f32x4 v = ((const f32x4*)sp)[i]; s += (v[0] + v[1]) + (v[2] + v[3]); }
            r2[tid] = rsqrtf(s * (1.f / DM) + EPS); }
        __syncthreads();
        pg8::Gemm g{HB, WGT, DM, DM, DM, 0, 0};
        pg8::EpiGate E{a.out, PPB, SSQ2, (unsigned*)ws, a.norm_final, r2, HB}; pg8::gemm_phase<pg8::EpiGate, pg8::StaticOrder, true>(lds, g, S, E, wave);
    }
}

extern "C" void kernel_launch(void* const* d_in, const int* in_sizes, int n_in, void* d_out, int out_size, void* d_ws, size_t ws_size, hipStream_t stream) {
    static int grid = 0;
    if (grid == 0) {
        if (n_in != 21 || in_sizes[0] != T * DM || out_size != T * DM || ws_size < WS_END) { fprintf(stderr, "kernel_launch: unexpected shapes (n_in %d, in0 %d, out %d, ws %zu)\n", n_in, n_in > 0 ? in_sizes[0] : -1, out_size, ws_size); grid = -1; return; }
        int dev = 0, cus = 0, per_cu = 0;
        hipGetDevice(&dev); hipDeviceGetAttribute(&cus, hipDeviceAttributeMultiprocessorCount, dev);
        if (hipFuncSetAttribute((const void*)fwd_kernel, hipFuncAttributeMaxDynamicSharedMemorySize, LDS_BYTES) != hipSuccess) { fprintf(stderr, "kernel_launch: hipFuncSetAttribute failed\n"); grid = -1; return; }
        hipOccupancyMaxActiveBlocksPerMultiprocessor(&per_cu, (const void*)fwd_kernel, 512, LDS_BYTES);
        (void)hipGetLastError();
        if (per_cu < 1) fprintf(stderr, "kernel_launch: occupancy query reports %d blocks per CU\n", per_cu);
        grid = cus > 256 ? 256 : cus;
    }
    if (grid < 0) return;
    Args a{};
    const float** f = (const float**)&a;
    for (int i = 0; i < 21; ++i) f[i] = (const float*)d_in[i];
    a.out = (float*)d_out; a.ws = (unsigned char*)d_ws;
    if (hipMemsetAsync(d_ws, 0, WS_CTL_BYTES, stream) != hipSuccess) { fprintf(stderr, "kernel_launch: hipMemsetAsync failed\n"); return; }
    void* args[] = {&a};
    hipError_t e = hipLaunchCooperativeKernel((const void*)fwd_kernel, dim3(grid), dim3(512), args, LDS_BYTES, stream);
    if (e != hipSuccess) fprintf(stderr, "kernel_launch: cooperative launch failed: %s (grid %d)\n", hipGetErrorString(e), grid);
}
```

```cpp
#include <hip/hip_runtime.h>
#include <hip/hip_cooperative_groups.h>
#include <cstdio>
#include <cstdint>
namespace cg = cooperative_groups;

#define LAS __attribute__((address_space(3)))
typedef unsigned short bf16_t;
typedef short bf16x8 __attribute__((ext_vector_type(8)));
typedef short s16x4 __attribute__((ext_vector_type(4)));
typedef float f32x4 __attribute__((ext_vector_type(4)));
typedef float f32x16 __attribute__((ext_vector_type(16)));
typedef unsigned u32x4 __attribute__((ext_vector_type(4)));
typedef unsigned u32x2 __attribute__((ext_vector_type(2)));

constexpr int T = 8192, SEQ = 4096, DM = 2048, DIN = 4608, DATT = 1024, DKV = 256, DSSM = 1024, PLE = 256;
constexpr int NG = 64, NCH = T / 16;
constexpr float EPS = 1e-6f;
#ifndef PH_MASK
#define PH_MASK 0xff
#endif
#ifndef GLDS_AUX
#define GLDS_AUX 0
#endif
#ifndef REP_MASK
#define REP_MASK 0
#endif

constexpr size_t MiB = 1u << 20;
constexpr size_t WS_W1T = 1 * MiB, WS_WGLUT = 19 * MiB, WS_WOT = 23 * MiB, WS_WGT = 31 * MiB, WS_WPT = 39 * MiB;
constexpr size_t WS_ROPE = 40 * MiB, WS_RINV = 40 * MiB + 65536, WS_LB16 = 40 * MiB + 131072, WS_SSQ1 = 41 * MiB, WS_SSQ2 = 42 * MiB;
constexpr size_t WS_PB = 43 * MiB, WS_WIN = 47 * MiB, WS_WBIG = 55 * MiB;
constexpr size_t WS_XB = 71 * MiB;
constexpr size_t WS_Q = 103 * MiB, WS_K = 119 * MiB, WS_V = 123 * MiB, WS_GA = 127 * MiB, WS_GS = 143 * MiB;
constexpr size_t WS_UCAT = 159 * MiB;
constexpr size_t WS_YMIX = 191 * MiB, WS_YS = 223 * MiB, WS_END = 239 * MiB;

constexpr int RING_BYTES = 131072, XCH_OFF = RING_BYTES, R2_OFF = RING_BYTES + 4096, XBST_OFF = RING_BYTES + 8192, LDS_BYTES = 147456;
constexpr size_t WS_BAR = 65536, WS_CTL_BYTES = 131072;

struct Args {
    const float *x, *p, *norm_mix, *w_in, *q_norm, *k_norm, *a_re, *a_im, *log_dt, *b_re, *b_im, *c_re, *c_im, *ssm_d, *w_glu, *b_glu, *w_out, *norm_ple, *w_ple_gate, *w_ple_proj, *norm_final;
    float* out; unsigned char* ws;
};

typedef __bf16 bf16s_;
__device__ __forceinline__ unsigned f2bf(float f) { return (unsigned)__builtin_bit_cast(unsigned short, (bf16s_)f); }
typedef float f32x2_ __attribute__((ext_vector_type(2)));
typedef __bf16 bf16x2_ __attribute__((ext_vector_type(2)));
__device__ __forceinline__ unsigned pk2(float lo, float hi) { const f32x2_ v = {lo, hi}; return __builtin_bit_cast(unsigned, __builtin_convertvector(v, bf16x2_)); }
__device__ __forceinline__ float bf2f(unsigned short b) { return __builtin_bit_cast(float, (unsigned)b << 16); }
__device__ __forceinline__ float bflo(unsigned w) { return __builtin_bit_cast(float, w << 16); }
__device__ __forceinline__ float bfhi(unsigned w) { return __builtin_bit_cast(float, w & 0xffff0000u); }
__device__ __forceinline__ unsigned cvt_pk_bf16(float lo, float hi) { unsigned r; asm volatile("v_cvt_pk_bf16_f32 %0, %1, %2" : "=v"(r) : "v"(lo), "v"(hi)); return r; }
__device__ __forceinline__ float sigmoidf_(float v) { return __builtin_amdgcn_rcpf(1.f + __builtin_amdgcn_exp2f(-1.4426950408889634f * v)); }
__device__ __forceinline__ float siluf_(float v) { return v * __builtin_amdgcn_rcpf(1.f + __builtin_amdgcn_exp2f(-1.4426950408889634f * v)); }
__device__ __forceinline__ float gelu_tanh(float v) { const float t = (-1.5957691216057308f * 1.4426950408889634f) * (v + 0.044715f * v * v * v); return v * __builtin_amdgcn_rcpf(1.f + __builtin_amdgcn_exp2f(t)); }
template <int K> __device__ __forceinline__ float swz_xor(float v) { return __int_as_float(__builtin_amdgcn_ds_swizzle(__float_as_int(v), (K << 10) | 0x1f)); }
__device__ __forceinline__ float sum_xor32(float v) { auto rr = __builtin_amdgcn_permlane32_swap(__float_as_uint(v), __float_as_uint(v), false, false); return __uint_as_float(rr[0]) + __uint_as_float(rr[1]); }
__device__ __forceinline__ float wave_sum(float v) { v += swz_xor<1>(v); v += swz_xor<2>(v); v += swz_xor<4>(v); v += swz_xor<8>(v); v += swz_xor<16>(v); return sum_xor32(v); }
#define LDS_WAIT() asm volatile("s_waitcnt lgkmcnt(0)" ::: "memory")
__device__ __forceinline__ int lane_id_opaque() { int l = __builtin_amdgcn_mbcnt_hi(~0u, __builtin_amdgcn_mbcnt_lo(~0u, 0u)); asm volatile("" : "+v"(l)); return l; }

namespace pg8 {
constexpr int BM = 256, BK = 64, HALF = 128, HTB = HALF * BK * 2, NXCD = 8, WGM = 8;
__host__ __device__ __forceinline__ int lds_byte(int r, int c) { const int st = (r >> 4) * 2 + (c >> 5), rr = r & 15, cc = c & 31, ob = rr * 64 + cc * 2; return st * 1024 + (ob ^ (((ob >> 9) & 1) << 5)); }
__host__ __device__ __forceinline__ void stage_rc(int b, int& R, int& C) { const int st = b / 1024, sb = b % 1024, swz = sb ^ (((sb >> 9) & 1) << 5); R = (st >> 1) * 16 + swz / 64; C = (st & 1) * 32 + (swz % 64) / 2; }
__host__ __device__ __forceinline__ int perm32(int rho) { const int n = rho >> 4, i = rho & 15; return 8 * (i >> 2) + 4 * n + (i & 3); }

struct Unit { int pm, pn, z; };
struct Gemm { const bf16_t* A; const bf16_t* Bt; int K, lda, ldb; size_t zA, zB; };

struct StaticOrder {
    int nM, nN, nwg, G, c;
    __device__ void init(int M, int N, int G_, int c_) { nM = M / BM; nN = N / BM; nwg = nM * nN; G = G_; c = c_; }
    __device__ bool next(int i, Unit& u) const {
        const long L = (long)i * G + c; if (L >= nwg) return false;
        int wgid = (int)L; { const int q = nwg / NXCD, r = nwg % NXCD, xcd = wgid % NXCD, off = wgid / NXCD; wgid = (xcd < r ? xcd * (q + 1) : r * (q + 1) + (xcd - r) * q) + off; }
        const int nig = WGM * nN, gid = wgid / nig, fm = gid * WGM, gsz = (nM - fm) < WGM ? (nM - fm) : WGM;
        u.pm = fm + ((wgid % nig) % gsz); u.pn = (wgid % nig) / gsz; u.z = 0; return true;
    }
};
struct BatchOrder {
    int n, G, c;
    __device__ bool next(int i, Unit& u) const { const int L = i * G + c; if (L >= n) return false;
        if ((n & 15) == 0) { const int x = L & 7, j = L >> 3; u.z = 8 * x + (j >> 1); u.pm = j & 1; }
        else { u.z = L >> 1; u.pm = L & 1; }
        u.pn = 0; return true; }
};

struct ListOrder {
    int L0, n, stride;
    __device__ bool next(int i, Unit& u) const { const int L = L0 + i * stride; if (L < 0 || L >= n) return false;
        const int x = L & 7, j = L >> 3; u.pm = 4 * x + (j >> 2); u.pn = j & 3; u.z = 0; return true; }
};
template <class Epi, class Sched, bool ALIGN_EPI>
__device__ __forceinline__ void gemm_phase(LAS unsigned char* lds, const Gemm g, const Sched& S, const Epi& E, const int wid) {
    const int lane = lane_id_opaque(), tid = wid * 64 + lane, wr = wid >> 2, wc = wid & 3, fr = lane & 15, fq = lane >> 4;
    const int K = g.K, nt = K / BK;
    unsigned voffA[2], voffB[2];
#pragma unroll
    for (int i = 0; i < 2; ++i) { int R, C; stage_rc(tid * 16 + i * 8192, R, C); const int Rb = (R & ~31) + perm32(R & 31);
        voffA[i] = (unsigned)(R * g.lda + C) * 2u; voffB[i] = (unsigned)(Rb * g.ldb + C) * 2u; }
    const size_t kstep = (size_t)(BK * 2);
    const size_t hstepA = (size_t)HALF * g.lda * 2, hstepB = (size_t)HALF * g.ldb * 2;
    const size_t tstepA = 2 * hstepA, tstepB = 2 * hstepB;
    const unsigned ldsw = (unsigned)wid * 1024u;
    const int aoff = lds_byte(wr * 64 + fr, fq * 8), boff = lds_byte(wc * 32 + fr, fq * 8);
#define PG8_SA(b, h) (((b) * 2 + (h)) * HTB)
#define PG8_SB(b, h) ((4 + (b) * 2 + (h)) * HTB)
#define PG8_STAGE(bufoff, gbase, voff) do { _Pragma("unroll") for (int _i = 0; _i < 2; ++_i) \
        __builtin_amdgcn_global_load_lds((const unsigned*)((const char*)(gbase) + (voff)[_i]), (LAS unsigned*)(lds + (bufoff) + ldsw + _i * 8192), 16, 0, GLDS_AUX); } while (0)
#define PG8_LDA(dst, b, h) do { _Pragma("unroll") for (int m = 0; m < 4; ++m) _Pragma("unroll") for (int k = 0; k < 2; ++k) dst[m][k] = *(const LAS bf16x8*)(lds + PG8_SA(b, h) + aoff + m * 2048 + k * 1024); } while (0)
#define PG8_LDB(dst, b, h) do { _Pragma("unroll") for (int n = 0; n < 2; ++n) _Pragma("unroll") for (int k = 0; k < 2; ++k) dst[n][k] = *(const LAS bf16x8*)(lds + PG8_SB(b, h) + boff + n * 2048 + k * 1024); } while (0)
#define PG8_MMA(ai, bj, At, Bt) do { __builtin_amdgcn_s_setprio(1); _Pragma("unroll") for (int m = 0; m < 4; ++m) _Pragma("unroll") for (int n = 0; n < 2; ++n) _Pragma("unroll") for (int k = 0; k < 2; ++k) \
        acc[ai][bj][m][n] = __builtin_amdgcn_mfma_f32_16x16x32_bf16(Bt[n][k], At[m][k], acc[ai][bj][m][n], 0, 0, 0); __builtin_amdgcn_s_setprio(0); } while (0)
#define PG8_WAIT_V(n) asm volatile("s_waitcnt vmcnt(" #n ")" ::: "memory")
#define PG8_WAIT_L(n) asm volatile("s_waitcnt lgkmcnt(" #n ")" ::: "memory")
#define PG8_BAR __builtin_amdgcn_s_barrier()
#define PG8_SCHED __builtin_amdgcn_sched_barrier(0)
    Unit cur, nxt; int ui = 0;
    if (!S.next(0, cur)) return;
    f32x4 acc[2][2][4][2];
#pragma unroll
    for (int a = 0; a < 2; ++a)
#pragma unroll
        for (int b = 0; b < 2; ++b)
#pragma unroll
            for (int m = 0; m < 4; ++m)
#pragma unroll
                for (int n = 0; n < 2; ++n) acc[a][b][m][n] = (f32x4){0.f, 0.f, 0.f, 0.f};
    bf16x8 At[4][2], B0[2][2], B1[2][2];
    const char* cA = (const char*)g.A + (size_t)cur.z * g.zA + (size_t)cur.pm * tstepA; const char* cB = (const char*)g.Bt + (size_t)cur.z * g.zB + (size_t)cur.pn * tstepB;
    PG8_STAGE(PG8_SB(0, 0), cB, voffB); PG8_STAGE(PG8_SB(0, 1), cB + hstepB, voffB); PG8_STAGE(PG8_SA(0, 0), cA, voffA); PG8_STAGE(PG8_SA(0, 1), cA + hstepA, voffA);
    if (wr == 1) PG8_BAR;
    PG8_WAIT_V(2); PG8_BAR;
    PG8_STAGE(PG8_SB(1, 0), cB + kstep, voffB); PG8_STAGE(PG8_SA(1, 0), cA + kstep, voffA); PG8_STAGE(PG8_SB(1, 1), cB + hstepB + kstep, voffB);
    PG8_WAIT_V(6); PG8_BAR;
    for (;;) {
        const bool has_next = S.next(ui + 1, nxt);
        const char* nA = has_next ? (const char*)g.A + (size_t)nxt.z * g.zA + (size_t)nxt.pm * tstepA : cA;
        const char* nB = has_next ? (const char*)g.Bt + (size_t)nxt.z * g.zB + (size_t)nxt.pn * tstepB : cB;
        for (int t = 0; t < nt; t += 2) {
            const bool last = (t == nt - 2);
            const char* a1 = cA + (size_t)(t + 1) * kstep;
            const char* a2 = last ? nA : cA + (size_t)(t + 2) * kstep; const char* b2 = last ? nB : cB + (size_t)(t + 2) * kstep;
            const char* a3 = a2 + kstep; const char* b3 = b2 + kstep;
            PG8_LDB(B0, 0, 0); PG8_LDB(B1, 0, 1); PG8_SCHED; PG8_LDA(At, 0, 0); PG8_STAGE(PG8_SA(1, 1), a1 + hstepA, voffA);
            PG8_WAIT_V(8); PG8_WAIT_L(0); PG8_BAR; PG8_MMA(0, 0, At, B0); PG8_MMA(0, 1, At, B1); PG8_BAR; PG8_SCHED;
            PG8_LDA(At, 0, 1); PG8_STAGE(PG8_SB(0, 0), b2, voffB); PG8_STAGE(PG8_SB(0, 1), b2 + hstepB, voffB); PG8_STAGE(PG8_SA(0, 0), a2, voffA);
            PG8_WAIT_V(8); PG8_WAIT_L(0); PG8_BAR; PG8_MMA(1, 0, At, B0); PG8_MMA(1, 1, At, B1); PG8_BAR; PG8_SCHED;
            PG8_LDB(B0, 1, 0); PG8_LDB(B1, 1, 1); PG8_SCHED; PG8_LDA(At, 1, 0); PG8_STAGE(PG8_SA(0, 1), a2 + hstepA, voffA);
            PG8_WAIT_V(8); PG8_WAIT_L(0); PG8_BAR; PG8_MMA(0, 0, At, B0); PG8_MMA(0, 1, At, B1); PG8_BAR; PG8_SCHED;
            PG8_LDA(At, 1, 1); PG8_STAGE(PG8_SB(1, 0), b3, voffB); PG8_STAGE(PG8_SB(1, 1), b3 + hstepB, voffB); PG8_STAGE(PG8_SA(1, 0), a3, voffA);
            PG8_WAIT_V(8); PG8_WAIT_L(0); PG8_BAR; PG8_MMA(1, 0, At, B0); PG8_MMA(1, 1, At, B1); PG8_BAR; PG8_SCHED;
        }
        if constexpr (ALIGN_EPI) { if (wr == 0) PG8_BAR; }
        if constexpr (!Epi::AFTER_DRAIN) E(acc, cur, wr, wc, fr, fq);
        if (!has_next) break;
#pragma unroll
        for (int a = 0; a < 2; ++a)
#pragma unroll
            for (int b = 0; b < 2; ++b)
#pragma unroll
                for (int m = 0; m < 4; ++m)
#pragma unroll
                    for (int n = 0; n < 2; ++n) acc[a][b][m][n] = (f32x4){0.f, 0.f, 0.f, 0.f};
        cur = nxt; cA = nA; cB = nB; ++ui;
        if constexpr (ALIGN_EPI) { if (wr == 1) PG8_BAR; }
    }
    PG8_WAIT_V(0);
    if constexpr (!ALIGN_EPI) { if (wr == 0) PG8_BAR; }
    PG8_BAR;
    if constexpr (Epi::AFTER_DRAIN) E.fused(acc, cur, wr, wc, lds, wid);
#undef PG8_SA
#undef PG8_SB
#undef PG8_STAGE
#undef PG8_LDA
#undef PG8_LDB
#undef PG8_MMA
#undef PG8_WAIT_V
#undef PG8_WAIT_L
#undef PG8_BAR
#undef PG8_SCHED
}

template <class EpiA, class EpiB>
__device__ __forceinline__ void gemm_phase2(LAS unsigned char* lds, const Gemm g0, const Unit u0, const EpiA& E0, const Gemm g1, const Unit u1, const EpiB& E1, const int wid) {
    const int lane = lane_id_opaque(), tid = wid * 64 + lane, wr = wid >> 2, wc = wid & 3, fr = lane & 15, fq = lane >> 4;
    unsigned vA0[2], vB0[2], vA1[2], vB1[2];
#pragma unroll
    for (int i = 0; i < 2; ++i) { int R, C; stage_rc(tid * 16 + i * 8192, R, C); const int Rb = (R & ~31) + perm32(R & 31);
        vA0[i] = (unsigned)(R * g0.lda + C) * 2u; vB0[i] = (unsigned)(Rb * g0.ldb + C) * 2u; vA1[i] = (unsigned)(R * g1.lda + C) * 2u; vB1[i] = (unsigned)(Rb * g1.ldb + C) * 2u; }
    const size_t kstep = (size_t)(BK * 2);
    const size_t hA0 = (size_t)HALF * g0.lda * 2, hB0 = (size_t)HALF * g0.ldb * 2, hA1 = (size_t)HALF * g1.lda * 2, hB1 = (size_t)HALF * g1.ldb * 2;
    const unsigned ldsw = (unsigned)wid * 1024u;
    const int aoff = lds_byte(wr * 64 + fr, fq * 8), boff = lds_byte(wc * 32 + fr, fq * 8);
#define PG8_SA(b, h) (((b) * 2 + (h)) * HTB)
#define PG8_SB(b, h) ((4 + (b) * 2 + (h)) * HTB)
#define PG8_STAGE(bufoff, gbase, voff) do { _Pragma("unroll") for (int _i = 0; _i < 2; ++_i) \
        __builtin_amdgcn_global_load_lds((const unsigned*)((const char*)(gbase) + (voff)[_i]), (LAS unsigned*)(lds + (bufoff) + ldsw + _i * 8192), 16, 0, 0); } while (0)
#define PG8_LDA(dst, b, h) do { _Pragma("unroll") for (int m = 0; m < 4; ++m) _Pragma("unroll") for (int k = 0; k < 2; ++k) dst[m][k] = *(const LAS bf16x8*)(lds + PG8_SA(b, h) + aoff + m * 2048 + k * 1024); } while (0)
#define PG8_LDB(dst, b, h) do { _Pragma("unroll") for (int n = 0; n < 2; ++n) _Pragma("unroll") for (int k = 0; k < 2; ++k) dst[n][k] = *(const LAS bf16x8*)(lds + PG8_SB(b, h) + boff + n * 2048 + k * 1024); } while (0)
#define PG8_MMA(ai, bj, At, Bt) do { __builtin_amdgcn_s_setprio(1); _Pragma("unroll") for (int m = 0; m < 4; ++m) _Pragma("unroll") for (int n = 0; n < 2; ++n) _Pragma("unroll") for (int k = 0; k < 2; ++k) \
        acc[ai][bj][m][n] = __builtin_amdgcn_mfma_f32_16x16x32_bf16(Bt[n][k], At[m][k], acc[ai][bj][m][n], 0, 0, 0); __builtin_amdgcn_s_setprio(0); } while (0)
#define PG8_WAIT_V(n) asm volatile("s_waitcnt vmcnt(" #n ")" ::: "memory")
#define PG8_WAIT_L(n) asm volatile("s_waitcnt lgkmcnt(" #n ")" ::: "memory")
#define PG8_BAR __builtin_amdgcn_s_barrier()
#define PG8_SCHED __builtin_amdgcn_sched_barrier(0)
    f32x4 acc[2][2][4][2];
#pragma unroll
    for (int a = 0; a < 2; ++a)
#pragma unroll
        for (int b = 0; b < 2; ++b)
#pragma unroll
            for (int m = 0; m < 4; ++m)
#pragma unroll
                for (int n = 0; n < 2; ++n) acc[a][b][m][n] = (f32x4){0.f, 0.f, 0.f, 0.f};
    bf16x8 At[4][2], B0[2][2], B1[2][2];
    const char* A0 = (const char*)g0.A + (size_t)u0.pm * 2 * hA0; const char* Bp0 = (const char*)g0.Bt + (size_t)u0.pn * 2 * hB0;
    const char* A1 = (const char*)g1.A + (size_t)u1.pm * 2 * hA1; const char* Bp1 = (const char*)g1.Bt + (size_t)u1.pn * 2 * hB1;
    PG8_STAGE(PG8_SB(0, 0), Bp0, vB0); PG8_STAGE(PG8_SB(0, 1), Bp0 + hB0, vB0); PG8_STAGE(PG8_SA(0, 0), A0, vA0); PG8_STAGE(PG8_SA(0, 1), A0 + hA0, vA0);
    if (wr == 1) PG8_BAR;
    PG8_WAIT_V(2); PG8_BAR;
    PG8_STAGE(PG8_SB(1, 0), Bp0 + kstep, vB0); PG8_STAGE(PG8_SA(1, 0), A0 + kstep, vA0); PG8_STAGE(PG8_SB(1, 1), Bp0 + hB0 + kstep, vB0);
    PG8_WAIT_V(6); PG8_BAR;
#pragma unroll
    for (int ui = 0; ui < 2; ++ui) {
        const char* cA = ui == 0 ? A0 : A1; const char* cB = ui == 0 ? Bp0 : Bp1;
        const size_t hAc = ui == 0 ? hA0 : hA1, hBc = ui == 0 ? hB0 : hB1;
        const int nt = (ui == 0 ? g0.K : g1.K) / BK;
        unsigned vAc[2], vBc[2];
#pragma unroll
        for (int i = 0; i < 2; ++i) { vAc[i] = ui == 0 ? vA0[i] : vA1[i]; vBc[i] = ui == 0 ? vB0[i] : vB1[i]; }
        for (int t = 0; t < nt; t += 2) {
            const bool last = (t == nt - 2);
            const char* a1 = cA + (size_t)(t + 1) * kstep;
            const char* a2 = last ? A1 : cA + (size_t)(t + 2) * kstep; const char* b2 = last ? Bp1 : cB + (size_t)(t + 2) * kstep;
            const char* a3 = a2 + kstep; const char* b3 = b2 + kstep;
            const size_t hA2 = last ? hA1 : hAc, hB2 = last ? hB1 : hBc;
            unsigned vA2[2], vB2[2];
#pragma unroll
            for (int i = 0; i < 2; ++i) { vA2[i] = last ? vA1[i] : vAc[i]; vB2[i] = last ? vB1[i] : vBc[i]; }
            PG8_LDB(B0, 0, 0); PG8_LDB(B1, 0, 1); PG8_SCHED; PG8_LDA(At, 0, 0); PG8_STAGE(PG8_SA(1, 1), a1 + hAc, vAc);
            PG8_WAIT_V(8); PG8_WAIT_L(0); PG8_BAR; PG8_MMA(0, 0, At, B0); PG8_MMA(0, 1, At, B1); PG8_BAR; PG8_SCHED;
            PG8_LDA(At, 0, 1); PG8_STAGE(PG8_SB(0, 0), b2, vB2); PG8_STAGE(PG8_SB(0, 1), b2 + hB2, vB2); PG8_STAGE(PG8_SA(0, 0), a2, vA2);
            PG8_WAIT_V(8); PG8_WAIT_L(0); PG8_BAR; PG8_MMA(1, 0, At, B0); PG8_MMA(1, 1, At, B1); PG8_BAR; PG8_SCHED;
            PG8_LDB(B0, 1, 0); PG8_LDB(B1, 1, 1); PG8_SCHED; PG8_LDA(At, 1, 0); PG8_STAGE(PG8_SA(0, 1), a2 + hA2, vA2);
            PG8_WAIT_V(8); PG8_WAIT_L(0); PG8_BAR; PG8_MMA(0, 0, At, B0); PG8_MMA(0, 1, At, B1); PG8_BAR; PG8_SCHED;
            PG8_LDA(At, 1, 1); PG8_STAGE(PG8_SB(1, 0), b3, vB2); PG8_STAGE(PG8_SB(1, 1), b3 + hB2, vB2); PG8_STAGE(PG8_SA(1, 0), a3, vA2);
            PG8_WAIT_V(8); PG8_WAIT_L(0); PG8_BAR; PG8_MMA(1, 0, At, B0); PG8_MMA(1, 1, At, B1); PG8_BAR; PG8_SCHED;
        }
        if (wr == 0) PG8_BAR;
        if (ui == 0) {
            E0(acc, u0, wr, wc, fr, fq);
#pragma unroll
            for (int a = 0; a < 2; ++a)
#pragma unroll
                for (int b = 0; b < 2; ++b)
#pragma unroll
                    for (int m = 0; m < 4; ++m)
#pragma unroll
                        for (int n = 0; n < 2; ++n) acc[a][b][m][n] = (f32x4){0.f, 0.f, 0.f, 0.f};
            if (wr == 1) PG8_BAR;
        } else E1(acc, u1, wr, wc, fr, fq);
    }
    PG8_WAIT_V(0);
    PG8_BAR;
#undef PG8_SA
#undef PG8_SB
#undef PG8_STAGE
#undef PG8_LDA
#undef PG8_LDB
#undef PG8_MMA
#undef PG8_WAIT_V
#undef PG8_WAIT_L
#undef PG8_BAR
#undef PG8_SCHED
}

#define EPI_FOR_ROWS _Pragma("unroll") for (int ai = 0; ai < 2; ++ai) _Pragma("unroll") for (int m = 0; m < 4; ++m)
#define EPI_ROWDEF const int rit = ai * HALF + wr * 64 + m * 16 + fr; const int row = u.pm * BM + rit; (void)rit; (void)row;

struct Epi1 {
    static constexpr bool AFTER_DRAIN = false;
    const float* rinv; const float* qnw; const float* knw; const float2* rope;
    bf16_t *Q, *Kb, *Vb, *GA, *GS, *UCAT; LAS float* xch; int pn0;
    __device__ __forceinline__ void operator()(const f32x4 (&acc)[2][2][4][2], const Unit& u, int wr, int wc, int, int) const {
        const int l_ = lane_id_opaque(), fr = l_ & 15, fq = l_ >> 4;
        const int pn = u.pn + pn0;
        if (pn <= 4) {
            float ss[2][4], rv[2][4];
            EPI_FOR_ROWS { EPI_ROWDEF const float r = rinv[row]; rv[ai][m] = r; float s = 0.f;
#pragma unroll
                for (int bj = 0; bj < 2; ++bj)
#pragma unroll
                    for (int n = 0; n < 2; ++n) { const f32x4 v = acc[ai][bj][m][n] * r; s += (v[0] * v[0] + v[1] * v[1]) + (v[2] * v[2] + v[3] * v[3]); }
                s += swz_xor<16>(s); s = sum_xor32(s); ss[ai][m] = s;
                if (fq == 0) xch[wc * 256 + rit] = s; }
            LDS_WAIT(); __builtin_amdgcn_s_barrier(); asm volatile("" ::: "memory");
            const int half = wc & 1, hd = wc >> 1;
            const float* nw = (pn < 4 ? qnw : knw) + 64 * half + 8 * fq;
            float w1[8], w2[8];
#pragma unroll
            for (int i = 0; i < 8; ++i) { w1[i] = nw[i]; w2[i] = nw[32 + i]; }
            EPI_FOR_ROWS { EPI_ROWDEF const float tot = ss[ai][m] + xch[(wc ^ 1) * 256 + rit];
                const float sc = rv[ai][m] * rsqrtf(tot * (1.f / 128.f) + EPS);
                const int t = row & (SEQ - 1); const int pos = half ? (t & 63) : (t >> 6);
                const float2* rp = rope + pos * 32 + 8 * fq;
                float o1[8], o2[8];
#pragma unroll
                for (int n = 0; n < 2; ++n)
#pragma unroll
                    for (int e = 0; e < 4; ++e) { const int i = 4 * n + e; const float2 cs = rp[i];
                        const float x1 = acc[ai][0][m][n][e] * sc * w1[i], x2 = acc[ai][1][m][n][e] * sc * w2[i];
                        o1[i] = x1 * cs.x - x2 * cs.y; o2[i] = x2 * cs.x + x1 * cs.y; }
                bf16_t* dst = (pn < 4) ? Q + (size_t)row * DATT + (2 * pn + hd) * 128 + 64 * half + 8 * fq : Kb + (size_t)row * DKV + hd * 128 + 64 * half + 8 * fq;
                u32x4 a; a.x = pk2(o1[0], o1[1]); a.y = pk2(o1[2], o1[3]); a.z = pk2(o1[4], o1[5]); a.w = pk2(o1[6], o1[7]);
                u32x4 b; b.x = pk2(o2[0], o2[1]); b.y = pk2(o2[2], o2[3]); b.z = pk2(o2[4], o2[5]); b.w = pk2(o2[6], o2[7]);
                *(u32x4*)dst = a; *(u32x4*)(dst + 32) = b; }
        } else {
            const int lg0 = 4 * (wc >> 1) + 2 * (wc & 1);
            EPI_FOR_ROWS { EPI_ROWDEF const float r = rinv[row];
#pragma unroll
                for (int bj = 0; bj < 2; ++bj) { const int L = 256 * pn + 32 * (lg0 + bj) + 8 * fq;
                    f32x4 v0 = acc[ai][bj][m][0] * r, v1 = acc[ai][bj][m][1] * r; bf16_t* dst;
                    if (pn == 5) dst = Vb + (size_t)row * DKV + (L - 1280);
                    else if (pn < 10) dst = GA + (size_t)row * DATT + (L - 1536);
                    else if (pn < 14) { const int Lu = L - 2560; dst = UCAT + ((size_t)(Lu >> 4) * NCH + (row >> 4)) * 512 + (row & 15) * 16 + (Lu & 15); }
                    else dst = GS + (size_t)row * DSSM + (L - 3584);
                    if ((pn >= 6 && pn < 10) || pn >= 14) {
#pragma unroll
                        for (int e = 0; e < 4; ++e) { v0[e] = siluf_(v0[e]); v1[e] = siluf_(v1[e]); } }
                    u32x4 w; w.x = pk2(v0[0], v0[1]); w.y = pk2(v0[2], v0[3]); w.z = pk2(v1[0], v1[1]); w.w = pk2(v1[2], v1[3]);
                    *(u32x4*)dst = w; } }
        }
    }
};
struct EpiS1 {
    static constexpr bool AFTER_DRAIN = true;
    const float* lb16; bf16_t* UCAT;
    __device__ __forceinline__ void operator()(const f32x4 (&)[2][2][4][2], const Unit&, int, int, int, int) const {}
    __device__ __forceinline__ void fused(const f32x4 (&acc)[2][2][4][2], const Unit& u, int wr, int wc, LAS unsigned char* lds, int wid) const {
        const int l_ = lane_id_opaque(), fr = l_ & 15, fq = l_ >> 4;
        LAS float* Tl = (LAS float*)lds;
#pragma unroll
        for (int d = 0; d < 2; ++d) {
            EPI_FOR_ROWS { const int rit = ai * HALF + wr * 64 + m * 16 + fr; LAS float* rp = Tl + rit * 128 + wc * 32 + 8 * fq;
                *(LAS f32x4*)rp = acc[ai][d][m][0]; *(LAS f32x4*)(rp + 4) = acc[ai][d][m][1]; }
            LDS_WAIT(); __builtin_amdgcn_s_barrier(); asm volatile("" ::: "memory");
            {
                const int p = l_; const float lr = lb16[((u.z * 2 + d) * 64 + p) * 2], li = lb16[((u.z * 2 + d) * 64 + p) * 2 + 1];
                LAS float* SEG = (LAS float*)(lds + XCH_OFF);
                float xr = 0.f, xi = 0.f;
#pragma unroll 8
                for (int i = 0; i < 32; ++i) { const int cc = wid * 32 + i, c = d ? 255 - cc : cc;
                    const float sr = Tl[c * 128 + p], si = Tl[c * 128 + 64 + p];
                    Tl[c * 128 + p] = xr; Tl[c * 128 + 64 + p] = xi;
                    const float nr = lr * xr - li * xi + sr; xi = lr * xi + li * xr + si; xr = nr; }
                SEG[(wid * 64 + p) * 2] = xr; SEG[(wid * 64 + p) * 2 + 1] = xi;
                LDS_WAIT(); __builtin_amdgcn_s_barrier(); asm volatile("" ::: "memory");
                float l32r = lr, l32i = li;
#pragma unroll
                for (int q = 0; q < 5; ++q) { const float t = l32r * l32r - l32i * l32i; l32i = 2.f * l32r * l32i; l32r = t; }
                float er = 0.f, ei = 0.f;
                for (int j = 0; j < wid; ++j) { const float tr = SEG[(j * 64 + p) * 2], ti = SEG[(j * 64 + p) * 2 + 1];
                    const float nr = l32r * er - l32i * ei + tr; ei = l32r * ei + l32i * er + ti; er = nr; }
#pragma unroll 8
                for (int i = 0; i < 32; ++i) { const int cc = wid * 32 + i, c = d ? 255 - cc : cc;
                    const float tr = Tl[c * 128 + p] + er, ti = Tl[c * 128 + 64 + p] + ei;
                    Tl[c * 128 + p] = __uint_as_float(pk2(tr, ti));
                    const float nr = lr * er - li * ei; ei = lr * ei + li * er; er = nr; }
            }
            LDS_WAIT(); __builtin_amdgcn_s_barrier(); asm volatile("" ::: "memory");
            {   bf16_t* ub = UCAT + ((size_t)u.z * NCH + u.pm * 256) * 512 + 256 + d * 128;
#pragma unroll
                for (int i = 0; i < 8; ++i) { const int q = wid * 64 + l_ + 512 * i, r = q >> 4, c8 = (q & 15) * 8;
                    *(u32x4*)(ub + (size_t)r * 512 + c8) = *(const LAS u32x4*)((LAS bf16_t*)(Tl + r * 128) + c8); } }
            LDS_WAIT(); __builtin_amdgcn_s_barrier(); asm volatile("" ::: "memory");
        }
    }
};
struct EpiS2 {
    static constexpr bool AFTER_DRAIN = false;
    bf16_t* YS;
    __device__ __forceinline__ void operator()(const f32x4 (&acc)[2][2][4][2], const Unit& u, int wr, int wc, int, int) const {
        const int l_ = lane_id_opaque(), fr = l_ & 15, fq = l_ >> 4;
        EPI_FOR_ROWS { EPI_ROWDEF
#pragma unroll
            for (int bj = 0; bj < 2; ++bj) { const int c = bj * HALF + wc * 32 + 8 * fq; const int j = c >> 4, h0 = c & 15;
                const f32x4 v0 = acc[ai][bj][m][0], v1 = acc[ai][bj][m][1];
                u32x4 w; w.x = pk2(gelu_tanh(v0[0]), gelu_tanh(v0[1])); w.y = pk2(gelu_tanh(v0[2]), gelu_tanh(v0[3])); w.z = pk2(gelu_tanh(v1[0]), gelu_tanh(v1[1])); w.w = pk2(gelu_tanh(v1[2]), gelu_tanh(v1[3]));
                *(u32x4*)(YS + ((size_t)row * 16 + j) * DSSM + u.z * 16 + h0) = w; } }
    }
};
struct EpiGlu {
    static constexpr bool AFTER_DRAIN = false;
    const float* bglu; const bf16_t* GS; bf16_t* YMIX;
    __device__ __forceinline__ void operator()(const f32x4 (&acc)[2][2][4][2], const Unit& u, int wr, int wc, int, int) const {
        const int l_ = lane_id_opaque(), fr = l_ & 15, fq = l_ >> 4;
        const int a0 = 128 * u.pn + 32 * wc + 8 * fq;
        float bv[8], bg[8];
#pragma unroll
        for (int i = 0; i < 8; ++i) { bv[i] = bglu[a0 + i]; bg[i] = bglu[1024 + a0 + i]; }
        u32x4 gsv[2][4];
        EPI_FOR_ROWS { EPI_ROWDEF gsv[ai][m] = __builtin_nontemporal_load((const u32x4*)(GS + (size_t)row * DSSM + a0)); }
        EPI_FOR_ROWS { EPI_ROWDEF const u32x4 gs = gsv[ai][m];
            float o[8];
#pragma unroll
            for (int n = 0; n < 2; ++n)
#pragma unroll
                for (int e = 0; e < 4; ++e) { const int i = 4 * n + e; o[i] = (acc[ai][0][m][n][e] + bv[i]) * sigmoidf_(acc[ai][1][m][n][e] + bg[i]); }
            o[0] *= bflo(gs.x); o[1] *= bfhi(gs.x); o[2] *= bflo(gs.y); o[3] *= bfhi(gs.y); o[4] *= bflo(gs.z); o[5] *= bfhi(gs.z); o[6] *= bflo(gs.w); o[7] *= bfhi(gs.w);
            u32x4 w; w.x = pk2(o[0], o[1]); w.y = pk2(o[2], o[3]); w.z = pk2(o[4], o[5]); w.w = pk2(o[6], o[7]);
            *(u32x4*)(YMIX + (size_t)row * DM + 1024 + a0) = w; }
    }
};
struct EpiBf {
    static constexpr bool AFTER_DRAIN = false;
    bf16_t* O; int ldc;
    __device__ __forceinline__ void operator()(const f32x4 (&acc)[2][2][4][2], const Unit& u, int wr, int wc, int, int) const {
        const int l_ = lane_id_opaque(), fr = l_ & 15, fq = l_ >> 4;
        EPI_FOR_ROWS { EPI_ROWDEF
#pragma unroll
            for (int bj = 0; bj < 2; ++bj) { const f32x4 v0 = acc[ai][bj][m][0], v1 = acc[ai][bj][m][1];
                u32x4 w; w.x = pk2(v0[0], v0[1]); w.y = pk2(v0[2], v0[3]); w.z = pk2(v1[0], v1[1]); w.w = pk2(v1[2], v1[3]);
                *(u32x4*)(O + (size_t)row * ldc + u.pn * BM + bj * HALF + wc * 32 + 8 * fq) = w; } }
    }
};
struct EpiOut {
    static constexpr bool AFTER_DRAIN = false;
    const float* x; float* H; bf16_t* HB; float* ssq;
    __device__ __forceinline__ void operator()(const f32x4 (&acc)[2][2][4][2], const Unit& u, int wr, int wc, int, int) const {
        const int l_ = lane_id_opaque(), fr = l_ & 15, fq = l_ >> 4;
#pragma unroll
        for (int ai = 0; ai < 2; ++ai) {
            f32x4 xv[4][2][2];
#pragma unroll
            for (int m = 0; m < 4; ++m) { EPI_ROWDEF
#pragma unroll
                for (int bj = 0; bj < 2; ++bj) { const size_t off = (size_t)row * DM + u.pn * BM + bj * HALF + wc * 32 + 8 * fq; xv[m][bj][0] = __builtin_nontemporal_load((const f32x4*)(x + off)); xv[m][bj][1] = __builtin_nontemporal_load((const f32x4*)(x + off + 4)); } }
#pragma unroll
            for (int m = 0; m < 4; ++m) { EPI_ROWDEF float s = 0.f;
#pragma unroll
                for (int bj = 0; bj < 2; ++bj) { const size_t off = (size_t)row * DM + u.pn * BM + bj * HALF + wc * 32 + 8 * fq;
                    const f32x4 v0 = acc[ai][bj][m][0] + xv[m][bj][0], v1 = acc[ai][bj][m][1] + xv[m][bj][1];
                    s += (v0[0] * v0[0] + v0[1] * v0[1]) + (v0[2] * v0[2] + v0[3] * v0[3]) + (v1[0] * v1[0] + v1[1] * v1[1]) + (v1[2] * v1[2] + v1[3] * v1[3]);
                    u32x4 w; w.x = pk2(v0[0], v0[1]); w.y = pk2(v0[2], v0[3]); w.z = pk2(v1[0], v1[1]); w.w = pk2(v1[2], v1[3]);
                    *(u32x4*)(HB + off) = w; }
                s += swz_xor<16>(s); s = sum_xor32(s);
                if (fq == 0) ssq[(size_t)row * 32 + u.pn * 4 + wc] = s; }
        }
    }
};
struct EpiGate {
    static constexpr bool AFTER_DRAIN = true;
    float* H; const bf16_t* PP; float* ssq; unsigned* cnt; const float* nf; const LAS float* r2; const bf16_t* HBr;
    __device__ __forceinline__ void operator()(const f32x4 (&)[2][2][4][2], const Unit&, int, int, int, int) const {}
    __device__ __forceinline__ void fused(f32x4 (&acc)[2][2][4][2], const Unit& u, int wr, int wc, LAS unsigned char* lds, int wid) const {
        const int l_ = lane_id_opaque(), fr = l_ & 15, fq = l_ >> 4, tid = wid * 64 + l_;
        LAS float* P = (LAS float*)lds; LAS float* Rn = P + 1024;
        EPI_FOR_ROWS { EPI_ROWDEF float s = 0.f; const float r = r2[rit];
#pragma unroll
            for (int bj = 0; bj < 2; ++bj) { const size_t off = (size_t)row * DM + u.pn * BM + bj * HALF + wc * 32 + 8 * fq;
                const u32x4 pp = __builtin_nontemporal_load((const u32x4*)(PP + off));
                const u32x4 hb = __builtin_nontemporal_load((const u32x4*)(HBr + off));
                f32x4 h0 = {bflo(hb.x), bfhi(hb.x), bflo(hb.y), bfhi(hb.y)}, h1 = {bflo(hb.z), bfhi(hb.z), bflo(hb.w), bfhi(hb.w)};
                const f32x4 a0 = acc[ai][bj][m][0] * r, a1 = acc[ai][bj][m][1] * r;
                h0[0] += sigmoidf_(a0[0]) * bflo(pp.x); h0[1] += sigmoidf_(a0[1]) * bfhi(pp.x); h0[2] += sigmoidf_(a0[2]) * bflo(pp.y); h0[3] += sigmoidf_(a0[3]) * bfhi(pp.y);
                h1[0] += sigmoidf_(a1[0]) * bflo(pp.z); h1[1] += sigmoidf_(a1[1]) * bfhi(pp.z); h1[2] += sigmoidf_(a1[2]) * bflo(pp.w); h1[3] += sigmoidf_(a1[3]) * bfhi(pp.w);
                acc[ai][bj][m][0] = h0; acc[ai][bj][m][1] = h1;
                s += (h0[0] * h0[0] + h0[1] * h0[1]) + (h0[2] * h0[2] + h0[3] * h0[3]) + (h1[0] * h1[0] + h1[1] * h1[1]) + (h1[2] * h1[2] + h1[3] * h1[3]); }
            s += swz_xor<16>(s); s = sum_xor32(s);
            if (fq == 0) P[rit * 4 + wc] = s; }
        LDS_WAIT(); __builtin_amdgcn_s_barrier(); asm volatile("" ::: "memory");
        if (tid < 256) { const float t = (P[tid * 4] + P[tid * 4 + 1]) + (P[tid * 4 + 2] + P[tid * 4 + 3]);
            __hip_atomic_store(ssq + (size_t)(u.pm * 256 + tid) * 8 + u.pn, t, __ATOMIC_RELAXED, __HIP_MEMORY_SCOPE_AGENT); }
        asm volatile("s_waitcnt vmcnt(0)" ::: "memory");
        if (wid < 4 && l_ == 0) __hip_atomic_fetch_add(cnt + 64 * u.pm, 1u, __ATOMIC_RELAXED, __HIP_MEMORY_SCOPE_AGENT);
        if (wid == 0) {
            unsigned sp = 0;
            while ((unsigned)__builtin_amdgcn_readfirstlane(__hip_atomic_load(cnt + 64 * u.pm, __ATOMIC_RELAXED, __HIP_MEMORY_SCOPE_AGENT)) < 32u) { __builtin_amdgcn_s_sleep(2); if (++sp > (1u << 22)) break; }
            __builtin_amdgcn_fence(__ATOMIC_ACQUIRE, "agent");
        }
        asm volatile("s_waitcnt vmcnt(0) lgkmcnt(0)" ::: "memory"); __builtin_amdgcn_s_barrier(); asm volatile("" ::: "memory");
        if (tid < 256) { const float* sp = ssq + (size_t)(u.pm * 256 + tid) * 8; float t = 0.f;
#pragma unroll
            for (int i = 0; i < 8; ++i) t += __hip_atomic_load(sp + i, __ATOMIC_RELAXED, __HIP_MEMORY_SCOPE_AGENT);
            Rn[tid] = rsqrtf(t * (1.f / DM) + EPS); }
        LDS_WAIT(); __builtin_amdgcn_s_barrier(); asm volatile("" ::: "memory");
        EPI_FOR_ROWS { EPI_ROWDEF const float rn = Rn[rit];
#pragma unroll
            for (int bj = 0; bj < 2; ++bj) { const int col = u.pn * BM + bj * HALF + wc * 32 + 8 * fq; const size_t off = (size_t)row * DM + col;
                *(f32x4*)(H + off) = acc[ai][bj][m][0] * rn * *(const f32x4*)(nf + col); *(f32x4*)(H + off + 4) = acc[ai][bj][m][1] * rn * *(const f32x4*)(nf + col + 4); } }
    }
};
}

namespace att {
constexpr int D = 128, NW = 8, QBLK = 32, KVBLK = 64;
constexpr float SCALE = 0.088388347648318440f;
constexpr float THR = 8.f;
constexpr int LDQ = DATT, LDK = DKV;
constexpr size_t SHM_V = KVBLK * D * 2, SHM_K = KVBLK * D * 2, SHM_ATTN = 2 * SHM_V + 2 * SHM_K + NW * 64 * 4;
#define KSWZ(row, colB) ((row) * 256 + ((colB) ^ (((row) & 7) << 4)))
#define SBAR() __builtin_amdgcn_sched_barrier(0)
__device__ __forceinline__ int crow(int r, int hi) { return (r & 3) + 8 * (r >> 2) + 4 * hi; }
__device__ __forceinline__ void partialSM(f32x16& p0, f32x16& p1, float& m_reg, float& mn, float& alpha) {
  constexpr float C = SCALE * 1.4426950408889634f;
  float pmax = p0[0]; for (int r = 1; r < 16; ++r) pmax = fmaxf(pmax, p0[r]); for (int r = 0; r < 16; ++r) pmax = fmaxf(pmax, p1[r]);
  { auto rr = __builtin_amdgcn_permlane32_swap(__float_as_uint(pmax), __float_as_uint(pmax), false, false);
    pmax = fmaxf(__uint_as_float(rr[0]), __uint_as_float(rr[1])); }
  if (__builtin_expect(__all(pmax - m_reg <= THR / SCALE), 1)) { mn = m_reg; alpha = 1.f; }
  else { mn = fmaxf(m_reg, pmax); alpha = __builtin_amdgcn_exp2f((m_reg - mn) * C); m_reg = mn; }
  float mnC = -mn * C;
  for (int r = 0; r < 16; ++r) p0[r] = fmaf(p0[r], C, mnC); for (int r = 0; r < 16; ++r) p1[r] = fmaf(p1[r], C, mnC);
  for (int r = 0; r < 16; ++r) p0[r] = __builtin_amdgcn_exp2f(p0[r]);
}
__device__ __forceinline__ void finishSM(f32x16& p0, f32x16& p1, float alpha, float& l_reg, bf16x8& pa0, bf16x8& pa1, bf16x8& pa2, bf16x8& pa3) {
  for (int r = 0; r < 16; ++r) p1[r] = __builtin_amdgcn_exp2f(p1[r]);
  float ps = 0; for (int r = 0; r < 16; ++r) ps += p0[r]; for (int r = 0; r < 16; ++r) ps += p1[r];
  { auto rr = __builtin_amdgcn_permlane32_swap(__float_as_uint(ps), __float_as_uint(ps), false, false);
    ps = __uint_as_float(rr[0]) + __uint_as_float(rr[1]); }
  l_reg = l_reg * alpha + ps;
#define PK4(P, BASE, OUT) do { unsigned a0 = cvt_pk_bf16(P[BASE + 0], P[BASE + 1]), a1 = cvt_pk_bf16(P[BASE + 2], P[BASE + 3]);   \
    unsigned b0 = cvt_pk_bf16(P[BASE + 4], P[BASE + 5]), b1 = cvt_pk_bf16(P[BASE + 6], P[BASE + 7]);                              \
    auto r0 = __builtin_amdgcn_permlane32_swap(a0, b0, false, false); auto r1 = __builtin_amdgcn_permlane32_swap(a1, b1, false, false); \
    u32x4 w = {r0[0], r1[0], r0[1], r1[1]}; OUT = *reinterpret_cast<bf16x8*>(&w); } while (0)
  PK4(p0, 0, pa0); PK4(p0, 8, pa1); PK4(p1, 0, pa2); PK4(p1, 8, pa3);
#undef PK4
}
__device__ __forceinline__ void qkt(f32x16& p0, f32x16& p1, const bf16_t* Ks, const bf16x8* qr, int r32, int hi) {
  p0 = f32x16{}; p1 = f32x16{};
  for (int d0 = 0; d0 < 8; ++d0) { int cb = (d0 * 16 + hi * 8) * 2;
    bf16x8 b0 = *reinterpret_cast<const bf16x8*>((const char*)Ks + KSWZ(r32, cb));
    bf16x8 b1 = *reinterpret_cast<const bf16x8*>((const char*)Ks + KSWZ(32 + r32, cb));
    p0 = __builtin_amdgcn_mfma_f32_32x32x16_bf16(b0, qr[d0], p0, 0, 0, 0);
    p1 = __builtin_amdgcn_mfma_f32_32x32x16_bf16(b1, qr[d0], p1, 0, 0, 0); }
}
__device__ __forceinline__ int v_st(int k, int c) { const int kk = (k & ~0xC) | ((k & 4) << 1) | ((k & 8) >> 1); return ((kk >> 3) * 4 + (c >> 5)) * 512 + ((kk & 7) * 32 + (c & 31)) * 2; }
__device__ __forceinline__ int v_rd_base(int lane) { return ((lane & 3) << 3) | (((lane >> 2) & 3) << 6) | (((lane >> 4) & 1) << 5) | (((lane >> 5) & 1) << 8); }
constexpr int v_rd_off(int d0, int ks, int half) { return d0 * 512 + ks * 4096 + half * 2048; }
template <int OFF> __device__ __forceinline__ s16x4 tr_read(int vb) {
  s16x4 r; asm volatile("ds_read_b64_tr_b16 %0, %1 offset:%2" : "=&v"(r) : "v"(vb), "i"(OFF) : "memory"); return r;
}
template <int D0> __device__ __forceinline__ void pv_one(f32x16& od, int vb, bf16x8 pa0, bf16x8 pa1, bf16x8 pa2, bf16x8 pa3) {
  const s16x4 l0 = tr_read<v_rd_off(D0, 0, 0)>(vb), h0 = tr_read<v_rd_off(D0, 0, 1)>(vb), l1 = tr_read<v_rd_off(D0, 1, 0)>(vb), h1 = tr_read<v_rd_off(D0, 1, 1)>(vb);
  const s16x4 l2 = tr_read<v_rd_off(D0, 2, 0)>(vb), h2 = tr_read<v_rd_off(D0, 2, 1)>(vb), l3 = tr_read<v_rd_off(D0, 3, 0)>(vb), h3 = tr_read<v_rd_off(D0, 3, 1)>(vb);
  asm volatile("s_waitcnt lgkmcnt(0)" ::: "memory"); SBAR();
#define PK(L, H) (bf16x8){L[0], L[1], L[2], L[3], H[0], H[1], H[2], H[3]}
  od = __builtin_amdgcn_mfma_f32_32x32x16_bf16(pa0, PK(l0, h0), od, 0, 0, 0);
  od = __builtin_amdgcn_mfma_f32_32x32x16_bf16(pa1, PK(l1, h1), od, 0, 0, 0);
  od = __builtin_amdgcn_mfma_f32_32x32x16_bf16(pa2, PK(l2, h2), od, 0, 0, 0);
  od = __builtin_amdgcn_mfma_f32_32x32x16_bf16(pa3, PK(l3, h3), od, 0, 0, 0);
#undef PK
}
__device__ __forceinline__ void pv_d0(f32x16* o, int vb, bf16x8 pa0, bf16x8 pa1, bf16x8 pa2, bf16x8 pa3) {
  pv_one<0>(o[0], vb, pa0, pa1, pa2, pa3); pv_one<1>(o[1], vb, pa0, pa1, pa2, pa3); pv_one<2>(o[2], vb, pa0, pa1, pa2, pa3); pv_one<3>(o[3], vb, pa0, pa1, pa2, pa3);
}
__device__ __forceinline__ void attn_dense_body(const bf16_t* __restrict__ Qb, const bf16_t* __restrict__ Kh, const bf16_t* __restrict__ Vh,
                                                const bf16_t* __restrict__ Gb, bf16_t* __restrict__ Yb, int seq, char* lds, const int wid) {
  const int lane = lane_id_opaque(), tid = wid * 64 + lane, r32 = lane & 31, hi = lane >> 5;
  bf16_t* V_lds = (bf16_t*)lds; bf16_t* K_lds = (bf16_t*)(lds + 2 * SHM_V);
  float* ws = (float*)(lds + 2 * SHM_V + 2 * SHM_K) + wid * 64; float* li_l = ws; float* al_l = ws + 32;
  float m_reg = -1e30f, l_reg = 0; f32x16 o[4] = {}; bf16x8 qr[8];
  const bf16_t* Qw = Qb + (long)(wid * QBLK + r32) * LDQ + hi * 8;
#pragma unroll
  for (int d0 = 0; d0 < 8; ++d0) qr[d0] = __builtin_nontemporal_load(reinterpret_cast<const bf16x8*>(Qw + d0 * 16));
  const int sr = tid >> 4, sc = (tid & 15) * 8, vst0 = v_st(sr, sc), vst1 = v_st(32 + sr, sc);
  const int vb0 = (int)(uintptr_t)V_lds + v_rd_base(lane);
  struct { bf16x8 vs0, vs1, ks0, ks1; } sr_[2];
#define SLOAD(i, k0) do { sr_[i].vs0 = *reinterpret_cast<const bf16x8*>(&Vh[(long)((k0) + sr) * LDK + sc]); sr_[i].vs1 = *reinterpret_cast<const bf16x8*>(&Vh[(long)((k0) + 32 + sr) * LDK + sc]); \
    sr_[i].ks0 = *reinterpret_cast<const bf16x8*>(&Kh[(long)((k0) + sr) * LDK + sc]); sr_[i].ks1 = *reinterpret_cast<const bf16x8*>(&Kh[(long)((k0) + 32 + sr) * LDK + sc]); } while (0)
#define SWRITE(b, i) do { *(bf16x8*)((char*)V_lds + (b) * SHM_V + vst0) = sr_[i].vs0;          \
    *(bf16x8*)((char*)V_lds + (b) * SHM_V + vst1) = sr_[i].vs1; int kc = sc * 2;               \
    *(bf16x8*)((char*)K_lds + (b) * SHM_K + KSWZ(sr, kc)) = sr_[i].ks0;                       \
    *(bf16x8*)((char*)K_lds + (b) * SHM_K + KSWZ(32 + sr, kc)) = sr_[i].ks1; } while (0)
#define SWAIT() asm volatile("s_waitcnt vmcnt(4)" ::: "memory")
#define RESC(a) do { if (__any((a) < 1.f)) { if (hi == 0) al_l[r32] = (a); asm volatile("s_waitcnt lgkmcnt(0)" ::: "memory"); \
    for (int d = 0; d < 4; ++d) for (int r = 0; r < 16; ++r) o[d][r] *= al_l[crow(r, hi)]; } } while (0)
  f32x16 pA0, pA1, pB0, pB1; float mnA, mnB, alA, alB; bf16x8 pa0, pa1, pa2, pa3; const int NT = seq / KVBLK;
  constexpr int SE = 0, SO = 1;
  SLOAD(SE, 0); asm volatile("s_waitcnt vmcnt(0)" ::: "memory"); SWRITE(0, SE); __syncthreads();
  qkt(pA0, pA1, K_lds, qr, r32, hi); partialSM(pA0, pA1, m_reg, mnA, alA);
  SLOAD(SO, KVBLK); if (2 < NT) SLOAD(SE, 2 * KVBLK);
  SWAIT(); SWRITE(1, SO); __syncthreads();
  for (int j = 1; j + 1 < NT; j += 2) {
    SBAR(); qkt(pB0, pB1, (bf16_t*)((char*)K_lds + SHM_K), qr, r32, hi);
    finishSM(pA0, pA1, alA, l_reg, pa0, pa1, pa2, pa3); SBAR();
    SLOAD(SO, (j + 2) * KVBLK); SBAR();
    pv_d0(o, vb0, pa0, pa1, pa2, pa3); partialSM(pB0, pB1, m_reg, mnB, alB);
    __syncthreads(); SWAIT(); SWRITE(0, SE);
    RESC(alB); __syncthreads();
    SBAR(); qkt(pA0, pA1, K_lds, qr, r32, hi);
    finishSM(pB0, pB1, alB, l_reg, pa0, pa1, pa2, pa3); SBAR();
    if (j + 3 < NT) SLOAD(SE, (j + 3) * KVBLK); SBAR();
    pv_d0(o, vb0 + (int)SHM_V, pa0, pa1, pa2, pa3); partialSM(pA0, pA1, m_reg, mnA, alA);
    __syncthreads(); SWAIT(); SWRITE(1, SO);
    RESC(alA); __syncthreads();
  }
  SBAR(); qkt(pB0, pB1, (bf16_t*)((char*)K_lds + SHM_K), qr, r32, hi);
  finishSM(pA0, pA1, alA, l_reg, pa0, pa1, pa2, pa3); SBAR();
  pv_d0(o, vb0, pa0, pa1, pa2, pa3); partialSM(pB0, pB1, m_reg, mnB, alB);
  __syncthreads(); RESC(alB);
  finishSM(pB0, pB1, alB, l_reg, pa0, pa1, pa2, pa3); SBAR();
  pv_d0(o, vb0 + (int)SHM_V, pa0, pa1, pa2, pa3);
  if (hi == 0) li_l[r32] = l_reg; asm volatile("s_waitcnt lgkmcnt(0)" ::: "memory");
  float rli[16];
#pragma unroll
  for (int r = 0; r < 16; ++r) rli[r] = __builtin_amdgcn_rcpf(li_l[crow(r, hi)]);
  bf16_t* Yw = Yb + (long)(wid * QBLK) * DM; const bf16_t* Gw = Gb + (long)(wid * QBLK) * DATT;
  __syncthreads();
  bf16_t* stg = (bf16_t*)(lds + wid * 8192);
#pragma unroll
  for (int r = 0; r < 16; ++r) { const int orow = crow(r, hi);
#pragma unroll
    for (int d0 = 0; d0 < 4; ++d0) stg[orow * 128 + d0 * 32 + r32] = (bf16_t)f2bf(o[d0][r] * rli[r]); }
  asm volatile("s_waitcnt lgkmcnt(0)" ::: "memory");
  const int l2 = lane_id_opaque();
#pragma unroll
  for (int i = 0; i < 8; ++i) { const int q = l2 + 64 * i, row = q >> 4, c8 = (q & 15) * 8;
    const u32x4 v = *(const u32x4*)(stg + row * 128 + c8); const u32x4 gg = __builtin_nontemporal_load((const u32x4*)(Gw + (unsigned)(row * DATT + c8)));
    u32x4 w; w.x = pk2(bflo(v.x) * bflo(gg.x), bfhi(v.x) * bfhi(gg.x)); w.y = pk2(bflo(v.y) * bflo(gg.y), bfhi(v.y) * bfhi(gg.y));
    w.z = pk2(bflo(v.z) * bflo(gg.z), bfhi(v.z) * bfhi(gg.z)); w.w = pk2(bflo(v.w) * bflo(gg.w), bfhi(v.w) * bfhi(gg.w));
    *(u32x4*)(Yw + (unsigned)(row * DM + c8)) = w; }
  __syncthreads();
#undef SLOAD
#undef SWRITE
#undef SWAIT
#undef RESC
}
#undef SBAR
}

__device__ __forceinline__ void p0_transpose_item(const float* W, int K, int N, bf16_t* WT, int wt_row0, const float* kscale, LAS float* scr, int k0, int n0, int lane) {
#pragma unroll
    for (int i = 0; i < 32; ++i) { const int kk = 2 * i + (lane >> 5); float v = W[(size_t)(k0 + kk) * N + n0 + (lane & 31)]; if (kscale) v *= kscale[k0 + kk]; scr[kk * 33 + (lane & 31)] = v; }
    LDS_WAIT(); asm volatile("" ::: "memory");
    const int c = lane & 7;
#pragma unroll
    for (int j = 0; j < 4; ++j) { const int n = (lane >> 3) + 8 * j; const LAS float* s = scr + (8 * c) * 33 + n;
        u32x4 o; o.x = pk2(s[0 * 33], s[1 * 33]); o.y = pk2(s[2 * 33], s[3 * 33]); o.z = pk2(s[4 * 33], s[5 * 33]); o.w = pk2(s[6 * 33], s[7 * 33]);
        *(u32x4*)(WT + (size_t)(wt_row0 + n) * K + k0 + 8 * c) = o; }
    LDS_WAIT(); asm volatile("" ::: "memory");
}

struct TrItem { const float* W; bf16_t* WT; const float* kscale; int K, N, wt_row0, k0, n0; };
__device__ __forceinline__ void p0_tr_load(const TrItem& d, float (&v)[32], int lane) {
#pragma unroll
    for (int i = 0; i < 32; ++i) { const int kk = 2 * i + (lane >> 5); v[i] = __builtin_nontemporal_load(d.W + (size_t)(d.k0 + kk) * d.N + d.n0 + (lane & 31)); }
    if (d.kscale) {
#pragma unroll
        for (int i = 0; i < 32; ++i) { const int kk = 2 * i + (lane >> 5); v[i] *= d.kscale[d.k0 + kk]; } }
}
__device__ __forceinline__ void p0_tr_store(const TrItem& d, const float (&v)[32], LAS float* scr, int lane) {
#pragma unroll
    for (int i = 0; i < 32; ++i) { const int kk = 2 * i + (lane >> 5); scr[kk * 33 + (lane & 31)] = v[i]; }
    LDS_WAIT(); asm volatile("" ::: "memory");
    const int c = lane & 7;
#pragma unroll
    for (int j = 0; j < 4; ++j) { const int n = (lane >> 3) + 8 * j; const LAS float* s = scr + (8 * c) * 33 + n;
        u32x4 o; o.x = pk2(s[0 * 33], s[1 * 33]); o.y = pk2(s[2 * 33], s[3 * 33]); o.z = pk2(s[4 * 33], s[5 * 33]); o.w = pk2(s[6 * 33], s[7 * 33]);
        *(u32x4*)(d.WT + (size_t)(d.wt_row0 + n) * d.K + d.k0 + 8 * c) = o; }
    LDS_WAIT(); asm volatile("" ::: "memory");
}
__device__ __forceinline__ void ssm_tables(const Args& a, int g, LAS unsigned char* lds, int tid) {
    LAS float* LD = (LAS float*)lds;
    LAS float* LBs = LD + 256;
    LAS float* BB = LBs + 256;
    LAS float* KT = BB + 4096;
    LAS float* CC = KT + 8192;
    float* lb16 = (float*)(a.ws + WS_LB16);
    bf16_t* WIN = (bf16_t*)(a.ws + WS_WIN) + (size_t)g * 256 * 256;
    bf16_t* WBIG = (bf16_t*)(a.ws + WS_WBIG) + (size_t)g * 256 * 512;
    LAS float* DD = CC + 4096;
    float cre_[4], cim_[4], bre_[4], bim_[4];
#pragma unroll
    for (int k = 0; k < 4; ++k) { const int e = tid + 512 * k; const int d = e >> 10, r = e & 1023; const size_t ci_ = (size_t)(d * NG + g) * 1024 + r; cre_[k] = a.c_re[ci_]; cim_[k] = a.c_im[ci_];
        const int dp = e >> 4, h = e & 15, d2 = dp >> 6, p2 = dp & 63; const size_t bi_ = ((size_t)(d2 * NG + g) * 64 + p2) * 16 + h; bre_[k] = a.b_re[bi_]; bim_[k] = a.b_im[bi_]; }
    const float dld = a.ssm_d[g * 16 + (tid & 15)];
    const int d_a = (tid >> 6) & 1, p_a = tid & 63, idx_a = (d_a * NG + g) * 64 + p_a;
    const float are_ = a.a_re[idx_a], aim_ = a.a_im[idx_a], ldt_ = a.log_dt[d_a * NG + g];
#pragma unroll
    for (int k = 0; k < 4; ++k) { const int e = tid + 512 * k; CC[e * 2] = cre_[k]; CC[e * 2 + 1] = cim_[k]; }
    if (tid < 16) DD[tid] = dld;
    if (tid < 128) {
        const float lr = fminf(are_, -1e-4f), li = aim_;
        const float dt = expf(ldt_);
        const float er = expf(lr * dt); float sn, cs; sincosf(li * dt, &sn, &cs);
        const float br = er * cs, bi = er * sn;
        LD[tid * 2] = lr * dt; LD[tid * 2 + 1] = li * dt; LBs[tid * 2] = br; LBs[tid * 2 + 1] = bi;
        const float nr = br - 1.f, ni = bi, den = lr * lr + li * li;
        KT[tid * 2] = (nr * lr + ni * li) / den; KT[tid * 2 + 1] = (ni * lr - nr * li) / den;
        const float e16 = expf(16.f * lr * dt); float s16, c16; sincosf(16.f * li * dt, &s16, &c16);
        lb16[(g * 128 + tid) * 2] = e16 * c16; lb16[(g * 128 + tid) * 2 + 1] = e16 * s16;
    }
    __syncthreads();
#pragma unroll
    for (int k = 0; k < 4; ++k) { const int e = tid + 512 * k; const int dp = e >> 4;
        const float xr = bre_[k], xi = bim_[k], cr = KT[dp * 2], ci = KT[dp * 2 + 1];
        BB[e * 2] = cr * xr - ci * xi; BB[e * 2 + 1] = cr * xi + ci * xr;
    }
    __syncthreads();
    {
        const int d = tid >> 8, hp = (tid >> 4) & 15, h = tid & 15; float acc[16];
#pragma unroll
        for (int t = 0; t < 16; ++t) acc[t] = 0.f;
        const LAS float* cc = CC + ((d * 16 + hp) * 64) * 2;
#pragma unroll 4
        for (int p = 0; p < 64; ++p) {
            const float c_r = cc[p * 2], c_i = cc[p * 2 + 1], b_r = BB[((d * 64 + p) * 16 + h) * 2], b_i = BB[((d * 64 + p) * 16 + h) * 2 + 1];
            float wr = c_r * b_r - c_i * b_i, wi = c_r * b_i + c_i * b_r; const float l_r = LBs[(d * 64 + p) * 2], l_i = LBs[(d * 64 + p) * 2 + 1];
#pragma unroll
            for (int t = 0; t < 16; ++t) { acc[t] += wr; const float nr = wr * l_r - wi * l_i; wi = wr * l_i + wi * l_r; wr = nr; }
        }
#pragma unroll
        for (int t = 0; t < 16; ++t) KT[((d * 16 + t) * 16 + hp) * 16 + h] = acc[t];
    }
    __syncthreads();
    for (int q = tid; q < 8192; q += 512) {
        const int n = q >> 5, kc = q & 31, s = kc >> 1, h0 = (kc & 1) * 8, j = n >> 4, hp = n & 15;
        const int dsel = s < j ? 0 : 1, tau = s < j ? j - s : s - j;
        const LAS float* k0 = KT + ((dsel * 16 + tau) * 16 + hp) * 16 + h0;
        const LAS float* kf = KT + ((0 * 16 + 0) * 16 + hp) * 16 + h0; const LAS float* kb = KT + ((1 * 16 + 0) * 16 + hp) * 16 + h0;
        const bool diag = (s == j); const float dval = DD[hp];
        float v[8];
#pragma unroll
        for (int e = 0; e < 8; ++e) { const float off = k0[e], dg = kf[e] + kb[e] + ((h0 + e) == hp ? dval : 0.f); v[e] = diag ? dg : off; }
        u32x4 w; w.x = pk2(v[0], v[1]); w.y = pk2(v[2], v[3]); w.z = pk2(v[4], v[5]); w.w = pk2(v[6], v[7]);
        *(u32x4*)(WBIG + (size_t)n * 512 + s * 16 + h0) = w;
    }
    for (int q = tid; q < 2048; q += 512) {
        const int p = q & 63, js = (q >> 6) & 15, d = q >> 10; const float ldr = LD[(d * 64 + p) * 2], ldi = LD[(d * 64 + p) * 2 + 1];
        {   const float pw = (float)(d == 0 ? js + 1 : 16 - js); const float er = __expf(pw * ldr); float sn, cs; __sincosf(pw * ldi, &sn, &cs); const float pr = er * cs, pi = er * sn;
#pragma unroll
            for (int hp = 0; hp < 16; ++hp) { const float c_r = CC[((d * 16 + hp) * 64 + p) * 2], c_i = CC[((d * 16 + hp) * 64 + p) * 2 + 1];
                *(unsigned*)(WBIG + (size_t)(js * 16 + hp) * 512 + 256 + d * 128 + 2 * p) = pk2(c_r * pr - c_i * pi, -(c_r * pi + c_i * pr)); } }
        {   const float pw = (float)(d == 0 ? 15 - js : js); const float er = __expf(pw * ldr); float sn, cs; __sincosf(pw * ldi, &sn, &cs); const float pr = er * cs, pi = er * sn;
            float zr[16], zi[16];
#pragma unroll
            for (int h = 0; h < 16; ++h) { const float b_r = BB[((d * 64 + p) * 16 + h) * 2], b_i = BB[((d * 64 + p) * 16 + h) * 2 + 1]; zr[h] = pr * b_r - pi * b_i; zi[h] = pr * b_i + pi * b_r; }
            bf16_t* d0 = WIN + (size_t)(d * 128 + p) * 256 + js * 16; bf16_t* d1 = d0 + (size_t)64 * 256;
            u32x4 w; w.x = pk2(zr[0], zr[1]); w.y = pk2(zr[2], zr[3]); w.z = pk2(zr[4], zr[5]); w.w = pk2(zr[6], zr[7]); *(u32x4*)d0 = w;
            w.x = pk2(zr[8], zr[9]); w.y = pk2(zr[10], zr[11]); w.z = pk2(zr[12], zr[13]); w.w = pk2(zr[14], zr[15]); *(u32x4*)(d0 + 8) = w;
            w.x = pk2(zi[0], zi[1]); w.y = pk2(zi[2], zi[3]); w.z = pk2(zi[4], zi[5]); w.w = pk2(zi[6], zi[7]); *(u32x4*)d1 = w;
            w.x = pk2(zi[8], zi[9]); w.y = pk2(zi[10], zi[11]); w.z = pk2(zi[12], zi[13]); w.w = pk2(zi[14], zi[15]); *(u32x4*)(d1 + 8) = w; }
    }
    __syncthreads();
}

#define XB_TMO      128
#define XB_XCNT(j)  (256  + 64 * (j))
#define XB_XSUB(j)  (1280 + 64 * (j))
#define XB_XGEN(j)  (2304 + 64 * (j))
#define XB_TOP      3328
#define XB_TOPGEN   3392
#define XCD_BAR_WORDS 3456
#define XB_SPIN_CAP (1u << 18)
__device__ __forceinline__ unsigned xb_ld(unsigned* p)              { return __hip_atomic_load(p, __ATOMIC_RELAXED, __HIP_MEMORY_SCOPE_AGENT); }
__device__ __forceinline__ unsigned xb_add(unsigned* p, unsigned v) { return __hip_atomic_fetch_add(p, v, __ATOMIC_RELAXED, __HIP_MEMORY_SCOPE_AGENT); }
__device__ __forceinline__ unsigned xb_xcc_id() { return (unsigned)__builtin_amdgcn_s_getreg((3 << 11) | 20) & 0xFu; }
#define XB_SPIN(cond, bar) do { unsigned _sp = 0; while (cond) { __builtin_amdgcn_s_sleep(1); \
    if ((++_sp & 255u) == 0u) { if (xb_ld(&(bar)[XB_TMO])) break; if (_sp > XB_SPIN_CAP) { atomicAdd(&(bar)[XB_TMO], 1u); break; } } } } while (0)
struct XcdBarrier { unsigned* bar; unsigned x; volatile LAS unsigned* st; };
__device__ __forceinline__ XcdBarrier xcd_barrier_post(unsigned* bar, volatile LAS unsigned* st, bool leader) {
    XcdBarrier b; b.bar = bar; b.x = xb_xcc_id(); b.st = st;
    if (leader) (void)xb_add(&bar[XB_XCNT(b.x)], 1u);
    return b;
}
__device__ __forceinline__ void xcd_barrier_complete(unsigned* bar, unsigned x, unsigned& nloc, unsigned& nx) {
    const unsigned G = gridDim.x * gridDim.y * gridDim.z;
    unsigned sum, cnt, mine, sp = 0u;
    for (;;) {
        sum = 0u; cnt = 0u; mine = 0u;
#pragma unroll
        for (unsigned j = 0; j < 16; ++j) { const unsigned c = xb_ld(&bar[XB_XCNT(j)]); sum += c; cnt += (c > 0u) ? 1u : 0u; mine = (j == x) ? c : mine; }
        if (sum == G) break;
        __builtin_amdgcn_s_sleep(1);
        if ((++sp & 255u) == 0u) { if (xb_ld(&bar[XB_TMO])) break; if (sp > XB_SPIN_CAP) { atomicAdd(&bar[XB_TMO], 1u); break; } }
    }
    nloc = mine > 0u ? mine : 1u; nx = cnt > 0u ? cnt : 1u;
}
__device__ __forceinline__ void xcd_barrier(const XcdBarrier& b, bool leader) {
    asm volatile("s_waitcnt vmcnt(0)" ::: "memory");
    __syncthreads();
    if (leader) {
        unsigned* bar = b.bar;
        __builtin_amdgcn_s_waitcnt(0);
        unsigned nloc = b.st[0], nx = b.st[1];
        if (nloc == 0u) { xcd_barrier_complete(bar, b.x, nloc, nx); b.st[0] = nloc; b.st[1] = nx; }
        const unsigned old = xb_add(&bar[XB_XSUB(b.x)], 1u);
        const unsigned gen = old / nloc;
        if (old + 1u == (gen + 1u) * nloc) {
            __builtin_amdgcn_fence(__ATOMIC_RELEASE, "agent");
            asm volatile("s_waitcnt vmcnt(0)" ::: "memory");
            const unsigned og = xb_add(&bar[XB_TOP], 1u);
            const unsigned tg = og / nx;
            if (og + 1u == (tg + 1u) * nx) xb_add(&bar[XB_TOPGEN], 1u);
            else XB_SPIN(xb_ld(&bar[XB_TOPGEN]) == tg, bar);
            __builtin_amdgcn_fence(__ATOMIC_ACQUIRE, "agent");
            xb_add(&bar[XB_XGEN(b.x)], 1u);
            asm volatile("s_waitcnt vmcnt(0)" ::: "memory");
        } else {
            XB_SPIN(xb_ld(&bar[XB_XGEN(b.x)]) == gen, bar);
            __builtin_amdgcn_fence(__ATOMIC_ACQUIRE, "agent");
            asm volatile("s_waitcnt vmcnt(0)" ::: "memory");
        }
    }
    __syncthreads();
}

__device__ __forceinline__ void xcd_barrier_arrive(const XcdBarrier& b, bool leader) {
    asm volatile("s_waitcnt vmcnt(0)" ::: "memory");
    __syncthreads();
    if (leader) {
        unsigned* bar = b.bar;
        __builtin_amdgcn_s_waitcnt(0);
        unsigned nloc = b.st[0], nx = b.st[1];
        if (nloc == 0u) { xcd_barrier_complete(bar, b.x, nloc, nx); b.st[0] = nloc; b.st[1] = nx; }
        const unsigned old = xb_add(&bar[XB_XSUB(b.x)], 1u);
        const unsigned gen = old / nloc;
        if (old + 1u == (gen + 1u) * nloc) {
            __builtin_amdgcn_fence(__ATOMIC_RELEASE, "agent");
            asm volatile("s_waitcnt vmcnt(0)" ::: "memory");
            const unsigned og = xb_add(&bar[XB_TOP], 1u);
            const unsigned tg = og / nx;
            if (og + 1u == (tg + 1u) * nx) { xb_add(&bar[XB_TOPGEN], 1u); b.st[5] = 3u; } else b.st[5] = 2u;
            b.st[6] = tg;
        } else { b.st[5] = 1u; b.st[6] = gen; }
    }
}
__device__ __forceinline__ void xcd_barrier_wait(const XcdBarrier& b, bool leader) {
    if (leader) {
        unsigned* bar = b.bar; const unsigned role = b.st[5], g = b.st[6];
        if (role >= 2u) {
            if (role == 2u) XB_SPIN(xb_ld(&bar[XB_TOPGEN]) == g, bar);
            __builtin_amdgcn_fence(__ATOMIC_ACQUIRE, "agent");
            xb_add(&bar[XB_XGEN(b.x)], 1u);
            asm volatile("s_waitcnt vmcnt(0)" ::: "memory");
        } else {
            XB_SPIN(xb_ld(&bar[XB_XGEN(b.x)]) == g, bar);
            __builtin_amdgcn_fence(__ATOMIC_ACQUIRE, "agent");
            asm volatile("s_waitcnt vmcnt(0)" ::: "memory");
        }
    }
    __syncthreads();
}

__global__ void __launch_bounds__(512, 2) fwd_kernel(Args a) {
    extern __shared__ __attribute__((aligned(16))) unsigned char lds_raw[];
    LAS unsigned char* lds = (LAS unsigned char*)lds_raw;
    cg::grid_group grid = cg::this_grid();
    const int wave = __builtin_amdgcn_readfirstlane(threadIdx.x >> 6);
    const bool leader = (wave == 0) && (lane_id_opaque() == 0);
    volatile LAS unsigned* xst = (volatile LAS unsigned*)(lds + XBST_OFF);
    if (leader) { xst[0] = 0u; xst[1] = 0u; }
    __syncthreads();
    if (a.ws == nullptr) grid.sync();
    const XcdBarrier xbar = xcd_barrier_post((unsigned*)(a.ws + WS_BAR), xst, leader);
#define GRID_SYNC() xcd_barrier(xbar, (wave == 0) && (lane_id_opaque() == 0))
#define LANE_IDS const int lane = lane_id_opaque(), tid = wave * 64 + lane; (void)tid;
    const int G = gridDim.x, bid = blockIdx.x;
    unsigned char* ws = a.ws;
    bf16_t* W1T = (bf16_t*)(ws + WS_W1T); bf16_t* WGLUT = (bf16_t*)(ws + WS_WGLUT); bf16_t* WOT = (bf16_t*)(ws + WS_WOT); bf16_t* WGT = (bf16_t*)(ws + WS_WGT); bf16_t* WPT = (bf16_t*)(ws + WS_WPT);
    float2* ROPE = (float2*)(ws + WS_ROPE); float* RINV = (float*)(ws + WS_RINV); float* LB16 = (float*)(ws + WS_LB16); float* SSQ1 = (float*)(ws + WS_SSQ1); float* SSQ2 = (float*)(ws + WS_SSQ2);
    bf16_t* PB = (bf16_t*)(ws + WS_PB); bf16_t* WIN = (bf16_t*)(ws + WS_WIN); bf16_t* WBIG = (bf16_t*)(ws + WS_WBIG);
    bf16_t* XB = (bf16_t*)(ws + WS_XB); bf16_t* HB = (bf16_t*)(ws + WS_XB);
    bf16_t* Q = (bf16_t*)(ws + WS_Q); bf16_t* KB = (bf16_t*)(ws + WS_K); bf16_t* VB = (bf16_t*)(ws + WS_V); bf16_t* GA = (bf16_t*)(ws + WS_GA); bf16_t* GS = (bf16_t*)(ws + WS_GS);
    bf16_t* UCAT = (bf16_t*)(ws + WS_UCAT); bf16_t* PPB = (bf16_t*)(ws + WS_UCAT); bf16_t* YMIX = (bf16_t*)(ws + WS_YMIX); bf16_t* YS = (bf16_t*)(ws + WS_YS);

#pragma unroll
    for (int rep_ = 0; rep_ < 1 + ((REP_MASK >> 0) & 1); ++rep_) { LANE_IDS
        const int gw = bid * 8 + wave, NGW = G * 8;
        LAS float* scr = (LAS float*)(lds + wave * 16384);
        constexpr int I1 = 32 * 144, I2 = 16 * 64, I3 = 32 * 64, I4 = 32 * 64, I5 = 4 * 64, NIT = I1 + I2 + I3 + I4 + I5;
        auto item_desc = [&](int r) -> TrItem {
            if (r < I1) { const int kb = r / 144, lgg = r % 144, pn = lgg >> 3, lg = lgg & 7, wtg = pn * 8 + 4 * (lg & 1) + 2 * (lg >> 2) + ((lg >> 1) & 1);
                return TrItem{a.w_in, W1T, a.norm_mix, DM, DIN, wtg * 32, kb * 64, lgg * 32}; } r -= I1;
            if (r < I2) { const int kb = r / 64, lgg = r % 64, l2 = lgg & 31, wtg = (l2 >> 2) * 8 + 4 * (lgg >> 5) + (l2 & 3);
                return TrItem{a.w_glu, WGLUT, nullptr, DSSM, 2 * DSSM, wtg * 32, kb * 64, lgg * 32}; } r -= I2;
            if (r < I3) { const int kb = r / 64, lgg = r % 64; return TrItem{a.w_out, WOT, nullptr, DM, DM, lgg * 32, kb * 64, lgg * 32}; } r -= I3;
            if (r < I4) { const int kb = r / 64, lgg = r % 64; return TrItem{a.w_ple_gate, WGT, a.norm_ple, DM, DM, lgg * 32, kb * 64, lgg * 32}; } r -= I4;
            const int kb = r / 64, lgg = r % 64; return TrItem{a.w_ple_proj, WPT, nullptr, PLE, DM, lgg * 32, kb * 64, lgg * 32};
        };
#pragma unroll
        for (int rq_ = 0; rq_ < 1 + ((REP_MASK >> 8) & 1); ++rq_)
        for (int it = gw; it < I1; it += 2 * NGW) {
            const bool two = it + NGW < I1;
            const TrItem dA = item_desc(it), dB = item_desc(two ? it + NGW : it);
            float vA[32], vB[32];
            p0_tr_load(dA, vA, lane); if (two) p0_tr_load(dB, vB, lane);
            p0_tr_store(dA, vA, scr, lane); if (two) p0_tr_store(dB, vB, scr, lane);
        }
#pragma unroll
        for (int rq_ = 0; rq_ < 1 + ((REP_MASK >> 9) & 1); ++rq_)
        for (int m = gw; m < T; m += 2 * NGW) {
            const int m2 = m + NGW; const bool two = m2 < T;
            const f32x4* xr = (const f32x4*)(a.x + (size_t)m * DM) + lane; const f32x4* xr2 = (const f32x4*)(a.x + (size_t)(two ? m2 : m) * DM) + lane;
            f32x4 v[8], w2[8]; float s = 0.f, s2 = 0.f;
#pragma unroll
            for (int j = 0; j < 8; ++j) v[j] = __builtin_nontemporal_load(xr + 64 * j);
#pragma unroll
            for (int j = 0; j < 8; ++j) w2[j] = __builtin_nontemporal_load(xr2 + 64 * j);
#pragma unroll
            for (int j = 0; j < 8; ++j) { s += (v[j][0] * v[j][0] + v[j][1] * v[j][1]) + (v[j][2] * v[j][2] + v[j][3] * v[j][3]); s2 += (w2[j][0] * w2[j][0] + w2[j][1] * w2[j][1]) + (w2[j][2] * w2[j][2] + w2[j][3] * w2[j][3]); }
            s = wave_sum(s); s2 = wave_sum(s2);
            if (lane == 0) { RINV[m] = rsqrtf(s * (1.f / DM) + EPS); if (two) RINV[m2] = rsqrtf(s2 * (1.f / DM) + EPS); }
            u32x2* o = (u32x2*)(XB + (size_t)m * DM) + lane; u32x2* o2 = (u32x2*)(XB + (size_t)m2 * DM) + lane;
#pragma unroll
            for (int j = 0; j < 8; ++j) { u32x2 w; w.x = pk2(v[j][0], v[j][1]); w.y = pk2(v[j][2], v[j][3]); o[64 * j] = w; }
            if (two) {
#pragma unroll
                for (int j = 0; j < 8; ++j) { u32x2 w; w.x = pk2(w2[j][0], w2[j][1]); w.y = pk2(w2[j][2], w2[j][3]); o2[64 * j] = w; } }
        }
        for (int i = bid * 512 + tid; i < T * PLE / 4; i += G * 512) { const f32x4 v = __builtin_nontemporal_load((const f32x4*)a.p + i); u32x2 w; w.x = pk2(v[0], v[1]); w.y = pk2(v[2], v[3]); ((u32x2*)PB)[i] = w; }
        for (int i = bid * 512 + tid; i < 2048; i += G * 512) { const int pos = i >> 5, f = i & 31; const float inv = powf(10000.f, -(float)f / 32.f); float sn, cs; sincosf((float)pos * inv, &sn, &cs); ROPE[i] = make_float2(cs, sn); }
        xcd_barrier_arrive(xbar, (wave == 0) && (lane_id_opaque() == 0));
        for (int it = I1 + gw; it < NIT; it += 2 * NGW) {
            const bool two = it + NGW < NIT;
            const TrItem dA = item_desc(it), dB = item_desc(two ? it + NGW : it);
            float vA[32], vB[32];
            p0_tr_load(dA, vA, lane); if (two) p0_tr_load(dB, vB, lane);
            p0_tr_store(dA, vA, scr, lane); if (two) p0_tr_store(dB, vB, scr, lane);
        }
        xcd_barrier_wait(xbar, (wave == 0) && (lane_id_opaque() == 0)); }


    if constexpr ((REP_MASK >> 10) & 1) { GRID_SYNC(); GRID_SYNC(); GRID_SYNC(); GRID_SYNC(); }
#pragma unroll
    for (int rep_ = 0; rep_ < 1 + ((REP_MASK >> 1) & 1); ++rep_) { LANE_IDS
        { pg8::Gemm g{XB, W1T, DM, DM, DM, 0, 0}; pg8::StaticOrder S; S.init(T, 14 * 256, G, bid);
          pg8::Epi1 E{RINV, a.q_norm, a.k_norm, ROPE, Q, KB, VB, GA, GS, UCAT, (LAS float*)(lds + XCH_OFF), 0};
          pg8::gemm_phase<pg8::Epi1, pg8::StaticOrder, true>(lds, g, S, E, wave); }
        __syncthreads();
        for (int gi = bid - (G - NG); gi >= 0 && gi < NG; gi += NG) ssm_tables(a, gi, lds, tid);
    GRID_SYNC(); }

#pragma unroll
    for (int rep_ = 0; rep_ < 1 + ((REP_MASK >> 2) & 1); ++rep_) {
#pragma unroll
        for (int rq_ = 0; rq_ < 2; ++rq_) {
        if (bid < 2 * NG) { if (rq_ == 1 && !((REP_MASK >> 6) & 1)) break;
            pg8::BatchOrder S{2 * NG, G, bid};
            { pg8::Gemm g{UCAT, WIN, 256, 512, 256, (size_t)NCH * 512 * 2, (size_t)256 * 256 * 2};
              pg8::EpiS1 E{LB16, UCAT}; pg8::gemm_phase<pg8::EpiS1, pg8::BatchOrder, true>(lds, g, S, E, wave); }
            asm volatile("s_waitcnt vmcnt(0)\n\tbuffer_inv sc1\n\ts_waitcnt vmcnt(0)" ::: "memory"); __syncthreads();
            { pg8::Gemm g{UCAT, WBIG, 512, 512, 512, (size_t)NCH * 512 * 2, (size_t)256 * 512 * 2};
              pg8::EpiS2 E{YS}; pg8::gemm_phase<pg8::EpiS2, pg8::BatchOrder, true>(lds, g, S, E, wave); }
        } else { if (rq_ == 1 && !((REP_MASK >> 11) & 1)) break;
            pg8::Gemm g{XB, W1T + (size_t)14 * 256 * DM, DM, DM, DM, 0, 0}; pg8::ListOrder S{bid - 2 * NG, 128, G};
            pg8::Epi1 E{RINV, a.q_norm, a.k_norm, ROPE, Q, KB, VB, GA, GS, UCAT, (LAS float*)(lds + XCH_OFF), 14};
            pg8::gemm_phase<pg8::Epi1, pg8::ListOrder, true>(lds, g, S, E, wave);
        }
        __syncthreads(); }
#pragma unroll
        for (int rq_ = 0; rq_ < 1 + ((REP_MASK >> 7) & 1); ++rq_)
        for (int un = bid; un < 256; un += G) {
            const int x = un & 7, jj = un >> 3, b = x >> 2, kvh = (x >> 1) & 1, idx = (x & 1) * 32 + jj, h = kvh * 4 + (idx >> 4), qb = idx & 15;
            const size_t tok0 = (size_t)b * SEQ + qb * 256;
            att::attn_dense_body(Q + tok0 * DATT + h * 128, KB + (size_t)b * SEQ * DKV + kvh * 128, VB + (size_t)b * SEQ * DKV + kvh * 128,
                                 GA + tok0 * DATT + h * 128, YMIX + tok0 * DM + h * 128, SEQ, (char*)lds_raw, wave);
        }
    GRID_SYNC(); }

#pragma unroll
    for (int rep_ = 0; rep_ < 1 + ((REP_MASK >> 3) & 1); ++rep_) {
        { pg8::StaticOrder S; S.init(T, 2 * DSSM, G, bid); pg8::Unit ua, ub;
          if (S.next(0, ua)) { ub = ua;
            pg8::Gemm ga{YS, WGLUT, DSSM, DSSM, DSSM, 0, 0}; pg8::EpiGlu Ea{a.b_glu, GS, YMIX};
            pg8::Gemm gb{PB, WPT, PLE, PLE, PLE, 0, 0}; pg8::EpiBf Eb{PPB, DM};
            pg8::gemm_phase2<pg8::EpiGlu, pg8::EpiBf>(lds, ga, ua, Ea, gb, ub, Eb, wave); } }
    GRID_SYNC(); }

#pragma unroll
    for (int rep_ = 0; rep_ < 1 + ((REP_MASK >> 4) & 1); ++rep_) {
        pg8::Gemm g{YMIX, WOT, DM, DM, DM, 0, 0}; pg8::StaticOrder S; S.init(T, DM, G, bid);
        pg8::EpiOut E{a.x, a.out, HB, SSQ1}; pg8::gemm_phase<pg8::EpiOut, pg8::StaticOrder, true>(lds, g, S, E, wave);
    GRID_SYNC(); }


    { LANE_IDS
        pg8::StaticOrder S; S.init(T, DM, G, bid); pg8::Unit u0;
        LAS float* r2 = (LAS float*)(lds + R2_OFF);
        if (S.next(0, u0) && tid < 256) { const float* sp = SSQ1 + (size_t)(u0.pm * 256 + tid) * 32; float s = 0.f;
#pragma unroll
            for (int i = 0; i < 8; ++i) { const f32x4 v = ((const f32x4*)sp)[i]; s += (v[0] + v[1]) + (v[2] + v[3]); }
            r2[tid] = rsqrtf(s * (1.f / DM) + EPS); }
        __syncthreads();
        pg8::Gemm g{HB, WGT, DM, DM, DM, 0, 0};
        pg8::EpiGate E{a.out, PPB, SSQ2, (unsigned*)ws, a.norm_final, r2, HB}; pg8::gemm_phase<pg8::EpiGate, pg8::StaticOrder, true>(lds, g, S, E, wave);
    }
}

extern "C" void kernel_launch(void* const* d_in, const int* in_sizes, int n_in, void* d_out, int out_size, void* d_ws, size_t ws_size, hipStream_t stream) {
    static int grid = 0;
    if (grid == 0) {
        if (n_in != 21 || in_sizes[0] != T * DM || out_size != T * DM || ws_size < WS_END) { fprintf(stderr, "kernel_launch: unexpected shapes (n_in %d, in0 %d, out %d, ws %zu)\n", n_in, n_in > 0 ? in_sizes[0] : -1, out_size, ws_size); grid = -1; return; }
        int dev = 0, cus = 0, per_cu = 0;
        hipGetDevice(&dev); hipDeviceGetAttribute(&cus, hipDeviceAttributeMultiprocessorCount, dev);
        if (hipFuncSetAttribute((const void*)fwd_kernel, hipFuncAttributeMaxDynamicSharedMemorySize, LDS_BYTES) != hipSuccess) { fprintf(stderr, "kernel_launch: hipFuncSetAttribute failed\n"); grid = -1; return; }
        hipOccupancyMaxActiveBlocksPerMultiprocessor(&per_cu, (const void*)fwd_kernel, 512, LDS_BYTES);
        (void)hipGetLastError();
        if (per_cu < 1) fprintf(stderr, "kernel_launch: occupancy query reports %d blocks per CU\n", per_cu);
        grid = cus > 256 ? 256 : cus;
    }
    if (grid < 0) return;
    Args a{};
    const float** f = (const float**)&a;
    for (int i = 0; i < 21; ++i) f[i] = (const float*)d_in[i];
    a.out = (float*)d_out; a.ws = (unsigned char*)d_ws;
    if (hipMemsetAsync(d_ws, 0, WS_CTL_BYTES, stream) != hipSuccess) { fprintf(stderr, "kernel_launch: hipMemsetAsync failed\n"); return; }
    void* args[] = {&a};
    hipError_t e = hipLaunchCooperativeKernel((const void*)fwd_kernel, dim3(grid), dim3(512), args, LDS_BYTES, stream);
    if (e != hipSuccess) fprintf(stderr, "kernel_launch: cooperative launch failed: %s (grid %d)\n", hipGetErrorString(e), grid);
}
```

```cpp
#include <hip/hip_runtime.h>
#include <hip/hip_cooperative_groups.h>
#include <cstdio>
#include <cstdint>
namespace cg = cooperative_groups;

#define LAS __attribute__((address_space(3)))
typedef unsigned short bf16_t;
typedef short bf16x8 __attribute__((ext_vector_type(8)));
typedef short s16x4 __attribute__((ext_vector_type(4)));
typedef float f32x4 __attribute__((ext_vector_type(4)));
typedef float f32x16 __attribute__((ext_vector_type(16)));
typedef unsigned u32x4 __attribute__((ext_vector_type(4)));
typedef unsigned u32x2 __attribute__((ext_vector_type(2)));

constexpr int T = 8192, SEQ = 4096, DM = 2048, DIN = 4608, DATT = 1024, DKV = 256, DSSM = 1024, PLE = 256;
constexpr int NG = 64, NCH = T / 16;
constexpr float EPS = 1e-6f;
#ifndef PH_MASK
#define PH_MASK 0xff
#endif
#ifndef GLDS_AUX
#define GLDS_AUX 0
#endif
#ifndef REP_MASK
#define REP_MASK 0
#endif

constexpr size_t MiB = 1u << 20;
constexpr size_t WS_W1T = 1 * MiB, WS_WGLUT = 19 * MiB, WS_WOT = 23 * MiB, WS_WGT = 31 * MiB, WS_WPT = 39 * MiB;
constexpr size_t WS_ROPE = 40 * MiB, WS_RINV = 40 * MiB + 65536, WS_LB16 = 40 * MiB + 131072, WS_SSQ1 = 41 * MiB, WS_SSQ2 = 42 * MiB;
constexpr size_t WS_PB = 43 * MiB, WS_WIN = 47 * MiB, WS_WBIG = 55 * MiB;
constexpr size_t WS_XB = 71 * MiB;
constexpr size_t WS_Q = 103 * MiB, WS_K = 119 * MiB, WS_V = 123 * MiB, WS_GA = 127 * MiB, WS_GS = 143 * MiB;
constexpr size_t WS_UCAT = 159 * MiB;
constexpr size_t WS_YMIX = 191 * MiB, WS_YS = 223 * MiB, WS_END = 239 * MiB;

constexpr int RING_BYTES = 131072, XCH_OFF = RING_BYTES, R2_OFF = RING_BYTES + 4096, XBST_OFF = RING_BYTES + 8192, LDS_BYTES = 147456;
constexpr size_t WS_BAR = 65536, WS_CTL_BYTES = 131072;

struct Args {
    const float *x, *p, *norm_mix, *w_in, *q_norm, *k_norm, *a_re, *a_im, *log_dt, *b_re, *b_im, *c_re, *c_im, *ssm_d, *w_glu, *b_glu, *w_out, *norm_ple, *w_ple_gate, *w_ple_proj, *norm_final;
    float* out; unsigned char* ws;
};

typedef __bf16 bf16s_;
__device__ __forceinline__ unsigned f2bf(float f) { return (unsigned)__builtin_bit_cast(unsigned short, (bf16s_)f); }
typedef float f32x2_ __attribute__((ext_vector_type(2)));
typedef __bf16 bf16x2_ __attribute__((ext_vector_type(2)));
__device__ __forceinline__ unsigned pk2(float lo, float hi) { const f32x2_ v = {lo, hi}; return __builtin_bit_cast(unsigned, __builtin_convertvector(v, bf16x2_)); }
__device__ __forceinline__ float bf2f(unsigned short b) { return __builtin_bit_cast(float, (unsigned)b << 16); }
__device__ __forceinline__ float bflo(unsigned w) { return __builtin_bit_cast(float, w << 16); }
__device__ __forceinline__ float bfhi(unsigned w) { return __builtin_bit_cast(float, w & 0xffff0000u); }
__device__ __forceinline__ unsigned cvt_pk_bf16(float lo, float hi) { unsigned r; asm volatile("v_cvt_pk_bf16_f32 %0, %1, %2" : "=v"(r) : "v"(lo), "v"(hi)); return r; }
__device__ __forceinline__ float sigmoidf_(float v) { return __builtin_amdgcn_rcpf(1.f + __builtin_amdgcn_exp2f(-1.4426950408889634f * v)); }
__device__ __forceinline__ float siluf_(float v) { return v * __builtin_amdgcn_rcpf(1.f + __builtin_amdgcn_exp2f(-1.4426950408889634f * v)); }
__device__ __forceinline__ float gelu_tanh(float v) { const float t = (-1.5957691216057308f * 1.4426950408889634f) * (v + 0.044715f * v * v * v); return v * __builtin_amdgcn_rcpf(1.f + __builtin_amdgcn_exp2f(t)); }
template <int K> __device__ __forceinline__ float swz_xor(float v) { return __int_as_float(__builtin_amdgcn_ds_swizzle(__float_as_int(v), (K << 10) | 0x1f)); }
__device__ __forceinline__ float sum_xor32(float v) { auto rr = __builtin_amdgcn_permlane32_swap(__float_as_uint(v), __float_as_uint(v), false, false); return __uint_as_float(rr[0]) + __uint_as_float(rr[1]); }
__device__ __forceinline__ float wave_sum(float v) { v += swz_xor<1>(v); v += swz_xor<2>(v); v += swz_xor<4>(v); v += swz_xor<8>(v); v += swz_xor<16>(v); return sum_xor32(v); }
#define LDS_WAIT() asm volatile("s_waitcnt lgkmcnt(0)" ::: "memory")
__device__ __forceinline__ int lane_id_opaque() { int l = __builtin_amdgcn_mbcnt_hi(~0u, __builtin_amdgcn_mbcnt_lo(~0u, 0u)); asm volatile("" : "+v"(l)); return l; }

namespace pg8 {
constexpr int BM = 256, BK = 64, HALF = 128, HTB = HALF * BK * 2, NXCD = 8, WGM = 4;
__host__ __device__ __forceinline__ int lds_byte(int r, int c) { const int st = (r >> 4) * 2 + (c >> 5), rr = r & 15, cc = c & 31, ob = rr * 64 + cc * 2; return st * 1024 + (ob ^ (((ob >> 9) & 1) << 5)); }
__host__ __device__ __forceinline__ void stage_rc(int b, int& R, int& C) { const int st = b / 1024, sb = b % 1024, swz = sb ^ (((sb >> 9) & 1) << 5); R = (st >> 1) * 16 + swz / 64; C = (st & 1) * 32 + (swz % 64) / 2; }
__host__ __device__ __forceinline__ int perm32(int rho) { const int n = rho >> 4, i = rho & 15; return 8 * (i >> 2) + 4 * n + (i & 3); }

struct Unit { int pm, pn, z; };
struct Gemm { const bf16_t* A; const bf16_t* Bt; int K, lda, ldb; size_t zA, zB; };

struct StaticOrder {
    int nM, nN, nwg, G, c;
    __device__ void init(int M, int N, int G_, int c_) { nM = M / BM; nN = N / BM; nwg = nM * nN; G = G_; c = c_; }
    __device__ bool next(int i, Unit& u) const {
        const long L = (long)i * G + c; if (L >= nwg) return false;
        int wgid = (int)L; { const int q = nwg / NXCD, r = nwg % NXCD, xcd = wgid % NXCD, off = wgid / NXCD; wgid = (xcd < r ? xcd * (q + 1) : r * (q + 1) + (xcd - r) * q) + off; }
        const int nig = WGM * nN, gid = wgid / nig, fm = gid * WGM, gsz = (nM - fm) < WGM ? (nM - fm) : WGM;
        u.pm = fm + ((wgid % nig) % gsz); u.pn = (wgid % nig) / gsz; u.z = 0; return true;
    }
};
struct BatchOrder {
    int n, G, c;
    __device__ bool next(int i, Unit& u) const { const int L = i * G + c; if (L >= n) return false;
        if ((n & 15) == 0) { const int x = L & 7, j = L >> 3; u.z = 8 * x + (j >> 1); u.pm = j & 1; }
        else { u.z = L >> 1; u.pm = L & 1; }
        u.pn = 0; return true; }
};

struct ListOrder {
    int L0, n, stride;
    __device__ bool next(int i, Unit& u) const { const int L = L0 + i * stride; if (L < 0 || L >= n) return false;
        const int x = L & 7, j = L >> 3; u.pm = 4 * x + (j >> 2); u.pn = j & 3; u.z = 0; return true; }
};
template <class Epi, class Sched, bool ALIGN_EPI>
__device__ __forceinline__ void gemm_phase(LAS unsigned char* lds, const Gemm g, const Sched& S, const Epi& E, const int wid) {
    const int lane = lane_id_opaque(), tid = wid * 64 + lane, wr = wid >> 2, wc = wid & 3, fr = lane & 15, fq = lane >> 4;
    const int K = g.K, nt = K / BK;
    unsigned voffA[2], voffB[2];
#pragma unroll
    for (int i = 0; i < 2; ++i) { int R, C; stage_rc(tid * 16 + i * 8192, R, C); const int Rb = (R & ~31) + perm32(R & 31);
        voffA[i] = (unsigned)(R * g.lda + C) * 2u; voffB[i] = (unsigned)(Rb * g.ldb + C) * 2u; }
    const size_t kstep = (size_t)(BK * 2);
    const size_t hstepA = (size_t)HALF * g.lda * 2, hstepB = (size_t)HALF * g.ldb * 2;
    const size_t tstepA = 2 * hstepA, tstepB = 2 * hstepB;
    const unsigned ldsw = (unsigned)wid * 1024u;
    const int aoff = lds_byte(wr * 64 + fr, fq * 8), boff = lds_byte(wc * 32 + fr, fq * 8);
#define PG8_SA(b, h) (((b) * 2 + (h)) * HTB)
#define PG8_SB(b, h) ((4 + (b) * 2 + (h)) * HTB)
#define PG8_STAGE(bufoff, gbase, voff) do { _Pragma("unroll") for (int _i = 0; _i < 2; ++_i) \
        __builtin_amdgcn_global_load_lds((const unsigned*)((const char*)(gbase) + (voff)[_i]), (LAS unsigned*)(lds + (bufoff) + ldsw + _i * 8192), 16, 0, GLDS_AUX); } while (0)
#define PG8_LDA(dst, b, h) do { _Pragma("unroll") for (int m = 0; m < 4; ++m) _Pragma("unroll") for (int k = 0; k < 2; ++k) dst[m][k] = *(const LAS bf16x8*)(lds + PG8_SA(b, h) + aoff + m * 2048 + k * 1024); } while (0)
#define PG8_LDB(dst, b, h) do { _Pragma("unroll") for (int n = 0; n < 2; ++n) _Pragma("unroll") for (int k = 0; k < 2; ++k) dst[n][k] = *(const LAS bf16x8*)(lds + PG8_SB(b, h) + boff + n * 2048 + k * 1024); } while (0)
#define PG8_MMA(ai, bj, At, Bt) do { __builtin_amdgcn_s_setprio(1); _Pragma("unroll") for (int m = 0; m < 4; ++m) _Pragma("unroll") for (int n = 0; n < 2; ++n) _Pragma("unroll") for (int k = 0; k < 2; ++k) \
        acc[ai][bj][m][n] = __builtin_amdgcn_mfma_f32_16x16x32_bf16(Bt[n][k], At[m][k], acc[ai][bj][m][n], 0, 0, 0); __builtin_amdgcn_s_setprio(0); } while (0)
#define PG8_WAIT_V(n) asm volatile("s_waitcnt vmcnt(" #n ")" ::: "memory")
#define PG8_WAIT_L(n) asm volatile("s_waitcnt lgkmcnt(" #n ")" ::: "memory")
#define PG8_BAR __builtin_amdgcn_s_barrier()
#define PG8_SCHED __builtin_amdgcn_sched_barrier(0)
    Unit cur, nxt; int ui = 0;
    if (!S.next(0, cur)) return;
    f32x4 acc[2][2][4][2];
#pragma unroll
    for (int a = 0; a < 2; ++a)
#pragma unroll
        for (int b = 0; b < 2; ++b)
#pragma unroll
            for (int m = 0; m < 4; ++m)
#pragma unroll
                for (int n = 0; n < 2; ++n) acc[a][b][m][n] = (f32x4){0.f, 0.f, 0.f, 0.f};
    bf16x8 At[4][2], B0[2][2], B1[2][2];
    const char* cA = (const char*)g.A + (size_t)cur.z * g.zA + (size_t)cur.pm * tstepA; const char* cB = (const char*)g.Bt + (size_t)cur.z * g.zB + (size_t)cur.pn * tstepB;
    PG8_STAGE(PG8_SB(0, 0), cB, voffB); PG8_STAGE(PG8_SB(0, 1), cB + hstepB, voffB); PG8_STAGE(PG8_SA(0, 0), cA, voffA); PG8_STAGE(PG8_SA(0, 1), cA + hstepA, voffA);
    if (wr == 1) PG8_BAR;
    PG8_WAIT_V(2); PG8_BAR;
    PG8_STAGE(PG8_SB(1, 0), cB + kstep, voffB); PG8_STAGE(PG8_SA(1, 0), cA + kstep, voffA); PG8_STAGE(PG8_SB(1, 1), cB + hstepB + kstep, voffB);
    PG8_WAIT_V(6); PG8_BAR;
    for (;;) {
        const bool has_next = S.next(ui + 1, nxt);
        const char* nA = has_next ? (const char*)g.A + (size_t)nxt.z * g.zA + (size_t)nxt.pm * tstepA : cA;
        const char* nB = has_next ? (const char*)g.Bt + (size_t)nxt.z * g.zB + (size_t)nxt.pn * tstepB : cB;
        for (int t = 0; t < nt; t += 2) {
            const bool last = (t == nt - 2);
            const char* a1 = cA + (size_t)(t + 1) * kstep;
            const char* a2 = last ? nA : cA + (size_t)(t + 2) * kstep; const char* b2 = last ? nB : cB + (size_t)(t + 2) * kstep;
            const char* a3 = a2 + kstep; const char* b3 = b2 + kstep;
            PG8_LDB(B0, 0, 0); PG8_LDB(B1, 0, 1); PG8_SCHED; PG8_LDA(At, 0, 0); PG8_STAGE(PG8_SA(1, 1), a1 + hstepA, voffA);
            PG8_WAIT_V(8); PG8_WAIT_L(0); PG8_BAR; PG8_MMA(0, 0, At, B0); PG8_MMA(0, 1, At, B1); PG8_BAR; PG8_SCHED;
            PG8_LDA(At, 0, 1); PG8_STAGE(PG8_SB(0, 0), b2, voffB); PG8_STAGE(PG8_SB(0, 1), b2 + hstepB, voffB); PG8_STAGE(PG8_SA(0, 0), a2, voffA);
            PG8_WAIT_V(8); PG8_WAIT_L(0); PG8_BAR; PG8_MMA(1, 0, At, B0); PG8_MMA(1, 1, At, B1); PG8_BAR; PG8_SCHED;
            PG8_LDB(B0, 1, 0); PG8_LDB(B1, 1, 1); PG8_SCHED; PG8_LDA(At, 1, 0); PG8_STAGE(PG8_SA(0, 1), a2 + hstepA, voffA);
            PG8_WAIT_V(8); PG8_WAIT_L(0); PG8_BAR; PG8_MMA(0, 0, At, B0); PG8_MMA(0, 1, At, B1); PG8_BAR; PG8_SCHED;
            PG8_LDA(At, 1, 1); PG8_STAGE(PG8_SB(1, 0), b3, voffB); PG8_STAGE(PG8_SB(1, 1), b3 + hstepB, voffB); PG8_STAGE(PG8_SA(1, 0), a3, voffA);
            PG8_WAIT_V(8); PG8_WAIT_L(0); PG8_BAR; PG8_MMA(1, 0, At, B0); PG8_MMA(1, 1, At, B1); PG8_BAR; PG8_SCHED;
        }
        if constexpr (ALIGN_EPI) { if (wr == 0) PG8_BAR; }
        if constexpr (!Epi::AFTER_DRAIN) E(acc, cur, wr, wc, fr, fq);
        if (!has_next) break;
#pragma unroll
        for (int a = 0; a < 2; ++a)
#pragma unroll
            for (int b = 0; b < 2; ++b)
#pragma unroll
                for (int m = 0; m < 4; ++m)
#pragma unroll
                    for (int n = 0; n < 2; ++n) acc[a][b][m][n] = (f32x4){0.f, 0.f, 0.f, 0.f};
        cur = nxt; cA = nA; cB = nB; ++ui;
        if constexpr (ALIGN_EPI) { if (wr == 1) PG8_BAR; }
    }
    PG8_WAIT_V(0);
    if constexpr (!ALIGN_EPI) { if (wr == 0) PG8_BAR; }
    PG8_BAR;
    if constexpr (Epi::AFTER_DRAIN) E.fused(acc, cur, wr, wc, lds, wid);
#undef PG8_SA
#undef PG8_SB
#undef PG8_STAGE
#undef PG8_LDA
#undef PG8_LDB
#undef PG8_MMA
#undef PG8_WAIT_V
#undef PG8_WAIT_L
#undef PG8_BAR
#undef PG8_SCHED
}

template <class EpiA, class EpiB>
__device__ __forceinline__ void gemm_phase2(LAS unsigned char* lds, const Gemm g0, const Unit u0, const EpiA& E0, const Gemm g1, const Unit u1, const EpiB& E1, const int wid) {
    const int lane = lane_id_opaque(), tid = wid * 64 + lane, wr = wid >> 2, wc = wid & 3, fr = lane & 15, fq = lane >> 4;
    unsigned vA0[2], vB0[2], vA1[2], vB1[2];
#pragma unroll
    for (int i = 0; i < 2; ++i) { int R, C; stage_rc(tid * 16 + i * 8192, R, C); const int Rb = (R & ~31) + perm32(R & 31);
        vA0[i] = (unsigned)(R * g0.lda + C) * 2u; vB0[i] = (unsigned)(Rb * g0.ldb + C) * 2u; vA1[i] = (unsigned)(R * g1.lda + C) * 2u; vB1[i] = (unsigned)(Rb * g1.ldb + C) * 2u; }
    const size_t kstep = (size_t)(BK * 2);
    const size_t hA0 = (size_t)HALF * g0.lda * 2, hB0 = (size_t)HALF * g0.ldb * 2, hA1 = (size_t)HALF * g1.lda * 2, hB1 = (size_t)HALF * g1.ldb * 2;
    const unsigned ldsw = (unsigned)wid * 1024u;
    const int aoff = lds_byte(wr * 64 + fr, fq * 8), boff = lds_byte(wc * 32 + fr, fq * 8);
#define PG8_SA(b, h) (((b) * 2 + (h)) * HTB)
#define PG8_SB(b, h) ((4 + (b) * 2 + (h)) * HTB)
#define PG8_STAGE(bufoff, gbase, voff) do { _Pragma("unroll") for (int _i = 0; _i < 2; ++_i) \
        __builtin_amdgcn_global_load_lds((const unsigned*)((const char*)(gbase) + (voff)[_i]), (LAS unsigned*)(lds + (bufoff) + ldsw + _i * 8192), 16, 0, 0); } while (0)
#define PG8_LDA(dst, b, h) do { _Pragma("unroll") for (int m = 0; m < 4; ++m) _Pragma("unroll") for (int k = 0; k < 2; ++k) dst[m][k] = *(const LAS bf16x8*)(lds + PG8_SA(b, h) + aoff + m * 2048 + k * 1024); } while (0)
#define PG8_LDB(dst, b, h) do { _Pragma("unroll") for (int n = 0; n < 2; ++n) _Pragma("unroll") for (int k = 0; k < 2; ++k) dst[n][k] = *(const LAS bf16x8*)(lds + PG8_SB(b, h) + boff + n * 2048 + k * 1024); } while (0)
#define PG8_MMA(ai, bj, At, Bt) do { __builtin_amdgcn_s_setprio(1); _Pragma("unroll") for (int m = 0; m < 4; ++m) _Pragma("unroll") for (int n = 0; n < 2; ++n) _Pragma("unroll") for (int k = 0; k < 2; ++k) \
        acc[ai][bj][m][n] = __builtin_amdgcn_mfma_f32_16x16x32_bf16(Bt[n][k], At[m][k], acc[ai][bj][m][n], 0, 0, 0); __builtin_amdgcn_s_setprio(0); } while (0)
#define PG8_WAIT_V(n) asm volatile("s_waitcnt vmcnt(" #n ")" ::: "memory")
#define PG8_WAIT_L(n) asm volatile("s_waitcnt lgkmcnt(" #n ")" ::: "memory")
#define PG8_BAR __builtin_amdgcn_s_barrier()
#define PG8_SCHED __builtin_amdgcn_sched_barrier(0)
    f32x4 acc[2][2][4][2];
#pragma unroll
    for (int a = 0; a < 2; ++a)
#pragma unroll
        for (int b = 0; b < 2; ++b)
#pragma unroll
            for (int m = 0; m < 4; ++m)
#pragma unroll
                for (int n = 0; n < 2; ++n) acc[a][b][m][n] = (f32x4){0.f, 0.f, 0.f, 0.f};
    bf16x8 At[4][2], B0[2][2], B1[2][2];
    const char* A0 = (const char*)g0.A + (size_t)u0.pm * 2 * hA0; const char* Bp0 = (const char*)g0.Bt + (size_t)u0.pn * 2 * hB0;
    const char* A1 = (const char*)g1.A + (size_t)u1.pm * 2 * hA1; const char* Bp1 = (const char*)g1.Bt + (size_t)u1.pn * 2 * hB1;
    PG8_STAGE(PG8_SB(0, 0), Bp0, vB0); PG8_STAGE(PG8_SB(0, 1), Bp0 + hB0, vB0); PG8_STAGE(PG8_SA(0, 0), A0, vA0); PG8_STAGE(PG8_SA(0, 1), A0 + hA0, vA0);
    if (wr == 1) PG8_BAR;
    PG8_WAIT_V(2); PG8_BAR;
    PG8_STAGE(PG8_SB(1, 0), Bp0 + kstep, vB0); PG8_STAGE(PG8_SA(1, 0), A0 + kstep, vA0); PG8_STAGE(PG8_SB(1, 1), Bp0 + hB0 + kstep, vB0);
    PG8_WAIT_V(6); PG8_BAR;
#pragma unroll
    for (int ui = 0; ui < 2; ++ui) {
        const char* cA = ui == 0 ? A0 : A1; const char* cB = ui == 0 ? Bp0 : Bp1;
        const size_t hAc = ui == 0 ? hA0 : hA1, hBc = ui == 0 ? hB0 : hB1;
        const int nt = (ui == 0 ? g0.K : g1.K) / BK;
        unsigned vAc[2], vBc[2];
#pragma unroll
        for (int i = 0; i < 2; ++i) { vAc[i] = ui == 0 ? vA0[i] : vA1[i]; vBc[i] = ui == 0 ? vB0[i] : vB1[i]; }
        for (int t = 0; t < nt; t += 2) {
            const bool last = (t == nt - 2);
            const char* a1 = cA + (size_t)(t + 1) * kstep;
            const char* a2 = last ? A1 : cA + (size_t)(t + 2) * kstep; const char* b2 = last ? Bp1 : cB + (size_t)(t + 2) * kstep;
            const char* a3 = a2 + kstep; const char* b3 = b2 + kstep;
            const size_t hA2 = last ? hA1 : hAc, hB2 = last ? hB1 : hBc;
            unsigned vA2[2], vB2[2];
#pragma unroll
            for (int i = 0; i < 2; ++i) { vA2[i] = last ? vA1[i] : vAc[i]; vB2[i] = last ? vB1[i] : vBc[i]; }
            PG8_LDB(B0, 0, 0); PG8_LDB(B1, 0, 1); PG8_SCHED; PG8_LDA(At, 0, 0); PG8_STAGE(PG8_SA(1, 1), a1 + hAc, vAc);
            PG8_WAIT_V(8); PG8_WAIT_L(0); PG8_BAR; PG8_MMA(0, 0, At, B0); PG8_MMA(0, 1, At, B1); PG8_BAR; PG8_SCHED;
            PG8_LDA(At, 0, 1); PG8_STAGE(PG8_SB(0, 0), b2, vB2); PG8_STAGE(PG8_SB(0, 1), b2 + hB2, vB2); PG8_STAGE(PG8_SA(0, 0), a2, vA2);
            PG8_WAIT_V(8); PG8_WAIT_L(0); PG8_BAR; PG8_MMA(1, 0, At, B0); PG8_MMA(1, 1, At, B1); PG8_BAR; PG8_SCHED;
            PG8_LDB(B0, 1, 0); PG8_LDB(B1, 1, 1); PG8_SCHED; PG8_LDA(At, 1, 0); PG8_STAGE(PG8_SA(0, 1), a2 + hA2, vA2);
            PG8_WAIT_V(8); PG8_WAIT_L(0); PG8_BAR; PG8_MMA(0, 0, At, B0); PG8_MMA(0, 1, At, B1); PG8_BAR; PG8_SCHED;
            PG8_LDA(At, 1, 1); PG8_STAGE(PG8_SB(1, 0), b3, vB2); PG8_STAGE(PG8_SB(1, 1), b3 + hB2, vB2); PG8_STAGE(PG8_SA(1, 0), a3, vA2);
            PG8_WAIT_V(8); PG8_WAIT_L(0); PG8_BAR; PG8_MMA(1, 0, At, B0); PG8_MMA(1, 1, At, B1); PG8_BAR; PG8_SCHED;
        }
        if (wr == 0) PG8_BAR;
        if (ui == 0) {
            E0(acc, u0, wr, wc, fr, fq);
#pragma unroll
            for (int a = 0; a < 2; ++a)
#pragma unroll
                for (int b = 0; b < 2; ++b)
#pragma unroll
                    for (int m = 0; m < 4; ++m)
#pragma unroll
                        for (int n = 0; n < 2; ++n) acc[a][b][m][n] = (f32x4){0.f, 0.f, 0.f, 0.f};
            if (wr == 1) PG8_BAR;
        } else E1(acc, u1, wr, wc, fr, fq);
    }
    PG8_WAIT_V(0);
    PG8_BAR;
#undef PG8_SA
#undef PG8_SB
#undef PG8_STAGE
#undef PG8_LDA
#undef PG8_LDB
#undef PG8_MMA
#undef PG8_WAIT_V
#undef PG8_WAIT_L
#undef PG8_BAR
#undef PG8_SCHED
}

#define EPI_FOR_ROWS _Pragma("unroll") for (int ai = 0; ai < 2; ++ai) _Pragma("unroll") for (int m = 0; m < 4; ++m)
#define EPI_ROWDEF const int rit = ai * HALF + wr * 64 + m * 16 + fr; const int row = u.pm * BM + rit; (void)rit; (void)row;

struct Epi1 {
    static constexpr bool AFTER_DRAIN = false;
    const float* rinv; const float* qnw; const float* knw; const float2* rope;
    bf16_t *Q, *Kb, *Vb, *GA, *GS, *UCAT; LAS float* xch; int pn0;
    __device__ __forceinline__ void operator()(const f32x4 (&acc)[2][2][4][2], const Unit& u, int wr, int wc, int, int) const {
        const int l_ = lane_id_opaque(), fr = l_ & 15, fq = l_ >> 4;
        const int pn = u.pn + pn0;
        if (pn <= 4) {
            float ss[2][4], rv[2][4];
            EPI_FOR_ROWS { EPI_ROWDEF const float r = rinv[row]; rv[ai][m] = r; float s = 0.f;
#pragma unroll
                for (int bj = 0; bj < 2; ++bj)
#pragma unroll
                    for (int n = 0; n < 2; ++n) { const f32x4 v = acc[ai][bj][m][n] * r; s += (v[0] * v[0] + v[1] * v[1]) + (v[2] * v[2] + v[3] * v[3]); }
                s += swz_xor<16>(s); s = sum_xor32(s); ss[ai][m] = s;
                if (fq == 0) xch[wc * 256 + rit] = s; }
            LDS_WAIT(); __builtin_amdgcn_s_barrier(); asm volatile("" ::: "memory");
            const int half = wc & 1, hd = wc >> 1;
            const float* nw = (pn < 4 ? qnw : knw) + 64 * half + 8 * fq;
            float w1[8], w2[8];
#pragma unroll
            for (int i = 0; i < 8; ++i) { w1[i] = nw[i]; w2[i] = nw[32 + i]; }
            EPI_FOR_ROWS { EPI_ROWDEF const float tot = ss[ai][m] + xch[(wc ^ 1) * 256 + rit];
                const float sc = rv[ai][m] * rsqrtf(tot * (1.f / 128.f) + EPS);
                const int t = row & (SEQ - 1); const int pos = half ? (t & 63) : (t >> 6);
                const float2* rp = rope + pos * 32 + 8 * fq;
                float o1[8], o2[8];
#pragma unroll
                for (int n = 0; n < 2; ++n)
#pragma unroll
                    for (int e = 0; e < 4; ++e) { const int i = 4 * n + e; const float2 cs = rp[i];
                        const float x1 = acc[ai][0][m][n][e] * sc * w1[i], x2 = acc[ai][1][m][n][e] * sc * w2[i];
                        o1[i] = x1 * cs.x - x2 * cs.y; o2[i] = x2 * cs.x + x1 * cs.y; }
                bf16_t* dst = (pn < 4) ? Q + (size_t)row * DATT + (2 * pn + hd) * 128 + 64 * half + 8 * fq : Kb + (size_t)row * DKV + hd * 128 + 64 * half + 8 * fq;
                u32x4 a; a.x = pk2(o1[0], o1[1]); a.y = pk2(o1[2], o1[3]); a.z = pk2(o1[4], o1[5]); a.w = pk2(o1[6], o1[7]);
                u32x4 b; b.x = pk2(o2[0], o2[1]); b.y = pk2(o2[2], o2[3]); b.z = pk2(o2[4], o2[5]); b.w = pk2(o2[6], o2[7]);
                *(u32x4*)dst = a; *(u32x4*)(dst + 32) = b; }
        } else {
            const int lg0 = 4 * (wc >> 1) + 2 * (wc & 1);
            EPI_FOR_ROWS { EPI_ROWDEF const float r = rinv[row];
#pragma unroll
                for (int bj = 0; bj < 2; ++bj) { const int L = 256 * pn + 32 * (lg0 + bj) + 8 * fq;
                    f32x4 v0 = acc[ai][bj][m][0] * r, v1 = acc[ai][bj][m][1] * r; bf16_t* dst;
                    if (pn == 5) dst = Vb + (size_t)row * DKV + (L - 1280);
                    else if (pn < 10) dst = GA + (size_t)row * DATT + (L - 1536);
                    else if (pn < 14) { const int Lu = L - 2560; dst = UCAT + ((size_t)(Lu >> 4) * NCH + (row >> 4)) * 512 + (row & 15) * 16 + (Lu & 15); }
                    else dst = GS + (size_t)row * DSSM + (L - 3584);
                    if ((pn >= 6 && pn < 10) || pn >= 14) {
#pragma unroll
                        for (int e = 0; e < 4; ++e) { v0[e] = siluf_(v0[e]); v1[e] = siluf_(v1[e]); } }
                    u32x4 w; w.x = pk2(v0[0], v0[1]); w.y = pk2(v0[2], v0[3]); w.z = pk2(v1[0], v1[1]); w.w = pk2(v1[2], v1[3]);
                    *(u32x4*)dst = w; } }
        }
    }
};
struct EpiS1 {
    static constexpr bool AFTER_DRAIN = true;
    const float* lb16; bf16_t* UCAT;
    __device__ __forceinline__ void operator()(const f32x4 (&)[2][2][4][2], const Unit&, int, int, int, int) const {}
    __device__ __forceinline__ void fused(const f32x4 (&acc)[2][2][4][2], const Unit& u, int wr, int wc, LAS unsigned char* lds, int wid) const {
        const int l_ = lane_id_opaque(), fr = l_ & 15, fq = l_ >> 4;
        LAS float* Tl = (LAS float*)lds;
#pragma unroll
        for (int d = 0; d < 2; ++d) {
            EPI_FOR_ROWS { const int rit = ai * HALF + wr * 64 + m * 16 + fr; LAS float* rp = Tl + rit * 128 + wc * 32 + 8 * fq;
                *(LAS f32x4*)rp = acc[ai][d][m][0]; *(LAS f32x4*)(rp + 4) = acc[ai][d][m][1]; }
            LDS_WAIT(); __builtin_amdgcn_s_barrier(); asm volatile("" ::: "memory");
            {
                const int p = l_; const float lr = lb16[((u.z * 2 + d) * 64 + p) * 2], li = lb16[((u.z * 2 + d) * 64 + p) * 2 + 1];
                LAS float* SEG = (LAS float*)(lds + XCH_OFF);
                float xr = 0.f, xi = 0.f;
#pragma unroll 8
                for (int i = 0; i < 32; ++i) { const int cc = wid * 32 + i, c = d ? 255 - cc : cc;
                    const float sr = Tl[c * 128 + p], si = Tl[c * 128 + 64 + p];
                    Tl[c * 128 + p] = xr; Tl[c * 128 + 64 + p] = xi;
                    const float nr = lr * xr - li * xi + sr; xi = lr * xi + li * xr + si; xr = nr; }
                SEG[(wid * 64 + p) * 2] = xr; SEG[(wid * 64 + p) * 2 + 1] = xi;
                LDS_WAIT(); __builtin_amdgcn_s_barrier(); asm volatile("" ::: "memory");
                float l32r = lr, l32i = li;
#pragma unroll
                for (int q = 0; q < 5; ++q) { const float t = l32r * l32r - l32i * l32i; l32i = 2.f * l32r * l32i; l32r = t; }
                float er = 0.f, ei = 0.f;
                for (int j = 0; j < wid; ++j) { const float tr = SEG[(j * 64 + p) * 2], ti = SEG[(j * 64 + p) * 2 + 1];
                    const float nr = l32r * er - l32i * ei + tr; ei = l32r * ei + l32i * er + ti; er = nr; }
#pragma unroll 8
                for (int i = 0; i < 32; ++i) { const int cc = wid * 32 + i, c = d ? 255 - cc : cc;
                    const float tr = Tl[c * 128 + p] + er, ti = Tl[c * 128 + 64 + p] + ei;
                    Tl[c * 128 + p] = __uint_as_float(pk2(tr, ti));
                    const float nr = lr * er - li * ei; ei = lr * ei + li * er; er = nr; }
            }
            LDS_WAIT(); __builtin_amdgcn_s_barrier(); asm volatile("" ::: "memory");
            {   bf16_t* ub = UCAT + ((size_t)u.z * NCH + u.pm * 256) * 512 + 256 + d * 128;
#pragma unroll
                for (int i = 0; i < 8; ++i) { const int q = wid * 64 + l_ + 512 * i, r = q >> 4, c8 = (q & 15) * 8;
                    *(u32x4*)(ub + (size_t)r * 512 + c8) = *(const LAS u32x4*)((LAS bf16_t*)(Tl + r * 128) + c8); } }
            LDS_WAIT(); __builtin_amdgcn_s_barrier(); asm volatile("" ::: "memory");
        }
    }
};
struct EpiS2 {
    static constexpr bool AFTER_DRAIN = false;
    bf16_t* YS;
    __device__ __forceinline__ void operator()(const f32x4 (&acc)[2][2][4][2], const Unit& u, int wr, int wc, int, int) const {
        const int l_ = lane_id_opaque(), fr = l_ & 15, fq = l_ >> 4;
        EPI_FOR_ROWS { EPI_ROWDEF
#pragma unroll
            for (int bj = 0; bj < 2; ++bj) { const int c = bj * HALF + wc * 32 + 8 * fq; const int j = c >> 4, h0 = c & 15;
                const f32x4 v0 = acc[ai][bj][m][0], v1 = acc[ai][bj][m][1];
                u32x4 w; w.x = pk2(gelu_tanh(v0[0]), gelu_tanh(v0[1])); w.y = pk2(gelu_tanh(v0[2]), gelu_tanh(v0[3])); w.z = pk2(gelu_tanh(v1[0]), gelu_tanh(v1[1])); w.w = pk2(gelu_tanh(v1[2]), gelu_tanh(v1[3]));
                *(u32x4*)(YS + ((size_t)row * 16 + j) * DSSM + u.z * 16 + h0) = w; } }
    }
};
struct EpiGlu {
    static constexpr bool AFTER_DRAIN = false;
    const float* bglu; const bf16_t* GS; bf16_t* YMIX;
    __device__ __forceinline__ void operator()(const f32x4 (&acc)[2][2][4][2], const Unit& u, int wr, int wc, int, int) const {
        const int l_ = lane_id_opaque(), fr = l_ & 15, fq = l_ >> 4;
        const int a0 = 128 * u.pn + 32 * wc + 8 * fq;
        float bv[8], bg[8];
#pragma unroll
        for (int i = 0; i < 8; ++i) { bv[i] = bglu[a0 + i]; bg[i] = bglu[1024 + a0 + i]; }
        u32x4 gsv[2][4];
        EPI_FOR_ROWS { EPI_ROWDEF gsv[ai][m] = __builtin_nontemporal_load((const u32x4*)(GS + (size_t)row * DSSM + a0)); }
        EPI_FOR_ROWS { EPI_ROWDEF const u32x4 gs = gsv[ai][m];
            float o[8];
#pragma unroll
            for (int n = 0; n < 2; ++n)
#pragma unroll
                for (int e = 0; e < 4; ++e) { const int i = 4 * n + e; o[i] = (acc[ai][0][m][n][e] + bv[i]) * sigmoidf_(acc[ai][1][m][n][e] + bg[i]); }
            o[0] *= bflo(gs.x); o[1] *= bfhi(gs.x); o[2] *= bflo(gs.y); o[3] *= bfhi(gs.y); o[4] *= bflo(gs.z); o[5] *= bfhi(gs.z); o[6] *= bflo(gs.w); o[7] *= bfhi(gs.w);
            u32x4 w; w.x = pk2(o[0], o[1]); w.y = pk2(o[2], o[3]); w.z = pk2(o[4], o[5]); w.w = pk2(o[6], o[7]);
            *(u32x4*)(YMIX + (size_t)row * DM + 1024 + a0) = w; }
    }
};
struct EpiBf {
    static constexpr bool AFTER_DRAIN = false;
    bf16_t* O; int ldc;
    __device__ __forceinline__ void operator()(const f32x4 (&acc)[2][2][4][2], const Unit& u, int wr, int wc, int, int) const {
        const int l_ = lane_id_opaque(), fr = l_ & 15, fq = l_ >> 4;
        EPI_FOR_ROWS { EPI_ROWDEF
#pragma unroll
            for (int bj = 0; bj < 2; ++bj) { const f32x4 v0 = acc[ai][bj][m][0], v1 = acc[ai][bj][m][1];
                u32x4 w; w.x = pk2(v0[0], v0[1]); w.y = pk2(v0[2], v0[3]); w.z = pk2(v1[0], v1[1]); w.w = pk2(v1[2], v1[3]);
                *(u32x4*)(O + (size_t)row * ldc + u.pn * BM + bj * HALF + wc * 32 + 8 * fq) = w; } }
    }
};
struct EpiOut {
    static constexpr bool AFTER_DRAIN = false;
    const float* x; float* H; bf16_t* HB; float* ssq;
    __device__ __forceinline__ void operator()(const f32x4 (&acc)[2][2][4][2], const Unit& u, int wr, int wc, int, int) const {
        const int l_ = lane_id_opaque(), fr = l_ & 15, fq = l_ >> 4;
#pragma unroll
        for (int ai = 0; ai < 2; ++ai) {
            f32x4 xv[4][2][2];
#pragma unroll
            for (int m = 0; m < 4; ++m) { EPI_ROWDEF
#pragma unroll
                for (int bj = 0; bj < 2; ++bj) { const size_t off = (size_t)row * DM + u.pn * BM + bj * HALF + wc * 32 + 8 * fq; xv[m][bj][0] = __builtin_nontemporal_load((const f32x4*)(x + off)); xv[m][bj][1] = __builtin_nontemporal_load((const f32x4*)(x + off + 4)); } }
#pragma unroll
            for (int m = 0; m < 4; ++m) { EPI_ROWDEF float s = 0.f;
#pragma unroll
                for (int bj = 0; bj < 2; ++bj) { const size_t off = (size_t)row * DM + u.pn * BM + bj * HALF + wc * 32 + 8 * fq;
                    const f32x4 v0 = acc[ai][bj][m][0] + xv[m][bj][0], v1 = acc[ai][bj][m][1] + xv[m][bj][1];
                    s += (v0[0] * v0[0] + v0[1] * v0[1]) + (v0[2] * v0[2] + v0[3] * v0[3]) + (v1[0] * v1[0] + v1[1] * v1[1]) + (v1[2] * v1[2] + v1[3] * v1[3]);
                    u32x4 w; w.x = pk2(v0[0], v0[1]); w.y = pk2(v0[2], v0[3]); w.z = pk2(v1[0], v1[1]); w.w = pk2(v1[2], v1[3]);
                    *(u32x4*)(HB + off) = w; }
                s += swz_xor<16>(s); s = sum_xor32(s);
                if (fq == 0) ssq[(size_t)row * 32 + u.pn * 4 + wc] = s; }
        }
    }
};
struct EpiGate {
    static constexpr bool AFTER_DRAIN = true;
    float* H; const bf16_t* PP; float* ssq; unsigned* cnt; const float* nf; const LAS float* r2; const bf16_t* HBr;
    __device__ __forceinline__ void operator()(const f32x4 (&)[2][2][4][2], const Unit&, int, int, int, int) const {}
    __device__ __forceinline__ void fused(f32x4 (&acc)[2][2][4][2], const Unit& u, int wr, int wc, LAS unsigned char* lds, int wid) const {
        const int l_ = lane_id_opaque(), fr = l_ & 15, fq = l_ >> 4, tid = wid * 64 + l_;
        LAS float* P = (LAS float*)lds; LAS float* Rn = P + 1024;
        EPI_FOR_ROWS { EPI_ROWDEF float s = 0.f; const float r = r2[rit];
#pragma unroll
            for (int bj = 0; bj < 2; ++bj) { const size_t off = (size_t)row * DM + u.pn * BM + bj * HALF + wc * 32 + 8 * fq;
                const u32x4 pp = __builtin_nontemporal_load((const u32x4*)(PP + off));
                const u32x4 hb = __builtin_nontemporal_load((const u32x4*)(HBr + off));
                f32x4 h0 = {bflo(hb.x), bfhi(hb.x), bflo(hb.y), bfhi(hb.y)}, h1 = {bflo(hb.z), bfhi(hb.z), bflo(hb.w), bfhi(hb.w)};
                const f32x4 a0 = acc[ai][bj][m][0] * r, a1 = acc[ai][bj][m][1] * r;
                h0[0] += sigmoidf_(a0[0]) * bflo(pp.x); h0[1] += sigmoidf_(a0[1]) * bfhi(pp.x); h0[2] += sigmoidf_(a0[2]) * bflo(pp.y); h0[3] += sigmoidf_(a0[3]) * bfhi(pp.y);
                h1[0] += sigmoidf_(a1[0]) * bflo(pp.z); h1[1] += sigmoidf_(a1[1]) * bfhi(pp.z); h1[2] += sigmoidf_(a1[2]) * bflo(pp.w); h1[3] += sigmoidf_(a1[3]) * bfhi(pp.w);
                acc[ai][bj][m][0] = h0; acc[ai][bj][m][1] = h1;
                s += (h0[0] * h0[0] + h0[1] * h0[1]) + (h0[2] * h0[2] + h0[3] * h0[3]) + (h1[0] * h1[0] + h1[1] * h1[1]) + (h1[2] * h1[2] + h1[3] * h1[3]); }
            s += swz_xor<16>(s); s = sum_xor32(s);
            if (fq == 0) P[rit * 4 + wc] = s; }
        LDS_WAIT(); __builtin_amdgcn_s_barrier(); asm volatile("" ::: "memory");
        if (tid < 256) { const float t = (P[tid * 4] + P[tid * 4 + 1]) + (P[tid * 4 + 2] + P[tid * 4 + 3]);
            __hip_atomic_store(ssq + (size_t)(u.pm * 256 + tid) * 8 + u.pn, t, __ATOMIC_RELAXED, __HIP_MEMORY_SCOPE_AGENT); }
        asm volatile("s_waitcnt vmcnt(0)" ::: "memory");
        if (wid < 4 && l_ == 0) __hip_atomic_fetch_add(cnt + 64 * u.pm, 1u, __ATOMIC_RELAXED, __HIP_MEMORY_SCOPE_AGENT);
        if (wid == 0) {
            unsigned sp = 0;
            while ((unsigned)__builtin_amdgcn_readfirstlane(__hip_atomic_load(cnt + 64 * u.pm, __ATOMIC_RELAXED, __HIP_MEMORY_SCOPE_AGENT)) < 32u) { __builtin_amdgcn_s_sleep(2); if (++sp > (1u << 22)) break; }
            __builtin_amdgcn_fence(__ATOMIC_ACQUIRE, "agent");
        }
        asm volatile("s_waitcnt vmcnt(0) lgkmcnt(0)" ::: "memory"); __builtin_amdgcn_s_barrier(); asm volatile("" ::: "memory");
        if (tid < 256) { const float* sp = ssq + (size_t)(u.pm * 256 + tid) * 8; float t = 0.f;
#pragma unroll
            for (int i = 0; i < 8; ++i) t += __hip_atomic_load(sp + i, __ATOMIC_RELAXED, __HIP_MEMORY_SCOPE_AGENT);
            Rn[tid] = rsqrtf(t * (1.f / DM) + EPS); }
        LDS_WAIT(); __builtin_amdgcn_s_barrier(); asm volatile("" ::: "memory");
        EPI_FOR_ROWS { EPI_ROWDEF const float rn = Rn[rit];
#pragma unroll
            for (int bj = 0; bj < 2; ++bj) { const int col = u.pn * BM + bj * HALF + wc * 32 + 8 * fq; const size_t off = (size_t)row * DM + col;
                *(f32x4*)(H + off) = acc[ai][bj][m][0] * rn * *(const f32x4*)(nf + col); *(f32x4*)(H + off + 4) = acc[ai][bj][m][1] * rn * *(const f32x4*)(nf + col + 4); } }
    }
};
}

namespace att {
constexpr int D = 128, NW = 8, QBLK = 32, KVBLK = 64;
constexpr float SCALE = 0.088388347648318440f;
constexpr float THR = 8.f;
constexpr int LDQ = DATT, LDK = DKV;
constexpr size_t SHM_V = KVBLK * D * 2, SHM_K = KVBLK * D * 2, SHM_ATTN = 2 * SHM_V + 2 * SHM_K + NW * 64 * 4;
#define KSWZ(row, colB) ((row) * 256 + ((colB) ^ (((row) & 7) << 4)))
#define SBAR() __builtin_amdgcn_sched_barrier(0)
__device__ __forceinline__ int crow(int r, int hi) { return (r & 3) + 8 * (r >> 2) + 4 * hi; }
__device__ __forceinline__ void partialSM(f32x16& p0, f32x16& p1, float& m_reg, float& mn, float& alpha) {
  constexpr float C = SCALE * 1.4426950408889634f;
  float pmax = p0[0]; for (int r = 1; r < 16; ++r) pmax = fmaxf(pmax, p0[r]); for (int r = 0; r < 16; ++r) pmax = fmaxf(pmax, p1[r]);
  { auto rr = __builtin_amdgcn_permlane32_swap(__float_as_uint(pmax), __float_as_uint(pmax), false, false);
    pmax = fmaxf(__uint_as_float(rr[0]), __uint_as_float(rr[1])); }
  if (__builtin_expect(__all(pmax - m_reg <= THR / SCALE), 1)) { mn = m_reg; alpha = 1.f; }
  else { mn = fmaxf(m_reg, pmax); alpha = __builtin_amdgcn_exp2f((m_reg - mn) * C); m_reg = mn; }
  float mnC = -mn * C;
  for (int r = 0; r < 16; ++r) p0[r] = fmaf(p0[r], C, mnC); for (int r = 0; r < 16; ++r) p1[r] = fmaf(p1[r], C, mnC);
  for (int r = 0; r < 16; ++r) p0[r] = __builtin_amdgcn_exp2f(p0[r]);
}
__device__ __forceinline__ void finishSM(f32x16& p0, f32x16& p1, float alpha, float& l_reg, bf16x8& pa0, bf16x8& pa1, bf16x8& pa2, bf16x8& pa3) {
  for (int r = 0; r < 16; ++r) p1[r] = __builtin_amdgcn_exp2f(p1[r]);
  float ps = 0; for (int r = 0; r < 16; ++r) ps += p0[r]; for (int r = 0; r < 16; ++r) ps += p1[r];
  { auto rr = __builtin_amdgcn_permlane32_swap(__float_as_uint(ps), __float_as_uint(ps), false, false);
    ps = __uint_as_float(rr[0]) + __uint_as_float(rr[1]); }
  l_reg = l_reg * alpha + ps;
#define PK4(P, BASE, OUT) do { unsigned a0 = cvt_pk_bf16(P[BASE + 0], P[BASE + 1]), a1 = cvt_pk_bf16(P[BASE + 2], P[BASE + 3]);   \
    unsigned b0 = cvt_pk_bf16(P[BASE + 4], P[BASE + 5]), b1 = cvt_pk_bf16(P[BASE + 6], P[BASE + 7]);                              \
    auto r0 = __builtin_amdgcn_permlane32_swap(a0, b0, false, false); auto r1 = __builtin_amdgcn_permlane32_swap(a1, b1, false, false); \
    u32x4 w = {r0[0], r1[0], r0[1], r1[1]}; OUT = *reinterpret_cast<bf16x8*>(&w); } while (0)
  PK4(p0, 0, pa0); PK4(p0, 8, pa1); PK4(p1, 0, pa2); PK4(p1, 8, pa3);
#undef PK4
}
__device__ __forceinline__ void qkt(f32x16& p0, f32x16& p1, const bf16_t* Ks, const bf16x8* qr, int r32, int hi) {
  p0 = f32x16{}; p1 = f32x16{};
  for (int d0 = 0; d0 < 8; ++d0) { int cb = (d0 * 16 + hi * 8) * 2;
    bf16x8 b0 = *reinterpret_cast<const bf16x8*>((const char*)Ks + KSWZ(r32, cb));
    bf16x8 b1 = *reinterpret_cast<const bf16x8*>((const char*)Ks + KSWZ(32 + r32, cb));
    p0 = __builtin_amdgcn_mfma_f32_32x32x16_bf16(b0, qr[d0], p0, 0, 0, 0);
    p1 = __builtin_amdgcn_mfma_f32_32x32x16_bf16(b1, qr[d0], p1, 0, 0, 0); }
}
__device__ __forceinline__ int v_st(int k, int c) { const int kk = (k & ~0xC) | ((k & 4) << 1) | ((k & 8) >> 1); return ((kk >> 3) * 4 + (c >> 5)) * 512 + ((kk & 7) * 32 + (c & 31)) * 2; }
__device__ __forceinline__ int v_rd_base(int lane) { return ((lane & 3) << 3) | (((lane >> 2) & 3) << 6) | (((lane >> 4) & 1) << 5) | (((lane >> 5) & 1) << 8); }
constexpr int v_rd_off(int d0, int ks, int half) { return d0 * 512 + ks * 4096 + half * 2048; }
template <int OFF> __device__ __forceinline__ s16x4 tr_read(int vb) {
  s16x4 r; asm volatile("ds_read_b64_tr_b16 %0, %1 offset:%2" : "=&v"(r) : "v"(vb), "i"(OFF) : "memory"); return r;
}
template <int D0> __device__ __forceinline__ void pv_one(f32x16& od, int vb, bf16x8 pa0, bf16x8 pa1, bf16x8 pa2, bf16x8 pa3) {
  const s16x4 l0 = tr_read<v_rd_off(D0, 0, 0)>(vb), h0 = tr_read<v_rd_off(D0, 0, 1)>(vb), l1 = tr_read<v_rd_off(D0, 1, 0)>(vb), h1 = tr_read<v_rd_off(D0, 1, 1)>(vb);
  const s16x4 l2 = tr_read<v_rd_off(D0, 2, 0)>(vb), h2 = tr_read<v_rd_off(D0, 2, 1)>(vb), l3 = tr_read<v_rd_off(D0, 3, 0)>(vb), h3 = tr_read<v_rd_off(D0, 3, 1)>(vb);
  asm volatile("s_waitcnt lgkmcnt(0)" ::: "memory"); SBAR();
#define PK(L, H) (bf16x8){L[0], L[1], L[2], L[3], H[0], H[1], H[2], H[3]}
  od = __builtin_amdgcn_mfma_f32_32x32x16_bf16(pa0, PK(l0, h0), od, 0, 0, 0);
  od = __builtin_amdgcn_mfma_f32_32x32x16_bf16(pa1, PK(l1, h1), od, 0, 0, 0);
  od = __builtin_amdgcn_mfma_f32_32x32x16_bf16(pa2, PK(l2, h2), od, 0, 0, 0);
  od = __builtin_amdgcn_mfma_f32_32x32x16_bf16(pa3, PK(l3, h3), od, 0, 0, 0);
#undef PK
}
__device__ __forceinline__ void pv_d0(f32x16* o, int vb, bf16x8 pa0, bf16x8 pa1, bf16x8 pa2, bf16x8 pa3) {
  pv_one<0>(o[0], vb, pa0, pa1, pa2, pa3); pv_one<1>(o[1], vb, pa0, pa1, pa2, pa3); pv_one<2>(o[2], vb, pa0, pa1, pa2, pa3); pv_one<3>(o[3], vb, pa0, pa1, pa2, pa3);
}
__device__ __forceinline__ void attn_dense_body(const bf16_t* __restrict__ Qb, const bf16_t* __restrict__ Kh, const bf16_t* __restrict__ Vh,
                                                const bf16_t* __restrict__ Gb, bf16_t* __restrict__ Yb, int seq, char* lds, const int wid) {
  const int lane = lane_id_opaque(), tid = wid * 64 + lane, r32 = lane & 31, hi = lane >> 5;
  bf16_t* V_lds = (bf16_t*)lds; bf16_t* K_lds = (bf16_t*)(lds + 2 * SHM_V);
  float* ws = (float*)(lds + 2 * SHM_V + 2 * SHM_K) + wid * 64; float* li_l = ws; float* al_l = ws + 32;
  float m_reg = -1e30f, l_reg = 0; f32x16 o[4] = {}; bf16x8 qr[8];
  const bf16_t* Qw = Qb + (long)(wid * QBLK + r32) * LDQ + hi * 8;
#pragma unroll
  for (int d0 = 0; d0 < 8; ++d0) qr[d0] = __builtin_nontemporal_load(reinterpret_cast<const bf16x8*>(Qw + d0 * 16));
  const int sr = tid >> 4, sc = (tid & 15) * 8, vst0 = v_st(sr, sc), vst1 = v_st(32 + sr, sc);
  const int vb0 = (int)(uintptr_t)V_lds + v_rd_base(lane);
  struct { bf16x8 vs0, vs1, ks0, ks1; } sr_[2];
#define SLOAD(i, k0) do { sr_[i].vs0 = *reinterpret_cast<const bf16x8*>(&Vh[(long)((k0) + sr) * LDK + sc]); sr_[i].vs1 = *reinterpret_cast<const bf16x8*>(&Vh[(long)((k0) + 32 + sr) * LDK + sc]); \
    sr_[i].ks0 = *reinterpret_cast<const bf16x8*>(&Kh[(long)((k0) + sr) * LDK + sc]); sr_[i].ks1 = *reinterpret_cast<const bf16x8*>(&Kh[(long)((k0) + 32 + sr) * LDK + sc]); } while (0)
#define SWRITE(b, i) do { *(bf16x8*)((char*)V_lds + (b) * SHM_V + vst0) = sr_[i].vs0;          \
    *(bf16x8*)((char*)V_lds + (b) * SHM_V + vst1) = sr_[i].vs1; int kc = sc * 2;               \
    *(bf16x8*)((char*)K_lds + (b) * SHM_K + KSWZ(sr, kc)) = sr_[i].ks0;                       \
    *(bf16x8*)((char*)K_lds + (b) * SHM_K + KSWZ(32 + sr, kc)) = sr_[i].ks1; } while (0)
#define SWAIT() asm volatile("s_waitcnt vmcnt(4)" ::: "memory")
#define RESC(a) do { if (__any((a) < 1.f)) { if (hi == 0) al_l[r32] = (a); asm volatile("s_waitcnt lgkmcnt(0)" ::: "memory"); \
    for (int d = 0; d < 4; ++d) for (int r = 0; r < 16; ++r) o[d][r] *= al_l[crow(r, hi)]; } } while (0)
  f32x16 pA0, pA1, pB0, pB1; float mnA, mnB, alA, alB; bf16x8 pa0, pa1, pa2, pa3; const int NT = seq / KVBLK;
  constexpr int SE = 0, SO = 1;
  SLOAD(SE, 0); asm volatile("s_waitcnt vmcnt(0)" ::: "memory"); SWRITE(0, SE); __syncthreads();
  qkt(pA0, pA1, K_lds, qr, r32, hi); partialSM(pA0, pA1, m_reg, mnA, alA);
  SLOAD(SO, KVBLK); if (2 < NT) SLOAD(SE, 2 * KVBLK);
  SWAIT(); SWRITE(1, SO); __syncthreads();
  for (int j = 1; j + 1 < NT; j += 2) {
    SBAR(); qkt(pB0, pB1, (bf16_t*)((char*)K_lds + SHM_K), qr, r32, hi);
    finishSM(pA0, pA1, alA, l_reg, pa0, pa1, pa2, pa3); SBAR();
    SLOAD(SO, (j + 2) * KVBLK); SBAR();
    pv_d0(o, vb0, pa0, pa1, pa2, pa3); partialSM(pB0, pB1, m_reg, mnB, alB);
    __syncthreads(); SWAIT(); SWRITE(0, SE);
    RESC(alB); __syncthreads();
    SBAR(); qkt(pA0, pA1, K_lds, qr, r32, hi);
    finishSM(pB0, pB1, alB, l_reg, pa0, pa1, pa2, pa3); SBAR();
    if (j + 3 < NT) SLOAD(SE, (j + 3) * KVBLK); SBAR();
    pv_d0(o, vb0 + (int)SHM_V, pa0, pa1, pa2, pa3); partialSM(pA0, pA1, m_reg, mnA, alA);
    __syncthreads(); SWAIT(); SWRITE(1, SO);
    RESC(alA); __syncthreads();
  }
  SBAR(); qkt(pB0, pB1, (bf16_t*)((char*)K_lds + SHM_K), qr, r32, hi);
  finishSM(pA0, pA1, alA, l_reg, pa0, pa1, pa2, pa3); SBAR();
  pv_d0(o, vb0, pa0, pa1, pa2, pa3); partialSM(pB0, pB1, m_reg, mnB, alB);
  __syncthreads(); RESC(alB);
  finishSM(pB0, pB1, alB, l_reg, pa0, pa1, pa2, pa3); SBAR();
  pv_d0(o, vb0 + (int)SHM_V, pa0, pa1, pa2, pa3);
  if (hi == 0) li_l[r32] = l_reg; asm volatile("s_waitcnt lgkmcnt(0)" ::: "memory");
  float rli[16];
#pragma unroll
  for (int r = 0; r < 16; ++r) rli[r] = __builtin_amdgcn_rcpf(li_l[crow(r, hi)]);
  bf16_t* Yw = Yb + (long)(wid * QBLK) * DM; const bf16_t* Gw = Gb + (long)(wid * QBLK) * DATT;
  __syncthreads();
  bf16_t* stg = (bf16_t*)(lds + wid * 8192);
#pragma unroll
  for (int r = 0; r < 16; ++r) { const int orow = crow(r, hi);
#pragma unroll
    for (int d0 = 0; d0 < 4; ++d0) stg[orow * 128 + d0 * 32 + r32] = (bf16_t)f2bf(o[d0][r] * rli[r]); }
  asm volatile("s_waitcnt lgkmcnt(0)" ::: "memory");
  const int l2 = lane_id_opaque();
#pragma unroll
  for (int i = 0; i < 8; ++i) { const int q = l2 + 64 * i, row = q >> 4, c8 = (q & 15) * 8;
    const u32x4 v = *(const u32x4*)(stg + row * 128 + c8); const u32x4 gg = __builtin_nontemporal_load((const u32x4*)(Gw + (unsigned)(row * DATT + c8)));
    u32x4 w; w.x = pk2(bflo(v.x) * bflo(gg.x), bfhi(v.x) * bfhi(gg.x)); w.y = pk2(bflo(v.y) * bflo(gg.y), bfhi(v.y) * bfhi(gg.y));
    w.z = pk2(bflo(v.z) * bflo(gg.z), bfhi(v.z) * bfhi(gg.z)); w.w = pk2(bflo(v.w) * bflo(gg.w), bfhi(v.w) * bfhi(gg.w));
    *(u32x4*)(Yw + (unsigned)(row * DM + c8)) = w; }
  __syncthreads();
#undef SLOAD
#undef SWRITE
#undef SWAIT
#undef RESC
}
#undef SBAR
}

__device__ __forceinline__ void p0_transpose_item(const float* W, int K, int N, bf16_t* WT, int wt_row0, const float* kscale, LAS float* scr, int k0, int n0, int lane) {
#pragma unroll
    for (int i = 0; i < 32; ++i) { const int kk = 2 * i + (lane >> 5); float v = W[(size_t)(k0 + kk) * N + n0 + (lane & 31)]; if (kscale) v *= kscale[k0 + kk]; scr[kk * 33 + (lane & 31)] = v; }
    LDS_WAIT(); asm volatile("" ::: "memory");
    const int c = lane & 7;
#pragma unroll
    for (int j = 0; j < 4; ++j) { const int n = (lane >> 3) + 8 * j; const LAS float* s = scr + (8 * c) * 33 + n;
        u32x4 o; o.x = pk2(s[0 * 33], s[1 * 33]); o.y = pk2(s[2 * 33], s[3 * 33]); o.z = pk2(s[4 * 33], s[5 * 33]); o.w = pk2(s[6 * 33], s[7 * 33]);
        *(u32x4*)(WT + (size_t)(wt_row0 + n) * K + k0 + 8 * c) = o; }
    LDS_WAIT(); asm volatile("" ::: "memory");
}

struct TrItem { const float* W; bf16_t* WT; const float* kscale; int K, N, wt_row0, k0, n0; };
__device__ __forceinline__ void p0_tr_load(const TrItem& d, float (&v)[32], int lane) {
#pragma unroll
    for (int i = 0; i < 32; ++i) { const int kk = 2 * i + (lane >> 5); v[i] = __builtin_nontemporal_load(d.W + (size_t)(d.k0 + kk) * d.N + d.n0 + (lane & 31)); }
    if (d.kscale) {
#pragma unroll
        for (int i = 0; i < 32; ++i) { const int kk = 2 * i + (lane >> 5); v[i] *= d.kscale[d.k0 + kk]; } }
}
__device__ __forceinline__ void p0_tr_store(const TrItem& d, const float (&v)[32], LAS float* scr, int lane) {
#pragma unroll
    for (int i = 0; i < 32; ++i) { const int kk = 2 * i + (lane >> 5); scr[kk * 33 + (lane & 31)] = v[i]; }
    LDS_WAIT(); asm volatile("" ::: "memory");
    const int c = lane & 7;
#pragma unroll
    for (int j = 0; j < 4; ++j) { const int n = (lane >> 3) + 8 * j; const LAS float* s = scr + (8 * c) * 33 + n;
        u32x4 o; o.x = pk2(s[0 * 33], s[1 * 33]); o.y = pk2(s[2 * 33], s[3 * 33]); o.z = pk2(s[4 * 33], s[5 * 33]); o.w = pk2(s[6 * 33], s[7 * 33]);
        *(u32x4*)(d.WT + (size_t)(d.wt_row0 + n) * d.K + d.k0 + 8 * c) = o; }
    LDS_WAIT(); asm volatile("" ::: "memory");
}
__device__ __forceinline__ void ssm_tables(const Args& a, int g, LAS unsigned char* lds, int tid) {
    LAS float* LD = (LAS float*)lds;
    LAS float* LBs = LD + 256;
    LAS float* BB = LBs + 256;
    LAS float* KT = BB + 4096;
    LAS float* CC = KT + 8192;
    float* lb16 = (float*)(a.ws + WS_LB16);
    bf16_t* WIN = (bf16_t*)(a.ws + WS_WIN) + (size_t)g * 256 * 256;
    bf16_t* WBIG = (bf16_t*)(a.ws + WS_WBIG) + (size_t)g * 256 * 512;
    LAS float* DD = CC + 4096;
    float cre_[4], cim_[4], bre_[4], bim_[4];
#pragma unroll
    for (int k = 0; k < 4; ++k) { const int e = tid + 512 * k; const int d = e >> 10, r = e & 1023; const size_t ci_ = (size_t)(d * NG + g) * 1024 + r; cre_[k] = a.c_re[ci_]; cim_[k] = a.c_im[ci_];
        const int dp = e >> 4, h = e & 15, d2 = dp >> 6, p2 = dp & 63; const size_t bi_ = ((size_t)(d2 * NG + g) * 64 + p2) * 16 + h; bre_[k] = a.b_re[bi_]; bim_[k] = a.b_im[bi_]; }
    const float dld = a.ssm_d[g * 16 + (tid & 15)];
    const int d_a = (tid >> 6) & 1, p_a = tid & 63, idx_a = (d_a * NG + g) * 64 + p_a;
    const float are_ = a.a_re[idx_a], aim_ = a.a_im[idx_a], ldt_ = a.log_dt[d_a * NG + g];
#pragma unroll
    for (int k = 0; k < 4; ++k) { const int e = tid + 512 * k; CC[e * 2] = cre_[k]; CC[e * 2 + 1] = cim_[k]; }
    if (tid < 16) DD[tid] = dld;
    if (tid < 128) {
        const float lr = fminf(are_, -1e-4f), li = aim_;
        const float dt = expf(ldt_);
        const float er = expf(lr * dt); float sn, cs; sincosf(li * dt, &sn, &cs);
        const float br = er * cs, bi = er * sn;
        LD[tid * 2] = lr * dt; LD[tid * 2 + 1] = li * dt; LBs[tid * 2] = br; LBs[tid * 2 + 1] = bi;
        const float nr = br - 1.f, ni = bi, den = lr * lr + li * li;
        KT[tid * 2] = (nr * lr + ni * li) / den; KT[tid * 2 + 1] = (ni * lr - nr * li) / den;
        const float e16 = expf(16.f * lr * dt); float s16, c16; sincosf(16.f * li * dt, &s16, &c16);
        lb16[(g * 128 + tid) * 2] = e16 * c16; lb16[(g * 128 + tid) * 2 + 1] = e16 * s16;
    }
    __syncthreads();
#pragma unroll
    for (int k = 0; k < 4; ++k) { const int e = tid + 512 * k; const int dp = e >> 4;
        const float xr = bre_[k], xi = bim_[k], cr = KT[dp * 2], ci = KT[dp * 2 + 1];
        BB[e * 2] = cr * xr - ci * xi; BB[e * 2 + 1] = cr * xi + ci * xr;
    }
    __syncthreads();
    {
        const int d = tid >> 8, hp = (tid >> 4) & 15, h = tid & 15; float acc[16];
#pragma unroll
        for (int t = 0; t < 16; ++t) acc[t] = 0.f;
        const LAS float* cc = CC + ((d * 16 + hp) * 64) * 2;
#pragma unroll 4
        for (int p = 0; p < 64; ++p) {
            const float c_r = cc[p * 2], c_i = cc[p * 2 + 1], b_r = BB[((d * 64 + p) * 16 + h) * 2], b_i = BB[((d * 64 + p) * 16 + h) * 2 + 1];
            float wr = c_r * b_r - c_i * b_i, wi = c_r * b_i + c_i * b_r; const float l_r = LBs[(d * 64 + p) * 2], l_i = LBs[(d * 64 + p) * 2 + 1];
#pragma unroll
            for (int t = 0; t < 16; ++t) { acc[t] += wr; const float nr = wr * l_r - wi * l_i; wi = wr * l_i + wi * l_r; wr = nr; }
        }
#pragma unroll
        for (int t = 0; t < 16; ++t) KT[((d * 16 + t) * 16 + hp) * 16 + h] = acc[t];
    }
    __syncthreads();
    for (int q = tid; q < 8192; q += 512) {
        const int n = q >> 5, kc = q & 31, s = kc >> 1, h0 = (kc & 1) * 8, j = n >> 4, hp = n & 15;
        const int dsel = s < j ? 0 : 1, tau = s < j ? j - s : s - j;
        const LAS float* k0 = KT + ((dsel * 16 + tau) * 16 + hp) * 16 + h0;
        const LAS float* kf = KT + ((0 * 16 + 0) * 16 + hp) * 16 + h0; const LAS float* kb = KT + ((1 * 16 + 0) * 16 + hp) * 16 + h0;
        const bool diag = (s == j); const float dval = DD[hp];
        float v[8];
#pragma unroll
        for (int e = 0; e < 8; ++e) { const float off = k0[e], dg = kf[e] + kb[e] + ((h0 + e) == hp ? dval : 0.f); v[e] = diag ? dg : off; }
        u32x4 w; w.x = pk2(v[0], v[1]); w.y = pk2(v[2], v[3]); w.z = pk2(v[4], v[5]); w.w = pk2(v[6], v[7]);
        *(u32x4*)(WBIG + (size_t)n * 512 + s * 16 + h0) = w;
    }
    for (int q = tid; q < 2048; q += 512) {
        const int p = q & 63, js = (q >> 6) & 15, d = q >> 10; const float ldr = LD[(d * 64 + p) * 2], ldi = LD[(d * 64 + p) * 2 + 1];
        {   const float pw = (float)(d == 0 ? js + 1 : 16 - js); const float er = __expf(pw * ldr); float sn, cs; __sincosf(pw * ldi, &sn, &cs); const float pr = er * cs, pi = er * sn;
#pragma unroll
            for (int hp = 0; hp < 16; ++hp) { const float c_r = CC[((d * 16 + hp) * 64 + p) * 2], c_i = CC[((d * 16 + hp) * 64 + p) * 2 + 1];
                *(unsigned*)(WBIG + (size_t)(js * 16 + hp) * 512 + 256 + d * 128 + 2 * p) = pk2(c_r * pr - c_i * pi, -(c_r * pi + c_i * pr)); } }
        {   const float pw = (float)(d == 0 ? 15 - js : js); const float er = __expf(pw * ldr); float sn, cs; __sincosf(pw * ldi, &sn, &cs); const float pr = er * cs, pi = er * sn;
            float zr[16], zi[16];
#pragma unroll
            for (int h = 0; h < 16; ++h) { const float b_r = BB[((d * 64 + p) * 16 + h) * 2], b_i = BB[((d * 64 + p) * 16 + h) * 2 + 1]; zr[h] = pr * b_r - pi * b_i; zi[h] = pr * b_i + pi * b_r; }
            bf16_t* d0 = WIN + (size_t)(d * 128 + p) * 256 + js * 16; bf16_t* d1 = d0 + (size_t)64 * 256;
            u32x4 w; w.x = pk2(zr[0], zr[1]); w.y = pk2(zr[2], zr[3]); w.z = pk2(zr[4], zr[5]); w.w = pk2(zr[6], zr[7]); *(u32x4*)d0 = w;
            w.x = pk2(zr[8], zr[9]); w.y = pk2(zr[10], zr[11]); w.z = pk2(zr[12], zr[13]); w.w = pk2(zr[14], zr[15]); *(u32x4*)(d0 + 8) = w;
            w.x = pk2(zi[0], zi[1]); w.y = pk2(zi[2], zi[3]); w.z = pk2(zi[4], zi[5]); w.w = pk2(zi[6], zi[7]); *(u32x4*)d1 = w;
            w.x = pk2(zi[8], zi[9]); w.y = pk2(zi[10], zi[11]); w.z = pk2(zi[12], zi[13]); w.w = pk2(zi[14], zi[15]); *(u32x4*)(d1 + 8) = w; }
    }
    __syncthreads();
}

#define XB_TMO      128
#define XB_XCNT(j)  (256  + 64 * (j))
#define XB_XSUB(j)  (1280 + 64 * (j))
#define XB_XGEN(j)  (2304 + 64 * (j))
#define XB_TOP      3328
#define XB_TOPGEN   3392
#define XCD_BAR_WORDS 3456
#define XB_SPIN_CAP (1u << 18)
__device__ __forceinline__ unsigned xb_ld(unsigned* p)              { return __hip_atomic_load(p, __ATOMIC_RELAXED, __HIP_MEMORY_SCOPE_AGENT); }
__device__ __forceinline__ unsigned xb_add(unsigned* p, unsigned v) { return __hip_atomic_fetch_add(p, v, __ATOMIC_RELAXED, __HIP_MEMORY_SCOPE_AGENT); }
__device__ __forceinline__ unsigned xb_xcc_id() { return (unsigned)__builtin_amdgcn_s_getreg((3 << 11) | 20) & 0xFu; }
#define XB_SPIN(cond, bar) do { unsigned _sp = 0; while (cond) { __builtin_amdgcn_s_sleep(1); \
    if ((++_sp & 255u) == 0u) { if (xb_ld(&(bar)[XB_TMO])) break; if (_sp > XB_SPIN_CAP) { atomicAdd(&(bar)[XB_TMO], 1u); break; } } } } while (0)
struct XcdBarrier { unsigned* bar; unsigned x; volatile LAS unsigned* st; };
__device__ __forceinline__ XcdBarrier xcd_barrier_post(unsigned* bar, volatile LAS unsigned* st, bool leader) {
    XcdBarrier b; b.bar = bar; b.x = xb_xcc_id(); b.st = st;
    if (leader) (void)xb_add(&bar[XB_XCNT(b.x)], 1u);
    return b;
}
__device__ __forceinline__ void xcd_barrier_complete(unsigned* bar, unsigned x, unsigned& nloc, unsigned& nx) {
    const unsigned G = gridDim.x * gridDim.y * gridDim.z;
    unsigned sum, cnt, mine, sp = 0u;
    for (;;) {
        sum = 0u; cnt = 0u; mine = 0u;
#pragma unroll
        for (unsigned j = 0; j < 16; ++j) { const unsigned c = xb_ld(&bar[XB_XCNT(j)]); sum += c; cnt += (c > 0u) ? 1u : 0u; mine = (j == x) ? c : mine; }
        if (sum == G) break;
        __builtin_amdgcn_s_sleep(1);
        if ((++sp & 255u) == 0u) { if (xb_ld(&bar[XB_TMO])) break; if (sp > XB_SPIN_CAP) { atomicAdd(&bar[XB_TMO], 1u); break; } }
    }
    nloc = mine > 0u ? mine : 1u; nx = cnt > 0u ? cnt : 1u;
}
__device__ __forceinline__ void xcd_barrier(const XcdBarrier& b, bool leader) {
    asm volatile("s_waitcnt vmcnt(0)" ::: "memory");
    __syncthreads();
    if (leader) {
        unsigned* bar = b.bar;
        __builtin_amdgcn_s_waitcnt(0);
        unsigned nloc = b.st[0], nx = b.st[1];
        if (nloc == 0u) { xcd_barrier_complete(bar, b.x, nloc, nx); b.st[0] = nloc; b.st[1] = nx; }
        const unsigned old = xb_add(&bar[XB_XSUB(b.x)], 1u);
        const unsigned gen = old / nloc;
        if (old + 1u == (gen + 1u) * nloc) {
            __builtin_amdgcn_fence(__ATOMIC_RELEASE, "agent");
            asm volatile("s_waitcnt vmcnt(0)" ::: "memory");
            const unsigned og = xb_add(&bar[XB_TOP], 1u);
            const unsigned tg = og / nx;
            if (og + 1u == (tg + 1u) * nx) xb_add(&bar[XB_TOPGEN], 1u);
            else XB_SPIN(xb_ld(&bar[XB_TOPGEN]) == tg, bar);
            __builtin_amdgcn_fence(__ATOMIC_ACQUIRE, "agent");
            xb_add(&bar[XB_XGEN(b.x)], 1u);
            asm volatile("s_waitcnt vmcnt(0)" ::: "memory");
        } else {
            XB_SPIN(xb_ld(&bar[XB_XGEN(b.x)]) == gen, bar);
            __builtin_amdgcn_fence(__ATOMIC_ACQUIRE, "agent");
            asm volatile("s_waitcnt vmcnt(0)" ::: "memory");
        }
    }
    __syncthreads();
}

__device__ __forceinline__ void xcd_barrier_arrive(const XcdBarrier& b, bool leader) {
    asm volatile("s_waitcnt vmcnt(0)" ::: "memory");
    __syncthreads();
    if (leader) {
        unsigned* bar = b.bar;
        __builtin_amdgcn_s_waitcnt(0);
        unsigned nloc = b.st[0], nx = b.st[1];
        if (nloc == 0u) { xcd_barrier_complete(bar, b.x, nloc, nx); b.st[0] = nloc; b.st[1] = nx; }
        const unsigned old = xb_add(&bar[XB_XSUB(b.x)], 1u);
        const unsigned gen = old / nloc;
        if (old + 1u == (gen + 1u) * nloc) {
            __builtin_amdgcn_fence(__ATOMIC_RELEASE, "agent");
            asm volatile("s_waitcnt vmcnt(0)" ::: "memory");
            const unsigned og = xb_add(&bar[XB_TOP], 1u);
            const unsigned tg = og / nx;
            if (og + 1u == (tg + 1u) * nx) { xb_add(&bar[XB_TOPGEN], 1u); b.st[5] = 3u; } else b.st[5] = 2u;
            b.st[6] = tg;
        } else { b.st[5] = 1u; b.st[6] = gen; }
    }
}
__device__ __forceinline__ void xcd_barrier_wait(const XcdBarrier& b, bool leader) {
    if (leader) {
        unsigned* bar = b.bar; const unsigned role = b.st[5], g = b.st[6];
        if (role >= 2u) {
            if (role == 2u) XB_SPIN(xb_ld(&bar[XB_TOPGEN]) == g, bar);
            __builtin_amdgcn_fence(__ATOMIC_ACQUIRE, "agent");
            xb_add(&bar[XB_XGEN(b.x)], 1u);
            asm volatile("s_waitcnt vmcnt(0)" ::: "memory");
        } else {
            XB_SPIN(xb_ld(&bar[XB_XGEN(b.x)]) == g, bar);
            __builtin_amdgcn_fence(__ATOMIC_ACQUIRE, "agent");
            asm volatile("s_waitcnt vmcnt(0)" ::: "memory");
        }
    }
    __syncthreads();
}

__global__ void __launch_bounds__(512, 2) fwd_kernel(Args a) {
    extern __shared__ __attribute__((aligned(16))) unsigned char lds_raw[];
    LAS unsigned char* lds = (LAS unsigned char*)lds_raw;
    cg::grid_group grid = cg::this_grid();
    const int wave = __builtin_amdgcn_readfirstlane(threadIdx.x >> 6);
    const bool leader = (wave == 0) && (lane_id_opaque() == 0);
    volatile LAS unsigned* xst = (volatile LAS unsigned*)(lds + XBST_OFF);
    if (leader) { xst[0] = 0u; xst[1] = 0u; }
    __syncthreads();
    if (a.ws == nullptr) grid.sync();
    const XcdBarrier xbar = xcd_barrier_post((unsigned*)(a.ws + WS_BAR), xst, leader);
#define GRID_SYNC() xcd_barrier(xbar, (wave == 0) && (lane_id_opaque() == 0))
#define LANE_IDS const int lane = lane_id_opaque(), tid = wave * 64 + lane; (void)tid;
    const int G = gridDim.x, bid = blockIdx.x;
    unsigned char* ws = a.ws;
    bf16_t* W1T = (bf16_t*)(ws + WS_W1T); bf16_t* WGLUT = (bf16_t*)(ws + WS_WGLUT); bf16_t* WOT = (bf16_t*)(ws + WS_WOT); bf16_t* WGT = (bf16_t*)(ws + WS_WGT); bf16_t* WPT = (bf16_t*)(ws + WS_WPT);
    float2* ROPE = (float2*)(ws + WS_ROPE); float* RINV = (float*)(ws + WS_RINV); float* LB16 = (float*)(ws + WS_LB16); float* SSQ1 = (float*)(ws + WS_SSQ1); float* SSQ2 = (float*)(ws + WS_SSQ2);
    bf16_t* PB = (bf16_t*)(ws + WS_PB); bf16_t* WIN = (bf16_t*)(ws + WS_WIN); bf16_t* WBIG = (bf16_t*)(ws + WS_WBIG);
    bf16_t* XB = (bf16_t*)(ws + WS_XB); bf16_t* HB = (bf16_t*)(ws + WS_XB);
    bf16_t* Q = (bf16_t*)(ws + WS_Q); bf16_t* KB = (bf16_t*)(ws + WS_K); bf16_t* VB = (bf16_t*)(ws + WS_V); bf16_t* GA = (bf16_t*)(ws + WS_GA); bf16_t* GS = (bf16_t*)(ws + WS_GS);
    bf16_t* UCAT = (bf16_t*)(ws + WS_UCAT); bf16_t* PPB = (bf16_t*)(ws + WS_UCAT); bf16_t* YMIX = (bf16_t*)(ws + WS_YMIX); bf16_t* YS = (bf16_t*)(ws + WS_YS);

#pragma unroll
    for (int rep_ = 0; rep_ < 1 + ((REP_MASK >> 0) & 1); ++rep_) { LANE_IDS
        const int gw = bid * 8 + wave, NGW = G * 8;
        LAS float* scr = (LAS float*)(lds + wave * 16384);
        constexpr int I1 = 32 * 144, I2 = 16 * 64, I3 = 32 * 64, I4 = 32 * 64, I5 = 4 * 64, NIT = I1 + I2 + I3 + I4 + I5;
        auto item_desc = [&](int r) -> TrItem {
            if (r < I1) { const int kb = r / 144, lgg = r % 144, pn = lgg >> 3, lg = lgg & 7, wtg = pn * 8 + 4 * (lg & 1) + 2 * (lg >> 2) + ((lg >> 1) & 1);
                return TrItem{a.w_in, W1T, a.norm_mix, DM, DIN, wtg * 32, kb * 64, lgg * 32}; } r -= I1;
            if (r < I2) { const int kb = r / 64, lgg = r % 64, l2 = lgg & 31, wtg = (l2 >> 2) * 8 + 4 * (lgg >> 5) + (l2 & 3);
                return TrItem{a.w_glu, WGLUT, nullptr, DSSM, 2 * DSSM, wtg * 32, kb * 64, lgg * 32}; } r -= I2;
            if (r < I3) { const int kb = r / 64, lgg = r % 64; return TrItem{a.w_out, WOT, nullptr, DM, DM, lgg * 32, kb * 64, lgg * 32}; } r -= I3;
            if (r < I4) { const int kb = r / 64, lgg = r % 64; return TrItem{a.w_ple_gate, WGT, a.norm_ple, DM, DM, lgg * 32, kb * 64, lgg * 32}; } r -= I4;
            const int kb = r / 64, lgg = r % 64; return TrItem{a.w_ple_proj, WPT, nullptr, PLE, DM, lgg * 32, kb * 64, lgg * 32};
        };
#pragma unroll
        for (int rq_ = 0; rq_ < 1 + ((REP_MASK >> 8) & 1); ++rq_)
        for (int it = gw; it < I1; it += 2 * NGW) {
            const bool two = it + NGW < I1;
            const TrItem dA = item_desc(it), dB = item_desc(two ? it + NGW : it);
            float vA[32], vB[32];
            p0_tr_load(dA, vA, lane); if (two) p0_tr_load(dB, vB, lane);
            p0_tr_store(dA, vA, scr, lane); if (two) p0_tr_store(dB, vB, scr, lane);
        }
#pragma unroll
        for (int rq_ = 0; rq_ < 1 + ((REP_MASK >> 9) & 1); ++rq_)
        for (int m = gw; m < T; m += 2 * NGW) {
            const int m2 = m + NGW; const bool two = m2 < T;
            const f32x4* xr = (const f32x4*)(a.x + (size_t)m * DM) + lane; const f32x4* xr2 = (const f32x4*)(a.x + (size_t)(two ? m2 : m) * DM) + lane;
            f32x4 v[8], w2[8]; float s = 0.f, s2 = 0.f;
#pragma unroll
            for (int j = 0; j < 8; ++j) v[j] = __builtin_nontemporal_load(xr + 64 * j);
#pragma unroll
            for (int j = 0; j < 8; ++j) w2[j] = __builtin_nontemporal_load(xr2 + 64 * j);
#pragma unroll
            for (int j = 0; j < 8; ++j) { s += (v[j][0] * v[j][0] + v[j][1] * v[j][1]) + (v[j][2] * v[j][2] + v[j][3] * v[j][3]); s2 += (w2[j][0] * w2[j][0] + w2[j][1] * w2[j][1]) + (w2[j][2] * w2[j][2] + w2[j][3] * w2[j][3]); }
            s = wave_sum(s); s2 = wave_sum(s2);
            if (lane == 0) { RINV[m] = rsqrtf(s * (1.f / DM) + EPS); if (two) RINV[m2] = rsqrtf(s2 * (1.f / DM) + EPS); }
            u32x2* o = (u32x2*)(XB + (size_t)m * DM) + lane; u32x2* o2 = (u32x2*)(XB + (size_t)m2 * DM) + lane;
#pragma unroll
            for (int j = 0; j < 8; ++j) { u32x2 w; w.x = pk2(v[j][0], v[j][1]); w.y = pk2(v[j][2], v[j][3]); o[64 * j] = w; }
            if (two) {
#pragma unroll
                for (int j = 0; j < 8; ++j) { u32x2 w; w.x = pk2(w2[j][0], w2[j][1]); w.y = pk2(w2[j][2], w2[j][3]); o2[64 * j] = w; } }
        }
        for (int i = bid * 512 + tid; i < T * PLE / 4; i += G * 512) { const f32x4 v = __builtin_nontemporal_load((const f32x4*)a.p + i); u32x2 w; w.x = pk2(v[0], v[1]); w.y = pk2(v[2], v[3]); ((u32x2*)PB)[i] = w; }
        for (int i = bid * 512 + tid; i < 2048; i += G * 512) { const int pos = i >> 5, f = i & 31; const float inv = powf(10000.f, -(float)f / 32.f); float sn, cs; sincosf((float)pos * inv, &sn, &cs); ROPE[i] = make_float2(cs, sn); }
        xcd_barrier_arrive(xbar, (wave == 0) && (lane_id_opaque() == 0));
        for (int it = I1 + gw; it < NIT; it += 2 * NGW) {
            const bool two = it + NGW < NIT;
            const TrItem dA = item_desc(it), dB = item_desc(two ? it + NGW : it);
            float vA[32], vB[32];
            p0_tr_load(dA, vA, lane); if (two) p0_tr_load(dB, vB, lane);
            p0_tr_store(dA, vA, scr, lane); if (two) p0_tr_store(dB, vB, scr, lane);
        }
        xcd_barrier_wait(xbar, (wave == 0) && (lane_id_opaque() == 0)); }


    if constexpr ((REP_MASK >> 10) & 1) { GRID_SYNC(); GRID_SYNC(); GRID_SYNC(); GRID_SYNC(); }
#pragma unroll
    for (int rep_ = 0; rep_ < 1 + ((REP_MASK >> 1) & 1); ++rep_) { LANE_IDS
        { pg8::Gemm g{XB, W1T, DM, DM, DM, 0, 0}; pg8::StaticOrder S; S.init(T, 14 * 256, G, bid);
          pg8::Epi1 E{RINV, a.q_norm, a.k_norm, ROPE, Q, KB, VB, GA, GS, UCAT, (LAS float*)(lds + XCH_OFF), 0};
          pg8::gemm_phase<pg8::Epi1, pg8::StaticOrder, true>(lds, g, S, E, wave); }
        __syncthreads();
        for (int gi = bid - (G - NG); gi >= 0 && gi < NG; gi += NG) ssm_tables(a, gi, lds, tid);
    GRID_SYNC(); }

#pragma unroll
    for (int rep_ = 0; rep_ < 1 + ((REP_MASK >> 2) & 1); ++rep_) {
#pragma unroll
        for (int rq_ = 0; rq_ < 2; ++rq_) {
        if (bid < 2 * NG) { if (rq_ == 1 && !((REP_MASK >> 6) & 1)) break;
            pg8::BatchOrder S{2 * NG, G, bid};
            { pg8::Gemm g{UCAT, WIN, 256, 512, 256, (size_t)NCH * 512 * 2, (size_t)256 * 256 * 2};
              pg8::EpiS1 E{LB16, UCAT}; pg8::gemm_phase<pg8::EpiS1, pg8::BatchOrder, true>(lds, g, S, E, wave); }
            asm volatile("s_waitcnt vmcnt(0)\n\tbuffer_inv sc1\n\ts_waitcnt vmcnt(0)" ::: "memory"); __syncthreads();
            { pg8::Gemm g{UCAT, WBIG, 512, 512, 512, (size_t)NCH * 512 * 2, (size_t)256 * 512 * 2};
              pg8::EpiS2 E{YS}; pg8::gemm_phase<pg8::EpiS2, pg8::BatchOrder, true>(lds, g, S, E, wave); }
        } else { if (rq_ == 1 && !((REP_MASK >> 11) & 1)) break;
            pg8::Gemm g{XB, W1T + (size_t)14 * 256 * DM, DM, DM, DM, 0, 0}; pg8::ListOrder S{bid - 2 * NG, 128, G};
            pg8::Epi1 E{RINV, a.q_norm, a.k_norm, ROPE, Q, KB, VB, GA, GS, UCAT, (LAS float*)(lds + XCH_OFF), 14};
            pg8::gemm_phase<pg8::Epi1, pg8::ListOrder, true>(lds, g, S, E, wave);
        }
        __syncthreads(); }
#pragma unroll
        for (int rq_ = 0; rq_ < 1 + ((REP_MASK >> 7) & 1); ++rq_)
        for (int un = bid; un < 256; un += G) {
            const int x = un & 7, jj = un >> 3, b = x >> 2, kvh = (x >> 1) & 1, idx = (x & 1) * 32 + jj, h = kvh * 4 + (idx >> 4), qb = idx & 15;
            const size_t tok0 = (size_t)b * SEQ + qb * 256;
            att::attn_dense_body(Q + tok0 * DATT + h * 128, KB + (size_t)b * SEQ * DKV + kvh * 128, VB + (size_t)b * SEQ * DKV + kvh * 128,
                                 GA + tok0 * DATT + h * 128, YMIX + tok0 * DM + h * 128, SEQ, (char*)lds_raw, wave);
        }
    GRID_SYNC(); }

#pragma unroll
    for (int rep_ = 0; rep_ < 1 + ((REP_MASK >> 3) & 1); ++rep_) {
        { pg8::StaticOrder S; S.init(T, 2 * DSSM, G, bid); pg8::Unit ua, ub;
          if (S.next(0, ua)) { ub = ua;
            pg8::Gemm ga{YS, WGLUT, DSSM, DSSM, DSSM, 0, 0}; pg8::EpiGlu Ea{a.b_glu, GS, YMIX};
            pg8::Gemm gb{PB, WPT, PLE, PLE, PLE, 0, 0}; pg8::EpiBf Eb{PPB, DM};
            pg8::gemm_phase2<pg8::EpiGlu, pg8::EpiBf>(lds, ga, ua, Ea, gb, ub, Eb, wave); } }
    GRID_SYNC(); }

#pragma unroll
    for (int rep_ = 0; rep_ < 1 + ((REP_MASK >> 4) & 1); ++rep_) {
        pg8::Gemm g{YMIX, WOT, DM, DM, DM, 0, 0}; pg8::StaticOrder S; S.init(T, DM, G, bid);
        pg8::EpiOut E{a.x, a.out, HB, SSQ1}; pg8::gemm_phase<pg8::EpiOut, pg8::StaticOrder, true>(lds, g, S, E, wave);
    GRID_SYNC(); }


    { LANE_IDS
        pg8::StaticOrder S; S.init(T, DM, G, bid); pg8::Unit u0;
        LAS float* r2 = (LAS float*)(lds + R2_OFF);
        if (S.next(0, u0) && tid < 256) { const float* sp = SSQ1 + (size_t)(u0.pm * 256 + tid) * 32; float s = 0.f;
#pragma unroll
            for (int i = 0; i < 8; ++i) { const f32x4 v = ((const f32x4*)sp)[i]; s += (v[0] + v[1]) + (v[2] + v[3]); }
            r2[tid] = rsqrtf(s * (1.f / DM) + EPS); }
        __syncthreads();
        pg8::Gemm g{HB, WGT, DM, DM, DM, 0, 0};
        pg8::EpiGate E{a.out, PPB, SSQ2, (unsigned*)ws, a.norm_final, r2, HB}; pg8::gemm_phase<pg8::EpiGate, pg8::StaticOrder, true>(lds, g, S, E, wave);
    }
}

extern "C" void kernel_launch(void* const* d_in, const int* in_sizes, int n_in, void* d_out, int out_size, void* d_ws, size_t ws_size, hipStream_t stream) {
    static int grid = 0;
    if (grid == 0) {
        if (n_in != 21 || in_sizes[0] != T * DM || out_size != T * DM || ws_size < WS_END) { fprintf(stderr, "kernel_launch: unexpected shapes (n_in %d, in0 %d, out %d, ws %zu)\n", n_in, n_in > 0 ? in_sizes[0] : -1, out_size, ws_size); grid = -1; return; }
        int dev = 0, cus = 0, per_cu = 0;
        hipGetDevice(&dev); hipDeviceGetAttribute(&cus, hipDeviceAttributeMultiprocessorCount, dev);
        if (hipFuncSetAttribute((const void*)fwd_kernel, hipFuncAttributeMaxDynamicSharedMemorySize, LDS_BYTES) != hipSuccess) { fprintf(stderr, "kernel_launch: hipFuncSetAttribute failed\n"); grid = -1; return; }
        hipOccupancyMaxActiveBlocksPerMultiprocessor(&per_cu, (const void*)fwd_kernel, 512, LDS_BYTES);
        (void)hipGetLastError();
        if (per_cu < 1) fprintf(stderr, "kernel_launch: occupancy query reports %d blocks per CU\n", per_cu);
        grid = cus > 256 ? 256 : cus;
    }
    if (grid < 0) return;
    Args a{};
    const float** f = (const float**)&a;
    for (int i = 0; i < 21; ++i) f[i] = (const float*)d_in[i];
    a.out = (float*)d_out; a.ws = (unsigned char*)d_ws;
    if (hipMemsetAsync(d_ws, 0, WS_CTL_BYTES, stream) != hipSuccess) { fprintf(stderr, "kernel_launch: hipMemsetAsync failed\n"); return; }
    void* args[] = {&a};
    hipError_t e = hipLaunchCooperativeKernel((const void*)fwd_kernel, dim3(grid), dim3(512), args, LDS_BYTES, stream);
    if (e != hipSuccess) fprintf(stderr, "kernel_launch: cooperative launch failed: %s (grid %d)\n", hipGetErrorString(e), grid);
}
```

```cpp
#include <hip/hip_runtime.h>
#include <hip/hip_cooperative_groups.h>
#include <cstdio>
#include <cstdint>
namespace cg = cooperative_groups;

#define LAS __attribute__((address_space(3)))
typedef unsigned short bf16_t;
typedef short bf16x8 __attribute__((ext_vector_type(8)));
typedef short s16x4 __attribute__((ext_vector_type(4)));
typedef float f32x4 __attribute__((ext_vector_type(4)));
typedef float f32x16 __attribute__((ext_vector_type(16)));
typedef unsigned u32x4 __attribute__((ext_vector_type(4)));
typedef unsigned u32x2 __attribute__((ext_vector_type(2)));

constexpr int T = 8192, SEQ = 4096, DM = 2048, DIN = 4608, DATT = 1024, DKV = 256, DSSM = 1024, PLE = 256;
constexpr int NG = 64, NCH = T / 16;
constexpr float EPS = 1e-6f;
#ifndef PH_MASK
#define PH_MASK 0xff
#endif
#ifndef GLDS_AUX
#define GLDS_AUX 0
#endif
#ifndef REP_MASK
#define REP_MASK 0
#endif

constexpr size_t MiB = 1u << 20;
constexpr size_t WS_W1T = 1 * MiB, WS_WGLUT = 19 * MiB, WS_WOT = 23 * MiB, WS_WGT = 31 * MiB, WS_WPT = 39 * MiB;
constexpr size_t WS_ROPE = 40 * MiB, WS_RINV = 40 * MiB + 65536, WS_LB16 = 40 * MiB + 131072, WS_SSQ1 = 41 * MiB, WS_SSQ2 = 42 * MiB;
constexpr size_t WS_PB = 43 * MiB, WS_WIN = 47 * MiB, WS_WBIG = 55 * MiB;
constexpr size_t WS_XB = 71 * MiB;
constexpr size_t WS_Q = 103 * MiB, WS_K = 119 * MiB, WS_V = 123 * MiB, WS_GA = 127 * MiB, WS_GS = 143 * MiB;
constexpr size_t WS_UCAT = 159 * MiB;
constexpr size_t WS_YMIX = 191 * MiB, WS_YS = 223 * MiB, WS_END = 239 * MiB;

constexpr int RING_BYTES = 131072, XCH_OFF = RING_BYTES, R2_OFF = RING_BYTES + 4096, XBST_OFF = RING_BYTES + 8192, LDS_BYTES = 147456;
constexpr size_t WS_BAR = 65536, WS_CTL_BYTES = 131072;

struct Args {
    const float *x, *p, *norm_mix, *w_in, *q_norm, *k_norm, *a_re, *a_im, *log_dt, *b_re, *b_im, *c_re, *c_im, *ssm_d, *w_glu, *b_glu, *w_out, *norm_ple, *w_ple_gate, *w_ple_proj, *norm_final;
    float* out; unsigned char* ws;
};

typedef __bf16 bf16s_;
__device__ __forceinline__ unsigned f2bf(float f) { return (unsigned)__builtin_bit_cast(unsigned short, (bf16s_)f); }
typedef float f32x2_ __attribute__((ext_vector_type(2)));
typedef __bf16 bf16x2_ __attribute__((ext_vector_type(2)));
__device__ __forceinline__ unsigned pk2(float lo, float hi) { const f32x2_ v = {lo, hi}; return __builtin_bit_cast(unsigned, __builtin_convertvector(v, bf16x2_)); }
__device__ __forceinline__ float bf2f(unsigned short b) { return __builtin_bit_cast(float, (unsigned)b << 16); }
__device__ __forceinline__ float bflo(unsigned w) { return __builtin_bit_cast(float, w << 16); }
__device__ __forceinline__ float bfhi(unsigned w) { return __builtin_bit_cast(float, w & 0xffff0000u); }
__device__ __forceinline__ unsigned cvt_pk_bf16(float lo, float hi) { unsigned r; asm volatile("v_cvt_pk_bf16_f32 %0, %1, %2" : "=v"(r) : "v"(lo), "v"(hi)); return r; }
__device__ __forceinline__ float sigmoidf_(float v) { return __builtin_amdgcn_rcpf(1.f + __builtin_amdgcn_exp2f(-1.4426950408889634f * v)); }
__device__ __forceinline__ float siluf_(float v) { return v * __builtin_amdgcn_rcpf(1.f + __builtin_amdgcn_exp2f(-1.4426950408889634f * v)); }
__device__ __forceinline__ float gelu_tanh(float v) { const float t = (-1.5957691216057308f * 1.4426950408889634f) * (v + 0.044715f * v * v * v); return v * __builtin_amdgcn_rcpf(1.f + __builtin_amdgcn_exp2f(t)); }
template <int K> __device__ __forceinline__ float swz_xor(float v) { return __int_as_float(__builtin_amdgcn_ds_swizzle(__float_as_int(v), (K << 10) | 0x1f)); }
__device__ __forceinline__ float sum_xor32(float v) { auto rr = __builtin_amdgcn_permlane32_swap(__float_as_uint(v), __float_as_uint(v), false, false); return __uint_as_float(rr[0]) + __uint_as_float(rr[1]); }
__device__ __forceinline__ float wave_sum(float v) { v += swz_xor<1>(v); v += swz_xor<2>(v); v += swz_xor<4>(v); v += swz_xor<8>(v); v += swz_xor<16>(v); return sum_xor32(v); }
#define LDS_WAIT() asm volatile("s_waitcnt lgkmcnt(0)" ::: "memory")
__device__ __forceinline__ int lane_id_opaque() { int l = __builtin_amdgcn_mbcnt_hi(~0u, __builtin_amdgcn_mbcnt_lo(~0u, 0u)); asm volatile("" : "+v"(l)); return l; }

namespace pg8 {
constexpr int BM = 256, BK = 64, HALF = 128, HTB = HALF * BK * 2, NXCD = 8, WGM = 4;
__host__ __device__ __forceinline__ int lds_byte(int r, int c) { const int st = (r >> 4) * 2 + (c >> 5), rr = r & 15, cc = c & 31, ob = rr * 64 + cc * 2; return st * 1024 + (ob ^ (((ob >> 9) & 1) << 5)); }
__host__ __device__ __forceinline__ void stage_rc(int b, int& R, int& C) { const int st = b / 1024, sb = b % 1024, swz = sb ^ (((sb >> 9) & 1) << 5); R = (st >> 1) * 16 + swz / 64; C = (st & 1) * 32 + (swz % 64) / 2; }
__host__ __device__ __forceinline__ int perm32(int rho) { const int n = rho >> 4, i = rho & 15; return 8 * (i >> 2) + 4 * n + (i & 3); }

struct Unit { int pm, pn, z; };
struct Gemm { const bf16_t* A; const bf16_t* Bt; int K, lda, ldb; size_t zA, zB; };

struct StaticOrder {
    int nM, nN, nwg, G, c;
    __device__ void init(int M, int N, int G_, int c_) { nM = M / BM; nN = N / BM; nwg = nM * nN; G = G_; c = c_; }
    __device__ bool next(int i, Unit& u) const {
        const long L = (long)i * G + c; if (L >= nwg) return false;
        int wgid = (int)L; { const int q = nwg / NXCD, r = nwg % NXCD, xcd = wgid % NXCD, off = wgid / NXCD; wgid = (xcd < r ? xcd * (q + 1) : r * (q + 1) + (xcd - r) * q) + off; }
        const int nig = WGM * nN, gid = wgid / nig, fm = gid * WGM, gsz = (nM - fm) < WGM ? (nM - fm) : WGM;
        u.pm = fm + ((wgid % nig) % gsz); u.pn = (wgid % nig) / gsz; u.z = 0; return true;
    }
};
struct BatchOrder {
    int n, G, c;
    __device__ bool next(int i, Unit& u) const { const int L = i * G + c; if (L >= n) return false;
        if ((n & 15) == 0) { const int x = L & 7, j = L >> 3; u.z = 8 * x + (j >> 1); u.pm = j & 1; }
        else { u.z = L >> 1; u.pm = L & 1; }
        u.pn = 0; return true; }
};

struct ListOrder {
    int L0, n, stride;
    __device__ bool next(int i, Unit& u) const { const int L = L0 + i * stride; if (L < 0 || L >= n) return false;
        const int x = L & 7, j = L >> 3; u.pm = 4 * x + (j >> 2); u.pn = j & 3; u.z = 0; return true; }
};
template <class Epi, class Sched, bool ALIGN_EPI>
__device__ __forceinline__ void gemm_phase(LAS unsigned char* lds, const Gemm g, const Sched& S, const Epi& E, const int wid) {
    const int lane = lane_id_opaque(), tid = wid * 64 + lane, wr = wid >> 2, wc = wid & 3, fr = lane & 15, fq = lane >> 4;
    const int K = g.K, nt = K / BK;
    unsigned voffA[2], voffB[2];
#pragma unroll
    for (int i = 0; i < 2; ++i) { int R, C; stage_rc(tid * 16 + i * 8192, R, C); const int Rb = (R & ~31) + perm32(R & 31);
        voffA[i] = (unsigned)(R * g.lda + C) * 2u; voffB[i] = (unsigned)(Rb * g.ldb + C) * 2u; }
    const size_t kstep = (size_t)(BK * 2);
    const size_t hstepA = (size_t)HALF * g.lda * 2, hstepB = (size_t)HALF * g.ldb * 2;
    const size_t tstepA = 2 * hstepA, tstepB = 2 * hstepB;
    const unsigned ldsw = (unsigned)wid * 1024u;
    const int aoff = lds_byte(wr * 64 + fr, fq * 8), boff = lds_byte(wc * 32 + fr, fq * 8);
#define PG8_SA(b, h) (((b) * 2 + (h)) * HTB)
#define PG8_SB(b, h) ((4 + (b) * 2 + (h)) * HTB)
#define PG8_STAGE(bufoff, gbase, voff) do { _Pragma("unroll") for (int _i = 0; _i < 2; ++_i) \
        __builtin_amdgcn_global_load_lds((const unsigned*)((const char*)(gbase) + (voff)[_i]), (LAS unsigned*)(lds + (bufoff) + ldsw + _i * 8192), 16, 0, GLDS_AUX); } while (0)
#define PG8_LDA(dst, b, h) do { _Pragma("unroll") for (int m = 0; m < 4; ++m) _Pragma("unroll") for (int k = 0; k < 2; ++k) dst[m][k] = *(const LAS bf16x8*)(lds + PG8_SA(b, h) + aoff + m * 2048 + k * 1024); } while (0)
#define PG8_LDB(dst, b, h) do { _Pragma("unroll") for (int n = 0; n < 2; ++n) _Pragma("unroll") for (int k = 0; k < 2; ++k) dst[n][k] = *(const LAS bf16x8*)(lds + PG8_SB(b, h) + boff + n * 2048 + k * 1024); } while (0)
#define PG8_MMA(ai, bj, At, Bt) do { __builtin_amdgcn_s_setprio(1); _Pragma("unroll") for (int m = 0; m < 4; ++m) _Pragma("unroll") for (int n = 0; n < 2; ++n) _Pragma("unroll") for (int k = 0; k < 2; ++k) \
        acc[ai][bj][m][n] = __builtin_amdgcn_mfma_f32_16x16x32_bf16(Bt[n][k], At[m][k], acc[ai][bj][m][n], 0, 0, 0); __builtin_amdgcn_s_setprio(0); } while (0)
#define PG8_WAIT_V(n) asm volatile("s_waitcnt vmcnt(" #n ")" ::: "memory")
#define PG8_WAIT_L(n) asm volatile("s_waitcnt lgkmcnt(" #n ")" ::: "memory")
#define PG8_BAR __builtin_amdgcn_s_barrier()
#define PG8_SCHED __builtin_amdgcn_sched_barrier(0)
    Unit cur, nxt; int ui = 0;
    if (!S.next(0, cur)) return;
    f32x4 acc[2][2][4][2];
#pragma unroll
    for (int a = 0; a < 2; ++a)
#pragma unroll
        for (int b = 0; b < 2; ++b)
#pragma unroll
            for (int m = 0; m < 4; ++m)
#pragma unroll
                for (int n = 0; n < 2; ++n) acc[a][b][m][n] = (f32x4){0.f, 0.f, 0.f, 0.f};
    bf16x8 At[4][2], B0[2][2], B1[2][2];
    const char* cA = (const char*)g.A + (size_t)cur.z * g.zA + (size_t)cur.pm * tstepA; const char* cB = (const char*)g.Bt + (size_t)cur.z * g.zB + (size_t)cur.pn * tstepB;
    PG8_STAGE(PG8_SB(0, 0), cB, voffB); PG8_STAGE(PG8_SB(0, 1), cB + hstepB, voffB); PG8_STAGE(PG8_SA(0, 0), cA, voffA); PG8_STAGE(PG8_SA(0, 1), cA + hstepA, voffA);
    if (wr == 1) PG8_BAR;
    PG8_WAIT_V(2); PG8_BAR;
    PG8_STAGE(PG8_SB(1, 0), cB + kstep, voffB); PG8_STAGE(PG8_SA(1, 0), cA + kstep, voffA); PG8_STAGE(PG8_SB(1, 1), cB + hstepB + kstep, voffB);
    PG8_WAIT_V(6); PG8_BAR;
    for (;;) {
        const bool has_next = S.next(ui + 1, nxt);
        const char* nA = has_next ? (const char*)g.A + (size_t)nxt.z * g.zA + (size_t)nxt.pm * tstepA : cA;
        const char* nB = has_next ? (const char*)g.Bt + (size_t)nxt.z * g.zB + (size_t)nxt.pn * tstepB : cB;
        for (int t = 0; t < nt; t += 2) {
            const bool last = (t == nt - 2);
            const char* a1 = cA + (size_t)(t + 1) * kstep;
            const char* a2 = last ? nA : cA + (size_t)(t + 2) * kstep; const char* b2 = last ? nB : cB + (size_t)(t + 2) * kstep;
            const char* a3 = a2 + kstep; const char* b3 = b2 + kstep;
            PG8_LDB(B0, 0, 0); PG8_LDB(B1, 0, 1); PG8_SCHED; PG8_LDA(At, 0, 0); PG8_STAGE(PG8_SA(1, 1), a1 + hstepA, voffA);
            PG8_WAIT_V(8); PG8_WAIT_L(0); PG8_BAR; PG8_MMA(0, 0, At, B0); PG8_MMA(0, 1, At, B1); PG8_BAR; PG8_SCHED;
            PG8_LDA(At, 0, 1); PG8_STAGE(PG8_SB(0, 0), b2, voffB); PG8_STAGE(PG8_SB(0, 1), b2 + hstepB, voffB); PG8_STAGE(PG8_SA(0, 0), a2, voffA);
            PG8_WAIT_V(8); PG8_WAIT_L(0); PG8_BAR; PG8_MMA(1, 0, At, B0); PG8_MMA(1, 1, At, B1); PG8_BAR; PG8_SCHED;
            PG8_LDB(B0, 1, 0); PG8_LDB(B1, 1, 1); PG8_SCHED; PG8_LDA(At, 1, 0); PG8_STAGE(PG8_SA(0, 1), a2 + hstepA, voffA);
            PG8_WAIT_V(8); PG8_WAIT_L(0); PG8_BAR; PG8_MMA(0, 0, At, B0); PG8_MMA(0, 1, At, B1); PG8_BAR; PG8_SCHED;
            PG8_LDA(At, 1, 1); PG8_STAGE(PG8_SB(1, 0), b3, voffB); PG8_STAGE(PG8_SB(1, 1), b3 + hstepB, voffB); PG8_STAGE(PG8_SA(1, 0), a3, voffA);
            PG8_WAIT_V(8); PG8_WAIT_L(0); PG8_BAR; PG8_MMA(1, 0, At, B0); PG8_MMA(1, 1, At, B1); PG8_BAR; PG8_SCHED;
        }
        if constexpr (ALIGN_EPI) { if (wr == 0) PG8_BAR; }
        if constexpr (!Epi::AFTER_DRAIN) E(acc, cur, wr, wc, fr, fq);
        if (!has_next) break;
#pragma unroll
        for (int a = 0; a < 2; ++a)
#pragma unroll
            for (int b = 0; b < 2; ++b)
#pragma unroll
                for (int m = 0; m < 4; ++m)
#pragma unroll
                    for (int n = 0; n < 2; ++n) acc[a][b][m][n] = (f32x4){0.f, 0.f, 0.f, 0.f};
        cur = nxt; cA = nA; cB = nB; ++ui;
        if constexpr (ALIGN_EPI) { if (wr == 1) PG8_BAR; }
    }
    PG8_WAIT_V(0);
    if constexpr (!ALIGN_EPI) { if (wr == 0) PG8_BAR; }
    PG8_BAR;
    if constexpr (Epi::AFTER_DRAIN) E.fused(acc, cur, wr, wc, lds, wid);
#undef PG8_SA
#undef PG8_SB
#undef PG8_STAGE
#undef PG8_LDA
#undef PG8_LDB
#undef PG8_MMA
#undef PG8_WAIT_V
#undef PG8_WAIT_L
#undef PG8_BAR
#undef PG8_SCHED
}

template <class EpiA, class EpiB>
__device__ __forceinline__ void gemm_phase2(LAS unsigned char* lds, const Gemm g0, const Unit u0, const EpiA& E0, const Gemm g1, const Unit u1, const EpiB& E1, const int wid) {
    const int lane = lane_id_opaque(), tid = wid * 64 + lane, wr = wid >> 2, wc = wid & 3, fr = lane & 15, fq = lane >> 4;
    unsigned vA0[2], vB0[2], vA1[2], vB1[2];
#pragma unroll
    for (int i = 0; i < 2; ++i) { int R, C; stage_rc(tid * 16 + i * 8192, R, C); const int Rb = (R & ~31) + perm32(R & 31);
        vA0[i] = (unsigned)(R * g0.lda + C) * 2u; vB0[i] = (unsigned)(Rb * g0.ldb + C) * 2u; vA1[i] = (unsigned)(R * g1.lda + C) * 2u; vB1[i] = (unsigned)(Rb * g1.ldb + C) * 2u; }
    const size_t kstep = (size_t)(BK * 2);
    const size_t hA0 = (size_t)HALF * g0.lda * 2, hB0 = (size_t)HALF * g0.ldb * 2, hA1 = (size_t)HALF * g1.lda * 2, hB1 = (size_t)HALF * g1.ldb * 2;
    const unsigned ldsw = (unsigned)wid * 1024u;
    const int aoff = lds_byte(wr * 64 + fr, fq * 8), boff = lds_byte(wc * 32 + fr, fq * 8);
#define PG8_SA(b, h) (((b) * 2 + (h)) * HTB)
#define PG8_SB(b, h) ((4 + (b) * 2 + (h)) * HTB)
#define PG8_STAGE(bufoff, gbase, voff) do { _Pragma("unroll") for (int _i = 0; _i < 2; ++_i) \
        __builtin_amdgcn_global_load_lds((const unsigned*)((const char*)(gbase) + (voff)[_i]), (LAS unsigned*)(lds + (bufoff) + ldsw + _i * 8192), 16, 0, 0); } while (0)
#define PG8_LDA(dst, b, h) do { _Pragma("unroll") for (int m = 0; m < 4; ++m) _Pragma("unroll") for (int k = 0; k < 2; ++k) dst[m][k] = *(const LAS bf16x8*)(lds + PG8_SA(b, h) + aoff + m * 2048 + k * 1024); } while (0)
#define PG8_LDB(dst, b, h) do { _Pragma("unroll") for (int n = 0; n < 2; ++n) _Pragma("unroll") for (int k = 0; k < 2; ++k) dst[n][k] = *(const LAS bf16x8*)(lds + PG8_SB(b, h) + boff + n * 2048 + k * 1024); } while (0)
#define PG8_MMA(ai, bj, At, Bt) do { __builtin_amdgcn_s_setprio(1); _Pragma("unroll") for (int m = 0; m < 4; ++m) _Pragma("unroll") for (int n = 0; n < 2; ++n) _Pragma("unroll") for (int k = 0; k < 2; ++k) \
        acc[ai][bj][m][n] = __builtin_amdgcn_mfma_f32_16x16x32_bf16(Bt[n][k], At[m][k], acc[ai][bj][m][n], 0, 0, 0); __builtin_amdgcn_s_setprio(0); } while (0)
#define PG8_WAIT_V(n) asm volatile("s_waitcnt vmcnt(" #n ")" ::: "memory")
#define PG8_WAIT_L(n) asm volatile("s_waitcnt lgkmcnt(" #n ")" ::: "memory")
#define PG8_BAR __builtin_amdgcn_s_barrier()
#define PG8_SCHED __builtin_amdgcn_sched_barrier(0)
    f32x4 acc[2][2][4][2];
#pragma unroll
    for (int a = 0; a < 2; ++a)
#pragma unroll
        for (int b = 0; b < 2; ++b)
#pragma unroll
            for (int m = 0; m < 4; ++m)
#pragma unroll
                for (int n = 0; n < 2; ++n) acc[a][b][m][n] = (f32x4){0.f, 0.f, 0.f, 0.f};
    bf16x8 At[4][2], B0[2][2], B1[2][2];
    const char* A0 = (const char*)g0.A + (size_t)u0.pm * 2 * hA0; const char* Bp0 = (const char*)g0.Bt + (size_t)u0.pn * 2 * hB0;
    const char* A1 = (const char*)g1.A + (size_t)u1.pm * 2 * hA1; const char* Bp1 = (const char*)g1.Bt + (size_t)u1.pn * 2 * hB1;
    PG8_STAGE(PG8_SB(0, 0), Bp0, vB0); PG8_STAGE(PG8_SB(0, 1), Bp0 + hB0, vB0); PG8_STAGE(PG8_SA(0, 0), A0, vA0); PG8_STAGE(PG8_SA(0, 1), A0 + hA0, vA0);
    if (wr == 1) PG8_BAR;
    PG8_WAIT_V(2); PG8_BAR;
    PG8_STAGE(PG8_SB(1, 0), Bp0 + kstep, vB0); PG8_STAGE(PG8_SA(1, 0), A0 + kstep, vA0); PG8_STAGE(PG8_SB(1, 1), Bp0 + hB0 + kstep, vB0);
    PG8_WAIT_V(6); PG8_BAR;
#pragma unroll
    for (int ui = 0; ui < 2; ++ui) {
        const char* cA = ui == 0 ? A0 : A1; const char* cB = ui == 0 ? Bp0 : Bp1;
        const size_t hAc = ui == 0 ? hA0 : hA1, hBc = ui == 0 ? hB0 : hB1;
        const int nt = (ui == 0 ? g0.K : g1.K) / BK;
        unsigned vAc[2], vBc[2];
#pragma unroll
        for (int i = 0; i < 2; ++i) { vAc[i] = ui == 0 ? vA0[i] : vA1[i]; vBc[i] = ui == 0 ? vB0[i] : vB1[i]; }
        for (int t = 0; t < nt; t += 2) {
            const bool last = (t == nt - 2);
            const char* a1 = cA + (size_t)(t + 1) * kstep;
            const char* a2 = last ? A1 : cA + (size_t)(t + 2) * kstep; const char* b2 = last ? Bp1 : cB + (size_t)(t + 2) * kstep;
            const char* a3 = a2 + kstep; const char* b3 = b2 + kstep;
            const size_t hA2 = last ? hA1 : hAc, hB2 = last ? hB1 : hBc;
            unsigned vA2[2], vB2[2];
#pragma unroll
            for (int i = 0; i < 2; ++i) { vA2[i] = last ? vA1[i] : vAc[i]; vB2[i] = last ? vB1[i] : vBc[i]; }
            PG8_LDB(B0, 0, 0); PG8_LDB(B1, 0, 1); PG8_SCHED; PG8_LDA(At, 0, 0); PG8_STAGE(PG8_SA(1, 1), a1 + hAc, vAc);
            PG8_WAIT_V(8); PG8_WAIT_L(0); PG8_BAR; PG8_MMA(0, 0, At, B0); PG8_MMA(0, 1, At, B1); PG8_BAR; PG8_SCHED;
            PG8_LDA(At, 0, 1); PG8_STAGE(PG8_SB(0, 0), b2, vB2); PG8_STAGE(PG8_SB(0, 1), b2 + hB2, vB2); PG8_STAGE(PG8_SA(0, 0), a2, vA2);
            PG8_WAIT_V(8); PG8_WAIT_L(0); PG8_BAR; PG8_MMA(1, 0, At, B0); PG8_MMA(1, 1, At, B1); PG8_BAR; PG8_SCHED;
            PG8_LDB(B0, 1, 0); PG8_LDB(B1, 1, 1); PG8_SCHED; PG8_LDA(At, 1, 0); PG8_STAGE(PG8_SA(0, 1), a2 + hA2, vA2);
            PG8_WAIT_V(8); PG8_WAIT_L(0); PG8_BAR; PG8_MMA(0, 0, At, B0); PG8_MMA(0, 1, At, B1); PG8_BAR; PG8_SCHED;
            PG8_LDA(At, 1, 1); PG8_STAGE(PG8_SB(1, 0), b3, vB2); PG8_STAGE(PG8_SB(1, 1), b3 + hB2, vB2); PG8_STAGE(PG8_SA(1, 0), a3, vA2);
            PG8_WAIT_V(8); PG8_WAIT_L(0); PG8_BAR; PG8_MMA(1, 0, At, B0); PG8_MMA(1, 1, At, B1); PG8_BAR; PG8_SCHED;
        }
        if (wr == 0) PG8_BAR;
        if (ui == 0) {
            E0(acc, u0, wr, wc, fr, fq);
#pragma unroll
            for (int a = 0; a < 2; ++a)
#pragma unroll
                for (int b = 0; b < 2; ++b)
#pragma unroll
                    for (int m = 0; m < 4; ++m)
#pragma unroll
                        for (int n = 0; n < 2; ++n) acc[a][b][m][n] = (f32x4){0.f, 0.f, 0.f, 0.f};
            if (wr == 1) PG8_BAR;
        } else E1(acc, u1, wr, wc, fr, fq);
    }
    PG8_WAIT_V(0);
    PG8_BAR;
#undef PG8_SA
#undef PG8_SB
#undef PG8_STAGE
#undef PG8_LDA
#undef PG8_LDB
#undef PG8_MMA
#undef PG8_WAIT_V
#undef PG8_WAIT_L
#undef PG8_BAR
#undef PG8_SCHED
}

#define EPI_FOR_ROWS _Pragma("unroll") for (int ai = 0; ai < 2; ++ai) _Pragma("unroll") for (int m = 0; m < 4; ++m)
#define EPI_ROWDEF const int rit = ai * HALF + wr * 64 + m * 16 + fr; const int row = u.pm * BM + rit; (void)rit; (void)row;

struct Epi1 {
    static constexpr bool AFTER_DRAIN = false;
    const float* rinv; const float* qnw; const float* knw; const float2* rope;
    bf16_t *Q, *Kb, *Vb, *GA, *GS, *UCAT; LAS float* xch; int pn0;
    __device__ __forceinline__ void operator()(const f32x4 (&acc)[2][2][4][2], const Unit& u, int wr, int wc, int, int) const {
        const int l_ = lane_id_opaque(), fr = l_ & 15, fq = l_ >> 4;
        const int pn = u.pn + pn0;
        if (pn <= 4) {
            float ss[2][4], rv[2][4];
            EPI_FOR_ROWS { EPI_ROWDEF const float r = rinv[row]; rv[ai][m] = r; float s = 0.f;
#pragma unroll
                for (int bj = 0; bj < 2; ++bj)
#pragma unroll
                    for (int n = 0; n < 2; ++n) { const f32x4 v = acc[ai][bj][m][n] * r; s += (v[0] * v[0] + v[1] * v[1]) + (v[2] * v[2] + v[3] * v[3]); }
                s += swz_xor<16>(s); s = sum_xor32(s); ss[ai][m] = s;
                if (fq == 0) xch[wc * 256 + rit] = s; }
            LDS_WAIT(); __builtin_amdgcn_s_barrier(); asm volatile("" ::: "memory");
            const int half = wc & 1, hd = wc >> 1;
            const float* nw = (pn < 4 ? qnw : knw) + 64 * half + 8 * fq;
            float w1[8], w2[8];
#pragma unroll
            for (int i = 0; i < 8; ++i) { w1[i] = nw[i]; w2[i] = nw[32 + i]; }
            EPI_FOR_ROWS { EPI_ROWDEF const float tot = ss[ai][m] + xch[(wc ^ 1) * 256 + rit];
                const float sc = rv[ai][m] * rsqrtf(tot * (1.f / 128.f) + EPS);
                const int t = row & (SEQ - 1); const int pos = half ? (t & 63) : (t >> 6);
                const float2* rp = rope + pos * 32 + 8 * fq;
                float o1[8], o2[8];
#pragma unroll
                for (int n = 0; n < 2; ++n)
#pragma unroll
                    for (int e = 0; e < 4; ++e) { const int i = 4 * n + e; const float2 cs = rp[i];
                        const float x1 = acc[ai][0][m][n][e] * sc * w1[i], x2 = acc[ai][1][m][n][e] * sc * w2[i];
                        o1[i] = x1 * cs.x - x2 * cs.y; o2[i] = x2 * cs.x + x1 * cs.y; }
                bf16_t* dst = (pn < 4) ? Q + (size_t)row * DATT + (2 * pn + hd) * 128 + 64 * half + 8 * fq : Kb + (size_t)row * DKV + hd * 128 + 64 * half + 8 * fq;
                u32x4 a; a.x = pk2(o1[0], o1[1]); a.y = pk2(o1[2], o1[3]); a.z = pk2(o1[4], o1[5]); a.w = pk2(o1[6], o1[7]);
                u32x4 b; b.x = pk2(o2[0], o2[1]); b.y = pk2(o2[2], o2[3]); b.z = pk2(o2[4], o2[5]); b.w = pk2(o2[6], o2[7]);
                *(u32x4*)dst = a; *(u32x4*)(dst + 32) = b; }
        } else {
            const int lg0 = 4 * (wc >> 1) + 2 * (wc & 1);
            EPI_FOR_ROWS { EPI_ROWDEF const float r = rinv[row];
#pragma unroll
                for (int bj = 0; bj < 2; ++bj) { const int L = 256 * pn + 32 * (lg0 + bj) + 8 * fq;
                    f32x4 v0 = acc[ai][bj][m][0] * r, v1 = acc[ai][bj][m][1] * r; bf16_t* dst;
                    if (pn == 5) dst = Vb + (size_t)row * DKV + (L - 1280);
                    else if (pn < 10) dst = GA + (size_t)row * DATT + (L - 1536);
                    else if (pn < 14) { const int Lu = L - 2560; dst = UCAT + ((size_t)(Lu >> 4) * NCH + (row >> 4)) * 512 + (row & 15) * 16 + (Lu & 15); }
                    else dst = GS + (size_t)row * DSSM + (L - 3584);
                    if ((pn >= 6 && pn < 10) || pn >= 14) {
#pragma unroll
                        for (int e = 0; e < 4; ++e) { v0[e] = siluf_(v0[e]); v1[e] = siluf_(v1[e]); } }
                    u32x4 w; w.x = pk2(v0[0], v0[1]); w.y = pk2(v0[2], v0[3]); w.z = pk2(v1[0], v1[1]); w.w = pk2(v1[2], v1[3]);
                    *(u32x4*)dst = w; } }
        }
    }
};
struct EpiS1 {
    static constexpr bool AFTER_DRAIN = true;
    const float* lb16; bf16_t* UCAT;
    __device__ __forceinline__ void operator()(const f32x4 (&)[2][2][4][2], const Unit&, int, int, int, int) const {}
    __device__ __forceinline__ void fused(const f32x4 (&acc)[2][2][4][2], const Unit& u, int wr, int wc, LAS unsigned char* lds, int wid) const {
        const int l_ = lane_id_opaque(), fr = l_ & 15, fq = l_ >> 4;
        LAS float* Tl = (LAS float*)lds;
#pragma unroll
        for (int d = 0; d < 2; ++d) {
            EPI_FOR_ROWS { const int rit = ai * HALF + wr * 64 + m * 16 + fr; LAS float* rp = Tl + rit * 128 + wc * 32 + 8 * fq;
                *(LAS f32x4*)rp = acc[ai][d][m][0]; *(LAS f32x4*)(rp + 4) = acc[ai][d][m][1]; }
            LDS_WAIT(); __builtin_amdgcn_s_barrier(); asm volatile("" ::: "memory");
            {
                const int p = l_; const float lr = lb16[((u.z * 2 + d) * 64 + p) * 2], li = lb16[((u.z * 2 + d) * 64 + p) * 2 + 1];
                LAS float* SEG = (LAS float*)(lds + XCH_OFF);
                float xr = 0.f, xi = 0.f;
#pragma unroll 8
                for (int i = 0; i < 32; ++i) { const int cc = wid * 32 + i, c = d ? 255 - cc : cc;
                    const float sr = Tl[c * 128 + p], si = Tl[c * 128 + 64 + p];
                    Tl[c * 128 + p] = xr; Tl[c * 128 + 64 + p] = xi;
                    const float nr = lr * xr - li * xi + sr; xi = lr * xi + li * xr + si; xr = nr; }
                SEG[(wid * 64 + p) * 2] = xr; SEG[(wid * 64 + p) * 2 + 1] = xi;
                LDS_WAIT(); __builtin_amdgcn_s_barrier(); asm volatile("" ::: "memory");
                float l32r = lr, l32i = li;
#pragma unroll
                for (int q = 0; q < 5; ++q) { const float t = l32r * l32r - l32i * l32i; l32i = 2.f * l32r * l32i; l32r = t; }
                float er = 0.f, ei = 0.f;
                for (int j = 0; j < wid; ++j) { const float tr = SEG[(j * 64 + p) * 2], ti = SEG[(j * 64 + p) * 2 + 1];
                    const float nr = l32r * er - l32i * ei + tr; ei = l32r * ei + l32i * er + ti; er = nr; }
#pragma unroll 8
                for (int i = 0; i < 32; ++i) { const int cc = wid * 32 + i, c = d ? 255 - cc : cc;
                    const float tr = Tl[c * 128 + p] + er, ti = Tl[c * 128 + 64 + p] + ei;
                    Tl[c * 128 + p] = __uint_as_float(pk2(tr, ti));
                    const float nr = lr * er - li * ei; ei = lr * ei + li * er; er = nr; }
            }
            LDS_WAIT(); __builtin_amdgcn_s_barrier(); asm volatile("" ::: "memory");
            {   bf16_t* ub = UCAT + ((size_t)u.z * NCH + u.pm * 256) * 512 + 256 + d * 128;
#pragma unroll
                for (int i = 0; i < 8; ++i) { const int q = wid * 64 + l_ + 512 * i, r = q >> 4, c8 = (q & 15) * 8;
                    *(u32x4*)(ub + (size_t)r * 512 + c8) = *(const LAS u32x4*)((LAS bf16_t*)(Tl + r * 128) + c8); } }
            LDS_WAIT(); __builtin_amdgcn_s_barrier(); asm volatile("" ::: "memory");
        }
    }
};
struct EpiS2 {
    static constexpr bool AFTER_DRAIN = false;
    bf16_t* YS;
    __device__ __forceinline__ void operator()(const f32x4 (&acc)[2][2][4][2], const Unit& u, int wr, int wc, int, int) const {
        const int l_ = lane_id_opaque(), fr = l_ & 15, fq = l_ >> 4;
        EPI_FOR_ROWS { EPI_ROWDEF
#pragma unroll
            for (int bj = 0; bj < 2; ++bj) { const int c = bj * HALF + wc * 32 + 8 * fq; const int j = c >> 4, h0 = c & 15;
                const f32x4 v0 = acc[ai][bj][m][0], v1 = acc[ai][bj][m][1];
                u32x4 w; w.x = pk2(gelu_tanh(v0[0]), gelu_tanh(v0[1])); w.y = pk2(gelu_tanh(v0[2]), gelu_tanh(v0[3])); w.z = pk2(gelu_tanh(v1[0]), gelu_tanh(v1[1])); w.w = pk2(gelu_tanh(v1[2]), gelu_tanh(v1[3]));
                *(u32x4*)(YS + ((size_t)row * 16 + j) * DSSM + u.z * 16 + h0) = w; } }
    }
};
struct EpiGlu {
    static constexpr bool AFTER_DRAIN = false;
    const float* bglu; const bf16_t* GS; bf16_t* YMIX;
    __device__ __forceinline__ void operator()(const f32x4 (&acc)[2][2][4][2], const Unit& u, int wr, int wc, int, int) const {
        const int l_ = lane_id_opaque(), fr = l_ & 15, fq = l_ >> 4;
        const int a0 = 128 * u.pn + 32 * wc + 8 * fq;
        float bv[8], bg[8];
#pragma unroll
        for (int i = 0; i < 8; ++i) { bv[i] = bglu[a0 + i]; bg[i] = bglu[1024 + a0 + i]; }
        u32x4 gsv[2][4];
        EPI_FOR_ROWS { EPI_ROWDEF gsv[ai][m] = __builtin_nontemporal_load((const u32x4*)(GS + (size_t)row * DSSM + a0)); }
        EPI_FOR_ROWS { EPI_ROWDEF const u32x4 gs = gsv[ai][m];
            float o[8];
#pragma unroll
            for (int n = 0; n < 2; ++n)
#pragma unroll
                for (int e = 0; e < 4; ++e) { const int i = 4 * n + e; o[i] = (acc[ai][0][m][n][e] + bv[i]) * sigmoidf_(acc[ai][1][m][n][e] + bg[i]); }
            o[0] *= bflo(gs.x); o[1] *= bfhi(gs.x); o[2] *= bflo(gs.y); o[3] *= bfhi(gs.y); o[4] *= bflo(gs.z); o[5] *= bfhi(gs.z); o[6] *= bflo(gs.w); o[7] *= bfhi(gs.w);
            u32x4 w; w.x = pk2(o[0], o[1]); w.y = pk2(o[2], o[3]); w.z = pk2(o[4], o[5]); w.w = pk2(o[6], o[7]);
            *(u32x4*)(YMIX + (size_t)row * DM + 1024 + a0) = w; }
    }
};
struct EpiBf {
    static constexpr bool AFTER_DRAIN = false;
    bf16_t* O; int ldc;
    __device__ __forceinline__ void operator()(const f32x4 (&acc)[2][2][4][2], const Unit& u, int wr, int wc, int, int) const {
        const int l_ = lane_id_opaque(), fr = l_ & 15, fq = l_ >> 4;
        EPI_FOR_ROWS { EPI_ROWDEF
#pragma unroll
            for (int bj = 0; bj < 2; ++bj) { const f32x4 v0 = acc[ai][bj][m][0], v1 = acc[ai][bj][m][1];
                u32x4 w; w.x = pk2(v0[0], v0[1]); w.y = pk2(v0[2], v0[3]); w.z = pk2(v1[0], v1[1]); w.w = pk2(v1[2], v1[3]);
                *(u32x4*)(O + (size_t)row * ldc + u.pn * BM + bj * HALF + wc * 32 + 8 * fq) = w; } }
    }
};
struct EpiOut {
    static constexpr bool AFTER_DRAIN = false;
    const float* x; float* H; bf16_t* HB; float* ssq;
    __device__ __forceinline__ void operator()(const f32x4 (&acc)[2][2][4][2], const Unit& u, int wr, int wc, int, int) const {
        const int l_ = lane_id_opaque(), fr = l_ & 15, fq = l_ >> 4;
#pragma unroll
        for (int ai = 0; ai < 2; ++ai) {
            f32x4 xv[4][2][2];
#pragma unroll
            for (int m = 0; m < 4; ++m) { EPI_ROWDEF
#pragma unroll
                for (int bj = 0; bj < 2; ++bj) { const size_t off = (size_t)row * DM + u.pn * BM + bj * HALF + wc * 32 + 8 * fq; xv[m][bj][0] = __builtin_nontemporal_load((const f32x4*)(x + off)); xv[m][bj][1] = __builtin_nontemporal_load((const f32x4*)(x + off + 4)); } }
#pragma unroll
            for (int m = 0; m < 4; ++m) { EPI_ROWDEF float s = 0.f;
#pragma unroll
                for (int bj = 0; bj < 2; ++bj) { const size_t off = (size_t)row * DM + u.pn * BM + bj * HALF + wc * 32 + 8 * fq;
                    const f32x4 v0 = acc[ai][bj][m][0] + xv[m][bj][0], v1 = acc[ai][bj][m][1] + xv[m][bj][1];
                    s += (v0[0] * v0[0] + v0[1] * v0[1]) + (v0[2] * v0[2] + v0[3] * v0[3]) + (v1[0] * v1[0] + v1[1] * v1[1]) + (v1[2] * v1[2] + v1[3] * v1[3]);
                    u32x4 w; w.x = pk2(v0[0], v0[1]); w.y = pk2(v0[2], v0[3]); w.z = pk2(v1[0], v1[1]); w.w = pk2(v1[2], v1[3]);
                    *(u32x4*)(HB + off) = w; }
                s += swz_xor<16>(s); s = sum_xor32(s);
                if (fq == 0) ssq[(size_t)row * 32 + u.pn * 4 + wc] = s; }
        }
    }
};
struct EpiGate {
    static constexpr bool AFTER_DRAIN = true;
    float* H; const bf16_t* PP; float* ssq; unsigned* cnt; const float* nf; const LAS float* r2; const bf16_t* HBr;
    __device__ __forceinline__ void operator()(const f32x4 (&)[2][2][4][2], const Unit&, int, int, int, int) const {}
    __device__ __forceinline__ void fused(f32x4 (&acc)[2][2][4][2], const Unit& u, int wr, int wc, LAS unsigned char* lds, int wid) const {
        const int l_ = lane_id_opaque(), fr = l_ & 15, fq = l_ >> 4, tid = wid * 64 + l_;
        LAS float* P = (LAS float*)lds; LAS float* Rn = P + 1024;
        EPI_FOR_ROWS { EPI_ROWDEF float s = 0.f; const float r = r2[rit];
#pragma unroll
            for (int bj = 0; bj < 2; ++bj) { const size_t off = (size_t)row * DM + u.pn * BM + bj * HALF + wc * 32 + 8 * fq;
                const u32x4 pp = __builtin_nontemporal_load((const u32x4*)(PP + off));
                const u32x4 hb = __builtin_nontemporal_load((const u32x4*)(HBr + off));
                f32x4 h0 = {bflo(hb.x), bfhi(hb.x), bflo(hb.y), bfhi(hb.y)}, h1 = {bflo(hb.z), bfhi(hb.z), bflo(hb.w), bfhi(hb.w)};
                const f32x4 a0 = acc[ai][bj][m][0] * r, a1 = acc[ai][bj][m][1] * r;
                h0[0] += sigmoidf_(a0[0]) * bflo(pp.x); h0[1] += sigmoidf_(a0[1]) * bfhi(pp.x); h0[2] += sigmoidf_(a0[2]) * bflo(pp.y); h0[3] += sigmoidf_(a0[3]) * bfhi(pp.y);
                h1[0] += sigmoidf_(a1[0]) * bflo(pp.z); h1[1] += sigmoidf_(a1[1]) * bfhi(pp.z); h1[2] += sigmoidf_(a1[2]) * bflo(pp.w); h1[3] += sigmoidf_(a1[3]) * bfhi(pp.w);
                acc[ai][bj][m][0] = h0; acc[ai][bj][m][1] = h1;
                s += (h0[0] * h0[0] + h0[1] * h0[1]) + (h0[2] * h0[2] + h0[3] * h0[3]) + (h1[0] * h1[0] + h1[1] * h1[1]) + (h1[2] * h1[2] + h1[3] * h1[3]); }
            s += swz_xor<16>(s); s = sum_xor32(s);
            if (fq == 0) P[rit * 4 + wc] = s; }
        LDS_WAIT(); __builtin_amdgcn_s_barrier(); asm volatile("" ::: "memory");
        if (tid < 256) { const float t = (P[tid * 4] + P[tid * 4 + 1]) + (P[tid * 4 + 2] + P[tid * 4 + 3]);
            __hip_atomic_store(ssq + (size_t)(u.pm * 256 + tid) * 8 + u.pn, t, __ATOMIC_RELAXED, __HIP_MEMORY_SCOPE_AGENT); }
        asm volatile("s_waitcnt vmcnt(0)" ::: "memory");
        if (wid < 4 && l_ == 0) __hip_atomic_fetch_add(cnt + 64 * u.pm, 1u, __ATOMIC_RELAXED, __HIP_MEMORY_SCOPE_AGENT);
        if (wid == 0) {
            unsigned sp = 0;
            while ((unsigned)__builtin_amdgcn_readfirstlane(__hip_atomic_load(cnt + 64 * u.pm, __ATOMIC_RELAXED, __HIP_MEMORY_SCOPE_AGENT)) < 32u) { __builtin_amdgcn_s_sleep(2); if (++sp > (1u << 22)) break; }
            __builtin_amdgcn_fence(__ATOMIC_ACQUIRE, "agent");
        }
        asm volatile("s_waitcnt vmcnt(0) lgkmcnt(0)" ::: "memory"); __builtin_amdgcn_s_barrier(); asm volatile("" ::: "memory");
        if (tid < 256) { const float* sp = ssq + (size_t)(u.pm * 256 + tid) * 8; float t = 0.f;
#pragma unroll
            for (int i = 0; i < 8; ++i) t += __hip_atomic_load(sp + i, __ATOMIC_RELAXED, __HIP_MEMORY_SCOPE_AGENT);
            Rn[tid] = rsqrtf(t * (1.f / DM) + EPS); }
        LDS_WAIT(); __builtin_amdgcn_s_barrier(); asm volatile("" ::: "memory");
        EPI_FOR_ROWS { EPI_ROWDEF const float rn = Rn[rit];
#pragma unroll
            for (int bj = 0; bj < 2; ++bj) { const int col = u.pn * BM + bj * HALF + wc * 32 + 8 * fq; const size_t off = (size_t)row * DM + col;
                *(f32x4*)(H + off) = acc[ai][bj][m][0] * rn * *(const f32x4*)(nf + col); *(f32x4*)(H + off + 4) = acc[ai][bj][m][1] * rn * *(const f32x4*)(nf + col + 4); } }
    }
};
}

namespace att {
constexpr int D = 128, NW = 8, QBLK = 32, KVBLK = 64;
constexpr float SCALE = 0.088388347648318440f;
constexpr float THR = 8.f;
constexpr int LDQ = DATT, LDK = DKV;
constexpr size_t SHM_V = KVBLK * D * 2, SHM_K = KVBLK * D * 2, SHM_ATTN = 2 * SHM_V + 2 * SHM_K + NW * 64 * 4;
#define KSWZ(row, colB) ((row) * 256 + ((colB) ^ (((row) & 7) << 4)))
#define SBAR() __builtin_amdgcn_sched_barrier(0)
__device__ __forceinline__ int crow(int r, int hi) { return (r & 3) + 8 * (r >> 2) + 4 * hi; }
__device__ __forceinline__ void partialSM(f32x16& p0, f32x16& p1, float& m_reg, float& mn, float& alpha) {
  constexpr float C = SCALE * 1.4426950408889634f;
  float pmax = p0[0]; for (int r = 1; r < 16; ++r) pmax = fmaxf(pmax, p0[r]); for (int r = 0; r < 16; ++r) pmax = fmaxf(pmax, p1[r]);
  { auto rr = __builtin_amdgcn_permlane32_swap(__float_as_uint(pmax), __float_as_uint(pmax), false, false);
    pmax = fmaxf(__uint_as_float(rr[0]), __uint_as_float(rr[1])); }
  if (__builtin_expect(__all(pmax - m_reg <= THR / SCALE), 1)) { mn = m_reg; alpha = 1.f; }
  else { mn = fmaxf(m_reg, pmax); alpha = __builtin_amdgcn_exp2f((m_reg - mn) * C); m_reg = mn; }
  float mnC = -mn * C;
  for (int r = 0; r < 16; ++r) p0[r] = fmaf(p0[r], C, mnC); for (int r = 0; r < 16; ++r) p1[r] = fmaf(p1[r], C, mnC);
  for (int r = 0; r < 16; ++r) p0[r] = __builtin_amdgcn_exp2f(p0[r]);
}
__device__ __forceinline__ void finishSM(f32x16& p0, f32x16& p1, float alpha, float& l_reg, bf16x8& pa0, bf16x8& pa1, bf16x8& pa2, bf16x8& pa3) {
  for (int r = 0; r < 16; ++r) p1[r] = __builtin_amdgcn_exp2f(p1[r]);
  float ps = 0; for (int r = 0; r < 16; ++r) ps += p0[r]; for (int r = 0; r < 16; ++r) ps += p1[r];
  { auto rr = __builtin_amdgcn_permlane32_swap(__float_as_uint(ps), __float_as_uint(ps), false, false);
    ps = __uint_as_float(rr[0]) + __uint_as_float(rr[1]); }
  l_reg = l_reg * alpha + ps;
#define PK4(P, BASE, OUT) do { unsigned a0 = cvt_pk_bf16(P[BASE + 0], P[BASE + 1]), a1 = cvt_pk_bf16(P[BASE + 2], P[BASE + 3]);   \
    unsigned b0 = cvt_pk_bf16(P[BASE + 4], P[BASE + 5]), b1 = cvt_pk_bf16(P[BASE + 6], P[BASE + 7]);                              \
    auto r0 = __builtin_amdgcn_permlane32_swap(a0, b0, false, false); auto r1 = __builtin_amdgcn_permlane32_swap(a1, b1, false, false); \
    u32x4 w = {r0[0], r1[0], r0[1], r1[1]}; OUT = *reinterpret_cast<bf16x8*>(&w); } while (0)
  PK4(p0, 0, pa0); PK4(p0, 8, pa1); PK4(p1, 0, pa2); PK4(p1, 8, pa3);
#undef PK4
}
__device__ __forceinline__ void qkt(f32x16& p0, f32x16& p1, const bf16_t* Ks, const bf16x8* qr, int r32, int hi) {
  p0 = f32x16{}; p1 = f32x16{};
  for (int d0 = 0; d0 < 8; ++d0) { int cb = (d0 * 16 + hi * 8) * 2;
    bf16x8 b0 = *reinterpret_cast<const bf16x8*>((const char*)Ks + KSWZ(r32, cb));
    bf16x8 b1 = *reinterpret_cast<const bf16x8*>((const char*)Ks + KSWZ(32 + r32, cb));
    p0 = __builtin_amdgcn_mfma_f32_32x32x16_bf16(b0, qr[d0], p0, 0, 0, 0);
    p1 = __builtin_amdgcn_mfma_f32_32x32x16_bf16(b1, qr[d0], p1, 0, 0, 0); }
}
__device__ __forceinline__ int v_st(int k, int c) { const int kk = (k & ~0xC) | ((k & 4) << 1) | ((k & 8) >> 1); return ((kk >> 3) * 4 + (c >> 5)) * 512 + ((kk & 7) * 32 + (c & 31)) * 2; }
__device__ __forceinline__ int v_rd_base(int lane) { return ((lane & 3) << 3) | (((lane >> 2) & 3) << 6) | (((lane >> 4) & 1) << 5) | (((lane >> 5) & 1) << 8); }
constexpr int v_rd_off(int d0, int ks, int half) { return d0 * 512 + ks * 4096 + half * 2048; }
template <int OFF> __device__ __forceinline__ s16x4 tr_read(int vb) {
  s16x4 r; asm volatile("ds_read_b64_tr_b16 %0, %1 offset:%2" : "=&v"(r) : "v"(vb), "i"(OFF) : "memory"); return r;
}
template <int D0> __device__ __forceinline__ void pv_one(f32x16& od, int vb, bf16x8 pa0, bf16x8 pa1, bf16x8 pa2, bf16x8 pa3) {
  const s16x4 l0 = tr_read<v_rd_off(D0, 0, 0)>(vb), h0 = tr_read<v_rd_off(D0, 0, 1)>(vb), l1 = tr_read<v_rd_off(D0, 1, 0)>(vb), h1 = tr_read<v_rd_off(D0, 1, 1)>(vb);
  const s16x4 l2 = tr_read<v_rd_off(D0, 2, 0)>(vb), h2 = tr_read<v_rd_off(D0, 2, 1)>(vb), l3 = tr_read<v_rd_off(D0, 3, 0)>(vb), h3 = tr_read<v_rd_off(D0, 3, 1)>(vb);
  asm volatile("s_waitcnt lgkmcnt(0)" ::: "memory"); SBAR();
#define PK(L, H) (bf16x8){L[0], L[1], L[2], L[3], H[0], H[1], H[2], H[3]}
  od = __builtin_amdgcn_mfma_f32_32x32x16_bf16(pa0, PK(l0, h0), od, 0, 0, 0);
  od = __builtin_amdgcn_mfma_f32_32x32x16_bf16(pa1, PK(l1, h1), od, 0, 0, 0);
  od = __builtin_amdgcn_mfma_f32_32x32x16_bf16(pa2, PK(l2, h2), od, 0, 0, 0);
  od = __builtin_amdgcn_mfma_f32_32x32x16_bf16(pa3, PK(l3, h3), od, 0, 0, 0);
#undef PK
}
__device__ __forceinline__ void pv_d0(f32x16* o, int vb, bf16x8 pa0, bf16x8 pa1, bf16x8 pa2, bf16x8 pa3) {
  pv_one<0>(o[0], vb, pa0, pa1, pa2, pa3); pv_one<1>(o[1], vb, pa0, pa1, pa2, pa3); pv_one<2>(o[2], vb, pa0, pa1, pa2, pa3); pv_one<3>(o[3], vb, pa0, pa1, pa2, pa3);
}
__device__ __forceinline__ void attn_dense_body(const bf16_t* __restrict__ Qb, const bf16_t* __restrict__ Kh, const bf16_t* __restrict__ Vh,
                                                const bf16_t* __restrict__ Gb, bf16_t* __restrict__ Yb, int seq, char* lds, const int wid) {
  const int lane = lane_id_opaque(), tid = wid * 64 + lane, r32 = lane & 31, hi = lane >> 5;
  bf16_t* V_lds = (bf16_t*)lds; bf16_t* K_lds = (bf16_t*)(lds + 2 * SHM_V);
  float* ws = (float*)(lds + 2 * SHM_V + 2 * SHM_K) + wid * 64; float* li_l = ws; float* al_l = ws + 32;
  float m_reg = -1e30f, l_reg = 0; f32x16 o[4] = {}; bf16x8 qr[8];
  const bf16_t* Qw = Qb + (long)(wid * QBLK + r32) * LDQ + hi * 8;
#pragma unroll
  for (int d0 = 0; d0 < 8; ++d0) qr[d0] = __builtin_nontemporal_load(reinterpret_cast<const bf16x8*>(Qw + d0 * 16));
  const int sr = tid >> 4, sc = (tid & 15) * 8, vst0 = v_st(sr, sc), vst1 = v_st(32 + sr, sc);
  const int vb0 = (int)(uintptr_t)V_lds + v_rd_base(lane);
  struct { bf16x8 vs0, vs1, ks0, ks1; } sr_[2];
#define SLOAD(i, k0) do { sr_[i].vs0 = *reinterpret_cast<const bf16x8*>(&Vh[(long)((k0) + sr) * LDK + sc]); sr_[i].vs1 = *reinterpret_cast<const bf16x8*>(&Vh[(long)((k0) + 32 + sr) * LDK + sc]); \
    sr_[i].ks0 = *reinterpret_cast<const bf16x8*>(&Kh[(long)((k0) + sr) * LDK + sc]); sr_[i].ks1 = *reinterpret_cast<const bf16x8*>(&Kh[(long)((k0) + 32 + sr) * LDK + sc]); } while (0)
#define SWRITE(b, i) do { *(bf16x8*)((char*)V_lds + (b) * SHM_V + vst0) = sr_[i].vs0;          \
    *(bf16x8*)((char*)V_lds + (b) * SHM_V + vst1) = sr_[i].vs1; int kc = sc * 2;               \
    *(bf16x8*)((char*)K_lds + (b) * SHM_K + KSWZ(sr, kc)) = sr_[i].ks0;                       \
    *(bf16x8*)((char*)K_lds + (b) * SHM_K + KSWZ(32 + sr, kc)) = sr_[i].ks1; } while (0)
#define SWAIT() asm volatile("s_waitcnt vmcnt(4)" ::: "memory")
#define RESC(a) do { if (__any((a) < 1.f)) { if (hi == 0) al_l[r32] = (a); asm volatile("s_waitcnt lgkmcnt(0)" ::: "memory"); \
    for (int d = 0; d < 4; ++d) for (int r = 0; r < 16; ++r) o[d][r] *= al_l[crow(r, hi)]; } } while (0)
  f32x16 pA0, pA1, pB0, pB1; float mnA, mnB, alA, alB; bf16x8 pa0, pa1, pa2, pa3; const int NT = seq / KVBLK;
  constexpr int SE = 0, SO = 1;
  SLOAD(SE, 0); asm volatile("s_waitcnt vmcnt(0)" ::: "memory"); SWRITE(0, SE); __syncthreads();
  qkt(pA0, pA1, K_lds, qr, r32, hi); partialSM(pA0, pA1, m_reg, mnA, alA);
  SLOAD(SO, KVBLK); if (2 < NT) SLOAD(SE, 2 * KVBLK);
  SWAIT(); SWRITE(1, SO); __syncthreads();
  for (int j = 1; j + 1 < NT; j += 2) {
    SBAR(); qkt(pB0, pB1, (bf16_t*)((char*)K_lds + SHM_K), qr, r32, hi);
    finishSM(pA0, pA1, alA, l_reg, pa0, pa1, pa2, pa3); SBAR();
    SLOAD(SO, (j + 2) * KVBLK); SBAR();
    pv_d0(o, vb0, pa0, pa1, pa2, pa3); partialSM(pB0, pB1, m_reg, mnB, alB);
    __syncthreads(); SWAIT(); SWRITE(0, SE);
    RESC(alB); __syncthreads();
    SBAR(); qkt(pA0, pA1, K_lds, qr, r32, hi);
    finishSM(pB0, pB1, alB, l_reg, pa0, pa1, pa2, pa3); SBAR();
    if (j + 3 < NT) SLOAD(SE, (j + 3) * KVBLK); SBAR();
    pv_d0(o, vb0 + (int)SHM_V, pa0, pa1, pa2, pa3); partialSM(pA0, pA1, m_reg, mnA, alA);
    __syncthreads(); SWAIT(); SWRITE(1, SO);
    RESC(alA); __syncthreads();
  }
  SBAR(); qkt(pB0, pB1, (bf16_t*)((char*)K_lds + SHM_K), qr, r32, hi);
  finishSM(pA0, pA1, alA, l_reg, pa0, pa1, pa2, pa3); SBAR();
  pv_d0(o, vb0, pa0, pa1, pa2, pa3); partialSM(pB0, pB1, m_reg, mnB, alB);
  __syncthreads(); RESC(alB);
  finishSM(pB0, pB1, alB, l_reg, pa0, pa1, pa2, pa3); SBAR();
  pv_d0(o, vb0 + (int)SHM_V, pa0, pa1, pa2, pa3);
  if (hi == 0) li_l[r32] = l_reg; asm volatile("s_waitcnt lgkmcnt(0)" ::: "memory");
  float rli[16];
#pragma unroll
  for (int r = 0; r < 16; ++r) rli[r] = __builtin_amdgcn_rcpf(li_l[crow(r, hi)]);
  bf16_t* Yw = Yb + (long)(wid * QBLK) * DM; const bf16_t* Gw = Gb + (long)(wid * QBLK) * DATT;
  __syncthreads();
  bf16_t* stg = (bf16_t*)(lds + wid * 8192);
#pragma unroll
  for (int r = 0; r < 16; ++r) { const int orow = crow(r, hi);
#pragma unroll
    for (int d0 = 0; d0 < 4; ++d0) stg[orow * 128 + d0 * 32 + r32] = (bf16_t)f2bf(o[d0][r] * rli[r]); }
  asm volatile("s_waitcnt lgkmcnt(0)" ::: "memory");
  const int l2 = lane_id_opaque();
#pragma unroll
  for (int i = 0; i < 8; ++i) { const int q = l2 + 64 * i, row = q >> 4, c8 = (q & 15) * 8;
    const u32x4 v = *(const u32x4*)(stg + row * 128 + c8); const u32x4 gg = __builtin_nontemporal_load((const u32x4*)(Gw + (unsigned)(row * DATT + c8)));
    u32x4 w; w.x = pk2(bflo(v.x) * bflo(gg.x), bfhi(v.x) * bfhi(gg.x)); w.y = pk2(bflo(v.y) * bflo(gg.y), bfhi(v.y) * bfhi(gg.y));
    w.z = pk2(bflo(v.z) * bflo(gg.z), bfhi(v.z) * bfhi(gg.z)); w.w = pk2(bflo(v.w) * bflo(gg.w), bfhi(v.w) * bfhi(gg.w));
    *(u32x4*)(Yw + (unsigned)(row * DM + c8)) = w; }
  __syncthreads();
#undef SLOAD
#undef SWRITE
#undef SWAIT
#undef RESC
}
#undef SBAR
}

__device__ __forceinline__ void p0_transpose_item(const float* W, int K, int N, bf16_t* WT, int wt_row0, const float* kscale, LAS float* scr, int k0, int n0, int lane) {
#pragma unroll
    for (int i = 0; i < 32; ++i) { const int kk = 2 * i + (lane >> 5); float v = W[(size_t)(k0 + kk) * N + n0 + (lane & 31)]; if (kscale) v *= kscale[k0 + kk]; scr[kk * 33 + (lane & 31)] = v; }
    LDS_WAIT(); asm volatile("" ::: "memory");
    const int c = lane & 7;
#pragma unroll
    for (int j = 0; j < 4; ++j) { const int n = (lane >> 3) + 8 * j; const LAS float* s = scr + (8 * c) * 33 + n;
        u32x4 o; o.x = pk2(s[0 * 33], s[1 * 33]); o.y = pk2(s[2 * 33], s[3 * 33]); o.z = pk2(s[4 * 33], s[5 * 33]); o.w = pk2(s[6 * 33], s[7 * 33]);
        *(u32x4*)(WT + (size_t)(wt_row0 + n) * K + k0 + 8 * c) = o; }
    LDS_WAIT(); asm volatile("" ::: "memory");
}

struct TrItem { const float* W; bf16_t* WT; const float* kscale; int K, N, wt_row0, k0, n0; };
__device__ __forceinline__ void p0_tr_load(const TrItem& d, float (&v)[32], int lane) {
#pragma unroll
    for (int i = 0; i < 32; ++i) { const int kk = 2 * i + (lane >> 5); v[i] = __builtin_nontemporal_load(d.W + (size_t)(d.k0 + kk) * d.N + d.n0 + (lane & 31)); }
    if (d.kscale) {
#pragma unroll
        for (int i = 0; i < 32; ++i) { const int kk = 2 * i + (lane >> 5); v[i] *= d.kscale[d.k0 + kk]; } }
}
__device__ __forceinline__ void p0_tr_store(const TrItem& d, const float (&v)[32], LAS float* scr, int lane) {
#pragma unroll
    for (int i = 0; i < 32; ++i) { const int kk = 2 * i + (lane >> 5); scr[kk * 33 + (lane & 31)] = v[i]; }
    LDS_WAIT(); asm volatile("" ::: "memory");
    const int c = lane & 7;
#pragma unroll
    for (int j = 0; j < 4; ++j) { const int n = (lane >> 3) + 8 * j; const LAS float* s = scr + (8 * c) * 33 + n;
        u32x4 o; o.x = pk2(s[0 * 33], s[1 * 33]); o.y = pk2(s[2 * 33], s[3 * 33]); o.z = pk2(s[4 * 33], s[5 * 33]); o.w = pk2(s[6 * 33], s[7 * 33]);
        *(u32x4*)(d.WT + (size_t)(d.wt_row0 + n) * d.K + d.k0 + 8 * c) = o; }
    LDS_WAIT(); asm volatile("" ::: "memory");
}
__device__ __forceinline__ void ssm_tables(const Args& a, int g, LAS unsigned char* lds, int tid) {
    LAS float* LD = (LAS float*)lds;
    LAS float* LBs = LD + 256;
    LAS float* BB = LBs + 256;
    LAS float* KT = BB + 4096;
    LAS float* CC = KT + 8192;
    float* lb16 = (float*)(a.ws + WS_LB16);
    bf16_t* WIN = (bf16_t*)(a.ws + WS_WIN) + (size_t)g * 256 * 256;
    bf16_t* WBIG = (bf16_t*)(a.ws + WS_WBIG) + (size_t)g * 256 * 512;
    LAS float* DD = CC + 4096;
    float cre_[4], cim_[4], bre_[4], bim_[4];
#pragma unroll
    for (int k = 0; k < 4; ++k) { const int e = tid + 512 * k; const int d = e >> 10, r = e & 1023; const size_t ci_ = (size_t)(d * NG + g) * 1024 + r; cre_[k] = a.c_re[ci_]; cim_[k] = a.c_im[ci_];
        const int dp = e >> 4, h = e & 15, d2 = dp >> 6, p2 = dp & 63; const size_t bi_ = ((size_t)(d2 * NG + g) * 64 + p2) * 16 + h; bre_[k] = a.b_re[bi_]; bim_[k] = a.b_im[bi_]; }
    const float dld = a.ssm_d[g * 16 + (tid & 15)];
    const int d_a = (tid >> 6) & 1, p_a = tid & 63, idx_a = (d_a * NG + g) * 64 + p_a;
    const float are_ = a.a_re[idx_a], aim_ = a.a_im[idx_a], ldt_ = a.log_dt[d_a * NG + g];
#pragma unroll
    for (int k = 0; k < 4; ++k) { const int e = tid + 512 * k; CC[e * 2] = cre_[k]; CC[e * 2 + 1] = cim_[k]; }
    if (tid < 16) DD[tid] = dld;
    if (tid < 128) {
        const float lr = fminf(are_, -1e-4f), li = aim_;
        const float dt = expf(ldt_);
        const float er = expf(lr * dt); float sn, cs; sincosf(li * dt, &sn, &cs);
        const float br = er * cs, bi = er * sn;
        LD[tid * 2] = lr * dt; LD[tid * 2 + 1] = li * dt; LBs[tid * 2] = br; LBs[tid * 2 + 1] = bi;
        const float nr = br - 1.f, ni = bi, den = lr * lr + li * li;
        KT[tid * 2] = (nr * lr + ni * li) / den; KT[tid * 2 + 1] = (ni * lr - nr * li) / den;
        const float e16 = expf(16.f * lr * dt); float s16, c16; sincosf(16.f * li * dt, &s16, &c16);
        lb16[(g * 128 + tid) * 2] = e16 * c16; lb16[(g * 128 + tid) * 2 + 1] = e16 * s16;
    }
    __syncthreads();
#pragma unroll
    for (int k = 0; k < 4; ++k) { const int e = tid + 512 * k; const int dp = e >> 4;
        const float xr = bre_[k], xi = bim_[k], cr = KT[dp * 2], ci = KT[dp * 2 + 1];
        BB[e * 2] = cr * xr - ci * xi; BB[e * 2 + 1] = cr * xi + ci * xr;
    }
    __syncthreads();
    {
        const int d = tid >> 8, hp = (tid >> 4) & 15, h = tid & 15; float acc[16];
#pragma unroll
        for (int t = 0; t < 16; ++t) acc[t] = 0.f;
        const LAS float* cc = CC + ((d * 16 + hp) * 64) * 2;
#pragma unroll 4
        for (int p = 0; p < 64; ++p) {
            const float c_r = cc[p * 2], c_i = cc[p * 2 + 1], b_r = BB[((d * 64 + p) * 16 + h) * 2], b_i = BB[((d * 64 + p) * 16 + h) * 2 + 1];
            float wr = c_r * b_r - c_i * b_i, wi = c_r * b_i + c_i * b_r; const float l_r = LBs[(d * 64 + p) * 2], l_i = LBs[(d * 64 + p) * 2 + 1];
#pragma unroll
            for (int t = 0; t < 16; ++t) { acc[t] += wr; const float nr = wr * l_r - wi * l_i; wi = wr * l_i + wi * l_r; wr = nr; }
        }
#pragma unroll
        for (int t = 0; t < 16; ++t) KT[((d * 16 + t) * 16 + hp) * 16 + h] = acc[t];
    }
    __syncthreads();
    for (int q = tid; q < 8192; q += 512) {
        const int n = q >> 5, kc = q & 31, s = kc >> 1, h0 = (kc & 1) * 8, j = n >> 4, hp = n & 15;
        const int dsel = s < j ? 0 : 1, tau = s < j ? j - s : s - j;
        const LAS float* k0 = KT + ((dsel * 16 + tau) * 16 + hp) * 16 + h0;
        const LAS float* kf = KT + ((0 * 16 + 0) * 16 + hp) * 16 + h0; const LAS float* kb = KT + ((1 * 16 + 0) * 16 + hp) * 16 + h0;
        const bool diag = (s == j); const float dval = DD[hp];
        float v[8];
#pragma unroll
        for (int e = 0; e < 8; ++e) { const float off = k0[e], dg = kf[e] + kb[e] + ((h0 + e) == hp ? dval : 0.f); v[e] = diag ? dg : off; }
        u32x4 w; w.x = pk2(v[0], v[1]); w.y = pk2(v[2], v[3]); w.z = pk2(v[4], v[5]); w.w = pk2(v[6], v[7]);
        *(u32x4*)(WBIG + (size_t)n * 512 + s * 16 + h0) = w;
    }
    for (int q = tid; q < 2048; q += 512) {
        const int p = q & 63, js = (q >> 6) & 15, d = q >> 10; const float ldr = LD[(d * 64 + p) * 2], ldi = LD[(d * 64 + p) * 2 + 1];
        {   const float pw = (float)(d == 0 ? js + 1 : 16 - js); const float er = __expf(pw * ldr); float sn, cs; __sincosf(pw * ldi, &sn, &cs); const float pr = er * cs, pi = er * sn;
#pragma unroll
            for (int hp = 0; hp < 16; ++hp) { const float c_r = CC[((d * 16 + hp) * 64 + p) * 2], c_i = CC[((d * 16 + hp) * 64 + p) * 2 + 1];
                *(unsigned*)(WBIG + (size_t)(js * 16 + hp) * 512 + 256 + d * 128 + 2 * p) = pk2(c_r * pr - c_i * pi, -(c_r * pi + c_i * pr)); } }
        {   const float pw = (float)(d == 0 ? 15 - js : js); const float er = __expf(pw * ldr); float sn, cs; __sincosf(pw * ldi, &sn, &cs); const float pr = er * cs, pi = er * sn;
            float zr[16], zi[16];
#pragma unroll
            for (int h = 0; h < 16; ++h) { const float b_r = BB[((d * 64 + p) * 16 + h) * 2], b_i = BB[((d * 64 + p) * 16 + h) * 2 + 1]; zr[h] = pr * b_r - pi * b_i; zi[h] = pr * b_i + pi * b_r; }
            bf16_t* d0 = WIN + (size_t)(d * 128 + p) * 256 + js * 16; bf16_t* d1 = d0 + (size_t)64 * 256;
            u32x4 w; w.x = pk2(zr[0], zr[1]); w.y = pk2(zr[2], zr[3]); w.z = pk2(zr[4], zr[5]); w.w = pk2(zr[6], zr[7]); *(u32x4*)d0 = w;
            w.x = pk2(zr[8], zr[9]); w.y = pk2(zr[10], zr[11]); w.z = pk2(zr[12], zr[13]); w.w = pk2(zr[14], zr[15]); *(u32x4*)(d0 + 8) = w;
            w.x = pk2(zi[0], zi[1]); w.y = pk2(zi[2], zi[3]); w.z = pk2(zi[4], zi[5]); w.w = pk2(zi[6], zi[7]); *(u32x4*)d1 = w;
            w.x = pk2(zi[8], zi[9]); w.y = pk2(zi[10], zi[11]); w.z = pk2(zi[12], zi[13]); w.w = pk2(zi[14], zi[15]); *(u32x4*)(d1 + 8) = w; }
    }
    __syncthreads();
}

#define XB_TMO      128
#define XB_XCNT(j)  (256  + 64 * (j))
#define XB_XSUB(j)  (1280 + 64 * (j))
#define XB_XGEN(j)  (2304 + 64 * (j))
#define XB_TOP      3328
#define XB_TOPGEN   3392
#define XCD_BAR_WORDS 3456
#define XB_SPIN_CAP (1u << 18)
__device__ __forceinline__ unsigned xb_ld(unsigned* p)              { return __hip_atomic_load(p, __ATOMIC_RELAXED, __HIP_MEMORY_SCOPE_AGENT); }
__device__ __forceinline__ unsigned xb_add(unsigned* p, unsigned v) { return __hip_atomic_fetch_add(p, v, __ATOMIC_RELAXED, __HIP_MEMORY_SCOPE_AGENT); }
__device__ __forceinline__ unsigned xb_xcc_id() { return (unsigned)__builtin_amdgcn_s_getreg((3 << 11) | 20) & 0xFu; }
#define XB_SPIN(cond, bar) do { unsigned _sp = 0; while (cond) { __builtin_amdgcn_s_sleep(1); \
    if ((++_sp & 255u) == 0u) { if (xb_ld(&(bar)[XB_TMO])) break; if (_sp > XB_SPIN_CAP) { atomicAdd(&(bar)[XB_TMO], 1u); break; } } } } while (0)
struct XcdBarrier { unsigned* bar; unsigned x; volatile LAS unsigned* st; };
__device__ __forceinline__ XcdBarrier xcd_barrier_post(unsigned* bar, volatile LAS unsigned* st, bool leader) {
    XcdBarrier b; b.bar = bar; b.x = xb_xcc_id(); b.st = st;
    if (leader) (void)xb_add(&bar[XB_XCNT(b.x)], 1u);
    return b;
}
__device__ __forceinline__ void xcd_barrier_complete(unsigned* bar, unsigned x, unsigned& nloc, unsigned& nx) {
    const unsigned G = gridDim.x * gridDim.y * gridDim.z;
    unsigned sum, cnt, mine, sp = 0u;
    for (;;) {
        sum = 0u; cnt = 0u; mine = 0u;
#pragma unroll
        for (unsigned j = 0; j < 16; ++j) { const unsigned c = xb_ld(&bar[XB_XCNT(j)]); sum += c; cnt += (c > 0u) ? 1u : 0u; mine = (j == x) ? c : mine; }
        if (sum == G) break;
        __builtin_amdgcn_s_sleep(1);
        if ((++sp & 255u) == 0u) { if (xb_ld(&bar[XB_TMO])) break; if (sp > XB_SPIN_CAP) { atomicAdd(&bar[XB_TMO], 1u); break; } }
    }
    nloc = mine > 0u ? mine : 1u; nx = cnt > 0u ? cnt : 1u;
}
__device__ __forceinline__ void xcd_barrier(const XcdBarrier& b, bool leader) {
    asm volatile("s_waitcnt vmcnt(0)" ::: "memory");
    __syncthreads();
    if (leader) {
        unsigned* bar = b.bar;
        __builtin_amdgcn_s_waitcnt(0);
        unsigned nloc = b.st[0], nx = b.st[1];
        if (nloc == 0u) { xcd_barrier_complete(bar, b.x, nloc, nx); b.st[0] = nloc; b.st[1] = nx; }
        const unsigned old = xb_add(&bar[XB_XSUB(b.x)], 1u);
        const unsigned gen = old / nloc;
        if (old + 1u == (gen + 1u) * nloc) {
            __builtin_amdgcn_fence(__ATOMIC_RELEASE, "agent");
            asm volatile("s_waitcnt vmcnt(0)" ::: "memory");
            const unsigned og = xb_add(&bar[XB_TOP], 1u);
            const unsigned tg = og / nx;
            if (og + 1u == (tg + 1u) * nx) xb_add(&bar[XB_TOPGEN], 1u);
            else XB_SPIN(xb_ld(&bar[XB_TOPGEN]) == tg, bar);
            __builtin_amdgcn_fence(__ATOMIC_ACQUIRE, "agent");
            xb_add(&bar[XB_XGEN(b.x)], 1u);
            asm volatile("s_waitcnt vmcnt(0)" ::: "memory");
        } else {
            XB_SPIN(xb_ld(&bar[XB_XGEN(b.x)]) == gen, bar);
            __builtin_amdgcn_fence(__ATOMIC_ACQUIRE, "agent");
            asm volatile("s_waitcnt vmcnt(0)" ::: "memory");
        }
    }
    __syncthreads();
}

__device__ __forceinline__ void xcd_barrier_arrive(const XcdBarrier& b, bool leader) {
    asm volatile("s_waitcnt vmcnt(0)" ::: "memory");
    __syncthreads();
    if (leader) {
        unsigned* bar = b.bar;
        __builtin_amdgcn_s_waitcnt(0);
        unsigned nloc = b.st[0], nx = b.st[1];
        if (nloc == 0u) { xcd_barrier_complete(bar, b.x, nloc, nx); b.st[0] = nloc; b.st[1] = nx; }
        const unsigned old = xb_add(&bar[XB_XSUB(b.x)], 1u);
        const unsigned gen = old / nloc;
        if (old + 1u == (gen + 1u) * nloc) {
            __builtin_amdgcn_fence(__ATOMIC_RELEASE, "agent");
            asm volatile("s_waitcnt vmcnt(0)" ::: "memory");
            const unsigned og = xb_add(&bar[XB_TOP], 1u);
            const unsigned tg = og / nx;
            if (og + 1u == (tg + 1u) * nx) { xb_add(&bar[XB_TOPGEN], 1u); b.st[5] = 3u; } else b.st[5] = 2u;
            b.st[6] = tg;
        } else { b.st[5] = 1u; b.st[6] = gen; }
    }
}
__device__ __forceinline__ void xcd_barrier_wait(const XcdBarrier& b, bool leader) {
    if (leader) {
        unsigned* bar = b.bar; const unsigned role = b.st[5], g = b.st[6];
        if (role >= 2u) {
            if (role == 2u) XB_SPIN(xb_ld(&bar[XB_TOPGEN]) == g, bar);
            __builtin_amdgcn_fence(__ATOMIC_ACQUIRE, "agent");
            xb_add(&bar[XB_XGEN(b.x)], 1u);
            asm volatile("s_waitcnt vmcnt(0)" ::: "memory");
        } else {
            XB_SPIN(xb_ld(&bar[XB_XGEN(b.x)]) == g, bar);
            __builtin_amdgcn_fence(__ATOMIC_ACQUIRE, "agent");
            asm volatile("s_waitcnt vmcnt(0)" ::: "memory");
        }
    }
    __syncthreads();
}

__global__ void __launch_bounds__(512, 2) fwd_kernel(Args a) {
    extern __shared__ __attribute__((aligned(16))) unsigned char lds_raw[];
    LAS unsigned char* lds = (LAS unsigned char*)lds_raw;
    cg::grid_group grid = cg::this_grid();
    const int wave = __builtin_amdgcn_readfirstlane(threadIdx.x >> 6);
    const bool leader = (wave == 0) && (lane_id_opaque() == 0);
    volatile LAS unsigned* xst = (volatile LAS unsigned*)(lds + XBST_OFF);
    if (leader) { xst[0] = 0u; xst[1] = 0u; }
    __syncthreads();
    if (a.ws == nullptr) grid.sync();
    const XcdBarrier xbar = xcd_barrier_post((unsigned*)(a.ws + WS_BAR), xst, leader);
#define GRID_SYNC() xcd_barrier(xbar, (wave == 0) && (lane_id_opaque() == 0))
#define LANE_IDS const int lane = lane_id_opaque(), tid = wave * 64 + lane; (void)tid;
    const int G = gridDim.x, bid = blockIdx.x;
    unsigned char* ws = a.ws;
    bf16_t* W1T = (bf16_t*)(ws + WS_W1T); bf16_t* WGLUT = (bf16_t*)(ws + WS_WGLUT); bf16_t* WOT = (bf16_t*)(ws + WS_WOT); bf16_t* WGT = (bf16_t*)(ws + WS_WGT); bf16_t* WPT = (bf16_t*)(ws + WS_WPT);
    float2* ROPE = (float2*)(ws + WS_ROPE); float* RINV = (float*)(ws + WS_RINV); float* LB16 = (float*)(ws + WS_LB16); float* SSQ1 = (float*)(ws + WS_SSQ1); float* SSQ2 = (float*)(ws + WS_SSQ2);
    bf16_t* PB = (bf16_t*)(ws + WS_PB); bf16_t* WIN = (bf16_t*)(ws + WS_WIN); bf16_t* WBIG = (bf16_t*)(ws + WS_WBIG);
    bf16_t* XB = (bf16_t*)(ws + WS_XB); bf16_t* HB = (bf16_t*)(ws + WS_XB);
    bf16_t* Q = (bf16_t*)(ws + WS_Q); bf16_t* KB = (bf16_t*)(ws + WS_K); bf16_t* VB = (bf16_t*)(ws + WS_V); bf16_t* GA = (bf16_t*)(ws + WS_GA); bf16_t* GS = (bf16_t*)(ws + WS_GS);
    bf16_t* UCAT = (bf16_t*)(ws + WS_UCAT); bf16_t* PPB = (bf16_t*)(ws + WS_UCAT); bf16_t* YMIX = (bf16_t*)(ws + WS_YMIX); bf16_t* YS = (bf16_t*)(ws + WS_YS);

#pragma unroll
    for (int rep_ = 0; rep_ < 1 + ((REP_MASK >> 0) & 1); ++rep_) { LANE_IDS
        const int gw = bid * 8 + wave, NGW = G * 8;
        LAS float* scr = (LAS float*)(lds + wave * 16384);
        constexpr int I1 = 32 * 144, I2 = 16 * 64, I3 = 32 * 64, I4 = 32 * 64, I5 = 4 * 64, NIT = I1 + I2 + I3 + I4 + I5;
        auto item_desc = [&](int r) -> TrItem {
            if (r < I1) { const int kb = r / 144, lgg = r % 144, pn = lgg >> 3, lg = lgg & 7, wtg = pn * 8 + 4 * (lg & 1) + 2 * (lg >> 2) + ((lg >> 1) & 1);
                return TrItem{a.w_in, W1T, a.norm_mix, DM, DIN, wtg * 32, kb * 64, lgg * 32}; } r -= I1;
            if (r < I2) { const int kb = r / 64, lgg = r % 64, l2 = lgg & 31, wtg = (l2 >> 2) * 8 + 4 * (lgg >> 5) + (l2 & 3);
                return TrItem{a.w_glu, WGLUT, nullptr, DSSM, 2 * DSSM, wtg * 32, kb * 64, lgg * 32}; } r -= I2;
            if (r < I3) { const int kb = r / 64, lgg = r % 64; return TrItem{a.w_out, WOT, nullptr, DM, DM, lgg * 32, kb * 64, lgg * 32}; } r -= I3;
            if (r < I4) { const int kb = r / 64, lgg = r % 64; return TrItem{a.w_ple_gate, WGT, a.norm_ple, DM, DM, lgg * 32, kb * 64, lgg * 32}; } r -= I4;
            const int kb = r / 64, lgg = r % 64; return TrItem{a.w_ple_proj, WPT, nullptr, PLE, DM, lgg * 32, kb * 64, lgg * 32};
        };
#pragma unroll
        for (int rq_ = 0; rq_ < 1 + ((REP_MASK >> 8) & 1); ++rq_)
        for (int it = gw; it < I1; it += 2 * NGW) {
            const bool two = it + NGW < I1;
            const TrItem dA = item_desc(it), dB = item_desc(two ? it + NGW : it);
            float vA[32], vB[32];
            p0_tr_load(dA, vA, lane); if (two) p0_tr_load(dB, vB, lane);
            p0_tr_store(dA, vA, scr, lane); if (two) p0_tr_store(dB, vB, scr, lane);
        }
        const int xrow0 = (G == 256) ? 1024 * (bid & 7) + ((bid >> 3) * 8 + wave) : gw; const int xstep = (G == 256) ? 256 : NGW, xend = (G == 256) ? 1024 * (bid & 7) + 1024 : T;
#pragma unroll
        for (int rq_ = 0; rq_ < 1 + ((REP_MASK >> 9) & 1); ++rq_)
        for (int m = xrow0; m < xend; m += 2 * xstep) {
            const int m2 = m + xstep; const bool two = m2 < xend;
            const f32x4* xr = (const f32x4*)(a.x + (size_t)m * DM) + lane; const f32x4* xr2 = (const f32x4*)(a.x + (size_t)(two ? m2 : m) * DM) + lane;
            f32x4 v[8], w2[8]; float s = 0.f, s2 = 0.f;
#pragma unroll
            for (int j = 0; j < 8; ++j) v[j] = __builtin_nontemporal_load(xr + 64 * j);
#pragma unroll
            for (int j = 0; j < 8; ++j) w2[j] = __builtin_nontemporal_load(xr2 + 64 * j);
#pragma unroll
            for (int j = 0; j < 8; ++j) { s += (v[j][0] * v[j][0] + v[j][1] * v[j][1]) + (v[j][2] * v[j][2] + v[j][3] * v[j][3]); s2 += (w2[j][0] * w2[j][0] + w2[j][1] * w2[j][1]) + (w2[j][2] * w2[j][2] + w2[j][3] * w2[j][3]); }
            s = wave_sum(s); s2 = wave_sum(s2);
            if (lane == 0) { RINV[m] = rsqrtf(s * (1.f / DM) + EPS); if (two) RINV[m2] = rsqrtf(s2 * (1.f / DM) + EPS); }
            u32x2* o = (u32x2*)(XB + (size_t)m * DM) + lane; u32x2* o2 = (u32x2*)(XB + (size_t)m2 * DM) + lane;
#pragma unroll
            for (int j = 0; j < 8; ++j) { u32x2 w; w.x = pk2(v[j][0], v[j][1]); w.y = pk2(v[j][2], v[j][3]); o[64 * j] = w; }
            if (two) {
#pragma unroll
                for (int j = 0; j < 8; ++j) { u32x2 w; w.x = pk2(w2[j][0], w2[j][1]); w.y = pk2(w2[j][2], w2[j][3]); o2[64 * j] = w; } }
        }
        for (int i = bid * 512 + tid; i < T * PLE / 4; i += G * 512) { const f32x4 v = __builtin_nontemporal_load((const f32x4*)a.p + i); u32x2 w; w.x = pk2(v[0], v[1]); w.y = pk2(v[2], v[3]); ((u32x2*)PB)[i] = w; }
        for (int i = bid * 512 + tid; i < 2048; i += G * 512) { const int pos = i >> 5, f = i & 31; const float inv = powf(10000.f, -(float)f / 32.f); float sn, cs; sincosf((float)pos * inv, &sn, &cs); ROPE[i] = make_float2(cs, sn); }
        xcd_barrier_arrive(xbar, (wave == 0) && (lane_id_opaque() == 0));
        for (int it = I1 + gw; it < NIT; it += 2 * NGW) {
            const bool two = it + NGW < NIT;
            const TrItem dA = item_desc(it), dB = item_desc(two ? it + NGW : it);
            float vA[32], vB[32];
            p0_tr_load(dA, vA, lane); if (two) p0_tr_load(dB, vB, lane);
            p0_tr_store(dA, vA, scr, lane); if (two) p0_tr_store(dB, vB, scr, lane);
        }
        xcd_barrier_wait(xbar, (wave == 0) && (lane_id_opaque() == 0)); }


    if constexpr ((REP_MASK >> 10) & 1) { GRID_SYNC(); GRID_SYNC(); GRID_SYNC(); GRID_SYNC(); }
#pragma unroll
    for (int rep_ = 0; rep_ < 1 + ((REP_MASK >> 1) & 1); ++rep_) { LANE_IDS
        { pg8::Gemm g{XB, W1T, DM, DM, DM, 0, 0}; pg8::StaticOrder S; S.init(T, 14 * 256, G, bid);
          pg8::Epi1 E{RINV, a.q_norm, a.k_norm, ROPE, Q, KB, VB, GA, GS, UCAT, (LAS float*)(lds + XCH_OFF), 0};
          pg8::gemm_phase<pg8::Epi1, pg8::StaticOrder, true>(lds, g, S, E, wave); }
        __syncthreads();
        for (int gi = bid - (G - NG); gi >= 0 && gi < NG; gi += NG) ssm_tables(a, gi, lds, tid);
    GRID_SYNC(); }

#pragma unroll
    for (int rep_ = 0; rep_ < 1 + ((REP_MASK >> 2) & 1); ++rep_) {
#pragma unroll
        for (int rq_ = 0; rq_ < 2; ++rq_) {
        if (bid < 2 * NG) { if (rq_ == 1 && !((REP_MASK >> 6) & 1)) break;
            pg8::BatchOrder S{2 * NG, G, bid};
            { pg8::Gemm g{UCAT, WIN, 256, 512, 256, (size_t)NCH * 512 * 2, (size_t)256 * 256 * 2};
              pg8::EpiS1 E{LB16, UCAT}; pg8::gemm_phase<pg8::EpiS1, pg8::BatchOrder, true>(lds, g, S, E, wave); }
            asm volatile("s_waitcnt vmcnt(0)\n\tbuffer_inv sc1\n\ts_waitcnt vmcnt(0)" ::: "memory"); __syncthreads();
            { pg8::Gemm g{UCAT, WBIG, 512, 512, 512, (size_t)NCH * 512 * 2, (size_t)256 * 512 * 2};
              pg8::EpiS2 E{YS}; pg8::gemm_phase<pg8::EpiS2, pg8::BatchOrder, true>(lds, g, S, E, wave); }
        } else { if (rq_ == 1 && !((REP_MASK >> 11) & 1)) break;
            pg8::Gemm g{XB, W1T + (size_t)14 * 256 * DM, DM, DM, DM, 0, 0}; pg8::ListOrder S{bid - 2 * NG, 128, G};
            pg8::Epi1 E{RINV, a.q_norm, a.k_norm, ROPE, Q, KB, VB, GA, GS, UCAT, (LAS float*)(lds + XCH_OFF), 14};
            pg8::gemm_phase<pg8::Epi1, pg8::ListOrder, true>(lds, g, S, E, wave);
        }
        __syncthreads(); }
#pragma unroll
        for (int rq_ = 0; rq_ < 1 + ((REP_MASK >> 7) & 1); ++rq_)
        for (int un = bid; un < 256; un += G) {
            const int x = un & 7, jj = un >> 3, b = x >> 2, kvh = (x >> 1) & 1, idx = (x & 1) * 32 + jj, h = kvh * 4 + (idx >> 4), qb = idx & 15;
            const size_t tok0 = (size_t)b * SEQ + qb * 256;
            att::attn_dense_body(Q + tok0 * DATT + h * 128, KB + (size_t)b * SEQ * DKV + kvh * 128, VB + (size_t)b * SEQ * DKV + kvh * 128,
                                 GA + tok0 * DATT + h * 128, YMIX + tok0 * DM + h * 128, SEQ, (char*)lds_raw, wave);
        }
    GRID_SYNC(); }

#pragma unroll
    for (int rep_ = 0; rep_ < 1 + ((REP_MASK >> 3) & 1); ++rep_) {
        { pg8::StaticOrder S; S.init(T, 2 * DSSM, G, bid); pg8::Unit ua, ub;
          if (S.next(0, ua)) { ub = ua;
            pg8::Gemm ga{YS, WGLUT, DSSM, DSSM, DSSM, 0, 0}; pg8::EpiGlu Ea{a.b_glu, GS, YMIX};
            pg8::Gemm gb{PB, WPT, PLE, PLE, PLE, 0, 0}; pg8::EpiBf Eb{PPB, DM};
            pg8::gemm_phase2<pg8::EpiGlu, pg8::EpiBf>(lds, ga, ua, Ea, gb, ub, Eb, wave); } }
    GRID_SYNC(); }

#pragma unroll
    for (int rep_ = 0; rep_ < 1 + ((REP_MASK >> 4) & 1); ++rep_) {
        pg8::Gemm g{YMIX, WOT, DM, DM, DM, 0, 0}; pg8::StaticOrder S; S.init(T, DM, G, bid);
        pg8::EpiOut E{a.x, a.out, HB, SSQ1}; pg8::gemm_phase<pg8::EpiOut, pg8::StaticOrder, true>(lds, g, S, E, wave);
    GRID_SYNC(); }


    { LANE_IDS
        pg8::StaticOrder S; S.init(T, DM, G, bid); pg8::Unit u0;
        LAS float* r2 = (LAS float*)(lds + R2_OFF);
        if (S.next(0, u0) && tid < 256) { const float* sp = SSQ1 + (size_t)(u0.pm * 256 + tid) * 32; float s = 0.f;
#pragma unroll
            for (int i = 0; i < 8; ++i) { const f32x4 v = ((const f32x4*)sp)[i]; s += (v[0] + v[1]) + (v[2] + v[3]); }
            r2[tid] = rsqrtf(s * (1.f / DM) + EPS); }
        __syncthreads();
        pg8::Gemm g{HB, WGT, DM, DM, DM, 0, 0};
        pg8::EpiGate E{a.out, PPB, SSQ2, (unsigned*)ws, a.norm_final, r2, HB}; pg8::gemm_phase<pg8::EpiGate, pg8::StaticOrder, true>(lds, g, S, E, wave);
    }
}

extern "C" void kernel_launch(void* const* d_in, const int* in_sizes, int n_in, void* d_out, int out_size, void* d_ws, size_t ws_size, hipStream_t stream) {
    static int grid = 0;
    if (grid == 0) {
        if (n_in != 21 || in_sizes[0] != T * DM || out_size != T * DM || ws_size < WS_END) { fprintf(stderr, "kernel_launch: unexpected shapes (n_in %d, in0 %d, out %d, ws %zu)\n", n_in, n_in > 0 ? in_sizes[0] : -1, out_size, ws_size); grid = -1; return; }
        int dev = 0, cus = 0, per_cu = 0;
        hipGetDevice(&dev); hipDeviceGetAttribute(&cus, hipDeviceAttributeMultiprocessorCount, dev);
        if (hipFuncSetAttribute((const void*)fwd_kernel, hipFuncAttributeMaxDynamicSharedMemorySize, LDS_BYTES) != hipSuccess) { fprintf(stderr, "kernel_launch: hipFuncSetAttribute failed\n"); grid = -1; return; }
        hipOccupancyMaxActiveBlocksPerMultiprocessor(&per_cu, (const void*)fwd_kernel, 512, LDS_BYTES);
        (void)hipGetLastError();
        if (per_cu < 1) fprintf(stderr, "kernel_launch: occupancy query reports %d blocks per CU\n", per_cu);
        grid = cus > 256 ? 256 : cus;
    }
    if (grid < 0) return;
    Args a{};
    const float** f = (const float**)&a;
    for (int i = 0; i < 21; ++i) f[i] = (const float*)d_in[i];
    a.out = (float*)d_out; a.ws = (unsigned char*)d_ws;
    if (hipMemsetAsync(d_ws, 0, WS_CTL_BYTES, stream) != hipSuccess) { fprintf(stderr, "kernel_launch: hipMemsetAsync failed\n"); return; }
    void* args[] = {&a};
    hipError_t e = hipLaunchCooperativeKernel((const void*)fwd_kernel, dim3(grid), dim3(512), args, LDS_BYTES, stream);
    if (e != hipSuccess) fprintf(stderr, "kernel_launch: cooperative launch failed: %s (grid %d)\n", hipGetErrorString(e), grid);
}
```
